# Optimizing an MI355X kernel written in HIP

```python
import math
import jax, jax.numpy as jnp
from jax import lax
import numpy as np

D_MODEL = 2048
BATCH = 4
SEQ = 2048
DEPTH = 2

CTX_LEN = 256
GRID_W = 64
N_MIXERS = 4
GROUP_W = D_MODEL // N_MIXERS

CHUNK = 128
SGU_HEADS = 4
SGU_HEAD_DIM = GROUP_W // SGU_HEADS

MLA_HEADS = 4
QK_NOPE = 128
QK_ROPE = 64
V_DIM = GROUP_W // MLA_HEADS
Q_LORA = 384
KV_LORA = 256
ROPE_THETA = 10000.0
Q_BLOCK = 128

S5_CH = 16
S5_GROUPS = GROUP_W // S5_CH
S5_STATE = 64
S5_MAX_RE = -1e-4
S5_DT_MIN = 1e-3
S5_DT_MAX = 1e-1

CONV_WIDTH = 3

N_EXPERTS = 16
EXPERT_FF = D_MODEL // 2
CAPACITY_FACTOR = 2

EPS = 1e-6

IN_SGU = 2 * GROUP_W
IN_MLA = Q_LORA + KV_LORA + QK_ROPE
IN_S5 = GROUP_W
IN_CONV = 3 * GROUP_W
IN_COLS = IN_SGU + IN_MLA + IN_S5 + IN_CONV
IN_SPLITS = (IN_SGU, IN_SGU + IN_MLA, IN_SGU + IN_MLA + IN_S5)

kernel_name = "hybrid_parallel_dit_block"


def rmsnorm(x, g):
    xf = x.astype(jnp.float32)
    y = xf * lax.rsqrt(jnp.mean(xf * xf, axis=-1, keepdims=True) + EPS)
    return (y * g.astype(jnp.float32)).astype(x.dtype)


def sgu_mix(p, norm_g, w_s, b_s):
    bsz, n, _ = p.shape
    u, v = jnp.split(jax.nn.gelu(p), 2, axis=-1)
    v = rmsnorm(v, norm_g).reshape(bsz, n // CHUNK, CHUNK, SGU_HEADS, SGU_HEAD_DIM)
    mixed = jnp.einsum("hpq,bkqhc->bkphc", w_s, v) + jnp.swapaxes(b_s, 0, 1)[None, None, :, :, None]
    return u * mixed.reshape(bsz, n, GROUP_W)


def rotate_pairs(xh, ang):
    x1, x2 = jnp.split(xh, 2, axis=-1)
    cos = jnp.cos(ang).astype(xh.dtype)
    sin = jnp.sin(ang).astype(xh.dtype)
    return jnp.concatenate([x1 * cos - x2 * sin, x2 * cos + x1 * sin], axis=-1)


def rope_2d(x, ang_row, ang_col):
    xr, xc = jnp.split(x, 2, axis=-1)
    return jnp.concatenate([rotate_pairs(xr, ang_row), rotate_pairs(xc, ang_col)], axis=-1)


def mla_queries(p_q, q_norm_g, w_uq):
    bsz, n, _ = p_q.shape
    q = (rmsnorm(p_q, q_norm_g) @ w_uq).reshape(bsz, n, MLA_HEADS, QK_NOPE + QK_ROPE)
    return q[..., :QK_NOPE], q[..., QK_NOPE:]


def mla_keys_values(p_kv, kv_norm_g, w_ukv):
    bsz, n, _ = p_kv.shape
    kv = (rmsnorm(p_kv, kv_norm_g) @ w_ukv).reshape(bsz, n, MLA_HEADS, QK_NOPE + V_DIM)
    return kv[..., :QK_NOPE], kv[..., QK_NOPE:]


def attend(qn, qr, kn, kr, v):
    s = jnp.einsum("bqhd,bkhd->bhqk", qn, kn) + jnp.einsum("bqhr,bkr->bhqk", qr, kr)
    pr = jax.nn.softmax(s.astype(jnp.float32) * (QK_NOPE + QK_ROPE) ** -0.5, axis=-1)
    return jnp.einsum("bhqk,bkhd->bqhd", pr.astype(v.dtype), v)


def blocked_attention(qn, qr, kn, kr, v):
    bsz, n = qn.shape[0], qn.shape[1]
    nblk = n // Q_BLOCK

    def to_blocks(t):
        return jnp.moveaxis(t.reshape(bsz, nblk, Q_BLOCK, *t.shape[2:]), 1, 0)

    out = lax.map(lambda qb: attend(qb[0], qb[1], kn, kr, v), (to_blocks(qn), to_blocks(qr)))
    return jnp.moveaxis(out, 0, 1).reshape(bsz, n, MLA_HEADS * V_DIM)


def s5_discretise(a_re, a_im, log_dt, b_re, b_im, c_re, c_im):
    a = lax.complex(jnp.minimum(a_re.astype(jnp.float32), S5_MAX_RE), a_im.astype(jnp.float32))
    dt = jnp.exp(log_dt.astype(jnp.float32))[..., None]
    abar = jnp.exp(a * dt)
    bbar = ((abar - 1.0) / a)[..., None] * lax.complex(b_re.astype(jnp.float32), b_im.astype(jnp.float32))
    cmat = lax.complex(c_re.astype(jnp.float32), c_im.astype(jnp.float32))
    return abar, bbar, cmat


def ssm_combine(e1, e2):
    a1, b1 = e1
    a2, b2 = e2
    return a1 * a2, a2 * b1 + b2


def linear_scan(abar, bu, s0, reverse):
    if s0 is not None:
        edge = -1 if reverse else 0
        bu = bu.at[:, edge].add(abar * s0)
    a = jnp.broadcast_to(abar, bu.shape)
    _, s = lax.associative_scan(ssm_combine, (a, bu), reverse=reverse, axis=1)
    return s


def s5_states(u, abar, bbar, s0_f, s0_b):
    bsz, n, _ = u.shape
    uf = u.astype(jnp.float32).reshape(bsz, n, S5_GROUPS, S5_CH)
    bu = jnp.einsum("blgc,zgnc->zblgn", uf, bbar)
    s_f = linear_scan(abar[0], bu[0], s0_f, reverse=False)
    s_b = linear_scan(abar[1], bu[1], s0_b, reverse=True)
    return s_f, s_b


def s5_readout(u, s_f, s_b, cmat, d_skip, w_glu, b_glu):
    bsz, n, _ = u.shape
    uf = u.astype(jnp.float32).reshape(bsz, n, S5_GROUPS, S5_CH)
    y = jnp.real(jnp.einsum("blgn,gcn->blgc", s_f, cmat[0]) + jnp.einsum("blgn,gcn->blgc", s_b, cmat[1]))
    y = y + d_skip.astype(jnp.float32).reshape(S5_GROUPS, S5_CH) * uf
    g = jax.nn.gelu(y.reshape(bsz, n, GROUP_W).astype(u.dtype))
    return g * jax.nn.sigmoid(g @ w_glu + b_glu)


def conv_mix(p, conv_w):
    b_gate, c_gate, h = jnp.split(p, 3, axis=-1)
    z = c_gate * h
    y = lax.conv_general_dilated(
        z, conv_w[:, None, :], window_strides=(1,),
        padding=((CONV_WIDTH // 2, CONV_WIDTH // 2),),
        dimension_numbers=("NWC", "WIO", "NWC"), feature_group_count=GROUP_W)
    return b_gate * y


def token_mixing(h_l, h_c, ang_row, ang_col, with_ctx_out, w_in, w_out,
                 sgu_norm_g, sgu_w, sgu_b, q_norm_g, w_uq, kv_norm_g, w_ukv,
                 a_re, a_im, log_dt, b_re, b_im, c_re, c_im, d_skip, w_glu, b_glu, conv_w):
    p_l = jnp.split(h_l @ w_in, IN_SPLITS, axis=-1)
    p_c = jnp.split(h_c @ w_in, IN_SPLITS, axis=-1)

    kn_c, v_c = mla_keys_values(p_c[1][..., Q_LORA:Q_LORA + KV_LORA], kv_norm_g, w_ukv)
    kr_c = p_c[1][..., Q_LORA + KV_LORA:]
    qn_l, qr_l = mla_queries(p_l[1][..., :Q_LORA], q_norm_g, w_uq)
    kn_l, v_l = mla_keys_values(p_l[1][..., Q_LORA:Q_LORA + KV_LORA], kv_norm_g, w_ukv)
    qr_l = rope_2d(qr_l, ang_row[:, None, :], ang_col[:, None, :])
    kr_l = rope_2d(p_l[1][..., Q_LORA + KV_LORA:], ang_row, ang_col)
    attn_l = blocked_attention(qn_l, qr_l,
                               jnp.concatenate([kn_c, kn_l], axis=1),
                               jnp.concatenate([kr_c, kr_l], axis=1),
                               jnp.concatenate([v_c, v_l], axis=1))

    abar, bbar, cmat = s5_discretise(a_re, a_im, log_dt, b_re, b_im, c_re, c_im)
    sf_c, sb_c = s5_states(p_c[2], abar, bbar, None, None)
    sf_l, sb_l = s5_states(p_l[2], abar, bbar, sf_c[:, -1], sb_c[:, 0])
    ssm_l = s5_readout(p_l[2], sf_l, sb_l, cmat, d_skip, w_glu, b_glu)

    out_l = jnp.concatenate([sgu_mix(p_l[0], sgu_norm_g, sgu_w, sgu_b), attn_l, ssm_l,
                             conv_mix(p_l[3], conv_w)], axis=-1) @ w_out
    if not with_ctx_out:
        return out_l, None

    bsz, n_c = h_c.shape[0], h_c.shape[1]
    qn_c, qr_c = mla_queries(p_c[1][..., :Q_LORA], q_norm_g, w_uq)
    attn_c = attend(qn_c, qr_c, kn_c, kr_c, v_c).reshape(bsz, n_c, GROUP_W)
    ssm_c = s5_readout(p_c[2], sf_c, sb_c, cmat, d_skip, w_glu, b_glu)
    out_c = jnp.concatenate([sgu_mix(p_c[0], sgu_norm_g, sgu_w, sgu_b), attn_c, ssm_c,
                             conv_mix(p_c[3], conv_w)], axis=-1) @ w_out
    return out_l, out_c


def ec_moe(h, w_router, w_gate, w_up, w_down):
    bsz, n, _ = h.shape
    cap = max(1, CAPACITY_FACTOR * n // N_EXPERTS)
    aff = jax.nn.softmax((h @ w_router).astype(jnp.float32), axis=-1)
    top_aff, top_idx = lax.top_k(jnp.swapaxes(aff, 1, 2), cap)
    bidx = jnp.arange(bsz)[:, None, None]
    xs = h[bidx, top_idx]
    hid = jax.nn.silu(jnp.einsum("becd,edf->becf", xs, w_gate)) * jnp.einsum("becd,edf->becf", xs, w_up)
    ys = jnp.einsum("becf,efd->becd", hid, w_down) * top_aff[..., None].astype(h.dtype)
    return jnp.zeros_like(h).at[bidx, top_idx].add(ys)


def setup_inputs(seed: int = 0) -> dict:
    key = jax.random.key(seed)
    ks = iter(jax.random.split(key, 48))
    f32 = jnp.float32

    def nrm(shape, scale):
        return scale * jax.random.normal(next(ks), shape, f32)

    L, G, N = DEPTH, S5_GROUPS, S5_STATE
    return {
        "x": nrm((BATCH, SEQ, D_MODEL), 1.0),
        "c": nrm((BATCH, D_MODEL), 1.0),
        "ctx": nrm((BATCH, CTX_LEN, D_MODEL), 1.0),
        "c_ctx": nrm((D_MODEL,), 1.0),
        "norm1_g": 1.0 + nrm((L, D_MODEL), 0.1),
        "norm2_g": 1.0 + nrm((L, D_MODEL), 0.1),
        "w_ada": nrm((L, D_MODEL, 6 * D_MODEL), 0.5 * D_MODEL ** -0.5),
        "b_ada": nrm((L, 6 * D_MODEL), 0.02),
        "w_in": nrm((L, D_MODEL, IN_COLS), D_MODEL ** -0.5),
        "w_out": nrm((L, N_MIXERS * GROUP_W, D_MODEL), (N_MIXERS * GROUP_W) ** -0.5),
        "sgu_norm_g": 1.0 + nrm((L, GROUP_W), 0.1),
        "sgu_w": nrm((L, SGU_HEADS, CHUNK, CHUNK), CHUNK ** -0.5),
        "sgu_b": 1.0 + nrm((L, SGU_HEADS, CHUNK), 0.1),
        "mla_q_norm_g": 1.0 + nrm((L, Q_LORA), 0.1),
        "mla_w_uq": nrm((L, Q_LORA, MLA_HEADS * (QK_NOPE + QK_ROPE)), Q_LORA ** -0.5),
        "mla_kv_norm_g": 1.0 + nrm((L, KV_LORA), 0.1),
        "mla_w_ukv": nrm((L, KV_LORA, MLA_HEADS * (QK_NOPE + V_DIM)), KV_LORA ** -0.5),
        "s5_a_re": -0.5 + nrm((L, 2, G, N), 0.01),
        "s5_a_im": math.pi * jnp.arange(N, dtype=f32) + nrm((L, 2, G, N), 0.01),
        "s5_log_dt": jax.random.uniform(next(ks), (L, 2, G), f32, math.log(S5_DT_MIN), math.log(S5_DT_MAX)),
        "s5_b_re": nrm((L, 2, G, N, S5_CH), (2 * S5_CH) ** -0.5),
        "s5_b_im": nrm((L, 2, G, N, S5_CH), (2 * S5_CH) ** -0.5),
        "s5_c_re": nrm((L, 2, G, S5_CH, N), (2 * N) ** -0.5),
        "s5_c_im": nrm((L, 2, G, S5_CH, N), (2 * N) ** -0.5),
        "s5_d": nrm((L, GROUP_W), 1.0),
        "s5_w_glu": nrm((L, GROUP_W, GROUP_W), GROUP_W ** -0.5),
        "s5_b_glu": nrm((L, GROUP_W), 0.02),
        "conv_w": nrm((L, CONV_WIDTH, GROUP_W), CONV_WIDTH ** -0.5),
        "moe_w_router": nrm((L, D_MODEL, N_EXPERTS), D_MODEL ** -0.5),
        "moe_w_gate": nrm((L, N_EXPERTS, D_MODEL, EXPERT_FF), D_MODEL ** -0.5),
        "moe_w_up": nrm((L, N_EXPERTS, D_MODEL, EXPERT_FF), D_MODEL ** -0.5),
        "moe_w_down": nrm((L, N_EXPERTS, EXPERT_FF, D_MODEL), EXPERT_FF ** -0.5),
        "final_norm_g": 1.0 + nrm((D_MODEL,), 0.1),
    }


def reference(x, c, ctx, c_ctx, norm1_g, norm2_g, w_ada, b_ada, w_in, w_out,
              sgu_norm_g, sgu_w, sgu_b, mla_q_norm_g, mla_w_uq, mla_kv_norm_g, mla_w_ukv,
              s5_a_re, s5_a_im, s5_log_dt, s5_b_re, s5_b_im, s5_c_re, s5_c_im, s5_d,
              s5_w_glu, s5_b_glu, conv_w, moe_w_router, moe_w_gate, moe_w_up, moe_w_down,
              final_norm_g):
    n = x.shape[1]
    rows = n // GRID_W
    row_id = jnp.repeat(jnp.arange(rows, dtype=jnp.float32), GRID_W)
    col_id = jnp.tile(jnp.arange(GRID_W, dtype=jnp.float32), rows)
    n_freq = QK_ROPE // 4
    inv_freq = ROPE_THETA ** (-jnp.arange(n_freq, dtype=jnp.float32) / n_freq)
    ang_row = row_id[:, None] * inv_freq
    ang_col = col_id[:, None] * inv_freq

    silu_c = jax.nn.silu(c)
    silu_cc = jax.nn.silu(c_ctx)
    x_l, x_c = x, ctx
    for i in range(DEPTH):
        last = i == DEPTH - 1
        mod_l = [m[:, None, :] for m in jnp.split(silu_c @ w_ada[i] + b_ada[i], 6, axis=-1)]
        mod_c = jnp.split(silu_cc @ w_ada[i] + b_ada[i], 6, axis=-1)

        h_l = rmsnorm(x_l, norm1_g[i]) * (1.0 + mod_l[1]) + mod_l[0]
        h_c = rmsnorm(x_c, norm1_g[i]) * (1.0 + mod_c[1]) + mod_c[0]
        o_l, o_c = token_mixing(h_l, h_c, ang_row, ang_col, not last, w_in[i], w_out[i],
                                sgu_norm_g[i], sgu_w[i], sgu_b[i],
                                mla_q_norm_g[i], mla_w_uq[i], mla_kv_norm_g[i], mla_w_ukv[i],
                                s5_a_re[i], s5_a_im[i], s5_log_dt[i], s5_b_re[i], s5_b_im[i],
                                s5_c_re[i], s5_c_im[i], s5_d[i], s5_w_glu[i], s5_b_glu[i], conv_w[i])
        x_l = x_l + mod_l[2] * o_l
        h_l = rmsnorm(x_l, norm2_g[i]) * (1.0 + mod_l[4]) + mod_l[3]
        x_l = x_l + mod_l[5] * ec_moe(h_l, moe_w_router[i], moe_w_gate[i], moe_w_up[i], moe_w_down[i])

        if not last:
            x_c = x_c + mod_c[2] * o_c
            h_c = rmsnorm(x_c, norm2_g[i]) * (1.0 + mod_c[4]) + mod_c[3]
            x_c = x_c + mod_c[5] * ec_moe(h_c, moe_w_router[i], moe_w_gate[i], moe_w_up[i], moe_w_down[i])

    return rmsnorm(x_l, final_norm_g)
```

```cpp
#include <hip/hip_runtime.h>
#include <cstdint>
#include <cstdio>

#ifndef MK_SPLIT
#define MK_SPLIT 1
#endif

#define LAS __attribute__((address_space(3)))
typedef unsigned short bf16_t;
typedef short bf16x8 __attribute__((ext_vector_type(8)));
typedef short bf16x4 __attribute__((ext_vector_type(4)));
typedef float f32x4 __attribute__((ext_vector_type(4)));
typedef float f32x2 __attribute__((ext_vector_type(2)));
typedef unsigned u32x4 __attribute__((ext_vector_type(4)));
typedef unsigned u32x2 __attribute__((ext_vector_type(2)));

constexpr int DM = 2048, NB = 4, SEQ = 2048, CTX = 256, NLAT = NB * SEQ, NCTX = NB * CTX, MT = NLAT + NCTX;
constexpr int INC = 3776, INP = 3840;
constexpr int C_SGU_U = 0, C_SGU_V = 512, C_CQ = 1024, C_CKV = 1408, C_KR = 1664, C_S5 = 1728, C_CVB = 2240, C_CVC = 2752, C_CVH = 3264;
constexpr int NKEY = CTX + SEQ;
constexpr int NE = 16, FF = 1024, CAPL = 256, CAPC = 32, EROWS = 1280;
constexpr int NCHUNK = MT / 16;
constexpr float EPS = 1e-6f;
constexpr float QSCALE = 0.07216878364870322f * 1.4426950408889634f;

constexpr size_t al256(size_t x) { return (x + 255) & ~(size_t)255; }
constexpr size_t WS_CTL = 0;
constexpr size_t CTL_BYTES = 65536;
constexpr size_t WS_MOD = WS_CTL + CTL_BYTES;
constexpr size_t WS_WTIN = al256(WS_MOD + (size_t)2 * 5 * 12288 * 4);
constexpr size_t WS_WTOUT = al256(WS_WTIN + (size_t)2 * INP * DM * 2);
constexpr size_t WS_WTUQ = al256(WS_WTOUT + (size_t)2 * DM * DM * 2);
constexpr size_t WS_WTUKV = al256(WS_WTUQ + (size_t)2 * 768 * 384 * 2);
constexpr size_t WS_WTGLU = al256(WS_WTUKV + (size_t)2 * 1024 * 256 * 2);
constexpr size_t WS_WTGU = al256(WS_WTGLU + (size_t)2 * 512 * 512 * 2);
constexpr size_t WS_WTDN = al256(WS_WTGU + (size_t)2 * NE * 2048 * DM * 2);
constexpr size_t WS_PW = al256(WS_WTDN + (size_t)2 * NE * DM * FF * 2);
constexpr size_t WS_BB = al256(WS_PW + (size_t)2 * 2 * 32 * 64 * 17 * 8);
constexpr size_t WS_KZ = al256(WS_BB + (size_t)2 * 2 * 32 * 64 * 16 * 8);
constexpr size_t WS_WST = al256(WS_KZ + (size_t)2 * 2 * 32 * 4096 * 4);
constexpr size_t WS_G2B = al256(WS_WST + (size_t)2 * 32 * 256 * 256 * 2);
constexpr size_t WS_H = al256(WS_G2B + (size_t)2 * 32 * 256 * 512 * 2);
constexpr size_t WS_PA = al256(WS_H + (size_t)MT * DM * 2);
constexpr size_t PA_BYTES = (size_t)NE * EROWS * DM * 2;
static_assert(PA_BYTES >= (size_t)MT * INP * 2, "P fits in the union");
constexpr size_t WS_XA = al256(WS_PA + PA_BYTES);
constexpr size_t WS_XB = al256(WS_XA + (size_t)MT * DM * 4);
constexpr size_t WS_CAT = al256(WS_XB + (size_t)MT * DM * 4);
constexpr size_t WS_QA = al256(WS_CAT + (size_t)MT * DM * 2);
constexpr size_t WS_KVA = al256(WS_QA + (size_t)MT * 384 * 2);
constexpr size_t WS_QB = al256(WS_KVA + (size_t)MT * 256 * 2);
constexpr size_t WS_KC = al256(WS_QB + (size_t)MT * 768 * 2);
constexpr size_t WS_VT = al256(WS_KC + (size_t)NB * 4 * NKEY * 192 * 2);
constexpr size_t WS_UPK = al256(WS_VT + (size_t)NB * 4 * 128 * NKEY * 2);
constexpr size_t WS_EST = al256(WS_UPK + (size_t)32 * 768 * 512 * 2);
constexpr size_t WS_GB = al256(WS_EST + (size_t)32 * 768 * 256 * 4);
constexpr size_t WS_AFF = al256(WS_GB + (size_t)MT * 512 * 2);
constexpr size_t WS_ROWTOK = al256(WS_AFF + (size_t)MT * 16 * 4);
constexpr size_t WS_ROWAFF = al256(WS_ROWTOK + (size_t)NE * EROWS * 4);
constexpr size_t WS_INV = al256(WS_ROWAFF + (size_t)NE * EROWS * 4);
constexpr size_t WS_HID = al256(WS_INV + (size_t)MT * 16 * 4);
constexpr size_t WS_YS = al256(WS_HID + (size_t)NE * EROWS * FF * 2);
constexpr size_t WS_ROPE = al256(WS_YS + (size_t)NE * EROWS * DM * 2);
constexpr size_t WS_END = al256(WS_ROPE + 64 * 16 * 8);

constexpr int LDS_GEMM = 131072;
constexpr int LDS_MISC = LDS_GEMM;
constexpr int LDS_BYTES = LDS_GEMM + 256;

__device__ __forceinline__ unsigned cvt_pk_bf16(float lo, float hi) { unsigned r; asm("v_cvt_pk_bf16_f32 %0, %1, %2" : "=v"(r) : "v"(lo), "v"(hi)); return r; }
__device__ __forceinline__ float bf2f(unsigned short b) { return __uint_as_float(((unsigned)b) << 16); }
__device__ __forceinline__ float bflo(unsigned w) { return __uint_as_float(w << 16); }
__device__ __forceinline__ float bfhi(unsigned w) { return __uint_as_float(w & 0xffff0000u); }
__device__ __forceinline__ unsigned short f2bf(float f) { return (unsigned short)(cvt_pk_bf16(f, 0.f) & 0xffffu); }
__device__ __forceinline__ int opaque_tid() { int t = threadIdx.x; asm volatile("" : "+v"(t)); return t; }
__device__ __forceinline__ unsigned char* opaque_ptr(unsigned char* q) { asm volatile("" : "+s"(q)); return q; }
__device__ __forceinline__ float wave_sum(float v) {
#pragma unroll
    for (int o = 32; o >= 1; o >>= 1) v += __shfl_xor(v, o);
    return v;
}
__device__ __forceinline__ float gelu_tanh(float x) {
    const float y = 1.5957691216057308f * (x + 0.044715f * x * x * x);
    return x / (1.0f + __expf(-y));
}
__device__ __forceinline__ float silu_f(float x) { return x / (1.0f + __expf(-x)); }
__device__ __forceinline__ float sigmoid_f(float x) { return 1.0f / (1.0f + __expf(-x)); }

#define XB_TMO      128
#define XB_XCNT(j)  (256  + 64 * (j))
#define XB_XSUB(j)  (1280 + 64 * (j))
#define XB_XGEN(j)  (2304 + 64 * (j))
#define XB_TOP      3328
#define XB_TOPGEN   3392
#define XCD_BAR_WORDS 3456
#define XB_SPIN_CAP (1u << 22)
__device__ __forceinline__ unsigned xb_ld(unsigned* p)              { return __hip_atomic_load(p, __ATOMIC_RELAXED, __HIP_MEMORY_SCOPE_AGENT); }
__device__ __forceinline__ unsigned xb_add(unsigned* p, unsigned v) { return __hip_atomic_fetch_add(p, v, __ATOMIC_RELAXED, __HIP_MEMORY_SCOPE_AGENT); }
__device__ __forceinline__ unsigned xb_xcc_id() { return (unsigned)__builtin_amdgcn_s_getreg((3 << 11) | 20) & 0xFu; }
#define XB_SPIN(cond, bar) do { unsigned _sp = 0; while (cond) { __builtin_amdgcn_s_sleep(1); \
    if ((++_sp & 255u) == 0u) { if (xb_ld(&(bar)[XB_TMO])) break; if (_sp > XB_SPIN_CAP) { atomicAdd(&(bar)[XB_TMO], 1u); break; } } } } while (0)
struct XcdBarrier { unsigned* bar; unsigned x; volatile LAS unsigned* st; };
__device__ __forceinline__ XcdBarrier xcd_barrier_post(unsigned* bar, volatile LAS unsigned* st) {
    XcdBarrier b; b.bar = bar; b.x = xb_xcc_id(); b.st = st;
    if (threadIdx.x == 0) (void)xb_add(&bar[XB_XCNT(b.x)], 1u);
    return b;
}
__device__ __forceinline__ void xcd_barrier_complete(unsigned* bar, unsigned x, unsigned& nloc, unsigned& nx) {
    const unsigned G = gridDim.x * gridDim.y * gridDim.z;
    unsigned sum, cnt, mine, sp = 0u;
    for (;;) {
        sum = 0u; cnt = 0u; mine = 0u;
#pragma unroll
        for (unsigned j = 0; j < 16; ++j) { const unsigned c = xb_ld(&bar[XB_XCNT(j)]); sum += c; cnt += (c > 0u) ? 1u : 0u; mine = (j == x) ? c : mine; }
        if (sum == G) break;
        __builtin_amdgcn_s_sleep(1);
        if ((++sp & 255u) == 0u) { if (xb_ld(&bar[XB_TMO])) break; if (sp > XB_SPIN_CAP) { atomicAdd(&bar[XB_TMO], 1u); break; } }
    }
    nloc = mine > 0u ? mine : 1u; nx = cnt > 0u ? cnt : 1u;
}
__device__ __forceinline__ void xcd_barrier(const XcdBarrier& b) {
    asm volatile("s_waitcnt vmcnt(0)" ::: "memory");
    __syncthreads();
    if (threadIdx.x == 0) {
        unsigned* bar = b.bar;
        __builtin_amdgcn_s_waitcnt(0);
        unsigned nloc = b.st[0], nx = b.st[1];
        if (nloc == 0u) { xcd_barrier_complete(bar, b.x, nloc, nx); b.st[0] = nloc; b.st[1] = nx; }
        const unsigned old = xb_add(&bar[XB_XSUB(b.x)], 1u);
        const unsigned gen = old / nloc;
        if (old + 1u == (gen + 1u) * nloc) {
            __builtin_amdgcn_fence(__ATOMIC_RELEASE, "agent");
            asm volatile("s_waitcnt vmcnt(0)" ::: "memory");
            const unsigned og = xb_add(&bar[XB_TOP], 1u);
            const unsigned tg = og / nx;
            if (og + 1u == (tg + 1u) * nx) xb_add(&bar[XB_TOPGEN], 1u);
            else XB_SPIN(xb_ld(&bar[XB_TOPGEN]) == tg, bar);
            __builtin_amdgcn_fence(__ATOMIC_ACQUIRE, "agent");
            xb_add(&bar[XB_XGEN(b.x)], 1u);
            asm volatile("s_waitcnt vmcnt(0)" ::: "memory");
        } else {
            XB_SPIN(xb_ld(&bar[XB_XGEN(b.x)]) == gen, bar);
            __builtin_amdgcn_fence(__ATOMIC_ACQUIRE, "agent");
            asm volatile("s_waitcnt vmcnt(0)" ::: "memory");
        }
    }
    __syncthreads();
}

namespace pg8 {
constexpr int BM = 256, BK = 64, HALF = 128, HTB = HALF * BK * 2, STAGE_BYTES = 8 * HTB;
__host__ __device__ __forceinline__ int lds_byte(int r, int c) { const int st = (r >> 4) * 2 + (c >> 5), rr = r & 15, cc = c & 31, ob = rr * 64 + cc * 2; return st * 1024 + (ob ^ (((ob >> 9) & 1) << 5)); }
__host__ __device__ __forceinline__ void stage_rc(int b, int& R, int& C) { const int st = b / 1024, sb = b % 1024, swz = sb ^ (((sb >> 9) & 1) << 5); R = (st >> 1) * 16 + swz / 64; C = (st & 1) * 32 + (swz % 64) / 2; }
__host__ __device__ __forceinline__ int perm32(int rho) { const int n = rho >> 4, i = rho & 15; return 8 * (i >> 2) + 4 * n + (i & 3); }

struct Unit { const char* a; const char* b; int pm, pn, pb; };
struct Desc { int lda, ldb, K; };

struct TileSched {
    const char* A; const char* B; size_t sA, sB;
    int lda, ldb, nM, nN, nB, G, c;
    __device__ __forceinline__ void init(const void* A_, const void* B_, int lda_, int ldb_, int nM_, int nN_, int nB_, size_t sA_, size_t sB_, int G_, int c_, int off) {
        A = (const char*)A_; B = (const char*)B_; lda = lda_; ldb = ldb_; nM = nM_; nN = nN_; nB = nB_; sA = sA_; sB = sB_; G = G_; c = (c_ + G_ - (off % G_)) % G_; }
    __device__ __forceinline__ bool next(int i, Unit& u) const {
        const int nwg = nM * nN; const long L = (long)i * G + c; if (L >= (long)nwg * nB) return false;
        const int pb = (int)(L / nwg); int wgid = (int)(L % nwg);
        { const int q = nwg / 8, r = nwg % 8, xcd = wgid % 8, off = wgid / 8; wgid = (xcd < r ? xcd * (q + 1) : r * (q + 1) + (xcd - r) * q) + off; }
        const int nig = 8 * nN, gid = wgid / nig, fm = gid * 8, gsz = (nM - fm) < 8 ? (nM - fm) : 8;
        u.pm = fm + ((wgid % nig) % gsz); u.pn = (wgid % nig) / gsz; u.pb = pb;
        u.a = A + (size_t)pb * sA + (size_t)u.pm * 256 * lda * 2; u.b = B + (size_t)pb * sB + (size_t)u.pn * 256 * ldb * 2; return true;
    }
};
struct MoeSched {
    const char* A; const char* B; size_t sA, sB; int lda, ldb, nM, nN, G, c;
    __device__ __forceinline__ void init(const void* A_, const void* B_, int lda_, int ldb_, int nM_, int nN_, size_t sA_, size_t sB_, int G_, int c_) {
        A = (const char*)A_; B = (const char*)B_; lda = lda_; ldb = ldb_; nM = nM_; nN = nN_; sA = sA_; sB = sB_; G = G_; c = c_; }
    __device__ __forceinline__ bool next(int i, Unit& u) const {
        int e, rem; const int per = nM * nN;
        if ((G & 7) == 0) { const int x = c & 7, j = c >> 3, w = G >> 3; const int L = i * w + j; if (L >= 2 * per) return false; e = 2 * x + L / per; rem = L % per; }
        else { const long L = (long)i * G + c; if (L >= (long)NE * per) return false; e = (int)(L / per); rem = (int)(L % per); }
        u.pn = rem / nM; u.pm = rem % nM; u.pb = e;
        u.a = A + (size_t)e * sA + (size_t)u.pm * 256 * lda * 2; u.b = B + (size_t)e * sB + (size_t)u.pn * 256 * ldb * 2; return true;
    }
};

template <class Epi, class Sched>
__device__ __forceinline__ void gemm_phase(LAS unsigned char* lds, const Desc g, const Sched& S, const Epi& E) {
    const int tid = opaque_tid(), wid = __builtin_amdgcn_readfirstlane(tid >> 6), lane = tid & 63, wr = wid >> 2, wc = wid & 3, fr = lane & 15, fq = lane >> 4;
    const int K = g.K, nt = K / BK;
    unsigned voffA[2], voffB[2];
#pragma unroll
    for (int i = 0; i < 2; ++i) { int R, C; stage_rc(tid * 16 + i * 8192, R, C); const int Rb = Epi::PERM ? ((R & ~31) + perm32(R & 31)) : R;
        voffA[i] = (unsigned)(R * g.lda + C) * 2u; voffB[i] = (unsigned)(Rb * g.ldb + C) * 2u; }
    const size_t kstep = (size_t)(BK * 2);
    const size_t hstepA = (size_t)HALF * g.lda * 2, hstepB = (size_t)HALF * g.ldb * 2;
    const unsigned ldsw = (unsigned)wid * 1024u;
    const int aoff = lds_byte(wr * 64 + fr, fq * 8), boff = lds_byte(wc * 32 + fr, fq * 8);
#define PG8_SA(b, h) (((b) * 2 + (h)) * HTB)
#define PG8_SB(b, h) ((4 + (b) * 2 + (h)) * HTB)
#define PG8_STAGE(bufoff, gbase, voff) do { _Pragma("unroll") for (int _i = 0; _i < 2; ++_i) \
        __builtin_amdgcn_global_load_lds((const unsigned*)((const char*)(gbase) + (voff)[_i]), (LAS unsigned*)(lds + (bufoff) + ldsw + _i * 8192), 16, 0, 0); } while (0)
#define PG8_LDA(dst, b, h) do { _Pragma("unroll") for (int m = 0; m < 4; ++m) _Pragma("unroll") for (int k = 0; k < 2; ++k) dst[m][k] = *(const LAS bf16x8*)(lds + PG8_SA(b, h) + aoff + m * 2048 + k * 1024); } while (0)
#define PG8_LDB(dst, b, h) do { _Pragma("unroll") for (int n = 0; n < 2; ++n) _Pragma("unroll") for (int k = 0; k < 2; ++k) dst[n][k] = *(const LAS bf16x8*)(lds + PG8_SB(b, h) + boff + n * 2048 + k * 1024); } while (0)
#define PG8_MMA(ai, bj, At, Bt) do { __builtin_amdgcn_s_setprio(1); _Pragma("unroll") for (int m = 0; m < 4; ++m) _Pragma("unroll") for (int n = 0; n < 2; ++n) _Pragma("unroll") for (int k = 0; k < 2; ++k) \
        acc[ai][bj][m][n] = __builtin_amdgcn_mfma_f32_16x16x32_bf16(Bt[n][k], At[m][k], acc[ai][bj][m][n], 0, 0, 0); __builtin_amdgcn_s_setprio(0); } while (0)
#define PG8_WAIT_V(n) asm volatile("s_waitcnt vmcnt(" #n ")" ::: "memory")
#define PG8_WAIT_L(n) asm volatile("s_waitcnt lgkmcnt(" #n ")" ::: "memory")
#define PG8_BAR __builtin_amdgcn_s_barrier()
#define PG8_SCHED __builtin_amdgcn_sched_barrier(0)
    Unit cur, nxt; int ui = 0;
    if (!S.next(0, cur)) return;
    f32x4 acc[2][2][4][2];
#pragma unroll
    for (int a = 0; a < 2; ++a)
#pragma unroll
        for (int b = 0; b < 2; ++b)
#pragma unroll
            for (int m = 0; m < 4; ++m)
#pragma unroll
                for (int n = 0; n < 2; ++n) acc[a][b][m][n] = (f32x4){0.f, 0.f, 0.f, 0.f};
    bf16x8 At[4][2], B0[2][2], B1[2][2];
    const char* cA = cur.a; const char* cB = cur.b;
    PG8_STAGE(PG8_SB(0, 0), cB, voffB); PG8_STAGE(PG8_SA(0, 0), cA, voffA); PG8_STAGE(PG8_SB(0, 1), cB + hstepB, voffB); PG8_STAGE(PG8_SA(0, 1), cA + hstepA, voffA);
    if (wr == 1) PG8_BAR;
    PG8_WAIT_V(4); PG8_BAR;
    PG8_STAGE(PG8_SB(1, 0), cB + kstep, voffB); PG8_STAGE(PG8_SA(1, 0), cA + kstep, voffA); PG8_STAGE(PG8_SB(1, 1), cB + hstepB + kstep, voffB);
    PG8_WAIT_V(6); PG8_BAR;
    for (;;) {
        const bool has_next = S.next(ui + 1, nxt);
        const char* nA = has_next ? nxt.a : cA; const char* nB = has_next ? nxt.b : cB;
#pragma nounroll
        for (int t = 0; t < nt; t += 2) {
            const bool last = (t == nt - 2);
            const char* a1 = cA + (size_t)(t + 1) * kstep;
            const char* a2 = last ? nA : cA + (size_t)(t + 2) * kstep; const char* b2 = last ? nB : cB + (size_t)(t + 2) * kstep;
            const char* a3 = a2 + kstep; const char* b3 = b2 + kstep;
            PG8_LDB(B0, 0, 0); PG8_SCHED; PG8_LDA(At, 0, 0); PG8_STAGE(PG8_SA(1, 1), a1 + hstepA, voffA);
            PG8_WAIT_L(8); PG8_BAR; PG8_WAIT_L(0); PG8_MMA(0, 0, At, B0); PG8_BAR; PG8_SCHED;
            PG8_LDB(B1, 0, 1); PG8_STAGE(PG8_SB(0, 0), b2, voffB);
            PG8_BAR; PG8_WAIT_L(0); PG8_MMA(0, 1, At, B1); PG8_BAR;
            PG8_LDA(At, 0, 1); PG8_STAGE(PG8_SA(0, 0), a2, voffA);
            PG8_BAR; PG8_WAIT_L(0); PG8_MMA(1, 0, At, B0); PG8_BAR; PG8_SCHED;
            PG8_STAGE(PG8_SB(0, 1), b2 + hstepB, voffB);
            PG8_WAIT_V(6); PG8_BAR; PG8_MMA(1, 1, At, B1); PG8_BAR;
            PG8_LDB(B0, 1, 0); PG8_SCHED; PG8_LDA(At, 1, 0); PG8_STAGE(PG8_SA(0, 1), a2 + hstepA, voffA);
            PG8_WAIT_L(8); PG8_BAR; PG8_WAIT_L(0); PG8_MMA(0, 0, At, B0); PG8_BAR; PG8_SCHED;
            PG8_LDB(B1, 1, 1); PG8_STAGE(PG8_SB(1, 0), b3, voffB);
            PG8_BAR; PG8_WAIT_L(0); PG8_MMA(0, 1, At, B1); PG8_BAR;
            PG8_LDA(At, 1, 1); PG8_STAGE(PG8_SA(1, 0), a3, voffA);
            PG8_BAR; PG8_WAIT_L(0); PG8_MMA(1, 0, At, B0); PG8_BAR; PG8_SCHED;
            PG8_STAGE(PG8_SB(1, 1), b3 + hstepB, voffB);
            PG8_WAIT_V(6); PG8_BAR; PG8_MMA(1, 1, At, B1); PG8_BAR;
        }
        E(acc, cur, wr, wc, fr, fq);
        if (!has_next) break;
#pragma unroll
        for (int a = 0; a < 2; ++a)
#pragma unroll
            for (int b = 0; b < 2; ++b)
#pragma unroll
                for (int m = 0; m < 4; ++m)
#pragma unroll
                    for (int n = 0; n < 2; ++n) acc[a][b][m][n] = (f32x4){0.f, 0.f, 0.f, 0.f};
        cur = nxt; cA = nA; cB = nB; ++ui;
    }
    PG8_WAIT_V(0);
    if (wr == 0) PG8_BAR;
    PG8_BAR;
#undef PG8_SA
#undef PG8_SB
#undef PG8_STAGE
#undef PG8_LDA
#undef PG8_LDB
#undef PG8_MMA
#undef PG8_WAIT_V
#undef PG8_WAIT_L
#undef PG8_BAR
#undef PG8_SCHED
}

#define PG8_FOR_PERM(...) \
    _Pragma("unroll") for (int ai = 0; ai < 2; ++ai) _Pragma("unroll") for (int m = 0; m < 4; ++m) { const int tr = ai * 128 + wr * 64 + m * 16 + fr; \
        _Pragma("unroll") for (int bj = 0; bj < 2; ++bj) { const int tc = bj * 128 + wc * 32 + 8 * fq; const f32x4 v0 = acc[ai][bj][m][0], v1 = acc[ai][bj][m][1]; __VA_ARGS__ } }
#define PG8_FOR_NOPERM(...) \
    _Pragma("unroll") for (int ai = 0; ai < 2; ++ai) _Pragma("unroll") for (int m = 0; m < 4; ++m) { const int tr = ai * 128 + wr * 64 + m * 16 + fr; \
        _Pragma("unroll") for (int bj = 0; bj < 2; ++bj) _Pragma("unroll") for (int n = 0; n < 2; ++n) { const int tc = bj * 128 + wc * 32 + 16 * n + 4 * fq; const f32x4 v = acc[ai][bj][m][n]; __VA_ARGS__ } }

typedef const f32x4 (&AccRef)[2][2][4][2];

struct EpiStoreBf16 {
    static constexpr bool PERM = true;
    bf16_t* O; int ldc;
    __device__ __forceinline__ void operator()(AccRef acc, const Unit& u, int wr, int wc, int fr, int fq) const {
        PG8_FOR_PERM({ u32x4 w; w.x = cvt_pk_bf16(v0[0], v0[1]); w.y = cvt_pk_bf16(v0[2], v0[3]); w.z = cvt_pk_bf16(v1[0], v1[1]); w.w = cvt_pk_bf16(v1[2], v1[3]);
            *(u32x4*)(O + (size_t)(u.pm * 256 + tr) * ldc + u.pn * 256 + tc) = w; })
    }
};
struct EpiQ {
    static constexpr bool PERM = false;
    bf16_t* Q; const f32x2* ROPE;
    __device__ __forceinline__ void operator()(AccRef acc, const Unit& u, int wr, int wc, int fr, int fq) const {
#pragma unroll
        for (int ai = 0; ai < 2; ++ai)
#pragma unroll
            for (int m = 0; m < 4; ++m) { const int row = u.pm * 256 + ai * 128 + wr * 64 + m * 16 + fr; const bool lat = row < NLAT; const int t = row & (SEQ - 1);
#pragma unroll
                for (int bj = 0; bj < 2; ++bj) { const int cg = u.pn * 256 + bj * 128 + wc * 32; const int dd = cg % 192; f32x4 a = acc[ai][bj][m][0], b = acc[ai][bj][m][1];
                    if (dd >= 128 && lat) { const int pos = (dd - 128) >= 32 ? (t & 63) : (t >> 6); const f32x4* rp = (const f32x4*)(ROPE + pos * 16 + 4 * fq); const f32x4 r0 = rp[0], r1 = rp[1];
                        const float cs[4] = {r0[0], r0[2], r1[0], r1[2]}, sn[4] = {r0[1], r0[3], r1[1], r1[3]};
#pragma unroll
                        for (int i = 0; i < 4; ++i) { const float x1 = a[i], x2 = b[i]; a[i] = x1 * cs[i] - x2 * sn[i]; b[i] = x2 * cs[i] + x1 * sn[i]; } }
                    a *= QSCALE; b *= QSCALE;
                    bf16_t* o = Q + (size_t)row * 768 + cg + 4 * fq;
                    u32x2 w0; w0.x = cvt_pk_bf16(a[0], a[1]); w0.y = cvt_pk_bf16(a[2], a[3]); *(u32x2*)o = w0;
                    u32x2 w1; w1.x = cvt_pk_bf16(b[0], b[1]); w1.y = cvt_pk_bf16(b[2], b[3]); *(u32x2*)(o + 16) = w1; } }
    }
};
struct EpiK {
    static constexpr bool PERM = true;
    bf16_t* KC;
    __device__ __forceinline__ void operator()(AccRef acc, const Unit& u, int wr, int wc, int fr, int fq) const {
        PG8_FOR_PERM({ const int row = u.pm * 256 + tr; int b, key; if (row < NLAT) { b = row >> 11; key = CTX + (row & (SEQ - 1)); } else { b = (row - NLAT) >> 8; key = (row - NLAT) & (CTX - 1); }
            const int col = u.pn * 256 + tc, h = col >> 7, d = col & 127;
            u32x4 w; w.x = cvt_pk_bf16(v0[0], v0[1]); w.y = cvt_pk_bf16(v0[2], v0[3]); w.z = cvt_pk_bf16(v1[0], v1[1]); w.w = cvt_pk_bf16(v1[2], v1[3]);
            *(u32x4*)(KC + ((size_t)(b * 4 + h) * NKEY + key) * 192 + d) = w; })
    }
};
struct EpiV {
    static constexpr bool PERM = true;
    bf16_t* VT;
    __device__ __forceinline__ void operator()(AccRef acc, const Unit& u, int wr, int wc, int fr, int fq) const {
        PG8_FOR_PERM({ const int hd = u.pm * 256 + tr, h = hd >> 7, d = hd & 127; const int tok = u.pn * 256 + tc; int b, key;
            if (tok < NLAT) { b = tok >> 11; key = CTX + (tok & (SEQ - 1)); } else { b = (tok - NLAT) >> 8; key = (tok - NLAT) & (CTX - 1); }
            u32x4 w; w.x = cvt_pk_bf16(v0[0], v0[1]); w.y = cvt_pk_bf16(v0[2], v0[3]); w.z = cvt_pk_bf16(v1[0], v1[1]); w.w = cvt_pk_bf16(v1[2], v1[3]);
            *(u32x4*)(VT + ((size_t)(b * 4 + h) * 128 + d) * NKEY + key) = w; })
    }
};
struct EpiS1 {
    static constexpr bool PERM = false;
    float* EST;
    __device__ __forceinline__ void operator()(AccRef acc, const Unit& u, int wr, int wc, int fr, int fq) const {
        PG8_FOR_NOPERM({ const int row = u.pm * 256 + tr; if (row < NCHUNK) *(f32x4*)(EST + ((size_t)u.pb * 768 + row) * 256 + tc) = v; })
    }
};
struct EpiS2 {
    static constexpr bool PERM = true;
    bf16_t* GB;
    __device__ __forceinline__ void operator()(AccRef acc, const Unit& u, int wr, int wc, int fr, int fq) const {
        PG8_FOR_PERM({ const int row = u.pm * 256 + tr; if (row < NCHUNK) { const int p = tc >> 4, c = tc & 15;
            u32x4 w; w.x = cvt_pk_bf16(gelu_tanh(v0[0]), gelu_tanh(v0[1])); w.y = cvt_pk_bf16(gelu_tanh(v0[2]), gelu_tanh(v0[3]));
            w.z = cvt_pk_bf16(gelu_tanh(v1[0]), gelu_tanh(v1[1])); w.w = cvt_pk_bf16(gelu_tanh(v1[2]), gelu_tanh(v1[3]));
            *(u32x4*)(GB + (size_t)(row * 16 + p) * 512 + u.pb * 16 + c) = w; } })
    }
};
struct EpiGlu {
    static constexpr bool PERM = true;
    const bf16_t* GB; const float* bias; bf16_t* CAT;
    __device__ __forceinline__ void operator()(AccRef acc, const Unit& u, int wr, int wc, int fr, int fq) const {
        PG8_FOR_PERM({ const int row = u.pm * 256 + tr, col = u.pn * 256 + tc;
            const u32x4 gv = *(const u32x4*)(GB + (size_t)row * 512 + col); const f32x4 b0 = *(const f32x4*)(bias + col), b1 = *(const f32x4*)(bias + col + 4);
            u32x4 w;
            w.x = cvt_pk_bf16(bflo(gv.x) * sigmoid_f(v0[0] + b0[0]), bfhi(gv.x) * sigmoid_f(v0[1] + b0[1]));
            w.y = cvt_pk_bf16(bflo(gv.y) * sigmoid_f(v0[2] + b0[2]), bfhi(gv.y) * sigmoid_f(v0[3] + b0[3]));
            w.z = cvt_pk_bf16(bflo(gv.z) * sigmoid_f(v1[0] + b1[0]), bfhi(gv.z) * sigmoid_f(v1[1] + b1[1]));
            w.w = cvt_pk_bf16(bflo(gv.w) * sigmoid_f(v1[2] + b1[2]), bfhi(gv.w) * sigmoid_f(v1[3] + b1[3]));
            *(u32x4*)(CAT + (size_t)row * DM + 1024 + col) = w; })
    }
};
struct EpiOut {
    static constexpr bool PERM = false;
    const float* xl; const float* xc; const float* gate; float* xo;
    __device__ __forceinline__ void operator()(AccRef acc, const Unit& u, int wr, int wc, int fr, int fq) const {
        PG8_FOR_NOPERM({ const int row = u.pm * 256 + tr, col = u.pn * 256 + tc; const int rr = row < NLAT ? (row >> 11) : 4;
            const float* src = row < NLAT ? xl + (size_t)row * DM : xc + (size_t)(row - NLAT) * DM;
            const f32x4 xv = *(const f32x4*)(src + col), gv = *(const f32x4*)(gate + (size_t)rr * 12288 + col);
            *(f32x4*)(xo + (size_t)row * DM + col) = xv + gv * v; })
    }
};
struct EpiGU {
    static constexpr bool PERM = true;
    bf16_t* HID;
    __device__ __forceinline__ void operator()(AccRef acc, const Unit& u, int wr, int wc, int fr, int fq) const {
        PG8_FOR_PERM({ const int row = u.pm * 256 + tr, j = (u.pn * 256 + tc) >> 1;
            u32x2 w; w.x = cvt_pk_bf16(silu_f(v0[0]) * v0[1], silu_f(v0[2]) * v0[3]); w.y = cvt_pk_bf16(silu_f(v1[0]) * v1[1], silu_f(v1[2]) * v1[3]);
            *(u32x2*)(HID + ((size_t)u.pb * EROWS + row) * FF + j) = w; })
    }
};
struct EpiDown {
    static constexpr bool PERM = true;
    bf16_t* YS; const float* RA;
    __device__ __forceinline__ void operator()(AccRef acc, const Unit& u, int wr, int wc, int fr, int fq) const {
        PG8_FOR_PERM({ const int row = u.pm * 256 + tr, col = u.pn * 256 + tc; const float a = RA[u.pb * EROWS + row];
            u32x4 w; w.x = cvt_pk_bf16(v0[0] * a, v0[1] * a); w.y = cvt_pk_bf16(v0[2] * a, v0[3] * a); w.z = cvt_pk_bf16(v1[0] * a, v1[1] * a); w.w = cvt_pk_bf16(v1[2] * a, v1[3] * a);
            *(u32x4*)(YS + ((size_t)u.pb * EROWS + row) * DM + col) = w; })
    }
};
}

struct Params { const float* in[33]; float* out; unsigned char* ws; int ph_lo, ph_hi; };
enum { I_X = 0, I_C, I_CTX, I_CCTX, I_N1G, I_N2G, I_WADA, I_BADA, I_WIN, I_WOUT, I_SGUNG, I_SGUW, I_SGUB, I_QNG, I_WUQ, I_KVNG, I_WUKV,
       I_ARE, I_AIM, I_LOGDT, I_BRE, I_BIM, I_CRE, I_CIM, I_S5D, I_WGLU, I_BGLU, I_CONVW, I_WROUTER, I_WGATE, I_WUP, I_WDOWN, I_FNG };

__device__ __forceinline__ void transpose_tile(const float* src, int N, int k0, int n0, bf16_t* dst, int ldd, int rmul, int radd, int remap_kv, LAS float* tile) {
    const int tid = threadIdx.x;
#pragma unroll
    for (int i = 0; i < 2; ++i) { const int r = (tid >> 4) + 32 * i, c4 = (tid & 15) * 4;
        const f32x4 v = *(const f32x4*)(src + (size_t)(k0 + r) * N + n0 + c4);
        tile[r * 65 + c4 + 0] = v[0]; tile[r * 65 + c4 + 1] = v[1]; tile[r * 65 + c4 + 2] = v[2]; tile[r * 65 + c4 + 3] = v[3]; }
    __syncthreads();
    { const int n = tid >> 3, kc = tid & 7; float f[8];
#pragma unroll
        for (int j = 0; j < 8; ++j) f[j] = tile[(kc * 8 + j) * 65 + n];
        int nn = n0 + n; if (remap_kv) nn = ((nn & 255) < 128) ? ((nn >> 8) * 128 + (nn & 127)) : (512 + (nn >> 8) * 128 + (nn & 127));
        const int drow = nn * rmul + radd;
        u32x4 w; w.x = cvt_pk_bf16(f[0], f[1]); w.y = cvt_pk_bf16(f[2], f[3]); w.z = cvt_pk_bf16(f[4], f[5]); w.w = cvt_pk_bf16(f[6], f[7]);
        *(u32x4*)(dst + (size_t)drow * ldd + k0 + kc * 8) = w; }
    __syncthreads();
}
constexpr int N_ADA_UNITS = 96, N_S5T_UNITS = 16, N_ROPE_UNITS = 2;
constexpr int T_WIN = 32 * 59, T_WOUT = 32 * 32, T_WUQ = 6 * 12, T_WUKV = 4 * 16, T_WGLU = 8 * 8, T_EXP = 512;
constexpr int N_TR = 2 * (T_WIN + T_WOUT + T_WUQ + T_WUKV + T_WGLU) + 3 * 32 * T_EXP;
constexpr int N_PRO_ITEMS = N_ADA_UNITS + N_S5T_UNITS + N_ROPE_UNITS + N_TR;

__device__ __forceinline__ void ph_prologue(const Params& p, LAS unsigned char* lds) {
    const int tid = opaque_tid(), lane = tid & 63, wave = tid >> 6;
    unsigned char* ws = opaque_ptr(p.ws);
    for (int it = blockIdx.x; it < N_PRO_ITEMS; it += gridDim.x) {
        if (it < N_ADA_UNITS) {
            const int l = it / 48, cb = it % 48;
            LAS float* sil = (LAS float*)lds;
            LAS float* red = (LAS float*)(lds + 40960);
            for (int i = tid; i < 5 * DM; i += 512) { const int r = i >> 11, k = i & (DM - 1); const float v = r < 4 ? p.in[I_C][r * DM + k] : p.in[I_CCTX][k]; sil[i] = silu_f(v); }
            __syncthreads();
            f32x4 acc[5];
#pragma unroll
            for (int r = 0; r < 5; ++r) acc[r] = (f32x4){0.f, 0.f, 0.f, 0.f};
            const float* W = p.in[I_WADA] + (size_t)l * DM * 12288 + cb * 256 + lane * 4;
            for (int k = wave * 256; k < wave * 256 + 256; k += 8) {
                f32x4 w[8];
#pragma unroll
                for (int j = 0; j < 8; ++j) w[j] = *(const f32x4*)(W + (size_t)(k + j) * 12288);
#pragma unroll
                for (int j = 0; j < 8; ++j)
#pragma unroll
                    for (int r = 0; r < 5; ++r) acc[r] += sil[r * DM + k + j] * w[j];
            }
#pragma unroll
            for (int r = 0; r < 5; ++r)
#pragma unroll
                for (int j = 0; j < 4; ++j) red[(wave * 5 + r) * 256 + lane * 4 + j] = acc[r][j];
            __syncthreads();
            float* mod = (float*)(ws + WS_MOD);
            for (int o = tid; o < 5 * 256; o += 512) { const int r = o >> 8, cc = o & 255; float s = 0.f;
#pragma unroll
                for (int w8 = 0; w8 < 8; ++w8) s += red[(w8 * 5 + r) * 256 + cc];
                mod[(size_t)(l * 5 + r) * 12288 + cb * 256 + cc] = s + p.in[I_BADA][l * 12288 + cb * 256 + cc]; }
            __syncthreads();
        } else if (it < N_ADA_UNITS + N_S5T_UNITS) {
            const int idx = (it - N_ADA_UNITS) * 512 + tid;
            const float are = fminf(p.in[I_ARE][idx], -1e-4f), aim = p.in[I_AIM][idx];
            const float dt = expf(p.in[I_LOGDT][idx >> 6]);
            f32x2* PW = (f32x2*)(ws + WS_PW) + (size_t)idx * 17; f32x2* BB = (f32x2*)(ws + WS_BB) + (size_t)idx * 16;
            float abr = 0.f, abi = 0.f;
            for (int d = 0; d <= 16; ++d) { const double mag = exp((double)are * (double)dt * d); double sn, cs; sincos((double)aim * (double)dt * d, &sn, &cs);
                const f32x2 v = {(float)(mag * cs), (float)(mag * sn)}; PW[d] = v; if (d == 1) { abr = v.x; abi = v.y; } }
            const float xr = abr - 1.0f, xi = abi, den = 1.0f / (are * are + aim * aim);
            const float cr = (xr * are + xi * aim) * den, ci = (xi * are - xr * aim) * den;
            for (int c = 0; c < 16; ++c) { const float br = p.in[I_BRE][(size_t)idx * 16 + c], bi = p.in[I_BIM][(size_t)idx * 16 + c]; BB[c] = (f32x2){cr * br - ci * bi, cr * bi + ci * br}; }
        } else if (it < N_ADA_UNITS + N_S5T_UNITS + N_ROPE_UNITS) {
            const int idx = (it - N_ADA_UNITS - N_S5T_UNITS) * 512 + tid; const int pos = idx >> 4, f = idx & 15;
            const float invf = powf(10000.0f, -(float)f * 0.0625f); const float ang = (float)pos * invf;
            ((f32x2*)(ws + WS_ROPE))[idx] = (f32x2){cosf(ang), sinf(ang)};
        } else {
            int t = it - N_ADA_UNITS - N_S5T_UNITS - N_ROPE_UNITS;
            LAS float* tile = (LAS float*)lds;
            if (t < 2 * T_WIN) { const int l = t / T_WIN, r = t % T_WIN; transpose_tile(p.in[I_WIN] + (size_t)l * DM * INC, INC, (r % 32) * 64, (r / 32) * 64, (bf16_t*)(ws + WS_WTIN) + (size_t)l * INP * DM, DM, 1, 0, 0, tile); continue; }
            t -= 2 * T_WIN;
            if (t < 2 * T_WOUT) { const int l = t / T_WOUT, r = t % T_WOUT; transpose_tile(p.in[I_WOUT] + (size_t)l * DM * DM, DM, (r % 32) * 64, (r / 32) * 64, (bf16_t*)(ws + WS_WTOUT) + (size_t)l * DM * DM, DM, 1, 0, 0, tile); continue; }
            t -= 2 * T_WOUT;
            if (t < 2 * T_WUQ) { const int l = t / T_WUQ, r = t % T_WUQ; transpose_tile(p.in[I_WUQ] + (size_t)l * 384 * 768, 768, (r % 6) * 64, (r / 6) * 64, (bf16_t*)(ws + WS_WTUQ) + (size_t)l * 768 * 384, 384, 1, 0, 0, tile); continue; }
            t -= 2 * T_WUQ;
            if (t < 2 * T_WUKV) { const int l = t / T_WUKV, r = t % T_WUKV; transpose_tile(p.in[I_WUKV] + (size_t)l * 256 * 1024, 1024, (r % 4) * 64, (r / 4) * 64, (bf16_t*)(ws + WS_WTUKV) + (size_t)l * 1024 * 256, 256, 1, 0, 1, tile); continue; }
            t -= 2 * T_WUKV;
            if (t < 2 * T_WGLU) { const int l = t / T_WGLU, r = t % T_WGLU; transpose_tile(p.in[I_WGLU] + (size_t)l * 512 * 512, 512, (r % 8) * 64, (r / 8) * 64, (bf16_t*)(ws + WS_WTGLU) + (size_t)l * 512 * 512, 512, 1, 0, 0, tile); continue; }
            t -= 2 * T_WGLU;
            if (t < 32 * T_EXP) { const int le = t / T_EXP, r = t % T_EXP; transpose_tile(p.in[I_WGATE] + (size_t)le * DM * FF, FF, (r % 32) * 64, (r / 32) * 64, (bf16_t*)(ws + WS_WTGU) + (size_t)le * 2048 * DM, DM, 2, 0, 0, tile); continue; }
            t -= 32 * T_EXP;
            if (t < 32 * T_EXP) { const int le = t / T_EXP, r = t % T_EXP; transpose_tile(p.in[I_WUP] + (size_t)le * DM * FF, FF, (r % 32) * 64, (r / 32) * 64, (bf16_t*)(ws + WS_WTGU) + (size_t)le * 2048 * DM, DM, 2, 1, 0, tile); continue; }
            t -= 32 * T_EXP;
            { const int le = t / T_EXP, r = t % T_EXP; transpose_tile(p.in[I_WDOWN] + (size_t)le * FF * DM, DM, (r % 16) * 64, (r / 16) * 64, (bf16_t*)(ws + WS_WTDN) + (size_t)le * DM * FF, FF, 1, 0, 0, tile); }
        }
    }
}

__device__ __forceinline__ void rms_mod_store(const f32x4 (&x)[8], const float* g, const float* scale, const float* shift, bf16_t* orow, f32x4 (&y)[8], int lane) {
    float ss = 0.f;
#pragma unroll
    for (int j = 0; j < 8; ++j) ss += x[j][0] * x[j][0] + x[j][1] * x[j][1] + x[j][2] * x[j][2] + x[j][3] * x[j][3];
    ss = wave_sum(ss);
    const float rinv = rsqrtf(ss * (1.0f / DM) + EPS);
#pragma unroll
    for (int j = 0; j < 8; ++j) { const int c = j * 256 + lane * 4;
        const f32x4 gv = *(const f32x4*)(g + c), sc = *(const f32x4*)(scale + c), sh = *(const f32x4*)(shift + c);
        y[j] = x[j] * rinv * gv * (1.0f + sc) + sh;
        u32x2 w; w.x = cvt_pk_bf16(y[j][0], y[j][1]); w.y = cvt_pk_bf16(y[j][2], y[j][3]); *(u32x2*)(orow + c) = w; }
}

constexpr int N1_ROWITEMS = MT / 8, N1_KZ = 1024, N1_WST = 1024, N1_INTER = 1024;
__device__ __forceinline__ void ph_norm1_tables(const Params& p) {
    const int tid = opaque_tid(), lane = tid & 63, wave = tid >> 6;
    unsigned char* ws = opaque_ptr(p.ws);
    const float* mod = (const float*)(ws + WS_MOD);
    for (int it = blockIdx.x; it < N1_ROWITEMS + N1_KZ + N1_WST + N1_INTER; it += gridDim.x) {
        if (it < N1_ROWITEMS) {
            const int row = it * 8 + wave; const int rr = row < NLAT ? (row >> 11) : 4;
            const float* xr = row < NLAT ? p.in[I_X] + (size_t)row * DM : p.in[I_CTX] + (size_t)(row - NLAT) * DM;
            f32x4 x[8], y[8];
#pragma unroll
            for (int j = 0; j < 8; ++j) x[j] = *(const f32x4*)(xr + j * 256 + lane * 4);
            const float* m = mod + (size_t)rr * 12288;
            rms_mod_store(x, p.in[I_N1G], m + DM, m, (bf16_t*)(ws + WS_H) + (size_t)row * DM, y, lane);
        } else if (it < N1_ROWITEMS + N1_KZ) {
            const int idx = (it - N1_ROWITEMS) * 512 + tid; const int cp = idx & 15, c = (idx >> 4) & 15, d = (idx >> 8) & 15, lzg = idx >> 12;
            const f32x2* PW = (const f32x2*)(ws + WS_PW) + (size_t)lzg * 64 * 17; const f32x2* BB = (const f32x2*)(ws + WS_BB) + (size_t)lzg * 64 * 16;
            const float* cre = p.in[I_CRE] + ((size_t)lzg * 16 + c) * 64; const float* cim = p.in[I_CIM] + ((size_t)lzg * 16 + c) * 64;
            float s = 0.f;
            for (int n = 0; n < 64; ++n) { const f32x2 pw = PW[n * 17 + d], bb = BB[n * 16 + cp]; const float cr = cre[n], ci = cim[n];
                const float tr = pw.x * bb.x - pw.y * bb.y, ti = pw.x * bb.y + pw.y * bb.x; s += cr * tr - ci * ti; }
            ((float*)(ws + WS_KZ))[idx] = s;
        } else if (it < N1_ROWITEMS + N1_KZ + N1_WST) {
            const int idx = (it - N1_ROWITEMS - N1_KZ) * 512 + tid; const int c8 = (idx & 1) * 8, pp = (idx >> 1) & 15, row = (idx >> 5) & 255, lg = idx >> 13;
            const int l = lg >> 5, g = lg & 31, z = row >> 7, ri = (row >> 6) & 1, n = row & 63;
            const size_t lzgn = (((size_t)l * 2 + z) * 32 + g) * 64 + n;
            const f32x2 pw = ((const f32x2*)(ws + WS_PW))[lzgn * 17 + (z == 0 ? 15 - pp : pp)]; const f32x2* BB = (const f32x2*)(ws + WS_BB) + lzgn * 16 + c8;
            float f[8];
#pragma unroll
            for (int j = 0; j < 8; ++j) { const f32x2 bb = BB[j]; f[j] = ri == 0 ? (pw.x * bb.x - pw.y * bb.y) : (pw.x * bb.y + pw.y * bb.x); }
            u32x4 w; w.x = cvt_pk_bf16(f[0], f[1]); w.y = cvt_pk_bf16(f[2], f[3]); w.z = cvt_pk_bf16(f[4], f[5]); w.w = cvt_pk_bf16(f[6], f[7]);
            *(u32x4*)((bf16_t*)(ws + WS_WST) + ((size_t)lg * 256 + row) * 256 + pp * 16 + c8) = w;
        } else {
            const int idx = (it - N1_ROWITEMS - N1_KZ - N1_WST) * 512 + tid; const int n8 = (idx & 7) * 8, ri = (idx >> 3) & 1, z = (idx >> 4) & 1, row = (idx >> 5) & 255, lg = idx >> 13;
            const int l = lg >> 5, g = lg & 31, pp = row >> 4, c = row & 15;
            const size_t lzg = ((size_t)l * 2 + z) * 32 + g;
            const f32x2* PW = (const f32x2*)(ws + WS_PW) + (lzg * 64 + n8) * 17 + (z == 0 ? pp + 1 : 16 - pp);
            const float* cre = p.in[I_CRE] + (lzg * 16 + c) * 64 + n8; const float* cim = p.in[I_CIM] + (lzg * 16 + c) * 64 + n8;
            float f[8];
#pragma unroll
            for (int j = 0; j < 8; ++j) { const f32x2 pw = PW[j * 17]; const float cr = cre[j], ci = cim[j]; f[j] = ri == 0 ? (cr * pw.x - ci * pw.y) : -(cr * pw.y + ci * pw.x); }
            u32x4 w; w.x = cvt_pk_bf16(f[0], f[1]); w.y = cvt_pk_bf16(f[2], f[3]); w.z = cvt_pk_bf16(f[4], f[5]); w.w = cvt_pk_bf16(f[6], f[7]);
            *(u32x4*)((bf16_t*)(ws + WS_G2B) + ((size_t)lg * 256 + row) * 512 + 256 + z * 128 + ri * 64 + n8) = w;
        }
    }
}

constexpr int B_ROWITEMS = MT / 8, B_SGU = 72 * 4, B_INTRA = 512;
__device__ __forceinline__ void ph_rowsplit(const Params& p, int l, LAS unsigned char* lds) {
    const int tid = opaque_tid(), lane = tid & 63, wave = tid >> 6;
    unsigned char* ws = opaque_ptr(p.ws);
    const bf16_t* P = (const bf16_t*)(ws + WS_PA);
    bf16_t* CAT = (bf16_t*)(ws + WS_CAT);
    for (int it = blockIdx.x; it < B_ROWITEMS + B_SGU + B_INTRA; it += gridDim.x) {
        if (it < B_ROWITEMS) {
            const int row = it * 8 + wave; const bf16_t* pr = P + (size_t)row * INP;
            const bool lat = row < NLAT; const int t = lat ? (row & (SEQ - 1)) : ((row - NLAT) & (CTX - 1)); const int b = lat ? (row >> 11) : ((row - NLAT) >> 8);
            const int seqlen = lat ? SEQ : CTX;
            { float f[8]; float ss = 0.f;
              if (lane < 48) { const u32x4 v = *(const u32x4*)(pr + C_CQ + lane * 8); f[0] = bflo(v.x); f[1] = bfhi(v.x); f[2] = bflo(v.y); f[3] = bfhi(v.y); f[4] = bflo(v.z); f[5] = bfhi(v.z); f[6] = bflo(v.w); f[7] = bfhi(v.w);
#pragma unroll
                  for (int j = 0; j < 8; ++j) ss += f[j] * f[j]; }
              else {
#pragma unroll
                  for (int j = 0; j < 8; ++j) f[j] = 0.f; }
              ss = wave_sum(ss); const float rinv = rsqrtf(ss * (1.0f / 384.0f) + EPS);
              if (lane < 48) { const float* g = p.in[I_QNG] + l * 384 + lane * 8; u32x4 w;
                  w.x = cvt_pk_bf16(f[0] * rinv * g[0], f[1] * rinv * g[1]); w.y = cvt_pk_bf16(f[2] * rinv * g[2], f[3] * rinv * g[3]);
                  w.z = cvt_pk_bf16(f[4] * rinv * g[4], f[5] * rinv * g[5]); w.w = cvt_pk_bf16(f[6] * rinv * g[6], f[7] * rinv * g[7]);
                  *(u32x4*)((bf16_t*)(ws + WS_QA) + (size_t)row * 384 + lane * 8) = w; } }
            { const u32x2 v = *(const u32x2*)(pr + C_CKV + lane * 4); const float f0 = bflo(v.x), f1 = bfhi(v.x), f2 = bflo(v.y), f3 = bfhi(v.y);
              const float ss = wave_sum(f0 * f0 + f1 * f1 + f2 * f2 + f3 * f3); const float rinv = rsqrtf(ss * (1.0f / 256.0f) + EPS);
              const float* g = p.in[I_KVNG] + l * 256 + lane * 4; u32x2 w; w.x = cvt_pk_bf16(f0 * rinv * g[0], f1 * rinv * g[1]); w.y = cvt_pk_bf16(f2 * rinv * g[2], f3 * rinv * g[3]);
              *(u32x2*)((bf16_t*)(ws + WS_KVA) + (size_t)row * 256 + lane * 4) = w; }
            { float v = bf2f(pr[C_KR + lane]); const float partner = __shfl_xor(v, 16);
              if (lat) { const int jj = lane & 31, fi = jj & 15; const int pos = lane >= 32 ? (t & 63) : (t >> 6);
                  const f32x2 r = ((const f32x2*)(ws + WS_ROPE))[pos * 16 + fi]; const float cs = r.x, sn = r.y;
                  v = jj < 16 ? (v * cs - partner * sn) : (v * cs + partner * sn); }
              const int key = lat ? CTX + t : t; const unsigned short o = f2bf(v);
              bf16_t* kc = (bf16_t*)(ws + WS_KC);
#pragma unroll
              for (int h = 0; h < 4; ++h) kc[((size_t)(b * 4 + h) * NKEY + key) * 192 + 128 + lane] = o; }
            { const u32x4 v = *(const u32x4*)(pr + C_S5 + lane * 8); const int g = lane >> 1, half = lane & 1;
              *(u32x4*)((bf16_t*)(ws + WS_UPK) + ((size_t)g * 768 + (row >> 4)) * 512 + (row & 15) * 16 + half * 8) = v; }
            { const int c0 = lane * 8; float zp[8], zc[8], zn[8];
#pragma unroll
              for (int j = 0; j < 8; ++j) { zp[j] = 0.f; zn[j] = 0.f; }
#define CONV_Z(dst, rp) do { const u32x4 a_ = *(const u32x4*)((rp) + C_CVC + c0); const u32x4 h_ = *(const u32x4*)((rp) + C_CVH + c0); \
                  dst[0] = bflo(a_.x) * bflo(h_.x); dst[1] = bfhi(a_.x) * bfhi(h_.x); dst[2] = bflo(a_.y) * bflo(h_.y); dst[3] = bfhi(a_.y) * bfhi(h_.y); \
                  dst[4] = bflo(a_.z) * bflo(h_.z); dst[5] = bfhi(a_.z) * bfhi(h_.z); dst[6] = bflo(a_.w) * bflo(h_.w); dst[7] = bfhi(a_.w) * bfhi(h_.w); } while (0)
              CONV_Z(zc, pr);
              if (t > 0) CONV_Z(zp, pr - INP);
              if (t < seqlen - 1) CONV_Z(zn, pr + INP);
#undef CONV_Z
              const u32x4 bg = *(const u32x4*)(pr + C_CVB + c0); float bgf[8] = {bflo(bg.x), bfhi(bg.x), bflo(bg.y), bfhi(bg.y), bflo(bg.z), bfhi(bg.z), bflo(bg.w), bfhi(bg.w)};
              const float* cw = p.in[I_CONVW] + (size_t)l * 3 * 512 + c0; float o[8];
#pragma unroll
              for (int j = 0; j < 8; ++j) o[j] = bgf[j] * (cw[j] * zp[j] + cw[512 + j] * zc[j] + cw[1024 + j] * zn[j]);
              u32x4 w; w.x = cvt_pk_bf16(o[0], o[1]); w.y = cvt_pk_bf16(o[2], o[3]); w.z = cvt_pk_bf16(o[4], o[5]); w.w = cvt_pk_bf16(o[6], o[7]);
              *(u32x4*)(CAT + (size_t)row * DM + 1536 + c0) = w; }
        } else if (it < B_ROWITEMS + B_SGU) {
            const int un = it - B_ROWITEMS, cc = un >> 2, h = un & 3; const int row0 = cc * 128;
            LAS bf16_t* Wl = (LAS bf16_t*)lds;
            LAS bf16_t* Vl = (LAS bf16_t*)(lds + 128 * 136 * 2);
            const float* Wg = p.in[I_SGUW] + ((size_t)l * 4 + h) * 128 * 128;
#pragma unroll
            for (int i = 0; i < 8; ++i) { const int e4 = (i * 512 + tid) * 4, r = e4 >> 7, c = e4 & 127; const f32x4 v = *(const f32x4*)(Wg + e4);
                u32x2 w; w.x = cvt_pk_bf16(v[0], v[1]); w.y = cvt_pk_bf16(v[2], v[3]); *(LAS u32x2*)(Wl + r * 136 + c) = w; }
            for (int qi = 0; qi < 16; ++qi) { const int q = wave * 16 + qi; const bf16_t* pr = P + (size_t)(row0 + q) * INP + C_SGU_V;
                const u32x4 v = *(const u32x4*)(pr + lane * 8); float f[8] = {bflo(v.x), bfhi(v.x), bflo(v.y), bfhi(v.y), bflo(v.z), bfhi(v.z), bflo(v.w), bfhi(v.w)}; float ss = 0.f;
#pragma unroll
                for (int j = 0; j < 8; ++j) { f[j] = gelu_tanh(f[j]); ss += f[j] * f[j]; }
                ss = wave_sum(ss); const float rinv = rsqrtf(ss * (1.0f / 512.0f) + EPS);
                if ((lane >> 4) == h) { const int c0 = (lane & 15) * 8; const float* g = p.in[I_SGUNG] + l * 512 + h * 128 + c0;
#pragma unroll
                    for (int j = 0; j < 8; ++j) Vl[(c0 + j) * 136 + q] = f2bf(f[j] * rinv * g[j]); } }
            __syncthreads();
            { const int fr = lane & 15, fq = lane >> 4; f32x4 acc[8];
#pragma unroll
              for (int nb = 0; nb < 8; ++nb) acc[nb] = (f32x4){0.f, 0.f, 0.f, 0.f};
#pragma unroll
              for (int ks = 0; ks < 4; ++ks) { const bf16x8 af = *(const LAS bf16x8*)(Wl + (wave * 16 + fr) * 136 + ks * 32 + fq * 8);
#pragma unroll
                  for (int nb = 0; nb < 8; ++nb) { const bf16x8 bfr = *(const LAS bf16x8*)(Vl + (nb * 16 + fr) * 136 + ks * 32 + fq * 8);
                      acc[nb] = __builtin_amdgcn_mfma_f32_16x16x32_bf16(bfr, af, acc[nb], 0, 0, 0); } }
              const int pp = wave * 16 + fr; const float bias = p.in[I_SGUB][((size_t)l * 4 + h) * 128 + pp]; const bf16_t* pr = P + (size_t)(row0 + pp) * INP + C_SGU_U + h * 128;
#pragma unroll
              for (int nb = 0; nb < 8; ++nb) { const int c = nb * 16 + 4 * fq; const u32x2 uv = *(const u32x2*)(pr + c);
                  u32x2 w; w.x = cvt_pk_bf16(gelu_tanh(bflo(uv.x)) * (acc[nb][0] + bias), gelu_tanh(bfhi(uv.x)) * (acc[nb][1] + bias));
                  w.y = cvt_pk_bf16(gelu_tanh(bflo(uv.y)) * (acc[nb][2] + bias), gelu_tanh(bfhi(uv.y)) * (acc[nb][3] + bias));
                  *(u32x2*)(CAT + (size_t)(row0 + pp) * DM + h * 128 + c) = w; } }
            __syncthreads();
        } else {
            const int idx = (it - B_ROWITEMS - B_SGU) * 512 + tid; const int c8 = (idx & 1) * 8, pq = (idx >> 1) & 15, row = (idx >> 5) & 255, g = idx >> 13;
            const int pp = row >> 4, c = row & 15;
            const float* KZf = (const float*)(ws + WS_KZ) + (((size_t)l * 2 + 0) * 32 + g) * 4096; const float* KZb = (const float*)(ws + WS_KZ) + (((size_t)l * 2 + 1) * 32 + g) * 4096;
            float f[8];
#pragma unroll
            for (int j = 0; j < 8; ++j) { float v = 0.f; if (pq <= pp) v += KZf[((pp - pq) * 16 + c) * 16 + c8 + j]; if (pq >= pp) v += KZb[((pq - pp) * 16 + c) * 16 + c8 + j];
                if (pq == pp && c8 + j == c) v += p.in[I_S5D][l * 512 + g * 16 + c]; f[j] = v; }
            u32x4 w; w.x = cvt_pk_bf16(f[0], f[1]); w.y = cvt_pk_bf16(f[2], f[3]); w.z = cvt_pk_bf16(f[4], f[5]); w.w = cvt_pk_bf16(f[6], f[7]);
            *(u32x4*)((bf16_t*)(ws + WS_G2B) + (((size_t)l * 32 + g) * 256 + row) * 512 + pq * 16 + c8) = w;
        }
    }
}

constexpr int KPITCH = 400, VPITCH = 144;
constexpr int KT_BYTES = 64 * KPITCH, VT_BYTES = 128 * VPITCH;
__device__ __forceinline__ void attn_unit(const bf16_t* Qrows  , const bf16_t* Kbh, const bf16_t* Vbh, int nkeys, bf16_t* Orows, LAS unsigned char* lds) {
    const int tid = opaque_tid(), lane = tid & 63, wave = tid >> 6, fr = lane & 15, fq = lane >> 4;
    LAS unsigned char* Kb[2] = {lds, lds + KT_BYTES + VT_BYTES};
    LAS unsigned char* Vb[2] = {lds + KT_BYTES, lds + 2 * KT_BYTES + VT_BYTES};
    bf16x8 qf[6];
    { const bf16_t* qr = Qrows + (size_t)(wave * 16 + fr) * 768 + fq * 8;
#pragma unroll
      for (int ks = 0; ks < 6; ++ks) qf[ks] = *(const bf16x8*)(qr + ks * 32); }
    f32x4 o[8];
#pragma unroll
    for (int db = 0; db < 8; ++db) o[db] = (f32x4){0.f, 0.f, 0.f, 0.f};
    float mrow = -1e30f, lsum = 0.f;
    const int nt = nkeys / 64;
    u32x4 kreg[3], vreg[2];
#define ATT_LOADG(tile) do { const char* kg = (const char*)(Kbh + (size_t)(tile) * 64 * 192); \
        _Pragma("unroll") for (int i = 0; i < 3; ++i) kreg[i] = *(const u32x4*)(kg + (size_t)(i * 512 + tid) * 16); \
        _Pragma("unroll") for (int i = 0; i < 2; ++i) { const int pc = i * 512 + tid; vreg[i] = *(const u32x4*)((const char*)(Vbh + (size_t)(pc >> 3) * NKEY + (tile) * 64) + (pc & 7) * 16); } } while (0)
#define ATT_STOREL(buf) do { \
        _Pragma("unroll") for (int i = 0; i < 3; ++i) { const int pc = i * 512 + tid; *(LAS u32x4*)(Kb[buf] + (pc / 24) * KPITCH + (pc % 24) * 16) = kreg[i]; } \
        _Pragma("unroll") for (int i = 0; i < 2; ++i) { const int pc = i * 512 + tid; *(LAS u32x4*)(Vb[buf] + (pc >> 3) * VPITCH + (pc & 7) * 16) = vreg[i]; } } while (0)
    ATT_LOADG(0); ATT_STOREL(0);
    __syncthreads();
    for (int j = 0; j < nt; ++j) {
        const int cur = j & 1;
        if (j + 1 < nt) ATT_LOADG(j + 1);
        f32x4 s[4];
#pragma unroll
        for (int kb = 0; kb < 4; ++kb) { s[kb] = (f32x4){0.f, 0.f, 0.f, 0.f};
#pragma unroll
            for (int ks = 0; ks < 6; ++ks) { const bf16x8 kf = *(const LAS bf16x8*)(Kb[cur] + (kb * 16 + fr) * KPITCH + ks * 64 + fq * 16);
                s[kb] = __builtin_amdgcn_mfma_f32_16x16x32_bf16(kf, qf[ks], s[kb], 0, 0, 0); } }
        float mx = s[0][0];
#pragma unroll
        for (int kb = 0; kb < 4; ++kb)
#pragma unroll
            for (int r = 0; r < 4; ++r) mx = fmaxf(mx, s[kb][r]);
        mx = fmaxf(mx, __shfl_xor(mx, 16)); mx = fmaxf(mx, __shfl_xor(mx, 32));
        const float mnew = fmaxf(mrow, mx), alpha = exp2f(mrow - mnew); mrow = mnew;
        float ps = 0.f;
#pragma unroll
        for (int kb = 0; kb < 4; ++kb)
#pragma unroll
            for (int r = 0; r < 4; ++r) { s[kb][r] = exp2f(s[kb][r] - mnew); ps += s[kb][r]; }
        lsum = lsum * alpha + ps;
#pragma unroll
        for (int db = 0; db < 8; ++db) o[db] *= alpha;
#pragma unroll
        for (int sidx = 0; sidx < 2; ++sidx) {
            u32x4 pw; pw.x = cvt_pk_bf16(s[2 * sidx][0], s[2 * sidx][1]); pw.y = cvt_pk_bf16(s[2 * sidx][2], s[2 * sidx][3]);
            pw.z = cvt_pk_bf16(s[2 * sidx + 1][0], s[2 * sidx + 1][1]); pw.w = cvt_pk_bf16(s[2 * sidx + 1][2], s[2 * sidx + 1][3]);
            const bf16x8 pf = __builtin_bit_cast(bf16x8, pw);
#pragma unroll
            for (int db = 0; db < 8; ++db) { const LAS unsigned char* vp = Vb[cur] + (db * 16 + fr) * VPITCH + sidx * 64 + fq * 8;
                u32x4 vw; const u32x2 lo = *(const LAS u32x2*)vp, hi = *(const LAS u32x2*)(vp + 32); vw.x = lo.x; vw.y = lo.y; vw.z = hi.x; vw.w = hi.y;
                o[db] = __builtin_amdgcn_mfma_f32_16x16x32_bf16(__builtin_bit_cast(bf16x8, vw), pf, o[db], 0, 0, 0); } }
        if (j + 1 < nt) ATT_STOREL(cur ^ 1);
        __syncthreads();
    }
#undef ATT_LOADG
#undef ATT_STOREL
    lsum += __shfl_xor(lsum, 16); lsum += __shfl_xor(lsum, 32);
    const float inv = 1.0f / lsum;
    bf16_t* orow = Orows + (size_t)(wave * 16 + fr) * DM;
#pragma unroll
    for (int db = 0; db < 8; ++db) { u32x2 w; w.x = cvt_pk_bf16(o[db][0] * inv, o[db][1] * inv); w.y = cvt_pk_bf16(o[db][2] * inv, o[db][3] * inv); *(u32x2*)(orow + db * 16 + 4 * fq) = w; }
}
__device__ __forceinline__ void ph_attn_carry(const Params& p, int l, LAS unsigned char* lds) {
    unsigned char* ws = opaque_ptr(p.ws); const int tid = opaque_tid();
    const int natt = (l == 0) ? 288 : 256;
    const bf16_t* QB = (const bf16_t*)(ws + WS_QB); const bf16_t* KC = (const bf16_t*)(ws + WS_KC); const bf16_t* VT = (const bf16_t*)(ws + WS_VT); bf16_t* CAT = (bf16_t*)(ws + WS_CAT);
    for (int it = blockIdx.x; it < natt + 32; it += gridDim.x) {
        if (it < natt) {
            int b, h, row0, nkeys;
            if (it < 256) { b = it >> 6; h = (it >> 4) & 3; row0 = b * SEQ + (it & 15) * 128; nkeys = NKEY; }
            else { const int u = it - 256; b = u >> 3; h = (u >> 1) & 3; row0 = NLAT + b * CTX + (u & 1) * 128; nkeys = CTX; }
            attn_unit(QB + (size_t)row0 * 768 + h * 192, KC + (size_t)(b * 4 + h) * NKEY * 192, VT + (size_t)(b * 4 + h) * 128 * NKEY, nkeys, CAT + (size_t)row0 * DM + 512 + h * 128, lds);
        } else {
            const int g = it - natt; const int z = tid >> 8, b = (tid >> 6) & 3, n = tid & 63;
            const f32x2 a16 = ((const f32x2*)(ws + WS_PW))[((((size_t)l * 2 + z) * 32 + g) * 64 + n) * 17 + 16];
            const float* EST = (const float*)(ws + WS_EST) + (size_t)g * 768 * 256 + z * 128 + n;
            bf16_t* UP = (bf16_t*)(ws + WS_UPK) + (size_t)g * 768 * 512 + 256 + z * 128 + n;
            float sr = 0.f, si = 0.f;
            for (int st = 0; st < 144; ++st) {
                int chunk;
                if (z == 0) chunk = st < 16 ? (512 + b * 16 + st) : (b * 128 + (st - 16));
                else        chunk = st < 16 ? (512 + b * 16 + (15 - st)) : (b * 128 + (143 - st));
                UP[(size_t)chunk * 512] = f2bf(sr); UP[(size_t)chunk * 512 + 64] = f2bf(si);
                const float er = EST[(size_t)chunk * 256], ei = EST[(size_t)chunk * 256 + 64];
                const float nr = a16.x * sr - a16.y * si + er, ni = a16.x * si + a16.y * sr + ei; sr = nr; si = ni;
            }
        }
    }
}

__device__ __forceinline__ void ph_norm2_router(const Params& p, int l) {
    const int tid = opaque_tid(), lane = tid & 63, wave = tid >> 6;
    unsigned char* ws = opaque_ptr(p.ws); const float* mod = (const float*)(ws + WS_MOD) + (size_t)l * 5 * 12288;
    const int nrows = (l == 0) ? MT : NLAT;
    const float* WR = p.in[I_WROUTER] + (size_t)l * DM * NE;
    for (int it = blockIdx.x; it < nrows / 8; it += gridDim.x) {
        const int row = it * 8 + wave; const int rr = row < NLAT ? (row >> 11) : 4;
        const float* xr = (const float*)(ws + WS_XB) + (size_t)row * DM;
        f32x4 x[8], y[8];
#pragma unroll
        for (int j = 0; j < 8; ++j) x[j] = *(const f32x4*)(xr + j * 256 + lane * 4);
        const float* m = mod + (size_t)rr * 12288;
        rms_mod_store(x, p.in[I_N2G] + l * DM, m + 4 * DM, m + 3 * DM, (bf16_t*)(ws + WS_H) + (size_t)row * DM, y, lane);
        float lg[16];
#pragma unroll
        for (int e = 0; e < 16; ++e) lg[e] = 0.f;
#pragma unroll
        for (int j = 0; j < 8; ++j)
#pragma unroll
            for (int i = 0; i < 4; ++i) { const float* wr = WR + (size_t)(j * 256 + lane * 4 + i) * NE; const float hv = y[j][i];
#pragma unroll
                for (int e4 = 0; e4 < 4; ++e4) { const f32x4 w = *(const f32x4*)(wr + e4 * 4); lg[e4 * 4 + 0] += hv * w[0]; lg[e4 * 4 + 1] += hv * w[1]; lg[e4 * 4 + 2] += hv * w[2]; lg[e4 * 4 + 3] += hv * w[3]; } }
        float mx = -1e30f;
#pragma unroll
        for (int e = 0; e < 16; ++e) { lg[e] = wave_sum(lg[e]); mx = fmaxf(mx, lg[e]); }
        float se = 0.f;
#pragma unroll
        for (int e = 0; e < 16; ++e) { lg[e] = __expf(lg[e] - mx); se += lg[e]; }
        const float inv = 1.0f / se;
        float mine = 0.f;
#pragma unroll
        for (int e = 0; e < 16; ++e) mine = (lane == e) ? lg[e] * inv : mine;
        if (lane < 16) ((float*)(ws + WS_AFF))[(size_t)row * 16 + lane] = mine;
    }
}

__device__ __forceinline__ void ph_topk(const Params& p, int l, LAS unsigned char* lds) {
    const int tid = opaque_tid(), lane = tid & 63, wave = tid >> 6;
    unsigned char* ws = opaque_ptr(p.ws); const float* AFF = (const float*)(ws + WS_AFF);
    int* ROWTOK = (int*)(ws + WS_ROWTOK); float* ROWAFF = (float*)(ws + WS_ROWAFF); int* INV = (int*)(ws + WS_INV);
    LAS int* hist = (LAS int*)lds;
    LAS int* ctl = (LAS int*)(lds + 1024);
    LAS int* wsum = (LAS int*)(lds + 1280);
    const int nunits = (l == 0) ? 128 : 64;
    for (int it = blockIdx.x; it < nunits; it += gridDim.x) {
        const bool lat = it < 64; const int u = lat ? it : it - 64; const int b = u >> 4, e = u & 15;
        const int n = lat ? SEQ : CTX, cap = lat ? CAPL : CAPC;
        const int tok0 = lat ? b * SEQ : NLAT + b * CTX; const int rowbase = lat ? b * CAPL : 1024 + b * CAPC;
        unsigned key[4];
#pragma unroll
        for (int j = 0; j < 4; ++j) { const int t = tid * 4 + j; key[j] = t < n ? __float_as_uint(AFF[(size_t)(tok0 + t) * 16 + e]) : 0u; }
        unsigned prefix = 0u; int remaining = cap;
        for (int pass = 3; pass >= 0; --pass) {
            if (tid < 256) hist[tid] = 0;
            __syncthreads();
#pragma unroll
            for (int j = 0; j < 4; ++j) { const int t = tid * 4 + j; if (t < n) { const bool match = (pass == 3) || ((key[j] >> (8 * (pass + 1))) == (prefix >> (8 * (pass + 1)))); if (match) atomicAdd((int*)&hist[(key[j] >> (8 * pass)) & 255u], 1); } }
            __syncthreads();
            if (wave == 0) {
                const int b0 = hist[4 * lane], b1 = hist[4 * lane + 1], b2 = hist[4 * lane + 2], b3 = hist[4 * lane + 3];
                const int s = b0 + b1 + b2 + b3; int suf = s;
#pragma unroll
                for (int off = 1; off < 64; off <<= 1) { const int t = __shfl_down(suf, off); if (lane + off < 64) suf += t; }
                const int above = suf - s; const int c3 = above + b3, c2 = c3 + b2, c1 = c2 + b1, c0 = c1 + b0;
                if (above < remaining && c0 >= remaining) { int dg, nr;
                    if (c3 >= remaining) { dg = 4 * lane + 3; nr = remaining - above; } else if (c2 >= remaining) { dg = 4 * lane + 2; nr = remaining - c3; }
                    else if (c1 >= remaining) { dg = 4 * lane + 1; nr = remaining - c2; } else { dg = 4 * lane; nr = remaining - c1; }
                    ctl[0] = dg; ctl[1] = nr; }
            }
            __syncthreads();
            prefix |= ((unsigned)ctl[0]) << (8 * pass); remaining = ctl[1];
            __syncthreads();
        }
        int cgt = 0, ceq = 0;
#pragma unroll
        for (int j = 0; j < 4; ++j) { const int t = tid * 4 + j; if (t < n) { cgt += key[j] > prefix ? 1 : 0; ceq += key[j] == prefix ? 1 : 0; } }
        const int packed = cgt | (ceq << 16);
        int inc = packed;
#pragma unroll
        for (int off = 1; off < 64; off <<= 1) { const int t = __shfl_up(inc, off); if (lane >= off) inc += t; }
        if (lane == 63) wsum[wave] = inc;
        __syncthreads();
        int base = 0;
#pragma unroll
        for (int w8 = 0; w8 < 8; ++w8) base += (w8 < wave) ? wsum[w8] : 0;
        int excl = base + inc - packed; int egt = excl & 0xffff, eeq = excl >> 16;
#pragma unroll
        for (int j = 0; j < 4; ++j) { const int t = tid * 4 + j; if (t < n) {
                const bool gt = key[j] > prefix, eq = key[j] == prefix; const bool sel = gt || (eq && eeq < remaining);
                const int slot = egt + (eeq < remaining ? eeq : remaining);
                if (sel) { ROWTOK[e * EROWS + rowbase + slot] = tok0 + t; ROWAFF[e * EROWS + rowbase + slot] = __uint_as_float(key[j]); }
                INV[(size_t)(tok0 + t) * 16 + e] = sel ? rowbase + slot : -1;
                egt += gt ? 1 : 0; eeq += eq ? 1 : 0; } }
        __syncthreads();
    }
}

__device__ __forceinline__ void ph_gather(const Params& p, int l) {
    const int tid = opaque_tid(), lane = tid & 63, wave = tid >> 6;
    unsigned char* ws = opaque_ptr(p.ws); const int* ROWTOK = (const int*)(ws + WS_ROWTOK);
    const int rows_per_e = (l == 0) ? 1152 : 1024;
    const int nitems = NE * rows_per_e / 8;
    for (int it = blockIdx.x; it < nitems; it += gridDim.x) {
        const int ridx = it * 8 + wave; const int e = ridx / rows_per_e, r = ridx % rows_per_e;
        const int tok = ROWTOK[e * EROWS + r];
        const u32x4* src = (const u32x4*)((const bf16_t*)(ws + WS_H) + (size_t)tok * DM); u32x4* dst = (u32x4*)((bf16_t*)(ws + WS_PA) + ((size_t)e * EROWS + r) * DM);
#pragma unroll
        for (int j = 0; j < 4; ++j) dst[j * 64 + lane] = src[j * 64 + lane];
    }
}

__device__ __forceinline__ void ph_combine(const Params& p, int l) {
    const int tid = opaque_tid(), lane = tid & 63, wave = tid >> 6;
    unsigned char* ws = opaque_ptr(p.ws); const float* mod = (const float*)(ws + WS_MOD);
    const int nrows = (l == 0) ? MT : NLAT;
    const int* INV = (const int*)(ws + WS_INV); const bf16_t* YS = (const bf16_t*)(ws + WS_YS);
    for (int it = blockIdx.x; it < nrows / 8; it += gridDim.x) {
        const int row = it * 8 + wave; const int rr = row < NLAT ? (row >> 11) : 4;
        const float* xr = (const float*)(ws + WS_XB) + (size_t)row * DM;
        f32x4 x[8], s[8], y[8];
#pragma unroll
        for (int j = 0; j < 8; ++j) { x[j] = *(const f32x4*)(xr + j * 256 + lane * 4); s[j] = (f32x4){0.f, 0.f, 0.f, 0.f}; }
        const int myinv = lane < 16 ? INV[(size_t)row * 16 + lane] : -1;
        for (int e = 0; e < 16; ++e) { const int r = __shfl(myinv, e); if (r >= 0) { const bf16_t* yr = YS + ((size_t)e * EROWS + r) * DM;
#pragma unroll
                for (int j = 0; j < 8; ++j) { const u32x2 v = *(const u32x2*)(yr + j * 256 + lane * 4); s[j][0] += bflo(v.x); s[j][1] += bfhi(v.x); s[j][2] += bflo(v.y); s[j][3] += bfhi(v.y); } } }
        const float* gate = mod + (size_t)(l * 5 + rr) * 12288 + 5 * DM;
#pragma unroll
        for (int j = 0; j < 8; ++j) { const f32x4 gv = *(const f32x4*)(gate + j * 256 + lane * 4); x[j] += gv * s[j]; }
        if (l == 0) {
            float* xo = (float*)(ws + WS_XA) + (size_t)row * DM;
#pragma unroll
            for (int j = 0; j < 8; ++j) *(f32x4*)(xo + j * 256 + lane * 4) = x[j];
            const float* m = mod + (size_t)(5 + rr) * 12288;
            rms_mod_store(x, p.in[I_N1G] + DM, m + DM, m, (bf16_t*)(ws + WS_H) + (size_t)row * DM, y, lane);
        } else {
            float ss = 0.f;
#pragma unroll
            for (int j = 0; j < 8; ++j) ss += x[j][0] * x[j][0] + x[j][1] * x[j][1] + x[j][2] * x[j][2] + x[j][3] * x[j][3];
            ss = wave_sum(ss); const float rinv = rsqrtf(ss * (1.0f / DM) + EPS);
            float* orow = p.out + (size_t)row * DM;
#pragma unroll
            for (int j = 0; j < 8; ++j) { const f32x4 gv = *(const f32x4*)(p.in[I_FNG] + j * 256 + lane * 4); *(f32x4*)(orow + j * 256 + lane * 4) = x[j] * rinv * gv; }
        }
    }
}

constexpr int NPH_LAYER = 13, NPH = 2 + 2 * NPH_LAYER;
__global__ void __launch_bounds__(512, 2) fwd(Params p) {
    extern __shared__ __attribute__((aligned(16))) unsigned char lds_raw[];
    LAS unsigned char* lds = (LAS unsigned char*)lds_raw;
    volatile LAS unsigned* MISC = (volatile LAS unsigned*)(lds + LDS_MISC);
    if (threadIdx.x < 16) MISC[threadIdx.x] = 0u;
    __syncthreads();
    unsigned char* ws = p.ws;
    const int lo = p.ph_lo, hi = p.ph_hi;
    XcdBarrier bar; bar.bar = (unsigned*)(ws + WS_CTL); bar.x = 0; bar.st = MISC;
    if (hi - lo > 1) bar = xcd_barrier_post((unsigned*)(ws + WS_CTL), MISC);
    const int G = gridDim.x, c = blockIdx.x;
#ifndef ONLY_PH
#define ONLY_PH -1
#endif
#define PSEL(id) (ONLY_PH < 0 || ONLY_PH == (id))
#define IN(k) (lo <= (k) && (k) < hi)
#define SEAM(k) do { if (IN(k) && IN((k) + 1)) xcd_barrier(bar); } while (0)

    if (PSEL(0) && IN(0)) { ph_prologue(p, lds); __syncthreads(); }
    SEAM(0);
    if (PSEL(1) && IN(1)) { ph_norm1_tables(p); }
    SEAM(1);
    for (int l = 0; l < 2; ++l) {
        const int pb = 2 + NPH_LAYER * l;
        const float* mod = (const float*)(ws + WS_MOD) + (size_t)l * 5 * 12288;
        if (PSEL(2) && IN(pb + 0)) {
            pg8::TileSched S; S.init(ws + WS_H, (bf16_t*)(ws + WS_WTIN) + (size_t)l * INP * DM, DM, DM, MT / 256, INP / 256, 1, 0, 0, G, c, 0);
            pg8::EpiStoreBf16 E{(bf16_t*)(ws + WS_PA), INP};
            pg8::gemm_phase(lds, pg8::Desc{DM, DM, DM}, S, E);
        }
        SEAM(pb + 0);
        if (PSEL(3) && IN(pb + 1)) { ph_rowsplit(p, l, lds); __syncthreads(); }
        SEAM(pb + 1);
        if (PSEL(4) && IN(pb + 2)) {
#ifndef C_SEL
#define C_SEL 15
#endif
            if (C_SEL & 1) { pg8::TileSched S; S.init(ws + WS_QA, (bf16_t*)(ws + WS_WTUQ) + (size_t)l * 768 * 384, 384, 384, MT / 256, 3, 1, 0, 0, G, c, 0);
              pg8::EpiQ E{(bf16_t*)(ws + WS_QB), (const f32x2*)(ws + WS_ROPE)}; pg8::gemm_phase(lds, pg8::Desc{384, 384, 384}, S, E); }
            if (C_SEL & 2) { pg8::TileSched S; S.init(ws + WS_KVA, (bf16_t*)(ws + WS_WTUKV) + (size_t)l * 1024 * 256, 256, 256, MT / 256, 2, 1, 0, 0, G, c, 112);
              pg8::EpiK E{(bf16_t*)(ws + WS_KC)}; pg8::gemm_phase(lds, pg8::Desc{256, 256, 256}, S, E); }
            if (C_SEL & 4) { pg8::TileSched S; S.init((bf16_t*)(ws + WS_WTUKV) + (size_t)l * 1024 * 256 + 512 * 256, ws + WS_KVA, 256, 256, 2, MT / 256, 1, 0, 0, G, c, 184);
              pg8::EpiV E{(bf16_t*)(ws + WS_VT)}; pg8::gemm_phase(lds, pg8::Desc{256, 256, 256}, S, E); }
            if (C_SEL & 8) { pg8::TileSched S; S.init(ws + WS_UPK, (bf16_t*)(ws + WS_WST) + (size_t)l * 32 * 256 * 256, 512, 256, 3, 1, 32, (size_t)768 * 512 * 2, (size_t)256 * 256 * 2, G, c, 0);
              pg8::EpiS1 E{(float*)(ws + WS_EST)}; pg8::gemm_phase(lds, pg8::Desc{512, 256, 256}, S, E); }
        }
        SEAM(pb + 2);
        if (PSEL(5) && IN(pb + 3)) { ph_attn_carry(p, l, lds); __syncthreads(); }
        SEAM(pb + 3);
        if (PSEL(6) && IN(pb + 4)) {
            pg8::TileSched S; S.init(ws + WS_UPK, (bf16_t*)(ws + WS_G2B) + (size_t)l * 32 * 256 * 512, 512, 512, 3, 1, 32, (size_t)768 * 512 * 2, (size_t)256 * 512 * 2, G, c, 0);
            pg8::EpiS2 E{(bf16_t*)(ws + WS_GB)}; pg8::gemm_phase(lds, pg8::Desc{512, 512, 512}, S, E);
        }
        SEAM(pb + 4);
        if (PSEL(7) && IN(pb + 5)) {
            pg8::TileSched S; S.init(ws + WS_GB, (bf16_t*)(ws + WS_WTGLU) + (size_t)l * 512 * 512, 512, 512, MT / 256, 2, 1, 0, 0, G, c, 0);
            pg8::EpiGlu E{(const bf16_t*)(ws + WS_GB), p.in[I_BGLU] + l * 512, (bf16_t*)(ws + WS_CAT)}; pg8::gemm_phase(lds, pg8::Desc{512, 512, 512}, S, E);
        }
        SEAM(pb + 5);
        if (PSEL(8) && IN(pb + 6)) {
            pg8::TileSched S; S.init(ws + WS_CAT, (bf16_t*)(ws + WS_WTOUT) + (size_t)l * DM * DM, DM, DM, (l == 0 ? MT : NLAT) / 256, DM / 256, 1, 0, 0, G, c, 0);
            pg8::EpiOut E{l == 0 ? p.in[I_X] : (const float*)(ws + WS_XA), l == 0 ? p.in[I_CTX] : (const float*)(ws + WS_XA) + (size_t)NLAT * DM, mod + 2 * DM, (float*)(ws + WS_XB)};
            pg8::gemm_phase(lds, pg8::Desc{DM, DM, DM}, S, E);
        }
        SEAM(pb + 6);
        if (PSEL(9) && IN(pb + 7)) { ph_norm2_router(p, l); }
        SEAM(pb + 7);
        if (PSEL(10) && IN(pb + 8)) { ph_topk(p, l, lds); __syncthreads(); }
        SEAM(pb + 8);
        if (PSEL(11) && IN(pb + 9)) { ph_gather(p, l); }
        SEAM(pb + 9);
        if (PSEL(12) && IN(pb + 10)) {
            pg8::MoeSched S; S.init(ws + WS_PA, (bf16_t*)(ws + WS_WTGU) + (size_t)l * NE * 2048 * DM, DM, DM, l == 0 ? 5 : 4, 8, (size_t)EROWS * DM * 2, (size_t)2048 * DM * 2, G, c);
            pg8::EpiGU E{(bf16_t*)(ws + WS_HID)}; pg8::gemm_phase(lds, pg8::Desc{DM, DM, DM}, S, E);
        }
        SEAM(pb + 10);
        if (PSEL(13) && IN(pb + 11)) {
            pg8::MoeSched S; S.init(ws + WS_HID, (bf16_t*)(ws + WS_WTDN) + (size_t)l * NE * DM * FF, FF, FF, l == 0 ? 5 : 4, 8, (size_t)EROWS * FF * 2, (size_t)DM * FF * 2, G, c);
            pg8::EpiDown E{(bf16_t*)(ws + WS_YS), (const float*)(ws + WS_ROWAFF)}; pg8::gemm_phase(lds, pg8::Desc{FF, FF, FF}, S, E);
        }
        SEAM(pb + 11);
        if (PSEL(14) && IN(pb + 12)) { ph_combine(p, l); }
        SEAM(pb + 12);
    }
#undef IN
#undef SEAM
}

extern "C" void kernel_launch(void* const* d_in, const int* in_sizes, int n_in, void* d_out, int out_size, void* d_ws, size_t ws_size, hipStream_t stream) {
    static int grid = 0;
    if (grid == 0) {
        if (n_in != 33 || ws_size < WS_END) { fprintf(stderr, "kernel_launch: need 33 inputs and >= %zu bytes of workspace; got %d, %zu\n", (size_t)WS_END, n_in, ws_size); grid = -1; return; }
        int dev = 0, cus = 0;
        if (hipGetDevice(&dev) != hipSuccess || hipDeviceGetAttribute(&cus, hipDeviceAttributeMultiprocessorCount, dev) != hipSuccess) { grid = -1; return; }
        if (hipFuncSetAttribute((const void*)fwd, hipFuncAttributeMaxDynamicSharedMemorySize, LDS_BYTES) != hipSuccess) { fprintf(stderr, "kernel_launch: hipFuncSetAttribute failed\n"); grid = -1; return; }
        (void)hipGetLastError();
        grid = cus > 256 ? 256 : cus;
    }
    if (grid < 0) return;
    (void)hipMemsetAsync((char*)d_ws + WS_CTL, 0, CTL_BYTES, stream);
    Params a{};
    for (int i = 0; i < 33; ++i) a.in[i] = (const float*)d_in[i];
    a.out = (float*)d_out; a.ws = (unsigned char*)d_ws;
#if MK_SPLIT
    for (int ph = 0; ph < NPH; ++ph) { a.ph_lo = ph; a.ph_hi = ph + 1; hipLaunchKernelGGL(fwd, dim3(grid), dim3(512), LDS_BYTES, stream, a); }
#else
    a.ph_lo = 0; a.ph_hi = NPH; hipLaunchKernelGGL(fwd, dim3(grid), dim3(512), LDS_BYTES, stream, a);
#endif
}
```

```cpp
#include <hip/hip_runtime.h>
#include <cstdint>
#include <cstdio>

#ifndef MK_SPLIT
#define MK_SPLIT 0
#endif

#define LAS __attribute__((address_space(3)))
typedef unsigned short bf16_t;
typedef short bf16x8 __attribute__((ext_vector_type(8)));
typedef short bf16x4 __attribute__((ext_vector_type(4)));
typedef float f32x4 __attribute__((ext_vector_type(4)));
typedef float f32x2 __attribute__((ext_vector_type(2)));
typedef unsigned u32x4 __attribute__((ext_vector_type(4)));
typedef unsigned u32x2 __attribute__((ext_vector_type(2)));

constexpr int DM = 2048, NB = 4, SEQ = 2048, CTX = 256, NLAT = NB * SEQ, NCTX = NB * CTX, MT = NLAT + NCTX;
constexpr int INC = 3776, INP = 3840;
constexpr int C_SGU_U = 0, C_SGU_V = 512, C_CQ = 1024, C_CKV = 1408, C_KR = 1664, C_S5 = 1728, C_CVB = 2240, C_CVC = 2752, C_CVH = 3264;
constexpr int NKEY = CTX + SEQ;
constexpr int NE = 16, FF = 1024, CAPL = 256, CAPC = 32, EROWS = 1280;
constexpr int NCHUNK = MT / 16;
constexpr float EPS = 1e-6f;
constexpr float QSCALE = 0.07216878364870322f * 1.4426950408889634f;

constexpr size_t al256(size_t x) { return (x + 255) & ~(size_t)255; }
constexpr size_t WS_CTL = 0;
constexpr size_t CTL_BYTES = 65536;
constexpr size_t WS_MOD = WS_CTL + CTL_BYTES;
constexpr size_t WS_WTIN = al256(WS_MOD + (size_t)2 * 5 * 12288 * 4);
constexpr size_t WS_WTOUT = al256(WS_WTIN + (size_t)2 * INP * DM * 2);
constexpr size_t WS_WTUQ = al256(WS_WTOUT + (size_t)2 * DM * DM * 2);
constexpr size_t WS_WTUKV = al256(WS_WTUQ + (size_t)2 * 768 * 384 * 2);
constexpr size_t WS_WTGLU = al256(WS_WTUKV + (size_t)2 * 1024 * 256 * 2);
constexpr size_t WS_WTGU = al256(WS_WTGLU + (size_t)2 * 512 * 512 * 2);
constexpr size_t WS_WTDN = al256(WS_WTGU + (size_t)2 * NE * 2048 * DM * 2);
constexpr size_t WS_PW = al256(WS_WTDN + (size_t)2 * NE * DM * FF * 2);
constexpr size_t WS_BB = al256(WS_PW + (size_t)2 * 2 * 32 * 64 * 17 * 8);
constexpr size_t WS_KZ = al256(WS_BB + (size_t)2 * 2 * 32 * 64 * 16 * 8);
constexpr size_t WS_WST = al256(WS_KZ + (size_t)2 * 2 * 32 * 4096 * 4);
constexpr size_t WS_G2B = al256(WS_WST + (size_t)2 * 32 * 256 * 256 * 2);
constexpr size_t WS_H = al256(WS_G2B + (size_t)2 * 32 * 256 * 512 * 2);
constexpr size_t WS_PA = al256(WS_H + (size_t)MT * DM * 2);
constexpr size_t PA_BYTES = (size_t)NE * EROWS * DM * 2;
static_assert(PA_BYTES >= (size_t)MT * INP * 2, "P fits in the union");
constexpr size_t WS_XA = al256(WS_PA + PA_BYTES);
constexpr size_t WS_XB = al256(WS_XA + (size_t)MT * DM * 4);
constexpr size_t WS_CAT = al256(WS_XB + (size_t)MT * DM * 4);
constexpr size_t WS_QA = al256(WS_CAT + (size_t)MT * DM * 2);
constexpr size_t WS_KVA = al256(WS_QA + (size_t)MT * 384 * 2);
constexpr size_t WS_QB = al256(WS_KVA + (size_t)MT * 256 * 2);
constexpr size_t WS_KC = al256(WS_QB + (size_t)MT * 768 * 2);
constexpr size_t WS_VT = al256(WS_KC + (size_t)NB * 4 * NKEY * 192 * 2);
constexpr size_t WS_UPK = al256(WS_VT + (size_t)NB * 4 * 128 * NKEY * 2);
constexpr size_t WS_EST = al256(WS_UPK + (size_t)32 * 768 * 512 * 2);
constexpr size_t WS_GB = al256(WS_EST + (size_t)32 * 768 * 256 * 4);
constexpr size_t WS_AFF = al256(WS_GB + (size_t)MT * 512 * 2);
constexpr size_t WS_ROWTOK = al256(WS_AFF + (size_t)MT * 16 * 4);
constexpr size_t WS_ROWAFF = al256(WS_ROWTOK + (size_t)NE * EROWS * 4);
constexpr size_t WS_INV = al256(WS_ROWAFF + (size_t)NE * EROWS * 4);
constexpr size_t WS_HID = al256(WS_INV + (size_t)MT * 16 * 4);
constexpr size_t WS_YS = al256(WS_HID + (size_t)NE * EROWS * FF * 2);
constexpr size_t WS_ROPE = al256(WS_YS + (size_t)NE * EROWS * DM * 2);
constexpr size_t WS_END = al256(WS_ROPE + 64 * 16 * 8);

constexpr int LDS_GEMM = 131072;
constexpr int LDS_MISC = LDS_GEMM;
constexpr int LDS_BYTES = LDS_GEMM + 256;

__device__ __forceinline__ unsigned cvt_pk_bf16(float lo, float hi) { unsigned r; asm("v_cvt_pk_bf16_f32 %0, %1, %2" : "=v"(r) : "v"(lo), "v"(hi)); return r; }
__device__ __forceinline__ float bf2f(unsigned short b) { return __uint_as_float(((unsigned)b) << 16); }
__device__ __forceinline__ float bflo(unsigned w) { return __uint_as_float(w << 16); }
__device__ __forceinline__ float bfhi(unsigned w) { return __uint_as_float(w & 0xffff0000u); }
__device__ __forceinline__ unsigned short f2bf(float f) { return (unsigned short)(cvt_pk_bf16(f, 0.f) & 0xffffu); }
__device__ __forceinline__ int opaque_tid() { int t = threadIdx.x; asm volatile("" : "+v"(t)); return t; }
__device__ __forceinline__ unsigned char* opaque_ptr(unsigned char* q) { asm volatile("" : "+s"(q)); return q; }
__device__ __forceinline__ float wave_sum(float v) {
#pragma unroll
    for (int o = 32; o >= 1; o >>= 1) v += __shfl_xor(v, o);
    return v;
}
__device__ __forceinline__ float gelu_tanh(float x) {
    const float y = 1.5957691216057308f * (x + 0.044715f * x * x * x);
    return x / (1.0f + __expf(-y));
}
__device__ __forceinline__ float silu_f(float x) { return x / (1.0f + __expf(-x)); }
__device__ __forceinline__ float sigmoid_f(float x) { return 1.0f / (1.0f + __expf(-x)); }

#define XB_TMO      128
#define XB_XCNT(j)  (256  + 64 * (j))
#define XB_XSUB(j)  (1280 + 64 * (j))
#define XB_XGEN(j)  (2304 + 64 * (j))
#define XB_TOP      3328
#define XB_TOPGEN   3392
#define XCD_BAR_WORDS 3456
#define XB_SPIN_CAP (1u << 22)
__device__ __forceinline__ unsigned xb_ld(unsigned* p)              { return __hip_atomic_load(p, __ATOMIC_RELAXED, __HIP_MEMORY_SCOPE_AGENT); }
__device__ __forceinline__ unsigned xb_add(unsigned* p, unsigned v) { return __hip_atomic_fetch_add(p, v, __ATOMIC_RELAXED, __HIP_MEMORY_SCOPE_AGENT); }
__device__ __forceinline__ unsigned xb_xcc_id() { return (unsigned)__builtin_amdgcn_s_getreg((3 << 11) | 20) & 0xFu; }
#define XB_SPIN(cond, bar) do { unsigned _sp = 0; while (cond) { __builtin_amdgcn_s_sleep(1); \
    if ((++_sp & 255u) == 0u) { if (xb_ld(&(bar)[XB_TMO])) break; if (_sp > XB_SPIN_CAP) { atomicAdd(&(bar)[XB_TMO], 1u); break; } } } } while (0)
struct XcdBarrier { unsigned* bar; unsigned x; volatile LAS unsigned* st; };
__device__ __forceinline__ XcdBarrier xcd_barrier_post(unsigned* bar, volatile LAS unsigned* st) {
    XcdBarrier b; b.bar = bar; b.x = xb_xcc_id(); b.st = st;
    if (threadIdx.x == 0) (void)xb_add(&bar[XB_XCNT(b.x)], 1u);
    return b;
}
__device__ __forceinline__ void xcd_barrier_complete(unsigned* bar, unsigned x, unsigned& nloc, unsigned& nx) {
    const unsigned G = gridDim.x * gridDim.y * gridDim.z;
    unsigned sum, cnt, mine, sp = 0u;
    for (;;) {
        sum = 0u; cnt = 0u; mine = 0u;
#pragma unroll
        for (unsigned j = 0; j < 16; ++j) { const unsigned c = xb_ld(&bar[XB_XCNT(j)]); sum += c; cnt += (c > 0u) ? 1u : 0u; mine = (j == x) ? c : mine; }
        if (sum == G) break;
        __builtin_amdgcn_s_sleep(1);
        if ((++sp & 255u) == 0u) { if (xb_ld(&bar[XB_TMO])) break; if (sp > XB_SPIN_CAP) { atomicAdd(&bar[XB_TMO], 1u); break; } }
    }
    nloc = mine > 0u ? mine : 1u; nx = cnt > 0u ? cnt : 1u;
}
__device__ __forceinline__ void xcd_barrier(const XcdBarrier& b) {
    asm volatile("s_waitcnt vmcnt(0)" ::: "memory");
    __syncthreads();
    if (threadIdx.x == 0) {
        unsigned* bar = b.bar;
        __builtin_amdgcn_s_waitcnt(0);
        unsigned nloc = b.st[0], nx = b.st[1];
        if (nloc == 0u) { xcd_barrier_complete(bar, b.x, nloc, nx); b.st[0] = nloc; b.st[1] = nx; }
        const unsigned old = xb_add(&bar[XB_XSUB(b.x)], 1u);
        const unsigned gen = old / nloc;
        if (old + 1u == (gen + 1u) * nloc) {
            __builtin_amdgcn_fence(__ATOMIC_RELEASE, "agent");
            asm volatile("s_waitcnt vmcnt(0)" ::: "memory");
            const unsigned og = xb_add(&bar[XB_TOP], 1u);
            const unsigned tg = og / nx;
            if (og + 1u == (tg + 1u) * nx) xb_add(&bar[XB_TOPGEN], 1u);
            else XB_SPIN(xb_ld(&bar[XB_TOPGEN]) == tg, bar);
            __builtin_amdgcn_fence(__ATOMIC_ACQUIRE, "agent");
            xb_add(&bar[XB_XGEN(b.x)], 1u);
            asm volatile("s_waitcnt vmcnt(0)" ::: "memory");
        } else {
            XB_SPIN(xb_ld(&bar[XB_XGEN(b.x)]) == gen, bar);
            __builtin_amdgcn_fence(__ATOMIC_ACQUIRE, "agent");
            asm volatile("s_waitcnt vmcnt(0)" ::: "memory");
        }
    }
    __syncthreads();
}

namespace pg8 {
constexpr int BM = 256, BK = 64, HALF = 128, HTB = HALF * BK * 2, STAGE_BYTES = 8 * HTB;
__host__ __device__ __forceinline__ int lds_byte(int r, int c) { const int st = (r >> 4) * 2 + (c >> 5), rr = r & 15, cc = c & 31, ob = rr * 64 + cc * 2; return st * 1024 + (ob ^ (((ob >> 9) & 1) << 5)); }
__host__ __device__ __forceinline__ void stage_rc(int b, int& R, int& C) { const int st = b / 1024, sb = b % 1024, swz = sb ^ (((sb >> 9) & 1) << 5); R = (st >> 1) * 16 + swz / 64; C = (st & 1) * 32 + (swz % 64) / 2; }
__host__ __device__ __forceinline__ int perm32(int rho) { const int n = rho >> 4, i = rho & 15; return 8 * (i >> 2) + 4 * n + (i & 3); }

struct Unit { const char* a; const char* b; int pm, pn, pb; };
struct Desc { int lda, ldb, K; };

struct TileSched {
    const char* A; const char* B; size_t sA, sB;
    int lda, ldb, nM, nN, nB, G, c;
    __device__ __forceinline__ void init(const void* A_, const void* B_, int lda_, int ldb_, int nM_, int nN_, int nB_, size_t sA_, size_t sB_, int G_, int c_, int off) {
        A = (const char*)A_; B = (const char*)B_; lda = lda_; ldb = ldb_; nM = nM_; nN = nN_; nB = nB_; sA = sA_; sB = sB_; G = G_; c = (c_ + G_ - (off % G_)) % G_; }
    __device__ __forceinline__ bool next(int i, Unit& u) const {
        const int nwg = nM * nN; const long L = (long)i * G + c; if (L >= (long)nwg * nB) return false;
        const int pb = (int)(L / nwg); int wgid = (int)(L % nwg);
        { const int q = nwg / 8, r = nwg % 8, xcd = wgid % 8, off = wgid / 8; wgid = (xcd < r ? xcd * (q + 1) : r * (q + 1) + (xcd - r) * q) + off; }
        const int nig = 8 * nN, gid = wgid / nig, fm = gid * 8, gsz = (nM - fm) < 8 ? (nM - fm) : 8;
        u.pm = fm + ((wgid % nig) % gsz); u.pn = (wgid % nig) / gsz; u.pb = pb;
        u.a = A + (size_t)pb * sA + (size_t)u.pm * 256 * lda * 2; u.b = B + (size_t)pb * sB + (size_t)u.pn * 256 * ldb * 2; return true;
    }
};
struct MoeSched {
    const char* A; const char* B; size_t sA, sB; int lda, ldb, nM, nN, G, c;
    __device__ __forceinline__ void init(const void* A_, const void* B_, int lda_, int ldb_, int nM_, int nN_, size_t sA_, size_t sB_, int G_, int c_) {
        A = (const char*)A_; B = (const char*)B_; lda = lda_; ldb = ldb_; nM = nM_; nN = nN_; sA = sA_; sB = sB_; G = G_; c = c_; }
    __device__ __forceinline__ bool next(int i, Unit& u) const {
        int e, rem; const int per = nM * nN;
        if ((G & 7) == 0) { const int x = c & 7, j = c >> 3, w = G >> 3; const int L = i * w + j; if (L >= 2 * per) return false; e = 2 * x + L / per; rem = L % per; }
        else { const long L = (long)i * G + c; if (L >= (long)NE * per) return false; e = (int)(L / per); rem = (int)(L % per); }
        u.pn = rem / nM; u.pm = rem % nM; u.pb = e;
        u.a = A + (size_t)e * sA + (size_t)u.pm * 256 * lda * 2; u.b = B + (size_t)e * sB + (size_t)u.pn * 256 * ldb * 2; return true;
    }
};

template <class Epi, class Sched>
__device__ __forceinline__ void gemm_phase(LAS unsigned char* lds, const Desc g, const Sched& S, const Epi& E) {
    const int tid = opaque_tid(), wid = __builtin_amdgcn_readfirstlane(tid >> 6), lane = tid & 63, wr = wid >> 2, wc = wid & 3, fr = lane & 15, fq = lane >> 4;
    const int K = g.K, nt = K / BK;
    unsigned voffA[2], voffB[2];
#pragma unroll
    for (int i = 0; i < 2; ++i) { int R, C; stage_rc(tid * 16 + i * 8192, R, C); const int Rb = Epi::PERM ? ((R & ~31) + perm32(R & 31)) : R;
        voffA[i] = (unsigned)(R * g.lda + C) * 2u; voffB[i] = (unsigned)(Rb * g.ldb + C) * 2u; }
    const size_t kstep = (size_t)(BK * 2);
    const size_t hstepA = (size_t)HALF * g.lda * 2, hstepB = (size_t)HALF * g.ldb * 2;
    const unsigned ldsw = (unsigned)wid * 1024u;
    const int aoff = lds_byte(wr * 64 + fr, fq * 8), boff = lds_byte(wc * 32 + fr, fq * 8);
#define PG8_SA(b, h) (((b) * 2 + (h)) * HTB)
#define PG8_SB(b, h) ((4 + (b) * 2 + (h)) * HTB)
#define PG8_STAGE(bufoff, gbase, voff) do { _Pragma("unroll") for (int _i = 0; _i < 2; ++_i) \
        __builtin_amdgcn_global_load_lds((const unsigned*)((const char*)(gbase) + (voff)[_i]), (LAS unsigned*)(lds + (bufoff) + ldsw + _i * 8192), 16, 0, 0); } while (0)
#define PG8_LDA(dst, b, h) do { _Pragma("unroll") for (int m = 0; m < 4; ++m) _Pragma("unroll") for (int k = 0; k < 2; ++k) dst[m][k] = *(const LAS bf16x8*)(lds + PG8_SA(b, h) + aoff + m * 2048 + k * 1024); } while (0)
#define PG8_LDB(dst, b, h) do { _Pragma("unroll") for (int n = 0; n < 2; ++n) _Pragma("unroll") for (int k = 0; k < 2; ++k) dst[n][k] = *(const LAS bf16x8*)(lds + PG8_SB(b, h) + boff + n * 2048 + k * 1024); } while (0)
#define PG8_MMA(ai, bj, At, Bt) do { __builtin_amdgcn_s_setprio(1); _Pragma("unroll") for (int m = 0; m < 4; ++m) _Pragma("unroll") for (int n = 0; n < 2; ++n) _Pragma("unroll") for (int k = 0; k < 2; ++k) \
        acc[ai][bj][m][n] = __builtin_amdgcn_mfma_f32_16x16x32_bf16(Bt[n][k], At[m][k], acc[ai][bj][m][n], 0, 0, 0); __builtin_amdgcn_s_setprio(0); } while (0)
#define PG8_WAIT_V(n) asm volatile("s_waitcnt vmcnt(" #n ")" ::: "memory")
#define PG8_WAIT_L(n) asm volatile("s_waitcnt lgkmcnt(" #n ")" ::: "memory")
#define PG8_BAR __builtin_amdgcn_s_barrier()
#define PG8_SCHED __builtin_amdgcn_sched_barrier(0)
    Unit cur, nxt; int ui = 0;
    if (!S.next(0, cur)) return;
    f32x4 acc[2][2][4][2];
#pragma unroll
    for (int a = 0; a < 2; ++a)
#pragma unroll
        for (int b = 0; b < 2; ++b)
#pragma unroll
            for (int m = 0; m < 4; ++m)
#pragma unroll
                for (int n = 0; n < 2; ++n) acc[a][b][m][n] = (f32x4){0.f, 0.f, 0.f, 0.f};
    bf16x8 At[4][2], B0[2][2], B1[2][2];
    const char* cA = cur.a; const char* cB = cur.b;
    PG8_STAGE(PG8_SB(0, 0), cB, voffB); PG8_STAGE(PG8_SA(0, 0), cA, voffA); PG8_STAGE(PG8_SB(0, 1), cB + hstepB, voffB); PG8_STAGE(PG8_SA(0, 1), cA + hstepA, voffA);
    if (wr == 1) PG8_BAR;
    PG8_WAIT_V(4); PG8_BAR;
    PG8_STAGE(PG8_SB(1, 0), cB + kstep, voffB); PG8_STAGE(PG8_SA(1, 0), cA + kstep, voffA); PG8_STAGE(PG8_SB(1, 1), cB + hstepB + kstep, voffB);
    PG8_WAIT_V(6); PG8_BAR;
    for (;;) {
        const bool has_next = S.next(ui + 1, nxt);
        const char* nA = has_next ? nxt.a : cA; const char* nB = has_next ? nxt.b : cB;
#pragma nounroll
        for (int t = 0; t < nt; t += 2) {
            const bool last = (t == nt - 2);
            const char* a1 = cA + (size_t)(t + 1) * kstep;
            const char* a2 = last ? nA : cA + (size_t)(t + 2) * kstep; const char* b2 = last ? nB : cB + (size_t)(t + 2) * kstep;
            const char* a3 = a2 + kstep; const char* b3 = b2 + kstep;
            PG8_LDB(B0, 0, 0); PG8_SCHED; PG8_LDA(At, 0, 0); PG8_STAGE(PG8_SA(1, 1), a1 + hstepA, voffA);
            PG8_WAIT_L(8); PG8_BAR; PG8_WAIT_L(0); PG8_MMA(0, 0, At, B0); PG8_BAR; PG8_SCHED;
            PG8_LDB(B1, 0, 1); PG8_STAGE(PG8_SB(0, 0), b2, voffB);
            PG8_BAR; PG8_WAIT_L(0); PG8_MMA(0, 1, At, B1); PG8_BAR;
            PG8_LDA(At, 0, 1); PG8_STAGE(PG8_SA(0, 0), a2, voffA);
            PG8_BAR; PG8_WAIT_L(0); PG8_MMA(1, 0, At, B0); PG8_BAR; PG8_SCHED;
            PG8_STAGE(PG8_SB(0, 1), b2 + hstepB, voffB);
            PG8_WAIT_V(6); PG8_BAR; PG8_MMA(1, 1, At, B1); PG8_BAR;
            PG8_LDB(B0, 1, 0); PG8_SCHED; PG8_LDA(At, 1, 0); PG8_STAGE(PG8_SA(0, 1), a2 + hstepA, voffA);
            PG8_WAIT_L(8); PG8_BAR; PG8_WAIT_L(0); PG8_MMA(0, 0, At, B0); PG8_BAR; PG8_SCHED;
            PG8_LDB(B1, 1, 1); PG8_STAGE(PG8_SB(1, 0), b3, voffB);
            PG8_BAR; PG8_WAIT_L(0); PG8_MMA(0, 1, At, B1); PG8_BAR;
            PG8_LDA(At, 1, 1); PG8_STAGE(PG8_SA(1, 0), a3, voffA);
            PG8_BAR; PG8_WAIT_L(0); PG8_MMA(1, 0, At, B0); PG8_BAR; PG8_SCHED;
            PG8_STAGE(PG8_SB(1, 1), b3 + hstepB, voffB);
            PG8_WAIT_V(6); PG8_BAR; PG8_MMA(1, 1, At, B1); PG8_BAR;
        }
        E(acc, cur, wr, wc, fr, fq);
        if (!has_next) break;
#pragma unroll
        for (int a = 0; a < 2; ++a)
#pragma unroll
            for (int b = 0; b < 2; ++b)
#pragma unroll
                for (int m = 0; m < 4; ++m)
#pragma unroll
                    for (int n = 0; n < 2; ++n) acc[a][b][m][n] = (f32x4){0.f, 0.f, 0.f, 0.f};
        cur = nxt; cA = nA; cB = nB; ++ui;
    }
    PG8_WAIT_V(0);
    if (wr == 0) PG8_BAR;
    PG8_BAR;
#undef PG8_SA
#undef PG8_SB
#undef PG8_STAGE
#undef PG8_LDA
#undef PG8_LDB
#undef PG8_MMA
#undef PG8_WAIT_V
#undef PG8_WAIT_L
#undef PG8_BAR
#undef PG8_SCHED
}

#define PG8_FOR_PERM(...) \
    _Pragma("unroll") for (int ai = 0; ai < 2; ++ai) _Pragma("unroll") for (int m = 0; m < 4; ++m) { const int tr = ai * 128 + wr * 64 + m * 16 + fr; \
        _Pragma("unroll") for (int bj = 0; bj < 2; ++bj) { const int tc = bj * 128 + wc * 32 + 8 * fq; const f32x4 v0 = acc[ai][bj][m][0], v1 = acc[ai][bj][m][1]; __VA_ARGS__ } }
#define PG8_FOR_NOPERM(...) \
    _Pragma("unroll") for (int ai = 0; ai < 2; ++ai) _Pragma("unroll") for (int m = 0; m < 4; ++m) { const int tr = ai * 128 + wr * 64 + m * 16 + fr; \
        _Pragma("unroll") for (int bj = 0; bj < 2; ++bj) _Pragma("unroll") for (int n = 0; n < 2; ++n) { const int tc = bj * 128 + wc * 32 + 16 * n + 4 * fq; const f32x4 v = acc[ai][bj][m][n]; __VA_ARGS__ } }

typedef const f32x4 (&AccRef)[2][2][4][2];

struct EpiStoreBf16 {
    static constexpr bool PERM = true;
    bf16_t* O; int ldc;
    __device__ __forceinline__ void operator()(AccRef acc, const Unit& u, int wr, int wc, int fr, int fq) const {
        PG8_FOR_PERM({ u32x4 w; w.x = cvt_pk_bf16(v0[0], v0[1]); w.y = cvt_pk_bf16(v0[2], v0[3]); w.z = cvt_pk_bf16(v1[0], v1[1]); w.w = cvt_pk_bf16(v1[2], v1[3]);
            *(u32x4*)(O + (size_t)(u.pm * 256 + tr) * ldc + u.pn * 256 + tc) = w; })
    }
};
struct EpiQ {
    static constexpr bool PERM = false;
    bf16_t* Q; const f32x2* ROPE;
    __device__ __forceinline__ void operator()(AccRef acc, const Unit& u, int wr, int wc, int fr, int fq) const {
#pragma unroll
        for (int ai = 0; ai < 2; ++ai)
#pragma unroll
            for (int m = 0; m < 4; ++m) { const int row = u.pm * 256 + ai * 128 + wr * 64 + m * 16 + fr; const bool lat = row < NLAT; const int t = row & (SEQ - 1);
#pragma unroll
                for (int bj = 0; bj < 2; ++bj) { const int cg = u.pn * 256 + bj * 128 + wc * 32; const int dd = cg % 192; f32x4 a = acc[ai][bj][m][0], b = acc[ai][bj][m][1];
                    if (dd >= 128 && lat) { const int pos = (dd - 128) >= 32 ? (t & 63) : (t >> 6); const f32x4* rp = (const f32x4*)(ROPE + pos * 16 + 4 * fq); const f32x4 r0 = rp[0], r1 = rp[1];
                        const float cs[4] = {r0[0], r0[2], r1[0], r1[2]}, sn[4] = {r0[1], r0[3], r1[1], r1[3]};
#pragma unroll
                        for (int i = 0; i < 4; ++i) { const float x1 = a[i], x2 = b[i]; a[i] = x1 * cs[i] - x2 * sn[i]; b[i] = x2 * cs[i] + x1 * sn[i]; } }
                    a *= QSCALE; b *= QSCALE;
                    bf16_t* o = Q + (size_t)row * 768 + cg + 4 * fq;
                    u32x2 w0; w0.x = cvt_pk_bf16(a[0], a[1]); w0.y = cvt_pk_bf16(a[2], a[3]); *(u32x2*)o = w0;
                    u32x2 w1; w1.x = cvt_pk_bf16(b[0], b[1]); w1.y = cvt_pk_bf16(b[2], b[3]); *(u32x2*)(o + 16) = w1; } }
    }
};
struct EpiK {
    static constexpr bool PERM = true;
    bf16_t* KC;
    __device__ __forceinline__ void operator()(AccRef acc, const Unit& u, int wr, int wc, int fr, int fq) const {
        PG8_FOR_PERM({ const int row = u.pm * 256 + tr; int b, key; if (row < NLAT) { b = row >> 11; key = CTX + (row & (SEQ - 1)); } else { b = (row - NLAT) >> 8; key = (row - NLAT) & (CTX - 1); }
            const int col = u.pn * 256 + tc, h = col >> 7, d = col & 127;
            u32x4 w; w.x = cvt_pk_bf16(v0[0], v0[1]); w.y = cvt_pk_bf16(v0[2], v0[3]); w.z = cvt_pk_bf16(v1[0], v1[1]); w.w = cvt_pk_bf16(v1[2], v1[3]);
            *(u32x4*)(KC + ((size_t)(b * 4 + h) * NKEY + key) * 192 + d) = w; })
    }
};
struct EpiV {
    static constexpr bool PERM = true;
    bf16_t* VT;
    __device__ __forceinline__ void operator()(AccRef acc, const Unit& u, int wr, int wc, int fr, int fq) const {
        PG8_FOR_PERM({ const int hd = u.pm * 256 + tr, h = hd >> 7, d = hd & 127; const int tok = u.pn * 256 + tc; int b, key;
            if (tok < NLAT) { b = tok >> 11; key = CTX + (tok & (SEQ - 1)); } else { b = (tok - NLAT) >> 8; key = (tok - NLAT) & (CTX - 1); }
            u32x4 w; w.x = cvt_pk_bf16(v0[0], v0[1]); w.y = cvt_pk_bf16(v0[2], v0[3]); w.z = cvt_pk_bf16(v1[0], v1[1]); w.w = cvt_pk_bf16(v1[2], v1[3]);
            *(u32x4*)(VT + ((size_t)(b * 4 + h) * 128 + d) * NKEY + key) = w; })
    }
};
struct EpiS1 {
    static constexpr bool PERM = false;
    float* EST;
    __device__ __forceinline__ void operator()(AccRef acc, const Unit& u, int wr, int wc, int fr, int fq) const {
        PG8_FOR_NOPERM({ const int row = u.pm * 256 + tr; if (row < NCHUNK) *(f32x4*)(EST + ((size_t)u.pb * 768 + row) * 256 + tc) = v; })
    }
};
struct EpiS2 {
    static constexpr bool PERM = true;
    bf16_t* GB;
    __device__ __forceinline__ void operator()(AccRef acc, const Unit& u, int wr, int wc, int fr, int fq) const {
        PG8_FOR_PERM({ const int row = u.pm * 256 + tr; if (row < NCHUNK) { const int p = tc >> 4, c = tc & 15;
            u32x4 w; w.x = cvt_pk_bf16(gelu_tanh(v0[0]), gelu_tanh(v0[1])); w.y = cvt_pk_bf16(gelu_tanh(v0[2]), gelu_tanh(v0[3]));
            w.z = cvt_pk_bf16(gelu_tanh(v1[0]), gelu_tanh(v1[1])); w.w = cvt_pk_bf16(gelu_tanh(v1[2]), gelu_tanh(v1[3]));
            *(u32x4*)(GB + (size_t)(row * 16 + p) * 512 + u.pb * 16 + c) = w; } })
    }
};
struct EpiGlu {
    static constexpr bool PERM = true;
    const bf16_t* GB; const float* bias; bf16_t* CAT;
    __device__ __forceinline__ void operator()(AccRef acc, const Unit& u, int wr, int wc, int fr, int fq) const {
        PG8_FOR_PERM({ const int row = u.pm * 256 + tr, col = u.pn * 256 + tc;
            const u32x4 gv = *(const u32x4*)(GB + (size_t)row * 512 + col); const f32x4 b0 = *(const f32x4*)(bias + col), b1 = *(const f32x4*)(bias + col + 4);
            u32x4 w;
            w.x = cvt_pk_bf16(bflo(gv.x) * sigmoid_f(v0[0] + b0[0]), bfhi(gv.x) * sigmoid_f(v0[1] + b0[1]));
            w.y = cvt_pk_bf16(bflo(gv.y) * sigmoid_f(v0[2] + b0[2]), bfhi(gv.y) * sigmoid_f(v0[3] + b0[3]));
            w.z = cvt_pk_bf16(bflo(gv.z) * sigmoid_f(v1[0] + b1[0]), bfhi(gv.z) * sigmoid_f(v1[1] + b1[1]));
            w.w = cvt_pk_bf16(bflo(gv.w) * sigmoid_f(v1[2] + b1[2]), bfhi(gv.w) * sigmoid_f(v1[3] + b1[3]));
            *(u32x4*)(CAT + (size_t)row * DM + 1024 + col) = w; })
    }
};
struct EpiOut {
    static constexpr bool PERM = false;
    const float* xl; const float* xc; const float* gate; float* xo;
    __device__ __forceinline__ void operator()(AccRef acc, const Unit& u, int wr, int wc, int fr, int fq) const {
        PG8_FOR_NOPERM({ const int row = u.pm * 256 + tr, col = u.pn * 256 + tc; const int rr = row < NLAT ? (row >> 11) : 4;
            const float* src = row < NLAT ? xl + (size_t)row * DM : xc + (size_t)(row - NLAT) * DM;
            const f32x4 xv = *(const f32x4*)(src + col), gv = *(const f32x4*)(gate + (size_t)rr * 12288 + col);
            *(f32x4*)(xo + (size_t)row * DM + col) = xv + gv * v; })
    }
};
struct EpiGU {
    static constexpr bool PERM = true;
    bf16_t* HID;
    __device__ __forceinline__ void operator()(AccRef acc, const Unit& u, int wr, int wc, int fr, int fq) const {
        PG8_FOR_PERM({ const int row = u.pm * 256 + tr, j = (u.pn * 256 + tc) >> 1;
            u32x2 w; w.x = cvt_pk_bf16(silu_f(v0[0]) * v0[1], silu_f(v0[2]) * v0[3]); w.y = cvt_pk_bf16(silu_f(v1[0]) * v1[1], silu_f(v1[2]) * v1[3]);
            *(u32x2*)(HID + ((size_t)u.pb * EROWS + row) * FF + j) = w; })
    }
};
struct EpiDown {
    static constexpr bool PERM = true;
    bf16_t* YS; const float* RA;
    __device__ __forceinline__ void operator()(AccRef acc, const Unit& u, int wr, int wc, int fr, int fq) const {
        PG8_FOR_PERM({ const int row = u.pm * 256 + tr, col = u.pn * 256 + tc; const float a = RA[u.pb * EROWS + row];
            u32x4 w; w.x = cvt_pk_bf16(v0[0] * a, v0[1] * a); w.y = cvt_pk_bf16(v0[2] * a, v0[3] * a); w.z = cvt_pk_bf16(v1[0] * a, v1[1] * a); w.w = cvt_pk_bf16(v1[2] * a, v1[3] * a);
            *(u32x4*)(YS + ((size_t)u.pb * EROWS + row) * DM + col) = w; })
    }
};
}

struct Params { const float* in[33]; float* out; unsigned char* ws; int ph_lo, ph_hi; };
enum { I_X = 0, I_C, I_CTX, I_CCTX, I_N1G, I_N2G, I_WADA, I_BADA, I_WIN, I_WOUT, I_SGUNG, I_SGUW, I_SGUB, I_QNG, I_WUQ, I_KVNG, I_WUKV,
       I_ARE, I_AIM, I_LOGDT, I_BRE, I_BIM, I_CRE, I_CIM, I_S5D, I_WGLU, I_BGLU, I_CONVW, I_WROUTER, I_WGATE, I_WUP, I_WDOWN, I_FNG };

__device__ __forceinline__ void transpose_tile(const float* src, int N, int k0, int n0, bf16_t* dst, int ldd, int rmul, int radd, int remap_kv, LAS float* tile) {
    const int tid = threadIdx.x;
#pragma unroll
    for (int i = 0; i < 2; ++i) { const int r = (tid >> 4) + 32 * i, c4 = (tid & 15) * 4;
        const f32x4 v = *(const f32x4*)(src + (size_t)(k0 + r) * N + n0 + c4);
        tile[r * 65 + c4 + 0] = v[0]; tile[r * 65 + c4 + 1] = v[1]; tile[r * 65 + c4 + 2] = v[2]; tile[r * 65 + c4 + 3] = v[3]; }
    __syncthreads();
    { const int n = tid >> 3, kc = tid & 7; float f[8];
#pragma unroll
        for (int j = 0; j < 8; ++j) f[j] = tile[(kc * 8 + j) * 65 + n];
        int nn = n0 + n; if (remap_kv) nn = ((nn & 255) < 128) ? ((nn >> 8) * 128 + (nn & 127)) : (512 + (nn >> 8) * 128 + (nn & 127));
        const int drow = nn * rmul + radd;
        u32x4 w; w.x = cvt_pk_bf16(f[0], f[1]); w.y = cvt_pk_bf16(f[2], f[3]); w.z = cvt_pk_bf16(f[4], f[5]); w.w = cvt_pk_bf16(f[6], f[7]);
        *(u32x4*)(dst + (size_t)drow * ldd + k0 + kc * 8) = w; }
    __syncthreads();
}
constexpr int N_ADA_UNITS = 96, N_S5T_UNITS = 16, N_ROPE_UNITS = 2;
constexpr int T_WIN = 32 * 59, T_WOUT = 32 * 32, T_WUQ = 6 * 12, T_WUKV = 4 * 16, T_WGLU = 8 * 8, T_EXP = 512;
constexpr int N_TR = 2 * (T_WIN + T_WOUT + T_WUQ + T_WUKV + T_WGLU) + 3 * 32 * T_EXP;
constexpr int N_PRO_ITEMS = N_ADA_UNITS + N_S5T_UNITS + N_ROPE_UNITS + N_TR;

__device__ __forceinline__ void ph_prologue(const Params& p, LAS unsigned char* lds) {
    const int tid = opaque_tid(), lane = tid & 63, wave = tid >> 6;
    unsigned char* ws = opaque_ptr(p.ws);
    for (int it = blockIdx.x; it < N_PRO_ITEMS; it += gridDim.x) {
        if (it < N_ADA_UNITS) {
            const int l = it / 48, cb = it % 48;
            LAS float* sil = (LAS float*)lds;
            LAS float* red = (LAS float*)(lds + 40960);
            for (int i = tid; i < 5 * DM; i += 512) { const int r = i >> 11, k = i & (DM - 1); const float v = r < 4 ? p.in[I_C][r * DM + k] : p.in[I_CCTX][k]; sil[i] = silu_f(v); }
            __syncthreads();
            f32x4 acc[5];
#pragma unroll
            for (int r = 0; r < 5; ++r) acc[r] = (f32x4){0.f, 0.f, 0.f, 0.f};
            const float* W = p.in[I_WADA] + (size_t)l * DM * 12288 + cb * 256 + lane * 4;
            for (int k = wave * 256; k < wave * 256 + 256; k += 8) {
                f32x4 w[8];
#pragma unroll
                for (int j = 0; j < 8; ++j) w[j] = *(const f32x4*)(W + (size_t)(k + j) * 12288);
#pragma unroll
                for (int j = 0; j < 8; ++j)
#pragma unroll
                    for (int r = 0; r < 5; ++r) acc[r] += sil[r * DM + k + j] * w[j];
            }
#pragma unroll
            for (int r = 0; r < 5; ++r)
#pragma unroll
                for (int j = 0; j < 4; ++j) red[(wave * 5 + r) * 256 + lane * 4 + j] = acc[r][j];
            __syncthreads();
            float* mod = (float*)(ws + WS_MOD);
            for (int o = tid; o < 5 * 256; o += 512) { const int r = o >> 8, cc = o & 255; float s = 0.f;
#pragma unroll
                for (int w8 = 0; w8 < 8; ++w8) s += red[(w8 * 5 + r) * 256 + cc];
                mod[(size_t)(l * 5 + r) * 12288 + cb * 256 + cc] = s + p.in[I_BADA][l * 12288 + cb * 256 + cc]; }
            __syncthreads();
        } else if (it < N_ADA_UNITS + N_S5T_UNITS) {
            const int idx = (it - N_ADA_UNITS) * 512 + tid;
            const float are = fminf(p.in[I_ARE][idx], -1e-4f), aim = p.in[I_AIM][idx];
            const float dt = expf(p.in[I_LOGDT][idx >> 6]);
            f32x2* PW = (f32x2*)(ws + WS_PW) + (size_t)idx * 17; f32x2* BB = (f32x2*)(ws + WS_BB) + (size_t)idx * 16;
            float abr = 0.f, abi = 0.f;
            for (int d = 0; d <= 16; ++d) { const double mag = exp((double)are * (double)dt * d); double sn, cs; sincos((double)aim * (double)dt * d, &sn, &cs);
                const f32x2 v = {(float)(mag * cs), (float)(mag * sn)}; PW[d] = v; if (d == 1) { abr = v.x; abi = v.y; } }
            const float xr = abr - 1.0f, xi = abi, den = 1.0f / (are * are + aim * aim);
            const float cr = (xr * are + xi * aim) * den, ci = (xi * are - xr * aim) * den;
            for (int c = 0; c < 16; ++c) { const float br = p.in[I_BRE][(size_t)idx * 16 + c], bi = p.in[I_BIM][(size_t)idx * 16 + c]; BB[c] = (f32x2){cr * br - ci * bi, cr * bi + ci * br}; }
        } else if (it < N_ADA_UNITS + N_S5T_UNITS + N_ROPE_UNITS) {
            const int idx = (it - N_ADA_UNITS - N_S5T_UNITS) * 512 + tid; const int pos = idx >> 4, f = idx & 15;
            const float invf = powf(10000.0f, -(float)f * 0.0625f); const float ang = (float)pos * invf;
            ((f32x2*)(ws + WS_ROPE))[idx] = (f32x2){cosf(ang), sinf(ang)};
        } else {
            int t = it - N_ADA_UNITS - N_S5T_UNITS - N_ROPE_UNITS;
            LAS float* tile = (LAS float*)lds;
            if (t < 2 * T_WIN) { const int l = t / T_WIN, r = t % T_WIN; transpose_tile(p.in[I_WIN] + (size_t)l * DM * INC, INC, (r % 32) * 64, (r / 32) * 64, (bf16_t*)(ws + WS_WTIN) + (size_t)l * INP * DM, DM, 1, 0, 0, tile); continue; }
            t -= 2 * T_WIN;
            if (t < 2 * T_WOUT) { const int l = t / T_WOUT, r = t % T_WOUT; transpose_tile(p.in[I_WOUT] + (size_t)l * DM * DM, DM, (r % 32) * 64, (r / 32) * 64, (bf16_t*)(ws + WS_WTOUT) + (size_t)l * DM * DM, DM, 1, 0, 0, tile); continue; }
            t -= 2 * T_WOUT;
            if (t < 2 * T_WUQ) { const int l = t / T_WUQ, r = t % T_WUQ; transpose_tile(p.in[I_WUQ] + (size_t)l * 384 * 768, 768, (r % 6) * 64, (r / 6) * 64, (bf16_t*)(ws + WS_WTUQ) + (size_t)l * 768 * 384, 384, 1, 0, 0, tile); continue; }
            t -= 2 * T_WUQ;
            if (t < 2 * T_WUKV) { const int l = t / T_WUKV, r = t % T_WUKV; transpose_tile(p.in[I_WUKV] + (size_t)l * 256 * 1024, 1024, (r % 4) * 64, (r / 4) * 64, (bf16_t*)(ws + WS_WTUKV) + (size_t)l * 1024 * 256, 256, 1, 0, 1, tile); continue; }
            t -= 2 * T_WUKV;
            if (t < 2 * T_WGLU) { const int l = t / T_WGLU, r = t % T_WGLU; transpose_tile(p.in[I_WGLU] + (size_t)l * 512 * 512, 512, (r % 8) * 64, (r / 8) * 64, (bf16_t*)(ws + WS_WTGLU) + (size_t)l * 512 * 512, 512, 1, 0, 0, tile); continue; }
            t -= 2 * T_WGLU;
            if (t < 32 * T_EXP) { const int le = t / T_EXP, r = t % T_EXP; transpose_tile(p.in[I_WGATE] + (size_t)le * DM * FF, FF, (r % 32) * 64, (r / 32) * 64, (bf16_t*)(ws + WS_WTGU) + (size_t)le * 2048 * DM, DM, 2, 0, 0, tile); continue; }
            t -= 32 * T_EXP;
            if (t < 32 * T_EXP) { const int le = t / T_EXP, r = t % T_EXP; transpose_tile(p.in[I_WUP] + (size_t)le * DM * FF, FF, (r % 32) * 64, (r / 32) * 64, (bf16_t*)(ws + WS_WTGU) + (size_t)le * 2048 * DM, DM, 2, 1, 0, tile); continue; }
            t -= 32 * T_EXP;
            { const int le = t / T_EXP, r = t % T_EXP; transpose_tile(p.in[I_WDOWN] + (size_t)le * FF * DM, DM, (r % 16) * 64, (r / 16) * 64, (bf16_t*)(ws + WS_WTDN) + (size_t)le * DM * FF, FF, 1, 0, 0, tile); }
        }
    }
}

__device__ __forceinline__ void rms_mod_store(const f32x4 (&x)[8], const float* g, const float* scale, const float* shift, bf16_t* orow, f32x4 (&y)[8], int lane) {
    float ss = 0.f;
#pragma unroll
    for (int j = 0; j < 8; ++j) ss += x[j][0] * x[j][0] + x[j][1] * x[j][1] + x[j][2] * x[j][2] + x[j][3] * x[j][3];
    ss = wave_sum(ss);
    const float rinv = rsqrtf(ss * (1.0f / DM) + EPS);
#pragma unroll
    for (int j = 0; j < 8; ++j) { const int c = j * 256 + lane * 4;
        const f32x4 gv = *(const f32x4*)(g + c), sc = *(const f32x4*)(scale + c), sh = *(const f32x4*)(shift + c);
        y[j] = x[j] * rinv * gv * (1.0f + sc) + sh;
        u32x2 w; w.x = cvt_pk_bf16(y[j][0], y[j][1]); w.y = cvt_pk_bf16(y[j][2], y[j][3]); *(u32x2*)(orow + c) = w; }
}

constexpr int N1_ROWITEMS = MT / 8, N1_KZ = 1024, N1_WST = 1024, N1_INTER = 1024;
__device__ __forceinline__ void ph_norm1_tables(const Params& p) {
    const int tid = opaque_tid(), lane = tid & 63, wave = tid >> 6;
    unsigned char* ws = opaque_ptr(p.ws);
    const float* mod = (const float*)(ws + WS_MOD);
    for (int it = blockIdx.x; it < N1_ROWITEMS + N1_KZ + N1_WST + N1_INTER; it += gridDim.x) {
        if (it < N1_ROWITEMS) {
            const int row = it * 8 + wave; const int rr = row < NLAT ? (row >> 11) : 4;
            const float* xr = row < NLAT ? p.in[I_X] + (size_t)row * DM : p.in[I_CTX] + (size_t)(row - NLAT) * DM;
            f32x4 x[8], y[8];
#pragma unroll
            for (int j = 0; j < 8; ++j) x[j] = *(const f32x4*)(xr + j * 256 + lane * 4);
            const float* m = mod + (size_t)rr * 12288;
            rms_mod_store(x, p.in[I_N1G], m + DM, m, (bf16_t*)(ws + WS_H) + (size_t)row * DM, y, lane);
        } else if (it < N1_ROWITEMS + N1_KZ) {
            const int idx = (it - N1_ROWITEMS) * 512 + tid; const int cp = idx & 15, c = (idx >> 4) & 15, d = (idx >> 8) & 15, lzg = idx >> 12;
            const f32x2* PW = (const f32x2*)(ws + WS_PW) + (size_t)lzg * 64 * 17; const f32x2* BB = (const f32x2*)(ws + WS_BB) + (size_t)lzg * 64 * 16;
            const float* cre = p.in[I_CRE] + ((size_t)lzg * 16 + c) * 64; const float* cim = p.in[I_CIM] + ((size_t)lzg * 16 + c) * 64;
            float s = 0.f;
            for (int n = 0; n < 64; ++n) { const f32x2 pw = PW[n * 17 + d], bb = BB[n * 16 + cp]; const float cr = cre[n], ci = cim[n];
                const float tr = pw.x * bb.x - pw.y * bb.y, ti = pw.x * bb.y + pw.y * bb.x; s += cr * tr - ci * ti; }
            ((float*)(ws + WS_KZ))[idx] = s;
        } else if (it < N1_ROWITEMS + N1_KZ + N1_WST) {
            const int idx = (it - N1_ROWITEMS - N1_KZ) * 512 + tid; const int c8 = (idx & 1) * 8, pp = (idx >> 1) & 15, row = (idx >> 5) & 255, lg = idx >> 13;
            const int l = lg >> 5, g = lg & 31, z = row >> 7, ri = (row >> 6) & 1, n = row & 63;
            const size_t lzgn = (((size_t)l * 2 + z) * 32 + g) * 64 + n;
            const f32x2 pw = ((const f32x2*)(ws + WS_PW))[lzgn * 17 + (z == 0 ? 15 - pp : pp)]; const f32x2* BB = (const f32x2*)(ws + WS_BB) + lzgn * 16 + c8;
            float f[8];
#pragma unroll
            for (int j = 0; j < 8; ++j) { const f32x2 bb = BB[j]; f[j] = ri == 0 ? (pw.x * bb.x - pw.y * bb.y) : (pw.x * bb.y + pw.y * bb.x); }
            u32x4 w; w.x = cvt_pk_bf16(f[0], f[1]); w.y = cvt_pk_bf16(f[2], f[3]); w.z = cvt_pk_bf16(f[4], f[5]); w.w = cvt_pk_bf16(f[6], f[7]);
            *(u32x4*)((bf16_t*)(ws + WS_WST) + ((size_t)lg * 256 + row) * 256 + pp * 16 + c8) = w;
        } else {
            const int idx = (it - N1_ROWITEMS - N1_KZ - N1_WST) * 512 + tid; const int n8 = (idx & 7) * 8, ri = (idx >> 3) & 1, z = (idx >> 4) & 1, row = (idx >> 5) & 255, lg = idx >> 13;
            const int l = lg >> 5, g = lg & 31, pp = row >> 4, c = row & 15;
            const size_t lzg = ((size_t)l * 2 + z) * 32 + g;
            const f32x2* PW = (const f32x2*)(ws + WS_PW) + (lzg * 64 + n8) * 17 + (z == 0 ? pp + 1 : 16 - pp);
            const float* cre = p.in[I_CRE] + (lzg * 16 + c) * 64 + n8; const float* cim = p.in[I_CIM] + (lzg * 16 + c) * 64 + n8;
            float f[8];
#pragma unroll
            for (int j = 0; j < 8; ++j) { const f32x2 pw = PW[j * 17]; const float cr = cre[j], ci = cim[j]; f[j] = ri == 0 ? (cr * pw.x - ci * pw.y) : -(cr * pw.y + ci * pw.x); }
            u32x4 w; w.x = cvt_pk_bf16(f[0], f[1]); w.y = cvt_pk_bf16(f[2], f[3]); w.z = cvt_pk_bf16(f[4], f[5]); w.w = cvt_pk_bf16(f[6], f[7]);
            *(u32x4*)((bf16_t*)(ws + WS_G2B) + ((size_t)lg * 256 + row) * 512 + 256 + z * 128 + ri * 64 + n8) = w;
        }
    }
}

constexpr int B_ROWITEMS = MT / 8, B_SGU = 72 * 4, B_INTRA = 512;
__device__ __forceinline__ void ph_rowsplit(const Params& p, int l, LAS unsigned char* lds) {
    const int tid = opaque_tid(), lane = tid & 63, wave = tid >> 6;
    unsigned char* ws = opaque_ptr(p.ws);
    const bf16_t* P = (const bf16_t*)(ws + WS_PA);
    bf16_t* CAT = (bf16_t*)(ws + WS_CAT);
    for (int it = blockIdx.x; it < B_ROWITEMS + B_SGU + B_INTRA; it += gridDim.x) {
        if (it < B_ROWITEMS) {
            const int row = it * 8 + wave; const bf16_t* pr = P + (size_t)row * INP;
            const bool lat = row < NLAT; const int t = lat ? (row & (SEQ - 1)) : ((row - NLAT) & (CTX - 1)); const int b = lat ? (row >> 11) : ((row - NLAT) >> 8);
            const int seqlen = lat ? SEQ : CTX;
            { float f[8]; float ss = 0.f;
              if (lane < 48) { const u32x4 v = *(const u32x4*)(pr + C_CQ + lane * 8); f[0] = bflo(v.x); f[1] = bfhi(v.x); f[2] = bflo(v.y); f[3] = bfhi(v.y); f[4] = bflo(v.z); f[5] = bfhi(v.z); f[6] = bflo(v.w); f[7] = bfhi(v.w);
#pragma unroll
                  for (int j = 0; j < 8; ++j) ss += f[j] * f[j]; }
              else {
#pragma unroll
                  for (int j = 0; j < 8; ++j) f[j] = 0.f; }
              ss = wave_sum(ss); const float rinv = rsqrtf(ss * (1.0f / 384.0f) + EPS);
              if (lane < 48) { const float* g = p.in[I_QNG] + l * 384 + lane * 8; u32x4 w;
                  w.x = cvt_pk_bf16(f[0] * rinv * g[0], f[1] * rinv * g[1]); w.y = cvt_pk_bf16(f[2] * rinv * g[2], f[3] * rinv * g[3]);
                  w.z = cvt_pk_bf16(f[4] * rinv * g[4], f[5] * rinv * g[5]); w.w = cvt_pk_bf16(f[6] * rinv * g[6], f[7] * rinv * g[7]);
                  *(u32x4*)((bf16_t*)(ws + WS_QA) + (size_t)row * 384 + lane * 8) = w; } }
            { const u32x2 v = *(const u32x2*)(pr + C_CKV + lane * 4); const float f0 = bflo(v.x), f1 = bfhi(v.x), f2 = bflo(v.y), f3 = bfhi(v.y);
              const float ss = wave_sum(f0 * f0 + f1 * f1 + f2 * f2 + f3 * f3); const float rinv = rsqrtf(ss * (1.0f / 256.0f) + EPS);
              const float* g = p.in[I_KVNG] + l * 256 + lane * 4; u32x2 w; w.x = cvt_pk_bf16(f0 * rinv * g[0], f1 * rinv * g[1]); w.y = cvt_pk_bf16(f2 * rinv * g[2], f3 * rinv * g[3]);
              *(u32x2*)((bf16_t*)(ws + WS_KVA) + (size_t)row * 256 + lane * 4) = w; }
            { float v = bf2f(pr[C_KR + lane]); const float partner = __shfl_xor(v, 16);
              if (lat) { const int jj = lane & 31, fi = jj & 15; const int pos = lane >= 32 ? (t & 63) : (t >> 6);
                  const f32x2 r = ((const f32x2*)(ws + WS_ROPE))[pos * 16 + fi]; const float cs = r.x, sn = r.y;
                  v = jj < 16 ? (v * cs - partner * sn) : (v * cs + partner * sn); }
              const int key = lat ? CTX + t : t; const unsigned short o = f2bf(v);
              bf16_t* kc = (bf16_t*)(ws + WS_KC);
#pragma unroll
              for (int h = 0; h < 4; ++h) kc[((size_t)(b * 4 + h) * NKEY + key) * 192 + 128 + lane] = o; }
            { const u32x4 v = *(const u32x4*)(pr + C_S5 + lane * 8); const int g = lane >> 1, half = lane & 1;
              *(u32x4*)((bf16_t*)(ws + WS_UPK) + ((size_t)g * 768 + (row >> 4)) * 512 + (row & 15) * 16 + half * 8) = v; }
            { const int c0 = lane * 8; float zp[8], zc[8], zn[8];
#pragma unroll
              for (int j = 0; j < 8; ++j) { zp[j] = 0.f; zn[j] = 0.f; }
#define CONV_Z(dst, rp) do { const u32x4 a_ = *(const u32x4*)((rp) + C_CVC + c0); const u32x4 h_ = *(const u32x4*)((rp) + C_CVH + c0); \
                  dst[0] = bflo(a_.x) * bflo(h_.x); dst[1] = bfhi(a_.x) * bfhi(h_.x); dst[2] = bflo(a_.y) * bflo(h_.y); dst[3] = bfhi(a_.y) * bfhi(h_.y); \
                  dst[4] = bflo(a_.z) * bflo(h_.z); dst[5] = bfhi(a_.z) * bfhi(h_.z); dst[6] = bflo(a_.w) * bflo(h_.w); dst[7] = bfhi(a_.w) * bfhi(h_.w); } while (0)
              CONV_Z(zc, pr);
              if (t > 0) CONV_Z(zp, pr - INP);
              if (t < seqlen - 1) CONV_Z(zn, pr + INP);
#undef CONV_Z
              const u32x4 bg = *(const u32x4*)(pr + C_CVB + c0); float bgf[8] = {bflo(bg.x), bfhi(bg.x), bflo(bg.y), bfhi(bg.y), bflo(bg.z), bfhi(bg.z), bflo(bg.w), bfhi(bg.w)};
              const float* cw = p.in[I_CONVW] + (size_t)l * 3 * 512 + c0; float o[8];
#pragma unroll
              for (int j = 0; j < 8; ++j) o[j] = bgf[j] * (cw[j] * zp[j] + cw[512 + j] * zc[j] + cw[1024 + j] * zn[j]);
              u32x4 w; w.x = cvt_pk_bf16(o[0], o[1]); w.y = cvt_pk_bf16(o[2], o[3]); w.z = cvt_pk_bf16(o[4], o[5]); w.w = cvt_pk_bf16(o[6], o[7]);
              *(u32x4*)(CAT + (size_t)row * DM + 1536 + c0) = w; }
        } else if (it < B_ROWITEMS + B_SGU) {
            const int un = it - B_ROWITEMS, cc = un >> 2, h = un & 3; const int row0 = cc * 128;
            LAS bf16_t* Wl = (LAS bf16_t*)lds;
            LAS bf16_t* Vl = (LAS bf16_t*)(lds + 128 * 136 * 2);
            const float* Wg = p.in[I_SGUW] + ((size_t)l * 4 + h) * 128 * 128;
#pragma unroll
            for (int i = 0; i < 8; ++i) { const int e4 = (i * 512 + tid) * 4, r = e4 >> 7, c = e4 & 127; const f32x4 v = *(const f32x4*)(Wg + e4);
                u32x2 w; w.x = cvt_pk_bf16(v[0], v[1]); w.y = cvt_pk_bf16(v[2], v[3]); *(LAS u32x2*)(Wl + r * 136 + c) = w; }
            for (int qi = 0; qi < 16; ++qi) { const int q = wave * 16 + qi; const bf16_t* pr = P + (size_t)(row0 + q) * INP + C_SGU_V;
                const u32x4 v = *(const u32x4*)(pr + lane * 8); float f[8] = {bflo(v.x), bfhi(v.x), bflo(v.y), bfhi(v.y), bflo(v.z), bfhi(v.z), bflo(v.w), bfhi(v.w)}; float ss = 0.f;
#pragma unroll
                for (int j = 0; j < 8; ++j) { f[j] = gelu_tanh(f[j]); ss += f[j] * f[j]; }
                ss = wave_sum(ss); const float rinv = rsqrtf(ss * (1.0f / 512.0f) + EPS);
                if ((lane >> 4) == h) { const int c0 = (lane & 15) * 8; const float* g = p.in[I_SGUNG] + l * 512 + h * 128 + c0;
#pragma unroll
                    for (int j = 0; j < 8; ++j) Vl[(c0 + j) * 136 + q] = f2bf(f[j] * rinv * g[j]); } }
            __syncthreads();
            { const int fr = lane & 15, fq = lane >> 4; f32x4 acc[8];
#pragma unroll
              for (int nb = 0; nb < 8; ++nb) acc[nb] = (f32x4){0.f, 0.f, 0.f, 0.f};
#pragma unroll
              for (int ks = 0; ks < 4; ++ks) { const bf16x8 af = *(const LAS bf16x8*)(Wl + (wave * 16 + fr) * 136 + ks * 32 + fq * 8);
#pragma unroll
                  for (int nb = 0; nb < 8; ++nb) { const bf16x8 bfr = *(const LAS bf16x8*)(Vl + (nb * 16 + fr) * 136 + ks * 32 + fq * 8);
                      acc[nb] = __builtin_amdgcn_mfma_f32_16x16x32_bf16(bfr, af, acc[nb], 0, 0, 0); } }
              const int pp = wave * 16 + fr; const float bias = p.in[I_SGUB][((size_t)l * 4 + h) * 128 + pp]; const bf16_t* pr = P + (size_t)(row0 + pp) * INP + C_SGU_U + h * 128;
#pragma unroll
              for (int nb = 0; nb < 8; ++nb) { const int c = nb * 16 + 4 * fq; const u32x2 uv = *(const u32x2*)(pr + c);
                  u32x2 w; w.x = cvt_pk_bf16(gelu_tanh(bflo(uv.x)) * (acc[nb][0] + bias), gelu_tanh(bfhi(uv.x)) * (acc[nb][1] + bias));
                  w.y = cvt_pk_bf16(gelu_tanh(bflo(uv.y)) * (acc[nb][2] + bias), gelu_tanh(bfhi(uv.y)) * (acc[nb][3] + bias));
                  *(u32x2*)(CAT + (size_t)(row0 + pp) * DM + h * 128 + c) = w; } }
            __syncthreads();
        } else {
            const int idx = (it - B_ROWITEMS - B_SGU) * 512 + tid; const int c8 = (idx & 1) * 8, pq = (idx >> 1) & 15, row = (idx >> 5) & 255, g = idx >> 13;
            const int pp = row >> 4, c = row & 15;
            const float* KZf = (const float*)(ws + WS_KZ) + (((size_t)l * 2 + 0) * 32 + g) * 4096; const float* KZb = (const float*)(ws + WS_KZ) + (((size_t)l * 2 + 1) * 32 + g) * 4096;
            float f[8];
#pragma unroll
            for (int j = 0; j < 8; ++j) { float v = 0.f; if (pq <= pp) v += KZf[((pp - pq) * 16 + c) * 16 + c8 + j]; if (pq >= pp) v += KZb[((pq - pp) * 16 + c) * 16 + c8 + j];
                if (pq == pp && c8 + j == c) v += p.in[I_S5D][l * 512 + g * 16 + c]; f[j] = v; }
            u32x4 w; w.x = cvt_pk_bf16(f[0], f[1]); w.y = cvt_pk_bf16(f[2], f[3]); w.z = cvt_pk_bf16(f[4], f[5]); w.w = cvt_pk_bf16(f[6], f[7]);
            *(u32x4*)((bf16_t*)(ws + WS_G2B) + (((size_t)l * 32 + g) * 256 + row) * 512 + pq * 16 + c8) = w;
        }
    }
}

constexpr int KPITCH = 400, VPITCH = 144;
constexpr int KT_BYTES = 64 * KPITCH, VT_BYTES = 128 * VPITCH;
__device__ __forceinline__ void attn_unit(const bf16_t* Qrows  , const bf16_t* Kbh, const bf16_t* Vbh, int nkeys, bf16_t* Orows, LAS unsigned char* lds) {
    const int tid = opaque_tid(), lane = tid & 63, wave = tid >> 6, fr = lane & 15, fq = lane >> 4;
    LAS unsigned char* Kb[2] = {lds, lds + KT_BYTES + VT_BYTES};
    LAS unsigned char* Vb[2] = {lds + KT_BYTES, lds + 2 * KT_BYTES + VT_BYTES};
    bf16x8 qf[6];
    { const bf16_t* qr = Qrows + (size_t)(wave * 16 + fr) * 768 + fq * 8;
#pragma unroll
      for (int ks = 0; ks < 6; ++ks) qf[ks] = *(const bf16x8*)(qr + ks * 32); }
    f32x4 o[8];
#pragma unroll
    for (int db = 0; db < 8; ++db) o[db] = (f32x4){0.f, 0.f, 0.f, 0.f};
    float mrow = -1e30f, lsum = 0.f;
    const int nt = nkeys / 64;
    u32x4 kreg[3], vreg[2];
#define ATT_LOADG(tile) do { const char* kg = (const char*)(Kbh + (size_t)(tile) * 64 * 192); \
        _Pragma("unroll") for (int i = 0; i < 3; ++i) kreg[i] = *(const u32x4*)(kg + (size_t)(i * 512 + tid) * 16); \
        _Pragma("unroll") for (int i = 0; i < 2; ++i) { const int pc = i * 512 + tid; vreg[i] = *(const u32x4*)((const char*)(Vbh + (size_t)(pc >> 3) * NKEY + (tile) * 64) + (pc & 7) * 16); } } while (0)
#define ATT_STOREL(buf) do { \
        _Pragma("unroll") for (int i = 0; i < 3; ++i) { const int pc = i * 512 + tid; *(LAS u32x4*)(Kb[buf] + (pc / 24) * KPITCH + (pc % 24) * 16) = kreg[i]; } \
        _Pragma("unroll") for (int i = 0; i < 2; ++i) { const int pc = i * 512 + tid; *(LAS u32x4*)(Vb[buf] + (pc >> 3) * VPITCH + (pc & 7) * 16) = vreg[i]; } } while (0)
    ATT_LOADG(0); ATT_STOREL(0);
    __syncthreads();
    for (int j = 0; j < nt; ++j) {
        const int cur = j & 1;
        if (j + 1 < nt) ATT_LOADG(j + 1);
        f32x4 s[4];
#pragma unroll
        for (int kb = 0; kb < 4; ++kb) { s[kb] = (f32x4){0.f, 0.f, 0.f, 0.f};
#pragma unroll
            for (int ks = 0; ks < 6; ++ks) { const bf16x8 kf = *(const LAS bf16x8*)(Kb[cur] + (kb * 16 + fr) * KPITCH + ks * 64 + fq * 16);
                s[kb] = __builtin_amdgcn_mfma_f32_16x16x32_bf16(kf, qf[ks], s[kb], 0, 0, 0); } }
        float mx = s[0][0];
#pragma unroll
        for (int kb = 0; kb < 4; ++kb)
#pragma unroll
            for (int r = 0; r < 4; ++r) mx = fmaxf(mx, s[kb][r]);
        mx = fmaxf(mx, __shfl_xor(mx, 16)); mx = fmaxf(mx, __shfl_xor(mx, 32));
        const float mnew = fmaxf(mrow, mx), alpha = exp2f(mrow - mnew); mrow = mnew;
        float ps = 0.f;
#pragma unroll
        for (int kb = 0; kb < 4; ++kb)
#pragma unroll
            for (int r = 0; r < 4; ++r) { s[kb][r] = exp2f(s[kb][r] - mnew); ps += s[kb][r]; }
        lsum = lsum * alpha + ps;
#pragma unroll
        for (int db = 0; db < 8; ++db) o[db] *= alpha;
#pragma unroll
        for (int sidx = 0; sidx < 2; ++sidx) {
            u32x4 pw; pw.x = cvt_pk_bf16(s[2 * sidx][0], s[2 * sidx][1]); pw.y = cvt_pk_bf16(s[2 * sidx][2], s[2 * sidx][3]);
            pw.z = cvt_pk_bf16(s[2 * sidx + 1][0], s[2 * sidx + 1][1]); pw.w = cvt_pk_bf16(s[2 * sidx + 1][2], s[2 * sidx + 1][3]);
            const bf16x8 pf = __builtin_bit_cast(bf16x8, pw);
#pragma unroll
            for (int db = 0; db < 8; ++db) { const LAS unsigned char* vp = Vb[cur] + (db * 16 + fr) * VPITCH + sidx * 64 + fq * 8;
                u32x4 vw; const u32x2 lo = *(const LAS u32x2*)vp, hi = *(const LAS u32x2*)(vp + 32); vw.x = lo.x; vw.y = lo.y; vw.z = hi.x; vw.w = hi.y;
                o[db] = __builtin_amdgcn_mfma_f32_16x16x32_bf16(__builtin_bit_cast(bf16x8, vw), pf, o[db], 0, 0, 0); } }
        if (j + 1 < nt) ATT_STOREL(cur ^ 1);
        __syncthreads();
    }
#undef ATT_LOADG
#undef ATT_STOREL
    lsum += __shfl_xor(lsum, 16); lsum += __shfl_xor(lsum, 32);
    const float inv = 1.0f / lsum;
    bf16_t* orow = Orows + (size_t)(wave * 16 + fr) * DM;
#pragma unroll
    for (int db = 0; db < 8; ++db) { u32x2 w; w.x = cvt_pk_bf16(o[db][0] * inv, o[db][1] * inv); w.y = cvt_pk_bf16(o[db][2] * inv, o[db][3] * inv); *(u32x2*)(orow + db * 16 + 4 * fq) = w; }
}
__device__ __forceinline__ void ph_attn_carry(const Params& p, int l, LAS unsigned char* lds) {
    unsigned char* ws = opaque_ptr(p.ws); const int tid = opaque_tid();
    const int natt = (l == 0) ? 288 : 256;
    const bf16_t* QB = (const bf16_t*)(ws + WS_QB); const bf16_t* KC = (const bf16_t*)(ws + WS_KC); const bf16_t* VT = (const bf16_t*)(ws + WS_VT); bf16_t* CAT = (bf16_t*)(ws + WS_CAT);
    for (int it = blockIdx.x; it < natt + 32; it += gridDim.x) {
        if (it < natt) {
            int b, h, row0, nkeys;
            if (it < 256) { b = it >> 6; h = (it >> 4) & 3; row0 = b * SEQ + (it & 15) * 128; nkeys = NKEY; }
            else { const int u = it - 256; b = u >> 3; h = (u >> 1) & 3; row0 = NLAT + b * CTX + (u & 1) * 128; nkeys = CTX; }
            attn_unit(QB + (size_t)row0 * 768 + h * 192, KC + (size_t)(b * 4 + h) * NKEY * 192, VT + (size_t)(b * 4 + h) * 128 * NKEY, nkeys, CAT + (size_t)row0 * DM + 512 + h * 128, lds);
        } else {
            const int g = it - natt; const int z = tid >> 8, b = (tid >> 6) & 3, n = tid & 63;
            const f32x2 a16 = ((const f32x2*)(ws + WS_PW))[((((size_t)l * 2 + z) * 32 + g) * 64 + n) * 17 + 16];
            const float* EST = (const float*)(ws + WS_EST) + (size_t)g * 768 * 256 + z * 128 + n;
            bf16_t* UP = (bf16_t*)(ws + WS_UPK) + (size_t)g * 768 * 512 + 256 + z * 128 + n;
            float sr = 0.f, si = 0.f;
            for (int st = 0; st < 144; ++st) {
                int chunk;
                if (z == 0) chunk = st < 16 ? (512 + b * 16 + st) : (b * 128 + (st - 16));
                else        chunk = st < 16 ? (512 + b * 16 + (15 - st)) : (b * 128 + (143 - st));
                UP[(size_t)chunk * 512] = f2bf(sr); UP[(size_t)chunk * 512 + 64] = f2bf(si);
                const float er = EST[(size_t)chunk * 256], ei = EST[(size_t)chunk * 256 + 64];
                const float nr = a16.x * sr - a16.y * si + er, ni = a16.x * si + a16.y * sr + ei; sr = nr; si = ni;
            }
        }
    }
}

__device__ __forceinline__ void ph_norm2_router(const Params& p, int l) {
    const int tid = opaque_tid(), lane = tid & 63, wave = tid >> 6;
    unsigned char* ws = opaque_ptr(p.ws); const float* mod = (const float*)(ws + WS_MOD) + (size_t)l * 5 * 12288;
    const int nrows = (l == 0) ? MT : NLAT;
    const float* WR = p.in[I_WROUTER] + (size_t)l * DM * NE;
    for (int it = blockIdx.x; it < nrows / 8; it += gridDim.x) {
        const int row = it * 8 + wave; const int rr = row < NLAT ? (row >> 11) : 4;
        const float* xr = (const float*)(ws + WS_XB) + (size_t)row * DM;
        f32x4 x[8], y[8];
#pragma unroll
        for (int j = 0; j < 8; ++j) x[j] = *(const f32x4*)(xr + j * 256 + lane * 4);
        const float* m = mod + (size_t)rr * 12288;
        rms_mod_store(x, p.in[I_N2G] + l * DM, m + 4 * DM, m + 3 * DM, (bf16_t*)(ws + WS_H) + (size_t)row * DM, y, lane);
        float lg[16];
#pragma unroll
        for (int e = 0; e < 16; ++e) lg[e] = 0.f;
#pragma unroll
        for (int j = 0; j < 8; ++j)
#pragma unroll
            for (int i = 0; i < 4; ++i) { const float* wr = WR + (size_t)(j * 256 + lane * 4 + i) * NE; const float hv = y[j][i];
#pragma unroll
                for (int e4 = 0; e4 < 4; ++e4) { const f32x4 w = *(const f32x4*)(wr + e4 * 4); lg[e4 * 4 + 0] += hv * w[0]; lg[e4 * 4 + 1] += hv * w[1]; lg[e4 * 4 + 2] += hv * w[2]; lg[e4 * 4 + 3] += hv * w[3]; } }
        float mx = -1e30f;
#pragma unroll
        for (int e = 0; e < 16; ++e) { lg[e] = wave_sum(lg[e]); mx = fmaxf(mx, lg[e]); }
        float se = 0.f;
#pragma unroll
        for (int e = 0; e < 16; ++e) { lg[e] = __expf(lg[e] - mx); se += lg[e]; }
        const float inv = 1.0f / se;
        float mine = 0.f;
#pragma unroll
        for (int e = 0; e < 16; ++e) mine = (lane == e) ? lg[e] * inv : mine;
        if (lane < 16) ((float*)(ws + WS_AFF))[(size_t)row * 16 + lane] = mine;
    }
}

__device__ __forceinline__ void ph_topk(const Params& p, int l, LAS unsigned char* lds) {
    const int tid = opaque_tid(), lane = tid & 63, wave = tid >> 6;
    unsigned char* ws = opaque_ptr(p.ws); const float* AFF = (const float*)(ws + WS_AFF);
    int* ROWTOK = (int*)(ws + WS_ROWTOK); float* ROWAFF = (float*)(ws + WS_ROWAFF); int* INV = (int*)(ws + WS_INV);
    LAS int* hist = (LAS int*)lds;
    LAS int* ctl = (LAS int*)(lds + 1024);
    LAS int* wsum = (LAS int*)(lds + 1280);
    const int nunits = (l == 0) ? 128 : 64;
    for (int it = blockIdx.x; it < nunits; it += gridDim.x) {
        const bool lat = it < 64; const int u = lat ? it : it - 64; const int b = u >> 4, e = u & 15;
        const int n = lat ? SEQ : CTX, cap = lat ? CAPL : CAPC;
        const int tok0 = lat ? b * SEQ : NLAT + b * CTX; const int rowbase = lat ? b * CAPL : 1024 + b * CAPC;
        unsigned key[4];
#pragma unroll
        for (int j = 0; j < 4; ++j) { const int t = tid * 4 + j; key[j] = t < n ? __float_as_uint(AFF[(size_t)(tok0 + t) * 16 + e]) : 0u; }
        unsigned prefix = 0u; int remaining = cap;
        for (int pass = 3; pass >= 0; --pass) {
            if (tid < 256) hist[tid] = 0;
            __syncthreads();
#pragma unroll
            for (int j = 0; j < 4; ++j) { const int t = tid * 4 + j; if (t < n) { const bool match = (pass == 3) || ((key[j] >> (8 * (pass + 1))) == (prefix >> (8 * (pass + 1)))); if (match) atomicAdd((int*)&hist[(key[j] >> (8 * pass)) & 255u], 1); } }
            __syncthreads();
            if (wave == 0) {
                const int b0 = hist[4 * lane], b1 = hist[4 * lane + 1], b2 = hist[4 * lane + 2], b3 = hist[4 * lane + 3];
                const int s = b0 + b1 + b2 + b3; int suf = s;
#pragma unroll
                for (int off = 1; off < 64; off <<= 1) { const int t = __shfl_down(suf, off); if (lane + off < 64) suf += t; }
                const int above = suf - s; const int c3 = above + b3, c2 = c3 + b2, c1 = c2 + b1, c0 = c1 + b0;
                if (above < remaining && c0 >= remaining) { int dg, nr;
                    if (c3 >= remaining) { dg = 4 * lane + 3; nr = remaining - above; } else if (c2 >= remaining) { dg = 4 * lane + 2; nr = remaining - c3; }
                    else if (c1 >= remaining) { dg = 4 * lane + 1; nr = remaining - c2; } else { dg = 4 * lane; nr = remaining - c1; }
                    ctl[0] = dg; ctl[1] = nr; }
            }
            __syncthreads();
            prefix |= ((unsigned)ctl[0]) << (8 * pass); remaining = ctl[1];
            __syncthreads();
        }
        int cgt = 0, ceq = 0;
#pragma unroll
        for (int j = 0; j < 4; ++j) { const int t = tid * 4 + j; if (t < n) { cgt += key[j] > prefix ? 1 : 0; ceq += key[j] == prefix ? 1 : 0; } }
        const int packed = cgt | (ceq << 16);
        int inc = packed;
#pragma unroll
        for (int off = 1; off < 64; off <<= 1) { const int t = __shfl_up(inc, off); if (lane >= off) inc += t; }
        if (lane == 63) wsum[wave] = inc;
        __syncthreads();
        int base = 0;
#pragma unroll
        for (int w8 = 0; w8 < 8; ++w8) base += (w8 < wave) ? wsum[w8] : 0;
        int excl = base + inc - packed; int egt = excl & 0xffff, eeq = excl >> 16;
#pragma unroll
        for (int j = 0; j < 4; ++j) { const int t = tid * 4 + j; if (t < n) {
                const bool gt = key[j] > prefix, eq = key[j] == prefix; const bool sel = gt || (eq && eeq < remaining);
                const int slot = egt + (eeq < remaining ? eeq : remaining);
                if (sel) { ROWTOK[e * EROWS + rowbase + slot] = tok0 + t; ROWAFF[e * EROWS + rowbase + slot] = __uint_as_float(key[j]); }
                INV[(size_t)(tok0 + t) * 16 + e] = sel ? rowbase + slot : -1;
                egt += gt ? 1 : 0; eeq += eq ? 1 : 0; } }
        __syncthreads();
    }
}

__device__ __forceinline__ void ph_gather(const Params& p, int l) {
    const int tid = opaque_tid(), lane = tid & 63, wave = tid >> 6;
    unsigned char* ws = opaque_ptr(p.ws); const int* ROWTOK = (const int*)(ws + WS_ROWTOK);
    const int rows_per_e = (l == 0) ? 1152 : 1024;
    const int nitems = NE * rows_per_e / 8;
    for (int it = blockIdx.x; it < nitems; it += gridDim.x) {
        const int ridx = it * 8 + wave; const int e = ridx / rows_per_e, r = ridx % rows_per_e;
        const int tok = ROWTOK[e * EROWS + r];
        const u32x4* src = (const u32x4*)((const bf16_t*)(ws + WS_H) + (size_t)tok * DM); u32x4* dst = (u32x4*)((bf16_t*)(ws + WS_PA) + ((size_t)e * EROWS + r) * DM);
#pragma unroll
        for (int j = 0; j < 4; ++j) dst[j * 64 + lane] = src[j * 64 + lane];
    }
}

__device__ __forceinline__ void ph_combine(const Params& p, int l) {
    const int tid = opaque_tid(), lane = tid & 63, wave = tid >> 6;
    unsigned char* ws = opaque_ptr(p.ws); const float* mod = (const float*)(ws + WS_MOD);
    const int nrows = (l == 0) ? MT : NLAT;
    const int* INV = (const int*)(ws + WS_INV); const bf16_t* YS = (const bf16_t*)(ws + WS_YS);
    for (int it = blockIdx.x; it < nrows / 8; it += gridDim.x) {
        const int row = it * 8 + wave; const int rr = row < NLAT ? (row >> 11) : 4;
        const float* xr = (const float*)(ws + WS_XB) + (size_t)row * DM;
        f32x4 x[8], s[8], y[8];
#pragma unroll
        for (int j = 0; j < 8; ++j) { x[j] = *(const f32x4*)(xr + j * 256 + lane * 4); s[j] = (f32x4){0.f, 0.f, 0.f, 0.f}; }
        const int myinv = lane < 16 ? INV[(size_t)row * 16 + lane] : -1;
        for (int e = 0; e < 16; ++e) { const int r = __shfl(myinv, e); if (r >= 0) { const bf16_t* yr = YS + ((size_t)e * EROWS + r) * DM;
#pragma unroll
                for (int j = 0; j < 8; ++j) { const u32x2 v = *(const u32x2*)(yr + j * 256 + lane * 4); s[j][0] += bflo(v.x); s[j][1] += bfhi(v.x); s[j][2] += bflo(v.y); s[j][3] += bfhi(v.y); } } }
        const float* gate = mod + (size_t)(l * 5 + rr) * 12288 + 5 * DM;
#pragma unroll
        for (int j = 0; j < 8; ++j) { const f32x4 gv = *(const f32x4*)(gate + j * 256 + lane * 4); x[j] += gv * s[j]; }
        if (l == 0) {
            float* xo = (float*)(ws + WS_XA) + (size_t)row * DM;
#pragma unroll
            for (int j = 0; j < 8; ++j) *(f32x4*)(xo + j * 256 + lane * 4) = x[j];
            const float* m = mod + (size_t)(5 + rr) * 12288;
            rms_mod_store(x, p.in[I_N1G] + DM, m + DM, m, (bf16_t*)(ws + WS_H) + (size_t)row * DM, y, lane);
        } else {
            float ss = 0.f;
#pragma unroll
            for (int j = 0; j < 8; ++j) ss += x[j][0] * x[j][0] + x[j][1] * x[j][1] + x[j][2] * x[j][2] + x[j][3] * x[j][3];
            ss = wave_sum(ss); const float rinv = rsqrtf(ss * (1.0f / DM) + EPS);
            float* orow = p.out + (size_t)row * DM;
#pragma unroll
            for (int j = 0; j < 8; ++j) { const f32x4 gv = *(const f32x4*)(p.in[I_FNG] + j * 256 + lane * 4); *(f32x4*)(orow + j * 256 + lane * 4) = x[j] * rinv * gv; }
        }
    }
}

constexpr int NPH_LAYER = 13, NPH = 2 + 2 * NPH_LAYER;
__global__ void __launch_bounds__(512, 2) fwd(Params p) {
    extern __shared__ __attribute__((aligned(16))) unsigned char lds_raw[];
    LAS unsigned char* lds = (LAS unsigned char*)lds_raw;
    volatile LAS unsigned* MISC = (volatile LAS unsigned*)(lds + LDS_MISC);
    if (threadIdx.x < 16) MISC[threadIdx.x] = 0u;
    __syncthreads();
    unsigned char* ws = p.ws;
    const int lo = p.ph_lo, hi = p.ph_hi;
    XcdBarrier bar; bar.bar = (unsigned*)(ws + WS_CTL); bar.x = 0; bar.st = MISC;
    if (hi - lo > 1) bar = xcd_barrier_post((unsigned*)(ws + WS_CTL), MISC);
    const int G = gridDim.x, c = blockIdx.x;
#ifndef ONLY_PH
#define ONLY_PH -1
#endif
#define PSEL(id) (ONLY_PH < 0 || ONLY_PH == (id))
#define IN(k) (lo <= (k) && (k) < hi)
#define SEAM(k) do { if (IN(k) && IN((k) + 1)) xcd_barrier(bar); } while (0)

    if (PSEL(0) && IN(0)) { ph_prologue(p, lds); __syncthreads(); }
    SEAM(0);
    if (PSEL(1) && IN(1)) { ph_norm1_tables(p); }
    SEAM(1);
    for (int l = 0; l < 2; ++l) {
        const int pb = 2 + NPH_LAYER * l;
        const float* mod = (const float*)(ws + WS_MOD) + (size_t)l * 5 * 12288;
        if (PSEL(2) && IN(pb + 0)) {
            pg8::TileSched S; S.init(ws + WS_H, (bf16_t*)(ws + WS_WTIN) + (size_t)l * INP * DM, DM, DM, MT / 256, INP / 256, 1, 0, 0, G, c, 0);
            pg8::EpiStoreBf16 E{(bf16_t*)(ws + WS_PA), INP};
            pg8::gemm_phase(lds, pg8::Desc{DM, DM, DM}, S, E);
        }
        SEAM(pb + 0);
        if (PSEL(3) && IN(pb + 1)) { ph_rowsplit(p, l, lds); __syncthreads(); }
        SEAM(pb + 1);
        if (PSEL(4) && IN(pb + 2)) {
#ifndef C_SEL
#define C_SEL 15
#endif
            if (C_SEL & 1) { pg8::TileSched S; S.init(ws + WS_QA, (bf16_t*)(ws + WS_WTUQ) + (size_t)l * 768 * 384, 384, 384, MT / 256, 3, 1, 0, 0, G, c, 0);
              pg8::EpiQ E{(bf16_t*)(ws + WS_QB), (const f32x2*)(ws + WS_ROPE)}; pg8::gemm_phase(lds, pg8::Desc{384, 384, 384}, S, E); }
            if (C_SEL & 2) { pg8::TileSched S; S.init(ws + WS_KVA, (bf16_t*)(ws + WS_WTUKV) + (size_t)l * 1024 * 256, 256, 256, MT / 256, 2, 1, 0, 0, G, c, 112);
              pg8::EpiK E{(bf16_t*)(ws + WS_KC)}; pg8::gemm_phase(lds, pg8::Desc{256, 256, 256}, S, E); }
            if (C_SEL & 4) { pg8::TileSched S; S.init((bf16_t*)(ws + WS_WTUKV) + (size_t)l * 1024 * 256 + 512 * 256, ws + WS_KVA, 256, 256, 2, MT / 256, 1, 0, 0, G, c, 184);
              pg8::EpiV E{(bf16_t*)(ws + WS_VT)}; pg8::gemm_phase(lds, pg8::Desc{256, 256, 256}, S, E); }
            if (C_SEL & 8) { pg8::TileSched S; S.init(ws + WS_UPK, (bf16_t*)(ws + WS_WST) + (size_t)l * 32 * 256 * 256, 512, 256, 3, 1, 32, (size_t)768 * 512 * 2, (size_t)256 * 256 * 2, G, c, 0);
              pg8::EpiS1 E{(float*)(ws + WS_EST)}; pg8::gemm_phase(lds, pg8::Desc{512, 256, 256}, S, E); }
        }
        SEAM(pb + 2);
        if (PSEL(5) && IN(pb + 3)) { ph_attn_carry(p, l, lds); __syncthreads(); }
        SEAM(pb + 3);
        if (PSEL(6) && IN(pb + 4)) {
            pg8::TileSched S; S.init(ws + WS_UPK, (bf16_t*)(ws + WS_G2B) + (size_t)l * 32 * 256 * 512, 512, 512, 3, 1, 32, (size_t)768 * 512 * 2, (size_t)256 * 512 * 2, G, c, 0);
            pg8::EpiS2 E{(bf16_t*)(ws + WS_GB)}; pg8::gemm_phase(lds, pg8::Desc{512, 512, 512}, S, E);
        }
        SEAM(pb + 4);
        if (PSEL(7) && IN(pb + 5)) {
            pg8::TileSched S; S.init(ws + WS_GB, (bf16_t*)(ws + WS_WTGLU) + (size_t)l * 512 * 512, 512, 512, MT / 256, 2, 1, 0, 0, G, c, 0);
            pg8::EpiGlu E{(const bf16_t*)(ws + WS_GB), p.in[I_BGLU] + l * 512, (bf16_t*)(ws + WS_CAT)}; pg8::gemm_phase(lds, pg8::Desc{512, 512, 512}, S, E);
        }
        SEAM(pb + 5);
        if (PSEL(8) && IN(pb + 6)) {
            pg8::TileSched S; S.init(ws + WS_CAT, (bf16_t*)(ws + WS_WTOUT) + (size_t)l * DM * DM, DM, DM, (l == 0 ? MT : NLAT) / 256, DM / 256, 1, 0, 0, G, c, 0);
            pg8::EpiOut E{l == 0 ? p.in[I_X] : (const float*)(ws + WS_XA), l == 0 ? p.in[I_CTX] : (const float*)(ws + WS_XA) + (size_t)NLAT * DM, mod + 2 * DM, (float*)(ws + WS_XB)};
            pg8::gemm_phase(lds, pg8::Desc{DM, DM, DM}, S, E);
        }
        SEAM(pb + 6);
        if (PSEL(9) && IN(pb + 7)) { ph_norm2_router(p, l); }
        SEAM(pb + 7);
        if (PSEL(10) && IN(pb + 8)) { ph_topk(p, l, lds); __syncthreads(); }
        SEAM(pb + 8);
        if (PSEL(11) && IN(pb + 9)) { ph_gather(p, l); }
        SEAM(pb + 9);
        if (PSEL(12) && IN(pb + 10)) {
            pg8::MoeSched S; S.init(ws + WS_PA, (bf16_t*)(ws + WS_WTGU) + (size_t)l * NE * 2048 * DM, DM, DM, l == 0 ? 5 : 4, 8, (size_t)EROWS * DM * 2, (size_t)2048 * DM * 2, G, c);
            pg8::EpiGU E{(bf16_t*)(ws + WS_HID)}; pg8::gemm_phase(lds, pg8::Desc{DM, DM, DM}, S, E);
        }
        SEAM(pb + 10);
        if (PSEL(13) && IN(pb + 11)) {
            pg8::MoeSched S; S.init(ws + WS_HID, (bf16_t*)(ws + WS_WTDN) + (size_t)l * NE * DM * FF, FF, FF, l == 0 ? 5 : 4, 8, (size_t)EROWS * FF * 2, (size_t)DM * FF * 2, G, c);
            pg8::EpiDown E{(bf16_t*)(ws + WS_YS), (const float*)(ws + WS_ROWAFF)}; pg8::gemm_phase(lds, pg8::Desc{FF, FF, FF}, S, E);
        }
        SEAM(pb + 11);
        if (PSEL(14) && IN(pb + 12)) { ph_combine(p, l); }
        SEAM(pb + 12);
    }
#undef IN
#undef SEAM
}

extern "C" void kernel_launch(void* const* d_in, const int* in_sizes, int n_in, void* d_out, int out_size, void* d_ws, size_t ws_size, hipStream_t stream) {
    static int grid = 0;
    if (grid == 0) {
        if (n_in != 33 || ws_size < WS_END) { fprintf(stderr, "kernel_launch: need 33 inputs and >= %zu bytes of workspace; got %d, %zu\n", (size_t)WS_END, n_in, ws_size); grid = -1; return; }
        int dev = 0, cus = 0;
        if (hipGetDevice(&dev) != hipSuccess || hipDeviceGetAttribute(&cus, hipDeviceAttributeMultiprocessorCount, dev) != hipSuccess) { grid = -1; return; }
        if (hipFuncSetAttribute((const void*)fwd, hipFuncAttributeMaxDynamicSharedMemorySize, LDS_BYTES) != hipSuccess) { fprintf(stderr, "kernel_launch: hipFuncSetAttribute failed\n"); grid = -1; return; }
        (void)hipGetLastError();
        grid = cus > 256 ? 256 : cus;
    }
    if (grid < 0) return;
    (void)hipMemsetAsync((char*)d_ws + WS_CTL, 0, CTL_BYTES, stream);
    Params a{};
    for (int i = 0; i < 33; ++i) a.in[i] = (const float*)d_in[i];
    a.out = (float*)d_out; a.ws = (unsigned char*)d_ws;
#if MK_SPLIT
    for (int ph = 0; ph < NPH; ++ph) { a.ph_lo = ph; a.ph_hi = ph + 1; hipLaunchKernelGGL(fwd, dim3(grid), dim3(512), LDS_BYTES, stream, a); }
#else
    a.ph_lo = 0; a.ph_hi = NPH; hipLaunchKernelGGL(fwd, dim3(grid), dim3(512), LDS_BYTES, stream, a);
#endif
}
```

```cpp
#include <hip/hip_runtime.h>
#include <cstdint>
#include <cstdio>

#ifndef MK_SPLIT
#define MK_SPLIT 0
#endif

#define LAS __attribute__((address_space(3)))
typedef unsigned short bf16_t;
typedef short bf16x8 __attribute__((ext_vector_type(8)));
typedef short bf16x4 __attribute__((ext_vector_type(4)));
typedef float f32x4 __attribute__((ext_vector_type(4)));
typedef float f32x2 __attribute__((ext_vector_type(2)));
typedef unsigned u32x4 __attribute__((ext_vector_type(4)));
typedef unsigned u32x2 __attribute__((ext_vector_type(2)));

constexpr int DM = 2048, NB = 4, SEQ = 2048, CTX = 256, NLAT = NB * SEQ, NCTX = NB * CTX, MT = NLAT + NCTX;
constexpr int INC = 3776, INP = 3840;
constexpr int C_SGU_U = 0, C_SGU_V = 512, C_CQ = 1024, C_CKV = 1408, C_KR = 1664, C_S5 = 1728, C_CVB = 2240, C_CVC = 2752, C_CVH = 3264;
constexpr int NKEY = CTX + SEQ;
constexpr int NE = 16, FF = 1024, CAPL = 256, CAPC = 32, EROWS = 1280;
constexpr int NCHUNK = MT / 16;
constexpr float EPS = 1e-6f;
constexpr float QSCALE = 0.07216878364870322f * 1.4426950408889634f;

constexpr size_t al256(size_t x) { return (x + 255) & ~(size_t)255; }
constexpr size_t WS_CTL = 0;
constexpr size_t CTL_BYTES = 65536;
constexpr size_t WS_MOD = WS_CTL + CTL_BYTES;
constexpr size_t WS_WTIN = al256(WS_MOD + (size_t)2 * 5 * 12288 * 4);
constexpr size_t WS_WTOUT = al256(WS_WTIN + (size_t)2 * INP * DM * 2);
constexpr size_t WS_WTUQ = al256(WS_WTOUT + (size_t)2 * DM * DM * 2);
constexpr size_t WS_WTUKV = al256(WS_WTUQ + (size_t)2 * 768 * 384 * 2);
constexpr size_t WS_WTGLU = al256(WS_WTUKV + (size_t)2 * 1024 * 256 * 2);
constexpr size_t WS_WTGU = al256(WS_WTGLU + (size_t)2 * 512 * 512 * 2);
constexpr size_t WS_WTDN = al256(WS_WTGU + (size_t)2 * NE * 2048 * DM * 2);
constexpr size_t WS_PW = al256(WS_WTDN + (size_t)2 * NE * DM * FF * 2);
constexpr size_t WS_BB = al256(WS_PW + (size_t)2 * 2 * 32 * 64 * 17 * 8);
constexpr size_t WS_KZ = al256(WS_BB + (size_t)2 * 2 * 32 * 64 * 16 * 8);
constexpr size_t WS_WST = al256(WS_KZ + (size_t)2 * 2 * 32 * 4096 * 4);
constexpr size_t WS_G2B = al256(WS_WST + (size_t)2 * 32 * 256 * 256 * 2);
constexpr size_t WS_H = al256(WS_G2B + (size_t)2 * 32 * 256 * 512 * 2);
constexpr size_t WS_PA = al256(WS_H + (size_t)MT * DM * 2);
constexpr size_t PA_BYTES = (size_t)NE * EROWS * DM * 2;
static_assert(PA_BYTES >= (size_t)MT * INP * 2, "P fits in the union");
constexpr size_t WS_XA = al256(WS_PA + PA_BYTES);
constexpr size_t WS_XB = al256(WS_XA + (size_t)MT * DM * 4);
constexpr size_t WS_CAT = al256(WS_XB + (size_t)MT * DM * 4);
constexpr size_t WS_QA = al256(WS_CAT + (size_t)MT * DM * 2);
constexpr size_t WS_KVA = al256(WS_QA + (size_t)MT * 384 * 2);
constexpr size_t WS_QB = al256(WS_KVA + (size_t)MT * 256 * 2);
constexpr size_t WS_KC = al256(WS_QB + (size_t)MT * 768 * 2);
constexpr size_t WS_VT = al256(WS_KC + (size_t)NB * 4 * NKEY * 192 * 2);
constexpr size_t WS_UPK = al256(WS_VT + (size_t)NB * 4 * 128 * NKEY * 2);
constexpr size_t WS_EST = al256(WS_UPK + (size_t)32 * 768 * 512 * 2);
constexpr size_t WS_GB = al256(WS_EST + (size_t)32 * 768 * 256 * 4);
constexpr size_t WS_AFF = al256(WS_GB + (size_t)MT * 512 * 2);
constexpr size_t WS_ROWTOK = al256(WS_AFF + (size_t)MT * 16 * 4);
constexpr size_t WS_ROWAFF = al256(WS_ROWTOK + (size_t)NE * EROWS * 4);
constexpr size_t WS_INV = al256(WS_ROWAFF + (size_t)NE * EROWS * 4);
constexpr size_t WS_HID = al256(WS_INV + (size_t)MT * 16 * 4);
constexpr size_t WS_YS = al256(WS_HID + (size_t)NE * EROWS * FF * 2);
constexpr size_t WS_ROPE = al256(WS_YS + (size_t)NE * EROWS * DM * 2);
constexpr size_t WS_END = al256(WS_ROPE + 64 * 16 * 8);

constexpr int LDS_GEMM = 131072;
constexpr int LDS_MISC = LDS_GEMM;
constexpr int LDS_BYTES = LDS_GEMM + 256;

__device__ __forceinline__ unsigned cvt_pk_bf16(float lo, float hi) { unsigned r; asm("v_cvt_pk_bf16_f32 %0, %1, %2" : "=v"(r) : "v"(lo), "v"(hi)); return r; }
__device__ __forceinline__ float bf2f(unsigned short b) { return __uint_as_float(((unsigned)b) << 16); }
__device__ __forceinline__ float bflo(unsigned w) { return __uint_as_float(w << 16); }
__device__ __forceinline__ float bfhi(unsigned w) { return __uint_as_float(w & 0xffff0000u); }
__device__ __forceinline__ unsigned short f2bf(float f) { return (unsigned short)(cvt_pk_bf16(f, 0.f) & 0xffffu); }
__device__ __forceinline__ int opaque_tid() { int t = threadIdx.x; asm volatile("" : "+v"(t)); return t; }
__device__ __forceinline__ unsigned char* opaque_ptr(unsigned char* q) { asm volatile("" : "+s"(q)); return q; }
__device__ __forceinline__ float wave_sum(float v) {
#pragma unroll
    for (int o = 32; o >= 1; o >>= 1) v += __shfl_xor(v, o);
    return v;
}
__device__ __forceinline__ float gelu_tanh(float x) {
    const float y = 1.5957691216057308f * (x + 0.044715f * x * x * x);
    return x / (1.0f + __expf(-y));
}
__device__ __forceinline__ float silu_f(float x) { return x / (1.0f + __expf(-x)); }
__device__ __forceinline__ float sigmoid_f(float x) { return 1.0f / (1.0f + __expf(-x)); }

#define XB_TMO      128
#define XB_XCNT(j)  (256  + 64 * (j))
#define XB_XSUB(j)  (1280 + 64 * (j))
#define XB_XGEN(j)  (2304 + 64 * (j))
#define XB_TOP      3328
#define XB_TOPGEN   3392
#define XCD_BAR_WORDS 3456
#define XB_SPIN_CAP (1u << 22)
__device__ __forceinline__ unsigned xb_ld(unsigned* p)              { return __hip_atomic_load(p, __ATOMIC_RELAXED, __HIP_MEMORY_SCOPE_AGENT); }
__device__ __forceinline__ unsigned xb_add(unsigned* p, unsigned v) { return __hip_atomic_fetch_add(p, v, __ATOMIC_RELAXED, __HIP_MEMORY_SCOPE_AGENT); }
__device__ __forceinline__ unsigned xb_xcc_id() { return (unsigned)__builtin_amdgcn_s_getreg((3 << 11) | 20) & 0xFu; }
#define XB_SPIN(cond, bar) do { unsigned _sp = 0; while (cond) { __builtin_amdgcn_s_sleep(1); \
    if ((++_sp & 255u) == 0u) { if (xb_ld(&(bar)[XB_TMO])) break; if (_sp > XB_SPIN_CAP) { atomicAdd(&(bar)[XB_TMO], 1u); break; } } } } while (0)
struct XcdBarrier { unsigned* bar; unsigned x; volatile LAS unsigned* st; };
__device__ __forceinline__ XcdBarrier xcd_barrier_post(unsigned* bar, volatile LAS unsigned* st) {
    XcdBarrier b; b.bar = bar; b.x = xb_xcc_id(); b.st = st;
    if (threadIdx.x == 0) (void)xb_add(&bar[XB_XCNT(b.x)], 1u);
    return b;
}
__device__ __forceinline__ void xcd_barrier_complete(unsigned* bar, unsigned x, unsigned& nloc, unsigned& nx) {
    const unsigned G = gridDim.x * gridDim.y * gridDim.z;
    unsigned sum, cnt, mine, sp = 0u;
    for (;;) {
        sum = 0u; cnt = 0u; mine = 0u;
#pragma unroll
        for (unsigned j = 0; j < 16; ++j) { const unsigned c = xb_ld(&bar[XB_XCNT(j)]); sum += c; cnt += (c > 0u) ? 1u : 0u; mine = (j == x) ? c : mine; }
        if (sum == G) break;
        __builtin_amdgcn_s_sleep(1);
        if ((++sp & 255u) == 0u) { if (xb_ld(&bar[XB_TMO])) break; if (sp > XB_SPIN_CAP) { atomicAdd(&bar[XB_TMO], 1u); break; } }
    }
    nloc = mine > 0u ? mine : 1u; nx = cnt > 0u ? cnt : 1u;
}
__device__ __forceinline__ void xcd_barrier(const XcdBarrier& b) {
    asm volatile("s_waitcnt vmcnt(0)" ::: "memory");
    __syncthreads();
    if (threadIdx.x == 0) {
        unsigned* bar = b.bar;
        __builtin_amdgcn_s_waitcnt(0);
        unsigned nloc = b.st[0], nx = b.st[1];
        if (nloc == 0u) { xcd_barrier_complete(bar, b.x, nloc, nx); b.st[0] = nloc; b.st[1] = nx; }
        const unsigned old = xb_add(&bar[XB_XSUB(b.x)], 1u);
        const unsigned gen = old / nloc;
        if (old + 1u == (gen + 1u) * nloc) {
            __builtin_amdgcn_fence(__ATOMIC_RELEASE, "agent");
            asm volatile("s_waitcnt vmcnt(0)" ::: "memory");
            const unsigned og = xb_add(&bar[XB_TOP], 1u);
            const unsigned tg = og / nx;
            if (og + 1u == (tg + 1u) * nx) xb_add(&bar[XB_TOPGEN], 1u);
            else XB_SPIN(xb_ld(&bar[XB_TOPGEN]) == tg, bar);
            __builtin_amdgcn_fence(__ATOMIC_ACQUIRE, "agent");
            xb_add(&bar[XB_XGEN(b.x)], 1u);
            asm volatile("s_waitcnt vmcnt(0)" ::: "memory");
        } else {
            XB_SPIN(xb_ld(&bar[XB_XGEN(b.x)]) == gen, bar);
            __builtin_amdgcn_fence(__ATOMIC_ACQUIRE, "agent");
            asm volatile("s_waitcnt vmcnt(0)" ::: "memory");
        }
    }
    __syncthreads();
}

namespace pg8 {
constexpr int BM = 256, BK = 64, HALF = 128, HTB = HALF * BK * 2, STAGE_BYTES = 8 * HTB;
__host__ __device__ __forceinline__ int lds_byte(int r, int c) { const int st = (r >> 4) * 2 + (c >> 5), rr = r & 15, cc = c & 31, ob = rr * 64 + cc * 2; return st * 1024 + (ob ^ (((ob >> 9) & 1) << 5)); }
__host__ __device__ __forceinline__ void stage_rc(int b, int& R, int& C) { const int st = b / 1024, sb = b % 1024, swz = sb ^ (((sb >> 9) & 1) << 5); R = (st >> 1) * 16 + swz / 64; C = (st & 1) * 32 + (swz % 64) / 2; }
__host__ __device__ __forceinline__ int perm32(int rho) { const int n = rho >> 4, i = rho & 15; return 8 * (i >> 2) + 4 * n + (i & 3); }

struct Unit { const char* a; const char* b; int pm, pn, pb; };
struct Desc { int lda, ldb, K; };

struct TileSched {
    const char* A; const char* B; size_t sA, sB;
    int lda, ldb, nM, nN, nB, G, c;
    __device__ __forceinline__ void init(const void* A_, const void* B_, int lda_, int ldb_, int nM_, int nN_, int nB_, size_t sA_, size_t sB_, int G_, int c_, int off) {
        A = (const char*)A_; B = (const char*)B_; lda = lda_; ldb = ldb_; nM = nM_; nN = nN_; nB = nB_; sA = sA_; sB = sB_; G = G_; c = (c_ + G_ - (off % G_)) % G_; }
    __device__ __forceinline__ bool next(int i, Unit& u) const {
        const int nwg = nM * nN; const long L = (long)i * G + c; if (L >= (long)nwg * nB) return false;
        const int pb = (int)(L / nwg); int wgid = (int)(L % nwg);
        { const int q = nwg / 8, r = nwg % 8, xcd = wgid % 8, off = wgid / 8; wgid = (xcd < r ? xcd * (q + 1) : r * (q + 1) + (xcd - r) * q) + off; }
        const int nig = 8 * nN, gid = wgid / nig, fm = gid * 8, gsz = (nM - fm) < 8 ? (nM - fm) : 8;
        u.pm = fm + ((wgid % nig) % gsz); u.pn = (wgid % nig) / gsz; u.pb = pb;
        u.a = A + (size_t)pb * sA + (size_t)u.pm * 256 * lda * 2; u.b = B + (size_t)pb * sB + (size_t)u.pn * 256 * ldb * 2; return true;
    }
};
struct MoeSched {
    const char* A; const char* B; size_t sA, sB; int lda, ldb, nM, nN, G, c;
    __device__ __forceinline__ void init(const void* A_, const void* B_, int lda_, int ldb_, int nM_, int nN_, size_t sA_, size_t sB_, int G_, int c_) {
        A = (const char*)A_; B = (const char*)B_; lda = lda_; ldb = ldb_; nM = nM_; nN = nN_; sA = sA_; sB = sB_; G = G_; c = c_; }
    __device__ __forceinline__ bool next(int i, Unit& u) const {
        int e, rem; const int per = nM * nN;
        if ((G & 7) == 0) { const int x = c & 7, j = c >> 3, w = G >> 3; const int L = i * w + j; if (L >= 2 * per) return false; e = 2 * x + L / per; rem = L % per; }
        else { const long L = (long)i * G + c; if (L >= (long)NE * per) return false; e = (int)(L / per); rem = (int)(L % per); }
        u.pn = rem / nM; u.pm = rem % nM; u.pb = e;
        u.a = A + (size_t)e * sA + (size_t)u.pm * 256 * lda * 2; u.b = B + (size_t)e * sB + (size_t)u.pn * 256 * ldb * 2; return true;
    }
};

template <class Epi, class Sched>
__device__ __forceinline__ void gemm_phase(LAS unsigned char* lds, const Desc g, const Sched& S, const Epi& E) {
    const int tid = opaque_tid(), wid = __builtin_amdgcn_readfirstlane(tid >> 6), lane = tid & 63, wr = wid >> 2, wc = wid & 3, fr = lane & 15, fq = lane >> 4;
    const int K = g.K, nt = K / BK;
    unsigned voffA[2], voffB[2];
#pragma unroll
    for (int i = 0; i < 2; ++i) { int R, C; stage_rc(tid * 16 + i * 8192, R, C); const int Rb = Epi::PERM ? ((R & ~31) + perm32(R & 31)) : R;
        voffA[i] = (unsigned)(R * g.lda + C) * 2u; voffB[i] = (unsigned)(Rb * g.ldb + C) * 2u; }
    const size_t kstep = (size_t)(BK * 2);
    const size_t hstepA = (size_t)HALF * g.lda * 2, hstepB = (size_t)HALF * g.ldb * 2;
    const unsigned ldsw = (unsigned)wid * 1024u;
    const int aoff = lds_byte(wr * 64 + fr, fq * 8), boff = lds_byte(wc * 32 + fr, fq * 8);
#define PG8_SA(b, h) (((b) * 2 + (h)) * HTB)
#define PG8_SB(b, h) ((4 + (b) * 2 + (h)) * HTB)
#define PG8_STAGE(bufoff, gbase, voff) do { _Pragma("unroll") for (int _i = 0; _i < 2; ++_i) \
        __builtin_amdgcn_global_load_lds((const unsigned*)((const char*)(gbase) + (voff)[_i]), (LAS unsigned*)(lds + (bufoff) + ldsw + _i * 8192), 16, 0, 0); } while (0)
#define PG8_LDA(dst, b, h) do { _Pragma("unroll") for (int m = 0; m < 4; ++m) _Pragma("unroll") for (int k = 0; k < 2; ++k) dst[m][k] = *(const LAS bf16x8*)(lds + PG8_SA(b, h) + aoff + m * 2048 + k * 1024); } while (0)
#define PG8_LDB(dst, b, h) do { _Pragma("unroll") for (int n = 0; n < 2; ++n) _Pragma("unroll") for (int k = 0; k < 2; ++k) dst[n][k] = *(const LAS bf16x8*)(lds + PG8_SB(b, h) + boff + n * 2048 + k * 1024); } while (0)
#define PG8_MMA(ai, bj, At, Bt) do { __builtin_amdgcn_s_setprio(1); _Pragma("unroll") for (int m = 0; m < 4; ++m) _Pragma("unroll") for (int n = 0; n < 2; ++n) _Pragma("unroll") for (int k = 0; k < 2; ++k) \
        acc[ai][bj][m][n] = __builtin_amdgcn_mfma_f32_16x16x32_bf16(Bt[n][k], At[m][k], acc[ai][bj][m][n], 0, 0, 0); __builtin_amdgcn_s_setprio(0); } while (0)
#define PG8_WAIT_V(n) asm volatile("s_waitcnt vmcnt(" #n ")" ::: "memory")
#define PG8_WAIT_L(n) asm volatile("s_waitcnt lgkmcnt(" #n ")" ::: "memory")
#define PG8_BAR __builtin_amdgcn_s_barrier()
#define PG8_SCHED __builtin_amdgcn_sched_barrier(0)
    Unit cur, nxt; int ui = 0;
    if (!S.next(0, cur)) return;
    f32x4 acc[2][2][4][2];
#pragma unroll
    for (int a = 0; a < 2; ++a)
#pragma unroll
        for (int b = 0; b < 2; ++b)
#pragma unroll
            for (int m = 0; m < 4; ++m)
#pragma unroll
                for (int n = 0; n < 2; ++n) acc[a][b][m][n] = (f32x4){0.f, 0.f, 0.f, 0.f};
    bf16x8 At[4][2], B0[2][2], B1[2][2];
    const char* cA = cur.a; const char* cB = cur.b;
    PG8_STAGE(PG8_SB(0, 0), cB, voffB); PG8_STAGE(PG8_SA(0, 0), cA, voffA); PG8_STAGE(PG8_SB(0, 1), cB + hstepB, voffB); PG8_STAGE(PG8_SA(0, 1), cA + hstepA, voffA);
    if (wr == 1) PG8_BAR;
    PG8_WAIT_V(4); PG8_BAR;
    PG8_STAGE(PG8_SB(1, 0), cB + kstep, voffB); PG8_STAGE(PG8_SA(1, 0), cA + kstep, voffA); PG8_STAGE(PG8_SB(1, 1), cB + hstepB + kstep, voffB);
    PG8_WAIT_V(6); PG8_BAR;
    for (;;) {
        const bool has_next = S.next(ui + 1, nxt);
        const char* nA = has_next ? nxt.a : cA; const char* nB = has_next ? nxt.b : cB;
#pragma nounroll
        for (int t = 0; t < nt; t += 2) {
            const bool last = (t == nt - 2);
            const char* a1 = cA + (size_t)(t + 1) * kstep;
            const char* a2 = last ? nA : cA + (size_t)(t + 2) * kstep; const char* b2 = last ? nB : cB + (size_t)(t + 2) * kstep;
            const char* a3 = a2 + kstep; const char* b3 = b2 + kstep;
            PG8_LDB(B0, 0, 0); PG8_SCHED; PG8_LDA(At, 0, 0); PG8_STAGE(PG8_SA(1, 1), a1 + hstepA, voffA);
            PG8_WAIT_L(8); PG8_BAR; PG8_WAIT_L(0); PG8_MMA(0, 0, At, B0); PG8_BAR; PG8_SCHED;
            PG8_LDB(B1, 0, 1); PG8_STAGE(PG8_SB(0, 0), b2, voffB);
            PG8_BAR; PG8_WAIT_L(0); PG8_MMA(0, 1, At, B1); PG8_BAR;
            PG8_LDA(At, 0, 1); PG8_STAGE(PG8_SA(0, 0), a2, voffA);
            PG8_BAR; PG8_WAIT_L(0); PG8_MMA(1, 0, At, B0); PG8_BAR; PG8_SCHED;
            PG8_STAGE(PG8_SB(0, 1), b2 + hstepB, voffB);
            PG8_WAIT_V(6); PG8_BAR; PG8_MMA(1, 1, At, B1); PG8_BAR;
            PG8_LDB(B0, 1, 0); PG8_SCHED; PG8_LDA(At, 1, 0); PG8_STAGE(PG8_SA(0, 1), a2 + hstepA, voffA);
            PG8_WAIT_L(8); PG8_BAR; PG8_WAIT_L(0); PG8_MMA(0, 0, At, B0); PG8_BAR; PG8_SCHED;
            PG8_LDB(B1, 1, 1); PG8_STAGE(PG8_SB(1, 0), b3, voffB);
            PG8_BAR; PG8_WAIT_L(0); PG8_MMA(0, 1, At, B1); PG8_BAR;
            PG8_LDA(At, 1, 1); PG8_STAGE(PG8_SA(1, 0), a3, voffA);
            PG8_BAR; PG8_WAIT_L(0); PG8_MMA(1, 0, At, B0); PG8_BAR; PG8_SCHED;
            PG8_STAGE(PG8_SB(1, 1), b3 + hstepB, voffB);
            PG8_WAIT_V(6); PG8_BAR; PG8_MMA(1, 1, At, B1); PG8_BAR;
        }
        E(acc, cur, wr, wc, fr, fq);
        if (!has_next) break;
#pragma unroll
        for (int a = 0; a < 2; ++a)
#pragma unroll
            for (int b = 0; b < 2; ++b)
#pragma unroll
                for (int m = 0; m < 4; ++m)
#pragma unroll
                    for (int n = 0; n < 2; ++n) acc[a][b][m][n] = (f32x4){0.f, 0.f, 0.f, 0.f};
        cur = nxt; cA = nA; cB = nB; ++ui;
    }
    PG8_WAIT_V(0);
    if (wr == 0) PG8_BAR;
    PG8_BAR;
#undef PG8_SA
#undef PG8_SB
#undef PG8_STAGE
#undef PG8_LDA
#undef PG8_LDB
#undef PG8_MMA
#undef PG8_WAIT_V
#undef PG8_WAIT_L
#undef PG8_BAR
#undef PG8_SCHED
}

#define PG8_FOR_PERM(...) \
    _Pragma("unroll") for (int ai = 0; ai < 2; ++ai) _Pragma("unroll") for (int m = 0; m < 4; ++m) { const int tr = ai * 128 + wr * 64 + m * 16 + fr; \
        _Pragma("unroll") for (int bj = 0; bj < 2; ++bj) { const int tc = bj * 128 + wc * 32 + 8 * fq; const f32x4 v0 = acc[ai][bj][m][0], v1 = acc[ai][bj][m][1]; __VA_ARGS__ } }
#define PG8_FOR_NOPERM(...) \
    _Pragma("unroll") for (int ai = 0; ai < 2; ++ai) _Pragma("unroll") for (int m = 0; m < 4; ++m) { const int tr = ai * 128 + wr * 64 + m * 16 + fr; \
        _Pragma("unroll") for (int bj = 0; bj < 2; ++bj) _Pragma("unroll") for (int n = 0; n < 2; ++n) { const int tc = bj * 128 + wc * 32 + 16 * n + 4 * fq; const f32x4 v = acc[ai][bj][m][n]; __VA_ARGS__ } }

typedef const f32x4 (&AccRef)[2][2][4][2];

struct EpiStoreBf16 {
    static constexpr bool PERM = true;
    bf16_t* O; int ldc;
    __device__ __forceinline__ void operator()(AccRef acc, const Unit& u, int wr, int wc, int fr, int fq) const {
        PG8_FOR_PERM({ u32x4 w; w.x = cvt_pk_bf16(v0[0], v0[1]); w.y = cvt_pk_bf16(v0[2], v0[3]); w.z = cvt_pk_bf16(v1[0], v1[1]); w.w = cvt_pk_bf16(v1[2], v1[3]);
            *(u32x4*)(O + (size_t)(u.pm * 256 + tr) * ldc + u.pn * 256 + tc) = w; })
    }
};
struct EpiQ {
    static constexpr bool PERM = false;
    bf16_t* Q; const f32x2* ROPE;
    __device__ __forceinline__ void operator()(AccRef acc, const Unit& u, int wr, int wc, int fr, int fq) const {
#pragma unroll
        for (int ai = 0; ai < 2; ++ai)
#pragma unroll
            for (int m = 0; m < 4; ++m) { const int row = u.pm * 256 + ai * 128 + wr * 64 + m * 16 + fr; const bool lat = row < NLAT; const int t = row & (SEQ - 1);
#pragma unroll
                for (int bj = 0; bj < 2; ++bj) { const int cg = u.pn * 256 + bj * 128 + wc * 32; const int dd = cg % 192; f32x4 a = acc[ai][bj][m][0], b = acc[ai][bj][m][1];
                    if (dd >= 128 && lat) { const int pos = (dd - 128) >= 32 ? (t & 63) : (t >> 6); const f32x4* rp = (const f32x4*)(ROPE + pos * 16 + 4 * fq); const f32x4 r0 = rp[0], r1 = rp[1];
                        const float cs[4] = {r0[0], r0[2], r1[0], r1[2]}, sn[4] = {r0[1], r0[3], r1[1], r1[3]};
#pragma unroll
                        for (int i = 0; i < 4; ++i) { const float x1 = a[i], x2 = b[i]; a[i] = x1 * cs[i] - x2 * sn[i]; b[i] = x2 * cs[i] + x1 * sn[i]; } }
                    a *= QSCALE; b *= QSCALE;
                    bf16_t* o = Q + (size_t)row * 768 + cg + 4 * fq;
                    u32x2 w0; w0.x = cvt_pk_bf16(a[0], a[1]); w0.y = cvt_pk_bf16(a[2], a[3]); *(u32x2*)o = w0;
                    u32x2 w1; w1.x = cvt_pk_bf16(b[0], b[1]); w1.y = cvt_pk_bf16(b[2], b[3]); *(u32x2*)(o + 16) = w1; } }
    }
};
struct EpiK {
    static constexpr bool PERM = true;
    bf16_t* KC;
    __device__ __forceinline__ void operator()(AccRef acc, const Unit& u, int wr, int wc, int fr, int fq) const {
        PG8_FOR_PERM({ const int row = u.pm * 256 + tr; int b, key; if (row < NLAT) { b = row >> 11; key = CTX + (row & (SEQ - 1)); } else { b = (row - NLAT) >> 8; key = (row - NLAT) & (CTX - 1); }
            const int col = u.pn * 256 + tc, h = col >> 7, d = col & 127;
            u32x4 w; w.x = cvt_pk_bf16(v0[0], v0[1]); w.y = cvt_pk_bf16(v0[2], v0[3]); w.z = cvt_pk_bf16(v1[0], v1[1]); w.w = cvt_pk_bf16(v1[2], v1[3]);
            *(u32x4*)(KC + ((size_t)(b * 4 + h) * NKEY + key) * 192 + d) = w; })
    }
};
struct EpiV {
    static constexpr bool PERM = true;
    bf16_t* VT;
    __device__ __forceinline__ void operator()(AccRef acc, const Unit& u, int wr, int wc, int fr, int fq) const {
        PG8_FOR_PERM({ const int hd = u.pm * 256 + tr, h = hd >> 7, d = hd & 127; const int tok = u.pn * 256 + tc; int b, key;
            if (tok < NLAT) { b = tok >> 11; key = CTX + (tok & (SEQ - 1)); } else { b = (tok - NLAT) >> 8; key = (tok - NLAT) & (CTX - 1); }
            u32x4 w; w.x = cvt_pk_bf16(v0[0], v0[1]); w.y = cvt_pk_bf16(v0[2], v0[3]); w.z = cvt_pk_bf16(v1[0], v1[1]); w.w = cvt_pk_bf16(v1[2], v1[3]);
            *(u32x4*)(VT + ((size_t)(b * 4 + h) * 128 + d) * NKEY + key) = w; })
    }
};
struct EpiS1 {
    static constexpr bool PERM = false;
    float* EST;
    __device__ __forceinline__ void operator()(AccRef acc, const Unit& u, int wr, int wc, int fr, int fq) const {
        PG8_FOR_NOPERM({ const int row = u.pm * 256 + tr; if (row < NCHUNK) *(f32x4*)(EST + ((size_t)u.pb * 768 + row) * 256 + tc) = v; })
    }
};
struct EpiS2 {
    static constexpr bool PERM = true;
    bf16_t* GB;
    __device__ __forceinline__ void operator()(AccRef acc, const Unit& u, int wr, int wc, int fr, int fq) const {
        PG8_FOR_PERM({ const int row = u.pm * 256 + tr; if (row < NCHUNK) { const int p = tc >> 4, c = tc & 15;
            u32x4 w; w.x = cvt_pk_bf16(gelu_tanh(v0[0]), gelu_tanh(v0[1])); w.y = cvt_pk_bf16(gelu_tanh(v0[2]), gelu_tanh(v0[3]));
            w.z = cvt_pk_bf16(gelu_tanh(v1[0]), gelu_tanh(v1[1])); w.w = cvt_pk_bf16(gelu_tanh(v1[2]), gelu_tanh(v1[3]));
            *(u32x4*)(GB + (size_t)(row * 16 + p) * 512 + u.pb * 16 + c) = w; } })
    }
};
struct EpiGlu {
    static constexpr bool PERM = true;
    const bf16_t* GB; const float* bias; bf16_t* CAT;
    __device__ __forceinline__ void operator()(AccRef acc, const Unit& u, int wr, int wc, int fr, int fq) const {
        PG8_FOR_PERM({ const int row = u.pm * 256 + tr, col = u.pn * 256 + tc;
            const u32x4 gv = *(const u32x4*)(GB + (size_t)row * 512 + col); const f32x4 b0 = *(const f32x4*)(bias + col), b1 = *(const f32x4*)(bias + col + 4);
            u32x4 w;
            w.x = cvt_pk_bf16(bflo(gv.x) * sigmoid_f(v0[0] + b0[0]), bfhi(gv.x) * sigmoid_f(v0[1] + b0[1]));
            w.y = cvt_pk_bf16(bflo(gv.y) * sigmoid_f(v0[2] + b0[2]), bfhi(gv.y) * sigmoid_f(v0[3] + b0[3]));
            w.z = cvt_pk_bf16(bflo(gv.z) * sigmoid_f(v1[0] + b1[0]), bfhi(gv.z) * sigmoid_f(v1[1] + b1[1]));
            w.w = cvt_pk_bf16(bflo(gv.w) * sigmoid_f(v1[2] + b1[2]), bfhi(gv.w) * sigmoid_f(v1[3] + b1[3]));
            *(u32x4*)(CAT + (size_t)row * DM + 1024 + col) = w; })
    }
};
struct EpiOut {
    static constexpr bool PERM = false;
    const float* xl; const float* xc; const float* gate; float* xo;
    __device__ __forceinline__ void operator()(AccRef acc, const Unit& u, int wr, int wc, int fr, int fq) const {
        PG8_FOR_NOPERM({ const int row = u.pm * 256 + tr, col = u.pn * 256 + tc; const int rr = row < NLAT ? (row >> 11) : 4;
            const float* src = row < NLAT ? xl + (size_t)row * DM : xc + (size_t)(row - NLAT) * DM;
            const f32x4 xv = *(const f32x4*)(src + col), gv = *(const f32x4*)(gate + (size_t)rr * 12288 + col);
            *(f32x4*)(xo + (size_t)row * DM + col) = xv + gv * v; })
    }
};
struct EpiGU {
    static constexpr bool PERM = true;
    bf16_t* HID;
    __device__ __forceinline__ void operator()(AccRef acc, const Unit& u, int wr, int wc, int fr, int fq) const {
        PG8_FOR_PERM({ const int row = u.pm * 256 + tr, j = (u.pn * 256 + tc) >> 1;
            u32x2 w; w.x = cvt_pk_bf16(silu_f(v0[0]) * v0[1], silu_f(v0[2]) * v0[3]); w.y = cvt_pk_bf16(silu_f(v1[0]) * v1[1], silu_f(v1[2]) * v1[3]);
            *(u32x2*)(HID + ((size_t)u.pb * EROWS + row) * FF + j) = w; })
    }
};
struct EpiDown {
    static constexpr bool PERM = true;
    bf16_t* YS; const float* RA;
    __device__ __forceinline__ void operator()(AccRef acc, const Unit& u, int wr, int wc, int fr, int fq) const {
        PG8_FOR_PERM({ const int row = u.pm * 256 + tr, col = u.pn * 256 + tc; const float a = RA[u.pb * EROWS + row];
            u32x4 w; w.x = cvt_pk_bf16(v0[0] * a, v0[1] * a); w.y = cvt_pk_bf16(v0[2] * a, v0[3] * a); w.z = cvt_pk_bf16(v1[0] * a, v1[1] * a); w.w = cvt_pk_bf16(v1[2] * a, v1[3] * a);
            *(u32x4*)(YS + ((size_t)u.pb * EROWS + row) * DM + col) = w; })
    }
};
}

struct Params { const float* in[33]; float* out; unsigned char* ws; int ph_lo, ph_hi; };
enum { I_X = 0, I_C, I_CTX, I_CCTX, I_N1G, I_N2G, I_WADA, I_BADA, I_WIN, I_WOUT, I_SGUNG, I_SGUW, I_SGUB, I_QNG, I_WUQ, I_KVNG, I_WUKV,
       I_ARE, I_AIM, I_LOGDT, I_BRE, I_BIM, I_CRE, I_CIM, I_S5D, I_WGLU, I_BGLU, I_CONVW, I_WROUTER, I_WGATE, I_WUP, I_WDOWN, I_FNG };

__device__ __forceinline__ void transpose_tile(const float* src, int N, int k0, int n0, bf16_t* dst, int ldd, int rmul, int radd, int remap_kv, LAS float* tile) {
    const int tid = threadIdx.x;
#pragma unroll
    for (int i = 0; i < 2; ++i) { const int r = (tid >> 4) + 32 * i, c4 = (tid & 15) * 4;
        const f32x4 v = *(const f32x4*)(src + (size_t)(k0 + r) * N + n0 + c4);
        tile[r * 65 + c4 + 0] = v[0]; tile[r * 65 + c4 + 1] = v[1]; tile[r * 65 + c4 + 2] = v[2]; tile[r * 65 + c4 + 3] = v[3]; }
    __syncthreads();
    { const int n = tid >> 3, kc = tid & 7; float f[8];
#pragma unroll
        for (int j = 0; j < 8; ++j) f[j] = tile[(kc * 8 + j) * 65 + n];
        int nn = n0 + n; if (remap_kv) nn = ((nn & 255) < 128) ? ((nn >> 8) * 128 + (nn & 127)) : (512 + (nn >> 8) * 128 + (nn & 127));
        const int drow = nn * rmul + radd;
        u32x4 w; w.x = cvt_pk_bf16(f[0], f[1]); w.y = cvt_pk_bf16(f[2], f[3]); w.z = cvt_pk_bf16(f[4], f[5]); w.w = cvt_pk_bf16(f[6], f[7]);
        *(u32x4*)(dst + (size_t)drow * ldd + k0 + kc * 8) = w; }
    __syncthreads();
}
constexpr int N_ADA_UNITS = 96, N_S5T_UNITS = 16, N_ROPE_UNITS = 2;
constexpr int T_WIN = 32 * 59, T_WOUT = 32 * 32, T_WUQ = 6 * 12, T_WUKV = 4 * 16, T_WGLU = 8 * 8, T_EXP = 512;
constexpr int N_TR = 2 * (T_WIN + T_WOUT + T_WUQ + T_WUKV + T_WGLU) + 3 * 32 * T_EXP;
constexpr int N_PRO_ITEMS = N_ADA_UNITS + N_S5T_UNITS + N_ROPE_UNITS + N_TR;

__device__ __forceinline__ void ph_prologue(const Params& p, LAS unsigned char* lds) {
    const int tid = opaque_tid(), lane = tid & 63, wave = tid >> 6;
    unsigned char* ws = opaque_ptr(p.ws);
    for (int it = blockIdx.x; it < N_PRO_ITEMS; it += gridDim.x) {
        if (it < N_ADA_UNITS) {
            const int l = it / 48, cb = it % 48;
            LAS float* sil = (LAS float*)lds;
            LAS float* red = (LAS float*)(lds + 40960);
            for (int i = tid; i < 5 * DM; i += 512) { const int r = i >> 11, k = i & (DM - 1); const float v = r < 4 ? p.in[I_C][r * DM + k] : p.in[I_CCTX][k]; sil[i] = silu_f(v); }
            __syncthreads();
            f32x4 acc[5];
#pragma unroll
            for (int r = 0; r < 5; ++r) acc[r] = (f32x4){0.f, 0.f, 0.f, 0.f};
            const float* W = p.in[I_WADA] + (size_t)l * DM * 12288 + cb * 256 + lane * 4;
            for (int k = wave * 256; k < wave * 256 + 256; k += 8) {
                f32x4 w[8];
#pragma unroll
                for (int j = 0; j < 8; ++j) w[j] = *(const f32x4*)(W + (size_t)(k + j) * 12288);
#pragma unroll
                for (int j = 0; j < 8; ++j)
#pragma unroll
                    for (int r = 0; r < 5; ++r) acc[r] += sil[r * DM + k + j] * w[j];
            }
#pragma unroll
            for (int r = 0; r < 5; ++r)
#pragma unroll
                for (int j = 0; j < 4; ++j) red[(wave * 5 + r) * 256 + lane * 4 + j] = acc[r][j];
            __syncthreads();
            float* mod = (float*)(ws + WS_MOD);
            for (int o = tid; o < 5 * 256; o += 512) { const int r = o >> 8, cc = o & 255; float s = 0.f;
#pragma unroll
                for (int w8 = 0; w8 < 8; ++w8) s += red[(w8 * 5 + r) * 256 + cc];
                mod[(size_t)(l * 5 + r) * 12288 + cb * 256 + cc] = s + p.in[I_BADA][l * 12288 + cb * 256 + cc]; }
            __syncthreads();
        } else if (it < N_ADA_UNITS + N_S5T_UNITS) {
            const int idx = (it - N_ADA_UNITS) * 512 + tid;
            const float are = fminf(p.in[I_ARE][idx], -1e-4f), aim = p.in[I_AIM][idx];
            const float dt = expf(p.in[I_LOGDT][idx >> 6]);
            f32x2* PW = (f32x2*)(ws + WS_PW) + (size_t)idx * 17; f32x2* BB = (f32x2*)(ws + WS_BB) + (size_t)idx * 16;
            float abr = 0.f, abi = 0.f;
            for (int d = 0; d <= 16; ++d) { const double mag = exp((double)are * (double)dt * d); double sn, cs; sincos((double)aim * (double)dt * d, &sn, &cs);
                const f32x2 v = {(float)(mag * cs), (float)(mag * sn)}; PW[d] = v; if (d == 1) { abr = v.x; abi = v.y; } }
            const float xr = abr - 1.0f, xi = abi, den = 1.0f / (are * are + aim * aim);
            const float cr = (xr * are + xi * aim) * den, ci = (xi * are - xr * aim) * den;
            for (int c = 0; c < 16; ++c) { const float br = p.in[I_BRE][(size_t)idx * 16 + c], bi = p.in[I_BIM][(size_t)idx * 16 + c]; BB[c] = (f32x2){cr * br - ci * bi, cr * bi + ci * br}; }
        } else if (it < N_ADA_UNITS + N_S5T_UNITS + N_ROPE_UNITS) {
            const int idx = (it - N_ADA_UNITS - N_S5T_UNITS) * 512 + tid; const int pos = idx >> 4, f = idx & 15;
            const float invf = powf(10000.0f, -(float)f * 0.0625f); const float ang = (float)pos * invf;
            ((f32x2*)(ws + WS_ROPE))[idx] = (f32x2){cosf(ang), sinf(ang)};
        } else {
            int t = it - N_ADA_UNITS - N_S5T_UNITS - N_ROPE_UNITS;
            LAS float* tile = (LAS float*)lds;
            if (t < 2 * T_WIN) { const int l = t / T_WIN, r = t % T_WIN; transpose_tile(p.in[I_WIN] + (size_t)l * DM * INC, INC, (r % 32) * 64, (r / 32) * 64, (bf16_t*)(ws + WS_WTIN) + (size_t)l * INP * DM, DM, 1, 0, 0, tile); continue; }
            t -= 2 * T_WIN;
            if (t < 2 * T_WOUT) { const int l = t / T_WOUT, r = t % T_WOUT; transpose_tile(p.in[I_WOUT] + (size_t)l * DM * DM, DM, (r % 32) * 64, (r / 32) * 64, (bf16_t*)(ws + WS_WTOUT) + (size_t)l * DM * DM, DM, 1, 0, 0, tile); continue; }
            t -= 2 * T_WOUT;
            if (t < 2 * T_WUQ) { const int l = t / T_WUQ, r = t % T_WUQ; transpose_tile(p.in[I_WUQ] + (size_t)l * 384 * 768, 768, (r % 6) * 64, (r / 6) * 64, (bf16_t*)(ws + WS_WTUQ) + (size_t)l * 768 * 384, 384, 1, 0, 0, tile); continue; }
            t -= 2 * T_WUQ;
            if (t < 2 * T_WUKV) { const int l = t / T_WUKV, r = t % T_WUKV; transpose_tile(p.in[I_WUKV] + (size_t)l * 256 * 1024, 1024, (r % 4) * 64, (r / 4) * 64, (bf16_t*)(ws + WS_WTUKV) + (size_t)l * 1024 * 256, 256, 1, 0, 1, tile); continue; }
            t -= 2 * T_WUKV;
            if (t < 2 * T_WGLU) { const int l = t / T_WGLU, r = t % T_WGLU; transpose_tile(p.in[I_WGLU] + (size_t)l * 512 * 512, 512, (r % 8) * 64, (r / 8) * 64, (bf16_t*)(ws + WS_WTGLU) + (size_t)l * 512 * 512, 512, 1, 0, 0, tile); continue; }
            t -= 2 * T_WGLU;
            if (t < 32 * T_EXP) { const int le = t / T_EXP, r = t % T_EXP; transpose_tile(p.in[I_WGATE] + (size_t)le * DM * FF, FF, (r % 32) * 64, (r / 32) * 64, (bf16_t*)(ws + WS_WTGU) + (size_t)le * 2048 * DM, DM, 2, 0, 0, tile); continue; }
            t -= 32 * T_EXP;
            if (t < 32 * T_EXP) { const int le = t / T_EXP, r = t % T_EXP; transpose_tile(p.in[I_WUP] + (size_t)le * DM * FF, FF, (r % 32) * 64, (r / 32) * 64, (bf16_t*)(ws + WS_WTGU) + (size_t)le * 2048 * DM, DM, 2, 1, 0, tile); continue; }
            t -= 32 * T_EXP;
            { const int le = t / T_EXP, r = t % T_EXP; transpose_tile(p.in[I_WDOWN] + (size_t)le * FF * DM, DM, (r % 16) * 64, (r / 16) * 64, (bf16_t*)(ws + WS_WTDN) + (size_t)le * DM * FF, FF, 1, 0, 0, tile); }
        }
    }
}

__device__ __forceinline__ void rms_mod_store(const f32x4 (&x)[8], const float* g, const float* scale, const float* shift, bf16_t* orow, f32x4 (&y)[8], int lane) {
    float ss = 0.f;
#pragma unroll
    for (int j = 0; j < 8; ++j) ss += x[j][0] * x[j][0] + x[j][1] * x[j][1] + x[j][2] * x[j][2] + x[j][3] * x[j][3];
    ss = wave_sum(ss);
    const float rinv = rsqrtf(ss * (1.0f / DM) + EPS);
#pragma unroll
    for (int j = 0; j < 8; ++j) { const int c = j * 256 + lane * 4;
        const f32x4 gv = *(const f32x4*)(g + c), sc = *(const f32x4*)(scale + c), sh = *(const f32x4*)(shift + c);
        y[j] = x[j] * rinv * gv * (1.0f + sc) + sh;
        u32x2 w; w.x = cvt_pk_bf16(y[j][0], y[j][1]); w.y = cvt_pk_bf16(y[j][2], y[j][3]); *(u32x2*)(orow + c) = w; }
}

constexpr int N1_ROWITEMS = MT / 8, N1_KZ = 64, N1_WST = 1024, N1_INTER = 1024;
__device__ __forceinline__ void ph_norm1_tables(const Params& p) {
    const int tid = opaque_tid(), lane = tid & 63, wave = tid >> 6;
    unsigned char* ws = opaque_ptr(p.ws);
    const float* mod = (const float*)(ws + WS_MOD);
    for (int it = blockIdx.x; it < N1_ROWITEMS + N1_KZ + N1_WST + N1_INTER; it += gridDim.x) {
        if (it < N1_ROWITEMS) {
            const int row = it * 8 + wave; const int rr = row < NLAT ? (row >> 11) : 4;
            const float* xr = row < NLAT ? p.in[I_X] + (size_t)row * DM : p.in[I_CTX] + (size_t)(row - NLAT) * DM;
            f32x4 x[8], y[8];
#pragma unroll
            for (int j = 0; j < 8; ++j) x[j] = *(const f32x4*)(xr + j * 256 + lane * 4);
            const float* m = mod + (size_t)rr * 12288;
            rms_mod_store(x, p.in[I_N1G], m + DM, m, (bf16_t*)(ws + WS_H) + (size_t)row * DM, y, lane);
        } else if (it < N1_ROWITEMS + N1_KZ) {
            const int idx = (it - N1_ROWITEMS) * 512 + tid; const int c = idx & 15, d = (idx >> 4) & 15, lzg = idx >> 8;
            const f32x2* PW = (const f32x2*)(ws + WS_PW) + (size_t)lzg * 64 * 17; const f32x4* BB4 = (const f32x4*)((const f32x2*)(ws + WS_BB) + (size_t)lzg * 64 * 16);
            const float* cre = p.in[I_CRE] + ((size_t)lzg * 16 + c) * 64; const float* cim = p.in[I_CIM] + ((size_t)lzg * 16 + c) * 64;
            float acc16[16];
#pragma unroll
            for (int q = 0; q < 16; ++q) acc16[q] = 0.f;
            for (int n = 0; n < 64; ++n) { const f32x2 pw = PW[n * 17 + d]; const float cr = cre[n], ci = cim[n]; const float tr = cr * pw.x - ci * pw.y, ti = cr * pw.y + ci * pw.x;
#pragma unroll
                for (int q = 0; q < 8; ++q) { const f32x4 bb = BB4[n * 8 + q]; acc16[2 * q] += tr * bb[0] - ti * bb[1]; acc16[2 * q + 1] += tr * bb[2] - ti * bb[3]; } }
            float* KZ = (float*)(ws + WS_KZ) + ((size_t)(lzg * 16 + d) * 16 + c) * 16;
#pragma unroll
            for (int q = 0; q < 4; ++q) *(f32x4*)(KZ + 4 * q) = (f32x4){acc16[4 * q], acc16[4 * q + 1], acc16[4 * q + 2], acc16[4 * q + 3]};
        } else if (it < N1_ROWITEMS + N1_KZ + N1_WST) {
            const int idx = (it - N1_ROWITEMS - N1_KZ) * 512 + tid; const int c8 = (idx & 1) * 8, pp = (idx >> 1) & 15, row = (idx >> 5) & 255, lg = idx >> 13;
            const int l = lg >> 5, g = lg & 31, z = row >> 7, ri = (row >> 6) & 1, n = row & 63;
            const size_t lzgn = (((size_t)l * 2 + z) * 32 + g) * 64 + n;
            const f32x2 pw = ((const f32x2*)(ws + WS_PW))[lzgn * 17 + (z == 0 ? 15 - pp : pp)]; const f32x2* BB = (const f32x2*)(ws + WS_BB) + lzgn * 16 + c8;
            float f[8];
#pragma unroll
            for (int j = 0; j < 8; ++j) { const f32x2 bb = BB[j]; f[j] = ri == 0 ? (pw.x * bb.x - pw.y * bb.y) : (pw.x * bb.y + pw.y * bb.x); }
            u32x4 w; w.x = cvt_pk_bf16(f[0], f[1]); w.y = cvt_pk_bf16(f[2], f[3]); w.z = cvt_pk_bf16(f[4], f[5]); w.w = cvt_pk_bf16(f[6], f[7]);
            *(u32x4*)((bf16_t*)(ws + WS_WST) + ((size_t)lg * 256 + row) * 256 + pp * 16 + c8) = w;
        } else {
            const int idx = (it - N1_ROWITEMS - N1_KZ - N1_WST) * 512 + tid; const int n8 = (idx & 7) * 8, ri = (idx >> 3) & 1, z = (idx >> 4) & 1, row = (idx >> 5) & 255, lg = idx >> 13;
            const int l = lg >> 5, g = lg & 31, pp = row >> 4, c = row & 15;
            const size_t lzg = ((size_t)l * 2 + z) * 32 + g;
            const f32x2* PW = (const f32x2*)(ws + WS_PW) + (lzg * 64 + n8) * 17 + (z == 0 ? pp + 1 : 16 - pp);
            const float* cre = p.in[I_CRE] + (lzg * 16 + c) * 64 + n8; const float* cim = p.in[I_CIM] + (lzg * 16 + c) * 64 + n8;
            float f[8];
#pragma unroll
            for (int j = 0; j < 8; ++j) { const f32x2 pw = PW[j * 17]; const float cr = cre[j], ci = cim[j]; f[j] = ri == 0 ? (cr * pw.x - ci * pw.y) : -(cr * pw.y + ci * pw.x); }
            u32x4 w; w.x = cvt_pk_bf16(f[0], f[1]); w.y = cvt_pk_bf16(f[2], f[3]); w.z = cvt_pk_bf16(f[4], f[5]); w.w = cvt_pk_bf16(f[6], f[7]);
            *(u32x4*)((bf16_t*)(ws + WS_G2B) + ((size_t)lg * 256 + row) * 512 + 256 + z * 128 + ri * 64 + n8) = w;
        }
    }
}

constexpr int B_ROWITEMS = MT / 8, B_SGU = 72 * 4, B_INTRA = 512;
__device__ __forceinline__ void ph_rowsplit(const Params& p, int l, LAS unsigned char* lds) {
    const int tid = opaque_tid(), lane = tid & 63, wave = tid >> 6;
    unsigned char* ws = opaque_ptr(p.ws);
    const bf16_t* P = (const bf16_t*)(ws + WS_PA);
    bf16_t* CAT = (bf16_t*)(ws + WS_CAT);
    for (int it0 = blockIdx.x; it0 < B_ROWITEMS + B_SGU + B_INTRA; it0 += gridDim.x) {
        const int it = it0 < B_SGU ? B_ROWITEMS + it0 : (it0 < B_SGU + B_ROWITEMS ? it0 - B_SGU : it0);
        if (it < B_ROWITEMS) {
            const int row = it * 8 + wave; const bf16_t* pr = P + (size_t)row * INP;
            const bool lat = row < NLAT; const int t = lat ? (row & (SEQ - 1)) : ((row - NLAT) & (CTX - 1)); const int b = lat ? (row >> 11) : ((row - NLAT) >> 8);
            const int seqlen = lat ? SEQ : CTX;
            { float f[8]; float ss = 0.f;
              if (lane < 48) { const u32x4 v = *(const u32x4*)(pr + C_CQ + lane * 8); f[0] = bflo(v.x); f[1] = bfhi(v.x); f[2] = bflo(v.y); f[3] = bfhi(v.y); f[4] = bflo(v.z); f[5] = bfhi(v.z); f[6] = bflo(v.w); f[7] = bfhi(v.w);
#pragma unroll
                  for (int j = 0; j < 8; ++j) ss += f[j] * f[j]; }
              else {
#pragma unroll
                  for (int j = 0; j < 8; ++j) f[j] = 0.f; }
              ss = wave_sum(ss); const float rinv = rsqrtf(ss * (1.0f / 384.0f) + EPS);
              if (lane < 48) { const float* g = p.in[I_QNG] + l * 384 + lane * 8; u32x4 w;
                  w.x = cvt_pk_bf16(f[0] * rinv * g[0], f[1] * rinv * g[1]); w.y = cvt_pk_bf16(f[2] * rinv * g[2], f[3] * rinv * g[3]);
                  w.z = cvt_pk_bf16(f[4] * rinv * g[4], f[5] * rinv * g[5]); w.w = cvt_pk_bf16(f[6] * rinv * g[6], f[7] * rinv * g[7]);
                  *(u32x4*)((bf16_t*)(ws + WS_QA) + (size_t)row * 384 + lane * 8) = w; } }
            { const u32x2 v = *(const u32x2*)(pr + C_CKV + lane * 4); const float f0 = bflo(v.x), f1 = bfhi(v.x), f2 = bflo(v.y), f3 = bfhi(v.y);
              const float ss = wave_sum(f0 * f0 + f1 * f1 + f2 * f2 + f3 * f3); const float rinv = rsqrtf(ss * (1.0f / 256.0f) + EPS);
              const float* g = p.in[I_KVNG] + l * 256 + lane * 4; u32x2 w; w.x = cvt_pk_bf16(f0 * rinv * g[0], f1 * rinv * g[1]); w.y = cvt_pk_bf16(f2 * rinv * g[2], f3 * rinv * g[3]);
              *(u32x2*)((bf16_t*)(ws + WS_KVA) + (size_t)row * 256 + lane * 4) = w; }
            { float v = bf2f(pr[C_KR + lane]); const float partner = __shfl_xor(v, 16);
              if (lat) { const int jj = lane & 31, fi = jj & 15; const int pos = lane >= 32 ? (t & 63) : (t >> 6);
                  const f32x2 r = ((const f32x2*)(ws + WS_ROPE))[pos * 16 + fi]; const float cs = r.x, sn = r.y;
                  v = jj < 16 ? (v * cs - partner * sn) : (v * cs + partner * sn); }
              const int key = lat ? CTX + t : t; const unsigned short o = f2bf(v);
              bf16_t* kc = (bf16_t*)(ws + WS_KC);
#pragma unroll
              for (int h = 0; h < 4; ++h) kc[((size_t)(b * 4 + h) * NKEY + key) * 192 + 128 + lane] = o; }
            { const u32x4 v = *(const u32x4*)(pr + C_S5 + lane * 8); const int g = lane >> 1, half = lane & 1;
              *(u32x4*)((bf16_t*)(ws + WS_UPK) + ((size_t)g * 768 + (row >> 4)) * 512 + (row & 15) * 16 + half * 8) = v; }
            { const int c0 = lane * 8; float zp[8], zc[8], zn[8];
#pragma unroll
              for (int j = 0; j < 8; ++j) { zp[j] = 0.f; zn[j] = 0.f; }
#define CONV_Z(dst, rp) do { const u32x4 a_ = *(const u32x4*)((rp) + C_CVC + c0); const u32x4 h_ = *(const u32x4*)((rp) + C_CVH + c0); \
                  dst[0] = bflo(a_.x) * bflo(h_.x); dst[1] = bfhi(a_.x) * bfhi(h_.x); dst[2] = bflo(a_.y) * bflo(h_.y); dst[3] = bfhi(a_.y) * bfhi(h_.y); \
                  dst[4] = bflo(a_.z) * bflo(h_.z); dst[5] = bfhi(a_.z) * bfhi(h_.z); dst[6] = bflo(a_.w) * bflo(h_.w); dst[7] = bfhi(a_.w) * bfhi(h_.w); } while (0)
              CONV_Z(zc, pr);
              if (t > 0) CONV_Z(zp, pr - INP);
              if (t < seqlen - 1) CONV_Z(zn, pr + INP);
#undef CONV_Z
              const u32x4 bg = *(const u32x4*)(pr + C_CVB + c0); float bgf[8] = {bflo(bg.x), bfhi(bg.x), bflo(bg.y), bfhi(bg.y), bflo(bg.z), bfhi(bg.z), bflo(bg.w), bfhi(bg.w)};
              const float* cw = p.in[I_CONVW] + (size_t)l * 3 * 512 + c0; float o[8];
#pragma unroll
              for (int j = 0; j < 8; ++j) o[j] = bgf[j] * (cw[j] * zp[j] + cw[512 + j] * zc[j] + cw[1024 + j] * zn[j]);
              u32x4 w; w.x = cvt_pk_bf16(o[0], o[1]); w.y = cvt_pk_bf16(o[2], o[3]); w.z = cvt_pk_bf16(o[4], o[5]); w.w = cvt_pk_bf16(o[6], o[7]);
              *(u32x4*)(CAT + (size_t)row * DM + 1536 + c0) = w; }
        } else if (it < B_ROWITEMS + B_SGU) {
            const int un = it - B_ROWITEMS, cc = un >> 2, h = un & 3; const int row0 = cc * 128;
            LAS bf16_t* Wl = (LAS bf16_t*)lds;
            LAS bf16_t* Vl = (LAS bf16_t*)(lds + 128 * 136 * 2);
            const float* Wg = p.in[I_SGUW] + ((size_t)l * 4 + h) * 128 * 128;
#pragma unroll
            for (int i = 0; i < 8; ++i) { const int e4 = (i * 512 + tid) * 4, r = e4 >> 7, c = e4 & 127; const f32x4 v = *(const f32x4*)(Wg + e4);
                u32x2 w; w.x = cvt_pk_bf16(v[0], v[1]); w.y = cvt_pk_bf16(v[2], v[3]); *(LAS u32x2*)(Wl + r * 136 + c) = w; }
            u32x4 vv[16];
#pragma unroll
            for (int qi = 0; qi < 16; ++qi) vv[qi] = *(const u32x4*)(P + (size_t)(row0 + wave * 16 + qi) * INP + C_SGU_V + lane * 8);
#pragma unroll
            for (int qi = 0; qi < 16; ++qi) { const int q = wave * 16 + qi;
                const u32x4 v = vv[qi]; float f[8] = {bflo(v.x), bfhi(v.x), bflo(v.y), bfhi(v.y), bflo(v.z), bfhi(v.z), bflo(v.w), bfhi(v.w)}; float ss = 0.f;
#pragma unroll
                for (int j = 0; j < 8; ++j) { f[j] = gelu_tanh(f[j]); ss += f[j] * f[j]; }
                ss = wave_sum(ss); const float rinv = rsqrtf(ss * (1.0f / 512.0f) + EPS);
                if ((lane >> 4) == h) { const int c0 = (lane & 15) * 8; const float* g = p.in[I_SGUNG] + l * 512 + h * 128 + c0;
#pragma unroll
                    for (int j = 0; j < 8; ++j) Vl[(c0 + j) * 136 + q] = f2bf(f[j] * rinv * g[j]); } }
            __syncthreads();
            { const int fr = lane & 15, fq = lane >> 4; f32x4 acc[8];
#pragma unroll
              for (int nb = 0; nb < 8; ++nb) acc[nb] = (f32x4){0.f, 0.f, 0.f, 0.f};
#pragma unroll
              for (int ks = 0; ks < 4; ++ks) { const bf16x8 af = *(const LAS bf16x8*)(Wl + (wave * 16 + fr) * 136 + ks * 32 + fq * 8);
#pragma unroll
                  for (int nb = 0; nb < 8; ++nb) { const bf16x8 bfr = *(const LAS bf16x8*)(Vl + (nb * 16 + fr) * 136 + ks * 32 + fq * 8);
                      acc[nb] = __builtin_amdgcn_mfma_f32_16x16x32_bf16(bfr, af, acc[nb], 0, 0, 0); } }
              const int pp = wave * 16 + fr; const float bias = p.in[I_SGUB][((size_t)l * 4 + h) * 128 + pp]; const bf16_t* pr = P + (size_t)(row0 + pp) * INP + C_SGU_U + h * 128;
#pragma unroll
              for (int nb = 0; nb < 8; ++nb) { const int c = nb * 16 + 4 * fq; const u32x2 uv = *(const u32x2*)(pr + c);
                  u32x2 w; w.x = cvt_pk_bf16(gelu_tanh(bflo(uv.x)) * (acc[nb][0] + bias), gelu_tanh(bfhi(uv.x)) * (acc[nb][1] + bias));
                  w.y = cvt_pk_bf16(gelu_tanh(bflo(uv.y)) * (acc[nb][2] + bias), gelu_tanh(bfhi(uv.y)) * (acc[nb][3] + bias));
                  *(u32x2*)(CAT + (size_t)(row0 + pp) * DM + h * 128 + c) = w; } }
            __syncthreads();
        } else {
            const int idx = (it - B_ROWITEMS - B_SGU) * 512 + tid; const int c8 = (idx & 1) * 8, pq = (idx >> 1) & 15, row = (idx >> 5) & 255, g = idx >> 13;
            const int pp = row >> 4, c = row & 15;
            const float* KZf = (const float*)(ws + WS_KZ) + (((size_t)l * 2 + 0) * 32 + g) * 4096; const float* KZb = (const float*)(ws + WS_KZ) + (((size_t)l * 2 + 1) * 32 + g) * 4096;
            float f[8];
#pragma unroll
            for (int j = 0; j < 8; ++j) { float v = 0.f; if (pq <= pp) v += KZf[((pp - pq) * 16 + c) * 16 + c8 + j]; if (pq >= pp) v += KZb[((pq - pp) * 16 + c) * 16 + c8 + j];
                if (pq == pp && c8 + j == c) v += p.in[I_S5D][l * 512 + g * 16 + c]; f[j] = v; }
            u32x4 w; w.x = cvt_pk_bf16(f[0], f[1]); w.y = cvt_pk_bf16(f[2], f[3]); w.z = cvt_pk_bf16(f[4], f[5]); w.w = cvt_pk_bf16(f[6], f[7]);
            *(u32x4*)((bf16_t*)(ws + WS_G2B) + (((size_t)l * 32 + g) * 256 + row) * 512 + pq * 16 + c8) = w;
        }
    }
}

constexpr int KPITCH = 400, VPITCH = 144;
constexpr int KT_BYTES = 64 * KPITCH, VT_BYTES = 128 * VPITCH;
__device__ __forceinline__ void attn_unit(const bf16_t* Qrows  , const bf16_t* Kbh, const bf16_t* Vbh, int nkeys, bf16_t* Orows, LAS unsigned char* lds) {
    const int tid = opaque_tid(), lane = tid & 63, wave = tid >> 6, fr = lane & 15, fq = lane >> 4;
    LAS unsigned char* Kb[2] = {lds, lds + KT_BYTES + VT_BYTES};
    LAS unsigned char* Vb[2] = {lds + KT_BYTES, lds + 2 * KT_BYTES + VT_BYTES};
    bf16x8 qf[6];
    { const bf16_t* qr = Qrows + (size_t)(wave * 16 + fr) * 768 + fq * 8;
#pragma unroll
      for (int ks = 0; ks < 6; ++ks) qf[ks] = *(const bf16x8*)(qr + ks * 32); }
    f32x4 o[8];
#pragma unroll
    for (int db = 0; db < 8; ++db) o[db] = (f32x4){0.f, 0.f, 0.f, 0.f};
    float mrow = -1e30f, lsum = 0.f;
    const int nt = nkeys / 64;
    u32x4 kreg[3], vreg[2];
#define ATT_LOADG(tile) do { const char* kg = (const char*)(Kbh + (size_t)(tile) * 64 * 192); \
        _Pragma("unroll") for (int i = 0; i < 3; ++i) kreg[i] = *(const u32x4*)(kg + (size_t)(i * 512 + tid) * 16); \
        _Pragma("unroll") for (int i = 0; i < 2; ++i) { const int pc = i * 512 + tid; vreg[i] = *(const u32x4*)((const char*)(Vbh + (size_t)(pc >> 3) * NKEY + (tile) * 64) + (pc & 7) * 16); } } while (0)
#define ATT_STOREL(buf) do { \
        _Pragma("unroll") for (int i = 0; i < 3; ++i) { const int pc = i * 512 + tid; *(LAS u32x4*)(Kb[buf] + (pc / 24) * KPITCH + (pc % 24) * 16) = kreg[i]; } \
        _Pragma("unroll") for (int i = 0; i < 2; ++i) { const int pc = i * 512 + tid; *(LAS u32x4*)(Vb[buf] + (pc >> 3) * VPITCH + (pc & 7) * 16) = vreg[i]; } } while (0)
    ATT_LOADG(0); ATT_STOREL(0);
    __syncthreads();
    for (int j = 0; j < nt; ++j) {
        const int cur = j & 1;
        if (j + 1 < nt) ATT_LOADG(j + 1);
        f32x4 s[4];
#pragma unroll
        for (int kb = 0; kb < 4; ++kb) { s[kb] = (f32x4){0.f, 0.f, 0.f, 0.f};
#pragma unroll
            for (int ks = 0; ks < 6; ++ks) { const bf16x8 kf = *(const LAS bf16x8*)(Kb[cur] + (kb * 16 + fr) * KPITCH + ks * 64 + fq * 16);
                s[kb] = __builtin_amdgcn_mfma_f32_16x16x32_bf16(kf, qf[ks], s[kb], 0, 0, 0); } }
        float mx = s[0][0];
#pragma unroll
        for (int kb = 0; kb < 4; ++kb)
#pragma unroll
            for (int r = 0; r < 4; ++r) mx = fmaxf(mx, s[kb][r]);
        mx = fmaxf(mx, __shfl_xor(mx, 16)); mx = fmaxf(mx, __shfl_xor(mx, 32));
        const float mnew = fmaxf(mrow, mx), alpha = exp2f(mrow - mnew); mrow = mnew;
        float ps = 0.f;
#pragma unroll
        for (int kb = 0; kb < 4; ++kb)
#pragma unroll
            for (int r = 0; r < 4; ++r) { s[kb][r] = exp2f(s[kb][r] - mnew); ps += s[kb][r]; }
        lsum = lsum * alpha + ps;
#pragma unroll
        for (int db = 0; db < 8; ++db) o[db] *= alpha;
#pragma unroll
        for (int sidx = 0; sidx < 2; ++sidx) {
            u32x4 pw; pw.x = cvt_pk_bf16(s[2 * sidx][0], s[2 * sidx][1]); pw.y = cvt_pk_bf16(s[2 * sidx][2], s[2 * sidx][3]);
            pw.z = cvt_pk_bf16(s[2 * sidx + 1][0], s[2 * sidx + 1][1]); pw.w = cvt_pk_bf16(s[2 * sidx + 1][2], s[2 * sidx + 1][3]);
            const bf16x8 pf = __builtin_bit_cast(bf16x8, pw);
#pragma unroll
            for (int db = 0; db < 8; ++db) { const LAS unsigned char* vp = Vb[cur] + (db * 16 + fr) * VPITCH + sidx * 64 + fq * 8;
                u32x4 vw; const u32x2 lo = *(const LAS u32x2*)vp, hi = *(const LAS u32x2*)(vp + 32); vw.x = lo.x; vw.y = lo.y; vw.z = hi.x; vw.w = hi.y;
                o[db] = __builtin_amdgcn_mfma_f32_16x16x32_bf16(__builtin_bit_cast(bf16x8, vw), pf, o[db], 0, 0, 0); } }
        if (j + 1 < nt) ATT_STOREL(cur ^ 1);
        __syncthreads();
    }
#undef ATT_LOADG
#undef ATT_STOREL
    lsum += __shfl_xor(lsum, 16); lsum += __shfl_xor(lsum, 32);
    const float inv = 1.0f / lsum;
    bf16_t* orow = Orows + (size_t)(wave * 16 + fr) * DM;
#pragma unroll
    for (int db = 0; db < 8; ++db) { u32x2 w; w.x = cvt_pk_bf16(o[db][0] * inv, o[db][1] * inv); w.y = cvt_pk_bf16(o[db][2] * inv, o[db][3] * inv); *(u32x2*)(orow + db * 16 + 4 * fq) = w; }
}
__device__ __forceinline__ void ph_attn_carry(const Params& p, int l, LAS unsigned char* lds) {
    unsigned char* ws = opaque_ptr(p.ws); const int tid = opaque_tid();
    const int natt = (l == 0) ? 288 : 256;
    const bf16_t* QB = (const bf16_t*)(ws + WS_QB); const bf16_t* KC = (const bf16_t*)(ws + WS_KC); const bf16_t* VT = (const bf16_t*)(ws + WS_VT); bf16_t* CAT = (bf16_t*)(ws + WS_CAT);
    for (int it = blockIdx.x; it < natt + 32; it += gridDim.x) {
        if (it < natt) {
            int b, h, row0, nkeys;
            if (it < 256) { b = it >> 6; h = (it >> 4) & 3; row0 = b * SEQ + (it & 15) * 128; nkeys = NKEY; }
            else { const int u = it - 256; b = u >> 3; h = (u >> 1) & 3; row0 = NLAT + b * CTX + (u & 1) * 128; nkeys = CTX; }
            attn_unit(QB + (size_t)row0 * 768 + h * 192, KC + (size_t)(b * 4 + h) * NKEY * 192, VT + (size_t)(b * 4 + h) * 128 * NKEY, nkeys, CAT + (size_t)row0 * DM + 512 + h * 128, lds);
        } else {
            const int g = it - natt; const int z = tid >> 8, b = (tid >> 6) & 3, n = tid & 63;
            const f32x2 a16 = ((const f32x2*)(ws + WS_PW))[((((size_t)l * 2 + z) * 32 + g) * 64 + n) * 17 + 16];
            const float* EST = (const float*)(ws + WS_EST) + (size_t)g * 768 * 256 + z * 128 + n;
            bf16_t* UP = (bf16_t*)(ws + WS_UPK) + (size_t)g * 768 * 512 + 256 + z * 128 + n;
            float sr = 0.f, si = 0.f;
            for (int st = 0; st < 144; ++st) {
                int chunk;
                if (z == 0) chunk = st < 16 ? (512 + b * 16 + st) : (b * 128 + (st - 16));
                else        chunk = st < 16 ? (512 + b * 16 + (15 - st)) : (b * 128 + (143 - st));
                UP[(size_t)chunk * 512] = f2bf(sr); UP[(size_t)chunk * 512 + 64] = f2bf(si);
                const float er = EST[(size_t)chunk * 256], ei = EST[(size_t)chunk * 256 + 64];
                const float nr = a16.x * sr - a16.y * si + er, ni = a16.x * si + a16.y * sr + ei; sr = nr; si = ni;
            }
        }
    }
}

__device__ __forceinline__ void ph_norm2_router(const Params& p, int l, LAS unsigned char* lds) {
    const int tid = opaque_tid(), lane = tid & 63, wave = tid >> 6;
    unsigned char* ws = opaque_ptr(p.ws); const float* mod = (const float*)(ws + WS_MOD) + (size_t)l * 5 * 12288;
    const int nrows = (l == 0) ? MT : NLAT;
    const float* WR = p.in[I_WROUTER] + (size_t)l * DM * NE;
    for (int idx = tid; idx < DM * 4; idx += 512) { const int c = idx >> 2, e4 = idx & 3; const f32x4 v = *(const f32x4*)(WR + (size_t)c * NE + e4 * 4);
        *(LAS f32x4*)(lds + (size_t)(((e4 * 2 + (c & 1)) * 1024 + (c >> 1)) * 16)) = v; }
    __syncthreads();
    const float* n2g = p.in[I_N2G] + l * DM;
    for (int it = blockIdx.x; it < nrows / 8; it += gridDim.x) {
        const int row = it * 8 + wave; const int rr = row < NLAT ? (row >> 11) : 4;
        const float* xr = (const float*)(ws + WS_XB) + (size_t)row * DM;
        const float* m = mod + (size_t)rr * 12288;
        f32x2 x[16], gv[16], sc[16], sh[16];
#pragma unroll
        for (int j = 0; j < 16; ++j) { const int c = j * 128 + lane * 2; x[j] = *(const f32x2*)(xr + c); gv[j] = *(const f32x2*)(n2g + c); sc[j] = *(const f32x2*)(m + 4 * DM + c); sh[j] = *(const f32x2*)(m + 3 * DM + c); }
        float ss = 0.f;
#pragma unroll
        for (int j = 0; j < 16; ++j) ss += x[j].x * x[j].x + x[j].y * x[j].y;
        ss = wave_sum(ss); const float rinv = rsqrtf(ss * (1.0f / DM) + EPS);
        bf16_t* orow = (bf16_t*)(ws + WS_H) + (size_t)row * DM;
        f32x4 lg[4];
#pragma unroll
        for (int e4 = 0; e4 < 4; ++e4) lg[e4] = (f32x4){0.f, 0.f, 0.f, 0.f};
#pragma unroll
        for (int j = 0; j < 16; ++j) { const f32x2 y = x[j] * rinv * gv[j] * (1.0f + sc[j]) + sh[j];
            *(unsigned*)(orow + j * 128 + lane * 2) = cvt_pk_bf16(y.x, y.y);
#pragma unroll
            for (int e4 = 0; e4 < 4; ++e4) { const f32x4 w0 = *(const LAS f32x4*)(lds + (size_t)(((e4 * 2 + 0) * 1024 + j * 64 + lane) * 16)); const f32x4 w1 = *(const LAS f32x4*)(lds + (size_t)(((e4 * 2 + 1) * 1024 + j * 64 + lane) * 16));
                lg[e4] += y.x * w0 + y.y * w1; } }
        float lgs[16]; float mx = -1e30f;
#pragma unroll
        for (int e = 0; e < 16; ++e) { lgs[e] = wave_sum(lg[e >> 2][e & 3]); mx = fmaxf(mx, lgs[e]); }
        float se = 0.f;
#pragma unroll
        for (int e = 0; e < 16; ++e) { lgs[e] = __expf(lgs[e] - mx); se += lgs[e]; }
        const float inv = 1.0f / se;
        float mine = 0.f;
#pragma unroll
        for (int e = 0; e < 16; ++e) mine = (lane == e) ? lgs[e] * inv : mine;
        if (lane < 16) ((float*)(ws + WS_AFF))[(size_t)row * 16 + lane] = mine;
    }
}

__device__ __forceinline__ void ph_topk(const Params& p, int l, LAS unsigned char* lds) {
    const int tid = opaque_tid(), lane = tid & 63, wave = tid >> 6;
    unsigned char* ws = opaque_ptr(p.ws); const float* AFF = (const float*)(ws + WS_AFF);
    int* ROWTOK = (int*)(ws + WS_ROWTOK); float* ROWAFF = (float*)(ws + WS_ROWAFF); int* INV = (int*)(ws + WS_INV);
    LAS int* hist = (LAS int*)lds;
    LAS int* ctl = (LAS int*)(lds + 1024);
    LAS int* wsum = (LAS int*)(lds + 1280);
    const int nunits = (l == 0) ? 128 : 64;
    for (int it = blockIdx.x; it < nunits; it += gridDim.x) {
        const bool lat = it < 64; const int u = lat ? it : it - 64; const int b = u >> 4, e = u & 15;
        const int n = lat ? SEQ : CTX, cap = lat ? CAPL : CAPC;
        const int tok0 = lat ? b * SEQ : NLAT + b * CTX; const int rowbase = lat ? b * CAPL : 1024 + b * CAPC;
        unsigned key[4];
#pragma unroll
        for (int j = 0; j < 4; ++j) { const int t = tid * 4 + j; key[j] = t < n ? __float_as_uint(AFF[(size_t)(tok0 + t) * 16 + e]) : 0u; }
        unsigned prefix = 0u; int remaining = cap;
        for (int pass = 3; pass >= 0; --pass) {
            if (tid < 256) hist[tid] = 0;
            __syncthreads();
#pragma unroll
            for (int j = 0; j < 4; ++j) { const int t = tid * 4 + j; if (t < n) { const bool match = (pass == 3) || ((key[j] >> (8 * (pass + 1))) == (prefix >> (8 * (pass + 1)))); if (match) atomicAdd((int*)&hist[(key[j] >> (8 * pass)) & 255u], 1); } }
            __syncthreads();
            if (wave == 0) {
                const int b0 = hist[4 * lane], b1 = hist[4 * lane + 1], b2 = hist[4 * lane + 2], b3 = hist[4 * lane + 3];
                const int s = b0 + b1 + b2 + b3; int suf = s;
#pragma unroll
                for (int off = 1; off < 64; off <<= 1) { const int t = __shfl_down(suf, off); if (lane + off < 64) suf += t; }
                const int above = suf - s; const int c3 = above + b3, c2 = c3 + b2, c1 = c2 + b1, c0 = c1 + b0;
                if (above < remaining && c0 >= remaining) { int dg, nr;
                    if (c3 >= remaining) { dg = 4 * lane + 3; nr = remaining - above; } else if (c2 >= remaining) { dg = 4 * lane + 2; nr = remaining - c3; }
                    else if (c1 >= remaining) { dg = 4 * lane + 1; nr = remaining - c2; } else { dg = 4 * lane; nr = remaining - c1; }
                    ctl[0] = dg; ctl[1] = nr; }
            }
            __syncthreads();
            prefix |= ((unsigned)ctl[0]) << (8 * pass); remaining = ctl[1];
            __syncthreads();
        }
        int cgt = 0, ceq = 0;
#pragma unroll
        for (int j = 0; j < 4; ++j) { const int t = tid * 4 + j; if (t < n) { cgt += key[j] > prefix ? 1 : 0; ceq += key[j] == prefix ? 1 : 0; } }
        const int packed = cgt | (ceq << 16);
        int inc = packed;
#pragma unroll
        for (int off = 1; off < 64; off <<= 1) { const int t = __shfl_up(inc, off); if (lane >= off) inc += t; }
        if (lane == 63) wsum[wave] = inc;
        __syncthreads();
        int base = 0;
#pragma unroll
        for (int w8 = 0; w8 < 8; ++w8) base += (w8 < wave) ? wsum[w8] : 0;
        int excl = base + inc - packed; int egt = excl & 0xffff, eeq = excl >> 16;
#pragma unroll
        for (int j = 0; j < 4; ++j) { const int t = tid * 4 + j; if (t < n) {
                const bool gt = key[j] > prefix, eq = key[j] == prefix; const bool sel = gt || (eq && eeq < remaining);
                const int slot = egt + (eeq < remaining ? eeq : remaining);
                if (sel) { ROWTOK[e * EROWS + rowbase + slot] = tok0 + t; ROWAFF[e * EROWS + rowbase + slot] = __uint_as_float(key[j]); }
                INV[(size_t)(tok0 + t) * 16 + e] = sel ? rowbase + slot : -1;
                egt += gt ? 1 : 0; eeq += eq ? 1 : 0; } }
        __syncthreads();
    }
}

__device__ __forceinline__ void ph_gather(const Params& p, int l) {
    const int tid = opaque_tid(), lane = tid & 63, wave = tid >> 6;
    unsigned char* ws = opaque_ptr(p.ws); const int* ROWTOK = (const int*)(ws + WS_ROWTOK);
    const int rows_per_e = (l == 0) ? 1152 : 1024;
    const int nitems = NE * rows_per_e / 8;
    for (int it = blockIdx.x; it < nitems; it += gridDim.x) {
        const int ridx = it * 8 + wave; const int e = ridx / rows_per_e, r = ridx % rows_per_e;
        const int tok = ROWTOK[e * EROWS + r];
        const u32x4* src = (const u32x4*)((const bf16_t*)(ws + WS_H) + (size_t)tok * DM); u32x4* dst = (u32x4*)((bf16_t*)(ws + WS_PA) + ((size_t)e * EROWS + r) * DM);
#pragma unroll
        for (int j = 0; j < 4; ++j) dst[j * 64 + lane] = src[j * 64 + lane];
    }
}

__device__ __forceinline__ void ph_combine(const Params& p, int l) {
    const int tid = opaque_tid(), lane = tid & 63, wave = tid >> 6;
    unsigned char* ws = opaque_ptr(p.ws); const float* mod = (const float*)(ws + WS_MOD);
    const int nrows = (l == 0) ? MT : NLAT;
    const int* INV = (const int*)(ws + WS_INV); const bf16_t* YS = (const bf16_t*)(ws + WS_YS);
    for (int it = blockIdx.x; it < nrows / 8; it += gridDim.x) {
        const int row = it * 8 + wave; const int rr = row < NLAT ? (row >> 11) : 4;
        const float* xr = (const float*)(ws + WS_XB) + (size_t)row * DM;
        f32x4 x[8], s[8], y[8];
#pragma unroll
        for (int j = 0; j < 8; ++j) { x[j] = *(const f32x4*)(xr + j * 256 + lane * 4); s[j] = (f32x4){0.f, 0.f, 0.f, 0.f}; }
        const int myinv = lane < 16 ? INV[(size_t)row * 16 + lane] : -1;
        unsigned msk = (unsigned)__ballot(myinv >= 0);
        while (msk) {
            const int e0 = __builtin_ctz(msk); msk &= msk - 1; const bool two = msk != 0u; const int e1 = two ? __builtin_ctz(msk) : e0; if (two) msk &= msk - 1;
            const int r0 = __shfl(myinv, e0), r1 = __shfl(myinv, e1);
            const bf16_t* y0 = YS + ((size_t)e0 * EROWS + r0) * DM; const bf16_t* y1 = YS + ((size_t)e1 * EROWS + r1) * DM;
            u32x2 v0[8], v1[8];
#pragma unroll
            for (int j = 0; j < 8; ++j) { v0[j] = *(const u32x2*)(y0 + j * 256 + lane * 4); v1[j] = *(const u32x2*)(y1 + j * 256 + lane * 4); }
            const float f1 = two ? 1.0f : 0.0f;
#pragma unroll
            for (int j = 0; j < 8; ++j) { s[j][0] += bflo(v0[j].x) + f1 * bflo(v1[j].x); s[j][1] += bfhi(v0[j].x) + f1 * bfhi(v1[j].x); s[j][2] += bflo(v0[j].y) + f1 * bflo(v1[j].y); s[j][3] += bfhi(v0[j].y) + f1 * bfhi(v1[j].y); }
        }
        const float* gate = mod + (size_t)(l * 5 + rr) * 12288 + 5 * DM;
#pragma unroll
        for (int j = 0; j < 8; ++j) { const f32x4 gv = *(const f32x4*)(gate + j * 256 + lane * 4); x[j] += gv * s[j]; }
        if (l == 0) {
            float* xo = (float*)(ws + WS_XA) + (size_t)row * DM;
#pragma unroll
            for (int j = 0; j < 8; ++j) *(f32x4*)(xo + j * 256 + lane * 4) = x[j];
            const float* m = mod + (size_t)(5 + rr) * 12288;
            rms_mod_store(x, p.in[I_N1G] + DM, m + DM, m, (bf16_t*)(ws + WS_H) + (size_t)row * DM, y, lane);
        } else {
            float ss = 0.f;
#pragma unroll
            for (int j = 0; j < 8; ++j) ss += x[j][0] * x[j][0] + x[j][1] * x[j][1] + x[j][2] * x[j][2] + x[j][3] * x[j][3];
            ss = wave_sum(ss); const float rinv = rsqrtf(ss * (1.0f / DM) + EPS);
            float* orow = p.out + (size_t)row * DM;
#pragma unroll
            for (int j = 0; j < 8; ++j) { const f32x4 gv = *(const f32x4*)(p.in[I_FNG] + j * 256 + lane * 4); *(f32x4*)(orow + j * 256 + lane * 4) = x[j] * rinv * gv; }
        }
    }
}

constexpr int NPH_LAYER = 13, NPH = 2 + 2 * NPH_LAYER;
__global__ void __launch_bounds__(512, 2) fwd(Params p) {
    extern __shared__ __attribute__((aligned(16))) unsigned char lds_raw[];
    LAS unsigned char* lds = (LAS unsigned char*)lds_raw;
    volatile LAS unsigned* MISC = (volatile LAS unsigned*)(lds + LDS_MISC);
    if (threadIdx.x < 16) MISC[threadIdx.x] = 0u;
    __syncthreads();
    unsigned char* ws = p.ws;
    const int lo = p.ph_lo, hi = p.ph_hi;
    XcdBarrier bar; bar.bar = (unsigned*)(ws + WS_CTL); bar.x = 0; bar.st = MISC;
    if (hi - lo > 1) bar = xcd_barrier_post((unsigned*)(ws + WS_CTL), MISC);
    const int G = gridDim.x, c = blockIdx.x;
#ifndef ONLY_PH
#define ONLY_PH -1
#endif
#define PSEL(id) (ONLY_PH < 0 || ONLY_PH == (id))
#ifndef DUP
#define DUP 0
#endif
#define NREP(id) ((((DUP) >> (id)) & 1) ? 2 : 1)
#define REPLOOP(id) for (int rep_ = 0; rep_ < NREP(id); ++rep_)
#define REPBAR(id) do { if (rep_ + 1 < NREP(id)) xcd_barrier(bar); } while (0)
#define IN(k) (lo <= (k) && (k) < hi)
#define SEAM(k) do { if (IN(k) && IN((k) + 1)) xcd_barrier(bar); } while (0)

    if (PSEL(0) && IN(0)) REPLOOP(0) { ph_prologue(p, lds); __syncthreads(); REPBAR(0); }
    SEAM(0);
    if (PSEL(1) && IN(1)) REPLOOP(1) { ph_norm1_tables(p); REPBAR(1); }
    SEAM(1);
    for (int l = 0; l < 2; ++l) {
        const int pb = 2 + NPH_LAYER * l;
        const float* mod = (const float*)(ws + WS_MOD) + (size_t)l * 5 * 12288;
        if (PSEL(2) && IN(pb + 0)) REPLOOP(2) {
            pg8::TileSched S; S.init(ws + WS_H, (bf16_t*)(ws + WS_WTIN) + (size_t)l * INP * DM, DM, DM, MT / 256, INP / 256, 1, 0, 0, G, c, 0);
            pg8::EpiStoreBf16 E{(bf16_t*)(ws + WS_PA), INP};
            pg8::gemm_phase(lds, pg8::Desc{DM, DM, DM}, S, E);
         REPBAR(2); }
        SEAM(pb + 0);
        if (PSEL(3) && IN(pb + 1)) REPLOOP(3) { ph_rowsplit(p, l, lds); __syncthreads();  REPBAR(3); }
        SEAM(pb + 1);
        if (PSEL(4) && IN(pb + 2)) REPLOOP(4) {
#ifndef C_SEL
#define C_SEL 15
#endif
            if (C_SEL & 1) { pg8::TileSched S; S.init(ws + WS_QA, (bf16_t*)(ws + WS_WTUQ) + (size_t)l * 768 * 384, 384, 384, MT / 256, 3, 1, 0, 0, G, c, 0);
              pg8::EpiQ E{(bf16_t*)(ws + WS_QB), (const f32x2*)(ws + WS_ROPE)}; pg8::gemm_phase(lds, pg8::Desc{384, 384, 384}, S, E); }
            if (C_SEL & 2) { pg8::TileSched S; S.init(ws + WS_KVA, (bf16_t*)(ws + WS_WTUKV) + (size_t)l * 1024 * 256, 256, 256, MT / 256, 2, 1, 0, 0, G, c, 112);
              pg8::EpiK E{(bf16_t*)(ws + WS_KC)}; pg8::gemm_phase(lds, pg8::Desc{256, 256, 256}, S, E); }
            if (C_SEL & 4) { pg8::TileSched S; S.init((bf16_t*)(ws + WS_WTUKV) + (size_t)l * 1024 * 256 + 512 * 256, ws + WS_KVA, 256, 256, 2, MT / 256, 1, 0, 0, G, c, 184);
              pg8::EpiV E{(bf16_t*)(ws + WS_VT)}; pg8::gemm_phase(lds, pg8::Desc{256, 256, 256}, S, E); }
            if (C_SEL & 8) { pg8::TileSched S; S.init(ws + WS_UPK, (bf16_t*)(ws + WS_WST) + (size_t)l * 32 * 256 * 256, 512, 256, 3, 1, 32, (size_t)768 * 512 * 2, (size_t)256 * 256 * 2, G, c, 0);
              pg8::EpiS1 E{(float*)(ws + WS_EST)}; pg8::gemm_phase(lds, pg8::Desc{512, 256, 256}, S, E); }
         REPBAR(4); }
        SEAM(pb + 2);
        if (PSEL(5) && IN(pb + 3)) REPLOOP(5) { ph_attn_carry(p, l, lds); __syncthreads();  REPBAR(5); }
        SEAM(pb + 3);
        if (PSEL(6) && IN(pb + 4)) REPLOOP(6) {
            pg8::TileSched S; S.init(ws + WS_UPK, (bf16_t*)(ws + WS_G2B) + (size_t)l * 32 * 256 * 512, 512, 512, 3, 1, 32, (size_t)768 * 512 * 2, (size_t)256 * 512 * 2, G, c, 0);
            pg8::EpiS2 E{(bf16_t*)(ws + WS_GB)}; pg8::gemm_phase(lds, pg8::Desc{512, 512, 512}, S, E);
         REPBAR(6); }
        SEAM(pb + 4);
        if (PSEL(7) && IN(pb + 5)) REPLOOP(7) {
            pg8::TileSched S; S.init(ws + WS_GB, (bf16_t*)(ws + WS_WTGLU) + (size_t)l * 512 * 512, 512, 512, MT / 256, 2, 1, 0, 0, G, c, 0);
            pg8::EpiGlu E{(const bf16_t*)(ws + WS_GB), p.in[I_BGLU] + l * 512, (bf16_t*)(ws + WS_CAT)}; pg8::gemm_phase(lds, pg8::Desc{512, 512, 512}, S, E);
         REPBAR(7); }
        SEAM(pb + 5);
        if (PSEL(8) && IN(pb + 6)) REPLOOP(8) {
            pg8::TileSched S; S.init(ws + WS_CAT, (bf16_t*)(ws + WS_WTOUT) + (size_t)l * DM * DM, DM, DM, (l == 0 ? MT : NLAT) / 256, DM / 256, 1, 0, 0, G, c, 0);
            pg8::EpiOut E{l == 0 ? p.in[I_X] : (const float*)(ws + WS_XA), l == 0 ? p.in[I_CTX] : (const float*)(ws + WS_XA) + (size_t)NLAT * DM, mod + 2 * DM, (float*)(ws + WS_XB)};
            pg8::gemm_phase(lds, pg8::Desc{DM, DM, DM}, S, E);
         REPBAR(8); }
        SEAM(pb + 6);
        if (PSEL(9) && IN(pb + 7)) REPLOOP(9) { ph_norm2_router(p, l, lds); __syncthreads(); REPBAR(9); }
        SEAM(pb + 7);
        if (PSEL(10) && IN(pb + 8)) REPLOOP(10) { ph_topk(p, l, lds); __syncthreads();  REPBAR(10); }
        SEAM(pb + 8);
        if (PSEL(11) && IN(pb + 9)) REPLOOP(11) { ph_gather(p, l);  REPBAR(11); }
        SEAM(pb + 9);
        if (PSEL(12) && IN(pb + 10)) REPLOOP(12) {
            pg8::MoeSched S; S.init(ws + WS_PA, (bf16_t*)(ws + WS_WTGU) + (size_t)l * NE * 2048 * DM, DM, DM, l == 0 ? 5 : 4, 8, (size_t)EROWS * DM * 2, (size_t)2048 * DM * 2, G, c);
            pg8::EpiGU E{(bf16_t*)(ws + WS_HID)}; pg8::gemm_phase(lds, pg8::Desc{DM, DM, DM}, S, E);
         REPBAR(12); }
        SEAM(pb + 10);
        if (PSEL(13) && IN(pb + 11)) REPLOOP(13) {
            pg8::MoeSched S; S.init(ws + WS_HID, (bf16_t*)(ws + WS_WTDN) + (size_t)l * NE * DM * FF, FF, FF, l == 0 ? 5 : 4, 8, (size_t)EROWS * FF * 2, (size_t)DM * FF * 2, G, c);
            pg8::EpiDown E{(bf16_t*)(ws + WS_YS), (const float*)(ws + WS_ROWAFF)}; pg8::gemm_phase(lds, pg8::Desc{FF, FF, FF}, S, E);
         REPBAR(13); }
        SEAM(pb + 11);
        if (PSEL(14) && IN(pb + 12)) REPLOOP(14) { ph_combine(p, l);  REPBAR(14); }
        SEAM(pb + 12);
    }
#undef IN
#undef SEAM
}

extern "C" void kernel_launch(void* const* d_in, const int* in_sizes, int n_in, void* d_out, int out_size, void* d_ws, size_t ws_size, hipStream_t stream) {
    static int grid = 0;
    if (grid == 0) {
        if (n_in != 33 || ws_size < WS_END) { fprintf(stderr, "kernel_launch: need 33 inputs and >= %zu bytes of workspace; got %d, %zu\n", (size_t)WS_END, n_in, ws_size); grid = -1; return; }
        int dev = 0, cus = 0;
        if (hipGetDevice(&dev) != hipSuccess || hipDeviceGetAttribute(&cus, hipDeviceAttributeMultiprocessorCount, dev) != hipSuccess) { grid = -1; return; }
        if (hipFuncSetAttribute((const void*)fwd, hipFuncAttributeMaxDynamicSharedMemorySize, LDS_BYTES) != hipSuccess) { fprintf(stderr, "kernel_launch: hipFuncSetAttribute failed\n"); grid = -1; return; }
        (void)hipGetLastError();
        grid = cus > 256 ? 256 : cus;
    }
    if (grid < 0) return;
    (void)hipMemsetAsync((char*)d_ws + WS_CTL, 0, CTL_BYTES, stream);
    Params a{};
    for (int i = 0; i < 33; ++i) a.in[i] = (const float*)d_in[i];
    a.out = (float*)d_out; a.ws = (unsigned char*)d_ws;
#if MK_SPLIT
    for (int ph = 0; ph < NPH; ++ph) { a.ph_lo = ph; a.ph_hi = ph + 1; hipLaunchKernelGGL(fwd, dim3(grid), dim3(512), LDS_BYTES, stream, a); }
#else
    a.ph_lo = 0; a.ph_hi = NPH; hipLaunchKernelGGL(fwd, dim3(grid), dim3(512), LDS_BYTES, stream, a);
#endif
}
```

```cpp
#include <hip/hip_runtime.h>
#include <cstdint>
#include <cstdio>

#ifndef MK_SPLIT
#define MK_SPLIT 0
#endif

#define LAS __attribute__((address_space(3)))
typedef unsigned short bf16_t;
typedef short bf16x8 __attribute__((ext_vector_type(8)));
typedef short bf16x4 __attribute__((ext_vector_type(4)));
typedef float f32x4 __attribute__((ext_vector_type(4)));
typedef float f32x2 __attribute__((ext_vector_type(2)));
typedef unsigned u32x4 __attribute__((ext_vector_type(4)));
typedef unsigned u32x2 __attribute__((ext_vector_type(2)));
typedef float f32x16 __attribute__((ext_vector_type(16)));

constexpr int DM = 2048, NB = 4, SEQ = 2048, CTX = 256, NLAT = NB * SEQ, NCTX = NB * CTX, MT = NLAT + NCTX;
constexpr int INC = 3776, INP = 3840;
constexpr int C_SGU_U = 0, C_SGU_V = 512, C_CQ = 1024, C_CKV = 1408, C_KR = 1664, C_S5 = 1728, C_CVB = 2240, C_CVC = 2752, C_CVH = 3264;
constexpr int NKEY = CTX + SEQ;
constexpr int NE = 16, FF = 1024, CAPL = 256, CAPC = 32, EROWS = 1280;
constexpr int NCHUNK = MT / 16;
constexpr float EPS = 1e-6f;
constexpr float QSCALE = 0.07216878364870322f * 1.4426950408889634f;

constexpr size_t al256(size_t x) { return (x + 255) & ~(size_t)255; }
constexpr size_t WS_CTL = 0;
constexpr size_t CTL_BYTES = 65536;
constexpr size_t WS_MOD = WS_CTL + CTL_BYTES;
constexpr size_t WS_WTIN = al256(WS_MOD + (size_t)2 * 5 * 12288 * 4);
constexpr size_t WS_WTOUT = al256(WS_WTIN + (size_t)2 * INP * DM * 2);
constexpr size_t WS_WTUQ = al256(WS_WTOUT + (size_t)2 * DM * DM * 2);
constexpr size_t WS_WTUKV = al256(WS_WTUQ + (size_t)2 * 768 * 384 * 2);
constexpr size_t WS_WTGLU = al256(WS_WTUKV + (size_t)2 * 1024 * 256 * 2);
constexpr size_t WS_WTGU = al256(WS_WTGLU + (size_t)2 * 512 * 512 * 2);
constexpr size_t WS_WTDN = al256(WS_WTGU + (size_t)2 * NE * 2048 * DM * 2);
constexpr size_t WS_PW = al256(WS_WTDN + (size_t)2 * NE * DM * FF * 2);
constexpr size_t WS_BB = al256(WS_PW + (size_t)2 * 2 * 32 * 64 * 17 * 8);
constexpr size_t WS_KZ = al256(WS_BB + (size_t)2 * 2 * 32 * 64 * 16 * 8);
constexpr size_t WS_WST = al256(WS_KZ + (size_t)2 * 2 * 32 * 4096 * 4);
constexpr size_t WS_G2B = al256(WS_WST + (size_t)2 * 32 * 256 * 256 * 2);
constexpr size_t WS_H = al256(WS_G2B + (size_t)2 * 32 * 256 * 512 * 2);
constexpr size_t WS_PA = al256(WS_H + (size_t)MT * DM * 2);
constexpr size_t PA_BYTES = (size_t)NE * EROWS * DM * 2;
static_assert(PA_BYTES >= (size_t)MT * INP * 2, "P fits in the union");
constexpr size_t WS_XA = al256(WS_PA + PA_BYTES);
constexpr size_t WS_XB = al256(WS_XA + (size_t)MT * DM * 4);
constexpr size_t WS_CAT = al256(WS_XB + (size_t)MT * DM * 4);
constexpr size_t WS_QA = al256(WS_CAT + (size_t)MT * DM * 2);
constexpr size_t WS_KVA = al256(WS_QA + (size_t)MT * 384 * 2);
constexpr size_t WS_QB = al256(WS_KVA + (size_t)MT * 256 * 2);
constexpr size_t WS_KC = al256(WS_QB + (size_t)MT * 768 * 2);
constexpr size_t WS_VT = al256(WS_KC + (size_t)NB * 4 * NKEY * 192 * 2);
constexpr size_t WS_UPK = al256(WS_VT + (size_t)NB * 4 * 128 * NKEY * 2);
constexpr size_t WS_EST = al256(WS_UPK + (size_t)32 * 768 * 512 * 2);
constexpr size_t WS_GB = al256(WS_EST + (size_t)32 * 768 * 256 * 4);
constexpr size_t WS_AFF = al256(WS_GB + (size_t)MT * 512 * 2);
constexpr size_t WS_ROWTOK = al256(WS_AFF + (size_t)MT * 16 * 4);
constexpr size_t WS_ROWAFF = al256(WS_ROWTOK + (size_t)NE * EROWS * 4);
constexpr size_t WS_INV = al256(WS_ROWAFF + (size_t)NE * EROWS * 4);
constexpr size_t WS_HID = al256(WS_INV + (size_t)MT * 16 * 4);
constexpr size_t WS_YS = al256(WS_HID + (size_t)NE * EROWS * FF * 2);
constexpr size_t WS_ROPE = al256(WS_YS + (size_t)NE * EROWS * DM * 2);
constexpr size_t WS_END = al256(WS_ROPE + 64 * 16 * 8);

constexpr int LDS_GEMM = 131072;
constexpr int LDS_MISC = LDS_GEMM;
constexpr int LDS_BYTES = LDS_GEMM + 256;

typedef __bf16 bf16x2_t __attribute__((ext_vector_type(2)));
__device__ __forceinline__ unsigned cvt_pk_bf16(float lo, float hi) { const f32x2 v = {lo, hi}; const bf16x2_t b = __builtin_convertvector(v, bf16x2_t); return __builtin_bit_cast(unsigned, b); }
__device__ __forceinline__ float bf2f(unsigned short b) { return __uint_as_float(((unsigned)b) << 16); }
__device__ __forceinline__ float bflo(unsigned w) { return __uint_as_float(w << 16); }
__device__ __forceinline__ float bfhi(unsigned w) { return __uint_as_float(w & 0xffff0000u); }
__device__ __forceinline__ unsigned short f2bf(float f) { return (unsigned short)(cvt_pk_bf16(f, 0.f) & 0xffffu); }
__device__ __forceinline__ int opaque_tid() { int t = threadIdx.x; asm volatile("" : "+v"(t)); return t; }
__device__ __forceinline__ unsigned char* opaque_ptr(unsigned char* q) { long z = 0; asm volatile("" : "+s"(z)); return q + z; }
__device__ __forceinline__ float wave_sum(float v) {
#pragma unroll
    for (int o = 32; o >= 1; o >>= 1) v += __shfl_xor(v, o);
    return v;
}
__device__ __forceinline__ float gelu_tanh(float x) {
    const float y = 1.5957691216057308f * (x + 0.044715f * x * x * x);
    return x / (1.0f + __expf(-y));
}
__device__ __forceinline__ float silu_f(float x) { return x / (1.0f + __expf(-x)); }
__device__ __forceinline__ float sigmoid_f(float x) { return 1.0f / (1.0f + __expf(-x)); }

#define XB_TMO      128
#define XB_XCNT(j)  (256  + 64 * (j))
#define XB_XSUB(j)  (1280 + 64 * (j))
#define XB_XGEN(j)  (2304 + 64 * (j))
#define XB_TOP      3328
#define XB_TOPGEN   3392
#define XCD_BAR_WORDS 3456
#define XB_SPIN_CAP (1u << 22)
__device__ __forceinline__ unsigned xb_ld(unsigned* p)              { return __hip_atomic_load(p, __ATOMIC_RELAXED, __HIP_MEMORY_SCOPE_AGENT); }
__device__ __forceinline__ unsigned xb_add(unsigned* p, unsigned v) { return __hip_atomic_fetch_add(p, v, __ATOMIC_RELAXED, __HIP_MEMORY_SCOPE_AGENT); }
__device__ __forceinline__ unsigned xb_xcc_id() { return (unsigned)__builtin_amdgcn_s_getreg((3 << 11) | 20) & 0xFu; }
#define XB_SPIN(cond, bar) do { unsigned _sp = 0; while (cond) { __builtin_amdgcn_s_sleep(1); \
    if ((++_sp & 255u) == 0u) { if (xb_ld(&(bar)[XB_TMO])) break; if (_sp > XB_SPIN_CAP) { atomicAdd(&(bar)[XB_TMO], 1u); break; } } } } while (0)
struct XcdBarrier { unsigned* bar; unsigned x; volatile LAS unsigned* st; };
__device__ __forceinline__ XcdBarrier xcd_barrier_post(unsigned* bar, volatile LAS unsigned* st) {
    XcdBarrier b; b.bar = bar; b.x = xb_xcc_id(); b.st = st;
    if (threadIdx.x == 0) (void)xb_add(&bar[XB_XCNT(b.x)], 1u);
    return b;
}
__device__ __forceinline__ void xcd_barrier_complete(unsigned* bar, unsigned x, unsigned& nloc, unsigned& nx) {
    const unsigned G = gridDim.x * gridDim.y * gridDim.z;
    unsigned sum, cnt, mine, sp = 0u;
    for (;;) {
        sum = 0u; cnt = 0u; mine = 0u;
#pragma unroll
        for (unsigned j = 0; j < 16; ++j) { const unsigned c = xb_ld(&bar[XB_XCNT(j)]); sum += c; cnt += (c > 0u) ? 1u : 0u; mine = (j == x) ? c : mine; }
        if (sum == G) break;
        __builtin_amdgcn_s_sleep(1);
        if ((++sp & 255u) == 0u) { if (xb_ld(&bar[XB_TMO])) break; if (sp > XB_SPIN_CAP) { atomicAdd(&bar[XB_TMO], 1u); break; } }
    }
    nloc = mine > 0u ? mine : 1u; nx = cnt > 0u ? cnt : 1u;
}
__device__ __forceinline__ void xcd_barrier(const XcdBarrier& b) {
    asm volatile("s_waitcnt vmcnt(0)" ::: "memory");
    __syncthreads();
    if (threadIdx.x == 0) {
        unsigned* bar = b.bar;
        __builtin_amdgcn_s_waitcnt(0);
        unsigned nloc = b.st[0], nx = b.st[1];
        if (nloc == 0u) { xcd_barrier_complete(bar, b.x, nloc, nx); b.st[0] = nloc; b.st[1] = nx; }
        const unsigned old = xb_add(&bar[XB_XSUB(b.x)], 1u);
        const unsigned gen = old / nloc;
        if (old + 1u == (gen + 1u) * nloc) {
            __builtin_amdgcn_fence(__ATOMIC_RELEASE, "agent");
            asm volatile("s_waitcnt vmcnt(0)" ::: "memory");
            const unsigned og = xb_add(&bar[XB_TOP], 1u);
            const unsigned tg = og / nx;
            if (og + 1u == (tg + 1u) * nx) xb_add(&bar[XB_TOPGEN], 1u);
            else XB_SPIN(xb_ld(&bar[XB_TOPGEN]) == tg, bar);
            __builtin_amdgcn_fence(__ATOMIC_ACQUIRE, "agent");
            xb_add(&bar[XB_XGEN(b.x)], 1u);
            asm volatile("s_waitcnt vmcnt(0)" ::: "memory");
        } else {
            XB_SPIN(xb_ld(&bar[XB_XGEN(b.x)]) == gen, bar);
            __builtin_amdgcn_fence(__ATOMIC_ACQUIRE, "agent");
            asm volatile("s_waitcnt vmcnt(0)" ::: "memory");
        }
    }
    __syncthreads();
}

namespace pg8 {
constexpr int BM = 256, BK = 64, HALF = 128, HTB = HALF * BK * 2, STAGE_BYTES = 8 * HTB;
__host__ __device__ __forceinline__ int lds_byte(int r, int c) { const int st = (r >> 4) * 2 + (c >> 5), rr = r & 15, cc = c & 31, ob = rr * 64 + cc * 2; return st * 1024 + (ob ^ (((ob >> 9) & 1) << 5)); }
__host__ __device__ __forceinline__ void stage_rc(int b, int& R, int& C) { const int st = b / 1024, sb = b % 1024, swz = sb ^ (((sb >> 9) & 1) << 5); R = (st >> 1) * 16 + swz / 64; C = (st & 1) * 32 + (swz % 64) / 2; }
__host__ __device__ __forceinline__ int perm32(int rho) { const int n = rho >> 4, i = rho & 15; return 8 * (i >> 2) + 4 * n + (i & 3); }

struct Unit { const char* a; const char* b; int pm, pn, pb; };
struct Desc { int lda, ldb, K; };

struct TileSched {
    const char* A; const char* B; size_t sA, sB;
    int lda, ldb, nM, nN, nB, G, c;
    __device__ __forceinline__ void init(const void* A_, const void* B_, int lda_, int ldb_, int nM_, int nN_, int nB_, size_t sA_, size_t sB_, int G_, int c_, int off) {
        A = (const char*)A_; B = (const char*)B_; lda = lda_; ldb = ldb_; nM = nM_; nN = nN_; nB = nB_; sA = sA_; sB = sB_; G = G_; c = (c_ + G_ - (off % G_)) % G_; }
    __device__ __forceinline__ bool next(int i, Unit& u) const {
        const int nwg = nM * nN; const long L = (long)i * G + c; if (L >= (long)nwg * nB) return false;
        const int pb = (int)(L / nwg); int wgid = (int)(L % nwg);
        { const int q = nwg / 8, r = nwg % 8, xcd = wgid % 8, off = wgid / 8; wgid = (xcd < r ? xcd * (q + 1) : r * (q + 1) + (xcd - r) * q) + off; }
        const int nig = 8 * nN, gid = wgid / nig, fm = gid * 8, gsz = (nM - fm) < 8 ? (nM - fm) : 8;
        u.pm = fm + ((wgid % nig) % gsz); u.pn = (wgid % nig) / gsz; u.pb = pb;
        u.a = A + (size_t)pb * sA + (size_t)u.pm * 256 * lda * 2; u.b = B + (size_t)pb * sB + (size_t)u.pn * 256 * ldb * 2; return true;
    }
};
struct MoeSched {
    const char* A; const char* B; size_t sA, sB; int lda, ldb, nM, nN, G, c;
    __device__ __forceinline__ void init(const void* A_, const void* B_, int lda_, int ldb_, int nM_, int nN_, size_t sA_, size_t sB_, int G_, int c_) {
        A = (const char*)A_; B = (const char*)B_; lda = lda_; ldb = ldb_; nM = nM_; nN = nN_; sA = sA_; sB = sB_; G = G_; c = c_; }
    __device__ __forceinline__ bool next(int i, Unit& u) const {
        int e, rem; const int per = nM * nN;
        if ((G & 7) == 0) { const int x = c & 7, j = c >> 3, w = G >> 3; const int L = i * w + j; if (L >= 2 * per) return false; e = 2 * x + L / per; rem = L % per; }
        else { const long L = (long)i * G + c; if (L >= (long)NE * per) return false; e = (int)(L / per); rem = (int)(L % per); }
        u.pn = rem / nM; u.pm = rem % nM; u.pb = e;
        u.a = A + (size_t)e * sA + (size_t)u.pm * 256 * lda * 2; u.b = B + (size_t)e * sB + (size_t)u.pn * 256 * ldb * 2; return true;
    }
};

template <class Epi, class Sched>
__device__ __forceinline__ void gemm_phase(LAS unsigned char* lds, const Desc g, const Sched& S, const Epi& E) {
    const int tid = opaque_tid(), wid = __builtin_amdgcn_readfirstlane(tid >> 6), lane = tid & 63, wr = wid >> 2, wc = wid & 3, fr = lane & 15, fq = lane >> 4;
    const int K = g.K, nt = K / BK;
    unsigned voffA[2], voffB[2];
#pragma unroll
    for (int i = 0; i < 2; ++i) { int R, C; stage_rc(tid * 16 + i * 8192, R, C); const int Rb = Epi::PERM ? ((R & ~31) + perm32(R & 31)) : R;
        voffA[i] = (unsigned)(R * g.lda + C) * 2u; voffB[i] = (unsigned)(Rb * g.ldb + C) * 2u; }
    const size_t kstep = (size_t)(BK * 2);
    const size_t hstepA = (size_t)HALF * g.lda * 2, hstepB = (size_t)HALF * g.ldb * 2;
    const unsigned ldsw = (unsigned)wid * 1024u;
    const int aoff = lds_byte(wr * 64 + fr, fq * 8), boff = lds_byte(wc * 32 + fr, fq * 8);
#define PG8_SA(b, h) (((b) * 2 + (h)) * HTB)
#define PG8_SB(b, h) ((4 + (b) * 2 + (h)) * HTB)
#define PG8_STAGE(bufoff, gbase, voff) do { _Pragma("unroll") for (int _i = 0; _i < 2; ++_i) \
        __builtin_amdgcn_global_load_lds((const unsigned*)((const char*)(gbase) + (voff)[_i]), (LAS unsigned*)(lds + (bufoff) + ldsw + _i * 8192), 16, 0, 0); } while (0)
#define PG8_LDA(dst, b, h) do { _Pragma("unroll") for (int m = 0; m < 4; ++m) _Pragma("unroll") for (int k = 0; k < 2; ++k) dst[m][k] = *(const LAS bf16x8*)(lds + PG8_SA(b, h) + aoff + m * 2048 + k * 1024); } while (0)
#define PG8_LDB(dst, b, h) do { _Pragma("unroll") for (int n = 0; n < 2; ++n) _Pragma("unroll") for (int k = 0; k < 2; ++k) dst[n][k] = *(const LAS bf16x8*)(lds + PG8_SB(b, h) + boff + n * 2048 + k * 1024); } while (0)
#define PG8_MMA(ai, bj, At, Bt) do { __builtin_amdgcn_s_setprio(1); _Pragma("unroll") for (int m = 0; m < 4; ++m) _Pragma("unroll") for (int n = 0; n < 2; ++n) _Pragma("unroll") for (int k = 0; k < 2; ++k) \
        acc[ai][bj][m][n] = __builtin_amdgcn_mfma_f32_16x16x32_bf16(Bt[n][k], At[m][k], acc[ai][bj][m][n], 0, 0, 0); __builtin_amdgcn_s_setprio(0); } while (0)
#define PG8_WAIT_V(n) asm volatile("s_waitcnt vmcnt(" #n ")" ::: "memory")
#define PG8_WAIT_L(n) asm volatile("s_waitcnt lgkmcnt(" #n ")" ::: "memory")
#define PG8_BAR __builtin_amdgcn_s_barrier()
#define PG8_SCHED __builtin_amdgcn_sched_barrier(0)
    Unit cur, nxt; int ui = 0;
    if (!S.next(0, cur)) return;
    f32x4 acc[2][2][4][2];
#pragma unroll
    for (int a = 0; a < 2; ++a)
#pragma unroll
        for (int b = 0; b < 2; ++b)
#pragma unroll
            for (int m = 0; m < 4; ++m)
#pragma unroll
                for (int n = 0; n < 2; ++n) acc[a][b][m][n] = (f32x4){0.f, 0.f, 0.f, 0.f};
    bf16x8 At[4][2], B0[2][2], B1[2][2];
    const char* cA = cur.a; const char* cB = cur.b;
    PG8_STAGE(PG8_SB(0, 0), cB, voffB); PG8_STAGE(PG8_SA(0, 0), cA, voffA); PG8_STAGE(PG8_SB(0, 1), cB + hstepB, voffB); PG8_STAGE(PG8_SA(0, 1), cA + hstepA, voffA);
    if (wr == 1) PG8_BAR;
    PG8_WAIT_V(4); PG8_BAR;
    PG8_STAGE(PG8_SB(1, 0), cB + kstep, voffB); PG8_STAGE(PG8_SA(1, 0), cA + kstep, voffA); PG8_STAGE(PG8_SB(1, 1), cB + hstepB + kstep, voffB);
    PG8_WAIT_V(6); PG8_BAR;
    for (;;) {
        const bool has_next = S.next(ui + 1, nxt);
        const char* nA = has_next ? nxt.a : cA; const char* nB = has_next ? nxt.b : cB;
#pragma nounroll
        for (int t = 0; t < nt; t += 2) {
            const bool last = (t == nt - 2);
            const char* a1 = cA + (size_t)(t + 1) * kstep;
            const char* a2 = last ? nA : cA + (size_t)(t + 2) * kstep; const char* b2 = last ? nB : cB + (size_t)(t + 2) * kstep;
            const char* a3 = a2 + kstep; const char* b3 = b2 + kstep;
            PG8_LDB(B0, 0, 0); PG8_SCHED; PG8_LDA(At, 0, 0); PG8_STAGE(PG8_SA(1, 1), a1 + hstepA, voffA);
            PG8_WAIT_L(8); PG8_BAR; PG8_WAIT_L(0); PG8_MMA(0, 0, At, B0); PG8_BAR; PG8_SCHED;
            PG8_LDB(B1, 0, 1); PG8_STAGE(PG8_SB(0, 0), b2, voffB);
            PG8_BAR; PG8_WAIT_L(0); PG8_MMA(0, 1, At, B1); PG8_BAR;
            PG8_LDA(At, 0, 1); PG8_STAGE(PG8_SA(0, 0), a2, voffA);
            PG8_BAR; PG8_WAIT_L(0); PG8_MMA(1, 0, At, B0); PG8_BAR; PG8_SCHED;
            PG8_STAGE(PG8_SB(0, 1), b2 + hstepB, voffB);
            PG8_WAIT_V(6); PG8_BAR; PG8_MMA(1, 1, At, B1); PG8_BAR;
            PG8_LDB(B0, 1, 0); PG8_SCHED; PG8_LDA(At, 1, 0); PG8_STAGE(PG8_SA(0, 1), a2 + hstepA, voffA);
            PG8_WAIT_L(8); PG8_BAR; PG8_WAIT_L(0); PG8_MMA(0, 0, At, B0); PG8_BAR; PG8_SCHED;
            PG8_LDB(B1, 1, 1); PG8_STAGE(PG8_SB(1, 0), b3, voffB);
            PG8_BAR; PG8_WAIT_L(0); PG8_MMA(0, 1, At, B1); PG8_BAR;
            PG8_LDA(At, 1, 1); PG8_STAGE(PG8_SA(1, 0), a3, voffA);
            PG8_BAR; PG8_WAIT_L(0); PG8_MMA(1, 0, At, B0); PG8_BAR; PG8_SCHED;
            PG8_STAGE(PG8_SB(1, 1), b3 + hstepB, voffB);
            PG8_WAIT_V(6); PG8_BAR; PG8_MMA(1, 1, At, B1); PG8_BAR;
        }
        E(acc, cur, wr, wc, fr, fq);
        if (!has_next) break;
#pragma unroll
        for (int a = 0; a < 2; ++a)
#pragma unroll
            for (int b = 0; b < 2; ++b)
#pragma unroll
                for (int m = 0; m < 4; ++m)
#pragma unroll
                    for (int n = 0; n < 2; ++n) acc[a][b][m][n] = (f32x4){0.f, 0.f, 0.f, 0.f};
        cur = nxt; cA = nA; cB = nB; ++ui;
    }
    PG8_WAIT_V(0);
    if (wr == 0) PG8_BAR;
    PG8_BAR;
#undef PG8_SA
#undef PG8_SB
#undef PG8_STAGE
#undef PG8_LDA
#undef PG8_LDB
#undef PG8_MMA
#undef PG8_WAIT_V
#undef PG8_WAIT_L
#undef PG8_BAR
#undef PG8_SCHED
}

#define PG8_FOR_PERM(...) \
    _Pragma("unroll") for (int ai = 0; ai < 2; ++ai) _Pragma("unroll") for (int m = 0; m < 4; ++m) { const int tr = ai * 128 + wr * 64 + m * 16 + fr; \
        _Pragma("unroll") for (int bj = 0; bj < 2; ++bj) { const int tc = bj * 128 + wc * 32 + 8 * fq; const f32x4 v0 = acc[ai][bj][m][0], v1 = acc[ai][bj][m][1]; __VA_ARGS__ } }
#define PG8_FOR_NOPERM(...) \
    _Pragma("unroll") for (int ai = 0; ai < 2; ++ai) _Pragma("unroll") for (int m = 0; m < 4; ++m) { const int tr = ai * 128 + wr * 64 + m * 16 + fr; \
        _Pragma("unroll") for (int bj = 0; bj < 2; ++bj) _Pragma("unroll") for (int n = 0; n < 2; ++n) { const int tc = bj * 128 + wc * 32 + 16 * n + 4 * fq; const f32x4 v = acc[ai][bj][m][n]; __VA_ARGS__ } }

typedef const f32x4 (&AccRef)[2][2][4][2];

struct EpiStoreBf16 {
    static constexpr bool PERM = true;
    bf16_t* O; int ldc;
    __device__ __forceinline__ void operator()(AccRef acc, const Unit& u, int wr, int wc, int fr, int fq) const {
        PG8_FOR_PERM({ u32x4 w; w.x = cvt_pk_bf16(v0[0], v0[1]); w.y = cvt_pk_bf16(v0[2], v0[3]); w.z = cvt_pk_bf16(v1[0], v1[1]); w.w = cvt_pk_bf16(v1[2], v1[3]);
            *(u32x4*)(O + (size_t)(u.pm * 256 + tr) * ldc + u.pn * 256 + tc) = w; })
    }
};
struct EpiQ {
    static constexpr bool PERM = false;
    bf16_t* Q; const f32x2* ROPE;
    __device__ __forceinline__ void operator()(AccRef acc, const Unit& u, int wr, int wc, int fr, int fq) const {
#pragma unroll
        for (int ai = 0; ai < 2; ++ai)
#pragma unroll
            for (int m = 0; m < 4; ++m) { const int row = u.pm * 256 + ai * 128 + wr * 64 + m * 16 + fr; const bool lat = row < NLAT; const int t = row & (SEQ - 1);
#pragma unroll
                for (int bj = 0; bj < 2; ++bj) { const int cg = u.pn * 256 + bj * 128 + wc * 32; const int dd = cg % 192; f32x4 a = acc[ai][bj][m][0], b = acc[ai][bj][m][1];
                    if (dd >= 128 && lat) { const int pos = (dd - 128) >= 32 ? (t & 63) : (t >> 6); const f32x4* rp = (const f32x4*)(ROPE + pos * 16 + 4 * fq); const f32x4 r0 = rp[0], r1 = rp[1];
                        const float cs[4] = {r0[0], r0[2], r1[0], r1[2]}, sn[4] = {r0[1], r0[3], r1[1], r1[3]};
#pragma unroll
                        for (int i = 0; i < 4; ++i) { const float x1 = a[i], x2 = b[i]; a[i] = x1 * cs[i] - x2 * sn[i]; b[i] = x2 * cs[i] + x1 * sn[i]; } }
                    a *= QSCALE; b *= QSCALE;
                    bf16_t* o = Q + (size_t)row * 768 + cg + 4 * fq;
                    u32x2 w0; w0.x = cvt_pk_bf16(a[0], a[1]); w0.y = cvt_pk_bf16(a[2], a[3]); *(u32x2*)o = w0;
                    u32x2 w1; w1.x = cvt_pk_bf16(b[0], b[1]); w1.y = cvt_pk_bf16(b[2], b[3]); *(u32x2*)(o + 16) = w1; } }
    }
};
struct EpiK {
    static constexpr bool PERM = true;
    bf16_t* KC;
    __device__ __forceinline__ void operator()(AccRef acc, const Unit& u, int wr, int wc, int fr, int fq) const {
        const int b = u.pm < 32 ? (u.pm >> 3) : (u.pm - 32), key0 = u.pm < 32 ? CTX + (u.pm & 7) * 256 : 0;
        bf16_t* base = KC + ((size_t)(b * 4 + u.pn * 2) * NKEY + key0) * 192 + (size_t)(wr * 64 + fr) * 192 + wc * 32 + 8 * fq;
#pragma unroll
        for (int ai = 0; ai < 2; ++ai)
#pragma unroll
            for (int m = 0; m < 4; ++m)
#pragma unroll
                for (int bj = 0; bj < 2; ++bj) { const f32x4 v0 = acc[ai][bj][m][0], v1 = acc[ai][bj][m][1];
                    u32x4 w; w.x = cvt_pk_bf16(v0[0], v0[1]); w.y = cvt_pk_bf16(v0[2], v0[3]); w.z = cvt_pk_bf16(v1[0], v1[1]); w.w = cvt_pk_bf16(v1[2], v1[3]);
                    *(u32x4*)(base + (size_t)(ai * 128 + m * 16) * 192 + (size_t)bj * NKEY * 192) = w; }
    }
};
struct EpiV {
    static constexpr bool PERM = true;
    bf16_t* VT;
    __device__ __forceinline__ void operator()(AccRef acc, const Unit& u, int wr, int wc, int fr, int fq) const {
        const int b = u.pn < 32 ? (u.pn >> 3) : (u.pn - 32), key0 = u.pn < 32 ? CTX + (u.pn & 7) * 256 : 0;
        bf16_t* base = VT + ((size_t)(b * 4 + u.pm * 2) * 128 + wr * 64 + fr) * NKEY + key0 + wc * 32 + 8 * fq;
#pragma unroll
        for (int ai = 0; ai < 2; ++ai)
#pragma unroll
            for (int m = 0; m < 4; ++m)
#pragma unroll
                for (int bj = 0; bj < 2; ++bj) { const f32x4 v0 = acc[ai][bj][m][0], v1 = acc[ai][bj][m][1];
                    u32x4 w; w.x = cvt_pk_bf16(v0[0], v0[1]); w.y = cvt_pk_bf16(v0[2], v0[3]); w.z = cvt_pk_bf16(v1[0], v1[1]); w.w = cvt_pk_bf16(v1[2], v1[3]);
                    *(u32x4*)(base + (size_t)(ai * 128 + m * 16) * NKEY + bj * 128) = w; }
    }
};
struct EpiS1 {
    static constexpr bool PERM = false;
    float* EST;
    __device__ __forceinline__ void operator()(AccRef acc, const Unit& u, int wr, int wc, int fr, int fq) const {
        PG8_FOR_NOPERM({ const int row = u.pm * 256 + tr; if (row < NCHUNK) *(f32x4*)(EST + ((size_t)u.pb * 768 + row) * 256 + tc) = v; })
    }
};
struct EpiS2 {
    static constexpr bool PERM = true;
    bf16_t* GB;
    __device__ __forceinline__ void operator()(AccRef acc, const Unit& u, int wr, int wc, int fr, int fq) const {
        PG8_FOR_PERM({ const int row = u.pm * 256 + tr; if (row < NCHUNK) { const int p = tc >> 4, c = tc & 15;
            u32x4 w; w.x = cvt_pk_bf16(gelu_tanh(v0[0]), gelu_tanh(v0[1])); w.y = cvt_pk_bf16(gelu_tanh(v0[2]), gelu_tanh(v0[3]));
            w.z = cvt_pk_bf16(gelu_tanh(v1[0]), gelu_tanh(v1[1])); w.w = cvt_pk_bf16(gelu_tanh(v1[2]), gelu_tanh(v1[3]));
            *(u32x4*)(GB + (size_t)(row * 16 + p) * 512 + u.pb * 16 + c) = w; } })
    }
};
struct EpiGlu {
    static constexpr bool PERM = true;
    const bf16_t* GB; const float* bias; bf16_t* CAT;
    __device__ __forceinline__ void operator()(AccRef acc, const Unit& u, int wr, int wc, int fr, int fq) const {
        PG8_FOR_PERM({ const int row = u.pm * 256 + tr, col = u.pn * 256 + tc;
            const u32x4 gv = *(const u32x4*)(GB + (size_t)row * 512 + col); const f32x4 b0 = *(const f32x4*)(bias + col), b1 = *(const f32x4*)(bias + col + 4);
            u32x4 w;
            w.x = cvt_pk_bf16(bflo(gv.x) * sigmoid_f(v0[0] + b0[0]), bfhi(gv.x) * sigmoid_f(v0[1] + b0[1]));
            w.y = cvt_pk_bf16(bflo(gv.y) * sigmoid_f(v0[2] + b0[2]), bfhi(gv.y) * sigmoid_f(v0[3] + b0[3]));
            w.z = cvt_pk_bf16(bflo(gv.z) * sigmoid_f(v1[0] + b1[0]), bfhi(gv.z) * sigmoid_f(v1[1] + b1[1]));
            w.w = cvt_pk_bf16(bflo(gv.w) * sigmoid_f(v1[2] + b1[2]), bfhi(gv.w) * sigmoid_f(v1[3] + b1[3]));
            *(u32x4*)(CAT + (size_t)row * DM + 1024 + col) = w; })
    }
};
struct EpiOut {
    static constexpr bool PERM = false;
    const float* xl; const float* xc; const float* gate; float* xo;
    __device__ __forceinline__ void operator()(AccRef acc, const Unit& u, int wr, int wc, int fr, int fq) const {
        PG8_FOR_NOPERM({ const int row = u.pm * 256 + tr, col = u.pn * 256 + tc; const int rr = row < NLAT ? (row >> 11) : 4;
            const float* src = row < NLAT ? xl + (size_t)row * DM : xc + (size_t)(row - NLAT) * DM;
            const f32x4 xv = *(const f32x4*)(src + col), gv = *(const f32x4*)(gate + (size_t)rr * 12288 + col);
            *(f32x4*)(xo + (size_t)row * DM + col) = xv + gv * v; })
    }
};
struct EpiGU {
    static constexpr bool PERM = true;
    bf16_t* HID;
    __device__ __forceinline__ void operator()(AccRef acc, const Unit& u, int wr, int wc, int fr, int fq) const {
        PG8_FOR_PERM({ const int row = u.pm * 256 + tr, j = (u.pn * 256 + tc) >> 1;
            u32x2 w; w.x = cvt_pk_bf16(silu_f(v0[0]) * v0[1], silu_f(v0[2]) * v0[3]); w.y = cvt_pk_bf16(silu_f(v1[0]) * v1[1], silu_f(v1[2]) * v1[3]);
            *(u32x2*)(HID + ((size_t)u.pb * EROWS + row) * FF + j) = w; })
    }
};
struct EpiDown {
    static constexpr bool PERM = true;
    bf16_t* YS; const float* RA;
    __device__ __forceinline__ void operator()(AccRef acc, const Unit& u, int wr, int wc, int fr, int fq) const {
        PG8_FOR_PERM({ const int row = u.pm * 256 + tr, col = u.pn * 256 + tc; const float a = RA[u.pb * EROWS + row];
            u32x4 w; w.x = cvt_pk_bf16(v0[0] * a, v0[1] * a); w.y = cvt_pk_bf16(v0[2] * a, v0[3] * a); w.z = cvt_pk_bf16(v1[0] * a, v1[1] * a); w.w = cvt_pk_bf16(v1[2] * a, v1[3] * a);
            *(u32x4*)(YS + ((size_t)u.pb * EROWS + row) * DM + col) = w; })
    }
};
}

struct Params { const float* in[33]; float* out; unsigned char* ws; int ph_lo, ph_hi; };
enum { I_X = 0, I_C, I_CTX, I_CCTX, I_N1G, I_N2G, I_WADA, I_BADA, I_WIN, I_WOUT, I_SGUNG, I_SGUW, I_SGUB, I_QNG, I_WUQ, I_KVNG, I_WUKV,
       I_ARE, I_AIM, I_LOGDT, I_BRE, I_BIM, I_CRE, I_CIM, I_S5D, I_WGLU, I_BGLU, I_CONVW, I_WROUTER, I_WGATE, I_WUP, I_WDOWN, I_FNG };

__device__ __forceinline__ void transpose_tile(const float* src, int N, int k0, int n0, bf16_t* dst, int ldd, int rmul, int radd, int remap_kv, LAS float* tile) {
    const int tid = threadIdx.x;
#pragma unroll
    for (int i = 0; i < 2; ++i) { const int r = (tid >> 4) + 32 * i, c4 = (tid & 15) * 4;
        const f32x4 v = *(const f32x4*)(src + (size_t)(k0 + r) * N + n0 + c4);
        tile[r * 65 + c4 + 0] = v[0]; tile[r * 65 + c4 + 1] = v[1]; tile[r * 65 + c4 + 2] = v[2]; tile[r * 65 + c4 + 3] = v[3]; }
    __syncthreads();
    { const int n = tid >> 3, kc = tid & 7; float f[8];
#pragma unroll
        for (int j = 0; j < 8; ++j) f[j] = tile[(kc * 8 + j) * 65 + n];
        int nn = n0 + n; if (remap_kv) nn = ((nn & 255) < 128) ? ((nn >> 8) * 128 + (nn & 127)) : (512 + (nn >> 8) * 128 + (nn & 127));
        const int drow = nn * rmul + radd;
        u32x4 w; w.x = cvt_pk_bf16(f[0], f[1]); w.y = cvt_pk_bf16(f[2], f[3]); w.z = cvt_pk_bf16(f[4], f[5]); w.w = cvt_pk_bf16(f[6], f[7]);
        *(u32x4*)(dst + (size_t)drow * ldd + k0 + kc * 8) = w; }
    __syncthreads();
}
constexpr int N_ADA_UNITS = 96, N_S5T_UNITS = 16, N_ROPE_UNITS = 2;
constexpr int T_WIN = 32 * 59, T_WOUT = 32 * 32, T_WUQ = 6 * 12, T_WUKV = 4 * 16, T_WGLU = 8 * 8, T_EXP = 512;
constexpr int N_TR = 2 * (T_WIN + T_WOUT + T_WUQ + T_WUKV + T_WGLU);
constexpr int N_PRO_ITEMS = N_ADA_UNITS + N_S5T_UNITS + N_ROPE_UNITS + N_TR;


__device__ __forceinline__ void transpose_block(const float* src, int N, int k0, int n0, bf16_t* dst, int ldd, int rmul, int radd, LAS float* tile  ) {
    const int tid = opaque_tid();
    f32x4 v[8];
#pragma unroll
    for (int i = 0; i < 8; ++i) v[i] = __builtin_nontemporal_load((const f32x4*)(src + (size_t)(k0 + (tid >> 6) + 8 * i) * N + n0 + (tid & 63) * 4));
#pragma unroll
    for (int i = 0; i < 8; ++i) { const int r = (tid >> 6) + 8 * i; *(LAS f32x4*)(tile + r * 260 + (((tid & 63) * 4) ^ (8 * (r >> 3)))) = v[i]; }
    __syncthreads();
#pragma unroll
    for (int i = 0; i < 4; ++i) { const int id = tid + 512 * i, n = id >> 3, kc = id & 7; float f[8];
#pragma unroll
        for (int j = 0; j < 8; ++j) f[j] = tile[(kc * 8 + j) * 260 + (n ^ (8 * kc))];
        u32x4 w; w.x = cvt_pk_bf16(f[0], f[1]); w.y = cvt_pk_bf16(f[2], f[3]); w.z = cvt_pk_bf16(f[4], f[5]); w.w = cvt_pk_bf16(f[6], f[7]);
        *(u32x4*)(dst + (size_t)((n0 + n) * rmul + radd) * ldd + k0 + kc * 8) = w; }
    __syncthreads();
}
constexpr int QB_EXP = T_EXP / 4, Q_GU = NE * 2 * QB_EXP, Q_LAYER = Q_GU + NE * QB_EXP, Q_TOTAL = 2 * Q_LAYER;
constexpr int CW_QHEAD = 4096, CW_DONE = 4160;
static_assert((CW_DONE + 64 * 32) * 4 <= (int)CTL_BYTES, "control words inside the memset region");
__device__ __forceinline__ void moe_convert_block(const Params& p, unsigned char* ws, int t, LAS float* tile) {
    const int l = t / Q_LAYER, r = t % Q_LAYER;
    if (r < Q_GU) { const int e = r / (2 * QB_EXP), rr = r % (2 * QB_EXP), up = rr / QB_EXP, q = rr % QB_EXP; const int le = l * NE + e;
        transpose_block((up ? p.in[I_WUP] : p.in[I_WGATE]) + (size_t)le * DM * FF, FF, (q >> 2) * 64, (q & 3) * 256, (bf16_t*)(ws + WS_WTGU) + (size_t)le * 2048 * DM, DM, 2, up, tile); }
    else { const int r2 = r - Q_GU, e = r2 / QB_EXP, q = r2 % QB_EXP; const int le = l * NE + e;
        transpose_block(p.in[I_WDOWN] + (size_t)le * FF * DM, DM, (q >> 3) * 64, (q & 7) * 256, (bf16_t*)(ws + WS_WTDN) + (size_t)le * DM * FF, FF, 1, 0, tile); }
}
#ifndef FILL_ON
#define FILL_ON 0
#endif
constexpr unsigned Q_BULK = 4;
__device__ __forceinline__ unsigned moe_claim(unsigned* ctl, int ph, int upto, int mode) {
    unsigned t = 0xffffffffu;
    const unsigned head = __hip_atomic_load(ctl + CW_QHEAD, __ATOMIC_RELAXED, __HIP_MEMORY_SCOPE_AGENT);
    const bool go = mode ? (head < (unsigned)upto) : (head < (unsigned)Q_TOTAL && __hip_atomic_load(ctl + CW_DONE + 64 * ph, __ATOMIC_RELAXED, __HIP_MEMORY_SCOPE_AGENT) < gridDim.x);
    if (go) t = __hip_atomic_fetch_add(ctl + CW_QHEAD, mode ? Q_BULK : 1u, __ATOMIC_RELAXED, __HIP_MEMORY_SCOPE_AGENT);
    return t;
}
__device__ __forceinline__ void moe_pump(const Params& p, LAS unsigned char* lds, int ph, int upto, int mode) {
    unsigned char* ws = opaque_ptr(p.ws); unsigned* ctl = (unsigned*)(ws + WS_CTL);
    LAS float* tile = (LAS float*)lds; volatile LAS unsigned* slot = (volatile LAS unsigned*)(lds + LDS_MISC + 32);
    const int tid = opaque_tid(); const int nblk = mode ? (int)Q_BULK : 1;
    __syncthreads();
    if (tid == 0) { if (mode == 0) (void)__hip_atomic_fetch_add(ctl + CW_DONE + 64 * ph, 1u, __ATOMIC_RELAXED, __HIP_MEMORY_SCOPE_AGENT); slot[0] = moe_claim(ctl, ph, upto, mode); }
    __syncthreads();
    for (;;) {
        const unsigned t = slot[0];
        if (t >= (unsigned)Q_TOTAL) break;
        unsigned nxt = 0u;
        if (tid == 0) nxt = moe_claim(ctl, ph, upto, mode);
#pragma unroll 1
        for (int k = 0; k < nblk; ++k) if ((int)t + k < Q_TOTAL) moe_convert_block(p, ws, (int)t + k, tile);
        if (tid == 0) slot[0] = nxt;
        __syncthreads();
    }
}
__device__ __forceinline__ void moe_fill(const Params& p, LAS unsigned char* lds, int ph) { if (FILL_ON) moe_pump(p, lds, ph, Q_TOTAL, 0); }
__device__ __forceinline__ void moe_require(const Params& p, LAS unsigned char* lds, int upto) { moe_pump(p, lds, 0, upto, 1); }

__device__ __forceinline__ void ph_prologue(const Params& p, LAS unsigned char* lds) {
    const int tid = opaque_tid(), lane = tid & 63, wave = tid >> 6;
    unsigned char* ws = opaque_ptr(p.ws);
    for (int it = blockIdx.x; it < N_PRO_ITEMS; it += gridDim.x) {
        if (it < N_ADA_UNITS) {
            const int l = it / 48, cb = it % 48;
            LAS float* sil = (LAS float*)lds;
            LAS float* red = (LAS float*)(lds + 40960);
            for (int i = tid; i < 5 * DM; i += 512) { const int r = i >> 11, k = i & (DM - 1); const float v = r < 4 ? p.in[I_C][r * DM + k] : p.in[I_CCTX][k]; sil[i] = silu_f(v); }
            __syncthreads();
            f32x4 acc[5];
#pragma unroll
            for (int r = 0; r < 5; ++r) acc[r] = (f32x4){0.f, 0.f, 0.f, 0.f};
            const float* W = p.in[I_WADA] + (size_t)l * DM * 12288 + cb * 256 + lane * 4;
            for (int k = wave * 256; k < wave * 256 + 256; k += 8) {
                f32x4 w[8];
#pragma unroll
                for (int j = 0; j < 8; ++j) w[j] = *(const f32x4*)(W + (size_t)(k + j) * 12288);
#pragma unroll
                for (int j = 0; j < 8; ++j)
#pragma unroll
                    for (int r = 0; r < 5; ++r) acc[r] += sil[r * DM + k + j] * w[j];
            }
#pragma unroll
            for (int r = 0; r < 5; ++r)
#pragma unroll
                for (int j = 0; j < 4; ++j) red[(wave * 5 + r) * 256 + lane * 4 + j] = acc[r][j];
            __syncthreads();
            float* mod = (float*)(ws + WS_MOD);
            for (int o = tid; o < 5 * 256; o += 512) { const int r = o >> 8, cc = o & 255; float s = 0.f;
#pragma unroll
                for (int w8 = 0; w8 < 8; ++w8) s += red[(w8 * 5 + r) * 256 + cc];
                mod[(size_t)(l * 5 + r) * 12288 + cb * 256 + cc] = s + p.in[I_BADA][l * 12288 + cb * 256 + cc]; }
            __syncthreads();
        } else if (it < N_ADA_UNITS + N_S5T_UNITS) {
            const int idx = (it - N_ADA_UNITS) * 512 + tid;
            const float are = fminf(p.in[I_ARE][idx], -1e-4f), aim = p.in[I_AIM][idx];
            const float dt = expf(p.in[I_LOGDT][idx >> 6]);
            f32x2* PW = (f32x2*)(ws + WS_PW) + (size_t)idx * 17; f32x2* BB = (f32x2*)(ws + WS_BB) + (size_t)idx * 16;
            float abr = 0.f, abi = 0.f;
            for (int d = 0; d <= 16; ++d) { const double mag = exp((double)are * (double)dt * d); double sn, cs; sincos((double)aim * (double)dt * d, &sn, &cs);
                const f32x2 v = {(float)(mag * cs), (float)(mag * sn)}; PW[d] = v; if (d == 1) { abr = v.x; abi = v.y; } }
            const float xr = abr - 1.0f, xi = abi, den = 1.0f / (are * are + aim * aim);
            const float cr = (xr * are + xi * aim) * den, ci = (xi * are - xr * aim) * den;
            for (int c = 0; c < 16; ++c) { const float br = p.in[I_BRE][(size_t)idx * 16 + c], bi = p.in[I_BIM][(size_t)idx * 16 + c]; BB[c] = (f32x2){cr * br - ci * bi, cr * bi + ci * br}; }
        } else if (it < N_ADA_UNITS + N_S5T_UNITS + N_ROPE_UNITS) {
            const int idx = (it - N_ADA_UNITS - N_S5T_UNITS) * 512 + tid; const int pos = idx >> 4, f = idx & 15;
            const float invf = powf(10000.0f, -(float)f * 0.0625f); const float ang = (float)pos * invf;
            ((f32x2*)(ws + WS_ROPE))[idx] = (f32x2){cosf(ang), sinf(ang)};
        } else {
            int t = it - N_ADA_UNITS - N_S5T_UNITS - N_ROPE_UNITS;
            LAS float* tile = (LAS float*)lds;
            if (t < 2 * T_WIN) { const int l = t / T_WIN, r = t % T_WIN; transpose_tile(p.in[I_WIN] + (size_t)l * DM * INC, INC, (r % 32) * 64, (r / 32) * 64, (bf16_t*)(ws + WS_WTIN) + (size_t)l * INP * DM, DM, 1, 0, 0, tile); continue; }
            t -= 2 * T_WIN;
            if (t < 2 * T_WOUT) { const int l = t / T_WOUT, r = t % T_WOUT; transpose_tile(p.in[I_WOUT] + (size_t)l * DM * DM, DM, (r % 32) * 64, (r / 32) * 64, (bf16_t*)(ws + WS_WTOUT) + (size_t)l * DM * DM, DM, 1, 0, 0, tile); continue; }
            t -= 2 * T_WOUT;
            if (t < 2 * T_WUQ) { const int l = t / T_WUQ, r = t % T_WUQ; transpose_tile(p.in[I_WUQ] + (size_t)l * 384 * 768, 768, (r % 6) * 64, (r / 6) * 64, (bf16_t*)(ws + WS_WTUQ) + (size_t)l * 768 * 384, 384, 1, 0, 0, tile); continue; }
            t -= 2 * T_WUQ;
            if (t < 2 * T_WUKV) { const int l = t / T_WUKV, r = t % T_WUKV; transpose_tile(p.in[I_WUKV] + (size_t)l * 256 * 1024, 1024, (r % 4) * 64, (r / 4) * 64, (bf16_t*)(ws + WS_WTUKV) + (size_t)l * 1024 * 256, 256, 1, 0, 1, tile); continue; }
            t -= 2 * T_WUKV;
            if (t < 2 * T_WGLU) { const int l = t / T_WGLU, r = t % T_WGLU; transpose_tile(p.in[I_WGLU] + (size_t)l * 512 * 512, 512, (r % 8) * 64, (r / 8) * 64, (bf16_t*)(ws + WS_WTGLU) + (size_t)l * 512 * 512, 512, 1, 0, 0, tile); continue; }
        }
    }
}

__device__ __forceinline__ void rms_mod_store(const f32x4 (&x)[8], const float* g, const float* scale, const float* shift, bf16_t* orow, f32x4 (&y)[8], int lane) {
    float ss = 0.f;
#pragma unroll
    for (int j = 0; j < 8; ++j) ss += x[j][0] * x[j][0] + x[j][1] * x[j][1] + x[j][2] * x[j][2] + x[j][3] * x[j][3];
    ss = wave_sum(ss);
    const float rinv = rsqrtf(ss * (1.0f / DM) + EPS);
#pragma unroll
    for (int j = 0; j < 8; ++j) { const int c = j * 256 + lane * 4;
        const f32x4 gv = *(const f32x4*)(g + c), sc = *(const f32x4*)(scale + c), sh = *(const f32x4*)(shift + c);
        y[j] = x[j] * rinv * gv * (1.0f + sc) + sh;
        u32x2 w; w.x = cvt_pk_bf16(y[j][0], y[j][1]); w.y = cvt_pk_bf16(y[j][2], y[j][3]); *(u32x2*)(orow + c) = w; }
}

constexpr int N1_ROWITEMS = MT / 8, N1_KZ = 64, N1_WST = 1024, N1_INTER = 1024;
__device__ __forceinline__ void ph_norm1_tables(const Params& p) {
    const int tid = opaque_tid(), lane = tid & 63, wave = tid >> 6;
    unsigned char* ws = opaque_ptr(p.ws);
    const float* mod = (const float*)(ws + WS_MOD);
    for (int it = blockIdx.x; it < N1_ROWITEMS + N1_KZ + N1_WST + N1_INTER; it += gridDim.x) {
        if (it < N1_ROWITEMS) {
            const int row = it * 8 + wave; const int rr = row < NLAT ? (row >> 11) : 4;
            const float* xr = row < NLAT ? p.in[I_X] + (size_t)row * DM : p.in[I_CTX] + (size_t)(row - NLAT) * DM;
            f32x4 x[8], y[8];
#pragma unroll
            for (int j = 0; j < 8; ++j) x[j] = *(const f32x4*)(xr + j * 256 + lane * 4);
            const float* m = mod + (size_t)rr * 12288;
            rms_mod_store(x, p.in[I_N1G], m + DM, m, (bf16_t*)(ws + WS_H) + (size_t)row * DM, y, lane);
        } else if (it < N1_ROWITEMS + N1_KZ) {
            const int idx = (it - N1_ROWITEMS) * 512 + tid; const int c = idx & 15, d = (idx >> 4) & 15, lzg = idx >> 8;
            const f32x2* PW = (const f32x2*)(ws + WS_PW) + (size_t)lzg * 64 * 17; const f32x4* BB4 = (const f32x4*)((const f32x2*)(ws + WS_BB) + (size_t)lzg * 64 * 16);
            const float* cre = p.in[I_CRE] + ((size_t)lzg * 16 + c) * 64; const float* cim = p.in[I_CIM] + ((size_t)lzg * 16 + c) * 64;
            float acc16[16];
#pragma unroll
            for (int q = 0; q < 16; ++q) acc16[q] = 0.f;
            for (int n = 0; n < 64; ++n) { const f32x2 pw = PW[n * 17 + d]; const float cr = cre[n], ci = cim[n]; const float tr = cr * pw.x - ci * pw.y, ti = cr * pw.y + ci * pw.x;
#pragma unroll
                for (int q = 0; q < 8; ++q) { const f32x4 bb = BB4[n * 8 + q]; acc16[2 * q] += tr * bb[0] - ti * bb[1]; acc16[2 * q + 1] += tr * bb[2] - ti * bb[3]; } }
            float* KZ = (float*)(ws + WS_KZ) + ((size_t)(lzg * 16 + d) * 16 + c) * 16;
#pragma unroll
            for (int q = 0; q < 4; ++q) *(f32x4*)(KZ + 4 * q) = (f32x4){acc16[4 * q], acc16[4 * q + 1], acc16[4 * q + 2], acc16[4 * q + 3]};
        } else if (it < N1_ROWITEMS + N1_KZ + N1_WST) {
            const int idx = (it - N1_ROWITEMS - N1_KZ) * 512 + tid; const int c8 = (idx & 1) * 8, pp = (idx >> 1) & 15, row = (idx >> 5) & 255, lg = idx >> 13;
            const int l = lg >> 5, g = lg & 31, z = row >> 7, ri = (row >> 6) & 1, n = row & 63;
            const size_t lzgn = (((size_t)l * 2 + z) * 32 + g) * 64 + n;
            const f32x2 pw = ((const f32x2*)(ws + WS_PW))[lzgn * 17 + (z == 0 ? 15 - pp : pp)]; const f32x2* BB = (const f32x2*)(ws + WS_BB) + lzgn * 16 + c8;
            float f[8];
#pragma unroll
            for (int j = 0; j < 8; ++j) { const f32x2 bb = BB[j]; f[j] = ri == 0 ? (pw.x * bb.x - pw.y * bb.y) : (pw.x * bb.y + pw.y * bb.x); }
            u32x4 w; w.x = cvt_pk_bf16(f[0], f[1]); w.y = cvt_pk_bf16(f[2], f[3]); w.z = cvt_pk_bf16(f[4], f[5]); w.w = cvt_pk_bf16(f[6], f[7]);
            *(u32x4*)((bf16_t*)(ws + WS_WST) + ((size_t)lg * 256 + row) * 256 + pp * 16 + c8) = w;
        } else {
            const int idx = (it - N1_ROWITEMS - N1_KZ - N1_WST) * 512 + tid; const int n8 = (idx & 7) * 8, ri = (idx >> 3) & 1, z = (idx >> 4) & 1, row = (idx >> 5) & 255, lg = idx >> 13;
            const int l = lg >> 5, g = lg & 31, pp = row >> 4, c = row & 15;
            const size_t lzg = ((size_t)l * 2 + z) * 32 + g;
            const f32x2* PW = (const f32x2*)(ws + WS_PW) + (lzg * 64 + n8) * 17 + (z == 0 ? pp + 1 : 16 - pp);
            const float* cre = p.in[I_CRE] + (lzg * 16 + c) * 64 + n8; const float* cim = p.in[I_CIM] + (lzg * 16 + c) * 64 + n8;
            float f[8];
#pragma unroll
            for (int j = 0; j < 8; ++j) { const f32x2 pw = PW[j * 17]; const float cr = cre[j], ci = cim[j]; f[j] = ri == 0 ? (cr * pw.x - ci * pw.y) : -(cr * pw.y + ci * pw.x); }
            u32x4 w; w.x = cvt_pk_bf16(f[0], f[1]); w.y = cvt_pk_bf16(f[2], f[3]); w.z = cvt_pk_bf16(f[4], f[5]); w.w = cvt_pk_bf16(f[6], f[7]);
            *(u32x4*)((bf16_t*)(ws + WS_G2B) + ((size_t)lg * 256 + row) * 512 + 256 + z * 128 + ri * 64 + n8) = w;
        }
    }
}

constexpr int B_ROWITEMS = MT / 8, B_SGU = 72 * 4, B_INTRA = 512;
__device__ __forceinline__ void ph_rowsplit(const Params& p, int l, LAS unsigned char* lds) {
    const int tid = opaque_tid(), lane = tid & 63, wave = tid >> 6;
    unsigned char* ws = opaque_ptr(p.ws);
    const bf16_t* P = (const bf16_t*)(ws + WS_PA);
    bf16_t* CAT = (bf16_t*)(ws + WS_CAT);
    for (int it0 = blockIdx.x; it0 < B_ROWITEMS + B_SGU + B_INTRA; it0 += gridDim.x) {
        const int it = it0 < B_SGU ? B_ROWITEMS + it0 : (it0 < B_SGU + B_ROWITEMS ? it0 - B_SGU : it0);
        if (it < B_ROWITEMS) {
            const int row = it * 8 + wave; const bf16_t* pr = P + (size_t)row * INP;
            const bool lat = row < NLAT; const int t = lat ? (row & (SEQ - 1)) : ((row - NLAT) & (CTX - 1)); const int b = lat ? (row >> 11) : ((row - NLAT) >> 8);
            const int seqlen = lat ? SEQ : CTX;
            { float f[8]; float ss = 0.f;
              if (lane < 48) { const u32x4 v = *(const u32x4*)(pr + C_CQ + lane * 8); f[0] = bflo(v.x); f[1] = bfhi(v.x); f[2] = bflo(v.y); f[3] = bfhi(v.y); f[4] = bflo(v.z); f[5] = bfhi(v.z); f[6] = bflo(v.w); f[7] = bfhi(v.w);
#pragma unroll
                  for (int j = 0; j < 8; ++j) ss += f[j] * f[j]; }
              else {
#pragma unroll
                  for (int j = 0; j < 8; ++j) f[j] = 0.f; }
              ss = wave_sum(ss); const float rinv = rsqrtf(ss * (1.0f / 384.0f) + EPS);
              if (lane < 48) { const float* g = p.in[I_QNG] + l * 384 + lane * 8; u32x4 w;
                  w.x = cvt_pk_bf16(f[0] * rinv * g[0], f[1] * rinv * g[1]); w.y = cvt_pk_bf16(f[2] * rinv * g[2], f[3] * rinv * g[3]);
                  w.z = cvt_pk_bf16(f[4] * rinv * g[4], f[5] * rinv * g[5]); w.w = cvt_pk_bf16(f[6] * rinv * g[6], f[7] * rinv * g[7]);
                  *(u32x4*)((bf16_t*)(ws + WS_QA) + (size_t)row * 384 + lane * 8) = w; } }
            { const u32x2 v = *(const u32x2*)(pr + C_CKV + lane * 4); const float f0 = bflo(v.x), f1 = bfhi(v.x), f2 = bflo(v.y), f3 = bfhi(v.y);
              const float ss = wave_sum(f0 * f0 + f1 * f1 + f2 * f2 + f3 * f3); const float rinv = rsqrtf(ss * (1.0f / 256.0f) + EPS);
              const float* g = p.in[I_KVNG] + l * 256 + lane * 4; u32x2 w; w.x = cvt_pk_bf16(f0 * rinv * g[0], f1 * rinv * g[1]); w.y = cvt_pk_bf16(f2 * rinv * g[2], f3 * rinv * g[3]);
              *(u32x2*)((bf16_t*)(ws + WS_KVA) + (size_t)row * 256 + lane * 4) = w; }
            { float v = bf2f(pr[C_KR + lane]); const float partner = __shfl_xor(v, 16);
              if (lat) { const int jj = lane & 31, fi = jj & 15; const int pos = lane >= 32 ? (t & 63) : (t >> 6);
                  const f32x2 r = ((const f32x2*)(ws + WS_ROPE))[pos * 16 + fi]; const float cs = r.x, sn = r.y;
                  v = jj < 16 ? (v * cs - partner * sn) : (v * cs + partner * sn); }
              const int key = lat ? CTX + t : t; const unsigned short o = f2bf(v);
              bf16_t* kc = (bf16_t*)(ws + WS_KC);
#pragma unroll
              for (int h = 0; h < 4; ++h) kc[((size_t)(b * 4 + h) * NKEY + key) * 192 + 128 + lane] = o; }
            { const u32x4 v = *(const u32x4*)(pr + C_S5 + lane * 8); const int g = lane >> 1, half = lane & 1;
              *(u32x4*)((bf16_t*)(ws + WS_UPK) + ((size_t)g * 768 + (row >> 4)) * 512 + (row & 15) * 16 + half * 8) = v; }
            { const int c0 = lane * 8; float zp[8], zc[8], zn[8];
#pragma unroll
              for (int j = 0; j < 8; ++j) { zp[j] = 0.f; zn[j] = 0.f; }
#define CONV_Z(dst, rp) do { const u32x4 a_ = *(const u32x4*)((rp) + C_CVC + c0); const u32x4 h_ = *(const u32x4*)((rp) + C_CVH + c0); \
                  dst[0] = bflo(a_.x) * bflo(h_.x); dst[1] = bfhi(a_.x) * bfhi(h_.x); dst[2] = bflo(a_.y) * bflo(h_.y); dst[3] = bfhi(a_.y) * bfhi(h_.y); \
                  dst[4] = bflo(a_.z) * bflo(h_.z); dst[5] = bfhi(a_.z) * bfhi(h_.z); dst[6] = bflo(a_.w) * bflo(h_.w); dst[7] = bfhi(a_.w) * bfhi(h_.w); } while (0)
              CONV_Z(zc, pr);
              if (t > 0) CONV_Z(zp, pr - INP);
              if (t < seqlen - 1) CONV_Z(zn, pr + INP);
#undef CONV_Z
              const u32x4 bg = *(const u32x4*)(pr + C_CVB + c0); float bgf[8] = {bflo(bg.x), bfhi(bg.x), bflo(bg.y), bfhi(bg.y), bflo(bg.z), bfhi(bg.z), bflo(bg.w), bfhi(bg.w)};
              const float* cw = p.in[I_CONVW] + (size_t)l * 3 * 512 + c0; float o[8];
#pragma unroll
              for (int j = 0; j < 8; ++j) o[j] = bgf[j] * (cw[j] * zp[j] + cw[512 + j] * zc[j] + cw[1024 + j] * zn[j]);
              u32x4 w; w.x = cvt_pk_bf16(o[0], o[1]); w.y = cvt_pk_bf16(o[2], o[3]); w.z = cvt_pk_bf16(o[4], o[5]); w.w = cvt_pk_bf16(o[6], o[7]);
              *(u32x4*)(CAT + (size_t)row * DM + 1536 + c0) = w; }
        } else if (it < B_ROWITEMS + B_SGU) {
            const int un = it - B_ROWITEMS, cc = un >> 2, h = un & 3; const int row0 = cc * 128;
            LAS bf16_t* Wl = (LAS bf16_t*)lds;
            LAS bf16_t* Vl = (LAS bf16_t*)(lds + 128 * 136 * 2);
            const float* Wg = p.in[I_SGUW] + ((size_t)l * 4 + h) * 128 * 128;
#pragma unroll
            for (int i = 0; i < 8; ++i) { const int e4 = (i * 512 + tid) * 4, r = e4 >> 7, c = e4 & 127; const f32x4 v = *(const f32x4*)(Wg + e4);
                u32x2 w; w.x = cvt_pk_bf16(v[0], v[1]); w.y = cvt_pk_bf16(v[2], v[3]); *(LAS u32x2*)(Wl + r * 136 + c) = w; }
            u32x4 vv[16];
#pragma unroll
            for (int qi = 0; qi < 16; ++qi) vv[qi] = *(const u32x4*)(P + (size_t)(row0 + wave * 16 + qi) * INP + C_SGU_V + lane * 8);
#pragma unroll
            for (int qi = 0; qi < 16; ++qi) { const int q = wave * 16 + qi;
                const u32x4 v = vv[qi]; float f[8] = {bflo(v.x), bfhi(v.x), bflo(v.y), bfhi(v.y), bflo(v.z), bfhi(v.z), bflo(v.w), bfhi(v.w)}; float ss = 0.f;
#pragma unroll
                for (int j = 0; j < 8; ++j) { f[j] = gelu_tanh(f[j]); ss += f[j] * f[j]; }
                ss = wave_sum(ss); const float rinv = rsqrtf(ss * (1.0f / 512.0f) + EPS);
                if ((lane >> 4) == h) { const int c0 = (lane & 15) * 8; const float* g = p.in[I_SGUNG] + l * 512 + h * 128 + c0;
#pragma unroll
                    for (int j = 0; j < 8; ++j) Vl[(c0 + j) * 136 + q] = f2bf(f[j] * rinv * g[j]); } }
            __syncthreads();
            { const int fr = lane & 15, fq = lane >> 4; f32x4 acc[8];
#pragma unroll
              for (int nb = 0; nb < 8; ++nb) acc[nb] = (f32x4){0.f, 0.f, 0.f, 0.f};
#pragma unroll
              for (int ks = 0; ks < 4; ++ks) { const bf16x8 af = *(const LAS bf16x8*)(Wl + (wave * 16 + fr) * 136 + ks * 32 + fq * 8);
#pragma unroll
                  for (int nb = 0; nb < 8; ++nb) { const bf16x8 bfr = *(const LAS bf16x8*)(Vl + (nb * 16 + fr) * 136 + ks * 32 + fq * 8);
                      acc[nb] = __builtin_amdgcn_mfma_f32_16x16x32_bf16(bfr, af, acc[nb], 0, 0, 0); } }
              const int pp = wave * 16 + fr; const float bias = p.in[I_SGUB][((size_t)l * 4 + h) * 128 + pp]; const bf16_t* pr = P + (size_t)(row0 + pp) * INP + C_SGU_U + h * 128;
#pragma unroll
              for (int nb = 0; nb < 8; ++nb) { const int c = nb * 16 + 4 * fq; const u32x2 uv = *(const u32x2*)(pr + c);
                  u32x2 w; w.x = cvt_pk_bf16(gelu_tanh(bflo(uv.x)) * (acc[nb][0] + bias), gelu_tanh(bfhi(uv.x)) * (acc[nb][1] + bias));
                  w.y = cvt_pk_bf16(gelu_tanh(bflo(uv.y)) * (acc[nb][2] + bias), gelu_tanh(bfhi(uv.y)) * (acc[nb][3] + bias));
                  *(u32x2*)(CAT + (size_t)(row0 + pp) * DM + h * 128 + c) = w; } }
            __syncthreads();
        } else {
            const int idx = (it - B_ROWITEMS - B_SGU) * 512 + tid; const int c8 = (idx & 1) * 8, pq = (idx >> 1) & 15, row = (idx >> 5) & 255, g = idx >> 13;
            const int pp = row >> 4, c = row & 15;
            const float* KZf = (const float*)(ws + WS_KZ) + (((size_t)l * 2 + 0) * 32 + g) * 4096; const float* KZb = (const float*)(ws + WS_KZ) + (((size_t)l * 2 + 1) * 32 + g) * 4096;
            float f[8];
#pragma unroll
            for (int j = 0; j < 8; ++j) { float v = 0.f; if (pq <= pp) v += KZf[((pp - pq) * 16 + c) * 16 + c8 + j]; if (pq >= pp) v += KZb[((pq - pp) * 16 + c) * 16 + c8 + j];
                if (pq == pp && c8 + j == c) v += p.in[I_S5D][l * 512 + g * 16 + c]; f[j] = v; }
            u32x4 w; w.x = cvt_pk_bf16(f[0], f[1]); w.y = cvt_pk_bf16(f[2], f[3]); w.z = cvt_pk_bf16(f[4], f[5]); w.w = cvt_pk_bf16(f[6], f[7]);
            *(u32x4*)((bf16_t*)(ws + WS_G2B) + (((size_t)l * 32 + g) * 256 + row) * 512 + pq * 16 + c8) = w;
        }
    }
}

constexpr int KPITCH = 400, VPITCH = 144;
constexpr int KT_BYTES = 64 * KPITCH, VT_BYTES = 128 * VPITCH;
__device__ __forceinline__ void attn_unit(const bf16_t* Qrows  , const bf16_t* Kbh, const bf16_t* Vbh, int nkeys, bf16_t* Orows, LAS unsigned char* lds) {
    const int tid = opaque_tid(), lane = tid & 63, wave = tid >> 6, l32 = lane & 31, hi = lane >> 5, qg = wave & 3, kh = wave >> 2;
    LAS unsigned char* Kb[2] = {lds, lds + KT_BYTES + VT_BYTES};
    LAS unsigned char* Vb[2] = {lds + KT_BYTES, lds + 2 * KT_BYTES + VT_BYTES};
    bf16x8 qf[12];
    { const bf16_t* qr = Qrows + (size_t)(qg * 32 + l32) * 768 + hi * 8;
#pragma unroll
      for (int ks = 0; ks < 12; ++ks) qf[ks] = *(const bf16x8*)(qr + ks * 16); }
    f32x16 o[4];
#pragma unroll
    for (int db = 0; db < 4; ++db)
#pragma unroll
        for (int r = 0; r < 16; ++r) o[db][r] = 0.f;
    float mrow = -1e30f, lsum = 0.f;
    const int nt = nkeys / 64;
    u32x4 kreg[3], vreg[2];
#define ATT_LOADG(tile) do { const char* kg = (const char*)(Kbh + (size_t)(tile) * 64 * 192); \
        _Pragma("unroll") for (int i = 0; i < 3; ++i) kreg[i] = *(const u32x4*)(kg + (size_t)(i * 512 + tid) * 16); \
        _Pragma("unroll") for (int i = 0; i < 2; ++i) { const int pc = i * 512 + tid; vreg[i] = *(const u32x4*)((const char*)(Vbh + (size_t)(pc >> 3) * NKEY + (tile) * 64) + (pc & 7) * 16); } } while (0)
#define ATT_STOREL(buf) do { \
        _Pragma("unroll") for (int i = 0; i < 3; ++i) { const int pc = i * 512 + tid; *(LAS u32x4*)(Kb[buf] + (pc / 24) * KPITCH + (pc % 24) * 16) = kreg[i]; } \
        _Pragma("unroll") for (int i = 0; i < 2; ++i) { const int pc = i * 512 + tid; *(LAS u32x4*)(Vb[buf] + (pc >> 3) * VPITCH + (pc & 7) * 16) = vreg[i]; } } while (0)
    ATT_LOADG(0); ATT_STOREL(0);
    __syncthreads();
    for (int j = 0; j < nt; ++j) {
        const int cur = j & 1;
        if (j + 1 < nt) ATT_LOADG(j + 1);
        f32x16 s;
#pragma unroll
        for (int r = 0; r < 16; ++r) s[r] = 0.f;
        { const LAS unsigned char* kp = Kb[cur] + (kh * 32 + l32) * KPITCH + hi * 16;
          bf16x8 ka[4], kb2[4];
#pragma unroll
          for (int i = 0; i < 4; ++i) ka[i] = *(const LAS bf16x8*)(kp + i * 32);
#pragma unroll
          for (int i = 0; i < 4; ++i) kb2[i] = *(const LAS bf16x8*)(kp + (4 + i) * 32);
          __builtin_amdgcn_sched_barrier(0);
#pragma unroll
          for (int i = 0; i < 4; ++i) s = __builtin_amdgcn_mfma_f32_32x32x16_bf16(ka[i], qf[i], s, 0, 0, 0);
#pragma unroll
          for (int i = 0; i < 4; ++i) ka[i] = *(const LAS bf16x8*)(kp + (8 + i) * 32);
          __builtin_amdgcn_sched_barrier(0);
#pragma unroll
          for (int i = 0; i < 4; ++i) s = __builtin_amdgcn_mfma_f32_32x32x16_bf16(kb2[i], qf[4 + i], s, 0, 0, 0);
          __builtin_amdgcn_sched_barrier(0);
#pragma unroll
          for (int i = 0; i < 4; ++i) s = __builtin_amdgcn_mfma_f32_32x32x16_bf16(ka[i], qf[8 + i], s, 0, 0, 0); }
        u32x2 vlo[4], vhi[4], wlo[4], whi[4];
#pragma unroll
        for (int db = 0; db < 4; ++db) { const LAS unsigned char* vp = Vb[cur] + (db * 32 + l32) * VPITCH + (kh * 32 + 4 * hi) * 2;
            vlo[db] = *(const LAS u32x2*)vp; vhi[db] = *(const LAS u32x2*)(vp + 16); }
        __builtin_amdgcn_sched_barrier(0);
        float mx = s[0];
#pragma unroll
        for (int r = 1; r < 16; ++r) mx = fmaxf(mx, s[r]);
        mx = fmaxf(mx, __shfl_xor(mx, 32));
        if (__any(mx > mrow + 8.0f)) {
            const float mnew = fmaxf(mrow, mx), alpha = __builtin_amdgcn_exp2f(mrow - mnew); mrow = mnew; lsum *= alpha;
#pragma unroll
            for (int db = 0; db < 4; ++db)
#pragma unroll
                for (int r = 0; r < 16; ++r) o[db][r] *= alpha;
        }
        float ps = 0.f;
#pragma unroll
        for (int r = 0; r < 16; ++r) { s[r] = __builtin_amdgcn_exp2f(s[r] - mrow); ps += s[r]; }
        lsum += ps;
        {
            u32x4 pw; pw.x = cvt_pk_bf16(s[0], s[1]); pw.y = cvt_pk_bf16(s[2], s[3]); pw.z = cvt_pk_bf16(s[4], s[5]); pw.w = cvt_pk_bf16(s[6], s[7]);
            const bf16x8 pf = __builtin_bit_cast(bf16x8, pw);
#pragma unroll
            for (int db = 0; db < 4; ++db) { const LAS unsigned char* vp = Vb[cur] + (db * 32 + l32) * VPITCH + (kh * 32 + 16 + 4 * hi) * 2;
                wlo[db] = *(const LAS u32x2*)vp; whi[db] = *(const LAS u32x2*)(vp + 16); }
            __builtin_amdgcn_sched_barrier(0);
#pragma unroll
            for (int db = 0; db < 4; ++db) { u32x4 vw; vw.x = vlo[db].x; vw.y = vlo[db].y; vw.z = vhi[db].x; vw.w = vhi[db].y;
                o[db] = __builtin_amdgcn_mfma_f32_32x32x16_bf16(__builtin_bit_cast(bf16x8, vw), pf, o[db], 0, 0, 0); }
        }
        {
            u32x4 pw; pw.x = cvt_pk_bf16(s[8], s[9]); pw.y = cvt_pk_bf16(s[10], s[11]); pw.z = cvt_pk_bf16(s[12], s[13]); pw.w = cvt_pk_bf16(s[14], s[15]);
            const bf16x8 pf = __builtin_bit_cast(bf16x8, pw);
#pragma unroll
            for (int db = 0; db < 4; ++db) { u32x4 vw; vw.x = wlo[db].x; vw.y = wlo[db].y; vw.z = whi[db].x; vw.w = whi[db].y;
                o[db] = __builtin_amdgcn_mfma_f32_32x32x16_bf16(__builtin_bit_cast(bf16x8, vw), pf, o[db], 0, 0, 0); }
        }
        if (j + 1 < nt) ATT_STOREL(cur ^ 1);
        __syncthreads();
    }
#undef ATT_LOADG
#undef ATT_STOREL
    lsum += __shfl_xor(lsum, 32);
    LAS float* mb = (LAS float*)lds + (size_t)qg * 66 * 64 + lane;
    if (kh == 1) {
#pragma unroll
        for (int db = 0; db < 4; ++db)
#pragma unroll
            for (int r = 0; r < 16; ++r) mb[(db * 16 + r) * 64] = o[db][r];
        mb[64 * 64] = mrow; mb[65 * 64] = lsum;
    }
    __syncthreads();
    if (kh == 0) {
        const float m1 = mb[64 * 64], l1 = mb[65 * 64];
        const float m = fmaxf(mrow, m1), e0 = __builtin_amdgcn_exp2f(mrow - m), e1 = __builtin_amdgcn_exp2f(m1 - m);
        const float inv = 1.0f / (lsum * e0 + l1 * e1), c0 = e0 * inv, c1 = e1 * inv;
        bf16_t* orow = Orows + (size_t)(qg * 32 + l32) * DM;
#pragma unroll
        for (int db = 0; db < 4; ++db)
#pragma unroll
            for (int k4 = 0; k4 < 4; ++k4) { float v[4];
#pragma unroll
                for (int i = 0; i < 4; ++i) v[i] = o[db][4 * k4 + i] * c0 + mb[(db * 16 + 4 * k4 + i) * 64] * c1;
                u32x2 w; w.x = cvt_pk_bf16(v[0], v[1]); w.y = cvt_pk_bf16(v[2], v[3]);
                *(u32x2*)(orow + db * 32 + 8 * k4 + 4 * hi) = w; }
    }
    __syncthreads();
}
__device__ __forceinline__ void ph_attn_carry(const Params& p, int l, LAS unsigned char* lds) {
    unsigned char* ws = opaque_ptr(p.ws); const int tid = opaque_tid();
    const int natt = (l == 0) ? 288 : 256;
    const bf16_t* QB = (const bf16_t*)(ws + WS_QB); const bf16_t* KC = (const bf16_t*)(ws + WS_KC); const bf16_t* VT = (const bf16_t*)(ws + WS_VT); bf16_t* CAT = (bf16_t*)(ws + WS_CAT);
    for (int it = blockIdx.x; it < natt; it += gridDim.x) {
        {
            int b, h, row0, nkeys;
            if (it < 256) { const int x = it & 7, jj = it >> 3, bh = 2 * x + (jj >> 4); b = bh >> 2; h = bh & 3; row0 = b * SEQ + (jj & 15) * 128; nkeys = NKEY; }
            else { const int u = it - 256; b = u >> 3; h = (u >> 1) & 3; row0 = NLAT + b * CTX + (u & 1) * 128; nkeys = CTX; }
            attn_unit(QB + (size_t)row0 * 768 + h * 192, KC + (size_t)(b * 4 + h) * NKEY * 192, VT + (size_t)(b * 4 + h) * 128 * NKEY, nkeys, CAT + (size_t)row0 * DM + 512 + h * 128, lds);
        }
    }
    for (int it = natt + (int)((blockIdx.x + gridDim.x - natt % gridDim.x) % gridDim.x); it < natt + 256; it += gridDim.x) {
        {
            const int u = it - natt; const int z = u >> 7, b = (u >> 5) & 3, g = u & 31, lane = tid & 63, w = tid >> 6;
            const f32x2 a16 = ((const f32x2*)(ws + WS_PW))[((((size_t)l * 2 + z) * 32 + g) * 64 + lane) * 17 + 16];
            const float* EST = (const float*)(ws + WS_EST) + (size_t)g * 768 * 256 + z * 128 + lane;
            bf16_t* UP = (bf16_t*)(ws + WS_UPK) + (size_t)g * 768 * 512 + 256 + z * 128 + lane;
            LAS f32x2* seg = (LAS f32x2*)lds;
            float er[18], ei[18];
#pragma unroll
            for (int i = 0; i < 18; ++i) { const int st = w * 18 + i; int chunk;
                if (z == 0) chunk = st < 16 ? (512 + b * 16 + st) : (b * 128 + (st - 16)); else chunk = st < 16 ? (512 + b * 16 + (15 - st)) : (b * 128 + (143 - st));
                er[i] = EST[(size_t)chunk * 256]; ei[i] = EST[(size_t)chunk * 256 + 64]; }
            float sr = 0.f, si = 0.f;
#pragma unroll
            for (int i = 0; i < 18; ++i) { const float nr = a16.x * sr - a16.y * si + er[i], ni = a16.x * si + a16.y * sr + ei[i]; sr = nr; si = ni; }
            seg[w * 64 + lane] = (f32x2){sr, si};
            float pr = 1.f, pi = 0.f;
#pragma unroll
            for (int i = 0; i < 18; ++i) { const float nr = pr * a16.x - pi * a16.y, ni = pr * a16.y + pi * a16.x; pr = nr; pi = ni; }
            __syncthreads();
            sr = 0.f; si = 0.f;
            for (int w2 = 0; w2 < w; ++w2) { const f32x2 sv = seg[w2 * 64 + lane]; const float nr = pr * sr - pi * si + sv.x, ni = pr * si + pi * sr + sv.y; sr = nr; si = ni; }
#pragma unroll
            for (int i = 0; i < 18; ++i) { const int st = w * 18 + i; int chunk;
                if (z == 0) chunk = st < 16 ? (512 + b * 16 + st) : (b * 128 + (st - 16)); else chunk = st < 16 ? (512 + b * 16 + (15 - st)) : (b * 128 + (143 - st));
                UP[(size_t)chunk * 512] = f2bf(sr); UP[(size_t)chunk * 512 + 64] = f2bf(si);
                const float nr = a16.x * sr - a16.y * si + er[i], ni = a16.x * si + a16.y * sr + ei[i]; sr = nr; si = ni; }
            __syncthreads();
        }
    }
}

__device__ __forceinline__ void ph_norm2_router(const Params& p, int l, LAS unsigned char* lds) {
    const int tid = opaque_tid(), lane = tid & 63, wave = tid >> 6;
    unsigned char* ws = opaque_ptr(p.ws); const float* mod = (const float*)(ws + WS_MOD) + (size_t)l * 5 * 12288;
    const int nrows = (l == 0) ? MT : NLAT;
    const float* WR = p.in[I_WROUTER] + (size_t)l * DM * NE;
    for (int idx = tid; idx < DM * 4; idx += 512) { const int c = idx >> 2, e4 = idx & 3; const f32x4 v = *(const f32x4*)(WR + (size_t)c * NE + e4 * 4);
        *(LAS f32x4*)(lds + (size_t)(((e4 * 2 + (c & 1)) * 1024 + (c >> 1)) * 16)) = v; }
    __syncthreads();
    const float* n2g = p.in[I_N2G] + l * DM;
    for (int it = blockIdx.x; it < nrows / 8; it += gridDim.x) {
        const int row = it * 8 + wave; const int rr = row < NLAT ? (row >> 11) : 4;
        const float* xr = (const float*)(ws + WS_XB) + (size_t)row * DM;
        const float* m = mod + (size_t)rr * 12288;
        f32x2 x[16], gv[16], sc[16], sh[16];
#pragma unroll
        for (int j = 0; j < 16; ++j) { const int c = j * 128 + lane * 2; x[j] = *(const f32x2*)(xr + c); gv[j] = *(const f32x2*)(n2g + c); sc[j] = *(const f32x2*)(m + 4 * DM + c); sh[j] = *(const f32x2*)(m + 3 * DM + c); }
        float ss = 0.f;
#pragma unroll
        for (int j = 0; j < 16; ++j) ss += x[j].x * x[j].x + x[j].y * x[j].y;
        ss = wave_sum(ss); const float rinv = rsqrtf(ss * (1.0f / DM) + EPS);
        bf16_t* orow = (bf16_t*)(ws + WS_H) + (size_t)row * DM;
        f32x4 lg[4];
#pragma unroll
        for (int e4 = 0; e4 < 4; ++e4) lg[e4] = (f32x4){0.f, 0.f, 0.f, 0.f};
#pragma unroll
        for (int j = 0; j < 16; ++j) { const f32x2 y = x[j] * rinv * gv[j] * (1.0f + sc[j]) + sh[j];
            *(unsigned*)(orow + j * 128 + lane * 2) = cvt_pk_bf16(y.x, y.y);
#pragma unroll
            for (int e4 = 0; e4 < 4; ++e4) { const f32x4 w0 = *(const LAS f32x4*)(lds + (size_t)(((e4 * 2 + 0) * 1024 + j * 64 + lane) * 16)); const f32x4 w1 = *(const LAS f32x4*)(lds + (size_t)(((e4 * 2 + 1) * 1024 + j * 64 + lane) * 16));
                lg[e4] += y.x * w0 + y.y * w1; }
            __builtin_amdgcn_sched_barrier(0); }
        float lgs[16]; float mx = -1e30f;
#pragma unroll
        for (int e = 0; e < 16; ++e) { lgs[e] = wave_sum(lg[e >> 2][e & 3]); mx = fmaxf(mx, lgs[e]); }
        float se = 0.f;
#pragma unroll
        for (int e = 0; e < 16; ++e) { lgs[e] = __expf(lgs[e] - mx); se += lgs[e]; }
        const float inv = 1.0f / se;
        float mine = 0.f;
#pragma unroll
        for (int e = 0; e < 16; ++e) mine = (lane == e) ? lgs[e] * inv : mine;
        if (lane < 16) ((float*)(ws + WS_AFF))[(size_t)row * 16 + lane] = mine;
    }
}

__device__ __forceinline__ void ph_topk(const Params& p, int l, LAS unsigned char* lds) {
    const int tid = opaque_tid(), lane = tid & 63, wave = tid >> 6;
    unsigned char* ws = opaque_ptr(p.ws); const float* AFF = (const float*)(ws + WS_AFF);
    int* ROWTOK = (int*)(ws + WS_ROWTOK); float* ROWAFF = (float*)(ws + WS_ROWAFF); int* INV = (int*)(ws + WS_INV);
    LAS int* hist = (LAS int*)lds;
    LAS int* ctl = (LAS int*)(lds + 1024);
    LAS int* wsum = (LAS int*)(lds + 1280);
    const int nunits = (l == 0) ? 128 : 64;
    for (int it = blockIdx.x; it < nunits; it += gridDim.x) {
        const bool lat = it < 64; const int u = lat ? it : it - 64; const int b = u >> 4, e = u & 15;
        const int n = lat ? SEQ : CTX, cap = lat ? CAPL : CAPC;
        const int tok0 = lat ? b * SEQ : NLAT + b * CTX; const int rowbase = lat ? b * CAPL : 1024 + b * CAPC;
        unsigned key[4];
#pragma unroll
        for (int j = 0; j < 4; ++j) { const int t = tid * 4 + j; key[j] = t < n ? __float_as_uint(AFF[(size_t)(tok0 + t) * 16 + e]) : 0u; }
        unsigned prefix = 0u; int remaining = cap;
        for (int pass = 3; pass >= 0; --pass) {
            if (tid < 256) hist[tid] = 0;
            __syncthreads();
#pragma unroll
            for (int j = 0; j < 4; ++j) { const int t = tid * 4 + j; if (t < n) { const bool match = (pass == 3) || ((key[j] >> (8 * (pass + 1))) == (prefix >> (8 * (pass + 1)))); if (match) atomicAdd((int*)&hist[(key[j] >> (8 * pass)) & 255u], 1); } }
            __syncthreads();
            if (wave == 0) {
                const int b0 = hist[4 * lane], b1 = hist[4 * lane + 1], b2 = hist[4 * lane + 2], b3 = hist[4 * lane + 3];
                const int s = b0 + b1 + b2 + b3; int suf = s;
#pragma unroll
                for (int off = 1; off < 64; off <<= 1) { const int t = __shfl_down(suf, off); if (lane + off < 64) suf += t; }
                const int above = suf - s; const int c3 = above + b3, c2 = c3 + b2, c1 = c2 + b1, c0 = c1 + b0;
                if (above < remaining && c0 >= remaining) { int dg, nr;
                    if (c3 >= remaining) { dg = 4 * lane + 3; nr = remaining - above; } else if (c2 >= remaining) { dg = 4 * lane + 2; nr = remaining - c3; }
                    else if (c1 >= remaining) { dg = 4 * lane + 1; nr = remaining - c2; } else { dg = 4 * lane; nr = remaining - c1; }
                    ctl[0] = dg; ctl[1] = nr; }
            }
            __syncthreads();
            prefix |= ((unsigned)ctl[0]) << (8 * pass); remaining = ctl[1];
            __syncthreads();
        }
        int cgt = 0, ceq = 0;
#pragma unroll
        for (int j = 0; j < 4; ++j) { const int t = tid * 4 + j; if (t < n) { cgt += key[j] > prefix ? 1 : 0; ceq += key[j] == prefix ? 1 : 0; } }
        const int packed = cgt | (ceq << 16);
        int inc = packed;
#pragma unroll
        for (int off = 1; off < 64; off <<= 1) { const int t = __shfl_up(inc, off); if (lane >= off) inc += t; }
        if (lane == 63) wsum[wave] = inc;
        __syncthreads();
        int base = 0;
#pragma unroll
        for (int w8 = 0; w8 < 8; ++w8) base += (w8 < wave) ? wsum[w8] : 0;
        int excl = base + inc - packed; int egt = excl & 0xffff, eeq = excl >> 16;
#pragma unroll
        for (int j = 0; j < 4; ++j) { const int t = tid * 4 + j; if (t < n) {
                const bool gt = key[j] > prefix, eq = key[j] == prefix; const bool sel = gt || (eq && eeq < remaining);
                const int slot = egt + (eeq < remaining ? eeq : remaining);
                if (sel) { ROWTOK[e * EROWS + rowbase + slot] = tok0 + t; ROWAFF[e * EROWS + rowbase + slot] = __uint_as_float(key[j]); }
                INV[(size_t)(tok0 + t) * 16 + e] = sel ? rowbase + slot : -1;
                egt += gt ? 1 : 0; eeq += eq ? 1 : 0; } }
        __syncthreads();
    }
}

__device__ __forceinline__ void ph_gather(const Params& p, int l) {
    const int tid = opaque_tid(), lane = tid & 63, wave = tid >> 6;
    unsigned char* ws = opaque_ptr(p.ws); const int* ROWTOK = (const int*)(ws + WS_ROWTOK);
    const int rows_per_e = (l == 0) ? 1152 : 1024;
    const int nitems = NE * rows_per_e / 8;
    for (int it = blockIdx.x; it < nitems; it += gridDim.x) {
        const int ridx = it * 8 + wave; const int e = ridx / rows_per_e, r = ridx % rows_per_e;
        const int tok = ROWTOK[e * EROWS + r];
        const u32x4* src = (const u32x4*)((const bf16_t*)(ws + WS_H) + (size_t)tok * DM); u32x4* dst = (u32x4*)((bf16_t*)(ws + WS_PA) + ((size_t)e * EROWS + r) * DM);
#pragma unroll
        for (int j = 0; j < 4; ++j) dst[j * 64 + lane] = src[j * 64 + lane];
    }
}

__device__ __forceinline__ void ph_combine(const Params& p, int l) {
    const int tid = opaque_tid(), lane = tid & 63, wave = tid >> 6;
    unsigned char* ws = opaque_ptr(p.ws); const float* mod = (const float*)(ws + WS_MOD);
    const int nrows = (l == 0) ? MT : NLAT;
    const int* INV = (const int*)(ws + WS_INV); const bf16_t* YS = (const bf16_t*)(ws + WS_YS);
    for (int it = blockIdx.x; it < nrows / 8; it += gridDim.x) {
        const int row = it * 8 + wave; const int rr = row < NLAT ? (row >> 11) : 4;
        const float* xr = (const float*)(ws + WS_XB) + (size_t)row * DM;
        f32x4 x[8], s[8], y[8];
#pragma unroll
        for (int j = 0; j < 8; ++j) { x[j] = *(const f32x4*)(xr + j * 256 + lane * 4); s[j] = (f32x4){0.f, 0.f, 0.f, 0.f}; }
        const int myinv = lane < 16 ? INV[(size_t)row * 16 + lane] : -1;
        unsigned msk = (unsigned)__ballot(myinv >= 0);
        while (msk) {
            const int e0 = __builtin_ctz(msk); msk &= msk - 1; const bool two = msk != 0u; const int e1 = two ? __builtin_ctz(msk) : e0; if (two) msk &= msk - 1;
            const int r0 = __shfl(myinv, e0), r1 = __shfl(myinv, e1);
            const bf16_t* y0 = YS + ((size_t)e0 * EROWS + r0) * DM; const bf16_t* y1 = YS + ((size_t)e1 * EROWS + r1) * DM;
            u32x2 v0[8], v1[8];
#pragma unroll
            for (int j = 0; j < 8; ++j) { v0[j] = *(const u32x2*)(y0 + j * 256 + lane * 4); v1[j] = *(const u32x2*)(y1 + j * 256 + lane * 4); }
            const float f1 = two ? 1.0f : 0.0f;
#pragma unroll
            for (int j = 0; j < 8; ++j) { s[j][0] += bflo(v0[j].x) + f1 * bflo(v1[j].x); s[j][1] += bfhi(v0[j].x) + f1 * bfhi(v1[j].x); s[j][2] += bflo(v0[j].y) + f1 * bflo(v1[j].y); s[j][3] += bfhi(v0[j].y) + f1 * bfhi(v1[j].y); }
        }
        const float* gate = mod + (size_t)(l * 5 + rr) * 12288 + 5 * DM;
#pragma unroll
        for (int j = 0; j < 8; ++j) { const f32x4 gv = *(const f32x4*)(gate + j * 256 + lane * 4); x[j] += gv * s[j]; }
        if (l == 0) {
            float* xo = (float*)(ws + WS_XA) + (size_t)row * DM;
#pragma unroll
            for (int j = 0; j < 8; ++j) *(f32x4*)(xo + j * 256 + lane * 4) = x[j];
            const float* m = mod + (size_t)(5 + rr) * 12288;
            rms_mod_store(x, p.in[I_N1G] + DM, m + DM, m, (bf16_t*)(ws + WS_H) + (size_t)row * DM, y, lane);
        } else {
            float ss = 0.f;
#pragma unroll
            for (int j = 0; j < 8; ++j) ss += x[j][0] * x[j][0] + x[j][1] * x[j][1] + x[j][2] * x[j][2] + x[j][3] * x[j][3];
            ss = wave_sum(ss); const float rinv = rsqrtf(ss * (1.0f / DM) + EPS);
            float* orow = p.out + (size_t)row * DM;
#pragma unroll
            for (int j = 0; j < 8; ++j) { const f32x4 gv = *(const f32x4*)(p.in[I_FNG] + j * 256 + lane * 4); *(f32x4*)(orow + j * 256 + lane * 4) = x[j] * rinv * gv; }
        }
    }
}

constexpr int NPH_LAYER = 13, NPH = 2 + 2 * NPH_LAYER;
__global__ void __launch_bounds__(512, 2) fwd(Params p) {
    extern __shared__ __attribute__((aligned(16))) unsigned char lds_raw[];
    LAS unsigned char* lds = (LAS unsigned char*)lds_raw;
    volatile LAS unsigned* MISC = (volatile LAS unsigned*)(lds + LDS_MISC);
    if (threadIdx.x < 16) MISC[threadIdx.x] = 0u;
    __syncthreads();
    unsigned char* ws = p.ws;
    const int lo = p.ph_lo, hi = p.ph_hi;
    XcdBarrier bar; bar.bar = (unsigned*)(ws + WS_CTL); bar.x = 0; bar.st = MISC;
    if (hi - lo > 1) bar = xcd_barrier_post((unsigned*)(ws + WS_CTL), MISC);
    const int G = gridDim.x, c = blockIdx.x;
#ifndef ONLY_PH
#define ONLY_PH -1
#endif
#define PSEL(id) (ONLY_PH < 0 || ONLY_PH == (id))
#ifndef DUP
#define DUP 0
#endif
#define NREP(id) ((((DUP) >> (id)) & 1) ? 2 : 1)
#define REPLOOP(id) for (int rep_ = 0; rep_ < NREP(id); ++rep_)
#define REPBAR(id) do { if (rep_ + 1 < NREP(id)) xcd_barrier(bar); } while (0)
#define IN(k) (lo <= (k) && (k) < hi)
#define SEAM(k) do { if (IN(k) && IN((k) + 1)) xcd_barrier(bar); } while (0)

    if (PSEL(0) && IN(0)) REPLOOP(0) { ph_prologue(p, lds); __syncthreads(); REPBAR(0); }
    SEAM(0);
    if (PSEL(1) && IN(1)) REPLOOP(1) { ph_norm1_tables(p); REPBAR(1); }
    SEAM(1);
    for (int l = 0; l < 2; ++l) {
        const int pb = 2 + NPH_LAYER * l;
        const float* mod = (const float*)(ws + WS_MOD) + (size_t)l * 5 * 12288;
        if (PSEL(2) && IN(pb + 0)) REPLOOP(2) {
            pg8::TileSched S; S.init(ws + WS_H, (bf16_t*)(ws + WS_WTIN) + (size_t)l * INP * DM, DM, DM, MT / 256, INP / 256, 1, 0, 0, G, c, 0);
            pg8::EpiStoreBf16 E{(bf16_t*)(ws + WS_PA), INP};
            pg8::gemm_phase(lds, pg8::Desc{DM, DM, DM}, S, E);
            moe_fill(p, lds, pb + 0);
         REPBAR(2); }
        SEAM(pb + 0);
        if (PSEL(3) && IN(pb + 1)) REPLOOP(3) { ph_rowsplit(p, l, lds); __syncthreads();  REPBAR(3); }
        SEAM(pb + 1);
        if (PSEL(4) && IN(pb + 2)) REPLOOP(4) {
#ifndef C_SEL
#define C_SEL 15
#endif
            if (C_SEL & 1) { pg8::TileSched S; S.init(ws + WS_QA, (bf16_t*)(ws + WS_WTUQ) + (size_t)l * 768 * 384, 384, 384, MT / 256, 3, 1, 0, 0, G, c, 0);
              pg8::EpiQ E{(bf16_t*)(ws + WS_QB), (const f32x2*)(ws + WS_ROPE)}; pg8::gemm_phase(lds, pg8::Desc{384, 384, 384}, S, E); }
            if (C_SEL & 2) { pg8::TileSched S; S.init(ws + WS_KVA, (bf16_t*)(ws + WS_WTUKV) + (size_t)l * 1024 * 256, 256, 256, MT / 256, 2, 1, 0, 0, G, c, 112);
              pg8::EpiK E{(bf16_t*)(ws + WS_KC)}; pg8::gemm_phase(lds, pg8::Desc{256, 256, 256}, S, E); }
            if (C_SEL & 4) { pg8::TileSched S; S.init((bf16_t*)(ws + WS_WTUKV) + (size_t)l * 1024 * 256 + 512 * 256, ws + WS_KVA, 256, 256, 2, MT / 256, 1, 0, 0, G, c, 184);
              pg8::EpiV E{(bf16_t*)(ws + WS_VT)}; pg8::gemm_phase(lds, pg8::Desc{256, 256, 256}, S, E); }
            if (C_SEL & 8) { pg8::TileSched S; S.init(ws + WS_UPK, (bf16_t*)(ws + WS_WST) + (size_t)l * 32 * 256 * 256, 512, 256, 3, 1, 32, (size_t)768 * 512 * 2, (size_t)256 * 256 * 2, G, c, 0);
              pg8::EpiS1 E{(float*)(ws + WS_EST)}; pg8::gemm_phase(lds, pg8::Desc{512, 256, 256}, S, E); }
            moe_fill(p, lds, pb + 2);
         REPBAR(4); }
        SEAM(pb + 2);
        if (PSEL(5) && IN(pb + 3)) REPLOOP(5) { ph_attn_carry(p, l, lds); __syncthreads();  REPBAR(5); }
        SEAM(pb + 3);
        if (PSEL(6) && IN(pb + 4)) REPLOOP(6) {
            pg8::TileSched S; S.init(ws + WS_UPK, (bf16_t*)(ws + WS_G2B) + (size_t)l * 32 * 256 * 512, 512, 512, 3, 1, 32, (size_t)768 * 512 * 2, (size_t)256 * 512 * 2, G, c, 0);
            pg8::EpiS2 E{(bf16_t*)(ws + WS_GB)}; pg8::gemm_phase(lds, pg8::Desc{512, 512, 512}, S, E);
            moe_fill(p, lds, pb + 4);
         REPBAR(6); }
        SEAM(pb + 4);
        if (PSEL(7) && IN(pb + 5)) REPLOOP(7) {
            pg8::TileSched S; S.init(ws + WS_GB, (bf16_t*)(ws + WS_WTGLU) + (size_t)l * 512 * 512, 512, 512, MT / 256, 2, 1, 0, 0, G, c, 0);
            pg8::EpiGlu E{(const bf16_t*)(ws + WS_GB), p.in[I_BGLU] + l * 512, (bf16_t*)(ws + WS_CAT)}; pg8::gemm_phase(lds, pg8::Desc{512, 512, 512}, S, E);
            moe_fill(p, lds, pb + 5);
         REPBAR(7); }
        SEAM(pb + 5);
        if (PSEL(8) && IN(pb + 6)) REPLOOP(8) {
            pg8::TileSched S; S.init(ws + WS_CAT, (bf16_t*)(ws + WS_WTOUT) + (size_t)l * DM * DM, DM, DM, (l == 0 ? MT : NLAT) / 256, DM / 256, 1, 0, 0, G, c, 0);
            pg8::EpiOut E{l == 0 ? p.in[I_X] : (const float*)(ws + WS_XA), l == 0 ? p.in[I_CTX] : (const float*)(ws + WS_XA) + (size_t)NLAT * DM, mod + 2 * DM, (float*)(ws + WS_XB)};
            pg8::gemm_phase(lds, pg8::Desc{DM, DM, DM}, S, E);
            moe_fill(p, lds, pb + 6);
         REPBAR(8); }
        SEAM(pb + 6);
        if (PSEL(9) && IN(pb + 7)) REPLOOP(9) { ph_norm2_router(p, l, lds); __syncthreads(); REPBAR(9); }
        SEAM(pb + 7);
        if (PSEL(10) && IN(pb + 8)) REPLOOP(10) { ph_topk(p, l, lds); __syncthreads(); moe_fill(p, lds, pb + 8);  REPBAR(10); }
        SEAM(pb + 8);
        if (PSEL(11) && IN(pb + 9)) REPLOOP(11) { ph_gather(p, l); moe_require(p, lds, l * Q_LAYER + Q_GU);  REPBAR(11); }
        SEAM(pb + 9);
        if (PSEL(12) && IN(pb + 10)) REPLOOP(12) {
            pg8::MoeSched S; S.init(ws + WS_PA, (bf16_t*)(ws + WS_WTGU) + (size_t)l * NE * 2048 * DM, DM, DM, l == 0 ? 5 : 4, 8, (size_t)EROWS * DM * 2, (size_t)2048 * DM * 2, G, c);
            pg8::EpiGU E{(bf16_t*)(ws + WS_HID)}; pg8::gemm_phase(lds, pg8::Desc{DM, DM, DM}, S, E);
            moe_require(p, lds, (l + 1) * Q_LAYER); moe_fill(p, lds, pb + 10);
         REPBAR(12); }
        SEAM(pb + 10);
        if (PSEL(13) && IN(pb + 11)) REPLOOP(13) {
            pg8::MoeSched S; S.init(ws + WS_HID, (bf16_t*)(ws + WS_WTDN) + (size_t)l * NE * DM * FF, FF, FF, l == 0 ? 5 : 4, 8, (size_t)EROWS * FF * 2, (size_t)DM * FF * 2, G, c);
            pg8::EpiDown E{(bf16_t*)(ws + WS_YS), (const float*)(ws + WS_ROWAFF)}; pg8::gemm_phase(lds, pg8::Desc{FF, FF, FF}, S, E);
            moe_fill(p, lds, pb + 11);
         REPBAR(13); }
        SEAM(pb + 11);
        if (PSEL(14) && IN(pb + 12)) REPLOOP(14) { ph_combine(p, l);  REPBAR(14); }
        SEAM(pb + 12);
    }
#undef IN
#undef SEAM
}

extern "C" void kernel_launch(void* const* d_in, const int* in_sizes, int n_in, void* d_out, int out_size, void* d_ws, size_t ws_size, hipStream_t stream) {
    static int grid = 0;
    if (grid == 0) {
        if (n_in != 33 || ws_size < WS_END) { fprintf(stderr, "kernel_launch: need 33 inputs and >= %zu bytes of workspace; got %d, %zu\n", (size_t)WS_END, n_in, ws_size); grid = -1; return; }
        int dev = 0, cus = 0;
        if (hipGetDevice(&dev) != hipSuccess || hipDeviceGetAttribute(&cus, hipDeviceAttributeMultiprocessorCount, dev) != hipSuccess) { grid = -1; return; }
        if (hipFuncSetAttribute((const void*)fwd, hipFuncAttributeMaxDynamicSharedMemorySize, LDS_BYTES) != hipSuccess) { fprintf(stderr, "kernel_launch: hipFuncSetAttribute failed\n"); grid = -1; return; }
        (void)hipGetLastError();
        grid = cus > 256 ? 256 : cus;
    }
    if (grid < 0) return;
    (void)hipMemsetAsync((char*)d_ws + WS_CTL, 0, CTL_BYTES, stream);
    Params a{};
    for (int i = 0; i < 33; ++i) a.in[i] = (const float*)d_in[i];
    a.out = (float*)d_out; a.ws = (unsigned char*)d_ws;
#if MK_SPLIT
    for (int ph = 0; ph < NPH; ++ph) { a.ph_lo = ph; a.ph_hi = ph + 1; hipLaunchKernelGGL(fwd, dim3(grid), dim3(512), LDS_BYTES, stream, a); }
#else
    a.ph_lo = 0; a.ph_hi = NPH; hipLaunchKernelGGL(fwd, dim3(grid), dim3(512), LDS_BYTES, stream, a);
#endif
}
```

```cpp
#include <hip/hip_runtime.h>
#include <cstdint>
#include <cstdio>

#ifndef MK_SPLIT
#define MK_SPLIT 0
#endif

#define LAS __attribute__((address_space(3)))
typedef unsigned short bf16_t;
typedef short bf16x8 __attribute__((ext_vector_type(8)));
typedef short bf16x4 __attribute__((ext_vector_type(4)));
typedef float f32x4 __attribute__((ext_vector_type(4)));
typedef float f32x2 __attribute__((ext_vector_type(2)));
typedef unsigned u32x4 __attribute__((ext_vector_type(4)));
typedef unsigned u32x2 __attribute__((ext_vector_type(2)));
typedef float f32x16 __attribute__((ext_vector_type(16)));

constexpr int DM = 2048, NB = 4, SEQ = 2048, CTX = 256, NLAT = NB * SEQ, NCTX = NB * CTX, MT = NLAT + NCTX;
constexpr int INC = 3776, INP = 3840;
constexpr int C_SGU_U = 0, C_SGU_V = 512, C_CQ = 1024, C_CKV = 1408, C_KR = 1664, C_S5 = 1728, C_CVB = 2240, C_CVC = 2752, C_CVH = 3264;
constexpr int NKEY = CTX + SEQ;
constexpr int NE = 16, FF = 1024, CAPL = 256, CAPC = 32, EROWS = 1280;
constexpr int NCHUNK = MT / 16;
constexpr float EPS = 1e-6f;
constexpr float QSCALE = 0.07216878364870322f * 1.4426950408889634f;

constexpr size_t al256(size_t x) { return (x + 255) & ~(size_t)255; }
constexpr size_t WS_CTL = 0;
constexpr size_t CTL_BYTES = 65536;
constexpr size_t WS_MOD = WS_CTL + CTL_BYTES;
constexpr size_t WS_WTIN = al256(WS_MOD + (size_t)2 * 5 * 12288 * 4);
constexpr size_t WS_WTOUT = al256(WS_WTIN + (size_t)2 * INP * DM * 2);
constexpr size_t WS_WTUQ = al256(WS_WTOUT + (size_t)2 * DM * DM * 2);
constexpr size_t WS_WTUKV = al256(WS_WTUQ + (size_t)2 * 768 * 384 * 2);
constexpr size_t WS_WTGLU = al256(WS_WTUKV + (size_t)2 * 1024 * 256 * 2);
constexpr size_t WS_WTGU = al256(WS_WTGLU + (size_t)2 * 512 * 512 * 2);
constexpr size_t WS_WTDN = al256(WS_WTGU + (size_t)2 * NE * 2048 * DM * 2);
constexpr size_t WS_PW = al256(WS_WTDN + (size_t)2 * NE * DM * FF * 2);
constexpr size_t WS_BB = al256(WS_PW + (size_t)2 * 2 * 32 * 64 * 17 * 8);
constexpr size_t WS_KZ = al256(WS_BB + (size_t)2 * 2 * 32 * 64 * 16 * 8);
constexpr size_t WS_WST = al256(WS_KZ + (size_t)2 * 2 * 32 * 4096 * 4);
constexpr size_t WS_G2B = al256(WS_WST + (size_t)2 * 32 * 256 * 256 * 2);
constexpr size_t WS_H = al256(WS_G2B + (size_t)2 * 32 * 256 * 512 * 2);
constexpr size_t WS_PA = al256(WS_H + (size_t)MT * DM * 2);
constexpr size_t PA_BYTES = (size_t)NE * EROWS * DM * 2;
static_assert(PA_BYTES >= (size_t)MT * INP * 2, "P fits in the union");
constexpr size_t WS_XA = al256(WS_PA + PA_BYTES);
constexpr size_t WS_XB = al256(WS_XA + (size_t)MT * DM * 4);
constexpr size_t WS_CAT = al256(WS_XB + (size_t)MT * DM * 4);
constexpr size_t WS_QA = al256(WS_CAT + (size_t)MT * DM * 2);
constexpr size_t WS_KVA = al256(WS_QA + (size_t)MT * 384 * 2);
constexpr size_t WS_QB = al256(WS_KVA + (size_t)MT * 256 * 2);
constexpr size_t WS_KC = al256(WS_QB + (size_t)MT * 768 * 2);
constexpr size_t WS_VT = al256(WS_KC + (size_t)NB * 4 * NKEY * 192 * 2);
constexpr size_t WS_UPK = al256(WS_VT + (size_t)NB * 4 * 128 * NKEY * 2);
constexpr size_t WS_EST = al256(WS_UPK + (size_t)32 * 768 * 512 * 2);
constexpr size_t WS_GB = al256(WS_EST + (size_t)32 * 768 * 256 * 4);
constexpr size_t WS_AFF = al256(WS_GB + (size_t)MT * 512 * 2);
constexpr size_t WS_ROWTOK = al256(WS_AFF + (size_t)MT * 16 * 4);
constexpr size_t WS_ROWAFF = al256(WS_ROWTOK + (size_t)NE * EROWS * 4);
constexpr size_t WS_INV = al256(WS_ROWAFF + (size_t)NE * EROWS * 4);
constexpr size_t WS_HID = al256(WS_INV + (size_t)MT * 16 * 4);
constexpr size_t WS_YS = al256(WS_HID + (size_t)NE * EROWS * FF * 2);
constexpr size_t WS_ROPE = al256(WS_YS + (size_t)NE * EROWS * DM * 2);
constexpr size_t WS_A16 = al256(WS_ROPE + 64 * 16 * 8);
constexpr size_t WS_END = al256(WS_A16 + (size_t)2 * 2 * 32 * 64 * 8);

constexpr int LDS_GEMM = 131072;
constexpr int LDS_ATTN = 3 * 44032;
constexpr int LDS_MISC = 133120;
constexpr int LDS_BYTES = LDS_MISC + 256;
static_assert(LDS_ATTN <= LDS_MISC && LDS_GEMM <= LDS_MISC, "LDS map");

typedef __bf16 bf16x2_t __attribute__((ext_vector_type(2)));
__device__ __forceinline__ unsigned cvt_pk_bf16(float lo, float hi) { const f32x2 v = {lo, hi}; const bf16x2_t b = __builtin_convertvector(v, bf16x2_t); return __builtin_bit_cast(unsigned, b); }
__device__ __forceinline__ float bf2f(unsigned short b) { return __uint_as_float(((unsigned)b) << 16); }
__device__ __forceinline__ float bflo(unsigned w) { return __uint_as_float(w << 16); }
__device__ __forceinline__ float bfhi(unsigned w) { return __uint_as_float(w & 0xffff0000u); }
__device__ __forceinline__ unsigned short f2bf(float f) { return (unsigned short)(cvt_pk_bf16(f, 0.f) & 0xffffu); }
__device__ __forceinline__ int opaque_tid() { int t = threadIdx.x; asm volatile("" : "+v"(t)); return t; }
__device__ __forceinline__ unsigned char* opaque_ptr(unsigned char* q) { long z = 0; asm volatile("" : "+s"(z)); return q + z; }
__device__ __forceinline__ float wave_sum(float v) {
#pragma unroll
    for (int o = 32; o >= 1; o >>= 1) v += __shfl_xor(v, o);
    return v;
}
__device__ __forceinline__ float gelu_tanh(float x) {
    const float y = 1.5957691216057308f * (x + 0.044715f * x * x * x);
    return x / (1.0f + __expf(-y));
}
__device__ __forceinline__ float silu_f(float x) { return x / (1.0f + __expf(-x)); }
__device__ __forceinline__ float sigmoid_f(float x) { return 1.0f / (1.0f + __expf(-x)); }

#define XB_TMO      128
#define XB_XCNT(j)  (256  + 64 * (j))
#define XB_XSUB(j)  (1280 + 64 * (j))
#define XB_XGEN(j)  (2304 + 64 * (j))
#define XB_TOP      3328
#define XB_TOPGEN   3392
#define XCD_BAR_WORDS 3456
#define XB_SPIN_CAP (1u << 22)
__device__ __forceinline__ unsigned xb_ld(unsigned* p)              { return __hip_atomic_load(p, __ATOMIC_RELAXED, __HIP_MEMORY_SCOPE_AGENT); }
__device__ __forceinline__ unsigned xb_add(unsigned* p, unsigned v) { return __hip_atomic_fetch_add(p, v, __ATOMIC_RELAXED, __HIP_MEMORY_SCOPE_AGENT); }
__device__ __forceinline__ unsigned xb_xcc_id() { return (unsigned)__builtin_amdgcn_s_getreg((3 << 11) | 20) & 0xFu; }
#define XB_SPIN(cond, bar) do { unsigned _sp = 0; while (cond) { __builtin_amdgcn_s_sleep(1); \
    if ((++_sp & 255u) == 0u) { if (xb_ld(&(bar)[XB_TMO])) break; if (_sp > XB_SPIN_CAP) { atomicAdd(&(bar)[XB_TMO], 1u); break; } } } } while (0)
struct XcdBarrier { unsigned* bar; unsigned x; volatile LAS unsigned* st; };
__device__ __forceinline__ XcdBarrier xcd_barrier_post(unsigned* bar, volatile LAS unsigned* st) {
    XcdBarrier b; b.bar = bar; b.x = xb_xcc_id(); b.st = st;
    if (threadIdx.x == 0) (void)xb_add(&bar[XB_XCNT(b.x)], 1u);
    return b;
}
__device__ __forceinline__ void xcd_barrier_complete(unsigned* bar, unsigned x, unsigned& nloc, unsigned& nx) {
    const unsigned G = gridDim.x * gridDim.y * gridDim.z;
    unsigned sum, cnt, mine, sp = 0u;
    for (;;) {
        sum = 0u; cnt = 0u; mine = 0u;
#pragma unroll
        for (unsigned j = 0; j < 16; ++j) { const unsigned c = xb_ld(&bar[XB_XCNT(j)]); sum += c; cnt += (c > 0u) ? 1u : 0u; mine = (j == x) ? c : mine; }
        if (sum == G) break;
        __builtin_amdgcn_s_sleep(1);
        if ((++sp & 255u) == 0u) { if (xb_ld(&bar[XB_TMO])) break; if (sp > XB_SPIN_CAP) { atomicAdd(&bar[XB_TMO], 1u); break; } }
    }
    nloc = mine > 0u ? mine : 1u; nx = cnt > 0u ? cnt : 1u;
}
__device__ __forceinline__ void xcd_barrier(const XcdBarrier& b) {
    asm volatile("s_waitcnt vmcnt(0)" ::: "memory");
    __syncthreads();
    if (threadIdx.x == 0) {
        unsigned* bar = b.bar;
        __builtin_amdgcn_s_waitcnt(0);
        unsigned nloc = b.st[0], nx = b.st[1];
        if (nloc == 0u) { xcd_barrier_complete(bar, b.x, nloc, nx); b.st[0] = nloc; b.st[1] = nx; }
        const unsigned old = xb_add(&bar[XB_XSUB(b.x)], 1u);
        const unsigned gen = old / nloc;
        if (old + 1u == (gen + 1u) * nloc) {
            __builtin_amdgcn_fence(__ATOMIC_RELEASE, "agent");
            asm volatile("s_waitcnt vmcnt(0)" ::: "memory");
            const unsigned og = xb_add(&bar[XB_TOP], 1u);
            const unsigned tg = og / nx;
            if (og + 1u == (tg + 1u) * nx) xb_add(&bar[XB_TOPGEN], 1u);
            else XB_SPIN(xb_ld(&bar[XB_TOPGEN]) == tg, bar);
            __builtin_amdgcn_fence(__ATOMIC_ACQUIRE, "agent");
            xb_add(&bar[XB_XGEN(b.x)], 1u);
            asm volatile("s_waitcnt vmcnt(0)" ::: "memory");
        } else {
            XB_SPIN(xb_ld(&bar[XB_XGEN(b.x)]) == gen, bar);
            __builtin_amdgcn_fence(__ATOMIC_ACQUIRE, "agent");
            asm volatile("s_waitcnt vmcnt(0)" ::: "memory");
        }
    }
    __syncthreads();
}

namespace pg8 {
constexpr int BM = 256, BK = 64, HALF = 128, HTB = HALF * BK * 2, STAGE_BYTES = 8 * HTB;
__host__ __device__ __forceinline__ int lds_byte(int r, int c) { const int st = (r >> 4) * 2 + (c >> 5), rr = r & 15, cc = c & 31, ob = rr * 64 + cc * 2; return st * 1024 + (ob ^ (((ob >> 9) & 1) << 5)); }
__host__ __device__ __forceinline__ void stage_rc(int b, int& R, int& C) { const int st = b / 1024, sb = b % 1024, swz = sb ^ (((sb >> 9) & 1) << 5); R = (st >> 1) * 16 + swz / 64; C = (st & 1) * 32 + (swz % 64) / 2; }
__host__ __device__ __forceinline__ int perm32(int rho) { const int n = rho >> 4, i = rho & 15; return 8 * (i >> 2) + 4 * n + (i & 3); }

struct Unit { const char* a; const char* b; int pm, pn, pb; };
struct Desc { int lda, ldb, K; };

struct TileSched {
    const char* A; const char* B; size_t sA, sB;
    int lda, ldb, nM, nN, nB, G, c;
    __device__ __forceinline__ void init(const void* A_, const void* B_, int lda_, int ldb_, int nM_, int nN_, int nB_, size_t sA_, size_t sB_, int G_, int c_, int off) {
        A = (const char*)A_; B = (const char*)B_; lda = lda_; ldb = ldb_; nM = nM_; nN = nN_; nB = nB_; sA = sA_; sB = sB_; G = G_; c = (c_ + G_ - (off % G_)) % G_; }
    __device__ __forceinline__ bool next(int i, Unit& u) const {
        const int nwg = nM * nN; const long L = (long)i * G + c; if (L >= (long)nwg * nB) return false;
        const int pb = (int)(L / nwg); int wgid = (int)(L % nwg);
        { const int q = nwg / 8, r = nwg % 8, xcd = wgid % 8, off = wgid / 8; wgid = (xcd < r ? xcd * (q + 1) : r * (q + 1) + (xcd - r) * q) + off; }
        const int nig = 8 * nN, gid = wgid / nig, fm = gid * 8, gsz = (nM - fm) < 8 ? (nM - fm) : 8;
        u.pm = fm + ((wgid % nig) % gsz); u.pn = (wgid % nig) / gsz; u.pb = pb;
        u.a = A + (size_t)pb * sA + (size_t)u.pm * 256 * lda * 2; u.b = B + (size_t)pb * sB + (size_t)u.pn * 256 * ldb * 2; return true;
    }
};
struct InSchedLast {
    TileSched T;
    __device__ __forceinline__ void init(const void* A_, const void* B_, int G_, int c_) { T.init(A_, B_, DM, DM, NLAT / 256, INP / 256, 1, 0, 0, G_, c_, 0); }
    __device__ __forceinline__ bool next(int i, Unit& u) const {
        const int nlat = (NLAT / 256) * (INP / 256); const long L = (long)i * T.G + T.c;
        if (L < nlat) return T.next(i, u);
        if (L >= nlat + 16) return false;
        const int k = (int)(L - nlat); u.pm = NLAT / 256 + (k >> 2); u.pn = 5 + (k & 3); u.pb = 0;
        u.a = T.A + (size_t)u.pm * 256 * DM * 2; u.b = T.B + (size_t)u.pn * 256 * DM * 2; return true;
    }
};
struct MoeSched {
    const char* A; const char* B; size_t sA, sB; int lda, ldb, nM, nN, G, c;
    __device__ __forceinline__ void init(const void* A_, const void* B_, int lda_, int ldb_, int nM_, int nN_, size_t sA_, size_t sB_, int G_, int c_) {
        A = (const char*)A_; B = (const char*)B_; lda = lda_; ldb = ldb_; nM = nM_; nN = nN_; sA = sA_; sB = sB_; G = G_; c = c_; }
    __device__ __forceinline__ bool next(int i, Unit& u) const {
        int e, rem; const int per = nM * nN;
        if ((G & 7) == 0) { const int x = c & 7, j = c >> 3, w = G >> 3; const int L = i * w + j; if (L >= 2 * per) return false; e = 2 * x + L / per; rem = L % per; }
        else { const long L = (long)i * G + c; if (L >= (long)NE * per) return false; e = (int)(L / per); rem = (int)(L % per); }
        u.pn = rem / nM; u.pm = rem % nM; u.pb = e;
        u.a = sA == 0 ? A : A + (size_t)e * sA + (size_t)u.pm * 256 * lda * 2; u.b = B + (size_t)e * sB + (size_t)u.pn * 256 * ldb * 2; return true;
    }
};

template <class Epi, class Sched, bool GATHER = false>
__device__ __forceinline__ void gemm_phase(LAS unsigned char* lds, const Desc g, const Sched& S, const Epi& E, const int* rowtok = nullptr, int nvalid = 0) {
    const int tid = opaque_tid(), wid = __builtin_amdgcn_readfirstlane(tid >> 6), lane = tid & 63, wr = wid >> 2, wc = wid & 3, fr = lane & 15, fq = lane >> 4;
    const int K = g.K, nt = K / BK;
    unsigned voffA[2], voffB[2]; int gR[2], gCc[2];
#pragma unroll
    for (int i = 0; i < 2; ++i) { int R, C; stage_rc(tid * 16 + i * 8192, R, C); const int Rb = Epi::PERM ? ((R & ~31) + perm32(R & 31)) : R;
        voffA[i] = (unsigned)(R * g.lda + C) * 2u; voffB[i] = (unsigned)(Rb * g.ldb + C) * 2u; gR[i] = R; gCc[i] = C; }
    unsigned gC[2][2], gN[2][2];
#define PG8_GOFF(u, o) do { _Pragma("unroll") for (int _h = 0; _h < 2; ++_h) _Pragma("unroll") for (int _i = 0; _i < 2; ++_i) { const int _r = (u).pm * 256 + _h * 128 + gR[_i]; \
        const int _tok = _r < nvalid ? rowtok[(u).pb * EROWS + _r] : 0; (o)[_h][_i] = (unsigned)(_tok * g.lda + gCc[_i]) * 2u; } } while (0)
    const size_t kstep = (size_t)(BK * 2);
    const size_t hstepA = (size_t)HALF * g.lda * 2, hstepB = (size_t)HALF * g.ldb * 2;
    const unsigned ldsw = (unsigned)wid * 1024u;
    const int aoff = lds_byte(wr * 64 + fr, fq * 8), boff = lds_byte(wc * 32 + fr, fq * 8);
#define PG8_SA(b, h) (((b) * 2 + (h)) * HTB)
#define PG8_SB(b, h) ((4 + (b) * 2 + (h)) * HTB)
#define PG8_STAGE(bufoff, gbase, voff) do { _Pragma("unroll") for (int _i = 0; _i < 2; ++_i) \
        __builtin_amdgcn_global_load_lds((const unsigned*)((const char*)(gbase) + (voff)[_i]), (LAS unsigned*)(lds + (bufoff) + ldsw + _i * 8192), 16, 0, 0); } while (0)
#define PG8_STAGE_A(bufoff, kptr, half, VO) do { if constexpr (GATHER) { _Pragma("unroll") for (int _i = 0; _i < 2; ++_i) \
        __builtin_amdgcn_global_load_lds((const unsigned*)((const char*)(kptr) + (VO)[half][_i]), (LAS unsigned*)(lds + (bufoff) + ldsw + _i * 8192), 16, 0, 0); } \
        else { PG8_STAGE(bufoff, (kptr) + (half) * hstepA, voffA); } } while (0)
#define PG8_LDA(dst, b, h) do { _Pragma("unroll") for (int m = 0; m < 4; ++m) _Pragma("unroll") for (int k = 0; k < 2; ++k) dst[m][k] = *(const LAS bf16x8*)(lds + PG8_SA(b, h) + aoff + m * 2048 + k * 1024); } while (0)
#define PG8_LDB(dst, b, h) do { _Pragma("unroll") for (int n = 0; n < 2; ++n) _Pragma("unroll") for (int k = 0; k < 2; ++k) dst[n][k] = *(const LAS bf16x8*)(lds + PG8_SB(b, h) + boff + n * 2048 + k * 1024); } while (0)
#define PG8_MMA(ai, bj, At, Bt) do { __builtin_amdgcn_s_setprio(1); _Pragma("unroll") for (int m = 0; m < 4; ++m) _Pragma("unroll") for (int n = 0; n < 2; ++n) _Pragma("unroll") for (int k = 0; k < 2; ++k) \
        acc[ai][bj][m][n] = __builtin_amdgcn_mfma_f32_16x16x32_bf16(Bt[n][k], At[m][k], acc[ai][bj][m][n], 0, 0, 0); __builtin_amdgcn_s_setprio(0); } while (0)
#define PG8_WAIT_V(n) asm volatile("s_waitcnt vmcnt(" #n ")" ::: "memory")
#define PG8_WAIT_L(n) asm volatile("s_waitcnt lgkmcnt(" #n ")" ::: "memory")
#define PG8_BAR __builtin_amdgcn_s_barrier()
#define PG8_SCHED __builtin_amdgcn_sched_barrier(0)
    Unit cur, nxt; int ui = 0;
    if (!S.next(0, cur)) return;
    f32x4 acc[2][2][4][2];
#pragma unroll
    for (int a = 0; a < 2; ++a)
#pragma unroll
        for (int b = 0; b < 2; ++b)
#pragma unroll
            for (int m = 0; m < 4; ++m)
#pragma unroll
                for (int n = 0; n < 2; ++n) acc[a][b][m][n] = (f32x4){0.f, 0.f, 0.f, 0.f};
    bf16x8 At[4][2], B0[2][2], B1[2][2];
    const char* cA = cur.a; const char* cB = cur.b;
    if constexpr (GATHER) { PG8_GOFF(cur, gC); }
    PG8_STAGE(PG8_SB(0, 0), cB, voffB); PG8_STAGE_A(PG8_SA(0, 0), cA, 0, gC); PG8_STAGE(PG8_SB(0, 1), cB + hstepB, voffB); PG8_STAGE_A(PG8_SA(0, 1), cA, 1, gC);
    if (wr == 1) PG8_BAR;
    PG8_WAIT_V(4); PG8_BAR;
    PG8_STAGE(PG8_SB(1, 0), cB + kstep, voffB); PG8_STAGE_A(PG8_SA(1, 0), cA + kstep, 0, gC); PG8_STAGE(PG8_SB(1, 1), cB + hstepB + kstep, voffB);
    PG8_WAIT_V(6); PG8_BAR;
    for (;;) {
        const bool has_next = S.next(ui + 1, nxt);
        const char* nA = has_next ? nxt.a : cA; const char* nB = has_next ? nxt.b : cB;
        if constexpr (GATHER) { if (has_next) { PG8_GOFF(nxt, gN); } else {
#pragma unroll
            for (int _h = 0; _h < 2; ++_h)
#pragma unroll
                for (int _i = 0; _i < 2; ++_i) gN[_h][_i] = gC[_h][_i]; } }
#pragma nounroll
        for (int t = 0; t < nt; t += 2) {
            const bool last = (t == nt - 2);
            const char* a1 = cA + (size_t)(t + 1) * kstep;
            const char* a2 = last ? nA : cA + (size_t)(t + 2) * kstep; const char* b2 = last ? nB : cB + (size_t)(t + 2) * kstep;
            const char* a3 = a2 + kstep; const char* b3 = b2 + kstep;
            unsigned g2[2][2];
            if constexpr (GATHER) {
#pragma unroll
                for (int _h = 0; _h < 2; ++_h)
#pragma unroll
                    for (int _i = 0; _i < 2; ++_i) g2[_h][_i] = last ? gN[_h][_i] : gC[_h][_i]; }
            PG8_LDB(B0, 0, 0); PG8_SCHED; PG8_LDA(At, 0, 0); PG8_STAGE_A(PG8_SA(1, 1), a1, 1, gC);
            PG8_WAIT_L(8); PG8_BAR; PG8_WAIT_L(0); PG8_MMA(0, 0, At, B0); PG8_BAR; PG8_SCHED;
            PG8_LDB(B1, 0, 1); PG8_STAGE(PG8_SB(0, 0), b2, voffB);
            PG8_BAR; PG8_WAIT_L(0); PG8_MMA(0, 1, At, B1); PG8_BAR;
            PG8_LDA(At, 0, 1); PG8_STAGE_A(PG8_SA(0, 0), a2, 0, g2);
            PG8_BAR; PG8_WAIT_L(0); PG8_MMA(1, 0, At, B0); PG8_BAR; PG8_SCHED;
            PG8_STAGE(PG8_SB(0, 1), b2 + hstepB, voffB);
            PG8_WAIT_V(6); PG8_BAR; PG8_MMA(1, 1, At, B1); PG8_BAR;
            PG8_LDB(B0, 1, 0); PG8_SCHED; PG8_LDA(At, 1, 0); PG8_STAGE_A(PG8_SA(0, 1), a2, 1, g2);
            PG8_WAIT_L(8); PG8_BAR; PG8_WAIT_L(0); PG8_MMA(0, 0, At, B0); PG8_BAR; PG8_SCHED;
            PG8_LDB(B1, 1, 1); PG8_STAGE(PG8_SB(1, 0), b3, voffB);
            PG8_BAR; PG8_WAIT_L(0); PG8_MMA(0, 1, At, B1); PG8_BAR;
            PG8_LDA(At, 1, 1); PG8_STAGE_A(PG8_SA(1, 0), a3, 0, g2);
            PG8_BAR; PG8_WAIT_L(0); PG8_MMA(1, 0, At, B0); PG8_BAR; PG8_SCHED;
            PG8_STAGE(PG8_SB(1, 1), b3 + hstepB, voffB);
            PG8_WAIT_V(6); PG8_BAR; PG8_MMA(1, 1, At, B1); PG8_BAR;
        }
        E(acc, cur, wr, wc, fr, fq);
        if (!has_next) break;
#pragma unroll
        for (int a = 0; a < 2; ++a)
#pragma unroll
            for (int b = 0; b < 2; ++b)
#pragma unroll
                for (int m = 0; m < 4; ++m)
#pragma unroll
                    for (int n = 0; n < 2; ++n) acc[a][b][m][n] = (f32x4){0.f, 0.f, 0.f, 0.f};
        cur = nxt; cA = nA; cB = nB; ++ui;
        if constexpr (GATHER) {
#pragma unroll
            for (int _h = 0; _h < 2; ++_h)
#pragma unroll
                for (int _i = 0; _i < 2; ++_i) gC[_h][_i] = gN[_h][_i]; }
    }
    PG8_WAIT_V(0);
    if (wr == 0) PG8_BAR;
    PG8_BAR;
#undef PG8_SA
#undef PG8_SB
#undef PG8_STAGE
#undef PG8_STAGE_A
#undef PG8_GOFF
#undef PG8_LDA
#undef PG8_LDB
#undef PG8_MMA
#undef PG8_WAIT_V
#undef PG8_WAIT_L
#undef PG8_BAR
#undef PG8_SCHED
}

#define PG8_FOR_PERM(...) \
    _Pragma("unroll") for (int ai = 0; ai < 2; ++ai) _Pragma("unroll") for (int m = 0; m < 4; ++m) { const int tr = ai * 128 + wr * 64 + m * 16 + fr; \
        _Pragma("unroll") for (int bj = 0; bj < 2; ++bj) { const int tc = bj * 128 + wc * 32 + 8 * fq; const f32x4 v0 = acc[ai][bj][m][0], v1 = acc[ai][bj][m][1]; __VA_ARGS__ } }
#define PG8_FOR_NOPERM(...) \
    _Pragma("unroll") for (int ai = 0; ai < 2; ++ai) _Pragma("unroll") for (int m = 0; m < 4; ++m) { const int tr = ai * 128 + wr * 64 + m * 16 + fr; \
        _Pragma("unroll") for (int bj = 0; bj < 2; ++bj) _Pragma("unroll") for (int n = 0; n < 2; ++n) { const int tc = bj * 128 + wc * 32 + 16 * n + 4 * fq; const f32x4 v = acc[ai][bj][m][n]; __VA_ARGS__ } }

typedef const f32x4 (&AccRef)[2][2][4][2];

struct EpiStoreBf16 {
    static constexpr bool PERM = true;
    bf16_t* O; int ldc;
    __device__ __forceinline__ void operator()(AccRef acc, const Unit& u, int wr, int wc, int fr, int fq) const {
        PG8_FOR_PERM({ u32x4 w; w.x = cvt_pk_bf16(v0[0], v0[1]); w.y = cvt_pk_bf16(v0[2], v0[3]); w.z = cvt_pk_bf16(v1[0], v1[1]); w.w = cvt_pk_bf16(v1[2], v1[3]);
            *(u32x4*)(O + (size_t)(u.pm * 256 + tr) * ldc + u.pn * 256 + tc) = w; })
    }
};
struct EpiQ {
    static constexpr bool PERM = false;
    bf16_t* Q; const f32x2* ROPE;
    __device__ __forceinline__ void operator()(AccRef acc, const Unit& u, int wr, int wc, int fr, int fq) const {
#pragma unroll
        for (int ai = 0; ai < 2; ++ai)
#pragma unroll
            for (int m = 0; m < 4; ++m) { const int row = u.pm * 256 + ai * 128 + wr * 64 + m * 16 + fr; const bool lat = row < NLAT; const int t = row & (SEQ - 1);
#pragma unroll
                for (int bj = 0; bj < 2; ++bj) { const int cg = u.pn * 256 + bj * 128 + wc * 32; const int dd = cg % 192; f32x4 a = acc[ai][bj][m][0], b = acc[ai][bj][m][1];
                    if (dd >= 128 && lat) { const int pos = (dd - 128) >= 32 ? (t & 63) : (t >> 6); const f32x4* rp = (const f32x4*)(ROPE + pos * 16 + 4 * fq); const f32x4 r0 = rp[0], r1 = rp[1];
                        const float cs[4] = {r0[0], r0[2], r1[0], r1[2]}, sn[4] = {r0[1], r0[3], r1[1], r1[3]};
#pragma unroll
                        for (int i = 0; i < 4; ++i) { const float x1 = a[i], x2 = b[i]; a[i] = x1 * cs[i] - x2 * sn[i]; b[i] = x2 * cs[i] + x1 * sn[i]; } }
                    a *= QSCALE; b *= QSCALE;
                    bf16_t* o = Q + (size_t)row * 768 + cg + 4 * fq;
                    u32x2 w0; w0.x = cvt_pk_bf16(a[0], a[1]); w0.y = cvt_pk_bf16(a[2], a[3]); *(u32x2*)o = w0;
                    u32x2 w1; w1.x = cvt_pk_bf16(b[0], b[1]); w1.y = cvt_pk_bf16(b[2], b[3]); *(u32x2*)(o + 16) = w1; } }
    }
};
struct EpiK {
    static constexpr bool PERM = true;
    bf16_t* KC;
    __device__ __forceinline__ void operator()(AccRef acc, const Unit& u, int wr, int wc, int fr, int fq) const {
        const int b = u.pm < 32 ? (u.pm >> 3) : (u.pm - 32), key0 = u.pm < 32 ? CTX + (u.pm & 7) * 256 : 0;
        bf16_t* base = KC + ((size_t)(b * 4 + u.pn * 2) * NKEY + key0) * 192 + (size_t)(wr * 64 + fr) * 192 + wc * 32 + 8 * fq;
#pragma unroll
        for (int ai = 0; ai < 2; ++ai)
#pragma unroll
            for (int m = 0; m < 4; ++m)
#pragma unroll
                for (int bj = 0; bj < 2; ++bj) { const f32x4 v0 = acc[ai][bj][m][0], v1 = acc[ai][bj][m][1];
                    u32x4 w; w.x = cvt_pk_bf16(v0[0], v0[1]); w.y = cvt_pk_bf16(v0[2], v0[3]); w.z = cvt_pk_bf16(v1[0], v1[1]); w.w = cvt_pk_bf16(v1[2], v1[3]);
                    *(u32x4*)(base + (size_t)(ai * 128 + m * 16) * 192 + (size_t)bj * NKEY * 192) = w; }
    }
};
struct EpiV {
    static constexpr bool PERM = true;
    bf16_t* VT;
    __device__ __forceinline__ void operator()(AccRef acc, const Unit& u, int wr, int wc, int fr, int fq) const {
        const int b = u.pn < 32 ? (u.pn >> 3) : (u.pn - 32), key0 = u.pn < 32 ? CTX + (u.pn & 7) * 256 : 0;
        bf16_t* base = VT + ((size_t)(b * 4 + u.pm * 2) * 128 + wr * 64 + fr) * NKEY + key0 + wc * 32 + 8 * fq;
#pragma unroll
        for (int ai = 0; ai < 2; ++ai)
#pragma unroll
            for (int m = 0; m < 4; ++m)
#pragma unroll
                for (int bj = 0; bj < 2; ++bj) { const f32x4 v0 = acc[ai][bj][m][0], v1 = acc[ai][bj][m][1];
                    u32x4 w; w.x = cvt_pk_bf16(v0[0], v0[1]); w.y = cvt_pk_bf16(v0[2], v0[3]); w.z = cvt_pk_bf16(v1[0], v1[1]); w.w = cvt_pk_bf16(v1[2], v1[3]);
                    *(u32x4*)(base + (size_t)(ai * 128 + m * 16) * NKEY + bj * 128) = w; }
    }
};
struct EpiS1 {
    static constexpr bool PERM = false;
    float* EST;
    __device__ __forceinline__ void operator()(AccRef acc, const Unit& u, int wr, int wc, int fr, int fq) const {
        PG8_FOR_NOPERM({ const int row = u.pm * 256 + tr; if (row < NCHUNK) *(f32x4*)(EST + ((size_t)u.pb * 768 + row) * 256 + tc) = v; })
    }
};
struct EpiS2 {
    static constexpr bool PERM = true;
    bf16_t* GB;
    __device__ __forceinline__ void operator()(AccRef acc, const Unit& u, int wr, int wc, int fr, int fq) const {
        PG8_FOR_PERM({ const int row = u.pm * 256 + tr; if (row < NCHUNK) { const int p = tc >> 4, c = tc & 15;
            u32x4 w; w.x = cvt_pk_bf16(gelu_tanh(v0[0]), gelu_tanh(v0[1])); w.y = cvt_pk_bf16(gelu_tanh(v0[2]), gelu_tanh(v0[3]));
            w.z = cvt_pk_bf16(gelu_tanh(v1[0]), gelu_tanh(v1[1])); w.w = cvt_pk_bf16(gelu_tanh(v1[2]), gelu_tanh(v1[3]));
            *(u32x4*)(GB + (size_t)(row * 16 + p) * 512 + u.pb * 16 + c) = w; } })
    }
};
struct EpiGlu {
    static constexpr bool PERM = true;
    const bf16_t* GB; const float* bias; bf16_t* CAT;
    __device__ __forceinline__ void operator()(AccRef acc, const Unit& u, int wr, int wc, int fr, int fq) const {
        PG8_FOR_PERM({ const int row = u.pm * 256 + tr, col = u.pn * 256 + tc;
            const u32x4 gv = *(const u32x4*)(GB + (size_t)row * 512 + col); const f32x4 b0 = *(const f32x4*)(bias + col), b1 = *(const f32x4*)(bias + col + 4);
            u32x4 w;
            w.x = cvt_pk_bf16(bflo(gv.x) * sigmoid_f(v0[0] + b0[0]), bfhi(gv.x) * sigmoid_f(v0[1] + b0[1]));
            w.y = cvt_pk_bf16(bflo(gv.y) * sigmoid_f(v0[2] + b0[2]), bfhi(gv.y) * sigmoid_f(v0[3] + b0[3]));
            w.z = cvt_pk_bf16(bflo(gv.z) * sigmoid_f(v1[0] + b1[0]), bfhi(gv.z) * sigmoid_f(v1[1] + b1[1]));
            w.w = cvt_pk_bf16(bflo(gv.w) * sigmoid_f(v1[2] + b1[2]), bfhi(gv.w) * sigmoid_f(v1[3] + b1[3]));
            *(u32x4*)(CAT + (size_t)row * DM + 1024 + col) = w; })
    }
};
struct EpiOut {
    static constexpr bool PERM = false;
    const float* xl; const float* xc; const float* gate; float* xo;
    __device__ __forceinline__ void operator()(AccRef acc, const Unit& u, int wr, int wc, int fr, int fq) const {
        PG8_FOR_NOPERM({ const int row = u.pm * 256 + tr, col = u.pn * 256 + tc; const int rr = row < NLAT ? (row >> 11) : 4;
            const float* src = row < NLAT ? xl + (size_t)row * DM : xc + (size_t)(row - NLAT) * DM;
            const f32x4 xv = *(const f32x4*)(src + col), gv = *(const f32x4*)(gate + (size_t)rr * 12288 + col);
            *(f32x4*)(xo + (size_t)row * DM + col) = xv + gv * v; })
    }
};
struct EpiGU {
    static constexpr bool PERM = true;
    bf16_t* HID;
    __device__ __forceinline__ void operator()(AccRef acc, const Unit& u, int wr, int wc, int fr, int fq) const {
        PG8_FOR_PERM({ const int row = u.pm * 256 + tr, j = (u.pn * 256 + tc) >> 1;
            u32x2 w; w.x = cvt_pk_bf16(silu_f(v0[0]) * v0[1], silu_f(v0[2]) * v0[3]); w.y = cvt_pk_bf16(silu_f(v1[0]) * v1[1], silu_f(v1[2]) * v1[3]);
            *(u32x2*)(HID + ((size_t)u.pb * EROWS + row) * FF + j) = w; })
    }
};
struct EpiDown {
    static constexpr bool PERM = true;
    bf16_t* YS; const float* RA;
    __device__ __forceinline__ void operator()(AccRef acc, const Unit& u, int wr, int wc, int fr, int fq) const {
        PG8_FOR_PERM({ const int row = u.pm * 256 + tr, col = u.pn * 256 + tc; const float a = RA[u.pb * EROWS + row];
            u32x4 w; w.x = cvt_pk_bf16(v0[0] * a, v0[1] * a); w.y = cvt_pk_bf16(v0[2] * a, v0[3] * a); w.z = cvt_pk_bf16(v1[0] * a, v1[1] * a); w.w = cvt_pk_bf16(v1[2] * a, v1[3] * a);
            *(u32x4*)(YS + ((size_t)u.pb * EROWS + row) * DM + col) = w; })
    }
};
}

struct Params { const float* in[33]; float* out; unsigned char* ws; int ph_lo, ph_hi; };
enum { I_X = 0, I_C, I_CTX, I_CCTX, I_N1G, I_N2G, I_WADA, I_BADA, I_WIN, I_WOUT, I_SGUNG, I_SGUW, I_SGUB, I_QNG, I_WUQ, I_KVNG, I_WUKV,
       I_ARE, I_AIM, I_LOGDT, I_BRE, I_BIM, I_CRE, I_CIM, I_S5D, I_WGLU, I_BGLU, I_CONVW, I_WROUTER, I_WGATE, I_WUP, I_WDOWN, I_FNG };

__device__ __forceinline__ void transpose_tile(const float* src, int N, int k0, int n0, bf16_t* dst, int ldd, int rmul, int radd, int remap_kv, LAS float* tile) {
    const int tid = threadIdx.x;
#pragma unroll
    for (int i = 0; i < 2; ++i) { const int r = (tid >> 4) + 32 * i, c4 = (tid & 15) * 4;
        const f32x4 v = *(const f32x4*)(src + (size_t)(k0 + r) * N + n0 + c4);
        tile[r * 65 + c4 + 0] = v[0]; tile[r * 65 + c4 + 1] = v[1]; tile[r * 65 + c4 + 2] = v[2]; tile[r * 65 + c4 + 3] = v[3]; }
    __syncthreads();
    { const int n = tid >> 3, kc = tid & 7; float f[8];
#pragma unroll
        for (int j = 0; j < 8; ++j) f[j] = tile[(kc * 8 + j) * 65 + n];
        int nn = n0 + n; if (remap_kv) nn = ((nn & 255) < 128) ? ((nn >> 8) * 128 + (nn & 127)) : (512 + (nn >> 8) * 128 + (nn & 127));
        const int drow = nn * rmul + radd;
        u32x4 w; w.x = cvt_pk_bf16(f[0], f[1]); w.y = cvt_pk_bf16(f[2], f[3]); w.z = cvt_pk_bf16(f[4], f[5]); w.w = cvt_pk_bf16(f[6], f[7]);
        *(u32x4*)(dst + (size_t)drow * ldd + k0 + kc * 8) = w; }
    __syncthreads();
}
constexpr int N_ADA_UNITS = 192, N_S5T_UNITS = 64, N_ROPE_UNITS = 2;
constexpr int T_WIN = 32 * 59, T_WOUT = 32 * 32, T_WUQ = 6 * 12, T_WUKV = 4 * 16, T_WGLU = 8 * 8, T_EXP = 512;
constexpr int N_TR = 2 * (T_WIN + T_WOUT + T_WUQ + T_WUKV + T_WGLU);
constexpr int N_PRO_ITEMS = N_ADA_UNITS + N_S5T_UNITS + N_ROPE_UNITS + N_TR;


__device__ __forceinline__ void transpose_block(const float* src, int N, int k0, int n0, bf16_t* dst, int ldd, int rmul, int radd, LAS float* tile  ) {
    const int tid = opaque_tid();
    f32x4 v[8];
#pragma unroll
    for (int i = 0; i < 8; ++i) v[i] = __builtin_nontemporal_load((const f32x4*)(src + (size_t)(k0 + (tid >> 6) + 8 * i) * N + n0 + (tid & 63) * 4));
#pragma unroll
    for (int i = 0; i < 8; ++i) { const int r = (tid >> 6) + 8 * i; *(LAS f32x4*)(tile + r * 260 + (((tid & 63) * 4) ^ (8 * (r >> 3)))) = v[i]; }
    __syncthreads();
#pragma unroll
    for (int i = 0; i < 4; ++i) { const int id = tid + 512 * i, n = id >> 3, kc = id & 7; float f[8];
#pragma unroll
        for (int j = 0; j < 8; ++j) f[j] = tile[(kc * 8 + j) * 260 + (n ^ (8 * kc))];
        u32x4 w; w.x = cvt_pk_bf16(f[0], f[1]); w.y = cvt_pk_bf16(f[2], f[3]); w.z = cvt_pk_bf16(f[4], f[5]); w.w = cvt_pk_bf16(f[6], f[7]);
        *(u32x4*)(dst + (size_t)((n0 + n) * rmul + radd) * ldd + k0 + kc * 8) = w; }
    __syncthreads();
}
constexpr int QB_EXP = T_EXP / 4, Q_GU = NE * 2 * QB_EXP, Q_LAYER = Q_GU + NE * QB_EXP, Q_TOTAL = 2 * Q_LAYER;
constexpr int CW_QHEAD = 4096, CW_DONE = 4160;
static_assert((CW_DONE + 64 * 32) * 4 <= (int)CTL_BYTES, "control words inside the memset region");
__device__ __forceinline__ void moe_convert_block(const Params& p, unsigned char* ws, int t, LAS float* tile) {
    const int l = t / Q_LAYER, r = t % Q_LAYER;
    if (r < Q_GU) { const int e = r / (2 * QB_EXP), rr = r % (2 * QB_EXP), up = rr / QB_EXP, q = rr % QB_EXP; const int le = l * NE + e;
        transpose_block((up ? p.in[I_WUP] : p.in[I_WGATE]) + (size_t)le * DM * FF, FF, (q >> 2) * 64, (q & 3) * 256, (bf16_t*)(ws + WS_WTGU) + (size_t)le * 2048 * DM, DM, 2, up, tile); }
    else { const int r2 = r - Q_GU, e = r2 / QB_EXP, q = r2 % QB_EXP; const int le = l * NE + e;
        transpose_block(p.in[I_WDOWN] + (size_t)le * FF * DM, DM, (q >> 3) * 64, (q & 7) * 256, (bf16_t*)(ws + WS_WTDN) + (size_t)le * DM * FF, FF, 1, 0, tile); }
}
#ifndef FILL_ON
#define FILL_ON 0
#endif
constexpr unsigned Q_BULK = 4;
__device__ __forceinline__ unsigned moe_claim(unsigned* ctl, int ph, int upto, int mode) {
    unsigned t = 0xffffffffu;
    const unsigned head = __hip_atomic_load(ctl + CW_QHEAD, __ATOMIC_RELAXED, __HIP_MEMORY_SCOPE_AGENT);
    const bool go = mode ? (head < (unsigned)upto) : (head < (unsigned)Q_TOTAL && __hip_atomic_load(ctl + CW_DONE + 64 * ph, __ATOMIC_RELAXED, __HIP_MEMORY_SCOPE_AGENT) < gridDim.x);
    if (go) t = __hip_atomic_fetch_add(ctl + CW_QHEAD, mode ? Q_BULK : 1u, __ATOMIC_RELAXED, __HIP_MEMORY_SCOPE_AGENT);
    return t;
}
__device__ __forceinline__ void moe_pump(const Params& p, LAS unsigned char* lds, int ph, int upto, int mode) {
    unsigned char* ws = opaque_ptr(p.ws); unsigned* ctl = (unsigned*)(ws + WS_CTL);
    LAS float* tile = (LAS float*)lds; volatile LAS unsigned* slot = (volatile LAS unsigned*)(lds + LDS_MISC + 32);
    const int tid = opaque_tid(); const int nblk = mode ? (int)Q_BULK : 1;
    __syncthreads();
    if (tid == 0) { if (mode == 0) (void)__hip_atomic_fetch_add(ctl + CW_DONE + 64 * ph, 1u, __ATOMIC_RELAXED, __HIP_MEMORY_SCOPE_AGENT); slot[0] = moe_claim(ctl, ph, upto, mode); }
    __syncthreads();
    for (;;) {
        const unsigned t = slot[0];
        if (t >= (unsigned)Q_TOTAL) break;
        unsigned nxt = 0u;
        if (tid == 0) nxt = moe_claim(ctl, ph, upto, mode);
#pragma unroll 1
        for (int k = 0; k < nblk; ++k) if ((int)t + k < Q_TOTAL) moe_convert_block(p, ws, (int)t + k, tile);
        if (tid == 0) slot[0] = nxt;
        __syncthreads();
    }
}
__device__ __forceinline__ void moe_fill(const Params& p, LAS unsigned char* lds, int ph) { if (FILL_ON) moe_pump(p, lds, ph, Q_TOTAL, 0); }
__device__ __forceinline__ void moe_require(const Params& p, LAS unsigned char* lds, int upto) { moe_pump(p, lds, 0, upto, 1); }

__device__ __forceinline__ void ph_prologue(const Params& p, LAS unsigned char* lds) {
    const int tid = opaque_tid(), lane = tid & 63, wave = tid >> 6;
    unsigned char* ws = opaque_ptr(p.ws);
    for (int it = blockIdx.x; it < N_PRO_ITEMS; it += gridDim.x) {
        if (it < N_ADA_UNITS) {
            const int l = it / 96, cb = it % 96;
            LAS float* sil = (LAS float*)lds;
            LAS float* red = (LAS float*)(lds + 40960);
            for (int i = tid; i < 5 * DM; i += 512) { const int r = i >> 11, k = i & (DM - 1); const float v = r < 4 ? p.in[I_C][r * DM + k] : p.in[I_CCTX][k]; sil[i] = silu_f(v); }
            __syncthreads();
            f32x2 acc[5];
#pragma unroll
            for (int r = 0; r < 5; ++r) acc[r] = (f32x2){0.f, 0.f};
            const float* W = p.in[I_WADA] + (size_t)l * DM * 12288 + cb * 128 + lane * 2;
            for (int k = wave * 256; k < wave * 256 + 256; k += 16) {
                f32x2 w[16];
#pragma unroll
                for (int j = 0; j < 16; ++j) w[j] = __builtin_nontemporal_load((const f32x2*)(W + (size_t)(k + j) * 12288));
#pragma unroll
                for (int j = 0; j < 16; ++j)
#pragma unroll
                    for (int r = 0; r < 5; ++r) acc[r] += sil[r * DM + k + j] * w[j];
            }
#pragma unroll
            for (int r = 0; r < 5; ++r) { red[(wave * 5 + r) * 128 + lane * 2] = acc[r].x; red[(wave * 5 + r) * 128 + lane * 2 + 1] = acc[r].y; }
            __syncthreads();
            float* mod = (float*)(ws + WS_MOD);
            for (int o = tid; o < 5 * 128; o += 512) { const int r = o >> 7, cc = o & 127; float sum = p.in[I_BADA][l * 12288 + cb * 128 + cc];
#pragma unroll
                for (int w8 = 0; w8 < 8; ++w8) sum += red[(w8 * 5 + r) * 128 + cc];
                mod[(size_t)(l * 5 + r) * 12288 + cb * 128 + cc] = sum; }
            __syncthreads();
        } else if (it < N_ADA_UNITS + N_S5T_UNITS) {
            const int lg = it - N_ADA_UNITS, l = lg >> 5, g = lg & 31;
            LAS f32x2* PWl = (LAS f32x2*)lds;
            LAS f32x2* BBl = (LAS f32x2*)(lds + 17408);
            LAS f32x2* Cl = (LAS f32x2*)(lds + 33792);
            LAS float* KZl = (LAS float*)(lds + 50176);
            for (int idx = tid; idx < 2 * 64 * 17; idx += 512) { const int z = idx / (64 * 17), n = (idx / 17) & 63, d = idx % 17; const int zgn = ((l * 2 + z) * 32 + g) * 64 + n;
                const float are = fminf(p.in[I_ARE][zgn], -1e-4f), aim = p.in[I_AIM][zgn]; const float dt = expf(p.in[I_LOGDT][zgn >> 6]);
                const double mag = exp((double)are * (double)dt * d); double sn, cs; sincos((double)aim * (double)dt * d, &sn, &cs);
                const f32x2 v = {(float)(mag * cs), (float)(mag * sn)}; PWl[idx] = v; if (d == 16) ((f32x2*)(ws + WS_A16))[zgn] = v; }
            for (int idx = tid; idx < 2 * 64 * 16; idx += 512) { const int z = idx >> 10, n = (idx >> 4) & 63, c = idx & 15; const int zgn = ((l * 2 + z) * 32 + g) * 64 + n;
                const float are = fminf(p.in[I_ARE][zgn], -1e-4f), aim = p.in[I_AIM][zgn]; const float dt = expf(p.in[I_LOGDT][zgn >> 6]);
                const double mag = exp((double)are * (double)dt); double sn, cs; sincos((double)aim * (double)dt, &sn, &cs);
                const float xr = (float)(mag * cs) - 1.0f, xi = (float)(mag * sn), den = 1.0f / (are * are + aim * aim);
                const float cr = (xr * are + xi * aim) * den, ci = (xi * are - xr * aim) * den;
                const float br = p.in[I_BRE][(size_t)zgn * 16 + c], bi = p.in[I_BIM][(size_t)zgn * 16 + c]; BBl[idx] = (f32x2){cr * br - ci * bi, cr * bi + ci * br}; }
            for (int idx = tid; idx < 2 * 16 * 64; idx += 512) { const int z = idx >> 10, cn = idx & 1023; const size_t src = ((size_t)((l * 2 + z) * 32 + g) * 16) * 64 + cn; Cl[idx] = (f32x2){p.in[I_CRE][src], p.in[I_CIM][src]}; }
            __syncthreads();
            { const int z = tid >> 8, d = (tid >> 4) & 15, c = tid & 15; float a16[16];
#pragma unroll
              for (int q = 0; q < 16; ++q) a16[q] = 0.f;
              for (int n = 0; n < 64; ++n) { const f32x2 pw = PWl[(z * 64 + n) * 17 + d], cm = Cl[(z * 16 + c) * 64 + n]; const float tr = cm.x * pw.x - cm.y * pw.y, ti = cm.x * pw.y + cm.y * pw.x;
#pragma unroll
                  for (int q = 0; q < 16; ++q) { const f32x2 bb = BBl[(z * 64 + n) * 16 + q]; a16[q] += tr * bb.x - ti * bb.y; } }
#pragma unroll
              for (int q = 0; q < 16; ++q) KZl[((z * 16 + d) * 16 + c) * 16 + q] = a16[q]; }
            __syncthreads();
            bf16_t* WST = (bf16_t*)(ws + WS_WST) + (size_t)lg * 256 * 256; bf16_t* G2B = (bf16_t*)(ws + WS_G2B) + (size_t)lg * 256 * 512;
            for (int i = 0; i < 16; ++i) { const int id = tid + 512 * i;
                {
                  const int c8 = (id & 1) * 8, pp = (id >> 1) & 15, row = id >> 5, z = row >> 7, ri = (row >> 6) & 1, n = row & 63;
                  const f32x2 pw = PWl[(z * 64 + n) * 17 + (z == 0 ? 15 - pp : pp)]; float f[8];
#pragma unroll
                  for (int j = 0; j < 8; ++j) { const f32x2 bb = BBl[(z * 64 + n) * 16 + c8 + j]; f[j] = ri == 0 ? (pw.x * bb.x - pw.y * bb.y) : (pw.x * bb.y + pw.y * bb.x); }
                  u32x4 w; w.x = cvt_pk_bf16(f[0], f[1]); w.y = cvt_pk_bf16(f[2], f[3]); w.z = cvt_pk_bf16(f[4], f[5]); w.w = cvt_pk_bf16(f[6], f[7]);
                  *(u32x4*)(WST + (size_t)row * 256 + pp * 16 + c8) = w; }
                {
                  const int n8 = (id & 7) * 8, ri = (id >> 3) & 1, z = (id >> 4) & 1, row = id >> 5, pp = row >> 4, c = row & 15; float f[8];
#pragma unroll
                  for (int j = 0; j < 8; ++j) { const f32x2 pw = PWl[(z * 64 + n8 + j) * 17 + (z == 0 ? pp + 1 : 16 - pp)], cm = Cl[(z * 16 + c) * 64 + n8 + j]; f[j] = ri == 0 ? (cm.x * pw.x - cm.y * pw.y) : -(cm.x * pw.y + cm.y * pw.x); }
                  u32x4 w; w.x = cvt_pk_bf16(f[0], f[1]); w.y = cvt_pk_bf16(f[2], f[3]); w.z = cvt_pk_bf16(f[4], f[5]); w.w = cvt_pk_bf16(f[6], f[7]);
                  *(u32x4*)(G2B + (size_t)row * 512 + 256 + z * 128 + ri * 64 + n8) = w; }
                {
                  const int c8 = (id & 1) * 8, pq = (id >> 1) & 15, row = id >> 5, pp = row >> 4, c = row & 15; float f[8];
#pragma unroll
                  for (int j = 0; j < 8; ++j) { float v = 0.f; if (pq <= pp) v += KZl[((0 * 16 + (pp - pq)) * 16 + c) * 16 + c8 + j]; if (pq >= pp) v += KZl[((1 * 16 + (pq - pp)) * 16 + c) * 16 + c8 + j];
                      if (pq == pp && c8 + j == c) v += p.in[I_S5D][l * 512 + g * 16 + c]; f[j] = v; }
                  u32x4 w; w.x = cvt_pk_bf16(f[0], f[1]); w.y = cvt_pk_bf16(f[2], f[3]); w.z = cvt_pk_bf16(f[4], f[5]); w.w = cvt_pk_bf16(f[6], f[7]);
                  *(u32x4*)(G2B + (size_t)row * 512 + pq * 16 + c8) = w; } }
            __syncthreads();
        } else if (it < N_ADA_UNITS + N_S5T_UNITS + N_ROPE_UNITS) {
            const int idx = (it - N_ADA_UNITS - N_S5T_UNITS) * 512 + tid; const int pos = idx >> 4, f = idx & 15;
            const float invf = powf(10000.0f, -(float)f * 0.0625f); const float ang = (float)pos * invf;
            ((f32x2*)(ws + WS_ROPE))[idx] = (f32x2){cosf(ang), sinf(ang)};
        } else {
            int t = it - N_ADA_UNITS - N_S5T_UNITS - N_ROPE_UNITS;
            LAS float* tile = (LAS float*)lds;
            if (t < 2 * T_WIN) { const int l = t / T_WIN, r = t % T_WIN; transpose_tile(p.in[I_WIN] + (size_t)l * DM * INC, INC, (r % 32) * 64, (r / 32) * 64, (bf16_t*)(ws + WS_WTIN) + (size_t)l * INP * DM, DM, 1, 0, 0, tile); continue; }
            t -= 2 * T_WIN;
            if (t < 2 * T_WOUT) { const int l = t / T_WOUT, r = t % T_WOUT; transpose_tile(p.in[I_WOUT] + (size_t)l * DM * DM, DM, (r % 32) * 64, (r / 32) * 64, (bf16_t*)(ws + WS_WTOUT) + (size_t)l * DM * DM, DM, 1, 0, 0, tile); continue; }
            t -= 2 * T_WOUT;
            if (t < 2 * T_WUQ) { const int l = t / T_WUQ, r = t % T_WUQ; transpose_tile(p.in[I_WUQ] + (size_t)l * 384 * 768, 768, (r % 6) * 64, (r / 6) * 64, (bf16_t*)(ws + WS_WTUQ) + (size_t)l * 768 * 384, 384, 1, 0, 0, tile); continue; }
            t -= 2 * T_WUQ;
            if (t < 2 * T_WUKV) { const int l = t / T_WUKV, r = t % T_WUKV; transpose_tile(p.in[I_WUKV] + (size_t)l * 256 * 1024, 1024, (r % 4) * 64, (r / 4) * 64, (bf16_t*)(ws + WS_WTUKV) + (size_t)l * 1024 * 256, 256, 1, 0, 1, tile); continue; }
            t -= 2 * T_WUKV;
            if (t < 2 * T_WGLU) { const int l = t / T_WGLU, r = t % T_WGLU; transpose_tile(p.in[I_WGLU] + (size_t)l * 512 * 512, 512, (r % 8) * 64, (r / 8) * 64, (bf16_t*)(ws + WS_WTGLU) + (size_t)l * 512 * 512, 512, 1, 0, 0, tile); continue; }
        }
    }
}

__device__ __forceinline__ void rms_mod_store(const f32x4 (&x)[8], const float* g, const float* scale, const float* shift, bf16_t* orow, f32x4 (&y)[8], int lane) {
    float ss = 0.f;
#pragma unroll
    for (int j = 0; j < 8; ++j) ss += x[j][0] * x[j][0] + x[j][1] * x[j][1] + x[j][2] * x[j][2] + x[j][3] * x[j][3];
    ss = wave_sum(ss);
    const float rinv = rsqrtf(ss * (1.0f / DM) + EPS);
#pragma unroll
    for (int j = 0; j < 8; ++j) { const int c = j * 256 + lane * 4;
        const f32x4 gv = *(const f32x4*)(g + c), sc = *(const f32x4*)(scale + c), sh = *(const f32x4*)(shift + c);
        y[j] = x[j] * rinv * gv * (1.0f + sc) + sh;
        u32x2 w; w.x = cvt_pk_bf16(y[j][0], y[j][1]); w.y = cvt_pk_bf16(y[j][2], y[j][3]); *(u32x2*)(orow + c) = w; }
}

constexpr int N1_ROWITEMS = MT / 8, N1_KZ = 64, N1_WST = 1024, N1_INTER = 1024;
__device__ __forceinline__ void ph_norm1_tables(const Params& p) {
    const int tid = opaque_tid(), lane = tid & 63, wave = tid >> 6;
    unsigned char* ws = opaque_ptr(p.ws);
    const float* mod = (const float*)(ws + WS_MOD);
    for (int it = blockIdx.x; it < N1_ROWITEMS; it += gridDim.x) {
        {
            const int row = it * 8 + wave; const int rr = row < NLAT ? (row >> 11) : 4;
            const float* xr = row < NLAT ? p.in[I_X] + (size_t)row * DM : p.in[I_CTX] + (size_t)(row - NLAT) * DM;
            f32x4 x[8], y[8];
#pragma unroll
            for (int j = 0; j < 8; ++j) x[j] = *(const f32x4*)(xr + j * 256 + lane * 4);
            const float* m = mod + (size_t)rr * 12288;
            rms_mod_store(x, p.in[I_N1G], m + DM, m, (bf16_t*)(ws + WS_H) + (size_t)row * DM, y, lane);
        }
    }
}

constexpr int B_ROWITEMS = MT / 8, B_SGU = 72 * 4, B_INTRA = 0;
__device__ __forceinline__ void ph_rowsplit(const Params& p, int l, LAS unsigned char* lds) {
    const int tid = opaque_tid(), lane = tid & 63, wave = tid >> 6;
    unsigned char* ws = opaque_ptr(p.ws);
    const bf16_t* P = (const bf16_t*)(ws + WS_PA);
    bf16_t* CAT = (bf16_t*)(ws + WS_CAT);
    const int nsgu = (l == 0) ? B_SGU : 256;
    for (int it0 = blockIdx.x; it0 < B_ROWITEMS + nsgu; it0 += gridDim.x) {
        const int it = it0 < nsgu ? B_ROWITEMS + it0 : it0 - nsgu;
        if (it < B_ROWITEMS) {
            const int row = it * 8 + wave; const bf16_t* pr = P + (size_t)row * INP;
            const bool lat = row < NLAT; const int t = lat ? (row & (SEQ - 1)) : ((row - NLAT) & (CTX - 1)); const int b = lat ? (row >> 11) : ((row - NLAT) >> 8);
            const int seqlen = lat ? SEQ : CTX;
            { float f[8]; float ss = 0.f;
              if (lane < 48) { const u32x4 v = *(const u32x4*)(pr + C_CQ + lane * 8); f[0] = bflo(v.x); f[1] = bfhi(v.x); f[2] = bflo(v.y); f[3] = bfhi(v.y); f[4] = bflo(v.z); f[5] = bfhi(v.z); f[6] = bflo(v.w); f[7] = bfhi(v.w);
#pragma unroll
                  for (int j = 0; j < 8; ++j) ss += f[j] * f[j]; }
              else {
#pragma unroll
                  for (int j = 0; j < 8; ++j) f[j] = 0.f; }
              ss = wave_sum(ss); const float rinv = rsqrtf(ss * (1.0f / 384.0f) + EPS);
              if (lane < 48) { const float* g = p.in[I_QNG] + l * 384 + lane * 8; u32x4 w;
                  w.x = cvt_pk_bf16(f[0] * rinv * g[0], f[1] * rinv * g[1]); w.y = cvt_pk_bf16(f[2] * rinv * g[2], f[3] * rinv * g[3]);
                  w.z = cvt_pk_bf16(f[4] * rinv * g[4], f[5] * rinv * g[5]); w.w = cvt_pk_bf16(f[6] * rinv * g[6], f[7] * rinv * g[7]);
                  *(u32x4*)((bf16_t*)(ws + WS_QA) + (size_t)row * 384 + lane * 8) = w; } }
            { const u32x2 v = *(const u32x2*)(pr + C_CKV + lane * 4); const float f0 = bflo(v.x), f1 = bfhi(v.x), f2 = bflo(v.y), f3 = bfhi(v.y);
              const float ss = wave_sum(f0 * f0 + f1 * f1 + f2 * f2 + f3 * f3); const float rinv = rsqrtf(ss * (1.0f / 256.0f) + EPS);
              const float* g = p.in[I_KVNG] + l * 256 + lane * 4; u32x2 w; w.x = cvt_pk_bf16(f0 * rinv * g[0], f1 * rinv * g[1]); w.y = cvt_pk_bf16(f2 * rinv * g[2], f3 * rinv * g[3]);
              *(u32x2*)((bf16_t*)(ws + WS_KVA) + (size_t)row * 256 + lane * 4) = w; }
            { float v = bf2f(pr[C_KR + lane]); const float partner = __shfl_xor(v, 16);
              if (lat) { const int jj = lane & 31, fi = jj & 15; const int pos = lane >= 32 ? (t & 63) : (t >> 6);
                  const f32x2 r = ((const f32x2*)(ws + WS_ROPE))[pos * 16 + fi]; const float cs = r.x, sn = r.y;
                  v = jj < 16 ? (v * cs - partner * sn) : (v * cs + partner * sn); }
              const int key = lat ? CTX + t : t; const unsigned short o = f2bf(v);
              bf16_t* kc = (bf16_t*)(ws + WS_KC);
#pragma unroll
              for (int h = 0; h < 4; ++h) kc[((size_t)(b * 4 + h) * NKEY + key) * 192 + 128 + lane] = o; }
            { const u32x4 v = *(const u32x4*)(pr + C_S5 + lane * 8); const int g = lane >> 1, half = lane & 1;
              *(u32x4*)((bf16_t*)(ws + WS_UPK) + ((size_t)g * 768 + (row >> 4)) * 512 + (row & 15) * 16 + half * 8) = v; }
            { const int c0 = lane * 8; float zp[8], zc[8], zn[8];
#pragma unroll
              for (int j = 0; j < 8; ++j) { zp[j] = 0.f; zn[j] = 0.f; }
#define CONV_Z(dst, rp) do { const u32x4 a_ = *(const u32x4*)((rp) + C_CVC + c0); const u32x4 h_ = *(const u32x4*)((rp) + C_CVH + c0); \
                  dst[0] = bflo(a_.x) * bflo(h_.x); dst[1] = bfhi(a_.x) * bfhi(h_.x); dst[2] = bflo(a_.y) * bflo(h_.y); dst[3] = bfhi(a_.y) * bfhi(h_.y); \
                  dst[4] = bflo(a_.z) * bflo(h_.z); dst[5] = bfhi(a_.z) * bfhi(h_.z); dst[6] = bflo(a_.w) * bflo(h_.w); dst[7] = bfhi(a_.w) * bfhi(h_.w); } while (0)
              CONV_Z(zc, pr);
              if (t > 0) CONV_Z(zp, pr - INP);
              if (t < seqlen - 1) CONV_Z(zn, pr + INP);
#undef CONV_Z
              const u32x4 bg = *(const u32x4*)(pr + C_CVB + c0); float bgf[8] = {bflo(bg.x), bfhi(bg.x), bflo(bg.y), bfhi(bg.y), bflo(bg.z), bfhi(bg.z), bflo(bg.w), bfhi(bg.w)};
              const float* cw = p.in[I_CONVW] + (size_t)l * 3 * 512 + c0; float o[8];
#pragma unroll
              for (int j = 0; j < 8; ++j) o[j] = bgf[j] * (cw[j] * zp[j] + cw[512 + j] * zc[j] + cw[1024 + j] * zn[j]);
              u32x4 w; w.x = cvt_pk_bf16(o[0], o[1]); w.y = cvt_pk_bf16(o[2], o[3]); w.z = cvt_pk_bf16(o[4], o[5]); w.w = cvt_pk_bf16(o[6], o[7]);
              *(u32x4*)(CAT + (size_t)row * DM + 1536 + c0) = w; }
        } else if (it < B_ROWITEMS + B_SGU) {
            const int un = it - B_ROWITEMS, cc = un >> 2, h = un & 3; const int row0 = cc * 128;
            LAS bf16_t* Wl = (LAS bf16_t*)lds;
            LAS bf16_t* Vl = (LAS bf16_t*)(lds + 128 * 136 * 2);
            const float* Wg = p.in[I_SGUW] + ((size_t)l * 4 + h) * 128 * 128;
#pragma unroll
            for (int i = 0; i < 8; ++i) { const int e4 = (i * 512 + tid) * 4, r = e4 >> 7, c = e4 & 127; const f32x4 v = *(const f32x4*)(Wg + e4);
                u32x2 w; w.x = cvt_pk_bf16(v[0], v[1]); w.y = cvt_pk_bf16(v[2], v[3]); *(LAS u32x2*)(Wl + r * 136 + c) = w; }
            u32x4 vv[16];
#pragma unroll
            for (int qi = 0; qi < 16; ++qi) vv[qi] = *(const u32x4*)(P + (size_t)(row0 + wave * 16 + qi) * INP + C_SGU_V + lane * 8);
#pragma unroll
            for (int qi = 0; qi < 16; ++qi) { const int q = wave * 16 + qi;
                const u32x4 v = vv[qi]; float f[8] = {bflo(v.x), bfhi(v.x), bflo(v.y), bfhi(v.y), bflo(v.z), bfhi(v.z), bflo(v.w), bfhi(v.w)}; float ss = 0.f;
#pragma unroll
                for (int j = 0; j < 8; ++j) { f[j] = gelu_tanh(f[j]); ss += f[j] * f[j]; }
                ss = wave_sum(ss); const float rinv = rsqrtf(ss * (1.0f / 512.0f) + EPS);
                if ((lane >> 4) == h) { const int c0 = (lane & 15) * 8; const float* g = p.in[I_SGUNG] + l * 512 + h * 128 + c0;
#pragma unroll
                    for (int j = 0; j < 8; ++j) Vl[(c0 + j) * 136 + q] = f2bf(f[j] * rinv * g[j]); } }
            __syncthreads();
            { const int fr = lane & 15, fq = lane >> 4; f32x4 acc[8];
#pragma unroll
              for (int nb = 0; nb < 8; ++nb) acc[nb] = (f32x4){0.f, 0.f, 0.f, 0.f};
#pragma unroll
              for (int ks = 0; ks < 4; ++ks) { const bf16x8 af = *(const LAS bf16x8*)(Wl + (wave * 16 + fr) * 136 + ks * 32 + fq * 8);
#pragma unroll
                  for (int nb = 0; nb < 8; ++nb) { const bf16x8 bfr = *(const LAS bf16x8*)(Vl + (nb * 16 + fr) * 136 + ks * 32 + fq * 8);
                      acc[nb] = __builtin_amdgcn_mfma_f32_16x16x32_bf16(bfr, af, acc[nb], 0, 0, 0); } }
              const int pp = wave * 16 + fr; const float bias = p.in[I_SGUB][((size_t)l * 4 + h) * 128 + pp]; const bf16_t* pr = P + (size_t)(row0 + pp) * INP + C_SGU_U + h * 128;
#pragma unroll
              for (int nb = 0; nb < 8; ++nb) { const int c = nb * 16 + 4 * fq; const u32x2 uv = *(const u32x2*)(pr + c);
                  u32x2 w; w.x = cvt_pk_bf16(gelu_tanh(bflo(uv.x)) * (acc[nb][0] + bias), gelu_tanh(bfhi(uv.x)) * (acc[nb][1] + bias));
                  w.y = cvt_pk_bf16(gelu_tanh(bflo(uv.y)) * (acc[nb][2] + bias), gelu_tanh(bfhi(uv.y)) * (acc[nb][3] + bias));
                  *(u32x2*)(CAT + (size_t)(row0 + pp) * DM + h * 128 + c) = w; } }
            __syncthreads();
        }
    }
}

constexpr int KPITCH = 400, VPITCH = 144;
constexpr int KT_BYTES = 64 * KPITCH, VT_BYTES = 128 * VPITCH;
__device__ __forceinline__ void attn_unit(const bf16_t* Qrows  , const bf16_t* Kbh, const bf16_t* Vbh, int nkeys, bf16_t* Orows, LAS unsigned char* lds) {
    const int tid = opaque_tid(), lane = tid & 63, wave = tid >> 6, l32 = lane & 31, hi = lane >> 5, qg = wave & 3, kh = wave >> 2;
    constexpr int TB = KT_BYTES + VT_BYTES;
    bf16x8 qf[12];
    { const bf16_t* qr = Qrows + (size_t)(qg * 32 + l32) * 768 + hi * 8;
#pragma unroll
      for (int ks = 0; ks < 12; ++ks) qf[ks] = *(const bf16x8*)(qr + ks * 16); }
    f32x16 o[4];
#pragma unroll
    for (int db = 0; db < 4; ++db)
#pragma unroll
        for (int r = 0; r < 16; ++r) o[db][r] = 0.f;
    float mrow = -1e30f, lsum = 0.f;
    const int nt = nkeys / 64;
    const int wv = __builtin_amdgcn_readfirstlane(wave);
    unsigned doff[6];
#pragma unroll
    for (int i = 0; i < 6; ++i) { const int pc = (wv + 8 * i) < 43 ? (wv + 8 * i) : 42; const int X = pc * 1024 + lane * 16;
        if (pc < 25) { const int row = X / KPITCH, col = X % KPITCH; doff[i] = (unsigned)(row * 384 + (col < 384 ? col : 0)); }
        else { const int Y = X - KT_BYTES, row = Y / VPITCH, col = Y % VPITCH; doff[i] = (unsigned)(row * (NKEY * 2) + (col < 128 ? col : 0)); } }
#define ATT_DMA(tile, slot) do { _Pragma("unroll") for (int i = 0; i < 6; ++i) { const int pc = (wv + 8 * i) < 43 ? (wv + 8 * i) : 42; \
        const char* src = (pc < 25 ? (const char*)Kbh + (size_t)(tile) * (64 * 384) : (const char*)Vbh + (size_t)(tile) * 128) + doff[i]; \
        __builtin_amdgcn_global_load_lds((const unsigned*)src, (LAS unsigned*)(lds + (slot) * TB + pc * 1024), 16, 0, 0); } } while (0)
    ATT_DMA(0, 0); ATT_DMA(1, 1);
    int cs = 0;
    for (int j = 0; j < nt; ++j) {
        if (j + 1 < nt) asm volatile("s_waitcnt vmcnt(6)" ::: "memory"); else asm volatile("s_waitcnt vmcnt(0)" ::: "memory");
        __builtin_amdgcn_s_barrier(); asm volatile("" ::: "memory");
        if (j + 2 < nt) { const int ns = cs == 0 ? 2 : cs - 1; ATT_DMA(j + 2, ns); }
        const LAS unsigned char* Kcur = lds + cs * TB; const LAS unsigned char* Vcur = Kcur + KT_BYTES;
        f32x16 s;
#pragma unroll
        for (int r = 0; r < 16; ++r) s[r] = 0.f;
        { const LAS unsigned char* kp = Kcur + (kh * 32 + l32) * KPITCH + hi * 16;
          bf16x8 ka[4], kb2[4];
#pragma unroll
          for (int i = 0; i < 4; ++i) ka[i] = *(const LAS bf16x8*)(kp + i * 32);
#pragma unroll
          for (int i = 0; i < 4; ++i) kb2[i] = *(const LAS bf16x8*)(kp + (4 + i) * 32);
          __builtin_amdgcn_sched_barrier(0);
#pragma unroll
          for (int i = 0; i < 4; ++i) s = __builtin_amdgcn_mfma_f32_32x32x16_bf16(ka[i], qf[i], s, 0, 0, 0);
#pragma unroll
          for (int i = 0; i < 4; ++i) ka[i] = *(const LAS bf16x8*)(kp + (8 + i) * 32);
          __builtin_amdgcn_sched_barrier(0);
#pragma unroll
          for (int i = 0; i < 4; ++i) s = __builtin_amdgcn_mfma_f32_32x32x16_bf16(kb2[i], qf[4 + i], s, 0, 0, 0);
          __builtin_amdgcn_sched_barrier(0);
#pragma unroll
          for (int i = 0; i < 4; ++i) s = __builtin_amdgcn_mfma_f32_32x32x16_bf16(ka[i], qf[8 + i], s, 0, 0, 0); }
        u32x2 vlo[4], vhi[4], wlo[4], whi[4];
#pragma unroll
        for (int db = 0; db < 4; ++db) { const LAS unsigned char* vp = Vcur + (db * 32 + l32) * VPITCH + (kh * 32 + 4 * hi) * 2;
            vlo[db] = *(const LAS u32x2*)vp; vhi[db] = *(const LAS u32x2*)(vp + 16); }
        __builtin_amdgcn_sched_barrier(0);
        float mx = s[0];
#pragma unroll
        for (int r = 1; r < 16; ++r) mx = fmaxf(mx, s[r]);
        mx = fmaxf(mx, __shfl_xor(mx, 32));
        if (__any(mx > mrow + 8.0f)) {
            const float mnew = fmaxf(mrow, mx), alpha = __builtin_amdgcn_exp2f(mrow - mnew); mrow = mnew; lsum *= alpha;
#pragma unroll
            for (int db = 0; db < 4; ++db)
#pragma unroll
                for (int r = 0; r < 16; ++r) o[db][r] *= alpha;
        }
        float ps = 0.f;
#pragma unroll
        for (int r = 0; r < 16; ++r) { s[r] = __builtin_amdgcn_exp2f(s[r] - mrow); ps += s[r]; }
        lsum += ps;
        {
            u32x4 pw; pw.x = cvt_pk_bf16(s[0], s[1]); pw.y = cvt_pk_bf16(s[2], s[3]); pw.z = cvt_pk_bf16(s[4], s[5]); pw.w = cvt_pk_bf16(s[6], s[7]);
            const bf16x8 pf = __builtin_bit_cast(bf16x8, pw);
#pragma unroll
            for (int db = 0; db < 4; ++db) { const LAS unsigned char* vp = Vcur + (db * 32 + l32) * VPITCH + (kh * 32 + 16 + 4 * hi) * 2;
                wlo[db] = *(const LAS u32x2*)vp; whi[db] = *(const LAS u32x2*)(vp + 16); }
            __builtin_amdgcn_sched_barrier(0);
#pragma unroll
            for (int db = 0; db < 4; ++db) { u32x4 vw; vw.x = vlo[db].x; vw.y = vlo[db].y; vw.z = vhi[db].x; vw.w = vhi[db].y;
                o[db] = __builtin_amdgcn_mfma_f32_32x32x16_bf16(__builtin_bit_cast(bf16x8, vw), pf, o[db], 0, 0, 0); }
        }
        {
            u32x4 pw; pw.x = cvt_pk_bf16(s[8], s[9]); pw.y = cvt_pk_bf16(s[10], s[11]); pw.z = cvt_pk_bf16(s[12], s[13]); pw.w = cvt_pk_bf16(s[14], s[15]);
            const bf16x8 pf = __builtin_bit_cast(bf16x8, pw);
#pragma unroll
            for (int db = 0; db < 4; ++db) { u32x4 vw; vw.x = wlo[db].x; vw.y = wlo[db].y; vw.z = whi[db].x; vw.w = whi[db].y;
                o[db] = __builtin_amdgcn_mfma_f32_32x32x16_bf16(__builtin_bit_cast(bf16x8, vw), pf, o[db], 0, 0, 0); }
        }
        cs = cs == 2 ? 0 : cs + 1;
    }
#undef ATT_DMA
    __syncthreads();
    lsum += __shfl_xor(lsum, 32);
    LAS float* mb = (LAS float*)lds + (size_t)qg * 66 * 64 + lane;
    if (kh == 1) {
#pragma unroll
        for (int db = 0; db < 4; ++db)
#pragma unroll
            for (int r = 0; r < 16; ++r) mb[(db * 16 + r) * 64] = o[db][r];
        mb[64 * 64] = mrow; mb[65 * 64] = lsum;
    }
    __syncthreads();
    if (kh == 0) {
        const float m1 = mb[64 * 64], l1 = mb[65 * 64];
        const float m = fmaxf(mrow, m1), e0 = __builtin_amdgcn_exp2f(mrow - m), e1 = __builtin_amdgcn_exp2f(m1 - m);
        const float inv = 1.0f / (lsum * e0 + l1 * e1), c0 = e0 * inv, c1 = e1 * inv;
        bf16_t* orow = Orows + (size_t)(qg * 32 + l32) * DM;
#pragma unroll
        for (int db = 0; db < 4; ++db)
#pragma unroll
            for (int k4 = 0; k4 < 4; ++k4) { float v[4];
#pragma unroll
                for (int i = 0; i < 4; ++i) v[i] = o[db][4 * k4 + i] * c0 + mb[(db * 16 + 4 * k4 + i) * 64] * c1;
                u32x2 w; w.x = cvt_pk_bf16(v[0], v[1]); w.y = cvt_pk_bf16(v[2], v[3]);
                *(u32x2*)(orow + db * 32 + 8 * k4 + 4 * hi) = w; }
    }
    __syncthreads();
}
__device__ __forceinline__ void ph_attn_carry(const Params& p, int l, LAS unsigned char* lds) {
    unsigned char* ws = opaque_ptr(p.ws); const int tid = opaque_tid();
    const int natt = (l == 0) ? 288 : 256;
    const bf16_t* QB = (const bf16_t*)(ws + WS_QB); const bf16_t* KC = (const bf16_t*)(ws + WS_KC); const bf16_t* VT = (const bf16_t*)(ws + WS_VT); bf16_t* CAT = (bf16_t*)(ws + WS_CAT);
    for (int it = blockIdx.x; it < natt; it += gridDim.x) {
        {
            int b, h, row0, nkeys;
            if (it < 256) { const int x = it & 7, jj = it >> 3, bh = 2 * x + (jj >> 4); b = bh >> 2; h = bh & 3; row0 = b * SEQ + (jj & 15) * 128; nkeys = NKEY; }
            else { const int u = it - 256; b = u >> 3; h = (u >> 1) & 3; row0 = NLAT + b * CTX + (u & 1) * 128; nkeys = CTX; }
            attn_unit(QB + (size_t)row0 * 768 + h * 192, KC + (size_t)(b * 4 + h) * NKEY * 192, VT + (size_t)(b * 4 + h) * 128 * NKEY, nkeys, CAT + (size_t)row0 * DM + 512 + h * 128, lds);
        }
    }
    for (int it = natt + (int)((blockIdx.x + gridDim.x - natt % gridDim.x) % gridDim.x); it < natt + 256; it += gridDim.x) {
        {
            const int u = it - natt; const int z = u >> 7, b = (u >> 5) & 3, g = u & 31, lane = tid & 63, w = tid >> 6;
            const f32x2 a16 = ((const f32x2*)(ws + WS_A16))[(((size_t)l * 2 + z) * 32 + g) * 64 + lane];
            const float* EST = (const float*)(ws + WS_EST) + (size_t)g * 768 * 256 + z * 128 + lane;
            bf16_t* UP = (bf16_t*)(ws + WS_UPK) + (size_t)g * 768 * 512 + 256 + z * 128 + lane;
            LAS f32x2* seg = (LAS f32x2*)lds;
            float er[18], ei[18];
#pragma unroll
            for (int i = 0; i < 18; ++i) { const int st = w * 18 + i; int chunk;
                if (z == 0) chunk = st < 16 ? (512 + b * 16 + st) : (b * 128 + (st - 16)); else chunk = st < 16 ? (512 + b * 16 + (15 - st)) : (b * 128 + (143 - st));
                er[i] = EST[(size_t)chunk * 256]; ei[i] = EST[(size_t)chunk * 256 + 64]; }
            float sr = 0.f, si = 0.f;
#pragma unroll
            for (int i = 0; i < 18; ++i) { const float nr = a16.x * sr - a16.y * si + er[i], ni = a16.x * si + a16.y * sr + ei[i]; sr = nr; si = ni; }
            seg[w * 64 + lane] = (f32x2){sr, si};
            float pr = 1.f, pi = 0.f;
#pragma unroll
            for (int i = 0; i < 18; ++i) { const float nr = pr * a16.x - pi * a16.y, ni = pr * a16.y + pi * a16.x; pr = nr; pi = ni; }
            __syncthreads();
            sr = 0.f; si = 0.f;
            for (int w2 = 0; w2 < w; ++w2) { const f32x2 sv = seg[w2 * 64 + lane]; const float nr = pr * sr - pi * si + sv.x, ni = pr * si + pi * sr + sv.y; sr = nr; si = ni; }
#pragma unroll
            for (int i = 0; i < 18; ++i) { const int st = w * 18 + i; int chunk;
                if (z == 0) chunk = st < 16 ? (512 + b * 16 + st) : (b * 128 + (st - 16)); else chunk = st < 16 ? (512 + b * 16 + (15 - st)) : (b * 128 + (143 - st));
                UP[(size_t)chunk * 512] = f2bf(sr); UP[(size_t)chunk * 512 + 64] = f2bf(si);
                const float nr = a16.x * sr - a16.y * si + er[i], ni = a16.x * si + a16.y * sr + ei[i]; sr = nr; si = ni; }
            __syncthreads();
        }
    }
}

__device__ __forceinline__ void ph_norm2_router(const Params& p, int l, LAS unsigned char* lds) {
    const int tid = opaque_tid(), lane = tid & 63, wave = tid >> 6;
    unsigned char* ws = opaque_ptr(p.ws); const float* mod = (const float*)(ws + WS_MOD) + (size_t)l * 5 * 12288;
    const int nrows = (l == 0) ? MT : NLAT;
    const float* WR = p.in[I_WROUTER] + (size_t)l * DM * NE;
    for (int idx = tid; idx < DM * 4; idx += 512) { const int c = idx >> 2, e4 = idx & 3; const f32x4 v = *(const f32x4*)(WR + (size_t)c * NE + e4 * 4);
        *(LAS f32x4*)(lds + (size_t)(((e4 * 2 + (c & 1)) * 1024 + (c >> 1)) * 16)) = v; }
    __syncthreads();
    const float* n2g = p.in[I_N2G] + l * DM;
    for (int it = blockIdx.x; it < nrows / 8; it += gridDim.x) {
        const int row = it * 8 + wave; const int rr = row < NLAT ? (row >> 11) : 4;
        const float* xr = (const float*)(ws + WS_XB) + (size_t)row * DM;
        const float* m = mod + (size_t)rr * 12288;
        f32x2 x[16], gv[16], sc[16], sh[16];
#pragma unroll
        for (int j = 0; j < 16; ++j) { const int c = j * 128 + lane * 2; x[j] = *(const f32x2*)(xr + c); gv[j] = *(const f32x2*)(n2g + c); sc[j] = *(const f32x2*)(m + 4 * DM + c); sh[j] = *(const f32x2*)(m + 3 * DM + c); }
        float ss = 0.f;
#pragma unroll
        for (int j = 0; j < 16; ++j) ss += x[j].x * x[j].x + x[j].y * x[j].y;
        ss = wave_sum(ss); const float rinv = rsqrtf(ss * (1.0f / DM) + EPS);
        bf16_t* orow = (bf16_t*)(ws + WS_H) + (size_t)row * DM;
        f32x4 lg[4];
#pragma unroll
        for (int e4 = 0; e4 < 4; ++e4) lg[e4] = (f32x4){0.f, 0.f, 0.f, 0.f};
#pragma unroll
        for (int j = 0; j < 16; ++j) { const f32x2 y = x[j] * rinv * gv[j] * (1.0f + sc[j]) + sh[j];
            *(unsigned*)(orow + j * 128 + lane * 2) = cvt_pk_bf16(y.x, y.y);
#pragma unroll
            for (int e4 = 0; e4 < 4; ++e4) { const f32x4 w0 = *(const LAS f32x4*)(lds + (size_t)(((e4 * 2 + 0) * 1024 + j * 64 + lane) * 16)); const f32x4 w1 = *(const LAS f32x4*)(lds + (size_t)(((e4 * 2 + 1) * 1024 + j * 64 + lane) * 16));
                lg[e4] += y.x * w0 + y.y * w1; }
            __builtin_amdgcn_sched_barrier(0); }
        float lgs[16]; float mx = -1e30f;
#pragma unroll
        for (int e = 0; e < 16; ++e) { lgs[e] = wave_sum(lg[e >> 2][e & 3]); mx = fmaxf(mx, lgs[e]); }
        float se = 0.f;
#pragma unroll
        for (int e = 0; e < 16; ++e) { lgs[e] = __expf(lgs[e] - mx); se += lgs[e]; }
        const float inv = 1.0f / se;
        float mine = 0.f;
#pragma unroll
        for (int e = 0; e < 16; ++e) mine = (lane == e) ? lgs[e] * inv : mine;
        if (lane < 16) ((float*)(ws + WS_AFF))[(size_t)row * 16 + lane] = mine;
    }
}

__device__ __forceinline__ void ph_topk(const Params& p, int l, LAS unsigned char* lds) {
    const int tid = opaque_tid(), lane = tid & 63, wave = tid >> 6;
    unsigned char* ws = opaque_ptr(p.ws); const float* AFF = (const float*)(ws + WS_AFF);
    int* ROWTOK = (int*)(ws + WS_ROWTOK); float* ROWAFF = (float*)(ws + WS_ROWAFF); int* INV = (int*)(ws + WS_INV);
    LAS int* hist = (LAS int*)lds;
    LAS int* ctl = (LAS int*)(lds + 1024);
    LAS int* wsum = (LAS int*)(lds + 1280);
    const int nunits = (l == 0) ? 128 : 64;
    for (int it = blockIdx.x; it < nunits; it += gridDim.x) {
        const bool lat = it < 64; const int u = lat ? it : it - 64; const int b = u >> 4, e = u & 15;
        const int n = lat ? SEQ : CTX, cap = lat ? CAPL : CAPC;
        const int tok0 = lat ? b * SEQ : NLAT + b * CTX; const int rowbase = lat ? b * CAPL : 1024 + b * CAPC;
        unsigned key[4];
#pragma unroll
        for (int j = 0; j < 4; ++j) { const int t = tid * 4 + j; key[j] = t < n ? __float_as_uint(AFF[(size_t)(tok0 + t) * 16 + e]) : 0u; }
        unsigned prefix = 0u; int remaining = cap;
        for (int pass = 3; pass >= 0; --pass) {
            if (tid < 256) hist[tid] = 0;
            __syncthreads();
#pragma unroll
            for (int j = 0; j < 4; ++j) { const int t = tid * 4 + j; if (t < n) { const bool match = (pass == 3) || ((key[j] >> (8 * (pass + 1))) == (prefix >> (8 * (pass + 1)))); if (match) atomicAdd((int*)&hist[(key[j] >> (8 * pass)) & 255u], 1); } }
            __syncthreads();
            if (wave == 0) {
                const int b0 = hist[4 * lane], b1 = hist[4 * lane + 1], b2 = hist[4 * lane + 2], b3 = hist[4 * lane + 3];
                const int s = b0 + b1 + b2 + b3; int suf = s;
#pragma unroll
                for (int off = 1; off < 64; off <<= 1) { const int t = __shfl_down(suf, off); if (lane + off < 64) suf += t; }
                const int above = suf - s; const int c3 = above + b3, c2 = c3 + b2, c1 = c2 + b1, c0 = c1 + b0;
                if (above < remaining && c0 >= remaining) { int dg, nr;
                    if (c3 >= remaining) { dg = 4 * lane + 3; nr = remaining - above; } else if (c2 >= remaining) { dg = 4 * lane + 2; nr = remaining - c3; }
                    else if (c1 >= remaining) { dg = 4 * lane + 1; nr = remaining - c2; } else { dg = 4 * lane; nr = remaining - c1; }
                    ctl[0] = dg; ctl[1] = nr; }
            }
            __syncthreads();
            prefix |= ((unsigned)ctl[0]) << (8 * pass); remaining = ctl[1];
            __syncthreads();
        }
        int cgt = 0, ceq = 0;
#pragma unroll
        for (int j = 0; j < 4; ++j) { const int t = tid * 4 + j; if (t < n) { cgt += key[j] > prefix ? 1 : 0; ceq += key[j] == prefix ? 1 : 0; } }
        const int packed = cgt | (ceq << 16);
        int inc = packed;
#pragma unroll
        for (int off = 1; off < 64; off <<= 1) { const int t = __shfl_up(inc, off); if (lane >= off) inc += t; }
        if (lane == 63) wsum[wave] = inc;
        __syncthreads();
        int base = 0;
#pragma unroll
        for (int w8 = 0; w8 < 8; ++w8) base += (w8 < wave) ? wsum[w8] : 0;
        int excl = base + inc - packed; int egt = excl & 0xffff, eeq = excl >> 16;
#pragma unroll
        for (int j = 0; j < 4; ++j) { const int t = tid * 4 + j; if (t < n) {
                const bool gt = key[j] > prefix, eq = key[j] == prefix; const bool sel = gt || (eq && eeq < remaining);
                const int slot = egt + (eeq < remaining ? eeq : remaining);
                if (sel) { ROWTOK[e * EROWS + rowbase + slot] = tok0 + t; ROWAFF[e * EROWS + rowbase + slot] = __uint_as_float(key[j]); }
                INV[(size_t)(tok0 + t) * 16 + e] = sel ? rowbase + slot : -1;
                egt += gt ? 1 : 0; eeq += eq ? 1 : 0; } }
        __syncthreads();
    }
}

__device__ __forceinline__ void ph_gather(const Params& p, int l) {
    const int tid = opaque_tid(), lane = tid & 63, wave = tid >> 6;
    unsigned char* ws = opaque_ptr(p.ws); const int* ROWTOK = (const int*)(ws + WS_ROWTOK);
    const int rows_per_e = (l == 0) ? 1152 : 1024;
    const int nitems = NE * rows_per_e / 8;
    for (int it = blockIdx.x; it < nitems; it += gridDim.x) {
        const int ridx = it * 8 + wave; const int e = ridx / rows_per_e, r = ridx % rows_per_e;
        const int tok = ROWTOK[e * EROWS + r];
        const u32x4* src = (const u32x4*)((const bf16_t*)(ws + WS_H) + (size_t)tok * DM); u32x4* dst = (u32x4*)((bf16_t*)(ws + WS_PA) + ((size_t)e * EROWS + r) * DM);
#pragma unroll
        for (int j = 0; j < 4; ++j) dst[j * 64 + lane] = src[j * 64 + lane];
    }
}

__device__ __forceinline__ void ph_combine(const Params& p, int l) {
    const int tid = opaque_tid(), lane = tid & 63, wave = tid >> 6;
    unsigned char* ws = opaque_ptr(p.ws); const float* mod = (const float*)(ws + WS_MOD);
    const int nrows = (l == 0) ? MT : NLAT;
    const int* INV = (const int*)(ws + WS_INV); const bf16_t* YS = (const bf16_t*)(ws + WS_YS);
    for (int it = blockIdx.x; it < nrows / 8; it += gridDim.x) {
        const int row = it * 8 + wave; const int rr = row < NLAT ? (row >> 11) : 4;
        const float* xr = (const float*)(ws + WS_XB) + (size_t)row * DM;
        f32x4 x[8], s[8], y[8];
#pragma unroll
        for (int j = 0; j < 8; ++j) { x[j] = *(const f32x4*)(xr + j * 256 + lane * 4); s[j] = (f32x4){0.f, 0.f, 0.f, 0.f}; }
        const int myinv = lane < 16 ? INV[(size_t)row * 16 + lane] : -1;
        unsigned msk = (unsigned)__ballot(myinv >= 0);
        while (msk) {
            const int e0 = __builtin_ctz(msk); msk &= msk - 1; const bool two = msk != 0u; const int e1 = two ? __builtin_ctz(msk) : e0; if (two) msk &= msk - 1;
            const int r0 = __shfl(myinv, e0), r1 = __shfl(myinv, e1);
            const bf16_t* y0 = YS + ((size_t)e0 * EROWS + r0) * DM; const bf16_t* y1 = YS + ((size_t)e1 * EROWS + r1) * DM;
            u32x2 v0[8], v1[8];
#pragma unroll
            for (int j = 0; j < 8; ++j) { v0[j] = *(const u32x2*)(y0 + j * 256 + lane * 4); v1[j] = *(const u32x2*)(y1 + j * 256 + lane * 4); }
            const float f1 = two ? 1.0f : 0.0f;
#pragma unroll
            for (int j = 0; j < 8; ++j) { s[j][0] += bflo(v0[j].x) + f1 * bflo(v1[j].x); s[j][1] += bfhi(v0[j].x) + f1 * bfhi(v1[j].x); s[j][2] += bflo(v0[j].y) + f1 * bflo(v1[j].y); s[j][3] += bfhi(v0[j].y) + f1 * bfhi(v1[j].y); }
        }
        const float* gate = mod + (size_t)(l * 5 + rr) * 12288 + 5 * DM;
#pragma unroll
        for (int j = 0; j < 8; ++j) { const f32x4 gv = *(const f32x4*)(gate + j * 256 + lane * 4); x[j] += gv * s[j]; }
        if (l == 0) {
            float* xo = (float*)(ws + WS_XA) + (size_t)row * DM;
#pragma unroll
            for (int j = 0; j < 8; ++j) *(f32x4*)(xo + j * 256 + lane * 4) = x[j];
            const float* m = mod + (size_t)(5 + rr) * 12288;
            rms_mod_store(x, p.in[I_N1G] + DM, m + DM, m, (bf16_t*)(ws + WS_H) + (size_t)row * DM, y, lane);
        } else {
            float ss = 0.f;
#pragma unroll
            for (int j = 0; j < 8; ++j) ss += x[j][0] * x[j][0] + x[j][1] * x[j][1] + x[j][2] * x[j][2] + x[j][3] * x[j][3];
            ss = wave_sum(ss); const float rinv = rsqrtf(ss * (1.0f / DM) + EPS);
            float* orow = p.out + (size_t)row * DM;
#pragma unroll
            for (int j = 0; j < 8; ++j) { const f32x4 gv = *(const f32x4*)(p.in[I_FNG] + j * 256 + lane * 4); *(f32x4*)(orow + j * 256 + lane * 4) = x[j] * rinv * gv; }
        }
    }
}

constexpr int NPH_LAYER = 13, NPH = 2 + 2 * NPH_LAYER;
__global__ void __launch_bounds__(512, 2) fwd(Params p) {
    extern __shared__ __attribute__((aligned(16))) unsigned char lds_raw[];
    LAS unsigned char* lds = (LAS unsigned char*)lds_raw;
    volatile LAS unsigned* MISC = (volatile LAS unsigned*)(lds + LDS_MISC);
    if (threadIdx.x < 16) MISC[threadIdx.x] = 0u;
    __syncthreads();
    unsigned char* ws = p.ws;
    const int lo = p.ph_lo, hi = p.ph_hi;
    XcdBarrier bar; bar.bar = (unsigned*)(ws + WS_CTL); bar.x = 0; bar.st = MISC;
    if (hi - lo > 1) bar = xcd_barrier_post((unsigned*)(ws + WS_CTL), MISC);
    const int G = gridDim.x, c = blockIdx.x;
#ifndef ONLY_PH
#define ONLY_PH -1
#endif
#define PSEL(id) (ONLY_PH < 0 || ONLY_PH == (id))
#ifndef DUP
#define DUP 0
#endif
#define NREP(id) ((((DUP) >> (id)) & 1) ? 2 : 1)
#define REPLOOP(id) for (int rep_ = 0; rep_ < NREP(id); ++rep_)
#define REPBAR(id) do { if (rep_ + 1 < NREP(id)) xcd_barrier(bar); } while (0)
#define IN(k) (lo <= (k) && (k) < hi)
#define SEAM(k) do { if (IN(k) && IN((k) + 1)) xcd_barrier(bar); } while (0)

    if (PSEL(0) && IN(0)) REPLOOP(0) { ph_prologue(p, lds); __syncthreads(); REPBAR(0); }
    SEAM(0);
    if (PSEL(1) && IN(1)) REPLOOP(1) { ph_norm1_tables(p); REPBAR(1); }
    SEAM(1);
    for (int l = 0; l < 2; ++l) {
        const int pb = 2 + NPH_LAYER * l;
        const float* mod = (const float*)(ws + WS_MOD) + (size_t)l * 5 * 12288;
        if (PSEL(2) && IN(pb + 0)) REPLOOP(2) {
            pg8::EpiStoreBf16 E{(bf16_t*)(ws + WS_PA), INP};
            if (l == 0) { pg8::TileSched S; S.init(ws + WS_H, (bf16_t*)(ws + WS_WTIN), DM, DM, MT / 256, INP / 256, 1, 0, 0, G, c, 0); pg8::gemm_phase(lds, pg8::Desc{DM, DM, DM}, S, E); }
            else { pg8::InSchedLast S; S.init(ws + WS_H, (bf16_t*)(ws + WS_WTIN) + (size_t)INP * DM, G, c); pg8::gemm_phase(lds, pg8::Desc{DM, DM, DM}, S, E); }
            moe_fill(p, lds, pb + 0);
         REPBAR(2); }
        SEAM(pb + 0);
        if (PSEL(3) && IN(pb + 1)) REPLOOP(3) { ph_rowsplit(p, l, lds); __syncthreads();  REPBAR(3); }
        SEAM(pb + 1);
        if (PSEL(4) && IN(pb + 2)) REPLOOP(4) {
#ifndef C_SEL
#define C_SEL 15
#endif
            if (C_SEL & 1) { pg8::TileSched S; S.init(ws + WS_QA, (bf16_t*)(ws + WS_WTUQ) + (size_t)l * 768 * 384, 384, 384, (l == 0 ? MT : NLAT) / 256, 3, 1, 0, 0, G, c, 0);
              pg8::EpiQ E{(bf16_t*)(ws + WS_QB), (const f32x2*)(ws + WS_ROPE)}; pg8::gemm_phase(lds, pg8::Desc{384, 384, 384}, S, E); }
            if (C_SEL & 2) { pg8::TileSched S; S.init(ws + WS_KVA, (bf16_t*)(ws + WS_WTUKV) + (size_t)l * 1024 * 256, 256, 256, MT / 256, 2, 1, 0, 0, G, c, 112);
              pg8::EpiK E{(bf16_t*)(ws + WS_KC)}; pg8::gemm_phase(lds, pg8::Desc{256, 256, 256}, S, E); }
            if (C_SEL & 4) { pg8::TileSched S; S.init((bf16_t*)(ws + WS_WTUKV) + (size_t)l * 1024 * 256 + 512 * 256, ws + WS_KVA, 256, 256, 2, MT / 256, 1, 0, 0, G, c, 184);
              pg8::EpiV E{(bf16_t*)(ws + WS_VT)}; pg8::gemm_phase(lds, pg8::Desc{256, 256, 256}, S, E); }
            if (C_SEL & 8) { pg8::TileSched S; S.init(ws + WS_UPK, (bf16_t*)(ws + WS_WST) + (size_t)l * 32 * 256 * 256, 512, 256, 3, 1, 32, (size_t)768 * 512 * 2, (size_t)256 * 256 * 2, G, c, 0);
              pg8::EpiS1 E{(float*)(ws + WS_EST)}; pg8::gemm_phase(lds, pg8::Desc{512, 256, 256}, S, E); }
            moe_fill(p, lds, pb + 2);
         REPBAR(4); }
        SEAM(pb + 2);
        if (PSEL(5) && IN(pb + 3)) REPLOOP(5) { ph_attn_carry(p, l, lds); __syncthreads();  REPBAR(5); }
        SEAM(pb + 3);
        if (PSEL(6) && IN(pb + 4)) REPLOOP(6) {
            pg8::TileSched S; S.init(ws + WS_UPK, (bf16_t*)(ws + WS_G2B) + (size_t)l * 32 * 256 * 512, 512, 512, 3, 1, 32, (size_t)768 * 512 * 2, (size_t)256 * 512 * 2, G, c, 0);
            pg8::EpiS2 E{(bf16_t*)(ws + WS_GB)}; pg8::gemm_phase(lds, pg8::Desc{512, 512, 512}, S, E);
            moe_fill(p, lds, pb + 4);
         REPBAR(6); }
        SEAM(pb + 4);
        if (PSEL(7) && IN(pb + 5)) REPLOOP(7) {
            pg8::TileSched S; S.init(ws + WS_GB, (bf16_t*)(ws + WS_WTGLU) + (size_t)l * 512 * 512, 512, 512, (l == 0 ? MT : NLAT) / 256, 2, 1, 0, 0, G, c, 0);
            pg8::EpiGlu E{(const bf16_t*)(ws + WS_GB), p.in[I_BGLU] + l * 512, (bf16_t*)(ws + WS_CAT)}; pg8::gemm_phase(lds, pg8::Desc{512, 512, 512}, S, E);
            moe_fill(p, lds, pb + 5);
         REPBAR(7); }
        SEAM(pb + 5);
        if (PSEL(8) && IN(pb + 6)) REPLOOP(8) {
            pg8::TileSched S; S.init(ws + WS_CAT, (bf16_t*)(ws + WS_WTOUT) + (size_t)l * DM * DM, DM, DM, (l == 0 ? MT : NLAT) / 256, DM / 256, 1, 0, 0, G, c, 0);
            pg8::EpiOut E{l == 0 ? p.in[I_X] : (const float*)(ws + WS_XA), l == 0 ? p.in[I_CTX] : (const float*)(ws + WS_XA) + (size_t)NLAT * DM, mod + 2 * DM, (float*)(ws + WS_XB)};
            pg8::gemm_phase(lds, pg8::Desc{DM, DM, DM}, S, E);
            moe_fill(p, lds, pb + 6);
         REPBAR(8); }
        SEAM(pb + 6);
        if (PSEL(9) && IN(pb + 7)) REPLOOP(9) { ph_norm2_router(p, l, lds); __syncthreads(); REPBAR(9); }
        SEAM(pb + 7);
        if (PSEL(10) && IN(pb + 8)) REPLOOP(10) { ph_topk(p, l, lds); __syncthreads(); moe_require(p, lds, l * Q_LAYER + Q_GU);  REPBAR(10); }
        if (PSEL(11) && IN(pb + 9)) REPLOOP(11) { }
        SEAM(pb + 9);
        if (PSEL(12) && IN(pb + 10)) REPLOOP(12) {
            pg8::MoeSched S; S.init(ws + WS_H, (bf16_t*)(ws + WS_WTGU) + (size_t)l * NE * 2048 * DM, DM, DM, l == 0 ? 5 : 4, 8, 0, (size_t)2048 * DM * 2, G, c);
            pg8::EpiGU E{(bf16_t*)(ws + WS_HID)}; pg8::gemm_phase<pg8::EpiGU, pg8::MoeSched, true>(lds, pg8::Desc{DM, DM, DM}, S, E, (const int*)(ws + WS_ROWTOK), l == 0 ? 1152 : 1024);
            moe_require(p, lds, (l + 1) * Q_LAYER); moe_fill(p, lds, pb + 10);
         REPBAR(12); }
        SEAM(pb + 10);
        if (PSEL(13) && IN(pb + 11)) REPLOOP(13) {
            pg8::MoeSched S; S.init(ws + WS_HID, (bf16_t*)(ws + WS_WTDN) + (size_t)l * NE * DM * FF, FF, FF, l == 0 ? 5 : 4, 8, (size_t)EROWS * FF * 2, (size_t)DM * FF * 2, G, c);
            pg8::EpiDown E{(bf16_t*)(ws + WS_YS), (const float*)(ws + WS_ROWAFF)}; pg8::gemm_phase(lds, pg8::Desc{FF, FF, FF}, S, E);
            moe_fill(p, lds, pb + 11);
         REPBAR(13); }
        SEAM(pb + 11);
        if (PSEL(14) && IN(pb + 12)) REPLOOP(14) { ph_combine(p, l);  REPBAR(14); }
        SEAM(pb + 12);
    }
#undef IN
#undef SEAM
}

extern "C" void kernel_launch(void* const* d_in, const int* in_sizes, int n_in, void* d_out, int out_size, void* d_ws, size_t ws_size, hipStream_t stream) {
    static int grid = 0;
    if (grid == 0) {
        if (n_in != 33 || ws_size < WS_END) { fprintf(stderr, "kernel_launch: need 33 inputs and >= %zu bytes of workspace; got %d, %zu\n", (size_t)WS_END, n_in, ws_size); grid = -1; return; }
        int dev = 0, cus = 0;
        if (hipGetDevice(&dev) != hipSuccess || hipDeviceGetAttribute(&cus, hipDeviceAttributeMultiprocessorCount, dev) != hipSuccess) { grid = -1; return; }
        if (hipFuncSetAttribute((const void*)fwd, hipFuncAttributeMaxDynamicSharedMemorySize, LDS_BYTES) != hipSuccess) { fprintf(stderr, "kernel_launch: hipFuncSetAttribute failed\n"); grid = -1; return; }
        (void)hipGetLastError();
        grid = cus > 256 ? 256 : cus;
    }
    if (grid < 0) return;
    (void)hipMemsetAsync((char*)d_ws + WS_CTL, 0, CTL_BYTES, stream);
    Params a{};
    for (int i = 0; i < 33; ++i) a.in[i] = (const float*)d_in[i];
    a.out = (float*)d_out; a.ws = (unsigned char*)d_ws;
#if MK_SPLIT
    for (int ph = 0; ph < NPH; ++ph) { a.ph_lo = ph; a.ph_hi = ph + 1; hipLaunchKernelGGL(fwd, dim3(grid), dim3(512), LDS_BYTES, stream, a); }
#else
    a.ph_lo = 0; a.ph_hi = NPH; hipLaunchKernelGGL(fwd, dim3(grid), dim3(512), LDS_BYTES, stream, a);
#endif
}
```

```cpp
#include <hip/hip_runtime.h>
#include <cstdint>
#include <cstdio>

#ifndef MK_SPLIT
#define MK_SPLIT 0
#endif

#define LAS __attribute__((address_space(3)))
typedef unsigned short bf16_t;
typedef short bf16x8 __attribute__((ext_vector_type(8)));
typedef short bf16x4 __attribute__((ext_vector_type(4)));
typedef float f32x4 __attribute__((ext_vector_type(4)));
typedef float f32x2 __attribute__((ext_vector_type(2)));
typedef unsigned u32x4 __attribute__((ext_vector_type(4)));
typedef unsigned u32x2 __attribute__((ext_vector_type(2)));
typedef float f32x16 __attribute__((ext_vector_type(16)));

constexpr int DM = 2048, NB = 4, SEQ = 2048, CTX = 256, NLAT = NB * SEQ, NCTX = NB * CTX, MT = NLAT + NCTX;
constexpr int INC = 3776, INP = 3840;
constexpr int C_SGU_U = 0, C_SGU_V = 512, C_CQ = 1024, C_CKV = 1408, C_KR = 1664, C_S5 = 1728, C_CVB = 2240, C_CVC = 2752, C_CVH = 3264;
constexpr int NKEY = CTX + SEQ;
constexpr int NE = 16, FF = 1024, CAPL = 256, CAPC = 32, EROWS = 1280;
constexpr int NCHUNK = MT / 16;
constexpr float EPS = 1e-6f;
constexpr float QSCALE = 0.07216878364870322f * 1.4426950408889634f;

constexpr size_t al256(size_t x) { return (x + 255) & ~(size_t)255; }
constexpr size_t WS_CTL = 0;
constexpr size_t CTL_BYTES = 65536;
constexpr size_t WS_MOD = WS_CTL + CTL_BYTES;
constexpr size_t WS_WTIN = al256(WS_MOD + (size_t)2 * 5 * 12288 * 4);
constexpr size_t WS_WTOUT = al256(WS_WTIN + (size_t)2 * INP * DM * 2);
constexpr size_t WS_WTUQ = al256(WS_WTOUT + (size_t)2 * DM * DM * 2);
constexpr size_t WS_WTUKV = al256(WS_WTUQ + (size_t)2 * 768 * 384 * 2);
constexpr size_t WS_WTGLU = al256(WS_WTUKV + (size_t)2 * 1024 * 256 * 2);
constexpr size_t WS_WTGU = al256(WS_WTGLU + (size_t)2 * 512 * 512 * 2);
constexpr size_t WS_WTDN = al256(WS_WTGU + (size_t)2 * NE * 2048 * DM * 2);
constexpr size_t WS_PW = al256(WS_WTDN + (size_t)2 * NE * DM * FF * 2);
constexpr size_t WS_BB = al256(WS_PW + (size_t)2 * 2 * 32 * 64 * 17 * 8);
constexpr size_t WS_KZ = al256(WS_BB + (size_t)2 * 2 * 32 * 64 * 16 * 8);
constexpr size_t WS_WST = al256(WS_KZ + (size_t)2 * 2 * 32 * 4096 * 4);
constexpr size_t WS_G2B = al256(WS_WST + (size_t)2 * 32 * 256 * 256 * 2);
constexpr size_t WS_H = al256(WS_G2B + (size_t)2 * 32 * 256 * 512 * 2);
constexpr size_t WS_PA = al256(WS_H + (size_t)MT * DM * 2);
constexpr size_t PA_BYTES = (size_t)NE * EROWS * DM * 2;
static_assert(PA_BYTES >= (size_t)MT * INP * 2, "P fits in the union");
constexpr size_t WS_XA = al256(WS_PA + PA_BYTES);
constexpr size_t WS_XB = al256(WS_XA + (size_t)MT * DM * 4);
constexpr size_t WS_CAT = al256(WS_XB + (size_t)MT * DM * 4);
constexpr size_t WS_QA = al256(WS_CAT + (size_t)MT * DM * 2);
constexpr size_t WS_KVA = al256(WS_QA + (size_t)MT * 384 * 2);
constexpr size_t WS_QB = al256(WS_KVA + (size_t)MT * 256 * 2);
constexpr size_t WS_KC = al256(WS_QB + (size_t)MT * 768 * 2);
constexpr size_t WS_VT = al256(WS_KC + (size_t)NB * 4 * NKEY * 192 * 2);
constexpr size_t WS_UPK = al256(WS_VT + (size_t)NB * 4 * 128 * NKEY * 2);
constexpr size_t WS_EST = al256(WS_UPK + (size_t)32 * 768 * 512 * 2);
constexpr size_t WS_GB = al256(WS_EST + (size_t)32 * 768 * 256 * 4);
constexpr size_t WS_AFF = al256(WS_GB + (size_t)MT * 512 * 2);
constexpr size_t WS_ROWTOK = al256(WS_AFF + (size_t)MT * 16 * 4);
constexpr size_t WS_ROWAFF = al256(WS_ROWTOK + (size_t)NE * EROWS * 4);
constexpr size_t WS_INV = al256(WS_ROWAFF + (size_t)NE * EROWS * 4);
constexpr size_t WS_HID = al256(WS_INV + (size_t)MT * 16 * 4);
constexpr size_t WS_YS = al256(WS_HID + (size_t)NE * EROWS * FF * 2);
constexpr size_t WS_ROPE = al256(WS_YS + (size_t)NE * EROWS * DM * 2);
constexpr size_t WS_A16 = al256(WS_ROPE + 64 * 16 * 8);
constexpr size_t WS_END = al256(WS_A16 + (size_t)2 * 2 * 32 * 64 * 8);

constexpr int LDS_GEMM = 131072;
constexpr int LDS_ATTN = 3 * 44032;
constexpr int LDS_MISC = 133120;
constexpr int LDS_BYTES = LDS_MISC + 256;
static_assert(LDS_ATTN <= LDS_MISC && LDS_GEMM <= LDS_MISC, "LDS map");

typedef __bf16 bf16x2_t __attribute__((ext_vector_type(2)));
__device__ __forceinline__ unsigned cvt_pk_bf16(float lo, float hi) { const f32x2 v = {lo, hi}; const bf16x2_t b = __builtin_convertvector(v, bf16x2_t); return __builtin_bit_cast(unsigned, b); }
__device__ __forceinline__ float bf2f(unsigned short b) { return __uint_as_float(((unsigned)b) << 16); }
__device__ __forceinline__ float bflo(unsigned w) { return __uint_as_float(w << 16); }
__device__ __forceinline__ float bfhi(unsigned w) { return __uint_as_float(w & 0xffff0000u); }
__device__ __forceinline__ unsigned short f2bf(float f) { return (unsigned short)(cvt_pk_bf16(f, 0.f) & 0xffffu); }
__device__ __forceinline__ int opaque_tid() { int t = threadIdx.x; asm volatile("" : "+v"(t)); return t; }
__device__ __forceinline__ unsigned char* opaque_ptr(unsigned char* q) { long z = 0; asm volatile("" : "+s"(z)); return q + z; }
__device__ __forceinline__ float wave_sum(float v) {
#pragma unroll
    for (int o = 32; o >= 1; o >>= 1) v += __shfl_xor(v, o);
    return v;
}
__device__ __forceinline__ float gelu_tanh(float x) {
    const float y = x * (-2.3022081986679503f - 0.10294324069457f * x * x);
    return x * __builtin_amdgcn_rcpf(1.0f + __builtin_amdgcn_exp2f(y));
}
__device__ __forceinline__ float silu_f(float x) { return x * __builtin_amdgcn_rcpf(1.0f + __builtin_amdgcn_exp2f(-1.4426950408889634f * x)); }
__device__ __forceinline__ float sigmoid_f(float x) { return __builtin_amdgcn_rcpf(1.0f + __builtin_amdgcn_exp2f(-1.4426950408889634f * x)); }

#define XB_TMO      128
#define XB_XCNT(j)  (256  + 64 * (j))
#define XB_XSUB(j)  (1280 + 64 * (j))
#define XB_XGEN(j)  (2304 + 64 * (j))
#define XB_TOP      3328
#define XB_TOPGEN   3392
#define XCD_BAR_WORDS 3456
#define XB_SPIN_CAP (1u << 22)
__device__ __forceinline__ unsigned xb_ld(unsigned* p)              { return __hip_atomic_load(p, __ATOMIC_RELAXED, __HIP_MEMORY_SCOPE_AGENT); }
__device__ __forceinline__ unsigned xb_add(unsigned* p, unsigned v) { return __hip_atomic_fetch_add(p, v, __ATOMIC_RELAXED, __HIP_MEMORY_SCOPE_AGENT); }
__device__ __forceinline__ unsigned xb_xcc_id() { return (unsigned)__builtin_amdgcn_s_getreg((3 << 11) | 20) & 0xFu; }
#define XB_SPIN(cond, bar) do { unsigned _sp = 0; while (cond) { __builtin_amdgcn_s_sleep(1); \
    if ((++_sp & 255u) == 0u) { if (xb_ld(&(bar)[XB_TMO])) break; if (_sp > XB_SPIN_CAP) { atomicAdd(&(bar)[XB_TMO], 1u); break; } } } } while (0)
struct XcdBarrier { unsigned* bar; unsigned x; volatile LAS unsigned* st; };
__device__ __forceinline__ XcdBarrier xcd_barrier_post(unsigned* bar, volatile LAS unsigned* st) {
    XcdBarrier b; b.bar = bar; b.x = xb_xcc_id(); b.st = st;
    if (threadIdx.x == 0) (void)xb_add(&bar[XB_XCNT(b.x)], 1u);
    return b;
}
__device__ __forceinline__ void xcd_barrier_complete(unsigned* bar, unsigned x, unsigned& nloc, unsigned& nx) {
    const unsigned G = gridDim.x * gridDim.y * gridDim.z;
    unsigned sum, cnt, mine, sp = 0u;
    for (;;) {
        sum = 0u; cnt = 0u; mine = 0u;
#pragma unroll
        for (unsigned j = 0; j < 16; ++j) { const unsigned c = xb_ld(&bar[XB_XCNT(j)]); sum += c; cnt += (c > 0u) ? 1u : 0u; mine = (j == x) ? c : mine; }
        if (sum == G) break;
        __builtin_amdgcn_s_sleep(1);
        if ((++sp & 255u) == 0u) { if (xb_ld(&bar[XB_TMO])) break; if (sp > XB_SPIN_CAP) { atomicAdd(&bar[XB_TMO], 1u); break; } }
    }
    nloc = mine > 0u ? mine : 1u; nx = cnt > 0u ? cnt : 1u;
}
__device__ __forceinline__ void xcd_barrier(const XcdBarrier& b) {
    asm volatile("s_waitcnt vmcnt(0)" ::: "memory");
    __syncthreads();
    if (threadIdx.x == 0) {
        unsigned* bar = b.bar;
        __builtin_amdgcn_s_waitcnt(0);
        unsigned nloc = b.st[0], nx = b.st[1];
        if (nloc == 0u) { xcd_barrier_complete(bar, b.x, nloc, nx); b.st[0] = nloc; b.st[1] = nx; }
        const unsigned old = xb_add(&bar[XB_XSUB(b.x)], 1u);
        const unsigned gen = old / nloc;
        if (old + 1u == (gen + 1u) * nloc) {
            __builtin_amdgcn_fence(__ATOMIC_RELEASE, "agent");
            asm volatile("s_waitcnt vmcnt(0)" ::: "memory");
            const unsigned og = xb_add(&bar[XB_TOP], 1u);
            const unsigned tg = og / nx;
            if (og + 1u == (tg + 1u) * nx) xb_add(&bar[XB_TOPGEN], 1u);
            else XB_SPIN(xb_ld(&bar[XB_TOPGEN]) == tg, bar);
            __builtin_amdgcn_fence(__ATOMIC_ACQUIRE, "agent");
            xb_add(&bar[XB_XGEN(b.x)], 1u);
            asm volatile("s_waitcnt vmcnt(0)" ::: "memory");
        } else {
            XB_SPIN(xb_ld(&bar[XB_XGEN(b.x)]) == gen, bar);
            __builtin_amdgcn_fence(__ATOMIC_ACQUIRE, "agent");
            asm volatile("s_waitcnt vmcnt(0)" ::: "memory");
        }
    }
    __syncthreads();
}

namespace pg8 {
constexpr int BM = 256, BK = 64, HALF = 128, HTB = HALF * BK * 2, STAGE_BYTES = 8 * HTB;
__host__ __device__ __forceinline__ int lds_byte(int r, int c) { const int st = (r >> 4) * 2 + (c >> 5), rr = r & 15, cc = c & 31, ob = rr * 64 + cc * 2; return st * 1024 + (ob ^ (((ob >> 9) & 1) << 5)); }
__host__ __device__ __forceinline__ void stage_rc(int b, int& R, int& C) { const int st = b / 1024, sb = b % 1024, swz = sb ^ (((sb >> 9) & 1) << 5); R = (st >> 1) * 16 + swz / 64; C = (st & 1) * 32 + (swz % 64) / 2; }
__host__ __device__ __forceinline__ int perm32(int rho) { const int n = rho >> 4, i = rho & 15; return 8 * (i >> 2) + 4 * n + (i & 3); }

struct Unit { const char* a; const char* b; int pm, pn, pb; };
struct Desc { int lda, ldb, K; };

struct TileSched {
    const char* A; const char* B; size_t sA, sB;
    int lda, ldb, nM, nN, nB, G, c;
    __device__ __forceinline__ void init(const void* A_, const void* B_, int lda_, int ldb_, int nM_, int nN_, int nB_, size_t sA_, size_t sB_, int G_, int c_, int off) {
        A = (const char*)A_; B = (const char*)B_; lda = lda_; ldb = ldb_; nM = nM_; nN = nN_; nB = nB_; sA = sA_; sB = sB_; G = G_; c = (c_ + G_ - (off % G_)) % G_; }
    __device__ __forceinline__ bool next(int i, Unit& u) const {
        const int nwg = nM * nN; const long L = (long)i * G + c; if (L >= (long)nwg * nB) return false;
        const int pb = (int)(L / nwg); int wgid = (int)(L % nwg);
        { const int q = nwg / 8, r = nwg % 8, xcd = wgid % 8, off = wgid / 8; wgid = (xcd < r ? xcd * (q + 1) : r * (q + 1) + (xcd - r) * q) + off; }
        const int nig = 8 * nN, gid = wgid / nig, fm = gid * 8, gsz = (nM - fm) < 8 ? (nM - fm) : 8;
        u.pm = fm + ((wgid % nig) % gsz); u.pn = (wgid % nig) / gsz; u.pb = pb;
        u.a = A + (size_t)pb * sA + (size_t)u.pm * 256 * lda * 2; u.b = B + (size_t)pb * sB + (size_t)u.pn * 256 * ldb * 2; return true;
    }
};
struct InSchedLast {
    TileSched T;
    __device__ __forceinline__ void init(const void* A_, const void* B_, int G_, int c_) { T.init(A_, B_, DM, DM, NLAT / 256, INP / 256, 1, 0, 0, G_, c_, 0); }
    __device__ __forceinline__ bool next(int i, Unit& u) const {
        const int nlat = (NLAT / 256) * (INP / 256); const long L = (long)i * T.G + T.c;
        if (L < nlat) return T.next(i, u);
        if (L >= nlat + 16) return false;
        const int k = (int)(L - nlat); u.pm = NLAT / 256 + (k >> 2); u.pn = 5 + (k & 3); u.pb = 0;
        u.a = T.A + (size_t)u.pm * 256 * DM * 2; u.b = T.B + (size_t)u.pn * 256 * DM * 2; return true;
    }
};
struct MoeSched {
    const char* A; const char* B; size_t sA, sB; int lda, ldb, nM, nN, G, c;
    __device__ __forceinline__ void init(const void* A_, const void* B_, int lda_, int ldb_, int nM_, int nN_, size_t sA_, size_t sB_, int G_, int c_) {
        A = (const char*)A_; B = (const char*)B_; lda = lda_; ldb = ldb_; nM = nM_; nN = nN_; sA = sA_; sB = sB_; G = G_; c = c_; }
    __device__ __forceinline__ bool next(int i, Unit& u) const {
        int e, rem; const int per = nM * nN;
        if ((G & 7) == 0) { const int x = c & 7, j = c >> 3, w = G >> 3; const int L = i * w + j; if (L >= 2 * per) return false; e = 2 * x + L / per; rem = L % per; }
        else { const long L = (long)i * G + c; if (L >= (long)NE * per) return false; e = (int)(L / per); rem = (int)(L % per); }
        u.pn = rem / nM; u.pm = rem % nM; u.pb = e;
        u.a = sA == 0 ? A : A + (size_t)e * sA + (size_t)u.pm * 256 * lda * 2; u.b = B + (size_t)e * sB + (size_t)u.pn * 256 * ldb * 2; return true;
    }
};

template <class Epi, class Sched, bool GATHER = false>
__device__ __forceinline__ void gemm_phase(LAS unsigned char* lds, const Desc g, const Sched& S, const Epi& E, const int* rowtok = nullptr, int nvalid = 0) {
    const int tid = opaque_tid(), wid = __builtin_amdgcn_readfirstlane(tid >> 6), lane = tid & 63, wr = wid >> 2, wc = wid & 3, fr = lane & 15, fq = lane >> 4;
    const int K = g.K, nt = K / BK;
    unsigned voffA[2], voffB[2]; int gR[2], gCc[2];
#pragma unroll
    for (int i = 0; i < 2; ++i) { int R, C; stage_rc(tid * 16 + i * 8192, R, C); const int Rb = Epi::PERM ? ((R & ~31) + perm32(R & 31)) : R;
        voffA[i] = (unsigned)(R * g.lda + C) * 2u; voffB[i] = (unsigned)(Rb * g.ldb + C) * 2u; gR[i] = R; gCc[i] = C; }
    unsigned gC[2][2], gN[2][2];
#define PG8_GOFF(u, o) do { _Pragma("unroll") for (int _h = 0; _h < 2; ++_h) _Pragma("unroll") for (int _i = 0; _i < 2; ++_i) { const int _r = (u).pm * 256 + _h * 128 + gR[_i]; \
        const int _tok = _r < nvalid ? rowtok[(u).pb * EROWS + _r] : 0; (o)[_h][_i] = (unsigned)(_tok * g.lda + gCc[_i]) * 2u; } } while (0)
    const size_t kstep = (size_t)(BK * 2);
    const size_t hstepA = (size_t)HALF * g.lda * 2, hstepB = (size_t)HALF * g.ldb * 2;
    const unsigned ldsw = (unsigned)wid * 1024u;
    const int aoff = lds_byte(wr * 64 + fr, fq * 8), boff = lds_byte(wc * 32 + fr, fq * 8);
#define PG8_SA(b, h) (((b) * 2 + (h)) * HTB)
#define PG8_SB(b, h) ((4 + (b) * 2 + (h)) * HTB)
#define PG8_STAGE(bufoff, gbase, voff) do { _Pragma("unroll") for (int _i = 0; _i < 2; ++_i) \
        __builtin_amdgcn_global_load_lds((const unsigned*)((const char*)(gbase) + (voff)[_i]), (LAS unsigned*)(lds + (bufoff) + ldsw + _i * 8192), 16, 0, 0); } while (0)
#define PG8_STAGE_A(bufoff, kptr, half, VO) do { if constexpr (GATHER) { _Pragma("unroll") for (int _i = 0; _i < 2; ++_i) \
        __builtin_amdgcn_global_load_lds((const unsigned*)((const char*)(kptr) + (VO)[half][_i]), (LAS unsigned*)(lds + (bufoff) + ldsw + _i * 8192), 16, 0, 0); } \
        else { PG8_STAGE(bufoff, (kptr) + (half) * hstepA, voffA); } } while (0)
#define PG8_LDA(dst, b, h) do { _Pragma("unroll") for (int m = 0; m < 4; ++m) _Pragma("unroll") for (int k = 0; k < 2; ++k) dst[m][k] = *(const LAS bf16x8*)(lds + PG8_SA(b, h) + aoff + m * 2048 + k * 1024); } while (0)
#define PG8_LDB(dst, b, h) do { _Pragma("unroll") for (int n = 0; n < 2; ++n) _Pragma("unroll") for (int k = 0; k < 2; ++k) dst[n][k] = *(const LAS bf16x8*)(lds + PG8_SB(b, h) + boff + n * 2048 + k * 1024); } while (0)
#define PG8_MMA(ai, bj, At, Bt) do { __builtin_amdgcn_s_setprio(1); _Pragma("unroll") for (int m = 0; m < 4; ++m) _Pragma("unroll") for (int n = 0; n < 2; ++n) _Pragma("unroll") for (int k = 0; k < 2; ++k) \
        acc[ai][bj][m][n] = __builtin_amdgcn_mfma_f32_16x16x32_bf16(Bt[n][k], At[m][k], acc[ai][bj][m][n], 0, 0, 0); __builtin_amdgcn_s_setprio(0); } while (0)
#define PG8_WAIT_V(n) asm volatile("s_waitcnt vmcnt(" #n ")" ::: "memory")
#define PG8_WAIT_L(n) asm volatile("s_waitcnt lgkmcnt(" #n ")" ::: "memory")
#define PG8_BAR __builtin_amdgcn_s_barrier()
#define PG8_SCHED __builtin_amdgcn_sched_barrier(0)
    Unit cur, nxt; int ui = 0;
    if (!S.next(0, cur)) return;
    f32x4 acc[2][2][4][2];
#pragma unroll
    for (int a = 0; a < 2; ++a)
#pragma unroll
        for (int b = 0; b < 2; ++b)
#pragma unroll
            for (int m = 0; m < 4; ++m)
#pragma unroll
                for (int n = 0; n < 2; ++n) acc[a][b][m][n] = (f32x4){0.f, 0.f, 0.f, 0.f};
    bf16x8 At[4][2], B0[2][2], B1[2][2];
    const char* cA = cur.a; const char* cB = cur.b;
    if constexpr (GATHER) { PG8_GOFF(cur, gC); }
    PG8_STAGE(PG8_SB(0, 0), cB, voffB); PG8_STAGE_A(PG8_SA(0, 0), cA, 0, gC); PG8_STAGE(PG8_SB(0, 1), cB + hstepB, voffB); PG8_STAGE_A(PG8_SA(0, 1), cA, 1, gC);
    if (wr == 1) PG8_BAR;
    PG8_WAIT_V(4); PG8_BAR;
    PG8_STAGE(PG8_SB(1, 0), cB + kstep, voffB); PG8_STAGE_A(PG8_SA(1, 0), cA + kstep, 0, gC); PG8_STAGE(PG8_SB(1, 1), cB + hstepB + kstep, voffB);
    PG8_WAIT_V(6); PG8_BAR;
    for (;;) {
        const bool has_next = S.next(ui + 1, nxt);
        const char* nA = has_next ? nxt.a : cA; const char* nB = has_next ? nxt.b : cB;
        if constexpr (GATHER) { if (has_next) { PG8_GOFF(nxt, gN); } else {
#pragma unroll
            for (int _h = 0; _h < 2; ++_h)
#pragma unroll
                for (int _i = 0; _i < 2; ++_i) gN[_h][_i] = gC[_h][_i]; } }
#pragma nounroll
        for (int t = 0; t < nt; t += 2) {
            const bool last = (t == nt - 2);
            const char* a1 = cA + (size_t)(t + 1) * kstep;
            const char* a2 = last ? nA : cA + (size_t)(t + 2) * kstep; const char* b2 = last ? nB : cB + (size_t)(t + 2) * kstep;
            const char* a3 = a2 + kstep; const char* b3 = b2 + kstep;
            unsigned g2[2][2];
            if constexpr (GATHER) {
#pragma unroll
                for (int _h = 0; _h < 2; ++_h)
#pragma unroll
                    for (int _i = 0; _i < 2; ++_i) g2[_h][_i] = last ? gN[_h][_i] : gC[_h][_i]; }
            PG8_LDB(B0, 0, 0); PG8_SCHED; PG8_LDA(At, 0, 0); PG8_STAGE_A(PG8_SA(1, 1), a1, 1, gC);
            PG8_WAIT_L(8); PG8_BAR; PG8_WAIT_L(0); PG8_MMA(0, 0, At, B0); PG8_BAR; PG8_SCHED;
            PG8_LDB(B1, 0, 1); PG8_STAGE(PG8_SB(0, 0), b2, voffB);
            PG8_BAR; PG8_WAIT_L(0); PG8_MMA(0, 1, At, B1); PG8_BAR;
            PG8_LDA(At, 0, 1); PG8_STAGE_A(PG8_SA(0, 0), a2, 0, g2);
            PG8_BAR; PG8_WAIT_L(0); PG8_MMA(1, 0, At, B0); PG8_BAR; PG8_SCHED;
            PG8_STAGE(PG8_SB(0, 1), b2 + hstepB, voffB);
            PG8_WAIT_V(6); PG8_BAR; PG8_MMA(1, 1, At, B1); PG8_BAR;
            PG8_LDB(B0, 1, 0); PG8_SCHED; PG8_LDA(At, 1, 0); PG8_STAGE_A(PG8_SA(0, 1), a2, 1, g2);
            PG8_WAIT_L(8); PG8_BAR; PG8_WAIT_L(0); PG8_MMA(0, 0, At, B0); PG8_BAR; PG8_SCHED;
            PG8_LDB(B1, 1, 1); PG8_STAGE(PG8_SB(1, 0), b3, voffB);
            PG8_BAR; PG8_WAIT_L(0); PG8_MMA(0, 1, At, B1); PG8_BAR;
            PG8_LDA(At, 1, 1); PG8_STAGE_A(PG8_SA(1, 0), a3, 0, g2);
            PG8_BAR; PG8_WAIT_L(0); PG8_MMA(1, 0, At, B0); PG8_BAR; PG8_SCHED;
            PG8_STAGE(PG8_SB(1, 1), b3 + hstepB, voffB);
            PG8_WAIT_V(6); PG8_BAR; PG8_MMA(1, 1, At, B1); PG8_BAR;
        }
        E(acc, cur, wr, wc, fr, fq);
        if (!has_next) break;
#pragma unroll
        for (int a = 0; a < 2; ++a)
#pragma unroll
            for (int b = 0; b < 2; ++b)
#pragma unroll
                for (int m = 0; m < 4; ++m)
#pragma unroll
                    for (int n = 0; n < 2; ++n) acc[a][b][m][n] = (f32x4){0.f, 0.f, 0.f, 0.f};
        cur = nxt; cA = nA; cB = nB; ++ui;
        if constexpr (GATHER) {
#pragma unroll
            for (int _h = 0; _h < 2; ++_h)
#pragma unroll
                for (int _i = 0; _i < 2; ++_i) gC[_h][_i] = gN[_h][_i]; }
    }
    PG8_WAIT_V(0);
    if (wr == 0) PG8_BAR;
    PG8_BAR;
#undef PG8_SA
#undef PG8_SB
#undef PG8_STAGE
#undef PG8_STAGE_A
#undef PG8_GOFF
#undef PG8_LDA
#undef PG8_LDB
#undef PG8_MMA
#undef PG8_WAIT_V
#undef PG8_WAIT_L
#undef PG8_BAR
#undef PG8_SCHED
}

#define PG8_FOR_PERM(...) \
    _Pragma("unroll") for (int ai = 0; ai < 2; ++ai) _Pragma("unroll") for (int m = 0; m < 4; ++m) { const int tr = ai * 128 + wr * 64 + m * 16 + fr; \
        _Pragma("unroll") for (int bj = 0; bj < 2; ++bj) { const int tc = bj * 128 + wc * 32 + 8 * fq; const f32x4 v0 = acc[ai][bj][m][0], v1 = acc[ai][bj][m][1]; __VA_ARGS__ } }
#define PG8_FOR_NOPERM(...) \
    _Pragma("unroll") for (int ai = 0; ai < 2; ++ai) _Pragma("unroll") for (int m = 0; m < 4; ++m) { const int tr = ai * 128 + wr * 64 + m * 16 + fr; \
        _Pragma("unroll") for (int bj = 0; bj < 2; ++bj) _Pragma("unroll") for (int n = 0; n < 2; ++n) { const int tc = bj * 128 + wc * 32 + 16 * n + 4 * fq; const f32x4 v = acc[ai][bj][m][n]; __VA_ARGS__ } }

typedef const f32x4 (&AccRef)[2][2][4][2];

struct EpiStoreBf16 {
    static constexpr bool PERM = true;
    bf16_t* O; int ldc;
    __device__ __forceinline__ void operator()(AccRef acc, const Unit& u, int wr, int wc, int fr, int fq) const {
        PG8_FOR_PERM({ u32x4 w; w.x = cvt_pk_bf16(v0[0], v0[1]); w.y = cvt_pk_bf16(v0[2], v0[3]); w.z = cvt_pk_bf16(v1[0], v1[1]); w.w = cvt_pk_bf16(v1[2], v1[3]);
            *(u32x4*)(O + (size_t)(u.pm * 256 + tr) * ldc + u.pn * 256 + tc) = w; })
    }
};
struct EpiQ {
    static constexpr bool PERM = false;
    bf16_t* Q; const f32x2* ROPE;
    __device__ __forceinline__ void operator()(AccRef acc, const Unit& u, int wr, int wc, int fr, int fq) const {
#pragma unroll
        for (int ai = 0; ai < 2; ++ai)
#pragma unroll
            for (int m = 0; m < 4; ++m) { const int row = u.pm * 256 + ai * 128 + wr * 64 + m * 16 + fr; const bool lat = row < NLAT; const int t = row & (SEQ - 1);
#pragma unroll
                for (int bj = 0; bj < 2; ++bj) { const int cg = u.pn * 256 + bj * 128 + wc * 32; const int dd = cg % 192; f32x4 a = acc[ai][bj][m][0], b = acc[ai][bj][m][1];
                    if (dd >= 128 && lat) { const int pos = (dd - 128) >= 32 ? (t & 63) : (t >> 6); const f32x4* rp = (const f32x4*)(ROPE + pos * 16 + 4 * fq); const f32x4 r0 = rp[0], r1 = rp[1];
                        const float cs[4] = {r0[0], r0[2], r1[0], r1[2]}, sn[4] = {r0[1], r0[3], r1[1], r1[3]};
#pragma unroll
                        for (int i = 0; i < 4; ++i) { const float x1 = a[i], x2 = b[i]; a[i] = x1 * cs[i] - x2 * sn[i]; b[i] = x2 * cs[i] + x1 * sn[i]; } }
                    a *= QSCALE; b *= QSCALE;
                    bf16_t* o = Q + (size_t)row * 768 + cg + 4 * fq;
                    u32x2 w0; w0.x = cvt_pk_bf16(a[0], a[1]); w0.y = cvt_pk_bf16(a[2], a[3]); *(u32x2*)o = w0;
                    u32x2 w1; w1.x = cvt_pk_bf16(b[0], b[1]); w1.y = cvt_pk_bf16(b[2], b[3]); *(u32x2*)(o + 16) = w1; } }
    }
};
struct EpiK {
    static constexpr bool PERM = true;
    bf16_t* KC;
    __device__ __forceinline__ void operator()(AccRef acc, const Unit& u, int wr, int wc, int fr, int fq) const {
        const int b = u.pm < 32 ? (u.pm >> 3) : (u.pm - 32), key0 = u.pm < 32 ? CTX + (u.pm & 7) * 256 : 0;
        bf16_t* base = KC + ((size_t)(b * 4 + u.pn * 2) * NKEY + key0) * 192 + (size_t)(wr * 64 + fr) * 192 + wc * 32 + 8 * fq;
#pragma unroll
        for (int ai = 0; ai < 2; ++ai)
#pragma unroll
            for (int m = 0; m < 4; ++m)
#pragma unroll
                for (int bj = 0; bj < 2; ++bj) { const f32x4 v0 = acc[ai][bj][m][0], v1 = acc[ai][bj][m][1];
                    u32x4 w; w.x = cvt_pk_bf16(v0[0], v0[1]); w.y = cvt_pk_bf16(v0[2], v0[3]); w.z = cvt_pk_bf16(v1[0], v1[1]); w.w = cvt_pk_bf16(v1[2], v1[3]);
                    *(u32x4*)(base + (size_t)(ai * 128 + m * 16) * 192 + (size_t)bj * NKEY * 192) = w; }
    }
};
struct EpiV {
    static constexpr bool PERM = true;
    bf16_t* VT;
    __device__ __forceinline__ void operator()(AccRef acc, const Unit& u, int wr, int wc, int fr, int fq) const {
        const int b = u.pn < 32 ? (u.pn >> 3) : (u.pn - 32), key0 = u.pn < 32 ? CTX + (u.pn & 7) * 256 : 0;
        bf16_t* base = VT + ((size_t)(b * 4 + u.pm * 2) * 128 + wr * 64 + fr) * NKEY + key0 + wc * 32 + 8 * fq;
#pragma unroll
        for (int ai = 0; ai < 2; ++ai)
#pragma unroll
            for (int m = 0; m < 4; ++m)
#pragma unroll
                for (int bj = 0; bj < 2; ++bj) { const f32x4 v0 = acc[ai][bj][m][0], v1 = acc[ai][bj][m][1];
                    u32x2 w0, w1; w0.x = cvt_pk_bf16(v0[0], v0[1]); w0.y = cvt_pk_bf16(v0[2], v0[3]); w1.x = cvt_pk_bf16(v1[0], v1[1]); w1.y = cvt_pk_bf16(v1[2], v1[3]);
                    bf16_t* q = base + (size_t)(ai * 128 + m * 16) * NKEY + bj * 128; const int odd = fq & 1;
                    *(u32x2*)(q + (odd ? -4 : 0)) = w0; *(u32x2*)(q + (odd ? 4 : 8)) = w1; }
    }
};
struct EpiS1 {
    static constexpr bool PERM = false;
    float* EST;
    __device__ __forceinline__ void operator()(AccRef acc, const Unit& u, int wr, int wc, int fr, int fq) const {
        PG8_FOR_NOPERM({ const int row = u.pm * 256 + tr; if (row < NCHUNK) *(f32x4*)(EST + ((size_t)u.pb * 768 + row) * 256 + tc) = v; })
    }
};
struct EpiS2 {
    static constexpr bool PERM = true;
    bf16_t* GB;
    __device__ __forceinline__ void operator()(AccRef acc, const Unit& u, int wr, int wc, int fr, int fq) const {
        PG8_FOR_PERM({ const int row = u.pm * 256 + tr; if (row < NCHUNK) { const int p = tc >> 4, c = tc & 15;
            u32x4 w; w.x = cvt_pk_bf16(gelu_tanh(v0[0]), gelu_tanh(v0[1])); w.y = cvt_pk_bf16(gelu_tanh(v0[2]), gelu_tanh(v0[3]));
            w.z = cvt_pk_bf16(gelu_tanh(v1[0]), gelu_tanh(v1[1])); w.w = cvt_pk_bf16(gelu_tanh(v1[2]), gelu_tanh(v1[3]));
            *(u32x4*)(GB + (size_t)(row * 16 + p) * 512 + u.pb * 16 + c) = w; } })
    }
};
struct EpiGlu {
    static constexpr bool PERM = true;
    const bf16_t* GB; const float* bias; bf16_t* CAT;
    __device__ __forceinline__ void operator()(AccRef acc, const Unit& u, int wr, int wc, int fr, int fq) const {
        PG8_FOR_PERM({ const int row = u.pm * 256 + tr, col = u.pn * 256 + tc;
            const u32x4 gv = *(const u32x4*)(GB + (size_t)row * 512 + col); const f32x4 b0 = *(const f32x4*)(bias + col), b1 = *(const f32x4*)(bias + col + 4);
            u32x4 w;
            w.x = cvt_pk_bf16(bflo(gv.x) * sigmoid_f(v0[0] + b0[0]), bfhi(gv.x) * sigmoid_f(v0[1] + b0[1]));
            w.y = cvt_pk_bf16(bflo(gv.y) * sigmoid_f(v0[2] + b0[2]), bfhi(gv.y) * sigmoid_f(v0[3] + b0[3]));
            w.z = cvt_pk_bf16(bflo(gv.z) * sigmoid_f(v1[0] + b1[0]), bfhi(gv.z) * sigmoid_f(v1[1] + b1[1]));
            w.w = cvt_pk_bf16(bflo(gv.w) * sigmoid_f(v1[2] + b1[2]), bfhi(gv.w) * sigmoid_f(v1[3] + b1[3]));
            *(u32x4*)(CAT + (size_t)row * DM + 1024 + col) = w; })
    }
};
struct EpiOut {
    static constexpr bool PERM = false;
    const float* xl; const float* xc; const float* gate; float* xo;
    __device__ __forceinline__ void operator()(AccRef acc, const Unit& u, int wr, int wc, int fr, int fq) const {
        PG8_FOR_NOPERM({ const int row = u.pm * 256 + tr, col = u.pn * 256 + tc; const int rr = row < NLAT ? (row >> 11) : 4;
            const float* src = row < NLAT ? xl + (size_t)row * DM : xc + (size_t)(row - NLAT) * DM;
            const f32x4 xv = *(const f32x4*)(src + col), gv = *(const f32x4*)(gate + (size_t)rr * 12288 + col);
            *(f32x4*)(xo + (size_t)row * DM + col) = xv + gv * v; })
    }
};
struct EpiGU {
    static constexpr bool PERM = true;
    bf16_t* HID;
    __device__ __forceinline__ void operator()(AccRef acc, const Unit& u, int wr, int wc, int fr, int fq) const {
        PG8_FOR_PERM({ const int row = u.pm * 256 + tr, j = (u.pn * 256 + tc) >> 1;
            u32x2 w; w.x = cvt_pk_bf16(silu_f(v0[0]) * v0[1], silu_f(v0[2]) * v0[3]); w.y = cvt_pk_bf16(silu_f(v1[0]) * v1[1], silu_f(v1[2]) * v1[3]);
            *(u32x2*)(HID + ((size_t)u.pb * EROWS + row) * FF + j) = w; })
    }
};
struct EpiDown {
    static constexpr bool PERM = true;
    bf16_t* YS; const float* RA;
    __device__ __forceinline__ void operator()(AccRef acc, const Unit& u, int wr, int wc, int fr, int fq) const {
        PG8_FOR_PERM({ const int row = u.pm * 256 + tr, col = u.pn * 256 + tc; const float a = RA[u.pb * EROWS + row];
            u32x4 w; w.x = cvt_pk_bf16(v0[0] * a, v0[1] * a); w.y = cvt_pk_bf16(v0[2] * a, v0[3] * a); w.z = cvt_pk_bf16(v1[0] * a, v1[1] * a); w.w = cvt_pk_bf16(v1[2] * a, v1[3] * a);
            *(u32x4*)(YS + ((size_t)u.pb * EROWS + row) * DM + col) = w; })
    }
};
}

struct Params { const float* in[33]; float* out; unsigned char* ws; int ph_lo, ph_hi; };
enum { I_X = 0, I_C, I_CTX, I_CCTX, I_N1G, I_N2G, I_WADA, I_BADA, I_WIN, I_WOUT, I_SGUNG, I_SGUW, I_SGUB, I_QNG, I_WUQ, I_KVNG, I_WUKV,
       I_ARE, I_AIM, I_LOGDT, I_BRE, I_BIM, I_CRE, I_CIM, I_S5D, I_WGLU, I_BGLU, I_CONVW, I_WROUTER, I_WGATE, I_WUP, I_WDOWN, I_FNG };

__device__ __forceinline__ void transpose_tile(const float* src, int N, int k0, int n0, bf16_t* dst, int ldd, int rmul, int radd, int remap_kv, LAS float* tile) {
    const int tid = threadIdx.x;
#pragma unroll
    for (int i = 0; i < 2; ++i) { const int r = (tid >> 4) + 32 * i, c4 = (tid & 15) * 4;
        const f32x4 v = *(const f32x4*)(src + (size_t)(k0 + r) * N + n0 + c4);
        tile[r * 65 + c4 + 0] = v[0]; tile[r * 65 + c4 + 1] = v[1]; tile[r * 65 + c4 + 2] = v[2]; tile[r * 65 + c4 + 3] = v[3]; }
    __syncthreads();
    { const int n = tid >> 3, kc = tid & 7; float f[8];
#pragma unroll
        for (int j = 0; j < 8; ++j) f[j] = tile[(kc * 8 + j) * 65 + n];
        int nn = n0 + n; if (remap_kv) nn = ((nn & 255) < 128) ? ((nn >> 8) * 128 + (nn & 127)) : (512 + (nn >> 8) * 128 + (nn & 127));
        const int drow = nn * rmul + radd;
        u32x4 w; w.x = cvt_pk_bf16(f[0], f[1]); w.y = cvt_pk_bf16(f[2], f[3]); w.z = cvt_pk_bf16(f[4], f[5]); w.w = cvt_pk_bf16(f[6], f[7]);
        *(u32x4*)(dst + (size_t)drow * ldd + k0 + kc * 8) = w; }
    __syncthreads();
}
constexpr int N_ADA_UNITS = 192, N_S5T_UNITS = 64, N_ROPE_UNITS = 2;
constexpr int T_WIN = 32 * 59, T_WOUT = 32 * 32, T_WUQ = 6 * 12, T_WUKV = 4 * 16, T_WGLU = 8 * 8, T_EXP = 512;
constexpr int N_TR = 2 * (T_WIN + T_WOUT + T_WUQ + T_WUKV + T_WGLU);
constexpr int N_PRO_ITEMS = N_ADA_UNITS + N_S5T_UNITS + N_ROPE_UNITS + N_TR;


__device__ __forceinline__ void transpose_block(const float* src, int N, int k0, int n0, bf16_t* dst, int ldd, int rmul, int radd, LAS float* tile  ) {
    const int tid = opaque_tid();
    f32x4 v[8];
#pragma unroll
    for (int i = 0; i < 8; ++i) v[i] = __builtin_nontemporal_load((const f32x4*)(src + (size_t)(k0 + (tid >> 6) + 8 * i) * N + n0 + (tid & 63) * 4));
#pragma unroll
    for (int i = 0; i < 8; ++i) { const int r = (tid >> 6) + 8 * i; *(LAS f32x4*)(tile + r * 260 + (((tid & 63) * 4) ^ (8 * (r >> 3)))) = v[i]; }
    __syncthreads();
#pragma unroll
    for (int i = 0; i < 4; ++i) { const int id = tid + 512 * i, n = id >> 3, kc = id & 7; float f[8];
#pragma unroll
        for (int j = 0; j < 8; ++j) f[j] = tile[(kc * 8 + j) * 260 + (n ^ (8 * kc))];
        u32x4 w; w.x = cvt_pk_bf16(f[0], f[1]); w.y = cvt_pk_bf16(f[2], f[3]); w.z = cvt_pk_bf16(f[4], f[5]); w.w = cvt_pk_bf16(f[6], f[7]);
        *(u32x4*)(dst + (size_t)((n0 + n) * rmul + radd) * ldd + k0 + kc * 8) = w; }
    __syncthreads();
}
constexpr int QB_EXP = T_EXP / 4, Q_GU = NE * 2 * QB_EXP, Q_LAYER = Q_GU + NE * QB_EXP, Q_TOTAL = 2 * Q_LAYER;
constexpr int CW_QHEAD = 4096, CW_DONE = 4160;
static_assert((CW_DONE + 64 * 32) * 4 <= (int)CTL_BYTES, "control words inside the memset region");
__device__ __forceinline__ void moe_convert_block(const Params& p, unsigned char* ws, int t, LAS float* tile) {
    const int l = t / Q_LAYER, r = t % Q_LAYER;
    if (r < Q_GU) { const int e = r / (2 * QB_EXP), rr = r % (2 * QB_EXP), up = rr / QB_EXP, q = rr % QB_EXP; const int le = l * NE + e;
        transpose_block((up ? p.in[I_WUP] : p.in[I_WGATE]) + (size_t)le * DM * FF, FF, (q >> 2) * 64, (q & 3) * 256, (bf16_t*)(ws + WS_WTGU) + (size_t)le * 2048 * DM, DM, 2, up, tile); }
    else { const int r2 = r - Q_GU, e = r2 / QB_EXP, q = r2 % QB_EXP; const int le = l * NE + e;
        transpose_block(p.in[I_WDOWN] + (size_t)le * FF * DM, DM, (q >> 3) * 64, (q & 7) * 256, (bf16_t*)(ws + WS_WTDN) + (size_t)le * DM * FF, FF, 1, 0, tile); }
}
#ifndef FILL_ON
#define FILL_ON 0
#endif
constexpr unsigned Q_BULK = 4;
__device__ __forceinline__ unsigned moe_claim(unsigned* ctl, int ph, int upto, int mode) {
    unsigned t = 0xffffffffu;
    const unsigned head = __hip_atomic_load(ctl + CW_QHEAD, __ATOMIC_RELAXED, __HIP_MEMORY_SCOPE_AGENT);
    const bool go = mode ? (head < (unsigned)upto) : (head < (unsigned)Q_TOTAL && __hip_atomic_load(ctl + CW_DONE + 64 * ph, __ATOMIC_RELAXED, __HIP_MEMORY_SCOPE_AGENT) < gridDim.x);
    if (go) t = __hip_atomic_fetch_add(ctl + CW_QHEAD, mode ? Q_BULK : 1u, __ATOMIC_RELAXED, __HIP_MEMORY_SCOPE_AGENT);
    return t;
}
__device__ __forceinline__ void moe_pump(const Params& p, LAS unsigned char* lds, int ph, int upto, int mode) {
    unsigned char* ws = opaque_ptr(p.ws); unsigned* ctl = (unsigned*)(ws + WS_CTL);
    LAS float* tile = (LAS float*)lds; volatile LAS unsigned* slot = (volatile LAS unsigned*)(lds + LDS_MISC + 32);
    const int tid = opaque_tid(); const int nblk = mode ? (int)Q_BULK : 1;
    __syncthreads();
    if (tid == 0) { if (mode == 0) (void)__hip_atomic_fetch_add(ctl + CW_DONE + 64 * ph, 1u, __ATOMIC_RELAXED, __HIP_MEMORY_SCOPE_AGENT); slot[0] = moe_claim(ctl, ph, upto, mode); }
    __syncthreads();
    for (;;) {
        const unsigned t = slot[0];
        if (t >= (unsigned)Q_TOTAL) break;
        unsigned nxt = 0u;
        if (tid == 0) nxt = moe_claim(ctl, ph, upto, mode);
#pragma unroll 1
        for (int k = 0; k < nblk; ++k) if ((int)t + k < Q_TOTAL) moe_convert_block(p, ws, (int)t + k, tile);
        if (tid == 0) slot[0] = nxt;
        __syncthreads();
    }
}
__device__ __forceinline__ void moe_fill(const Params& p, LAS unsigned char* lds, int ph) { if (FILL_ON) moe_pump(p, lds, ph, Q_TOTAL, 0); }
__device__ __forceinline__ void moe_require(const Params& p, LAS unsigned char* lds, int upto) { moe_pump(p, lds, 0, upto, 1); }

__device__ __forceinline__ void ph_prologue(const Params& p, LAS unsigned char* lds) {
    const int tid = opaque_tid(), lane = tid & 63, wave = tid >> 6;
    unsigned char* ws = opaque_ptr(p.ws);
    for (int it = blockIdx.x; it < N_PRO_ITEMS; it += gridDim.x) {
        if (it < N_ADA_UNITS) {
            const int l = it / 96, cb = it % 96;
            LAS float* sil = (LAS float*)lds;
            LAS float* red = (LAS float*)(lds + 40960);
            for (int i = tid; i < 5 * DM; i += 512) { const int r = i >> 11, k = i & (DM - 1); const float v = r < 4 ? p.in[I_C][r * DM + k] : p.in[I_CCTX][k]; sil[i] = silu_f(v); }
            __syncthreads();
            f32x2 acc[5];
#pragma unroll
            for (int r = 0; r < 5; ++r) acc[r] = (f32x2){0.f, 0.f};
            const float* W = p.in[I_WADA] + (size_t)l * DM * 12288 + cb * 128 + lane * 2;
            for (int k = wave * 256; k < wave * 256 + 256; k += 16) {
                f32x2 w[16];
#pragma unroll
                for (int j = 0; j < 16; ++j) w[j] = __builtin_nontemporal_load((const f32x2*)(W + (size_t)(k + j) * 12288));
#pragma unroll
                for (int j = 0; j < 16; ++j)
#pragma unroll
                    for (int r = 0; r < 5; ++r) acc[r] += sil[r * DM + k + j] * w[j];
            }
#pragma unroll
            for (int r = 0; r < 5; ++r) { red[(wave * 5 + r) * 128 + lane * 2] = acc[r].x; red[(wave * 5 + r) * 128 + lane * 2 + 1] = acc[r].y; }
            __syncthreads();
            float* mod = (float*)(ws + WS_MOD);
            for (int o = tid; o < 5 * 128; o += 512) { const int r = o >> 7, cc = o & 127; float sum = p.in[I_BADA][l * 12288 + cb * 128 + cc];
#pragma unroll
                for (int w8 = 0; w8 < 8; ++w8) sum += red[(w8 * 5 + r) * 128 + cc];
                mod[(size_t)(l * 5 + r) * 12288 + cb * 128 + cc] = sum; }
            __syncthreads();
        } else if (it < N_ADA_UNITS + N_S5T_UNITS) {
            const int lg = it - N_ADA_UNITS, l = lg >> 5, g = lg & 31;
            LAS f32x2* PWl = (LAS f32x2*)lds;
            LAS f32x2* BBl = (LAS f32x2*)(lds + 17408);
            LAS f32x2* Cl = (LAS f32x2*)(lds + 33792);
            LAS float* KZl = (LAS float*)(lds + 50176);
            for (int idx = tid; idx < 2 * 64 * 17; idx += 512) { const int z = idx / (64 * 17), n = (idx / 17) & 63, d = idx % 17; const int zgn = ((l * 2 + z) * 32 + g) * 64 + n;
                const float are = fminf(p.in[I_ARE][zgn], -1e-4f), aim = p.in[I_AIM][zgn]; const float dt = expf(p.in[I_LOGDT][zgn >> 6]);
                const double mag = exp((double)are * (double)dt * d); double sn, cs; sincos((double)aim * (double)dt * d, &sn, &cs);
                const f32x2 v = {(float)(mag * cs), (float)(mag * sn)}; PWl[idx] = v; if (d == 16) ((f32x2*)(ws + WS_A16))[zgn] = v; }
            for (int idx = tid; idx < 2 * 64 * 16; idx += 512) { const int z = idx >> 10, n = (idx >> 4) & 63, c = idx & 15; const int zgn = ((l * 2 + z) * 32 + g) * 64 + n;
                const float are = fminf(p.in[I_ARE][zgn], -1e-4f), aim = p.in[I_AIM][zgn]; const float dt = expf(p.in[I_LOGDT][zgn >> 6]);
                const double mag = exp((double)are * (double)dt); double sn, cs; sincos((double)aim * (double)dt, &sn, &cs);
                const float xr = (float)(mag * cs) - 1.0f, xi = (float)(mag * sn), den = 1.0f / (are * are + aim * aim);
                const float cr = (xr * are + xi * aim) * den, ci = (xi * are - xr * aim) * den;
                const float br = p.in[I_BRE][(size_t)zgn * 16 + c], bi = p.in[I_BIM][(size_t)zgn * 16 + c]; BBl[idx] = (f32x2){cr * br - ci * bi, cr * bi + ci * br}; }
            for (int idx = tid; idx < 2 * 16 * 64; idx += 512) { const int z = idx >> 10, cn = idx & 1023; const size_t src = ((size_t)((l * 2 + z) * 32 + g) * 16) * 64 + cn; Cl[idx] = (f32x2){p.in[I_CRE][src], p.in[I_CIM][src]}; }
            __syncthreads();
            { const int z = tid >> 8, d = (tid >> 4) & 15, c = tid & 15; float a16[16];
#pragma unroll
              for (int q = 0; q < 16; ++q) a16[q] = 0.f;
              for (int n = 0; n < 64; ++n) { const f32x2 pw = PWl[(z * 64 + n) * 17 + d], cm = Cl[(z * 16 + c) * 64 + n]; const float tr = cm.x * pw.x - cm.y * pw.y, ti = cm.x * pw.y + cm.y * pw.x;
#pragma unroll
                  for (int q = 0; q < 16; ++q) { const f32x2 bb = BBl[(z * 64 + n) * 16 + q]; a16[q] += tr * bb.x - ti * bb.y; } }
#pragma unroll
              for (int q = 0; q < 16; ++q) KZl[((z * 16 + d) * 16 + c) * 16 + q] = a16[q]; }
            __syncthreads();
            bf16_t* WST = (bf16_t*)(ws + WS_WST) + (size_t)lg * 256 * 256; bf16_t* G2B = (bf16_t*)(ws + WS_G2B) + (size_t)lg * 256 * 512;
            for (int i = 0; i < 16; ++i) { const int id = tid + 512 * i;
                {
                  const int c8 = (id & 1) * 8, pp = (id >> 1) & 15, row = id >> 5, z = row >> 7, ri = (row >> 6) & 1, n = row & 63;
                  const f32x2 pw = PWl[(z * 64 + n) * 17 + (z == 0 ? 15 - pp : pp)]; float f[8];
#pragma unroll
                  for (int j = 0; j < 8; ++j) { const f32x2 bb = BBl[(z * 64 + n) * 16 + c8 + j]; f[j] = ri == 0 ? (pw.x * bb.x - pw.y * bb.y) : (pw.x * bb.y + pw.y * bb.x); }
                  u32x4 w; w.x = cvt_pk_bf16(f[0], f[1]); w.y = cvt_pk_bf16(f[2], f[3]); w.z = cvt_pk_bf16(f[4], f[5]); w.w = cvt_pk_bf16(f[6], f[7]);
                  *(u32x4*)(WST + (size_t)row * 256 + pp * 16 + c8) = w; }
                {
                  const int n8 = (id & 7) * 8, ri = (id >> 3) & 1, z = (id >> 4) & 1, row = id >> 5, pp = row >> 4, c = row & 15; float f[8];
#pragma unroll
                  for (int j = 0; j < 8; ++j) { const f32x2 pw = PWl[(z * 64 + n8 + j) * 17 + (z == 0 ? pp + 1 : 16 - pp)], cm = Cl[(z * 16 + c) * 64 + n8 + j]; f[j] = ri == 0 ? (cm.x * pw.x - cm.y * pw.y) : -(cm.x * pw.y + cm.y * pw.x); }
                  u32x4 w; w.x = cvt_pk_bf16(f[0], f[1]); w.y = cvt_pk_bf16(f[2], f[3]); w.z = cvt_pk_bf16(f[4], f[5]); w.w = cvt_pk_bf16(f[6], f[7]);
                  *(u32x4*)(G2B + (size_t)row * 512 + 256 + z * 128 + ri * 64 + n8) = w; }
                {
                  const int c8 = (id & 1) * 8, pq = (id >> 1) & 15, row = id >> 5, pp = row >> 4, c = row & 15; float f[8];
#pragma unroll
                  for (int j = 0; j < 8; ++j) { float v = 0.f; if (pq <= pp) v += KZl[((0 * 16 + (pp - pq)) * 16 + c) * 16 + c8 + j]; if (pq >= pp) v += KZl[((1 * 16 + (pq - pp)) * 16 + c) * 16 + c8 + j];
                      if (pq == pp && c8 + j == c) v += p.in[I_S5D][l * 512 + g * 16 + c]; f[j] = v; }
                  u32x4 w; w.x = cvt_pk_bf16(f[0], f[1]); w.y = cvt_pk_bf16(f[2], f[3]); w.z = cvt_pk_bf16(f[4], f[5]); w.w = cvt_pk_bf16(f[6], f[7]);
                  *(u32x4*)(G2B + (size_t)row * 512 + pq * 16 + c8) = w; } }
            __syncthreads();
        } else if (it < N_ADA_UNITS + N_S5T_UNITS + N_ROPE_UNITS) {
            const int idx = (it - N_ADA_UNITS - N_S5T_UNITS) * 512 + tid; const int pos = idx >> 4, f = idx & 15;
            const float invf = powf(10000.0f, -(float)f * 0.0625f); const float ang = (float)pos * invf;
            ((f32x2*)(ws + WS_ROPE))[idx] = (f32x2){cosf(ang), sinf(ang)};
        } else {
            int t = it - N_ADA_UNITS - N_S5T_UNITS - N_ROPE_UNITS;
            LAS float* tile = (LAS float*)lds;
            if (t < 2 * T_WIN) { const int l = t / T_WIN, r = t % T_WIN; transpose_tile(p.in[I_WIN] + (size_t)l * DM * INC, INC, (r % 32) * 64, (r / 32) * 64, (bf16_t*)(ws + WS_WTIN) + (size_t)l * INP * DM, DM, 1, 0, 0, tile); continue; }
            t -= 2 * T_WIN;
            if (t < 2 * T_WOUT) { const int l = t / T_WOUT, r = t % T_WOUT; transpose_tile(p.in[I_WOUT] + (size_t)l * DM * DM, DM, (r % 32) * 64, (r / 32) * 64, (bf16_t*)(ws + WS_WTOUT) + (size_t)l * DM * DM, DM, 1, 0, 0, tile); continue; }
            t -= 2 * T_WOUT;
            if (t < 2 * T_WUQ) { const int l = t / T_WUQ, r = t % T_WUQ; transpose_tile(p.in[I_WUQ] + (size_t)l * 384 * 768, 768, (r % 6) * 64, (r / 6) * 64, (bf16_t*)(ws + WS_WTUQ) + (size_t)l * 768 * 384, 384, 1, 0, 0, tile); continue; }
            t -= 2 * T_WUQ;
            if (t < 2 * T_WUKV) { const int l = t / T_WUKV, r = t % T_WUKV; transpose_tile(p.in[I_WUKV] + (size_t)l * 256 * 1024, 1024, (r % 4) * 64, (r / 4) * 64, (bf16_t*)(ws + WS_WTUKV) + (size_t)l * 1024 * 256, 256, 1, 0, 1, tile); continue; }
            t -= 2 * T_WUKV;
            if (t < 2 * T_WGLU) { const int l = t / T_WGLU, r = t % T_WGLU; transpose_tile(p.in[I_WGLU] + (size_t)l * 512 * 512, 512, (r % 8) * 64, (r / 8) * 64, (bf16_t*)(ws + WS_WTGLU) + (size_t)l * 512 * 512, 512, 1, 0, 0, tile); continue; }
        }
    }
}

__device__ __forceinline__ void rms_mod_store(const f32x4 (&x)[8], const float* g, const float* scale, const float* shift, bf16_t* orow, f32x4 (&y)[8], int lane) {
    float ss = 0.f;
#pragma unroll
    for (int j = 0; j < 8; ++j) ss += x[j][0] * x[j][0] + x[j][1] * x[j][1] + x[j][2] * x[j][2] + x[j][3] * x[j][3];
    ss = wave_sum(ss);
    const float rinv = rsqrtf(ss * (1.0f / DM) + EPS);
#pragma unroll
    for (int j = 0; j < 8; ++j) { const int c = j * 256 + lane * 4;
        const f32x4 gv = *(const f32x4*)(g + c), sc = *(const f32x4*)(scale + c), sh = *(const f32x4*)(shift + c);
        y[j] = x[j] * rinv * gv * (1.0f + sc) + sh;
        u32x2 w; w.x = cvt_pk_bf16(y[j][0], y[j][1]); w.y = cvt_pk_bf16(y[j][2], y[j][3]); *(u32x2*)(orow + c) = w; }
}

constexpr int N1_ROWITEMS = MT / 8, N1_KZ = 64, N1_WST = 1024, N1_INTER = 1024;
__device__ __forceinline__ void ph_norm1_tables(const Params& p) {
    const int tid = opaque_tid(), lane = tid & 63, wave = tid >> 6;
    unsigned char* ws = opaque_ptr(p.ws);
    const float* mod = (const float*)(ws + WS_MOD);
    for (int it = blockIdx.x; it < N1_ROWITEMS; it += gridDim.x) {
        {
            const int row = it * 8 + wave; const int rr = row < NLAT ? (row >> 11) : 4;
            const float* xr = row < NLAT ? p.in[I_X] + (size_t)row * DM : p.in[I_CTX] + (size_t)(row - NLAT) * DM;
            f32x4 x[8], y[8];
#pragma unroll
            for (int j = 0; j < 8; ++j) x[j] = *(const f32x4*)(xr + j * 256 + lane * 4);
            const float* m = mod + (size_t)rr * 12288;
            rms_mod_store(x, p.in[I_N1G], m + DM, m, (bf16_t*)(ws + WS_H) + (size_t)row * DM, y, lane);
        }
    }
}

constexpr int B_ROWITEMS = MT / 8, B_SGU = 72 * 4, B_INTRA = 0;
__device__ __forceinline__ void ph_rowsplit(const Params& p, int l, LAS unsigned char* lds) {
    const int tid = opaque_tid(), lane = tid & 63, wave = tid >> 6;
    unsigned char* ws = opaque_ptr(p.ws);
    const bf16_t* P = (const bf16_t*)(ws + WS_PA);
    bf16_t* CAT = (bf16_t*)(ws + WS_CAT);
    const int nsgu = (l == 0) ? B_SGU : 256;
    for (int it0 = blockIdx.x; it0 < B_ROWITEMS + nsgu; it0 += gridDim.x) {
        const int it = it0 < nsgu ? B_ROWITEMS + it0 : it0 - nsgu;
        if (it < B_ROWITEMS) {
            const int row = it * 8 + wave; const bf16_t* pr = P + (size_t)row * INP;
            const bool lat = row < NLAT; const int t = lat ? (row & (SEQ - 1)) : ((row - NLAT) & (CTX - 1)); const int b = lat ? (row >> 11) : ((row - NLAT) >> 8);
            const int seqlen = lat ? SEQ : CTX;
            { float f[8]; float ss = 0.f;
              if (lane < 48) { const u32x4 v = *(const u32x4*)(pr + C_CQ + lane * 8); f[0] = bflo(v.x); f[1] = bfhi(v.x); f[2] = bflo(v.y); f[3] = bfhi(v.y); f[4] = bflo(v.z); f[5] = bfhi(v.z); f[6] = bflo(v.w); f[7] = bfhi(v.w);
#pragma unroll
                  for (int j = 0; j < 8; ++j) ss += f[j] * f[j]; }
              else {
#pragma unroll
                  for (int j = 0; j < 8; ++j) f[j] = 0.f; }
              ss = wave_sum(ss); const float rinv = rsqrtf(ss * (1.0f / 384.0f) + EPS);
              if (lane < 48) { const float* g = p.in[I_QNG] + l * 384 + lane * 8; u32x4 w;
                  w.x = cvt_pk_bf16(f[0] * rinv * g[0], f[1] * rinv * g[1]); w.y = cvt_pk_bf16(f[2] * rinv * g[2], f[3] * rinv * g[3]);
                  w.z = cvt_pk_bf16(f[4] * rinv * g[4], f[5] * rinv * g[5]); w.w = cvt_pk_bf16(f[6] * rinv * g[6], f[7] * rinv * g[7]);
                  *(u32x4*)((bf16_t*)(ws + WS_QA) + (size_t)row * 384 + lane * 8) = w; } }
            { const u32x2 v = *(const u32x2*)(pr + C_CKV + lane * 4); const float f0 = bflo(v.x), f1 = bfhi(v.x), f2 = bflo(v.y), f3 = bfhi(v.y);
              const float ss = wave_sum(f0 * f0 + f1 * f1 + f2 * f2 + f3 * f3); const float rinv = rsqrtf(ss * (1.0f / 256.0f) + EPS);
              const float* g = p.in[I_KVNG] + l * 256 + lane * 4; u32x2 w; w.x = cvt_pk_bf16(f0 * rinv * g[0], f1 * rinv * g[1]); w.y = cvt_pk_bf16(f2 * rinv * g[2], f3 * rinv * g[3]);
              *(u32x2*)((bf16_t*)(ws + WS_KVA) + (size_t)row * 256 + lane * 4) = w; }
            { float v = bf2f(pr[C_KR + lane]); const float partner = __shfl_xor(v, 16);
              if (lat) { const int jj = lane & 31, fi = jj & 15; const int pos = lane >= 32 ? (t & 63) : (t >> 6);
                  const f32x2 r = ((const f32x2*)(ws + WS_ROPE))[pos * 16 + fi]; const float cs = r.x, sn = r.y;
                  v = jj < 16 ? (v * cs - partner * sn) : (v * cs + partner * sn); }
              const int key = lat ? CTX + t : t; const unsigned short o = f2bf(v);
              bf16_t* kc = (bf16_t*)(ws + WS_KC);
#pragma unroll
              for (int h = 0; h < 4; ++h) kc[((size_t)(b * 4 + h) * NKEY + key) * 192 + 128 + lane] = o; }
            { const u32x4 v = *(const u32x4*)(pr + C_S5 + lane * 8); const int g = lane >> 1, half = lane & 1;
              *(u32x4*)((bf16_t*)(ws + WS_UPK) + ((size_t)g * 768 + (row >> 4)) * 512 + (row & 15) * 16 + half * 8) = v; }
            { const int c0 = lane * 8; float zp[8], zc[8], zn[8];
#pragma unroll
              for (int j = 0; j < 8; ++j) { zp[j] = 0.f; zn[j] = 0.f; }
#define CONV_Z(dst, rp) do { const u32x4 a_ = *(const u32x4*)((rp) + C_CVC + c0); const u32x4 h_ = *(const u32x4*)((rp) + C_CVH + c0); \
                  dst[0] = bflo(a_.x) * bflo(h_.x); dst[1] = bfhi(a_.x) * bfhi(h_.x); dst[2] = bflo(a_.y) * bflo(h_.y); dst[3] = bfhi(a_.y) * bfhi(h_.y); \
                  dst[4] = bflo(a_.z) * bflo(h_.z); dst[5] = bfhi(a_.z) * bfhi(h_.z); dst[6] = bflo(a_.w) * bflo(h_.w); dst[7] = bfhi(a_.w) * bfhi(h_.w); } while (0)
              CONV_Z(zc, pr);
              if (t > 0) CONV_Z(zp, pr - INP);
              if (t < seqlen - 1) CONV_Z(zn, pr + INP);
#undef CONV_Z
              const u32x4 bg = *(const u32x4*)(pr + C_CVB + c0); float bgf[8] = {bflo(bg.x), bfhi(bg.x), bflo(bg.y), bfhi(bg.y), bflo(bg.z), bfhi(bg.z), bflo(bg.w), bfhi(bg.w)};
              const float* cw = p.in[I_CONVW] + (size_t)l * 3 * 512 + c0; float o[8];
#pragma unroll
              for (int j = 0; j < 8; ++j) o[j] = bgf[j] * (cw[j] * zp[j] + cw[512 + j] * zc[j] + cw[1024 + j] * zn[j]);
              u32x4 w; w.x = cvt_pk_bf16(o[0], o[1]); w.y = cvt_pk_bf16(o[2], o[3]); w.z = cvt_pk_bf16(o[4], o[5]); w.w = cvt_pk_bf16(o[6], o[7]);
              *(u32x4*)(CAT + (size_t)row * DM + 1536 + c0) = w; }
        } else if (it < B_ROWITEMS + B_SGU) {
            const int un = it - B_ROWITEMS, cc = un >> 2, h = un & 3; const int row0 = cc * 128;
            LAS bf16_t* Wl = (LAS bf16_t*)lds;
            LAS bf16_t* Vl = (LAS bf16_t*)(lds + 128 * 136 * 2);
            const float* Wg = p.in[I_SGUW] + ((size_t)l * 4 + h) * 128 * 128;
#pragma unroll
            for (int i = 0; i < 8; ++i) { const int e4 = (i * 512 + tid) * 4, r = e4 >> 7, c = e4 & 127; const f32x4 v = *(const f32x4*)(Wg + e4);
                u32x2 w; w.x = cvt_pk_bf16(v[0], v[1]); w.y = cvt_pk_bf16(v[2], v[3]); *(LAS u32x2*)(Wl + r * 136 + c) = w; }
            u32x4 vv[16];
#pragma unroll
            for (int qi = 0; qi < 16; ++qi) vv[qi] = *(const u32x4*)(P + (size_t)(row0 + wave * 16 + qi) * INP + C_SGU_V + lane * 8);
#pragma unroll
            for (int qi = 0; qi < 16; ++qi) { const int q = wave * 16 + qi;
                const u32x4 v = vv[qi]; float f[8] = {bflo(v.x), bfhi(v.x), bflo(v.y), bfhi(v.y), bflo(v.z), bfhi(v.z), bflo(v.w), bfhi(v.w)}; float ss = 0.f;
#pragma unroll
                for (int j = 0; j < 8; ++j) { f[j] = gelu_tanh(f[j]); ss += f[j] * f[j]; }
                ss = wave_sum(ss); const float rinv = rsqrtf(ss * (1.0f / 512.0f) + EPS);
                if ((lane >> 4) == h) { const int c0 = (lane & 15) * 8; const float* g = p.in[I_SGUNG] + l * 512 + h * 128 + c0;
#pragma unroll
                    for (int j = 0; j < 8; ++j) Vl[(c0 + j) * 136 + q] = f2bf(f[j] * rinv * g[j]); } }
            __syncthreads();
            { const int fr = lane & 15, fq = lane >> 4; f32x4 acc[8];
#pragma unroll
              for (int nb = 0; nb < 8; ++nb) acc[nb] = (f32x4){0.f, 0.f, 0.f, 0.f};
#pragma unroll
              for (int ks = 0; ks < 4; ++ks) { const bf16x8 af = *(const LAS bf16x8*)(Wl + (wave * 16 + fr) * 136 + ks * 32 + fq * 8);
#pragma unroll
                  for (int nb = 0; nb < 8; ++nb) { const bf16x8 bfr = *(const LAS bf16x8*)(Vl + (nb * 16 + fr) * 136 + ks * 32 + fq * 8);
                      acc[nb] = __builtin_amdgcn_mfma_f32_16x16x32_bf16(bfr, af, acc[nb], 0, 0, 0); } }
              const int pp = wave * 16 + fr; const float bias = p.in[I_SGUB][((size_t)l * 4 + h) * 128 + pp]; const bf16_t* pr = P + (size_t)(row0 + pp) * INP + C_SGU_U + h * 128;
#pragma unroll
              for (int nb = 0; nb < 8; ++nb) { const int c = nb * 16 + 4 * fq; const u32x2 uv = *(const u32x2*)(pr + c);
                  u32x2 w; w.x = cvt_pk_bf16(gelu_tanh(bflo(uv.x)) * (acc[nb][0] + bias), gelu_tanh(bfhi(uv.x)) * (acc[nb][1] + bias));
                  w.y = cvt_pk_bf16(gelu_tanh(bflo(uv.y)) * (acc[nb][2] + bias), gelu_tanh(bfhi(uv.y)) * (acc[nb][3] + bias));
                  *(u32x2*)(CAT + (size_t)(row0 + pp) * DM + h * 128 + c) = w; } }
            __syncthreads();
        }
    }
}

constexpr int KPITCH = 400, VPITCH = 144;
constexpr int KT_BYTES = 64 * KPITCH, VT_BYTES = 128 * VPITCH;
__device__ __forceinline__ void attn_unit(const bf16_t* Qrows  , const bf16_t* Kbh, const bf16_t* Vbh, int nkeys, bf16_t* Orows, LAS unsigned char* lds) {
    const int tid = opaque_tid(), lane = tid & 63, wave = tid >> 6, l32 = lane & 31, hi = lane >> 5, qg = wave & 3, kh = wave >> 2;
    constexpr int VRING = 3 * KT_BYTES;
    bf16x8 qf[12];
    { const bf16_t* qr = Qrows + (size_t)(qg * 32 + l32) * 768 + hi * 8;
#pragma unroll
      for (int ks = 0; ks < 12; ++ks) qf[ks] = *(const bf16x8*)(qr + ks * 16); }
    f32x16 o[4];
#pragma unroll
    for (int db = 0; db < 4; ++db)
#pragma unroll
        for (int r = 0; r < 16; ++r) o[db][r] = 0.f;
    float mrow = -1e30f, lsum = 0.f;
    const int nt = nkeys / 64;
    const int wv = __builtin_amdgcn_readfirstlane(wave);
    unsigned doffK[4], doffV[3];
#pragma unroll
    for (int i = 0; i < 4; ++i) { const int pc = (wv + 8 * i) < 25 ? (wv + 8 * i) : 24; const int X = pc * 1024 + lane * 16, row = X / KPITCH, col = X % KPITCH; doffK[i] = (unsigned)(row * 384 + (col < 384 ? col : 0)); }
#pragma unroll
    for (int i = 0; i < 3; ++i) { const int pc = (wv + 8 * i) < 18 ? (wv + 8 * i) : 17; const int Y = pc * 1024 + lane * 16, row = Y / VPITCH, col = Y % VPITCH; doffV[i] = (unsigned)(row * (NKEY * 2) + (col < 128 ? col : 0)); }
#define ATT_DMAK(tile, slot) do { _Pragma("unroll") for (int i = 0; i < 4; ++i) { const int pc = (wv + 8 * i) < 25 ? (wv + 8 * i) : 24; \
        __builtin_amdgcn_global_load_lds((const unsigned*)((const char*)Kbh + (size_t)(tile) * (64 * 384) + doffK[i]), (LAS unsigned*)(lds + (slot) * KT_BYTES + pc * 1024), 16, 0, 0); } } while (0)
#define ATT_DMAV(tile, slot) do { _Pragma("unroll") for (int i = 0; i < 3; ++i) { const int pc = (wv + 8 * i) < 18 ? (wv + 8 * i) : 17; \
        __builtin_amdgcn_global_load_lds((const unsigned*)((const char*)Vbh + (size_t)(tile) * 128 + doffV[i]), (LAS unsigned*)(lds + VRING + (slot) * VT_BYTES + pc * 1024), 16, 0, 0); } } while (0)
#define ATT_STEP(S, SN, QK, ks_, vs_) do { \
        float mx = S[0]; \
        _Pragma("unroll") for (int r = 1; r < 16; ++r) mx = fmaxf(mx, S[r]); \
        mx = fmaxf(mx, __shfl_xor(mx, 32)); \
        if (__any(mx > mrow + 8.0f)) { const float mnew = fmaxf(mrow, mx), alpha = __builtin_amdgcn_exp2f(mrow - mnew); mrow = mnew; lsum *= alpha; \
            _Pragma("unroll") for (int db = 0; db < 4; ++db) _Pragma("unroll") for (int r = 0; r < 16; ++r) o[db][r] *= alpha; } \
        __builtin_amdgcn_sched_barrier(0); \
        const LAS unsigned char* Vcur = lds + VRING + (vs_) * VT_BYTES; \
        u32x4 vf0[4], vf1[4]; \
        float ps = 0.f; u32x4 pw0, pw1; \
        if (QK) { const LAS unsigned char* kp = lds + (ks_) * KT_BYTES + (kh * 32 + l32) * KPITCH + hi * 16; \
            bf16x8 kf[12]; \
            _Pragma("unroll") for (int i = 0; i < 12; ++i) kf[i] = *(const LAS bf16x8*)(kp + i * 32); \
            _Pragma("unroll") for (int r = 0; r < 16; ++r) SN[r] = 0.f; \
            __builtin_amdgcn_sched_barrier(0); \
              \
            _Pragma("unroll") for (int i = 0; i < 12; ++i) { \
                SN = __builtin_amdgcn_mfma_f32_32x32x16_bf16(kf[i], qf[i], SN, 0, 0, 0); \
                S[i] = __builtin_amdgcn_exp2f(S[i] - mrow); ps += S[i]; \
                if (i < 4) { S[12 + i] = __builtin_amdgcn_exp2f(S[12 + i] - mrow); ps += S[12 + i]; } \
                if (i == 1) pw0.x = cvt_pk_bf16(S[0], S[1]); if (i == 3) { pw0.y = cvt_pk_bf16(S[2], S[3]); pw1.z = cvt_pk_bf16(S[12], S[13]); pw1.w = cvt_pk_bf16(S[14], S[15]); } \
                if (i == 5) pw0.z = cvt_pk_bf16(S[4], S[5]); if (i == 7) pw0.w = cvt_pk_bf16(S[6], S[7]); if (i == 9) pw1.x = cvt_pk_bf16(S[8], S[9]); if (i == 11) pw1.y = cvt_pk_bf16(S[10], S[11]); \
                if (i >= 8) { const int db = i - 8; const LAS unsigned char* vp = Vcur + (db * 32 + l32) * VPITCH + kh * 64 + hi * 16; \
                    vf0[db] = *(const LAS u32x4*)vp; vf1[db] = *(const LAS u32x4*)(vp + 32); } \
                __builtin_amdgcn_sched_barrier(0); } \
        } else { \
            _Pragma("unroll") for (int db = 0; db < 4; ++db) { const LAS unsigned char* vp = Vcur + (db * 32 + l32) * VPITCH + kh * 64 + hi * 16; \
                vf0[db] = *(const LAS u32x4*)vp; vf1[db] = *(const LAS u32x4*)(vp + 32); } \
            _Pragma("unroll") for (int r = 0; r < 16; ++r) { S[r] = __builtin_amdgcn_exp2f(S[r] - mrow); ps += S[r]; } \
            pw0.x = cvt_pk_bf16(S[0], S[1]); pw0.y = cvt_pk_bf16(S[2], S[3]); pw0.z = cvt_pk_bf16(S[4], S[5]); pw0.w = cvt_pk_bf16(S[6], S[7]); \
            pw1.x = cvt_pk_bf16(S[8], S[9]); pw1.y = cvt_pk_bf16(S[10], S[11]); pw1.z = cvt_pk_bf16(S[12], S[13]); pw1.w = cvt_pk_bf16(S[14], S[15]); } \
        lsum += ps; \
        { const bf16x8 pf = __builtin_bit_cast(bf16x8, pw0); \
          _Pragma("unroll") for (int db = 0; db < 4; ++db) o[db] = __builtin_amdgcn_mfma_f32_32x32x16_bf16(__builtin_bit_cast(bf16x8, vf0[db]), pf, o[db], 0, 0, 0); } \
        { const bf16x8 pf = __builtin_bit_cast(bf16x8, pw1); \
          _Pragma("unroll") for (int db = 0; db < 4; ++db) o[db] = __builtin_amdgcn_mfma_f32_32x32x16_bf16(__builtin_bit_cast(bf16x8, vf1[db]), pf, o[db], 0, 0, 0); } \
        __builtin_amdgcn_sched_barrier(0); } while (0)
#define ATT_SYNC(full) do { if (full) asm volatile("s_waitcnt vmcnt(7)" ::: "memory"); else asm volatile("s_waitcnt vmcnt(0)" ::: "memory"); \
        __builtin_amdgcn_s_barrier(); asm volatile("" ::: "memory"); } while (0)
    ATT_DMAK(0, 0); ATT_DMAV(0, 0); ATT_DMAK(1, 1); ATT_DMAV(1, 1); if (nt > 2) ATT_DMAK(2, 2);
    asm volatile("s_waitcnt vmcnt(0)" ::: "memory");
    __builtin_amdgcn_s_barrier(); asm volatile("" ::: "memory");
    f32x16 sA, sB;
    { const LAS unsigned char* kp = lds + (kh * 32 + l32) * KPITCH + hi * 16;
#pragma unroll
      for (int r = 0; r < 16; ++r) sA[r] = 0.f;
#pragma unroll
      for (int i = 0; i < 12; ++i) { const bf16x8 kf = *(const LAS bf16x8*)(kp + i * 32); sA = __builtin_amdgcn_mfma_f32_32x32x16_bf16(kf, qf[i], sA, 0, 0, 0); } }
    int k1 = 1, v0 = 0;
    int j = 0;
    for (; j + 2 < nt; j += 2) {
        ATT_SYNC(true);
        if (j + 3 < nt) ATT_DMAK(j + 3, v0);
        ATT_DMAV(j + 2, v0 == 0 ? 2 : v0 - 1);
        ATT_STEP(sA, sB, true, k1, v0);
        k1 = k1 == 2 ? 0 : k1 + 1; v0 = v0 == 2 ? 0 : v0 + 1;
        ATT_SYNC(j + 3 < nt);
        if (j + 4 < nt) ATT_DMAK(j + 4, v0);
        if (j + 3 < nt) ATT_DMAV(j + 3, v0 == 0 ? 2 : v0 - 1);
        ATT_STEP(sB, sA, true, k1, v0);
        k1 = k1 == 2 ? 0 : k1 + 1; v0 = v0 == 2 ? 0 : v0 + 1;
    }
    ATT_SYNC(false);
    ATT_STEP(sA, sB, true, k1, v0);
    k1 = k1 == 2 ? 0 : k1 + 1; v0 = v0 == 2 ? 0 : v0 + 1;
    ATT_SYNC(false);
    ATT_STEP(sB, sA, false, k1, v0);
#undef ATT_STEP
#undef ATT_SYNC
#undef ATT_DMAK
#undef ATT_DMAV
    __syncthreads();
    lsum += __shfl_xor(lsum, 32);
    LAS float* mb = (LAS float*)lds + (size_t)qg * 66 * 64 + lane;
    if (kh == 1) {
#pragma unroll
        for (int db = 0; db < 4; ++db)
#pragma unroll
            for (int r = 0; r < 16; ++r) mb[(db * 16 + r) * 64] = o[db][r];
        mb[64 * 64] = mrow; mb[65 * 64] = lsum;
    }
    __syncthreads();
    if (kh == 0) {
        const float m1 = mb[64 * 64], l1 = mb[65 * 64];
        const float m = fmaxf(mrow, m1), e0 = __builtin_amdgcn_exp2f(mrow - m), e1 = __builtin_amdgcn_exp2f(m1 - m);
        const float inv = 1.0f / (lsum * e0 + l1 * e1), c0 = e0 * inv, c1 = e1 * inv;
        bf16_t* orow = Orows + (size_t)(qg * 32 + l32) * DM;
#pragma unroll
        for (int db = 0; db < 4; ++db)
#pragma unroll
            for (int k4 = 0; k4 < 4; ++k4) { float v[4];
#pragma unroll
                for (int i = 0; i < 4; ++i) v[i] = o[db][4 * k4 + i] * c0 + mb[(db * 16 + 4 * k4 + i) * 64] * c1;
                u32x2 w; w.x = cvt_pk_bf16(v[0], v[1]); w.y = cvt_pk_bf16(v[2], v[3]);
                *(u32x2*)(orow + db * 32 + 8 * k4 + 4 * hi) = w; }
    }
    __syncthreads();
}
__device__ __forceinline__ void ph_attn_carry(const Params& p, int l, LAS unsigned char* lds) {
    unsigned char* ws = opaque_ptr(p.ws); const int tid = opaque_tid();
    const int natt = (l == 0) ? 288 : 256;
    const bf16_t* QB = (const bf16_t*)(ws + WS_QB); const bf16_t* KC = (const bf16_t*)(ws + WS_KC); const bf16_t* VT = (const bf16_t*)(ws + WS_VT); bf16_t* CAT = (bf16_t*)(ws + WS_CAT);
    for (int it = blockIdx.x; it < natt; it += gridDim.x) {
        {
            int b, h, row0, nkeys;
            if (it < 256) { const int x = it & 7, jj = it >> 3, bh = 2 * x + (jj >> 4); b = bh >> 2; h = bh & 3; row0 = b * SEQ + (jj & 15) * 128; nkeys = NKEY; }
            else { const int u = it - 256; b = u >> 3; h = (u >> 1) & 3; row0 = NLAT + b * CTX + (u & 1) * 128; nkeys = CTX; }
            attn_unit(QB + (size_t)row0 * 768 + h * 192, KC + (size_t)(b * 4 + h) * NKEY * 192, VT + (size_t)(b * 4 + h) * 128 * NKEY, nkeys, CAT + (size_t)row0 * DM + 512 + h * 128, lds);
        }
    }
    for (int it = natt + (int)((blockIdx.x + gridDim.x - natt % gridDim.x) % gridDim.x); it < natt + 256; it += gridDim.x) {
        {
            const int u = it - natt; const int z = u >> 7, b = (u >> 5) & 3, g = u & 31, lane = tid & 63, w = tid >> 6;
            const f32x2 a16 = ((const f32x2*)(ws + WS_A16))[(((size_t)l * 2 + z) * 32 + g) * 64 + lane];
            const float* EST = (const float*)(ws + WS_EST) + (size_t)g * 768 * 256 + z * 128 + lane;
            bf16_t* UP = (bf16_t*)(ws + WS_UPK) + (size_t)g * 768 * 512 + 256 + z * 128 + lane;
            LAS f32x2* seg = (LAS f32x2*)lds;
            float er[18], ei[18];
#pragma unroll
            for (int i = 0; i < 18; ++i) { const int st = w * 18 + i; int chunk;
                if (z == 0) chunk = st < 16 ? (512 + b * 16 + st) : (b * 128 + (st - 16)); else chunk = st < 16 ? (512 + b * 16 + (15 - st)) : (b * 128 + (143 - st));
                er[i] = EST[(size_t)chunk * 256]; ei[i] = EST[(size_t)chunk * 256 + 64]; }
            float sr = 0.f, si = 0.f;
#pragma unroll
            for (int i = 0; i < 18; ++i) { const float nr = a16.x * sr - a16.y * si + er[i], ni = a16.x * si + a16.y * sr + ei[i]; sr = nr; si = ni; }
            seg[w * 64 + lane] = (f32x2){sr, si};
            float pr = 1.f, pi = 0.f;
#pragma unroll
            for (int i = 0; i < 18; ++i) { const float nr = pr * a16.x - pi * a16.y, ni = pr * a16.y + pi * a16.x; pr = nr; pi = ni; }
            __syncthreads();
            sr = 0.f; si = 0.f;
            for (int w2 = 0; w2 < w; ++w2) { const f32x2 sv = seg[w2 * 64 + lane]; const float nr = pr * sr - pi * si + sv.x, ni = pr * si + pi * sr + sv.y; sr = nr; si = ni; }
#pragma unroll
            for (int i = 0; i < 18; ++i) { const int st = w * 18 + i; int chunk;
                if (z == 0) chunk = st < 16 ? (512 + b * 16 + st) : (b * 128 + (st - 16)); else chunk = st < 16 ? (512 + b * 16 + (15 - st)) : (b * 128 + (143 - st));
                UP[(size_t)chunk * 512] = f2bf(sr); UP[(size_t)chunk * 512 + 64] = f2bf(si);
                const float nr = a16.x * sr - a16.y * si + er[i], ni = a16.x * si + a16.y * sr + ei[i]; sr = nr; si = ni; }
            __syncthreads();
        }
    }
}

__device__ __forceinline__ void ph_norm2_router(const Params& p, int l, LAS unsigned char* lds) {
    const int tid = opaque_tid(), lane = tid & 63, wave = tid >> 6;
    unsigned char* ws = opaque_ptr(p.ws); const float* mod = (const float*)(ws + WS_MOD) + (size_t)l * 5 * 12288;
    const int nrows = (l == 0) ? MT : NLAT;
    const float* WR = p.in[I_WROUTER] + (size_t)l * DM * NE;
    for (int idx = tid; idx < DM * 4; idx += 512) { const int c = idx & (DM - 1), e4 = idx >> 11; const f32x4 v = *(const f32x4*)(WR + (size_t)c * NE + e4 * 4);
        *(LAS f32x4*)(lds + (size_t)(((e4 * 2 + (c & 1)) * 1024 + (c >> 1)) * 16)) = v; }
    __syncthreads();
    const float* n2g = p.in[I_N2G] + l * DM;
    for (int it = blockIdx.x; it < nrows / 8; it += gridDim.x) {
        const int row = it * 8 + wave; const int rr = row < NLAT ? (row >> 11) : 4;
        const float* xr = (const float*)(ws + WS_XB) + (size_t)row * DM;
        const float* m = mod + (size_t)rr * 12288;
        f32x2 x[16], gv[16], sc[16], sh[16];
#pragma unroll
        for (int j = 0; j < 16; ++j) { const int c = j * 128 + lane * 2; x[j] = *(const f32x2*)(xr + c); gv[j] = *(const f32x2*)(n2g + c); sc[j] = *(const f32x2*)(m + 4 * DM + c); sh[j] = *(const f32x2*)(m + 3 * DM + c); }
        float ss = 0.f;
#pragma unroll
        for (int j = 0; j < 16; ++j) ss += x[j].x * x[j].x + x[j].y * x[j].y;
        ss = wave_sum(ss); const float rinv = rsqrtf(ss * (1.0f / DM) + EPS);
        bf16_t* orow = (bf16_t*)(ws + WS_H) + (size_t)row * DM;
        f32x4 lg[4];
#pragma unroll
        for (int e4 = 0; e4 < 4; ++e4) lg[e4] = (f32x4){0.f, 0.f, 0.f, 0.f};
#pragma unroll
        for (int j = 0; j < 16; ++j) { const f32x2 y = x[j] * rinv * gv[j] * (1.0f + sc[j]) + sh[j];
            *(unsigned*)(orow + j * 128 + lane * 2) = cvt_pk_bf16(y.x, y.y);
#pragma unroll
            for (int e4 = 0; e4 < 4; ++e4) { const f32x4 w0 = *(const LAS f32x4*)(lds + (size_t)(((e4 * 2 + 0) * 1024 + j * 64 + lane) * 16)); const f32x4 w1 = *(const LAS f32x4*)(lds + (size_t)(((e4 * 2 + 1) * 1024 + j * 64 + lane) * 16));
                lg[e4] += y.x * w0 + y.y * w1; }
            __builtin_amdgcn_sched_barrier(0); }
        float lgs[16]; float mx = -1e30f;
#pragma unroll
        for (int e = 0; e < 16; ++e) { lgs[e] = wave_sum(lg[e >> 2][e & 3]); mx = fmaxf(mx, lgs[e]); }
        float se = 0.f;
#pragma unroll
        for (int e = 0; e < 16; ++e) { lgs[e] = __expf(lgs[e] - mx); se += lgs[e]; }
        const float inv = 1.0f / se;
        float mine = 0.f;
#pragma unroll
        for (int e = 0; e < 16; ++e) mine = (lane == e) ? lgs[e] * inv : mine;
        if (lane < 16) ((float*)(ws + WS_AFF))[(size_t)row * 16 + lane] = mine;
    }
}

__device__ __forceinline__ void ph_topk(const Params& p, int l, LAS unsigned char* lds) {
    const int tid = opaque_tid(), lane = tid & 63, wave = tid >> 6;
    unsigned char* ws = opaque_ptr(p.ws); const float* AFF = (const float*)(ws + WS_AFF);
    int* ROWTOK = (int*)(ws + WS_ROWTOK); float* ROWAFF = (float*)(ws + WS_ROWAFF); int* INV = (int*)(ws + WS_INV);
    LAS int* hist = (LAS int*)lds;
    LAS int* ctl = (LAS int*)(lds + 1024);
    LAS int* wsum = (LAS int*)(lds + 1280);
    const int nunits = (l == 0) ? 128 : 64;
    for (int it = blockIdx.x; it < nunits; it += gridDim.x) {
        const bool lat = it < 64; const int u = lat ? it : it - 64; const int b = u >> 4, e = u & 15;
        const int n = lat ? SEQ : CTX, cap = lat ? CAPL : CAPC;
        const int tok0 = lat ? b * SEQ : NLAT + b * CTX; const int rowbase = lat ? b * CAPL : 1024 + b * CAPC;
        unsigned key[4];
#pragma unroll
        for (int j = 0; j < 4; ++j) { const int t = tid * 4 + j; key[j] = t < n ? __float_as_uint(AFF[(size_t)(tok0 + t) * 16 + e]) : 0u; }
        unsigned prefix = 0u; int remaining = cap;
        for (int pass = 3; pass >= 0; --pass) {
            if (tid < 256) hist[tid] = 0;
            __syncthreads();
#pragma unroll
            for (int j = 0; j < 4; ++j) { const int t = tid * 4 + j; if (t < n) { const bool match = (pass == 3) || ((key[j] >> (8 * (pass + 1))) == (prefix >> (8 * (pass + 1)))); if (match) atomicAdd((int*)&hist[(key[j] >> (8 * pass)) & 255u], 1); } }
            __syncthreads();
            if (wave == 0) {
                const int b0 = hist[4 * lane], b1 = hist[4 * lane + 1], b2 = hist[4 * lane + 2], b3 = hist[4 * lane + 3];
                const int s = b0 + b1 + b2 + b3; int suf = s;
#pragma unroll
                for (int off = 1; off < 64; off <<= 1) { const int t = __shfl_down(suf, off); if (lane + off < 64) suf += t; }
                const int above = suf - s; const int c3 = above + b3, c2 = c3 + b2, c1 = c2 + b1, c0 = c1 + b0;
                if (above < remaining && c0 >= remaining) { int dg, nr;
                    if (c3 >= remaining) { dg = 4 * lane + 3; nr = remaining - above; } else if (c2 >= remaining) { dg = 4 * lane + 2; nr = remaining - c3; }
                    else if (c1 >= remaining) { dg = 4 * lane + 1; nr = remaining - c2; } else { dg = 4 * lane; nr = remaining - c1; }
                    ctl[0] = dg; ctl[1] = nr; }
            }
            __syncthreads();
            prefix |= ((unsigned)ctl[0]) << (8 * pass); remaining = ctl[1];
            __syncthreads();
        }
        int cgt = 0, ceq = 0;
#pragma unroll
        for (int j = 0; j < 4; ++j) { const int t = tid * 4 + j; if (t < n) { cgt += key[j] > prefix ? 1 : 0; ceq += key[j] == prefix ? 1 : 0; } }
        const int packed = cgt | (ceq << 16);
        int inc = packed;
#pragma unroll
        for (int off = 1; off < 64; off <<= 1) { const int t = __shfl_up(inc, off); if (lane >= off) inc += t; }
        if (lane == 63) wsum[wave] = inc;
        __syncthreads();
        int base = 0;
#pragma unroll
        for (int w8 = 0; w8 < 8; ++w8) base += (w8 < wave) ? wsum[w8] : 0;
        int excl = base + inc - packed; int egt = excl & 0xffff, eeq = excl >> 16;
#pragma unroll
        for (int j = 0; j < 4; ++j) { const int t = tid * 4 + j; if (t < n) {
                const bool gt = key[j] > prefix, eq = key[j] == prefix; const bool sel = gt || (eq && eeq < remaining);
                const int slot = egt + (eeq < remaining ? eeq : remaining);
                if (sel) { ROWTOK[e * EROWS + rowbase + slot] = tok0 + t; ROWAFF[e * EROWS + rowbase + slot] = __uint_as_float(key[j]); }
                INV[(size_t)(tok0 + t) * 16 + e] = sel ? rowbase + slot : -1;
                egt += gt ? 1 : 0; eeq += eq ? 1 : 0; } }
        __syncthreads();
    }
}

__device__ __forceinline__ void ph_gather(const Params& p, int l) {
    const int tid = opaque_tid(), lane = tid & 63, wave = tid >> 6;
    unsigned char* ws = opaque_ptr(p.ws); const int* ROWTOK = (const int*)(ws + WS_ROWTOK);
    const int rows_per_e = (l == 0) ? 1152 : 1024;
    const int nitems = NE * rows_per_e / 8;
    for (int it = blockIdx.x; it < nitems; it += gridDim.x) {
        const int ridx = it * 8 + wave; const int e = ridx / rows_per_e, r = ridx % rows_per_e;
        const int tok = ROWTOK[e * EROWS + r];
        const u32x4* src = (const u32x4*)((const bf16_t*)(ws + WS_H) + (size_t)tok * DM); u32x4* dst = (u32x4*)((bf16_t*)(ws + WS_PA) + ((size_t)e * EROWS + r) * DM);
#pragma unroll
        for (int j = 0; j < 4; ++j) dst[j * 64 + lane] = src[j * 64 + lane];
    }
}

__device__ __forceinline__ void ph_combine(const Params& p, int l) {
    const int tid = opaque_tid(), lane = tid & 63, wave = tid >> 6;
    unsigned char* ws = opaque_ptr(p.ws); const float* mod = (const float*)(ws + WS_MOD);
    const int nrows = (l == 0) ? MT : NLAT;
    const int* INV = (const int*)(ws + WS_INV); const bf16_t* YS = (const bf16_t*)(ws + WS_YS);
    for (int it = blockIdx.x; it < nrows / 8; it += gridDim.x) {
        const int row = it * 8 + wave; const int rr = row < NLAT ? (row >> 11) : 4;
        const float* xr = (const float*)(ws + WS_XB) + (size_t)row * DM;
        f32x4 x[8], s[8], y[8];
#pragma unroll
        for (int j = 0; j < 8; ++j) { x[j] = *(const f32x4*)(xr + j * 256 + lane * 4); s[j] = (f32x4){0.f, 0.f, 0.f, 0.f}; }
        const int myinv = lane < 16 ? INV[(size_t)row * 16 + lane] : -1;
        unsigned msk = (unsigned)__ballot(myinv >= 0);
        while (msk) {
            const int e0 = __builtin_ctz(msk); msk &= msk - 1; const bool two = msk != 0u; const int e1 = two ? __builtin_ctz(msk) : e0; if (two) msk &= msk - 1;
            const int r0 = __shfl(myinv, e0), r1 = __shfl(myinv, e1);
            const bf16_t* y0 = YS + ((size_t)e0 * EROWS + r0) * DM; const bf16_t* y1 = YS + ((size_t)e1 * EROWS + r1) * DM;
            u32x2 v0[8], v1[8];
#pragma unroll
            for (int j = 0; j < 8; ++j) { v0[j] = *(const u32x2*)(y0 + j * 256 + lane * 4); v1[j] = *(const u32x2*)(y1 + j * 256 + lane * 4); }
            const float f1 = two ? 1.0f : 0.0f;
#pragma unroll
            for (int j = 0; j < 8; ++j) { s[j][0] += bflo(v0[j].x) + f1 * bflo(v1[j].x); s[j][1] += bfhi(v0[j].x) + f1 * bfhi(v1[j].x); s[j][2] += bflo(v0[j].y) + f1 * bflo(v1[j].y); s[j][3] += bfhi(v0[j].y) + f1 * bfhi(v1[j].y); }
        }
        const float* gate = mod + (size_t)(l * 5 + rr) * 12288 + 5 * DM;
#pragma unroll
        for (int j = 0; j < 8; ++j) { const f32x4 gv = *(const f32x4*)(gate + j * 256 + lane * 4); x[j] += gv * s[j]; }
        if (l == 0) {
            float* xo = (float*)(ws + WS_XA) + (size_t)row * DM;
#pragma unroll
            for (int j = 0; j < 8; ++j) *(f32x4*)(xo + j * 256 + lane * 4) = x[j];
            const float* m = mod + (size_t)(5 + rr) * 12288;
            rms_mod_store(x, p.in[I_N1G] + DM, m + DM, m, (bf16_t*)(ws + WS_H) + (size_t)row * DM, y, lane);
        } else {
            float ss = 0.f;
#pragma unroll
            for (int j = 0; j < 8; ++j) ss += x[j][0] * x[j][0] + x[j][1] * x[j][1] + x[j][2] * x[j][2] + x[j][3] * x[j][3];
            ss = wave_sum(ss); const float rinv = rsqrtf(ss * (1.0f / DM) + EPS);
            float* orow = p.out + (size_t)row * DM;
#pragma unroll
            for (int j = 0; j < 8; ++j) { const f32x4 gv = *(const f32x4*)(p.in[I_FNG] + j * 256 + lane * 4); *(f32x4*)(orow + j * 256 + lane * 4) = x[j] * rinv * gv; }
        }
    }
}

constexpr int NPH_LAYER = 13, NPH = 2 + 2 * NPH_LAYER;
__global__ void __launch_bounds__(512, 2) fwd(Params p) {
    extern __shared__ __attribute__((aligned(16))) unsigned char lds_raw[];
    LAS unsigned char* lds = (LAS unsigned char*)lds_raw;
    volatile LAS unsigned* MISC = (volatile LAS unsigned*)(lds + LDS_MISC);
    if (threadIdx.x < 16) MISC[threadIdx.x] = 0u;
    __syncthreads();
    unsigned char* ws = p.ws;
    const int lo = p.ph_lo, hi = p.ph_hi;
    XcdBarrier bar; bar.bar = (unsigned*)(ws + WS_CTL); bar.x = 0; bar.st = MISC;
    if (hi - lo > 1) bar = xcd_barrier_post((unsigned*)(ws + WS_CTL), MISC);
    const int G = gridDim.x, c = blockIdx.x;
#ifndef ONLY_PH
#define ONLY_PH -1
#endif
#define PSEL(id) (ONLY_PH < 0 || ONLY_PH == (id))
#ifndef DUP
#define DUP 0
#endif
#define NREP(id) ((((DUP) >> (id)) & 1) ? 2 : 1)
#define REPLOOP(id) for (int rep_ = 0; rep_ < NREP(id); ++rep_)
#define REPBAR(id) do { if (rep_ + 1 < NREP(id)) xcd_barrier(bar); } while (0)
#define IN(k) (lo <= (k) && (k) < hi)
#define SEAM(k) do { if (IN(k) && IN((k) + 1)) xcd_barrier(bar); } while (0)

    if (PSEL(0) && IN(0)) REPLOOP(0) { ph_prologue(p, lds); __syncthreads(); REPBAR(0); }
    SEAM(0);
    if (PSEL(1) && IN(1)) REPLOOP(1) { ph_norm1_tables(p); REPBAR(1); }
    SEAM(1);
    for (int l = 0; l < 2; ++l) {
        const int pb = 2 + NPH_LAYER * l;
        const float* mod = (const float*)(ws + WS_MOD) + (size_t)l * 5 * 12288;
        if (PSEL(2) && IN(pb + 0)) REPLOOP(2) {
            pg8::EpiStoreBf16 E{(bf16_t*)(ws + WS_PA), INP};
            if (l == 0) { pg8::TileSched S; S.init(ws + WS_H, (bf16_t*)(ws + WS_WTIN), DM, DM, MT / 256, INP / 256, 1, 0, 0, G, c, 0); pg8::gemm_phase(lds, pg8::Desc{DM, DM, DM}, S, E); }
            else { pg8::InSchedLast S; S.init(ws + WS_H, (bf16_t*)(ws + WS_WTIN) + (size_t)INP * DM, G, c); pg8::gemm_phase(lds, pg8::Desc{DM, DM, DM}, S, E); }
            moe_fill(p, lds, pb + 0);
         REPBAR(2); }
        SEAM(pb + 0);
        if (PSEL(3) && IN(pb + 1)) REPLOOP(3) { ph_rowsplit(p, l, lds); __syncthreads();  REPBAR(3); }
        SEAM(pb + 1);
        if (PSEL(4) && IN(pb + 2)) REPLOOP(4) {
#ifndef C_SEL
#define C_SEL 15
#endif
            if (C_SEL & 1) { pg8::TileSched S; S.init(ws + WS_QA, (bf16_t*)(ws + WS_WTUQ) + (size_t)l * 768 * 384, 384, 384, (l == 0 ? MT : NLAT) / 256, 3, 1, 0, 0, G, c, 0);
              pg8::EpiQ E{(bf16_t*)(ws + WS_QB), (const f32x2*)(ws + WS_ROPE)}; pg8::gemm_phase(lds, pg8::Desc{384, 384, 384}, S, E); }
            if (C_SEL & 2) { pg8::TileSched S; S.init(ws + WS_KVA, (bf16_t*)(ws + WS_WTUKV) + (size_t)l * 1024 * 256, 256, 256, MT / 256, 2, 1, 0, 0, G, c, 112);
              pg8::EpiK E{(bf16_t*)(ws + WS_KC)}; pg8::gemm_phase(lds, pg8::Desc{256, 256, 256}, S, E); }
            if (C_SEL & 4) { pg8::TileSched S; S.init((bf16_t*)(ws + WS_WTUKV) + (size_t)l * 1024 * 256 + 512 * 256, ws + WS_KVA, 256, 256, 2, MT / 256, 1, 0, 0, G, c, 184);
              pg8::EpiV E{(bf16_t*)(ws + WS_VT)}; pg8::gemm_phase(lds, pg8::Desc{256, 256, 256}, S, E); }
            if (C_SEL & 8) { pg8::TileSched S; S.init(ws + WS_UPK, (bf16_t*)(ws + WS_WST) + (size_t)l * 32 * 256 * 256, 512, 256, 3, 1, 32, (size_t)768 * 512 * 2, (size_t)256 * 256 * 2, G, c, 0);
              pg8::EpiS1 E{(float*)(ws + WS_EST)}; pg8::gemm_phase(lds, pg8::Desc{512, 256, 256}, S, E); }
            moe_fill(p, lds, pb + 2);
         REPBAR(4); }
        SEAM(pb + 2);
        if (PSEL(5) && IN(pb + 3)) REPLOOP(5) { ph_attn_carry(p, l, lds); __syncthreads();  REPBAR(5); }
        SEAM(pb + 3);
        if (PSEL(6) && IN(pb + 4)) REPLOOP(6) {
            pg8::TileSched S; S.init(ws + WS_UPK, (bf16_t*)(ws + WS_G2B) + (size_t)l * 32 * 256 * 512, 512, 512, 3, 1, 32, (size_t)768 * 512 * 2, (size_t)256 * 512 * 2, G, c, 0);
            pg8::EpiS2 E{(bf16_t*)(ws + WS_GB)}; pg8::gemm_phase(lds, pg8::Desc{512, 512, 512}, S, E);
            moe_fill(p, lds, pb + 4);
         REPBAR(6); }
        SEAM(pb + 4);
        if (PSEL(7) && IN(pb + 5)) REPLOOP(7) {
            pg8::TileSched S; S.init(ws + WS_GB, (bf16_t*)(ws + WS_WTGLU) + (size_t)l * 512 * 512, 512, 512, (l == 0 ? MT : NLAT) / 256, 2, 1, 0, 0, G, c, 0);
            pg8::EpiGlu E{(const bf16_t*)(ws + WS_GB), p.in[I_BGLU] + l * 512, (bf16_t*)(ws + WS_CAT)}; pg8::gemm_phase(lds, pg8::Desc{512, 512, 512}, S, E);
            moe_fill(p, lds, pb + 5);
         REPBAR(7); }
        SEAM(pb + 5);
        if (PSEL(8) && IN(pb + 6)) REPLOOP(8) {
            pg8::TileSched S; S.init(ws + WS_CAT, (bf16_t*)(ws + WS_WTOUT) + (size_t)l * DM * DM, DM, DM, (l == 0 ? MT : NLAT) / 256, DM / 256, 1, 0, 0, G, c, 0);
            pg8::EpiOut E{l == 0 ? p.in[I_X] : (const float*)(ws + WS_XA), l == 0 ? p.in[I_CTX] : (const float*)(ws + WS_XA) + (size_t)NLAT * DM, mod + 2 * DM, (float*)(ws + WS_XB)};
            pg8::gemm_phase(lds, pg8::Desc{DM, DM, DM}, S, E);
            moe_fill(p, lds, pb + 6);
         REPBAR(8); }
        SEAM(pb + 6);
        if (PSEL(9) && IN(pb + 7)) REPLOOP(9) { ph_norm2_router(p, l, lds); __syncthreads(); REPBAR(9); }
        SEAM(pb + 7);
        if (PSEL(10) && IN(pb + 8)) REPLOOP(10) { ph_topk(p, l, lds); __syncthreads(); moe_require(p, lds, l * Q_LAYER + Q_GU);  REPBAR(10); }
        if (PSEL(11) && IN(pb + 9)) REPLOOP(11) { }
        SEAM(pb + 9);
        if (PSEL(12) && IN(pb + 10)) REPLOOP(12) {
            pg8::MoeSched S; S.init(ws + WS_H, (bf16_t*)(ws + WS_WTGU) + (size_t)l * NE * 2048 * DM, DM, DM, l == 0 ? 5 : 4, 8, 0, (size_t)2048 * DM * 2, G, c);
            pg8::EpiGU E{(bf16_t*)(ws + WS_HID)}; pg8::gemm_phase<pg8::EpiGU, pg8::MoeSched, true>(lds, pg8::Desc{DM, DM, DM}, S, E, (const int*)(ws + WS_ROWTOK), l == 0 ? 1152 : 1024);
            moe_require(p, lds, (l + 1) * Q_LAYER); moe_fill(p, lds, pb + 10);
         REPBAR(12); }
        SEAM(pb + 10);
        if (PSEL(13) && IN(pb + 11)) REPLOOP(13) {
            pg8::MoeSched S; S.init(ws + WS_HID, (bf16_t*)(ws + WS_WTDN) + (size_t)l * NE * DM * FF, FF, FF, l == 0 ? 5 : 4, 8, (size_t)EROWS * FF * 2, (size_t)DM * FF * 2, G, c);
            pg8::EpiDown E{(bf16_t*)(ws + WS_YS), (const float*)(ws + WS_ROWAFF)}; pg8::gemm_phase(lds, pg8::Desc{FF, FF, FF}, S, E);
            moe_fill(p, lds, pb + 11);
         REPBAR(13); }
        SEAM(pb + 11);
        if (PSEL(14) && IN(pb + 12)) REPLOOP(14) { ph_combine(p, l);  REPBAR(14); }
        SEAM(pb + 12);
    }
#undef IN
#undef SEAM
}

extern "C" void kernel_launch(void* const* d_in, const int* in_sizes, int n_in, void* d_out, int out_size, void* d_ws, size_t ws_size, hipStream_t stream) {
    static int grid = 0;
    if (grid == 0) {
        if (n_in != 33 || ws_size < WS_END) { fprintf(stderr, "kernel_launch: need 33 inputs and >= %zu bytes of workspace; got %d, %zu\n", (size_t)WS_END, n_in, ws_size); grid = -1; return; }
        int dev = 0, cus = 0;
        if (hipGetDevice(&dev) != hipSuccess || hipDeviceGetAttribute(&cus, hipDeviceAttributeMultiprocessorCount, dev) != hipSuccess) { grid = -1; return; }
        if (hipFuncSetAttribute((const void*)fwd, hipFuncAttributeMaxDynamicSharedMemorySize, LDS_BYTES) != hipSuccess) { fprintf(stderr, "kernel_launch: hipFuncSetAttribute failed\n"); grid = -1; return; }
        (void)hipGetLastError();
        grid = cus > 256 ? 256 : cus;
    }
    if (grid < 0) return;
    (void)hipMemsetAsync((char*)d_ws + WS_CTL, 0, CTL_BYTES, stream);
    Params a{};
    for (int i = 0; i < 33; ++i) a.in[i] = (const float*)d_in[i];
    a.out = (float*)d_out; a.ws = (unsigned char*)d_ws;
#if MK_SPLIT
    for (int ph = 0; ph < NPH; ++ph) { a.ph_lo = ph; a.ph_hi = ph + 1; hipLaunchKernelGGL(fwd, dim3(grid), dim3(512), LDS_BYTES, stream, a); }
#else
    a.ph_lo = 0; a.ph_hi = NPH; hipLaunchKernelGGL(fwd, dim3(grid), dim3(512), LDS_BYTES, stream, a);
#endif
}
```

```cpp
#include <hip/hip_runtime.h>
#include <cstdint>
#include <cstdio>

#ifndef MK_SPLIT
#define MK_SPLIT 0
#endif

#define LAS __attribute__((address_space(3)))
typedef unsigned short bf16_t;
typedef short bf16x8 __attribute__((ext_vector_type(8)));
typedef short bf16x4 __attribute__((ext_vector_type(4)));
typedef float f32x4 __attribute__((ext_vector_type(4)));
typedef float f32x2 __attribute__((ext_vector_type(2)));
typedef unsigned u32x4 __attribute__((ext_vector_type(4)));
typedef unsigned u32x2 __attribute__((ext_vector_type(2)));
typedef float f32x16 __attribute__((ext_vector_type(16)));

constexpr int DM = 2048, NB = 4, SEQ = 2048, CTX = 256, NLAT = NB * SEQ, NCTX = NB * CTX, MT = NLAT + NCTX;
constexpr int INC = 3776, INP = 3840;
constexpr int C_SGU_U = 0, C_SGU_V = 512, C_CQ = 1024, C_CKV = 1408, C_KR = 1664, C_S5 = 1728, C_CVB = 2240, C_CVC = 2752, C_CVH = 3264;
constexpr int NKEY = CTX + SEQ;
constexpr int NE = 16, FF = 1024, CAPL = 256, CAPC = 32, EROWS = 1280;
constexpr int NCHUNK = MT / 16;
constexpr float EPS = 1e-6f;
constexpr float QSCALE = 0.07216878364870322f * 1.4426950408889634f;

constexpr size_t al256(size_t x) { return (x + 255) & ~(size_t)255; }
constexpr size_t WS_CTL = 0;
constexpr size_t CTL_BYTES = 65536;
constexpr size_t WS_MOD = WS_CTL + CTL_BYTES;
constexpr size_t WS_WTIN = al256(WS_MOD + (size_t)2 * 5 * 12288 * 4);
constexpr size_t WS_WTOUT = al256(WS_WTIN + (size_t)2 * INP * DM * 2);
constexpr size_t WS_WTUQ = al256(WS_WTOUT + (size_t)2 * DM * DM * 2);
constexpr size_t WS_WTUKV = al256(WS_WTUQ + (size_t)2 * 768 * 384 * 2);
constexpr size_t WS_WTGLU = al256(WS_WTUKV + (size_t)2 * 1024 * 256 * 2);
constexpr size_t WS_WTGU = al256(WS_WTGLU + (size_t)2 * 512 * 512 * 2);
constexpr size_t WS_WTDN = al256(WS_WTGU + (size_t)2 * NE * 2048 * DM * 2);
constexpr size_t WS_PW = al256(WS_WTDN + (size_t)2 * NE * DM * FF * 2);
constexpr size_t WS_BB = al256(WS_PW + (size_t)2 * 2 * 32 * 64 * 17 * 8);
constexpr size_t WS_KZ = al256(WS_BB + (size_t)2 * 2 * 32 * 64 * 16 * 8);
constexpr size_t WS_WST = al256(WS_KZ + (size_t)2 * 2 * 32 * 4096 * 4);
constexpr size_t WS_G2B = al256(WS_WST + (size_t)2 * 32 * 256 * 256 * 2);
constexpr size_t WS_H = al256(WS_G2B + (size_t)2 * 32 * 256 * 512 * 2);
constexpr size_t WS_PA = al256(WS_H + (size_t)MT * DM * 2);
constexpr size_t PA_BYTES = (size_t)NE * EROWS * DM * 2;
static_assert(PA_BYTES >= (size_t)MT * INP * 2, "P fits in the union");
constexpr size_t WS_XA = al256(WS_PA + PA_BYTES);
constexpr size_t WS_XB = al256(WS_XA + (size_t)MT * DM * 4);
constexpr size_t WS_CAT = al256(WS_XB + (size_t)MT * DM * 4);
constexpr size_t WS_QA = al256(WS_CAT + (size_t)MT * DM * 2);
constexpr size_t WS_KVA = al256(WS_QA + (size_t)MT * 384 * 2);
constexpr size_t WS_QB = al256(WS_KVA + (size_t)MT * 256 * 2);
constexpr size_t WS_KC = al256(WS_QB + (size_t)MT * 768 * 2);
constexpr size_t WS_VT = al256(WS_KC + (size_t)NB * 4 * NKEY * 192 * 2);
constexpr size_t WS_UPK = al256(WS_VT + (size_t)NB * 4 * 128 * NKEY * 2);
constexpr size_t WS_EST = al256(WS_UPK + (size_t)32 * 768 * 512 * 2);
constexpr size_t WS_GB = al256(WS_EST + (size_t)32 * 768 * 256 * 4);
constexpr size_t WS_AFF = al256(WS_GB + (size_t)MT * 512 * 2);
constexpr size_t WS_ROWTOK = al256(WS_AFF + (size_t)MT * 16 * 4);
constexpr size_t WS_ROWAFF = al256(WS_ROWTOK + (size_t)NE * EROWS * 4);
constexpr size_t WS_INV = al256(WS_ROWAFF + (size_t)NE * EROWS * 4);
constexpr size_t WS_HID = al256(WS_INV + (size_t)MT * 16 * 4);
constexpr size_t WS_YS = al256(WS_HID + (size_t)NE * EROWS * FF * 2);
constexpr size_t WS_ROPE = al256(WS_YS + (size_t)NE * EROWS * DM * 2);
constexpr size_t WS_A16 = al256(WS_ROPE + 64 * 16 * 8);
constexpr size_t WS_END = al256(WS_A16 + (size_t)2 * 2 * 32 * 64 * 8);

constexpr int LDS_GEMM = 131072;
constexpr int LDS_ATTN = 3 * 44032;
constexpr int LDS_MISC = 133120;
constexpr int LDS_BYTES = LDS_MISC + 256;
static_assert(LDS_ATTN <= LDS_MISC && LDS_GEMM <= LDS_MISC, "LDS map");

typedef __bf16 bf16x2_t __attribute__((ext_vector_type(2)));
__device__ __forceinline__ unsigned cvt_pk_bf16(float lo, float hi) { const f32x2 v = {lo, hi}; const bf16x2_t b = __builtin_convertvector(v, bf16x2_t); return __builtin_bit_cast(unsigned, b); }
__device__ __forceinline__ float bf2f(unsigned short b) { return __uint_as_float(((unsigned)b) << 16); }
__device__ __forceinline__ float bflo(unsigned w) { return __uint_as_float(w << 16); }
__device__ __forceinline__ float bfhi(unsigned w) { return __uint_as_float(w & 0xffff0000u); }
__device__ __forceinline__ unsigned short f2bf(float f) { return (unsigned short)(cvt_pk_bf16(f, 0.f) & 0xffffu); }
__device__ __forceinline__ int opaque_tid() { int t = threadIdx.x; asm volatile("" : "+v"(t)); return t; }
__device__ __forceinline__ unsigned char* opaque_ptr(unsigned char* q) { long z = 0; asm volatile("" : "+s"(z)); return q + z; }
__device__ __forceinline__ float wave_sum(float v) {
#pragma unroll
    for (int o = 32; o >= 1; o >>= 1) v += __shfl_xor(v, o);
    return v;
}
__device__ __forceinline__ float gelu_tanh(float x) {
    const float y = x * (-2.3022081986679503f - 0.10294324069457f * x * x);
    return x * __builtin_amdgcn_rcpf(1.0f + __builtin_amdgcn_exp2f(y));
}
__device__ __forceinline__ float silu_f(float x) { return x * __builtin_amdgcn_rcpf(1.0f + __builtin_amdgcn_exp2f(-1.4426950408889634f * x)); }
__device__ __forceinline__ float sigmoid_f(float x) { return __builtin_amdgcn_rcpf(1.0f + __builtin_amdgcn_exp2f(-1.4426950408889634f * x)); }

#define XB_TMO      128
#define XB_XCNT(j)  (256  + 64 * (j))
#define XB_XSUB(j)  (1280 + 64 * (j))
#define XB_XGEN(j)  (2304 + 64 * (j))
#define XB_TOP      3328
#define XB_TOPGEN   3392
#define XCD_BAR_WORDS 3456
#define XB_SPIN_CAP (1u << 22)
__device__ __forceinline__ unsigned xb_ld(unsigned* p)              { return __hip_atomic_load(p, __ATOMIC_RELAXED, __HIP_MEMORY_SCOPE_AGENT); }
__device__ __forceinline__ unsigned xb_add(unsigned* p, unsigned v) { return __hip_atomic_fetch_add(p, v, __ATOMIC_RELAXED, __HIP_MEMORY_SCOPE_AGENT); }
__device__ __forceinline__ unsigned xb_xcc_id() { return (unsigned)__builtin_amdgcn_s_getreg((3 << 11) | 20) & 0xFu; }
#define XB_SPIN(cond, bar) do { unsigned _sp = 0; while (cond) { __builtin_amdgcn_s_sleep(1); \
    if ((++_sp & 255u) == 0u) { if (xb_ld(&(bar)[XB_TMO])) break; if (_sp > XB_SPIN_CAP) { atomicAdd(&(bar)[XB_TMO], 1u); break; } } } } while (0)
struct XcdBarrier { unsigned* bar; unsigned x; volatile LAS unsigned* st; };
__device__ __forceinline__ XcdBarrier xcd_barrier_post(unsigned* bar, volatile LAS unsigned* st) {
    XcdBarrier b; b.bar = bar; b.x = xb_xcc_id(); b.st = st;
    if (threadIdx.x == 0) (void)xb_add(&bar[XB_XCNT(b.x)], 1u);
    return b;
}
__device__ __forceinline__ void xcd_barrier_complete(unsigned* bar, unsigned x, unsigned& nloc, unsigned& nx) {
    const unsigned G = gridDim.x * gridDim.y * gridDim.z;
    unsigned sum, cnt, mine, sp = 0u;
    for (;;) {
        sum = 0u; cnt = 0u; mine = 0u;
#pragma unroll
        for (unsigned j = 0; j < 16; ++j) { const unsigned c = xb_ld(&bar[XB_XCNT(j)]); sum += c; cnt += (c > 0u) ? 1u : 0u; mine = (j == x) ? c : mine; }
        if (sum == G) break;
        __builtin_amdgcn_s_sleep(1);
        if ((++sp & 255u) == 0u) { if (xb_ld(&bar[XB_TMO])) break; if (sp > XB_SPIN_CAP) { atomicAdd(&bar[XB_TMO], 1u); break; } }
    }
    nloc = mine > 0u ? mine : 1u; nx = cnt > 0u ? cnt : 1u;
}
__device__ __forceinline__ void xcd_barrier(const XcdBarrier& b) {
    asm volatile("s_waitcnt vmcnt(0)" ::: "memory");
    __syncthreads();
    if (threadIdx.x == 0) {
        unsigned* bar = b.bar;
        __builtin_amdgcn_s_waitcnt(0);
        unsigned nloc = b.st[0], nx = b.st[1];
        if (nloc == 0u) { xcd_barrier_complete(bar, b.x, nloc, nx); b.st[0] = nloc; b.st[1] = nx; }
        const unsigned old = xb_add(&bar[XB_XSUB(b.x)], 1u);
        const unsigned gen = old / nloc;
        if (old + 1u == (gen + 1u) * nloc) {
            __builtin_amdgcn_fence(__ATOMIC_RELEASE, "agent");
            asm volatile("s_waitcnt vmcnt(0)" ::: "memory");
            const unsigned og = xb_add(&bar[XB_TOP], 1u);
            const unsigned tg = og / nx;
            if (og + 1u == (tg + 1u) * nx) xb_add(&bar[XB_TOPGEN], 1u);
            else XB_SPIN(xb_ld(&bar[XB_TOPGEN]) == tg, bar);
            __builtin_amdgcn_fence(__ATOMIC_ACQUIRE, "agent");
            xb_add(&bar[XB_XGEN(b.x)], 1u);
            asm volatile("s_waitcnt vmcnt(0)" ::: "memory");
        } else {
            XB_SPIN(xb_ld(&bar[XB_XGEN(b.x)]) == gen, bar);
            __builtin_amdgcn_fence(__ATOMIC_ACQUIRE, "agent");
            asm volatile("s_waitcnt vmcnt(0)" ::: "memory");
        }
    }
    __syncthreads();
}

namespace pg8 {
constexpr int BM = 256, BK = 64, HALF = 128, HTB = HALF * BK * 2, STAGE_BYTES = 8 * HTB;
__host__ __device__ __forceinline__ int lds_byte(int r, int c) { const int st = (r >> 4) * 2 + (c >> 5), rr = r & 15, cc = c & 31, ob = rr * 64 + cc * 2; return st * 1024 + (ob ^ (((ob >> 9) & 1) << 5)); }
__host__ __device__ __forceinline__ void stage_rc(int b, int& R, int& C) { const int st = b / 1024, sb = b % 1024, swz = sb ^ (((sb >> 9) & 1) << 5); R = (st >> 1) * 16 + swz / 64; C = (st & 1) * 32 + (swz % 64) / 2; }
__host__ __device__ __forceinline__ int perm32(int rho) { const int n = rho >> 4, i = rho & 15; return 8 * (i >> 2) + 4 * n + (i & 3); }

struct Unit { const char* a; const char* b; int pm, pn, pb; };
struct Desc { int lda, ldb, K; };

struct TileSched {
    const char* A; const char* B; size_t sA, sB;
    int lda, ldb, nM, nN, nB, G, c;
    __device__ __forceinline__ void init(const void* A_, const void* B_, int lda_, int ldb_, int nM_, int nN_, int nB_, size_t sA_, size_t sB_, int G_, int c_, int off) {
        A = (const char*)A_; B = (const char*)B_; lda = lda_; ldb = ldb_; nM = nM_; nN = nN_; nB = nB_; sA = sA_; sB = sB_; G = G_; c = (c_ + G_ - (off % G_)) % G_; }
    __device__ __forceinline__ bool next(int i, Unit& u) const {
        const int nwg = nM * nN; const long L = (long)i * G + c; if (L >= (long)nwg * nB) return false;
        const int pb = (int)(L / nwg); int wgid = (int)(L % nwg);
        { const int q = nwg / 8, r = nwg % 8, xcd = wgid % 8, off = wgid / 8; wgid = (xcd < r ? xcd * (q + 1) : r * (q + 1) + (xcd - r) * q) + off; }
        const int nig = 8 * nN, gid = wgid / nig, fm = gid * 8, gsz = (nM - fm) < 8 ? (nM - fm) : 8;
        u.pm = fm + ((wgid % nig) % gsz); u.pn = (wgid % nig) / gsz; u.pb = pb;
        u.a = A + (size_t)pb * sA + (size_t)u.pm * 256 * lda * 2; u.b = B + (size_t)pb * sB + (size_t)u.pn * 256 * ldb * 2; return true;
    }
};
struct InSchedLast {
    TileSched T;
    __device__ __forceinline__ void init(const void* A_, const void* B_, int G_, int c_) { T.init(A_, B_, DM, DM, NLAT / 256, INP / 256, 1, 0, 0, G_, c_, 0); }
    __device__ __forceinline__ bool next(int i, Unit& u) const {
        const int nlat = (NLAT / 256) * (INP / 256); const long L = (long)i * T.G + T.c;
        if (L < nlat) return T.next(i, u);
        if (L >= nlat + 16) return false;
        const int k = (int)(L - nlat); u.pm = NLAT / 256 + (k >> 2); u.pn = 5 + (k & 3); u.pb = 0;
        u.a = T.A + (size_t)u.pm * 256 * DM * 2; u.b = T.B + (size_t)u.pn * 256 * DM * 2; return true;
    }
};
struct MoeSched {
    const char* A; const char* B; size_t sA, sB; int lda, ldb, nM, nN, G, c;
    __device__ __forceinline__ void init(const void* A_, const void* B_, int lda_, int ldb_, int nM_, int nN_, size_t sA_, size_t sB_, int G_, int c_) {
        A = (const char*)A_; B = (const char*)B_; lda = lda_; ldb = ldb_; nM = nM_; nN = nN_; sA = sA_; sB = sB_; G = G_; c = c_; }
    __device__ __forceinline__ bool next(int i, Unit& u) const {
        int e, rem; const int per = nM * nN;
        if ((G & 7) == 0) { const int x = c & 7, j = c >> 3, w = G >> 3; const int L = i * w + j; if (L >= 2 * per) return false; e = 2 * x + L / per; rem = L % per; }
        else { const long L = (long)i * G + c; if (L >= (long)NE * per) return false; e = (int)(L / per); rem = (int)(L % per); }
        u.pn = rem / nM; u.pm = rem % nM; u.pb = e;
        u.a = sA == 0 ? A : A + (size_t)e * sA + (size_t)u.pm * 256 * lda * 2; u.b = B + (size_t)e * sB + (size_t)u.pn * 256 * ldb * 2; return true;
    }
};

template <class Epi, class Sched, bool GATHER = false>
__device__ __forceinline__ void gemm_phase(LAS unsigned char* lds, const Desc g, const Sched& S, const Epi& E, const int* rowtok = nullptr, int nvalid = 0) {
    const int tid = opaque_tid(), wid = __builtin_amdgcn_readfirstlane(tid >> 6), lane = tid & 63, wr = wid >> 2, wc = wid & 3, fr = lane & 15, fq = lane >> 4;
    const int K = g.K, nt = K / BK;
    unsigned voffA[2], voffB[2]; int gR[2], gCc[2];
#pragma unroll
    for (int i = 0; i < 2; ++i) { int R, C; stage_rc(tid * 16 + i * 8192, R, C); const int Rb = Epi::PERM ? ((R & ~31) + perm32(R & 31)) : R;
        voffA[i] = (unsigned)(R * g.lda + C) * 2u; voffB[i] = (unsigned)(Rb * g.ldb + C) * 2u; gR[i] = R; gCc[i] = C; }
    unsigned gC[2][2], gN[2][2];
#define PG8_GOFF(u, o) do { _Pragma("unroll") for (int _h = 0; _h < 2; ++_h) _Pragma("unroll") for (int _i = 0; _i < 2; ++_i) { const int _r = (u).pm * 256 + _h * 128 + gR[_i]; \
        const int _tok = _r < nvalid ? rowtok[(u).pb * EROWS + _r] : 0; (o)[_h][_i] = (unsigned)(_tok * g.lda + gCc[_i]) * 2u; } } while (0)
    const size_t kstep = (size_t)(BK * 2);
    const size_t hstepA = (size_t)HALF * g.lda * 2, hstepB = (size_t)HALF * g.ldb * 2;
    const unsigned ldsw = (unsigned)wid * 1024u;
    const int aoff = lds_byte(wr * 64 + fr, fq * 8), boff = lds_byte(wc * 32 + fr, fq * 8);
#define PG8_SA(b, h) (((b) * 2 + (h)) * HTB)
#define PG8_SB(b, h) ((4 + (b) * 2 + (h)) * HTB)
#define PG8_STAGE(bufoff, gbase, voff) do { _Pragma("unroll") for (int _i = 0; _i < 2; ++_i) \
        __builtin_amdgcn_global_load_lds((const unsigned*)((const char*)(gbase) + (voff)[_i]), (LAS unsigned*)(lds + (bufoff) + ldsw + _i * 8192), 16, 0, 0); } while (0)
#define PG8_STAGE_A(bufoff, kptr, half, VO) do { if constexpr (GATHER) { _Pragma("unroll") for (int _i = 0; _i < 2; ++_i) \
        __builtin_amdgcn_global_load_lds((const unsigned*)((const char*)(kptr) + (VO)[half][_i]), (LAS unsigned*)(lds + (bufoff) + ldsw + _i * 8192), 16, 0, 0); } \
        else { PG8_STAGE(bufoff, (kptr) + (half) * hstepA, voffA); } } while (0)
#define PG8_LDA(dst, b, h) do { _Pragma("unroll") for (int m = 0; m < 4; ++m) _Pragma("unroll") for (int k = 0; k < 2; ++k) dst[m][k] = *(const LAS bf16x8*)(lds + PG8_SA(b, h) + aoff + m * 2048 + k * 1024); } while (0)
#define PG8_LDB(dst, b, h) do { _Pragma("unroll") for (int n = 0; n < 2; ++n) _Pragma("unroll") for (int k = 0; k < 2; ++k) dst[n][k] = *(const LAS bf16x8*)(lds + PG8_SB(b, h) + boff + n * 2048 + k * 1024); } while (0)
#define PG8_MMA(ai, bj, At, Bt) do { __builtin_amdgcn_s_setprio(1); _Pragma("unroll") for (int m = 0; m < 4; ++m) _Pragma("unroll") for (int n = 0; n < 2; ++n) _Pragma("unroll") for (int k = 0; k < 2; ++k) \
        acc[ai][bj][m][n] = __builtin_amdgcn_mfma_f32_16x16x32_bf16(Bt[n][k], At[m][k], acc[ai][bj][m][n], 0, 0, 0); __builtin_amdgcn_s_setprio(0); } while (0)
#define PG8_WAIT_V(n) asm volatile("s_waitcnt vmcnt(" #n ")" ::: "memory")
#define PG8_WAIT_L(n) asm volatile("s_waitcnt lgkmcnt(" #n ")" ::: "memory")
#define PG8_BAR __builtin_amdgcn_s_barrier()
#define PG8_SCHED __builtin_amdgcn_sched_barrier(0)
    Unit cur, nxt; int ui = 0;
    if (!S.next(0, cur)) return;
    f32x4 acc[2][2][4][2];
#pragma unroll
    for (int a = 0; a < 2; ++a)
#pragma unroll
        for (int b = 0; b < 2; ++b)
#pragma unroll
            for (int m = 0; m < 4; ++m)
#pragma unroll
                for (int n = 0; n < 2; ++n) acc[a][b][m][n] = (f32x4){0.f, 0.f, 0.f, 0.f};
    bf16x8 At[4][2], B0[2][2], B1[2][2];
    const char* cA = cur.a; const char* cB = cur.b;
    if constexpr (GATHER) { PG8_GOFF(cur, gC); }
    PG8_STAGE(PG8_SB(0, 0), cB, voffB); PG8_STAGE_A(PG8_SA(0, 0), cA, 0, gC); PG8_STAGE(PG8_SB(0, 1), cB + hstepB, voffB); PG8_STAGE_A(PG8_SA(0, 1), cA, 1, gC);
    if (wr == 1) PG8_BAR;
    PG8_WAIT_V(4); PG8_BAR;
    PG8_STAGE(PG8_SB(1, 0), cB + kstep, voffB); PG8_STAGE_A(PG8_SA(1, 0), cA + kstep, 0, gC); PG8_STAGE(PG8_SB(1, 1), cB + hstepB + kstep, voffB);
    PG8_WAIT_V(6); PG8_BAR;
    for (;;) {
        const bool has_next = S.next(ui + 1, nxt);
        const char* nA = has_next ? nxt.a : cA; const char* nB = has_next ? nxt.b : cB;
        if constexpr (GATHER) { if (has_next) { PG8_GOFF(nxt, gN); } else {
#pragma unroll
            for (int _h = 0; _h < 2; ++_h)
#pragma unroll
                for (int _i = 0; _i < 2; ++_i) gN[_h][_i] = gC[_h][_i]; } }
#pragma nounroll
        for (int t = 0; t < nt; t += 2) {
            const bool last = (t == nt - 2);
            const char* a1 = cA + (size_t)(t + 1) * kstep;
            const char* a2 = last ? nA : cA + (size_t)(t + 2) * kstep; const char* b2 = last ? nB : cB + (size_t)(t + 2) * kstep;
            const char* a3 = a2 + kstep; const char* b3 = b2 + kstep;
            unsigned g2[2][2];
            if constexpr (GATHER) {
#pragma unroll
                for (int _h = 0; _h < 2; ++_h)
#pragma unroll
                    for (int _i = 0; _i < 2; ++_i) g2[_h][_i] = last ? gN[_h][_i] : gC[_h][_i]; }
            PG8_LDB(B0, 0, 0); PG8_SCHED; PG8_LDA(At, 0, 0); PG8_STAGE_A(PG8_SA(1, 1), a1, 1, gC);
            PG8_WAIT_L(8); PG8_BAR; PG8_WAIT_L(0); PG8_MMA(0, 0, At, B0); PG8_BAR; PG8_SCHED;
            PG8_LDB(B1, 0, 1); PG8_STAGE(PG8_SB(0, 0), b2, voffB);
            PG8_BAR; PG8_WAIT_L(0); PG8_MMA(0, 1, At, B1); PG8_BAR;
            PG8_LDA(At, 0, 1); PG8_STAGE_A(PG8_SA(0, 0), a2, 0, g2);
            PG8_BAR; PG8_WAIT_L(0); PG8_MMA(1, 0, At, B0); PG8_BAR; PG8_SCHED;
            PG8_STAGE(PG8_SB(0, 1), b2 + hstepB, voffB);
            PG8_WAIT_V(6); PG8_BAR; PG8_MMA(1, 1, At, B1); PG8_BAR;
            PG8_LDB(B0, 1, 0); PG8_SCHED; PG8_LDA(At, 1, 0); PG8_STAGE_A(PG8_SA(0, 1), a2, 1, g2);
            PG8_WAIT_L(8); PG8_BAR; PG8_WAIT_L(0); PG8_MMA(0, 0, At, B0); PG8_BAR; PG8_SCHED;
            PG8_LDB(B1, 1, 1); PG8_STAGE(PG8_SB(1, 0), b3, voffB);
            PG8_BAR; PG8_WAIT_L(0); PG8_MMA(0, 1, At, B1); PG8_BAR;
            PG8_LDA(At, 1, 1); PG8_STAGE_A(PG8_SA(1, 0), a3, 0, g2);
            PG8_BAR; PG8_WAIT_L(0); PG8_MMA(1, 0, At, B0); PG8_BAR; PG8_SCHED;
            PG8_STAGE(PG8_SB(1, 1), b3 + hstepB, voffB);
            PG8_WAIT_V(6); PG8_BAR; PG8_MMA(1, 1, At, B1); PG8_BAR;
        }
        E(acc, cur, wr, wc, fr, fq);
        if (!has_next) break;
#pragma unroll
        for (int a = 0; a < 2; ++a)
#pragma unroll
            for (int b = 0; b < 2; ++b)
#pragma unroll
                for (int m = 0; m < 4; ++m)
#pragma unroll
                    for (int n = 0; n < 2; ++n) acc[a][b][m][n] = (f32x4){0.f, 0.f, 0.f, 0.f};
        cur = nxt; cA = nA; cB = nB; ++ui;
        if constexpr (GATHER) {
#pragma unroll
            for (int _h = 0; _h < 2; ++_h)
#pragma unroll
                for (int _i = 0; _i < 2; ++_i) gC[_h][_i] = gN[_h][_i]; }
    }
    PG8_WAIT_V(0);
    if (wr == 0) PG8_BAR;
    PG8_BAR;
#undef PG8_SA
#undef PG8_SB
#undef PG8_STAGE
#undef PG8_STAGE_A
#undef PG8_GOFF
#undef PG8_LDA
#undef PG8_LDB
#undef PG8_MMA
#undef PG8_WAIT_V
#undef PG8_WAIT_L
#undef PG8_BAR
#undef PG8_SCHED
}

#define PG8_FOR_PERM(...) \
    _Pragma("unroll") for (int ai = 0; ai < 2; ++ai) _Pragma("unroll") for (int m = 0; m < 4; ++m) { const int tr = ai * 128 + wr * 64 + m * 16 + fr; \
        _Pragma("unroll") for (int bj = 0; bj < 2; ++bj) { const int tc = bj * 128 + wc * 32 + 8 * fq; const f32x4 v0 = acc[ai][bj][m][0], v1 = acc[ai][bj][m][1]; __VA_ARGS__ } }
#define PG8_FOR_NOPERM(...) \
    _Pragma("unroll") for (int ai = 0; ai < 2; ++ai) _Pragma("unroll") for (int m = 0; m < 4; ++m) { const int tr = ai * 128 + wr * 64 + m * 16 + fr; \
        _Pragma("unroll") for (int bj = 0; bj < 2; ++bj) _Pragma("unroll") for (int n = 0; n < 2; ++n) { const int tc = bj * 128 + wc * 32 + 16 * n + 4 * fq; const f32x4 v = acc[ai][bj][m][n]; __VA_ARGS__ } }

typedef const f32x4 (&AccRef)[2][2][4][2];

struct EpiStoreBf16 {
    static constexpr bool PERM = true;
    bf16_t* O; int ldc;
    __device__ __forceinline__ void operator()(AccRef acc, const Unit& u, int wr, int wc, int fr, int fq) const {
        PG8_FOR_PERM({ u32x4 w; w.x = cvt_pk_bf16(v0[0], v0[1]); w.y = cvt_pk_bf16(v0[2], v0[3]); w.z = cvt_pk_bf16(v1[0], v1[1]); w.w = cvt_pk_bf16(v1[2], v1[3]);
            *(u32x4*)(O + (size_t)(u.pm * 256 + tr) * ldc + u.pn * 256 + tc) = w; })
    }
};
struct EpiQ {
    static constexpr bool PERM = false;
    bf16_t* Q; const f32x2* ROPE;
    __device__ __forceinline__ void operator()(AccRef acc, const Unit& u, int wr, int wc, int fr, int fq) const {
#pragma unroll
        for (int ai = 0; ai < 2; ++ai)
#pragma unroll
            for (int m = 0; m < 4; ++m) { const int row = u.pm * 256 + ai * 128 + wr * 64 + m * 16 + fr; const bool lat = row < NLAT; const int t = row & (SEQ - 1);
#pragma unroll
                for (int bj = 0; bj < 2; ++bj) { const int cg = u.pn * 256 + bj * 128 + wc * 32; const int dd = cg % 192; f32x4 a = acc[ai][bj][m][0], b = acc[ai][bj][m][1];
                    if (dd >= 128 && lat) { const int pos = (dd - 128) >= 32 ? (t & 63) : (t >> 6); const f32x4* rp = (const f32x4*)(ROPE + pos * 16 + 4 * fq); const f32x4 r0 = rp[0], r1 = rp[1];
                        const float cs[4] = {r0[0], r0[2], r1[0], r1[2]}, sn[4] = {r0[1], r0[3], r1[1], r1[3]};
#pragma unroll
                        for (int i = 0; i < 4; ++i) { const float x1 = a[i], x2 = b[i]; a[i] = x1 * cs[i] - x2 * sn[i]; b[i] = x2 * cs[i] + x1 * sn[i]; } }
                    a *= QSCALE; b *= QSCALE;
                    bf16_t* o = Q + (size_t)row * 768 + cg + 4 * fq;
                    u32x2 w0; w0.x = cvt_pk_bf16(a[0], a[1]); w0.y = cvt_pk_bf16(a[2], a[3]); *(u32x2*)o = w0;
                    u32x2 w1; w1.x = cvt_pk_bf16(b[0], b[1]); w1.y = cvt_pk_bf16(b[2], b[3]); *(u32x2*)(o + 16) = w1; } }
    }
};
struct EpiK {
    static constexpr bool PERM = true;
    bf16_t* KC;
    __device__ __forceinline__ void operator()(AccRef acc, const Unit& u, int wr, int wc, int fr, int fq) const {
        const int b = u.pm < 32 ? (u.pm >> 3) : (u.pm - 32), key0 = u.pm < 32 ? CTX + (u.pm & 7) * 256 : 0;
        bf16_t* base = KC + ((size_t)(b * 4 + u.pn * 2) * NKEY + key0) * 192 + (size_t)(wr * 64 + fr) * 192 + wc * 32 + 8 * fq;
#pragma unroll
        for (int ai = 0; ai < 2; ++ai)
#pragma unroll
            for (int m = 0; m < 4; ++m)
#pragma unroll
                for (int bj = 0; bj < 2; ++bj) { const f32x4 v0 = acc[ai][bj][m][0], v1 = acc[ai][bj][m][1];
                    u32x4 w; w.x = cvt_pk_bf16(v0[0], v0[1]); w.y = cvt_pk_bf16(v0[2], v0[3]); w.z = cvt_pk_bf16(v1[0], v1[1]); w.w = cvt_pk_bf16(v1[2], v1[3]);
                    *(u32x4*)(base + (size_t)(ai * 128 + m * 16) * 192 + (size_t)bj * NKEY * 192) = w; }
    }
};
struct EpiV {
    static constexpr bool PERM = true;
    bf16_t* VT;
    __device__ __forceinline__ void operator()(AccRef acc, const Unit& u, int wr, int wc, int fr, int fq) const {
        const int b = u.pn < 32 ? (u.pn >> 3) : (u.pn - 32), key0 = u.pn < 32 ? CTX + (u.pn & 7) * 256 : 0;
        bf16_t* base = VT + ((size_t)(b * 4 + u.pm * 2) * 128 + wr * 64 + fr) * NKEY + key0 + wc * 32 + 8 * fq;
#pragma unroll
        for (int ai = 0; ai < 2; ++ai)
#pragma unroll
            for (int m = 0; m < 4; ++m)
#pragma unroll
                for (int bj = 0; bj < 2; ++bj) { const f32x4 v0 = acc[ai][bj][m][0], v1 = acc[ai][bj][m][1];
                    u32x2 w0, w1; w0.x = cvt_pk_bf16(v0[0], v0[1]); w0.y = cvt_pk_bf16(v0[2], v0[3]); w1.x = cvt_pk_bf16(v1[0], v1[1]); w1.y = cvt_pk_bf16(v1[2], v1[3]);
                    bf16_t* q = base + (size_t)(ai * 128 + m * 16) * NKEY + bj * 128; const int odd = fq & 1;
                    *(u32x2*)(q + (odd ? -4 : 0)) = w0; *(u32x2*)(q + (odd ? 4 : 8)) = w1; }
    }
};
struct EpiS1 {
    static constexpr bool PERM = false;
    float* EST;
    __device__ __forceinline__ void operator()(AccRef acc, const Unit& u, int wr, int wc, int fr, int fq) const {
        PG8_FOR_NOPERM({ const int row = u.pm * 256 + tr; if (row < NCHUNK) *(f32x4*)(EST + ((size_t)u.pb * 768 + row) * 256 + tc) = v; })
    }
};
struct EpiS2 {
    static constexpr bool PERM = true;
    bf16_t* GB;
    __device__ __forceinline__ void operator()(AccRef acc, const Unit& u, int wr, int wc, int fr, int fq) const {
        PG8_FOR_PERM({ const int row = u.pm * 256 + tr; if (row < NCHUNK) { const int p = tc >> 4, c = tc & 15;
            u32x4 w; w.x = cvt_pk_bf16(gelu_tanh(v0[0]), gelu_tanh(v0[1])); w.y = cvt_pk_bf16(gelu_tanh(v0[2]), gelu_tanh(v0[3]));
            w.z = cvt_pk_bf16(gelu_tanh(v1[0]), gelu_tanh(v1[1])); w.w = cvt_pk_bf16(gelu_tanh(v1[2]), gelu_tanh(v1[3]));
            *(u32x4*)(GB + (size_t)(row * 16 + p) * 512 + u.pb * 16 + c) = w; } })
    }
};
struct EpiGlu {
    static constexpr bool PERM = true;
    const bf16_t* GB; const float* bias; bf16_t* CAT;
    __device__ __forceinline__ void operator()(AccRef acc, const Unit& u, int wr, int wc, int fr, int fq) const {
        PG8_FOR_PERM({ const int row = u.pm * 256 + tr, col = u.pn * 256 + tc;
            const u32x4 gv = *(const u32x4*)(GB + (size_t)row * 512 + col); const f32x4 b0 = *(const f32x4*)(bias + col), b1 = *(const f32x4*)(bias + col + 4);
            u32x4 w;
            w.x = cvt_pk_bf16(bflo(gv.x) * sigmoid_f(v0[0] + b0[0]), bfhi(gv.x) * sigmoid_f(v0[1] + b0[1]));
            w.y = cvt_pk_bf16(bflo(gv.y) * sigmoid_f(v0[2] + b0[2]), bfhi(gv.y) * sigmoid_f(v0[3] + b0[3]));
            w.z = cvt_pk_bf16(bflo(gv.z) * sigmoid_f(v1[0] + b1[0]), bfhi(gv.z) * sigmoid_f(v1[1] + b1[1]));
            w.w = cvt_pk_bf16(bflo(gv.w) * sigmoid_f(v1[2] + b1[2]), bfhi(gv.w) * sigmoid_f(v1[3] + b1[3]));
            *(u32x4*)(CAT + (size_t)row * DM + 1024 + col) = w; })
    }
};
struct EpiOut {
    static constexpr bool PERM = true;
    const float* xl; const float* xc; const bf16_t* xs; const float* gate; bf16_t* xo;
    __device__ __forceinline__ void operator()(AccRef acc, const Unit& u, int wr, int wc, int fr, int fq) const {
        PG8_FOR_PERM({ const int row = u.pm * 256 + tr, col = u.pn * 256 + tc; const int rr = row < NLAT ? (row >> 11) : 4;
            f32x4 x0, x1;
            if (xs) { const u32x4 xv = *(const u32x4*)(xs + (size_t)row * DM + col); x0 = (f32x4){bflo(xv.x), bfhi(xv.x), bflo(xv.y), bfhi(xv.y)}; x1 = (f32x4){bflo(xv.z), bfhi(xv.z), bflo(xv.w), bfhi(xv.w)}; }
            else { const float* src = (row < NLAT ? xl + (size_t)row * DM : xc + (size_t)(row - NLAT) * DM) + col; x0 = *(const f32x4*)src; x1 = *(const f32x4*)(src + 4); }
            const float* gp = gate + (size_t)rr * 12288 + col; const f32x4 g0 = *(const f32x4*)gp, g1 = *(const f32x4*)(gp + 4);
            x0 += g0 * v0; x1 += g1 * v1;
            u32x4 w; w.x = cvt_pk_bf16(x0[0], x0[1]); w.y = cvt_pk_bf16(x0[2], x0[3]); w.z = cvt_pk_bf16(x1[0], x1[1]); w.w = cvt_pk_bf16(x1[2], x1[3]);
            *(u32x4*)(xo + (size_t)row * DM + col) = w; })
    }
};
struct EpiGU {
    static constexpr bool PERM = true;
    bf16_t* HID;
    __device__ __forceinline__ void operator()(AccRef acc, const Unit& u, int wr, int wc, int fr, int fq) const {
        PG8_FOR_PERM({ const int row = u.pm * 256 + tr, j = (u.pn * 256 + tc) >> 1;
            u32x2 w; w.x = cvt_pk_bf16(silu_f(v0[0]) * v0[1], silu_f(v0[2]) * v0[3]); w.y = cvt_pk_bf16(silu_f(v1[0]) * v1[1], silu_f(v1[2]) * v1[3]);
            *(u32x2*)(HID + ((size_t)u.pb * EROWS + row) * FF + j) = w; })
    }
};
struct EpiDown {
    static constexpr bool PERM = true;
    bf16_t* YS; const float* RA;
    __device__ __forceinline__ void operator()(AccRef acc, const Unit& u, int wr, int wc, int fr, int fq) const {
        PG8_FOR_PERM({ const int row = u.pm * 256 + tr, col = u.pn * 256 + tc; const float a = RA[u.pb * EROWS + row];
            u32x4 w; w.x = cvt_pk_bf16(v0[0] * a, v0[1] * a); w.y = cvt_pk_bf16(v0[2] * a, v0[3] * a); w.z = cvt_pk_bf16(v1[0] * a, v1[1] * a); w.w = cvt_pk_bf16(v1[2] * a, v1[3] * a);
            *(u32x4*)(YS + ((size_t)u.pb * EROWS + row) * DM + col) = w; })
    }
};
}

struct Params { const float* in[33]; float* out; unsigned char* ws; int ph_lo, ph_hi; };
enum { I_X = 0, I_C, I_CTX, I_CCTX, I_N1G, I_N2G, I_WADA, I_BADA, I_WIN, I_WOUT, I_SGUNG, I_SGUW, I_SGUB, I_QNG, I_WUQ, I_KVNG, I_WUKV,
       I_ARE, I_AIM, I_LOGDT, I_BRE, I_BIM, I_CRE, I_CIM, I_S5D, I_WGLU, I_BGLU, I_CONVW, I_WROUTER, I_WGATE, I_WUP, I_WDOWN, I_FNG };

__device__ __forceinline__ void transpose_tile(const float* src, int N, int k0, int n0, bf16_t* dst, int ldd, int rmul, int radd, int remap_kv, LAS float* tile) {
    const int tid = threadIdx.x;
#pragma unroll
    for (int i = 0; i < 2; ++i) { const int r = (tid >> 4) + 32 * i, c4 = (tid & 15) * 4;
        const f32x4 v = *(const f32x4*)(src + (size_t)(k0 + r) * N + n0 + c4);
        tile[r * 65 + c4 + 0] = v[0]; tile[r * 65 + c4 + 1] = v[1]; tile[r * 65 + c4 + 2] = v[2]; tile[r * 65 + c4 + 3] = v[3]; }
    __syncthreads();
    { const int n = tid >> 3, kc = tid & 7; float f[8];
#pragma unroll
        for (int j = 0; j < 8; ++j) f[j] = tile[(kc * 8 + j) * 65 + n];
        int nn = n0 + n; if (remap_kv) nn = ((nn & 255) < 128) ? ((nn >> 8) * 128 + (nn & 127)) : (512 + (nn >> 8) * 128 + (nn & 127));
        const int drow = nn * rmul + radd;
        u32x4 w; w.x = cvt_pk_bf16(f[0], f[1]); w.y = cvt_pk_bf16(f[2], f[3]); w.z = cvt_pk_bf16(f[4], f[5]); w.w = cvt_pk_bf16(f[6], f[7]);
        *(u32x4*)(dst + (size_t)drow * ldd + k0 + kc * 8) = w; }
    __syncthreads();
}
constexpr int N_ADA_UNITS = 192, N_S5T_UNITS = 64, N_ROPE_UNITS = 2;
constexpr int T_WIN = 32 * 59, T_WOUT = 32 * 32, T_WUQ = 6 * 12, T_WUKV = 4 * 16, T_WGLU = 8 * 8, T_EXP = 512;
constexpr int N_TR = 2 * (T_WIN + T_WOUT + T_WUQ + T_WUKV + T_WGLU);
constexpr int N_PRO_ITEMS = N_ADA_UNITS + N_S5T_UNITS + N_ROPE_UNITS + N_TR;


__device__ __forceinline__ void transpose_block(const float* src, int N, int k0, int n0, bf16_t* dst, int ldd, int rmul, int radd, LAS float* tile  ) {
    const int tid = opaque_tid();
    f32x4 v[8];
#pragma unroll
    for (int i = 0; i < 8; ++i) v[i] = __builtin_nontemporal_load((const f32x4*)(src + (size_t)(k0 + (tid >> 6) + 8 * i) * N + n0 + (tid & 63) * 4));
#pragma unroll
    for (int i = 0; i < 8; ++i) { const int r = (tid >> 6) + 8 * i; *(LAS f32x4*)(tile + r * 260 + (((tid & 63) * 4) ^ (8 * (r >> 3)))) = v[i]; }
    __syncthreads();
#pragma unroll
    for (int i = 0; i < 4; ++i) { const int id = tid + 512 * i, n = id >> 3, kc = id & 7; float f[8];
#pragma unroll
        for (int j = 0; j < 8; ++j) f[j] = tile[(kc * 8 + j) * 260 + (n ^ (8 * kc))];
        u32x4 w; w.x = cvt_pk_bf16(f[0], f[1]); w.y = cvt_pk_bf16(f[2], f[3]); w.z = cvt_pk_bf16(f[4], f[5]); w.w = cvt_pk_bf16(f[6], f[7]);
        *(u32x4*)(dst + (size_t)((n0 + n) * rmul + radd) * ldd + k0 + kc * 8) = w; }
    __syncthreads();
}
constexpr int QB_EXP = T_EXP / 4, Q_GU = NE * 2 * QB_EXP, Q_LAYER = Q_GU + NE * QB_EXP, Q_TOTAL = 2 * Q_LAYER;
constexpr int CW_QHEAD = 4096, CW_DONE = 4160;
static_assert((CW_DONE + 64 * 32) * 4 <= (int)CTL_BYTES, "control words inside the memset region");
__device__ __forceinline__ void moe_convert_block(const Params& p, unsigned char* ws, int t, LAS float* tile) {
    const int l = t / Q_LAYER, r = t % Q_LAYER;
    if (r < Q_GU) { const int e = r / (2 * QB_EXP), rr = r % (2 * QB_EXP), up = rr / QB_EXP, q = rr % QB_EXP; const int le = l * NE + e;
        transpose_block((up ? p.in[I_WUP] : p.in[I_WGATE]) + (size_t)le * DM * FF, FF, (q >> 2) * 64, (q & 3) * 256, (bf16_t*)(ws + WS_WTGU) + (size_t)le * 2048 * DM, DM, 2, up, tile); }
    else { const int r2 = r - Q_GU, e = r2 / QB_EXP, q = r2 % QB_EXP; const int le = l * NE + e;
        transpose_block(p.in[I_WDOWN] + (size_t)le * FF * DM, DM, (q >> 3) * 64, (q & 7) * 256, (bf16_t*)(ws + WS_WTDN) + (size_t)le * DM * FF, FF, 1, 0, tile); }
}
#ifndef FILL_ON
#define FILL_ON 0
#endif
constexpr unsigned Q_BULK = 4;
__device__ __forceinline__ unsigned moe_claim(unsigned* ctl, int ph, int upto, int mode, unsigned target) {
    unsigned t = 0xffffffffu;
    const unsigned head = __hip_atomic_load(ctl + CW_QHEAD, __ATOMIC_RELAXED, __HIP_MEMORY_SCOPE_AGENT);
    const bool go = mode ? (head < (unsigned)upto) : (head < (unsigned)Q_TOTAL && __hip_atomic_load(ctl + CW_DONE + 64 * ph, __ATOMIC_RELAXED, __HIP_MEMORY_SCOPE_AGENT) < target);
    if (go) t = __hip_atomic_fetch_add(ctl + CW_QHEAD, mode ? Q_BULK : 1u, __ATOMIC_RELAXED, __HIP_MEMORY_SCOPE_AGENT);
    return t;
}
__device__ __forceinline__ void moe_pump(const Params& p, LAS unsigned char* lds, int ph, int upto, int mode, unsigned target = 0u, bool count_me = true) {
    unsigned char* ws = opaque_ptr(p.ws); unsigned* ctl = (unsigned*)(ws + WS_CTL);
    LAS float* tile = (LAS float*)lds; volatile LAS unsigned* slot = (volatile LAS unsigned*)(lds + LDS_MISC + 32);
    const int tid = opaque_tid(); const int nblk = mode ? (int)Q_BULK : 1;
    __syncthreads();
    if (tid == 0) { if (mode == 0 && count_me) (void)__hip_atomic_fetch_add(ctl + CW_DONE + 64 * ph, 1u, __ATOMIC_RELAXED, __HIP_MEMORY_SCOPE_AGENT); slot[0] = moe_claim(ctl, ph, upto, mode, target ? target : gridDim.x); }
    __syncthreads();
    for (;;) {
        const unsigned t = slot[0];
        if (t >= (unsigned)Q_TOTAL) break;
        unsigned nxt = 0u;
        if (tid == 0) nxt = moe_claim(ctl, ph, upto, mode, target ? target : gridDim.x);
#pragma unroll 1
        for (int k = 0; k < nblk; ++k) if ((int)t + k < Q_TOTAL) moe_convert_block(p, ws, (int)t + k, tile);
        if (tid == 0) slot[0] = nxt;
        __syncthreads();
    }
}
__device__ __forceinline__ void moe_fill(const Params& p, LAS unsigned char* lds, int ph) { if (FILL_ON) moe_pump(p, lds, ph, Q_TOTAL, 0); }
__device__ __forceinline__ void moe_mark_done(const Params& p, int ph) { if (threadIdx.x == 0) (void)__hip_atomic_fetch_add((unsigned*)(p.ws + WS_CTL) + CW_DONE + 64 * ph, 1u, __ATOMIC_RELAXED, __HIP_MEMORY_SCOPE_AGENT); }
__device__ __forceinline__ void moe_convert_while(const Params& p, LAS unsigned char* lds, int ph, unsigned ngemm) { moe_pump(p, lds, ph, Q_TOTAL, 0, ngemm, false); }
__device__ __forceinline__ void moe_require(const Params& p, LAS unsigned char* lds, int upto) { moe_pump(p, lds, 0, upto, 1); }

__device__ __forceinline__ void ph_prologue(const Params& p, LAS unsigned char* lds) {
    const int tid = opaque_tid(), lane = tid & 63, wave = tid >> 6;
    unsigned char* ws = opaque_ptr(p.ws);
    for (int it = blockIdx.x; it < N_PRO_ITEMS; it += gridDim.x) {
        if (it < N_ADA_UNITS) {
            const int l = it / 96, cb = it % 96;
            LAS float* sil = (LAS float*)lds;
            LAS float* red = (LAS float*)(lds + 40960);
            for (int i = tid; i < 5 * DM; i += 512) { const int r = i >> 11, k = i & (DM - 1); const float v = r < 4 ? p.in[I_C][r * DM + k] : p.in[I_CCTX][k]; sil[i] = silu_f(v); }
            __syncthreads();
            f32x2 acc[5];
#pragma unroll
            for (int r = 0; r < 5; ++r) acc[r] = (f32x2){0.f, 0.f};
            const float* W = p.in[I_WADA] + (size_t)l * DM * 12288 + cb * 128 + lane * 2;
            for (int k = wave * 256; k < wave * 256 + 256; k += 16) {
                f32x2 w[16];
#pragma unroll
                for (int j = 0; j < 16; ++j) w[j] = __builtin_nontemporal_load((const f32x2*)(W + (size_t)(k + j) * 12288));
#pragma unroll
                for (int j = 0; j < 16; ++j)
#pragma unroll
                    for (int r = 0; r < 5; ++r) acc[r] += sil[r * DM + k + j] * w[j];
            }
#pragma unroll
            for (int r = 0; r < 5; ++r) { red[(wave * 5 + r) * 128 + lane * 2] = acc[r].x; red[(wave * 5 + r) * 128 + lane * 2 + 1] = acc[r].y; }
            __syncthreads();
            float* mod = (float*)(ws + WS_MOD);
            for (int o = tid; o < 5 * 128; o += 512) { const int r = o >> 7, cc = o & 127; float sum = p.in[I_BADA][l * 12288 + cb * 128 + cc];
#pragma unroll
                for (int w8 = 0; w8 < 8; ++w8) sum += red[(w8 * 5 + r) * 128 + cc];
                mod[(size_t)(l * 5 + r) * 12288 + cb * 128 + cc] = sum; }
            __syncthreads();
        } else if (it < N_ADA_UNITS + N_S5T_UNITS) {
            const int lg = it - N_ADA_UNITS, l = lg >> 5, g = lg & 31;
            LAS f32x2* PWl = (LAS f32x2*)lds;
            LAS f32x2* BBl = (LAS f32x2*)(lds + 17408);
            LAS f32x2* Cl = (LAS f32x2*)(lds + 33792);
            LAS float* KZl = (LAS float*)(lds + 50176);
            for (int idx = tid; idx < 2 * 64 * 17; idx += 512) { const int z = idx / (64 * 17), n = (idx / 17) & 63, d = idx % 17; const int zgn = ((l * 2 + z) * 32 + g) * 64 + n;
                const float are = fminf(p.in[I_ARE][zgn], -1e-4f), aim = p.in[I_AIM][zgn]; const float dt = expf(p.in[I_LOGDT][zgn >> 6]);
                const double mag = exp((double)are * (double)dt * d); double sn, cs; sincos((double)aim * (double)dt * d, &sn, &cs);
                const f32x2 v = {(float)(mag * cs), (float)(mag * sn)}; PWl[idx] = v; if (d == 16) ((f32x2*)(ws + WS_A16))[zgn] = v; }
            for (int idx = tid; idx < 2 * 64 * 16; idx += 512) { const int z = idx >> 10, n = (idx >> 4) & 63, c = idx & 15; const int zgn = ((l * 2 + z) * 32 + g) * 64 + n;
                const float are = fminf(p.in[I_ARE][zgn], -1e-4f), aim = p.in[I_AIM][zgn]; const float dt = expf(p.in[I_LOGDT][zgn >> 6]);
                const double mag = exp((double)are * (double)dt); double sn, cs; sincos((double)aim * (double)dt, &sn, &cs);
                const float xr = (float)(mag * cs) - 1.0f, xi = (float)(mag * sn), den = 1.0f / (are * are + aim * aim);
                const float cr = (xr * are + xi * aim) * den, ci = (xi * are - xr * aim) * den;
                const float br = p.in[I_BRE][(size_t)zgn * 16 + c], bi = p.in[I_BIM][(size_t)zgn * 16 + c]; BBl[idx] = (f32x2){cr * br - ci * bi, cr * bi + ci * br}; }
            for (int idx = tid; idx < 2 * 16 * 64; idx += 512) { const int z = idx >> 10, cn = idx & 1023; const size_t src = ((size_t)((l * 2 + z) * 32 + g) * 16) * 64 + cn; Cl[idx] = (f32x2){p.in[I_CRE][src], p.in[I_CIM][src]}; }
            __syncthreads();
            { const int z = tid >> 8, d = (tid >> 4) & 15, c = tid & 15; float a16[16];
#pragma unroll
              for (int q = 0; q < 16; ++q) a16[q] = 0.f;
              for (int n = 0; n < 64; ++n) { const f32x2 pw = PWl[(z * 64 + n) * 17 + d], cm = Cl[(z * 16 + c) * 64 + n]; const float tr = cm.x * pw.x - cm.y * pw.y, ti = cm.x * pw.y + cm.y * pw.x;
#pragma unroll
                  for (int q = 0; q < 16; ++q) { const f32x2 bb = BBl[(z * 64 + n) * 16 + q]; a16[q] += tr * bb.x - ti * bb.y; } }
#pragma unroll
              for (int q = 0; q < 16; ++q) KZl[((z * 16 + d) * 16 + c) * 16 + q] = a16[q]; }
            __syncthreads();
            bf16_t* WST = (bf16_t*)(ws + WS_WST) + (size_t)lg * 256 * 256; bf16_t* G2B = (bf16_t*)(ws + WS_G2B) + (size_t)lg * 256 * 512;
            for (int i = 0; i < 16; ++i) { const int id = tid + 512 * i;
                {
                  const int c8 = (id & 1) * 8, pp = (id >> 1) & 15, row = id >> 5, z = row >> 7, ri = (row >> 6) & 1, n = row & 63;
                  const f32x2 pw = PWl[(z * 64 + n) * 17 + (z == 0 ? 15 - pp : pp)]; float f[8];
#pragma unroll
                  for (int j = 0; j < 8; ++j) { const f32x2 bb = BBl[(z * 64 + n) * 16 + c8 + j]; f[j] = ri == 0 ? (pw.x * bb.x - pw.y * bb.y) : (pw.x * bb.y + pw.y * bb.x); }
                  u32x4 w; w.x = cvt_pk_bf16(f[0], f[1]); w.y = cvt_pk_bf16(f[2], f[3]); w.z = cvt_pk_bf16(f[4], f[5]); w.w = cvt_pk_bf16(f[6], f[7]);
                  *(u32x4*)(WST + (size_t)row * 256 + pp * 16 + c8) = w; }
                {
                  const int n8 = (id & 7) * 8, ri = (id >> 3) & 1, z = (id >> 4) & 1, row = id >> 5, pp = row >> 4, c = row & 15; float f[8];
#pragma unroll
                  for (int j = 0; j < 8; ++j) { const f32x2 pw = PWl[(z * 64 + n8 + j) * 17 + (z == 0 ? pp + 1 : 16 - pp)], cm = Cl[(z * 16 + c) * 64 + n8 + j]; f[j] = ri == 0 ? (cm.x * pw.x - cm.y * pw.y) : -(cm.x * pw.y + cm.y * pw.x); }
                  u32x4 w; w.x = cvt_pk_bf16(f[0], f[1]); w.y = cvt_pk_bf16(f[2], f[3]); w.z = cvt_pk_bf16(f[4], f[5]); w.w = cvt_pk_bf16(f[6], f[7]);
                  *(u32x4*)(G2B + (size_t)row * 512 + 256 + z * 128 + ri * 64 + n8) = w; }
                {
                  const int c8 = (id & 1) * 8, pq = (id >> 1) & 15, row = id >> 5, pp = row >> 4, c = row & 15; float f[8];
#pragma unroll
                  for (int j = 0; j < 8; ++j) { float v = 0.f; if (pq <= pp) v += KZl[((0 * 16 + (pp - pq)) * 16 + c) * 16 + c8 + j]; if (pq >= pp) v += KZl[((1 * 16 + (pq - pp)) * 16 + c) * 16 + c8 + j];
                      if (pq == pp && c8 + j == c) v += p.in[I_S5D][l * 512 + g * 16 + c]; f[j] = v; }
                  u32x4 w; w.x = cvt_pk_bf16(f[0], f[1]); w.y = cvt_pk_bf16(f[2], f[3]); w.z = cvt_pk_bf16(f[4], f[5]); w.w = cvt_pk_bf16(f[6], f[7]);
                  *(u32x4*)(G2B + (size_t)row * 512 + pq * 16 + c8) = w; } }
            __syncthreads();
        } else if (it < N_ADA_UNITS + N_S5T_UNITS + N_ROPE_UNITS) {
            const int idx = (it - N_ADA_UNITS - N_S5T_UNITS) * 512 + tid; const int pos = idx >> 4, f = idx & 15;
            const float invf = powf(10000.0f, -(float)f * 0.0625f); const float ang = (float)pos * invf;
            ((f32x2*)(ws + WS_ROPE))[idx] = (f32x2){cosf(ang), sinf(ang)};
        } else {
            int t = it - N_ADA_UNITS - N_S5T_UNITS - N_ROPE_UNITS;
            LAS float* tile = (LAS float*)lds;
            if (t < 2 * T_WIN) { const int l = t / T_WIN, r = t % T_WIN; transpose_tile(p.in[I_WIN] + (size_t)l * DM * INC, INC, (r % 32) * 64, (r / 32) * 64, (bf16_t*)(ws + WS_WTIN) + (size_t)l * INP * DM, DM, 1, 0, 0, tile); continue; }
            t -= 2 * T_WIN;
            if (t < 2 * T_WOUT) { const int l = t / T_WOUT, r = t % T_WOUT; transpose_tile(p.in[I_WOUT] + (size_t)l * DM * DM, DM, (r % 32) * 64, (r / 32) * 64, (bf16_t*)(ws + WS_WTOUT) + (size_t)l * DM * DM, DM, 1, 0, 0, tile); continue; }
            t -= 2 * T_WOUT;
            if (t < 2 * T_WUQ) { const int l = t / T_WUQ, r = t % T_WUQ; transpose_tile(p.in[I_WUQ] + (size_t)l * 384 * 768, 768, (r % 6) * 64, (r / 6) * 64, (bf16_t*)(ws + WS_WTUQ) + (size_t)l * 768 * 384, 384, 1, 0, 0, tile); continue; }
            t -= 2 * T_WUQ;
            if (t < 2 * T_WUKV) { const int l = t / T_WUKV, r = t % T_WUKV; transpose_tile(p.in[I_WUKV] + (size_t)l * 256 * 1024, 1024, (r % 4) * 64, (r / 4) * 64, (bf16_t*)(ws + WS_WTUKV) + (size_t)l * 1024 * 256, 256, 1, 0, 1, tile); continue; }
            t -= 2 * T_WUKV;
            if (t < 2 * T_WGLU) { const int l = t / T_WGLU, r = t % T_WGLU; transpose_tile(p.in[I_WGLU] + (size_t)l * 512 * 512, 512, (r % 8) * 64, (r / 8) * 64, (bf16_t*)(ws + WS_WTGLU) + (size_t)l * 512 * 512, 512, 1, 0, 0, tile); continue; }
        }
    }
}

__device__ __forceinline__ void rms_mod_store(const f32x4 (&x)[8], const float* g, const float* scale, const float* shift, bf16_t* orow, f32x4 (&y)[8], int lane) {
    float ss = 0.f;
#pragma unroll
    for (int j = 0; j < 8; ++j) ss += x[j][0] * x[j][0] + x[j][1] * x[j][1] + x[j][2] * x[j][2] + x[j][3] * x[j][3];
    ss = wave_sum(ss);
    const float rinv = rsqrtf(ss * (1.0f / DM) + EPS);
#pragma unroll
    for (int j = 0; j < 8; ++j) { const int c = j * 256 + lane * 4;
        const f32x4 gv = *(const f32x4*)(g + c), sc = *(const f32x4*)(scale + c), sh = *(const f32x4*)(shift + c);
        y[j] = x[j] * rinv * gv * (1.0f + sc) + sh;
        u32x2 w; w.x = cvt_pk_bf16(y[j][0], y[j][1]); w.y = cvt_pk_bf16(y[j][2], y[j][3]); *(u32x2*)(orow + c) = w; }
}

constexpr int N1_ROWITEMS = MT / 8, N1_KZ = 64, N1_WST = 1024, N1_INTER = 1024;
__device__ __forceinline__ void ph_norm1_tables(const Params& p) {
    const int tid = opaque_tid(), lane = tid & 63, wave = tid >> 6;
    unsigned char* ws = opaque_ptr(p.ws);
    const float* mod = (const float*)(ws + WS_MOD);
    for (int it = blockIdx.x; it < N1_ROWITEMS; it += gridDim.x) {
        {
            const int row = it * 8 + wave; const int rr = row < NLAT ? (row >> 11) : 4;
            const float* xr = row < NLAT ? p.in[I_X] + (size_t)row * DM : p.in[I_CTX] + (size_t)(row - NLAT) * DM;
            f32x4 x[8], y[8];
#pragma unroll
            for (int j = 0; j < 8; ++j) x[j] = *(const f32x4*)(xr + j * 256 + lane * 4);
            const float* m = mod + (size_t)rr * 12288;
            rms_mod_store(x, p.in[I_N1G], m + DM, m, (bf16_t*)(ws + WS_H) + (size_t)row * DM, y, lane);
        }
    }
}

constexpr int B_ROWITEMS = MT / 8, B_SGU = 72 * 4, B_INTRA = 0;
__device__ __forceinline__ void ph_rowsplit(const Params& p, int l, LAS unsigned char* lds) {
    const int tid = opaque_tid(), lane = tid & 63, wave = tid >> 6;
    unsigned char* ws = opaque_ptr(p.ws);
    const bf16_t* P = (const bf16_t*)(ws + WS_PA);
    bf16_t* CAT = (bf16_t*)(ws + WS_CAT);
    const int nsgu = (l == 0) ? B_SGU : 256;
    for (int it0 = blockIdx.x; it0 < B_ROWITEMS + nsgu; it0 += gridDim.x) {
        const int it = it0 < nsgu ? B_ROWITEMS + it0 : it0 - nsgu;
        if (it < B_ROWITEMS) {
            const int row = it * 8 + wave; const bf16_t* pr = P + (size_t)row * INP;
            const bool lat = row < NLAT; const int t = lat ? (row & (SEQ - 1)) : ((row - NLAT) & (CTX - 1)); const int b = lat ? (row >> 11) : ((row - NLAT) >> 8);
            const int seqlen = lat ? SEQ : CTX;
            { float f[8]; float ss = 0.f;
              if (lane < 48) { const u32x4 v = *(const u32x4*)(pr + C_CQ + lane * 8); f[0] = bflo(v.x); f[1] = bfhi(v.x); f[2] = bflo(v.y); f[3] = bfhi(v.y); f[4] = bflo(v.z); f[5] = bfhi(v.z); f[6] = bflo(v.w); f[7] = bfhi(v.w);
#pragma unroll
                  for (int j = 0; j < 8; ++j) ss += f[j] * f[j]; }
              else {
#pragma unroll
                  for (int j = 0; j < 8; ++j) f[j] = 0.f; }
              ss = wave_sum(ss); const float rinv = rsqrtf(ss * (1.0f / 384.0f) + EPS);
              if (lane < 48) { const float* g = p.in[I_QNG] + l * 384 + lane * 8; u32x4 w;
                  w.x = cvt_pk_bf16(f[0] * rinv * g[0], f[1] * rinv * g[1]); w.y = cvt_pk_bf16(f[2] * rinv * g[2], f[3] * rinv * g[3]);
                  w.z = cvt_pk_bf16(f[4] * rinv * g[4], f[5] * rinv * g[5]); w.w = cvt_pk_bf16(f[6] * rinv * g[6], f[7] * rinv * g[7]);
                  *(u32x4*)((bf16_t*)(ws + WS_QA) + (size_t)row * 384 + lane * 8) = w; } }
            { const u32x2 v = *(const u32x2*)(pr + C_CKV + lane * 4); const float f0 = bflo(v.x), f1 = bfhi(v.x), f2 = bflo(v.y), f3 = bfhi(v.y);
              const float ss = wave_sum(f0 * f0 + f1 * f1 + f2 * f2 + f3 * f3); const float rinv = rsqrtf(ss * (1.0f / 256.0f) + EPS);
              const float* g = p.in[I_KVNG] + l * 256 + lane * 4; u32x2 w; w.x = cvt_pk_bf16(f0 * rinv * g[0], f1 * rinv * g[1]); w.y = cvt_pk_bf16(f2 * rinv * g[2], f3 * rinv * g[3]);
              *(u32x2*)((bf16_t*)(ws + WS_KVA) + (size_t)row * 256 + lane * 4) = w; }
            { float v = bf2f(pr[C_KR + lane]); const float partner = __shfl_xor(v, 16);
              if (lat) { const int jj = lane & 31, fi = jj & 15; const int pos = lane >= 32 ? (t & 63) : (t >> 6);
                  const f32x2 r = ((const f32x2*)(ws + WS_ROPE))[pos * 16 + fi]; const float cs = r.x, sn = r.y;
                  v = jj < 16 ? (v * cs - partner * sn) : (v * cs + partner * sn); }
              const int key = lat ? CTX + t : t; const unsigned short o = f2bf(v);
              bf16_t* kc = (bf16_t*)(ws + WS_KC);
#pragma unroll
              for (int h = 0; h < 4; ++h) kc[((size_t)(b * 4 + h) * NKEY + key) * 192 + 128 + lane] = o; }
            { const u32x4 v = *(const u32x4*)(pr + C_S5 + lane * 8); const int g = lane >> 1, half = lane & 1;
              *(u32x4*)((bf16_t*)(ws + WS_UPK) + ((size_t)g * 768 + (row >> 4)) * 512 + (row & 15) * 16 + half * 8) = v; }
            { const int c0 = lane * 8; float zp[8], zc[8], zn[8];
#pragma unroll
              for (int j = 0; j < 8; ++j) { zp[j] = 0.f; zn[j] = 0.f; }
#define CONV_Z(dst, rp) do { const u32x4 a_ = *(const u32x4*)((rp) + C_CVC + c0); const u32x4 h_ = *(const u32x4*)((rp) + C_CVH + c0); \
                  dst[0] = bflo(a_.x) * bflo(h_.x); dst[1] = bfhi(a_.x) * bfhi(h_.x); dst[2] = bflo(a_.y) * bflo(h_.y); dst[3] = bfhi(a_.y) * bfhi(h_.y); \
                  dst[4] = bflo(a_.z) * bflo(h_.z); dst[5] = bfhi(a_.z) * bfhi(h_.z); dst[6] = bflo(a_.w) * bflo(h_.w); dst[7] = bfhi(a_.w) * bfhi(h_.w); } while (0)
              CONV_Z(zc, pr);
              if (t > 0) CONV_Z(zp, pr - INP);
              if (t < seqlen - 1) CONV_Z(zn, pr + INP);
#undef CONV_Z
              const u32x4 bg = *(const u32x4*)(pr + C_CVB + c0); float bgf[8] = {bflo(bg.x), bfhi(bg.x), bflo(bg.y), bfhi(bg.y), bflo(bg.z), bfhi(bg.z), bflo(bg.w), bfhi(bg.w)};
              const float* cw = p.in[I_CONVW] + (size_t)l * 3 * 512 + c0; float o[8];
#pragma unroll
              for (int j = 0; j < 8; ++j) o[j] = bgf[j] * (cw[j] * zp[j] + cw[512 + j] * zc[j] + cw[1024 + j] * zn[j]);
              u32x4 w; w.x = cvt_pk_bf16(o[0], o[1]); w.y = cvt_pk_bf16(o[2], o[3]); w.z = cvt_pk_bf16(o[4], o[5]); w.w = cvt_pk_bf16(o[6], o[7]);
              *(u32x4*)(CAT + (size_t)row * DM + 1536 + c0) = w; }
        } else if (it < B_ROWITEMS + B_SGU) {
            const int un = it - B_ROWITEMS, cc = un >> 2, h = un & 3; const int row0 = cc * 128;
            LAS bf16_t* Wl = (LAS bf16_t*)lds;
            LAS bf16_t* Vl = (LAS bf16_t*)(lds + 128 * 136 * 2);
            const float* Wg = p.in[I_SGUW] + ((size_t)l * 4 + h) * 128 * 128;
#pragma unroll
            for (int i = 0; i < 8; ++i) { const int e4 = (i * 512 + tid) * 4, r = e4 >> 7, c = e4 & 127; const f32x4 v = *(const f32x4*)(Wg + e4);
                u32x2 w; w.x = cvt_pk_bf16(v[0], v[1]); w.y = cvt_pk_bf16(v[2], v[3]); *(LAS u32x2*)(Wl + r * 136 + c) = w; }
            u32x4 vv[16];
#pragma unroll
            for (int qi = 0; qi < 16; ++qi) vv[qi] = *(const u32x4*)(P + (size_t)(row0 + wave * 16 + qi) * INP + C_SGU_V + lane * 8);
#pragma unroll
            for (int qi = 0; qi < 16; ++qi) { const int q = wave * 16 + qi;
                const u32x4 v = vv[qi]; float f[8] = {bflo(v.x), bfhi(v.x), bflo(v.y), bfhi(v.y), bflo(v.z), bfhi(v.z), bflo(v.w), bfhi(v.w)}; float ss = 0.f;
#pragma unroll
                for (int j = 0; j < 8; ++j) { f[j] = gelu_tanh(f[j]); ss += f[j] * f[j]; }
                ss = wave_sum(ss); const float rinv = rsqrtf(ss * (1.0f / 512.0f) + EPS);
                if ((lane >> 4) == h) { const int c0 = (lane & 15) * 8; const float* g = p.in[I_SGUNG] + l * 512 + h * 128 + c0;
#pragma unroll
                    for (int j = 0; j < 8; ++j) Vl[(c0 + j) * 136 + q] = f2bf(f[j] * rinv * g[j]); } }
            __syncthreads();
            { const int fr = lane & 15, fq = lane >> 4; f32x4 acc[8];
#pragma unroll
              for (int nb = 0; nb < 8; ++nb) acc[nb] = (f32x4){0.f, 0.f, 0.f, 0.f};
#pragma unroll
              for (int ks = 0; ks < 4; ++ks) { const bf16x8 af = *(const LAS bf16x8*)(Wl + (wave * 16 + fr) * 136 + ks * 32 + fq * 8);
#pragma unroll
                  for (int nb = 0; nb < 8; ++nb) { const bf16x8 bfr = *(const LAS bf16x8*)(Vl + (nb * 16 + fr) * 136 + ks * 32 + fq * 8);
                      acc[nb] = __builtin_amdgcn_mfma_f32_16x16x32_bf16(bfr, af, acc[nb], 0, 0, 0); } }
              const int pp = wave * 16 + fr; const float bias = p.in[I_SGUB][((size_t)l * 4 + h) * 128 + pp]; const bf16_t* pr = P + (size_t)(row0 + pp) * INP + C_SGU_U + h * 128;
#pragma unroll
              for (int nb = 0; nb < 8; ++nb) { const int c = nb * 16 + 4 * fq; const u32x2 uv = *(const u32x2*)(pr + c);
                  u32x2 w; w.x = cvt_pk_bf16(gelu_tanh(bflo(uv.x)) * (acc[nb][0] + bias), gelu_tanh(bfhi(uv.x)) * (acc[nb][1] + bias));
                  w.y = cvt_pk_bf16(gelu_tanh(bflo(uv.y)) * (acc[nb][2] + bias), gelu_tanh(bfhi(uv.y)) * (acc[nb][3] + bias));
                  *(u32x2*)(CAT + (size_t)(row0 + pp) * DM + h * 128 + c) = w; } }
            __syncthreads();
        }
    }
}

constexpr int KPITCH = 400, VPITCH = 144;
constexpr int KT_BYTES = 64 * KPITCH, VT_BYTES = 128 * VPITCH;
__device__ __forceinline__ void attn_unit(const bf16_t* Qrows  , const bf16_t* Kbh, const bf16_t* Vbh, int nkeys, bf16_t* Orows, LAS unsigned char* lds) {
    const int tid = opaque_tid(), lane = tid & 63, wave = tid >> 6, l32 = lane & 31, hi = lane >> 5, qg = wave & 3, kh = wave >> 2;
    constexpr int VRING = 3 * KT_BYTES;
    bf16x8 qf[12];
    { const bf16_t* qr = Qrows + (size_t)(qg * 32 + l32) * 768 + hi * 8;
#pragma unroll
      for (int ks = 0; ks < 12; ++ks) qf[ks] = *(const bf16x8*)(qr + ks * 16); }
    f32x16 o[4];
#pragma unroll
    for (int db = 0; db < 4; ++db)
#pragma unroll
        for (int r = 0; r < 16; ++r) o[db][r] = 0.f;
    float mrow = -1e30f, lsum = 0.f;
    const int nt = nkeys / 64;
    const int wv = __builtin_amdgcn_readfirstlane(wave);
    unsigned doffK[4], doffV[3];
#pragma unroll
    for (int i = 0; i < 4; ++i) { const int pc = (wv + 8 * i) < 25 ? (wv + 8 * i) : 24; const int X = pc * 1024 + lane * 16, row = X / KPITCH, col = X % KPITCH; doffK[i] = (unsigned)(row * 384 + (col < 384 ? col : 0)); }
#pragma unroll
    for (int i = 0; i < 3; ++i) { const int pc = (wv + 8 * i) < 18 ? (wv + 8 * i) : 17; const int Y = pc * 1024 + lane * 16, row = Y / VPITCH, col = Y % VPITCH; doffV[i] = (unsigned)(row * (NKEY * 2) + (col < 128 ? col : 0)); }
#define ATT_DMAK(tile, slot) do { _Pragma("unroll") for (int i = 0; i < 4; ++i) { const int pc = (wv + 8 * i) < 25 ? (wv + 8 * i) : 24; \
        __builtin_amdgcn_global_load_lds((const unsigned*)((const char*)Kbh + (size_t)(tile) * (64 * 384) + doffK[i]), (LAS unsigned*)(lds + (slot) * KT_BYTES + pc * 1024), 16, 0, 0); } } while (0)
#define ATT_DMAV(tile, slot) do { _Pragma("unroll") for (int i = 0; i < 3; ++i) { const int pc = (wv + 8 * i) < 18 ? (wv + 8 * i) : 17; \
        __builtin_amdgcn_global_load_lds((const unsigned*)((const char*)Vbh + (size_t)(tile) * 128 + doffV[i]), (LAS unsigned*)(lds + VRING + (slot) * VT_BYTES + pc * 1024), 16, 0, 0); } } while (0)
#define ATT_STEP(S, SN, QK, ks_, vs_) do { \
        float mx = S[0]; \
        _Pragma("unroll") for (int r = 1; r < 16; ++r) mx = fmaxf(mx, S[r]); \
        mx = fmaxf(mx, __shfl_xor(mx, 32)); \
        if (__any(mx > mrow + 8.0f)) { const float mnew = fmaxf(mrow, mx), alpha = __builtin_amdgcn_exp2f(mrow - mnew); mrow = mnew; lsum *= alpha; \
            _Pragma("unroll") for (int db = 0; db < 4; ++db) _Pragma("unroll") for (int r = 0; r < 16; ++r) o[db][r] *= alpha; } \
        __builtin_amdgcn_sched_barrier(0); \
        const LAS unsigned char* Vcur = lds + VRING + (vs_) * VT_BYTES; \
        u32x4 vf0[4], vf1[4]; \
        float ps = 0.f; u32x4 pw0, pw1; \
        if (QK) { const LAS unsigned char* kp = lds + (ks_) * KT_BYTES + (kh * 32 + l32) * KPITCH + hi * 16; \
            bf16x8 kf[12]; \
            _Pragma("unroll") for (int i = 0; i < 12; ++i) kf[i] = *(const LAS bf16x8*)(kp + i * 32); \
            _Pragma("unroll") for (int r = 0; r < 16; ++r) SN[r] = 0.f; \
            __builtin_amdgcn_sched_barrier(0); \
              \
            _Pragma("unroll") for (int i = 0; i < 12; ++i) { \
                SN = __builtin_amdgcn_mfma_f32_32x32x16_bf16(kf[i], qf[i], SN, 0, 0, 0); \
                S[i] = __builtin_amdgcn_exp2f(S[i] - mrow); ps += S[i]; \
                if (i < 4) { S[12 + i] = __builtin_amdgcn_exp2f(S[12 + i] - mrow); ps += S[12 + i]; } \
                if (i == 1) pw0.x = cvt_pk_bf16(S[0], S[1]); if (i == 3) { pw0.y = cvt_pk_bf16(S[2], S[3]); pw1.z = cvt_pk_bf16(S[12], S[13]); pw1.w = cvt_pk_bf16(S[14], S[15]); } \
                if (i == 5) pw0.z = cvt_pk_bf16(S[4], S[5]); if (i == 7) pw0.w = cvt_pk_bf16(S[6], S[7]); if (i == 9) pw1.x = cvt_pk_bf16(S[8], S[9]); if (i == 11) pw1.y = cvt_pk_bf16(S[10], S[11]); \
                if (i >= 8) { const int db = i - 8; const LAS unsigned char* vp = Vcur + (db * 32 + l32) * VPITCH + kh * 64 + hi * 16; \
                    vf0[db] = *(const LAS u32x4*)vp; vf1[db] = *(const LAS u32x4*)(vp + 32); } \
                __builtin_amdgcn_sched_barrier(0); } \
        } else { \
            _Pragma("unroll") for (int db = 0; db < 4; ++db) { const LAS unsigned char* vp = Vcur + (db * 32 + l32) * VPITCH + kh * 64 + hi * 16; \
                vf0[db] = *(const LAS u32x4*)vp; vf1[db] = *(const LAS u32x4*)(vp + 32); } \
            _Pragma("unroll") for (int r = 0; r < 16; ++r) { S[r] = __builtin_amdgcn_exp2f(S[r] - mrow); ps += S[r]; } \
            pw0.x = cvt_pk_bf16(S[0], S[1]); pw0.y = cvt_pk_bf16(S[2], S[3]); pw0.z = cvt_pk_bf16(S[4], S[5]); pw0.w = cvt_pk_bf16(S[6], S[7]); \
            pw1.x = cvt_pk_bf16(S[8], S[9]); pw1.y = cvt_pk_bf16(S[10], S[11]); pw1.z = cvt_pk_bf16(S[12], S[13]); pw1.w = cvt_pk_bf16(S[14], S[15]); } \
        lsum += ps; \
        { const bf16x8 pf = __builtin_bit_cast(bf16x8, pw0); \
          _Pragma("unroll") for (int db = 0; db < 4; ++db) o[db] = __builtin_amdgcn_mfma_f32_32x32x16_bf16(__builtin_bit_cast(bf16x8, vf0[db]), pf, o[db], 0, 0, 0); } \
        { const bf16x8 pf = __builtin_bit_cast(bf16x8, pw1); \
          _Pragma("unroll") for (int db = 0; db < 4; ++db) o[db] = __builtin_amdgcn_mfma_f32_32x32x16_bf16(__builtin_bit_cast(bf16x8, vf1[db]), pf, o[db], 0, 0, 0); } \
        __builtin_amdgcn_sched_barrier(0); } while (0)
#define ATT_SYNC(full) do { if (full) asm volatile("s_waitcnt vmcnt(7)" ::: "memory"); else asm volatile("s_waitcnt vmcnt(0)" ::: "memory"); \
        __builtin_amdgcn_s_barrier(); asm volatile("" ::: "memory"); } while (0)
    ATT_DMAK(0, 0); ATT_DMAV(0, 0); ATT_DMAK(1, 1); ATT_DMAV(1, 1); if (nt > 2) ATT_DMAK(2, 2);
    asm volatile("s_waitcnt vmcnt(0)" ::: "memory");
    __builtin_amdgcn_s_barrier(); asm volatile("" ::: "memory");
    f32x16 sA, sB;
    { const LAS unsigned char* kp = lds + (kh * 32 + l32) * KPITCH + hi * 16;
#pragma unroll
      for (int r = 0; r < 16; ++r) sA[r] = 0.f;
#pragma unroll
      for (int i = 0; i < 12; ++i) { const bf16x8 kf = *(const LAS bf16x8*)(kp + i * 32); sA = __builtin_amdgcn_mfma_f32_32x32x16_bf16(kf, qf[i], sA, 0, 0, 0); } }
    int k1 = 1, v0 = 0;
    int j = 0;
    for (; j + 2 < nt; j += 2) {
        ATT_SYNC(true);
        if (j + 3 < nt) ATT_DMAK(j + 3, v0);
        ATT_DMAV(j + 2, v0 == 0 ? 2 : v0 - 1);
        ATT_STEP(sA, sB, true, k1, v0);
        k1 = k1 == 2 ? 0 : k1 + 1; v0 = v0 == 2 ? 0 : v0 + 1;
        ATT_SYNC(j + 3 < nt);
        if (j + 4 < nt) ATT_DMAK(j + 4, v0);
        if (j + 3 < nt) ATT_DMAV(j + 3, v0 == 0 ? 2 : v0 - 1);
        ATT_STEP(sB, sA, true, k1, v0);
        k1 = k1 == 2 ? 0 : k1 + 1; v0 = v0 == 2 ? 0 : v0 + 1;
    }
    ATT_SYNC(false);
    ATT_STEP(sA, sB, true, k1, v0);
    k1 = k1 == 2 ? 0 : k1 + 1; v0 = v0 == 2 ? 0 : v0 + 1;
    ATT_SYNC(false);
    ATT_STEP(sB, sA, false, k1, v0);
#undef ATT_STEP
#undef ATT_SYNC
#undef ATT_DMAK
#undef ATT_DMAV
    __syncthreads();
    lsum += __shfl_xor(lsum, 32);
    LAS float* mb = (LAS float*)lds + (size_t)qg * 66 * 64 + lane;
    if (kh == 1) {
#pragma unroll
        for (int db = 0; db < 4; ++db)
#pragma unroll
            for (int r = 0; r < 16; ++r) mb[(db * 16 + r) * 64] = o[db][r];
        mb[64 * 64] = mrow; mb[65 * 64] = lsum;
    }
    __syncthreads();
    if (kh == 0) {
        const float m1 = mb[64 * 64], l1 = mb[65 * 64];
        const float m = fmaxf(mrow, m1), e0 = __builtin_amdgcn_exp2f(mrow - m), e1 = __builtin_amdgcn_exp2f(m1 - m);
        const float inv = 1.0f / (lsum * e0 + l1 * e1), c0 = e0 * inv, c1 = e1 * inv;
        bf16_t* orow = Orows + (size_t)(qg * 32 + l32) * DM;
#pragma unroll
        for (int db = 0; db < 4; ++db)
#pragma unroll
            for (int k4 = 0; k4 < 4; ++k4) { float v[4];
#pragma unroll
                for (int i = 0; i < 4; ++i) v[i] = o[db][4 * k4 + i] * c0 + mb[(db * 16 + 4 * k4 + i) * 64] * c1;
                u32x2 w; w.x = cvt_pk_bf16(v[0], v[1]); w.y = cvt_pk_bf16(v[2], v[3]);
                *(u32x2*)(orow + db * 32 + 8 * k4 + 4 * hi) = w; }
    }
    __syncthreads();
}
__device__ __forceinline__ void ph_attn_carry(const Params& p, int l, LAS unsigned char* lds) {
    unsigned char* ws = opaque_ptr(p.ws); const int tid = opaque_tid();
    const int natt = (l == 0) ? 288 : 256;
    const bf16_t* QB = (const bf16_t*)(ws + WS_QB); const bf16_t* KC = (const bf16_t*)(ws + WS_KC); const bf16_t* VT = (const bf16_t*)(ws + WS_VT); bf16_t* CAT = (bf16_t*)(ws + WS_CAT);
    for (int it = blockIdx.x; it < natt; it += gridDim.x) {
        {
            int b, h, row0, nkeys;
            if (it < 256) { const int x = it & 7, jj = it >> 3, bh = 2 * x + (jj >> 4); b = bh >> 2; h = bh & 3; row0 = b * SEQ + (jj & 15) * 128; nkeys = NKEY; }
            else { const int u = it - 256; b = u >> 3; h = (u >> 1) & 3; row0 = NLAT + b * CTX + (u & 1) * 128; nkeys = CTX; }
            attn_unit(QB + (size_t)row0 * 768 + h * 192, KC + (size_t)(b * 4 + h) * NKEY * 192, VT + (size_t)(b * 4 + h) * 128 * NKEY, nkeys, CAT + (size_t)row0 * DM + 512 + h * 128, lds);
        }
    }
    for (int it = natt + (int)((blockIdx.x + gridDim.x - natt % gridDim.x) % gridDim.x); it < natt + 256; it += gridDim.x) {
        {
            const int u = it - natt; const int z = u >> 7, b = (u >> 5) & 3, g = u & 31, lane = tid & 63, w = tid >> 6;
            const f32x2 a16 = ((const f32x2*)(ws + WS_A16))[(((size_t)l * 2 + z) * 32 + g) * 64 + lane];
            const float* EST = (const float*)(ws + WS_EST) + (size_t)g * 768 * 256 + z * 128 + lane;
            bf16_t* UP = (bf16_t*)(ws + WS_UPK) + (size_t)g * 768 * 512 + 256 + z * 128 + lane;
            LAS f32x2* seg = (LAS f32x2*)lds;
            float er[18], ei[18];
#pragma unroll
            for (int i = 0; i < 18; ++i) { const int st = w * 18 + i; int chunk;
                if (z == 0) chunk = st < 16 ? (512 + b * 16 + st) : (b * 128 + (st - 16)); else chunk = st < 16 ? (512 + b * 16 + (15 - st)) : (b * 128 + (143 - st));
                er[i] = EST[(size_t)chunk * 256]; ei[i] = EST[(size_t)chunk * 256 + 64]; }
            float sr = 0.f, si = 0.f;
#pragma unroll
            for (int i = 0; i < 18; ++i) { const float nr = a16.x * sr - a16.y * si + er[i], ni = a16.x * si + a16.y * sr + ei[i]; sr = nr; si = ni; }
            seg[w * 64 + lane] = (f32x2){sr, si};
            float pr = 1.f, pi = 0.f;
#pragma unroll
            for (int i = 0; i < 18; ++i) { const float nr = pr * a16.x - pi * a16.y, ni = pr * a16.y + pi * a16.x; pr = nr; pi = ni; }
            __syncthreads();
            sr = 0.f; si = 0.f;
            for (int w2 = 0; w2 < w; ++w2) { const f32x2 sv = seg[w2 * 64 + lane]; const float nr = pr * sr - pi * si + sv.x, ni = pr * si + pi * sr + sv.y; sr = nr; si = ni; }
#pragma unroll
            for (int i = 0; i < 18; ++i) { const int st = w * 18 + i; int chunk;
                if (z == 0) chunk = st < 16 ? (512 + b * 16 + st) : (b * 128 + (st - 16)); else chunk = st < 16 ? (512 + b * 16 + (15 - st)) : (b * 128 + (143 - st));
                UP[(size_t)chunk * 512] = f2bf(sr); UP[(size_t)chunk * 512 + 64] = f2bf(si);
                const float nr = a16.x * sr - a16.y * si + er[i], ni = a16.x * si + a16.y * sr + ei[i]; sr = nr; si = ni; }
            __syncthreads();
        }
    }
}

__device__ __forceinline__ void ph_norm2_router(const Params& p, int l, LAS unsigned char* lds) {
    const int tid = opaque_tid(), lane = tid & 63, wave = tid >> 6;
    unsigned char* ws = opaque_ptr(p.ws); const float* mod = (const float*)(ws + WS_MOD) + (size_t)l * 5 * 12288;
    const int nrows = (l == 0) ? MT : NLAT;
    const float* WR = p.in[I_WROUTER] + (size_t)l * DM * NE;
    for (int idx = tid; idx < DM * 4; idx += 512) { const int c = idx & (DM - 1), e4 = idx >> 11; const f32x4 v = *(const f32x4*)(WR + (size_t)c * NE + e4 * 4);
        *(LAS f32x4*)(lds + (size_t)(((e4 * 2 + (c & 1)) * 1024 + (c >> 1)) * 16)) = v; }
    __syncthreads();
    const float* n2g = p.in[I_N2G] + l * DM;
    for (int it = blockIdx.x; it < nrows / 8; it += gridDim.x) {
        const int row = it * 8 + wave; const int rr = row < NLAT ? (row >> 11) : 4;
        const bf16_t* xr = (const bf16_t*)(ws + WS_XB) + (size_t)row * DM;
        const float* m = mod + (size_t)rr * 12288;
        f32x2 x[16], gv[16], sc[16], sh[16];
#pragma unroll
        for (int j = 0; j < 16; ++j) { const int c = j * 128 + lane * 2; { const unsigned xw = *(const unsigned*)(xr + c); x[j] = (f32x2){bflo(xw), bfhi(xw)}; } gv[j] = *(const f32x2*)(n2g + c); sc[j] = *(const f32x2*)(m + 4 * DM + c); sh[j] = *(const f32x2*)(m + 3 * DM + c); }
        float ss = 0.f;
#pragma unroll
        for (int j = 0; j < 16; ++j) ss += x[j].x * x[j].x + x[j].y * x[j].y;
        ss = wave_sum(ss); const float rinv = rsqrtf(ss * (1.0f / DM) + EPS);
        bf16_t* orow = (bf16_t*)(ws + WS_H) + (size_t)row * DM;
        f32x4 lg[4];
#pragma unroll
        for (int e4 = 0; e4 < 4; ++e4) lg[e4] = (f32x4){0.f, 0.f, 0.f, 0.f};
#pragma unroll
        for (int j = 0; j < 16; ++j) { const f32x2 y = x[j] * rinv * gv[j] * (1.0f + sc[j]) + sh[j];
            *(unsigned*)(orow + j * 128 + lane * 2) = cvt_pk_bf16(y.x, y.y);
#pragma unroll
            for (int e4 = 0; e4 < 4; ++e4) { const f32x4 w0 = *(const LAS f32x4*)(lds + (size_t)(((e4 * 2 + 0) * 1024 + j * 64 + lane) * 16)); const f32x4 w1 = *(const LAS f32x4*)(lds + (size_t)(((e4 * 2 + 1) * 1024 + j * 64 + lane) * 16));
                lg[e4] += y.x * w0 + y.y * w1; }
            __builtin_amdgcn_sched_barrier(0); }
        float lgs[16]; float mx = -1e30f;
#pragma unroll
        for (int e = 0; e < 16; ++e) { lgs[e] = wave_sum(lg[e >> 2][e & 3]); mx = fmaxf(mx, lgs[e]); }
        float se = 0.f;
#pragma unroll
        for (int e = 0; e < 16; ++e) { lgs[e] = __expf(lgs[e] - mx); se += lgs[e]; }
        const float inv = 1.0f / se;
        float mine = 0.f;
#pragma unroll
        for (int e = 0; e < 16; ++e) mine = (lane == e) ? lgs[e] * inv : mine;
        if (lane < 16) ((float*)(ws + WS_AFF))[(size_t)row * 16 + lane] = mine;
    }
}

__device__ __forceinline__ void ph_topk(const Params& p, int l, LAS unsigned char* lds) {
    const int tid = opaque_tid(), lane = tid & 63, wave = tid >> 6;
    unsigned char* ws = opaque_ptr(p.ws); const float* AFF = (const float*)(ws + WS_AFF);
    int* ROWTOK = (int*)(ws + WS_ROWTOK); float* ROWAFF = (float*)(ws + WS_ROWAFF); int* INV = (int*)(ws + WS_INV);
    LAS int* hist = (LAS int*)lds;
    LAS int* ctl = (LAS int*)(lds + 1024);
    LAS int* wsum = (LAS int*)(lds + 1280);
    const int nunits = (l == 0) ? 128 : 64;
    for (int it = blockIdx.x; it < nunits; it += gridDim.x) {
        const bool lat = it < 64; const int u = lat ? it : it - 64; const int b = u >> 4, e = u & 15;
        const int n = lat ? SEQ : CTX, cap = lat ? CAPL : CAPC;
        const int tok0 = lat ? b * SEQ : NLAT + b * CTX; const int rowbase = lat ? b * CAPL : 1024 + b * CAPC;
        unsigned key[4];
#pragma unroll
        for (int j = 0; j < 4; ++j) { const int t = tid * 4 + j; key[j] = t < n ? __float_as_uint(AFF[(size_t)(tok0 + t) * 16 + e]) : 0u; }
        unsigned prefix = 0u; int remaining = cap;
        for (int pass = 3; pass >= 0; --pass) {
            if (tid < 256) hist[tid] = 0;
            __syncthreads();
#pragma unroll
            for (int j = 0; j < 4; ++j) { const int t = tid * 4 + j; if (t < n) { const bool match = (pass == 3) || ((key[j] >> (8 * (pass + 1))) == (prefix >> (8 * (pass + 1)))); if (match) atomicAdd((int*)&hist[(key[j] >> (8 * pass)) & 255u], 1); } }
            __syncthreads();
            if (wave == 0) {
                const int b0 = hist[4 * lane], b1 = hist[4 * lane + 1], b2 = hist[4 * lane + 2], b3 = hist[4 * lane + 3];
                const int s = b0 + b1 + b2 + b3; int suf = s;
#pragma unroll
                for (int off = 1; off < 64; off <<= 1) { const int t = __shfl_down(suf, off); if (lane + off < 64) suf += t; }
                const int above = suf - s; const int c3 = above + b3, c2 = c3 + b2, c1 = c2 + b1, c0 = c1 + b0;
                if (above < remaining && c0 >= remaining) { int dg, nr;
                    if (c3 >= remaining) { dg = 4 * lane + 3; nr = remaining - above; } else if (c2 >= remaining) { dg = 4 * lane + 2; nr = remaining - c3; }
                    else if (c1 >= remaining) { dg = 4 * lane + 1; nr = remaining - c2; } else { dg = 4 * lane; nr = remaining - c1; }
                    ctl[0] = dg; ctl[1] = nr; }
            }
            __syncthreads();
            prefix |= ((unsigned)ctl[0]) << (8 * pass); remaining = ctl[1];
            __syncthreads();
        }
        int cgt = 0, ceq = 0;
#pragma unroll
        for (int j = 0; j < 4; ++j) { const int t = tid * 4 + j; if (t < n) { cgt += key[j] > prefix ? 1 : 0; ceq += key[j] == prefix ? 1 : 0; } }
        const int packed = cgt | (ceq << 16);
        int inc = packed;
#pragma unroll
        for (int off = 1; off < 64; off <<= 1) { const int t = __shfl_up(inc, off); if (lane >= off) inc += t; }
        if (lane == 63) wsum[wave] = inc;
        __syncthreads();
        int base = 0;
#pragma unroll
        for (int w8 = 0; w8 < 8; ++w8) base += (w8 < wave) ? wsum[w8] : 0;
        int excl = base + inc - packed; int egt = excl & 0xffff, eeq = excl >> 16;
#pragma unroll
        for (int j = 0; j < 4; ++j) { const int t = tid * 4 + j; if (t < n) {
                const bool gt = key[j] > prefix, eq = key[j] == prefix; const bool sel = gt || (eq && eeq < remaining);
                const int slot = egt + (eeq < remaining ? eeq : remaining);
                if (sel) { ROWTOK[e * EROWS + rowbase + slot] = tok0 + t; ROWAFF[e * EROWS + rowbase + slot] = __uint_as_float(key[j]); }
                INV[(size_t)(tok0 + t) * 16 + e] = sel ? rowbase + slot : -1;
                egt += gt ? 1 : 0; eeq += eq ? 1 : 0; } }
        __syncthreads();
    }
}

__device__ __forceinline__ void ph_gather(const Params& p, int l) {
    const int tid = opaque_tid(), lane = tid & 63, wave = tid >> 6;
    unsigned char* ws = opaque_ptr(p.ws); const int* ROWTOK = (const int*)(ws + WS_ROWTOK);
    const int rows_per_e = (l == 0) ? 1152 : 1024;
    const int nitems = NE * rows_per_e / 8;
    for (int it = blockIdx.x; it < nitems; it += gridDim.x) {
        const int ridx = it * 8 + wave; const int e = ridx / rows_per_e, r = ridx % rows_per_e;
        const int tok = ROWTOK[e * EROWS + r];
        const u32x4* src = (const u32x4*)((const bf16_t*)(ws + WS_H) + (size_t)tok * DM); u32x4* dst = (u32x4*)((bf16_t*)(ws + WS_PA) + ((size_t)e * EROWS + r) * DM);
#pragma unroll
        for (int j = 0; j < 4; ++j) dst[j * 64 + lane] = src[j * 64 + lane];
    }
}

__device__ __forceinline__ void ph_combine(const Params& p, int l) {
    const int tid = opaque_tid(), lane = tid & 63, wave = tid >> 6;
    unsigned char* ws = opaque_ptr(p.ws); const float* mod = (const float*)(ws + WS_MOD);
    const int nrows = (l == 0) ? MT : NLAT;
    const int* INV = (const int*)(ws + WS_INV); const bf16_t* YS = (const bf16_t*)(ws + WS_YS);
    for (int it = blockIdx.x; it < nrows / 8; it += gridDim.x) {
        const int row = it * 8 + wave; const int rr = row < NLAT ? (row >> 11) : 4;
        const bf16_t* xr = (const bf16_t*)(ws + WS_XB) + (size_t)row * DM;
        f32x4 x[8], s[8], y[8];
#pragma unroll
        for (int j = 0; j < 8; ++j) { const u32x2 xv = *(const u32x2*)(xr + j * 256 + lane * 4); x[j] = (f32x4){bflo(xv.x), bfhi(xv.x), bflo(xv.y), bfhi(xv.y)}; s[j] = (f32x4){0.f, 0.f, 0.f, 0.f}; }
        const int myinv = lane < 16 ? INV[(size_t)row * 16 + lane] : -1;
        unsigned msk = (unsigned)__ballot(myinv >= 0);
        while (msk) {
            const int e0 = __builtin_ctz(msk); msk &= msk - 1; const bool two = msk != 0u; const int e1 = two ? __builtin_ctz(msk) : e0; if (two) msk &= msk - 1;
            const int r0 = __shfl(myinv, e0), r1 = __shfl(myinv, e1);
            const bf16_t* y0 = YS + ((size_t)e0 * EROWS + r0) * DM; const bf16_t* y1 = YS + ((size_t)e1 * EROWS + r1) * DM;
            u32x2 v0[8], v1[8];
#pragma unroll
            for (int j = 0; j < 8; ++j) { v0[j] = *(const u32x2*)(y0 + j * 256 + lane * 4); v1[j] = *(const u32x2*)(y1 + j * 256 + lane * 4); }
            const float f1 = two ? 1.0f : 0.0f;
#pragma unroll
            for (int j = 0; j < 8; ++j) { s[j][0] += bflo(v0[j].x) + f1 * bflo(v1[j].x); s[j][1] += bfhi(v0[j].x) + f1 * bfhi(v1[j].x); s[j][2] += bflo(v0[j].y) + f1 * bflo(v1[j].y); s[j][3] += bfhi(v0[j].y) + f1 * bfhi(v1[j].y); }
        }
        const float* gate = mod + (size_t)(l * 5 + rr) * 12288 + 5 * DM;
#pragma unroll
        for (int j = 0; j < 8; ++j) { const f32x4 gv = *(const f32x4*)(gate + j * 256 + lane * 4); x[j] += gv * s[j]; }
        if (l == 0) {
            bf16_t* xo = (bf16_t*)(ws + WS_XA) + (size_t)row * DM;
#pragma unroll
            for (int j = 0; j < 8; ++j) { u32x2 w; w.x = cvt_pk_bf16(x[j][0], x[j][1]); w.y = cvt_pk_bf16(x[j][2], x[j][3]); *(u32x2*)(xo + j * 256 + lane * 4) = w; }
            const float* m = mod + (size_t)(5 + rr) * 12288;
            rms_mod_store(x, p.in[I_N1G] + DM, m + DM, m, (bf16_t*)(ws + WS_H) + (size_t)row * DM, y, lane);
        } else {
            float ss = 0.f;
#pragma unroll
            for (int j = 0; j < 8; ++j) ss += x[j][0] * x[j][0] + x[j][1] * x[j][1] + x[j][2] * x[j][2] + x[j][3] * x[j][3];
            ss = wave_sum(ss); const float rinv = rsqrtf(ss * (1.0f / DM) + EPS);
            float* orow = p.out + (size_t)row * DM;
#pragma unroll
            for (int j = 0; j < 8; ++j) { const f32x4 gv = *(const f32x4*)(p.in[I_FNG] + j * 256 + lane * 4); *(f32x4*)(orow + j * 256 + lane * 4) = x[j] * rinv * gv; }
        }
    }
}

constexpr int NPH_LAYER = 13, NPH = 2 + 2 * NPH_LAYER;
__global__ void __launch_bounds__(512, 2) fwd(Params p) {
    extern __shared__ __attribute__((aligned(16))) unsigned char lds_raw[];
    LAS unsigned char* lds = (LAS unsigned char*)lds_raw;
    volatile LAS unsigned* MISC = (volatile LAS unsigned*)(lds + LDS_MISC);
    if (threadIdx.x < 16) MISC[threadIdx.x] = 0u;
    __syncthreads();
    unsigned char* ws = p.ws;
    const int lo = p.ph_lo, hi = p.ph_hi;
    XcdBarrier bar; bar.bar = (unsigned*)(ws + WS_CTL); bar.x = 0; bar.st = MISC;
    if (hi - lo > 1) bar = xcd_barrier_post((unsigned*)(ws + WS_CTL), MISC);
    const int G = gridDim.x, c = blockIdx.x;
#ifndef NCONV_A
#define NCONV_A 48
#endif
#ifndef NCONV_G
#define NCONV_G 48
#endif
#ifndef NCONV_K
#define NCONV_K 32
#endif
    const int nconv = (G == 256) ? 1 : 0;
    const int GgA = G - nconv * NCONV_A, GgG = G - nconv * NCONV_G, GgK = G - nconv * NCONV_K;
#ifndef ONLY_PH
#define ONLY_PH -1
#endif
#define PSEL(id) (ONLY_PH < 0 || ONLY_PH == (id))
#ifndef DUP
#define DUP 0
#endif
#define NREP(id) ((((DUP) >> (id)) & 1) ? 2 : 1)
#define REPLOOP(id) for (int rep_ = 0; rep_ < NREP(id); ++rep_)
#define REPBAR(id) do { if (rep_ + 1 < NREP(id)) xcd_barrier(bar); } while (0)
#define IN(k) (lo <= (k) && (k) < hi)
#define SEAM(k) do { if (IN(k) && IN((k) + 1)) xcd_barrier(bar); } while (0)

    if (PSEL(0) && IN(0)) REPLOOP(0) { ph_prologue(p, lds); __syncthreads(); REPBAR(0); }
    SEAM(0);
    if (PSEL(1) && IN(1)) REPLOOP(1) { ph_norm1_tables(p); REPBAR(1); }
    SEAM(1);
    for (int l = 0; l < 2; ++l) {
        const int pb = 2 + NPH_LAYER * l;
        const float* mod = (const float*)(ws + WS_MOD) + (size_t)l * 5 * 12288;
        if (PSEL(2) && IN(pb + 0)) REPLOOP(2) {
            pg8::EpiStoreBf16 E{(bf16_t*)(ws + WS_PA), INP};
            if (l == 0) { if (c >= GgA) moe_convert_while(p, lds, pb + 0, GgA);
                else { pg8::TileSched S; S.init(ws + WS_H, (bf16_t*)(ws + WS_WTIN), DM, DM, MT / 256, INP / 256, 1, 0, 0, GgA, c, 0); pg8::gemm_phase(lds, pg8::Desc{DM, DM, DM}, S, E); if (nconv) moe_mark_done(p, pb + 0); } }
            else { pg8::InSchedLast S; S.init(ws + WS_H, (bf16_t*)(ws + WS_WTIN) + (size_t)INP * DM, G, c); pg8::gemm_phase(lds, pg8::Desc{DM, DM, DM}, S, E); }
            moe_fill(p, lds, pb + 0);
         REPBAR(2); }
        SEAM(pb + 0);
        if (PSEL(3) && IN(pb + 1)) REPLOOP(3) { ph_rowsplit(p, l, lds); __syncthreads();  REPBAR(3); }
        SEAM(pb + 1);
        if (PSEL(4) && IN(pb + 2)) REPLOOP(4) {
#ifndef C_SEL
#define C_SEL 15
#endif
            if (C_SEL & 1) { pg8::TileSched S; S.init(ws + WS_QA, (bf16_t*)(ws + WS_WTUQ) + (size_t)l * 768 * 384, 384, 384, (l == 0 ? MT : NLAT) / 256, 3, 1, 0, 0, G, c, 0);
              pg8::EpiQ E{(bf16_t*)(ws + WS_QB), (const f32x2*)(ws + WS_ROPE)}; pg8::gemm_phase(lds, pg8::Desc{384, 384, 384}, S, E); }
            if (C_SEL & 2) { pg8::TileSched S; S.init(ws + WS_KVA, (bf16_t*)(ws + WS_WTUKV) + (size_t)l * 1024 * 256, 256, 256, MT / 256, 2, 1, 0, 0, G, c, 112);
              pg8::EpiK E{(bf16_t*)(ws + WS_KC)}; pg8::gemm_phase(lds, pg8::Desc{256, 256, 256}, S, E); }
            if (C_SEL & 4) { pg8::TileSched S; S.init((bf16_t*)(ws + WS_WTUKV) + (size_t)l * 1024 * 256 + 512 * 256, ws + WS_KVA, 256, 256, 2, MT / 256, 1, 0, 0, G, c, 184);
              pg8::EpiV E{(bf16_t*)(ws + WS_VT)}; pg8::gemm_phase(lds, pg8::Desc{256, 256, 256}, S, E); }
            if (C_SEL & 8) { pg8::TileSched S; S.init(ws + WS_UPK, (bf16_t*)(ws + WS_WST) + (size_t)l * 32 * 256 * 256, 512, 256, 3, 1, 32, (size_t)768 * 512 * 2, (size_t)256 * 256 * 2, G, c, 0);
              pg8::EpiS1 E{(float*)(ws + WS_EST)}; pg8::gemm_phase(lds, pg8::Desc{512, 256, 256}, S, E); }
            moe_fill(p, lds, pb + 2);
         REPBAR(4); }
        SEAM(pb + 2);
        if (PSEL(5) && IN(pb + 3)) REPLOOP(5) { ph_attn_carry(p, l, lds); __syncthreads();  REPBAR(5); }
        SEAM(pb + 3);
        if (PSEL(6) && IN(pb + 4)) REPLOOP(6) {
            pg8::TileSched S; S.init(ws + WS_UPK, (bf16_t*)(ws + WS_G2B) + (size_t)l * 32 * 256 * 512, 512, 512, 3, 1, 32, (size_t)768 * 512 * 2, (size_t)256 * 512 * 2, G, c, 0);
            pg8::EpiS2 E{(bf16_t*)(ws + WS_GB)}; pg8::gemm_phase(lds, pg8::Desc{512, 512, 512}, S, E);
            moe_fill(p, lds, pb + 4);
         REPBAR(6); }
        SEAM(pb + 4);
        if (PSEL(7) && IN(pb + 5)) REPLOOP(7) {
            pg8::TileSched S; S.init(ws + WS_GB, (bf16_t*)(ws + WS_WTGLU) + (size_t)l * 512 * 512, 512, 512, (l == 0 ? MT : NLAT) / 256, 2, 1, 0, 0, G, c, 0);
            pg8::EpiGlu E{(const bf16_t*)(ws + WS_GB), p.in[I_BGLU] + l * 512, (bf16_t*)(ws + WS_CAT)}; pg8::gemm_phase(lds, pg8::Desc{512, 512, 512}, S, E);
            moe_fill(p, lds, pb + 5);
         REPBAR(7); }
        SEAM(pb + 5);
        if (PSEL(8) && IN(pb + 6)) REPLOOP(8) {
            pg8::TileSched S; S.init(ws + WS_CAT, (bf16_t*)(ws + WS_WTOUT) + (size_t)l * DM * DM, DM, DM, (l == 0 ? MT : NLAT) / 256, DM / 256, 1, 0, 0, l == 0 ? GgG : G, c, 0);
            pg8::EpiOut E{p.in[I_X], p.in[I_CTX], l == 0 ? (const bf16_t*)nullptr : (const bf16_t*)(ws + WS_XA), mod + 2 * DM, (bf16_t*)(ws + WS_XB)};
            if (l == 0 && c >= GgG) moe_convert_while(p, lds, pb + 6, GgG); else { pg8::gemm_phase(lds, pg8::Desc{DM, DM, DM}, S, E); if (l == 0 && nconv) moe_mark_done(p, pb + 6); }
            moe_fill(p, lds, pb + 6);
         REPBAR(8); }
        SEAM(pb + 6);
        if (PSEL(9) && IN(pb + 7)) REPLOOP(9) { ph_norm2_router(p, l, lds); __syncthreads(); REPBAR(9); }
        SEAM(pb + 7);
        if (PSEL(10) && IN(pb + 8)) REPLOOP(10) { ph_topk(p, l, lds); __syncthreads(); moe_require(p, lds, l * Q_LAYER + Q_GU);  REPBAR(10); }
        if (PSEL(11) && IN(pb + 9)) REPLOOP(11) { }
        SEAM(pb + 9);
        if (PSEL(12) && IN(pb + 10)) REPLOOP(12) {
            pg8::MoeSched S; S.init(ws + WS_H, (bf16_t*)(ws + WS_WTGU) + (size_t)l * NE * 2048 * DM, DM, DM, l == 0 ? 5 : 4, 8, 0, (size_t)2048 * DM * 2, l == 0 ? GgK : G, c);
            pg8::EpiGU E{(bf16_t*)(ws + WS_HID)};
            if (l == 0 && c >= GgK) moe_convert_while(p, lds, pb + 10, GgK); else { pg8::gemm_phase<pg8::EpiGU, pg8::MoeSched, true>(lds, pg8::Desc{DM, DM, DM}, S, E, (const int*)(ws + WS_ROWTOK), l == 0 ? 1152 : 1024); if (l == 0 && nconv) moe_mark_done(p, pb + 10); }
            moe_require(p, lds, (l + 1) * Q_LAYER); moe_fill(p, lds, pb + 10);
         REPBAR(12); }
        SEAM(pb + 10);
        if (PSEL(13) && IN(pb + 11)) REPLOOP(13) {
            pg8::MoeSched S; S.init(ws + WS_HID, (bf16_t*)(ws + WS_WTDN) + (size_t)l * NE * DM * FF, FF, FF, l == 0 ? 5 : 4, 8, (size_t)EROWS * FF * 2, (size_t)DM * FF * 2, l == 0 ? GgK : G, c);
            pg8::EpiDown E{(bf16_t*)(ws + WS_YS), (const float*)(ws + WS_ROWAFF)};
            if (l == 0 && c >= GgK) moe_convert_while(p, lds, pb + 11, GgK); else { pg8::gemm_phase(lds, pg8::Desc{FF, FF, FF}, S, E); if (l == 0 && nconv) moe_mark_done(p, pb + 11); }
            moe_fill(p, lds, pb + 11);
         REPBAR(13); }
        SEAM(pb + 11);
        if (PSEL(14) && IN(pb + 12)) REPLOOP(14) { ph_combine(p, l);  REPBAR(14); }
        SEAM(pb + 12);
    }
#undef IN
#undef SEAM
}

extern "C" void kernel_launch(void* const* d_in, const int* in_sizes, int n_in, void* d_out, int out_size, void* d_ws, size_t ws_size, hipStream_t stream) {
    static int grid = 0;
    if (grid == 0) {
        if (n_in != 33 || ws_size < WS_END) { fprintf(stderr, "kernel_launch: need 33 inputs and >= %zu bytes of workspace; got %d, %zu\n", (size_t)WS_END, n_in, ws_size); grid = -1; return; }
        int dev = 0, cus = 0;
        if (hipGetDevice(&dev) != hipSuccess || hipDeviceGetAttribute(&cus, hipDeviceAttributeMultiprocessorCount, dev) != hipSuccess) { grid = -1; return; }
        if (hipFuncSetAttribute((const void*)fwd, hipFuncAttributeMaxDynamicSharedMemorySize, LDS_BYTES) != hipSuccess) { fprintf(stderr, "kernel_launch: hipFuncSetAttribute failed\n"); grid = -1; return; }
        (void)hipGetLastError();
        grid = cus > 256 ? 256 : cus;
    }
    if (grid < 0) return;
    (void)hipMemsetAsync((char*)d_ws + WS_CTL, 0, CTL_BYTES, stream);
    Params a{};
    for (int i = 0; i < 33; ++i) a.in[i] = (const float*)d_in[i];
    a.out = (float*)d_out; a.ws = (unsigned char*)d_ws;
#if MK_SPLIT
    for (int ph = 0; ph < NPH; ++ph) { a.ph_lo = ph; a.ph_hi = ph + 1; hipLaunchKernelGGL(fwd, dim3(grid), dim3(512), LDS_BYTES, stream, a); }
#else
    a.ph_lo = 0; a.ph_hi = NPH; hipLaunchKernelGGL(fwd, dim3(grid), dim3(512), LDS_BYTES, stream, a);
#endif
}
```

```cpp
#include <hip/hip_runtime.h>
#include <cstdint>
#include <cstdio>

#ifndef MK_SPLIT
#define MK_SPLIT 0
#endif

#define LAS __attribute__((address_space(3)))
typedef unsigned short bf16_t;
typedef short bf16x8 __attribute__((ext_vector_type(8)));
typedef short bf16x4 __attribute__((ext_vector_type(4)));
typedef float f32x4 __attribute__((ext_vector_type(4)));
typedef float f32x2 __attribute__((ext_vector_type(2)));
typedef unsigned u32x4 __attribute__((ext_vector_type(4)));
typedef unsigned u32x2 __attribute__((ext_vector_type(2)));
typedef float f32x16 __attribute__((ext_vector_type(16)));

constexpr int DM = 2048, NB = 4, SEQ = 2048, CTX = 256, NLAT = NB * SEQ, NCTX = NB * CTX, MT = NLAT + NCTX;
constexpr int INC = 3776, INP = 3840;
constexpr int C_SGU_U = 0, C_SGU_V = 512, C_CQ = 1024, C_CKV = 1408, C_KR = 1664, C_S5 = 1728, C_CVB = 2240, C_CVC = 2752, C_CVH = 3264;
constexpr int NKEY = CTX + SEQ;
constexpr int NE = 16, FF = 1024, CAPL = 256, CAPC = 32, EROWS = 1280;
constexpr int NCHUNK = MT / 16;
constexpr float EPS = 1e-6f;
constexpr float QSCALE = 0.07216878364870322f * 1.4426950408889634f;

constexpr size_t al256(size_t x) { return (x + 255) & ~(size_t)255; }
constexpr size_t WS_CTL = 0;
constexpr size_t CTL_BYTES = 65536;
constexpr size_t WS_MOD = WS_CTL + CTL_BYTES;
constexpr size_t WS_WTIN = al256(WS_MOD + (size_t)2 * 5 * 12288 * 4);
constexpr size_t WS_WTOUT = al256(WS_WTIN + (size_t)2 * INP * DM * 2);
constexpr size_t WS_WTUQ = al256(WS_WTOUT + (size_t)2 * DM * DM * 2);
constexpr size_t WS_WTUKV = al256(WS_WTUQ + (size_t)2 * 768 * 384 * 2);
constexpr size_t WS_WTGLU = al256(WS_WTUKV + (size_t)2 * 1024 * 256 * 2);
constexpr size_t WS_WTGU = al256(WS_WTGLU + (size_t)2 * 512 * 512 * 2);
constexpr size_t WS_WTDN = al256(WS_WTGU + (size_t)2 * NE * 2048 * DM * 2);
constexpr size_t WS_PW = al256(WS_WTDN + (size_t)2 * NE * DM * FF * 2);
constexpr size_t WS_BB = al256(WS_PW + (size_t)2 * 2 * 32 * 64 * 17 * 8);
constexpr size_t WS_KZ = al256(WS_BB + (size_t)2 * 2 * 32 * 64 * 16 * 8);
constexpr size_t WS_WST = al256(WS_KZ + (size_t)2 * 2 * 32 * 4096 * 4);
constexpr size_t WS_G2B = al256(WS_WST + (size_t)2 * 32 * 256 * 256 * 2);
constexpr size_t WS_H = al256(WS_G2B + (size_t)2 * 32 * 256 * 512 * 2);
constexpr size_t WS_PA = al256(WS_H + (size_t)MT * DM * 2);
constexpr size_t PA_BYTES = (size_t)NE * EROWS * DM * 2;
static_assert(PA_BYTES >= (size_t)MT * INP * 2, "P fits in the union");
constexpr size_t WS_XA = al256(WS_PA + PA_BYTES);
constexpr size_t WS_XB = al256(WS_XA + (size_t)MT * DM * 4);
constexpr size_t WS_CAT = al256(WS_XB + (size_t)MT * DM * 4);
constexpr size_t WS_QA = al256(WS_CAT + (size_t)MT * DM * 2);
constexpr size_t WS_KVA = al256(WS_QA + (size_t)MT * 384 * 2);
constexpr size_t WS_QB = al256(WS_KVA + (size_t)MT * 256 * 2);
constexpr size_t WS_KC = al256(WS_QB + (size_t)MT * 768 * 2);
constexpr size_t WS_VT = al256(WS_KC + (size_t)NB * 4 * NKEY * 192 * 2);
constexpr size_t WS_UPK = al256(WS_VT + (size_t)NB * 4 * 128 * NKEY * 2);
constexpr size_t WS_EST = al256(WS_UPK + (size_t)32 * 768 * 512 * 2);
constexpr size_t WS_GB = al256(WS_EST + (size_t)32 * 768 * 256 * 4);
constexpr size_t WS_AFF = al256(WS_GB + (size_t)MT * 512 * 2);
constexpr size_t WS_ROWTOK = al256(WS_AFF + (size_t)MT * 16 * 4);
constexpr size_t WS_ROWAFF = al256(WS_ROWTOK + (size_t)NE * EROWS * 4);
constexpr size_t WS_INV = al256(WS_ROWAFF + (size_t)NE * EROWS * 4);
constexpr size_t WS_HID = al256(WS_INV + (size_t)MT * 16 * 4);
constexpr size_t WS_YS = al256(WS_HID + (size_t)NE * EROWS * FF * 2);
constexpr size_t WS_ROPE = al256(WS_YS + (size_t)NE * EROWS * DM * 2);
constexpr size_t WS_A16 = al256(WS_ROPE + 64 * 16 * 8);
constexpr size_t WS_END = al256(WS_A16 + (size_t)2 * 2 * 32 * 64 * 8);

constexpr int LDS_GEMM = 131072;
constexpr int LDS_ATTN = 3 * 44032;
constexpr int LDS_MISC = 133120;
constexpr int LDS_BYTES = LDS_MISC + 256;
static_assert(LDS_ATTN <= LDS_MISC && LDS_GEMM <= LDS_MISC, "LDS map");

typedef __bf16 bf16x2_t __attribute__((ext_vector_type(2)));
__device__ __forceinline__ unsigned cvt_pk_bf16(float lo, float hi) { const f32x2 v = {lo, hi}; const bf16x2_t b = __builtin_convertvector(v, bf16x2_t); return __builtin_bit_cast(unsigned, b); }
__device__ __forceinline__ float bf2f(unsigned short b) { return __uint_as_float(((unsigned)b) << 16); }
__device__ __forceinline__ float bflo(unsigned w) { return __uint_as_float(w << 16); }
__device__ __forceinline__ float bfhi(unsigned w) { return __uint_as_float(w & 0xffff0000u); }
__device__ __forceinline__ unsigned short f2bf(float f) { return (unsigned short)(cvt_pk_bf16(f, 0.f) & 0xffffu); }
__device__ __forceinline__ int opaque_tid() { int t = threadIdx.x; asm volatile("" : "+v"(t)); return t; }
__device__ __forceinline__ unsigned char* opaque_ptr(unsigned char* q) { long z = 0; asm volatile("" : "+s"(z)); return q + z; }
__device__ __forceinline__ float wave_sum(float v) {
#pragma unroll
    for (int o = 32; o >= 1; o >>= 1) v += __shfl_xor(v, o);
    return v;
}
__device__ __forceinline__ float gelu_tanh(float x) {
    const float y = x * (-2.3022081986679503f - 0.10294324069457f * x * x);
    return x * __builtin_amdgcn_rcpf(1.0f + __builtin_amdgcn_exp2f(y));
}
__device__ __forceinline__ float silu_f(float x) { return x * __builtin_amdgcn_rcpf(1.0f + __builtin_amdgcn_exp2f(-1.4426950408889634f * x)); }
__device__ __forceinline__ float sigmoid_f(float x) { return __builtin_amdgcn_rcpf(1.0f + __builtin_amdgcn_exp2f(-1.4426950408889634f * x)); }

#define XB_TMO      128
#define XB_XCNT(j)  (256  + 64 * (j))
#define XB_XSUB(j)  (1280 + 64 * (j))
#define XB_XGEN(j)  (2304 + 64 * (j))
#define XB_TOP      3328
#define XB_TOPGEN   3392
#define XCD_BAR_WORDS 3456
#define XB_SPIN_CAP (1u << 22)
__device__ __forceinline__ unsigned xb_ld(unsigned* p)              { return __hip_atomic_load(p, __ATOMIC_RELAXED, __HIP_MEMORY_SCOPE_AGENT); }
__device__ __forceinline__ unsigned xb_add(unsigned* p, unsigned v) { return __hip_atomic_fetch_add(p, v, __ATOMIC_RELAXED, __HIP_MEMORY_SCOPE_AGENT); }
__device__ __forceinline__ unsigned xb_xcc_id() { return (unsigned)__builtin_amdgcn_s_getreg((3 << 11) | 20) & 0xFu; }
#define XB_SPIN(cond, bar) do { unsigned _sp = 0; while (cond) { __builtin_amdgcn_s_sleep(1); \
    if ((++_sp & 255u) == 0u) { if (xb_ld(&(bar)[XB_TMO])) break; if (_sp > XB_SPIN_CAP) { atomicAdd(&(bar)[XB_TMO], 1u); break; } } } } while (0)
struct XcdBarrier { unsigned* bar; unsigned x; volatile LAS unsigned* st; };
__device__ __forceinline__ XcdBarrier xcd_barrier_post(unsigned* bar, volatile LAS unsigned* st) {
    XcdBarrier b; b.bar = bar; b.x = xb_xcc_id(); b.st = st;
    if (threadIdx.x == 0) (void)xb_add(&bar[XB_XCNT(b.x)], 1u);
    return b;
}
__device__ __forceinline__ void xcd_barrier_complete(unsigned* bar, unsigned x, unsigned& nloc, unsigned& nx) {
    const unsigned G = gridDim.x * gridDim.y * gridDim.z;
    unsigned sum, cnt, mine, sp = 0u;
    for (;;) {
        sum = 0u; cnt = 0u; mine = 0u;
#pragma unroll
        for (unsigned j = 0; j < 16; ++j) { const unsigned c = xb_ld(&bar[XB_XCNT(j)]); sum += c; cnt += (c > 0u) ? 1u : 0u; mine = (j == x) ? c : mine; }
        if (sum == G) break;
        __builtin_amdgcn_s_sleep(1);
        if ((++sp & 255u) == 0u) { if (xb_ld(&bar[XB_TMO])) break; if (sp > XB_SPIN_CAP) { atomicAdd(&bar[XB_TMO], 1u); break; } }
    }
    nloc = mine > 0u ? mine : 1u; nx = cnt > 0u ? cnt : 1u;
}
__device__ __forceinline__ void xcd_barrier(const XcdBarrier& b) {
    asm volatile("s_waitcnt vmcnt(0)" ::: "memory");
    __syncthreads();
    if (threadIdx.x == 0) {
        unsigned* bar = b.bar;
        __builtin_amdgcn_s_waitcnt(0);
        unsigned nloc = b.st[0], nx = b.st[1];
        if (nloc == 0u) { xcd_barrier_complete(bar, b.x, nloc, nx); b.st[0] = nloc; b.st[1] = nx; }
        const unsigned old = xb_add(&bar[XB_XSUB(b.x)], 1u);
        const unsigned gen = old / nloc;
        if (old + 1u == (gen + 1u) * nloc) {
            __builtin_amdgcn_fence(__ATOMIC_RELEASE, "agent");
            asm volatile("s_waitcnt vmcnt(0)" ::: "memory");
            const unsigned og = xb_add(&bar[XB_TOP], 1u);
            const unsigned tg = og / nx;
            if (og + 1u == (tg + 1u) * nx) xb_add(&bar[XB_TOPGEN], 1u);
            else XB_SPIN(xb_ld(&bar[XB_TOPGEN]) == tg, bar);
            __builtin_amdgcn_fence(__ATOMIC_ACQUIRE, "agent");
            xb_add(&bar[XB_XGEN(b.x)], 1u);
            asm volatile("s_waitcnt vmcnt(0)" ::: "memory");
        } else {
            XB_SPIN(xb_ld(&bar[XB_XGEN(b.x)]) == gen, bar);
            __builtin_amdgcn_fence(__ATOMIC_ACQUIRE, "agent");
            asm volatile("s_waitcnt vmcnt(0)" ::: "memory");
        }
    }
    __syncthreads();
}

namespace pg8 {
constexpr int BM = 256, BK = 64, HALF = 128, HTB = HALF * BK * 2, STAGE_BYTES = 8 * HTB;
__host__ __device__ __forceinline__ int lds_byte(int r, int c) { const int st = (r >> 4) * 2 + (c >> 5), rr = r & 15, cc = c & 31, ob = rr * 64 + cc * 2; return st * 1024 + (ob ^ (((ob >> 9) & 1) << 5)); }
__host__ __device__ __forceinline__ void stage_rc(int b, int& R, int& C) { const int st = b / 1024, sb = b % 1024, swz = sb ^ (((sb >> 9) & 1) << 5); R = (st >> 1) * 16 + swz / 64; C = (st & 1) * 32 + (swz % 64) / 2; }
__host__ __device__ __forceinline__ int perm32(int rho) { const int n = rho >> 4, i = rho & 15; return 8 * (i >> 2) + 4 * n + (i & 3); }

struct Unit { const char* a; const char* b; int pm, pn, pb; };
struct Desc { int lda, ldb, K; };

struct TileSched {
    const char* A; const char* B; size_t sA, sB;
    int lda, ldb, nM, nN, nB, G, c;
    __device__ __forceinline__ void init(const void* A_, const void* B_, int lda_, int ldb_, int nM_, int nN_, int nB_, size_t sA_, size_t sB_, int G_, int c_, int off) {
        A = (const char*)A_; B = (const char*)B_; lda = lda_; ldb = ldb_; nM = nM_; nN = nN_; nB = nB_; sA = sA_; sB = sB_; G = G_; c = (c_ + G_ - (off % G_)) % G_; }
    __device__ __forceinline__ bool next(int i, Unit& u) const {
        const int nwg = nM * nN; const long L = (long)i * G + c; if (L >= (long)nwg * nB) return false;
        const int pb = (int)(L / nwg); int wgid = (int)(L % nwg);
        { const int q = nwg / 8, r = nwg % 8, xcd = wgid % 8, off = wgid / 8; wgid = (xcd < r ? xcd * (q + 1) : r * (q + 1) + (xcd - r) * q) + off; }
        const int nig = 8 * nN, gid = wgid / nig, fm = gid * 8, gsz = (nM - fm) < 8 ? (nM - fm) : 8;
        u.pm = fm + ((wgid % nig) % gsz); u.pn = (wgid % nig) / gsz; u.pb = pb;
        u.a = A + (size_t)pb * sA + (size_t)u.pm * 256 * lda * 2; u.b = B + (size_t)pb * sB + (size_t)u.pn * 256 * ldb * 2; return true;
    }
};
struct InSchedLast {
    TileSched T;
    __device__ __forceinline__ void init(const void* A_, const void* B_, int G_, int c_) { T.init(A_, B_, DM, DM, NLAT / 256, INP / 256, 1, 0, 0, G_, c_, 0); }
    __device__ __forceinline__ bool next(int i, Unit& u) const {
        const int nlat = (NLAT / 256) * (INP / 256); const long L = (long)i * T.G + T.c;
        if (L < nlat) return T.next(i, u);
        if (L >= nlat + 16) return false;
        const int k = (int)(L - nlat); u.pm = NLAT / 256 + (k >> 2); u.pn = 5 + (k & 3); u.pb = 0;
        u.a = T.A + (size_t)u.pm * 256 * DM * 2; u.b = T.B + (size_t)u.pn * 256 * DM * 2; return true;
    }
};
struct MoeSched {
    const char* A; const char* B; size_t sA, sB; int lda, ldb, nM, nN, G, c;
    __device__ __forceinline__ void init(const void* A_, const void* B_, int lda_, int ldb_, int nM_, int nN_, size_t sA_, size_t sB_, int G_, int c_) {
        A = (const char*)A_; B = (const char*)B_; lda = lda_; ldb = ldb_; nM = nM_; nN = nN_; sA = sA_; sB = sB_; G = G_; c = c_; }
    __device__ __forceinline__ bool next(int i, Unit& u) const {
        int e, rem; const int per = nM * nN;
        if ((G & 7) == 0) { const int x = c & 7, j = c >> 3, w = G >> 3; const int L = i * w + j; if (L >= 2 * per) return false; e = 2 * x + L / per; rem = L % per; }
        else { const long L = (long)i * G + c; if (L >= (long)NE * per) return false; e = (int)(L / per); rem = (int)(L % per); }
        u.pn = rem / nM; u.pm = rem % nM; u.pb = e;
        u.a = sA == 0 ? A : A + (size_t)e * sA + (size_t)u.pm * 256 * lda * 2; u.b = B + (size_t)e * sB + (size_t)u.pn * 256 * ldb * 2; return true;
    }
};

template <class Epi, class Sched, bool GATHER = false>
__device__ __forceinline__ void gemm_phase(LAS unsigned char* lds, const Desc g, const Sched& S, const Epi& E, const int* rowtok = nullptr, int nvalid = 0) {
    const int tid = opaque_tid(), wid = __builtin_amdgcn_readfirstlane(tid >> 6), lane = tid & 63, wr = wid >> 2, wc = wid & 3, fr = lane & 15, fq = lane >> 4;
    const int K = g.K, nt = K / BK;
    unsigned voffA[2], voffB[2]; int gR[2], gCc[2];
#pragma unroll
    for (int i = 0; i < 2; ++i) { int R, C; stage_rc(tid * 16 + i * 8192, R, C); const int Rb = Epi::PERM ? ((R & ~31) + perm32(R & 31)) : R;
        voffA[i] = (unsigned)(R * g.lda + C) * 2u; voffB[i] = (unsigned)(Rb * g.ldb + C) * 2u; gR[i] = R; gCc[i] = C; }
    unsigned gC[2][2], gN[2][2];
#define PG8_GOFF(u, o) do { _Pragma("unroll") for (int _h = 0; _h < 2; ++_h) _Pragma("unroll") for (int _i = 0; _i < 2; ++_i) { const int _r = (u).pm * 256 + _h * 128 + gR[_i]; \
        const int _tok = _r < nvalid ? rowtok[(u).pb * EROWS + _r] : 0; (o)[_h][_i] = (unsigned)(_tok * g.lda + gCc[_i]) * 2u; } } while (0)
    const size_t kstep = (size_t)(BK * 2);
    const size_t hstepA = (size_t)HALF * g.lda * 2, hstepB = (size_t)HALF * g.ldb * 2;
    const unsigned ldsw = (unsigned)wid * 1024u;
    const int aoff = lds_byte(wr * 64 + fr, fq * 8), boff = lds_byte(wc * 32 + fr, fq * 8);
#define PG8_SA(b, h) (((b) * 2 + (h)) * HTB)
#define PG8_SB(b, h) ((4 + (b) * 2 + (h)) * HTB)
#define PG8_STAGE(bufoff, gbase, voff) do { _Pragma("unroll") for (int _i = 0; _i < 2; ++_i) \
        __builtin_amdgcn_global_load_lds((const unsigned*)((const char*)(gbase) + (voff)[_i]), (LAS unsigned*)(lds + (bufoff) + ldsw + _i * 8192), 16, 0, 0); } while (0)
#define PG8_STAGE_A(bufoff, kptr, half, VO) do { if constexpr (GATHER) { _Pragma("unroll") for (int _i = 0; _i < 2; ++_i) \
        __builtin_amdgcn_global_load_lds((const unsigned*)((const char*)(kptr) + (VO)[half][_i]), (LAS unsigned*)(lds + (bufoff) + ldsw + _i * 8192), 16, 0, 0); } \
        else { PG8_STAGE(bufoff, (kptr) + (half) * hstepA, voffA); } } while (0)
#define PG8_LDA(dst, b, h) do { _Pragma("unroll") for (int m = 0; m < 4; ++m) _Pragma("unroll") for (int k = 0; k < 2; ++k) dst[m][k] = *(const LAS bf16x8*)(lds + PG8_SA(b, h) + aoff + m * 2048 + k * 1024); } while (0)
#define PG8_LDB(dst, b, h) do { _Pragma("unroll") for (int n = 0; n < 2; ++n) _Pragma("unroll") for (int k = 0; k < 2; ++k) dst[n][k] = *(const LAS bf16x8*)(lds + PG8_SB(b, h) + boff + n * 2048 + k * 1024); } while (0)
#define PG8_MMA(ai, bj, At, Bt) do { __builtin_amdgcn_s_setprio(1); _Pragma("unroll") for (int m = 0; m < 4; ++m) _Pragma("unroll") for (int n = 0; n < 2; ++n) _Pragma("unroll") for (int k = 0; k < 2; ++k) \
        acc[ai][bj][m][n] = __builtin_amdgcn_mfma_f32_16x16x32_bf16(Bt[n][k], At[m][k], acc[ai][bj][m][n], 0, 0, 0); __builtin_amdgcn_s_setprio(0); } while (0)
#define PG8_WAIT_V(n) asm volatile("s_waitcnt vmcnt(" #n ")" ::: "memory")
#define PG8_WAIT_L(n) asm volatile("s_waitcnt lgkmcnt(" #n ")" ::: "memory")
#define PG8_BAR __builtin_amdgcn_s_barrier()
#define PG8_SCHED __builtin_amdgcn_sched_barrier(0)
    Unit cur, nxt; int ui = 0;
    if (!S.next(0, cur)) return;
    f32x4 acc[2][2][4][2];
#pragma unroll
    for (int a = 0; a < 2; ++a)
#pragma unroll
        for (int b = 0; b < 2; ++b)
#pragma unroll
            for (int m = 0; m < 4; ++m)
#pragma unroll
                for (int n = 0; n < 2; ++n) acc[a][b][m][n] = (f32x4){0.f, 0.f, 0.f, 0.f};
    bf16x8 At[4][2], B0[2][2], B1[2][2];
    const char* cA = cur.a; const char* cB = cur.b;
    if constexpr (GATHER) { PG8_GOFF(cur, gC); }
    PG8_STAGE(PG8_SB(0, 0), cB, voffB); PG8_STAGE_A(PG8_SA(0, 0), cA, 0, gC); PG8_STAGE(PG8_SB(0, 1), cB + hstepB, voffB); PG8_STAGE_A(PG8_SA(0, 1), cA, 1, gC);
    if (wr == 1) PG8_BAR;
    PG8_WAIT_V(4); PG8_BAR;
    PG8_STAGE(PG8_SB(1, 0), cB + kstep, voffB); PG8_STAGE_A(PG8_SA(1, 0), cA + kstep, 0, gC); PG8_STAGE(PG8_SB(1, 1), cB + hstepB + kstep, voffB);
    PG8_WAIT_V(6); PG8_BAR;
    for (;;) {
        const bool has_next = S.next(ui + 1, nxt);
        const char* nA = has_next ? nxt.a : cA; const char* nB = has_next ? nxt.b : cB;
        if constexpr (GATHER) { if (has_next) { PG8_GOFF(nxt, gN); } else {
#pragma unroll
            for (int _h = 0; _h < 2; ++_h)
#pragma unroll
                for (int _i = 0; _i < 2; ++_i) gN[_h][_i] = gC[_h][_i]; } }
#pragma nounroll
        for (int t = 0; t < nt; t += 2) {
            const bool last = (t == nt - 2);
            const char* a1 = cA + (size_t)(t + 1) * kstep;
            const char* a2 = last ? nA : cA + (size_t)(t + 2) * kstep; const char* b2 = last ? nB : cB + (size_t)(t + 2) * kstep;
            const char* a3 = a2 + kstep; const char* b3 = b2 + kstep;
            unsigned g2[2][2];
            if constexpr (GATHER) {
#pragma unroll
                for (int _h = 0; _h < 2; ++_h)
#pragma unroll
                    for (int _i = 0; _i < 2; ++_i) g2[_h][_i] = last ? gN[_h][_i] : gC[_h][_i]; }
            PG8_LDB(B0, 0, 0); PG8_SCHED; PG8_LDA(At, 0, 0); PG8_STAGE_A(PG8_SA(1, 1), a1, 1, gC);
            PG8_WAIT_L(8); PG8_BAR; PG8_WAIT_L(0); PG8_MMA(0, 0, At, B0); PG8_BAR; PG8_SCHED;
            PG8_LDB(B1, 0, 1); PG8_STAGE(PG8_SB(0, 0), b2, voffB);
            PG8_BAR; PG8_WAIT_L(0); PG8_MMA(0, 1, At, B1); PG8_BAR;
            PG8_LDA(At, 0, 1); PG8_STAGE_A(PG8_SA(0, 0), a2, 0, g2);
            PG8_BAR; PG8_WAIT_L(0); PG8_MMA(1, 0, At, B0); PG8_BAR; PG8_SCHED;
            PG8_STAGE(PG8_SB(0, 1), b2 + hstepB, voffB);
            PG8_WAIT_V(6); PG8_BAR; PG8_MMA(1, 1, At, B1); PG8_BAR;
            PG8_LDB(B0, 1, 0); PG8_SCHED; PG8_LDA(At, 1, 0); PG8_STAGE_A(PG8_SA(0, 1), a2, 1, g2);
            PG8_WAIT_L(8); PG8_BAR; PG8_WAIT_L(0); PG8_MMA(0, 0, At, B0); PG8_BAR; PG8_SCHED;
            PG8_LDB(B1, 1, 1); PG8_STAGE(PG8_SB(1, 0), b3, voffB);
            PG8_BAR; PG8_WAIT_L(0); PG8_MMA(0, 1, At, B1); PG8_BAR;
            PG8_LDA(At, 1, 1); PG8_STAGE_A(PG8_SA(1, 0), a3, 0, g2);
            PG8_BAR; PG8_WAIT_L(0); PG8_MMA(1, 0, At, B0); PG8_BAR; PG8_SCHED;
            PG8_STAGE(PG8_SB(1, 1), b3 + hstepB, voffB);
            PG8_WAIT_V(6); PG8_BAR; PG8_MMA(1, 1, At, B1); PG8_BAR;
        }
        E(acc, cur, wr, wc, fr, fq);
        if (!has_next) break;
#pragma unroll
        for (int a = 0; a < 2; ++a)
#pragma unroll
            for (int b = 0; b < 2; ++b)
#pragma unroll
                for (int m = 0; m < 4; ++m)
#pragma unroll
                    for (int n = 0; n < 2; ++n) acc[a][b][m][n] = (f32x4){0.f, 0.f, 0.f, 0.f};
        cur = nxt; cA = nA; cB = nB; ++ui;
        if constexpr (GATHER) {
#pragma unroll
            for (int _h = 0; _h < 2; ++_h)
#pragma unroll
                for (int _i = 0; _i < 2; ++_i) gC[_h][_i] = gN[_h][_i]; }
    }
    PG8_WAIT_V(0);
    if (wr == 0) PG8_BAR;
    PG8_BAR;
#undef PG8_SA
#undef PG8_SB
#undef PG8_STAGE
#undef PG8_STAGE_A
#undef PG8_GOFF
#undef PG8_LDA
#undef PG8_LDB
#undef PG8_MMA
#undef PG8_WAIT_V
#undef PG8_WAIT_L
#undef PG8_BAR
#undef PG8_SCHED
}

#define PG8_FOR_PERM(...) \
    _Pragma("unroll") for (int ai = 0; ai < 2; ++ai) _Pragma("unroll") for (int m = 0; m < 4; ++m) { const int tr = ai * 128 + wr * 64 + m * 16 + fr; \
        _Pragma("unroll") for (int bj = 0; bj < 2; ++bj) { const int tc = bj * 128 + wc * 32 + 8 * fq; const f32x4 v0 = acc[ai][bj][m][0], v1 = acc[ai][bj][m][1]; __VA_ARGS__ } }
#define PG8_FOR_NOPERM(...) \
    _Pragma("unroll") for (int ai = 0; ai < 2; ++ai) _Pragma("unroll") for (int m = 0; m < 4; ++m) { const int tr = ai * 128 + wr * 64 + m * 16 + fr; \
        _Pragma("unroll") for (int bj = 0; bj < 2; ++bj) _Pragma("unroll") for (int n = 0; n < 2; ++n) { const int tc = bj * 128 + wc * 32 + 16 * n + 4 * fq; const f32x4 v = acc[ai][bj][m][n]; __VA_ARGS__ } }

typedef const f32x4 (&AccRef)[2][2][4][2];

struct EpiStoreBf16 {
    static constexpr bool PERM = true;
    bf16_t* O; int ldc;
    __device__ __forceinline__ void operator()(AccRef acc, const Unit& u, int wr, int wc, int fr, int fq) const {
        PG8_FOR_PERM({ u32x4 w; w.x = cvt_pk_bf16(v0[0], v0[1]); w.y = cvt_pk_bf16(v0[2], v0[3]); w.z = cvt_pk_bf16(v1[0], v1[1]); w.w = cvt_pk_bf16(v1[2], v1[3]);
            *(u32x4*)(O + (size_t)(u.pm * 256 + tr) * ldc + u.pn * 256 + tc) = w; })
    }
};
struct EpiQ {
    static constexpr bool PERM = false;
    bf16_t* Q; const f32x2* ROPE;
    __device__ __forceinline__ void operator()(AccRef acc, const Unit& u, int wr, int wc, int fr, int fq) const {
#pragma unroll
        for (int ai = 0; ai < 2; ++ai)
#pragma unroll
            for (int m = 0; m < 4; ++m) { const int row = u.pm * 256 + ai * 128 + wr * 64 + m * 16 + fr; const bool lat = row < NLAT; const int t = row & (SEQ - 1);
#pragma unroll
                for (int bj = 0; bj < 2; ++bj) { const int cg = u.pn * 256 + bj * 128 + wc * 32; const int dd = cg % 192; f32x4 a = acc[ai][bj][m][0], b = acc[ai][bj][m][1];
                    if (dd >= 128 && lat) { const int pos = (dd - 128) >= 32 ? (t & 63) : (t >> 6); const f32x4* rp = (const f32x4*)(ROPE + pos * 16 + 4 * fq); const f32x4 r0 = rp[0], r1 = rp[1];
                        const float cs[4] = {r0[0], r0[2], r1[0], r1[2]}, sn[4] = {r0[1], r0[3], r1[1], r1[3]};
#pragma unroll
                        for (int i = 0; i < 4; ++i) { const float x1 = a[i], x2 = b[i]; a[i] = x1 * cs[i] - x2 * sn[i]; b[i] = x2 * cs[i] + x1 * sn[i]; } }
                    a *= QSCALE; b *= QSCALE;
                    bf16_t* o = Q + (size_t)row * 768 + cg + 4 * fq;
                    u32x2 w0; w0.x = cvt_pk_bf16(a[0], a[1]); w0.y = cvt_pk_bf16(a[2], a[3]); *(u32x2*)o = w0;
                    u32x2 w1; w1.x = cvt_pk_bf16(b[0], b[1]); w1.y = cvt_pk_bf16(b[2], b[3]); *(u32x2*)(o + 16) = w1; } }
    }
};
struct EpiK {
    static constexpr bool PERM = true;
    bf16_t* KC;
    __device__ __forceinline__ void operator()(AccRef acc, const Unit& u, int wr, int wc, int fr, int fq) const {
        const int b = u.pm < 32 ? (u.pm >> 3) : (u.pm - 32), key0 = u.pm < 32 ? CTX + (u.pm & 7) * 256 : 0;
        bf16_t* base = KC + ((size_t)(b * 4 + u.pn * 2) * NKEY + key0) * 192 + (size_t)(wr * 64 + fr) * 192 + wc * 32 + 8 * fq;
#pragma unroll
        for (int ai = 0; ai < 2; ++ai)
#pragma unroll
            for (int m = 0; m < 4; ++m)
#pragma unroll
                for (int bj = 0; bj < 2; ++bj) { const f32x4 v0 = acc[ai][bj][m][0], v1 = acc[ai][bj][m][1];
                    u32x4 w; w.x = cvt_pk_bf16(v0[0], v0[1]); w.y = cvt_pk_bf16(v0[2], v0[3]); w.z = cvt_pk_bf16(v1[0], v1[1]); w.w = cvt_pk_bf16(v1[2], v1[3]);
                    *(u32x4*)(base + (size_t)(ai * 128 + m * 16) * 192 + (size_t)bj * NKEY * 192) = w; }
    }
};
struct EpiV {
    static constexpr bool PERM = true;
    bf16_t* VT;
    __device__ __forceinline__ void operator()(AccRef acc, const Unit& u, int wr, int wc, int fr, int fq) const {
        const int b = u.pn < 32 ? (u.pn >> 3) : (u.pn - 32), key0 = u.pn < 32 ? CTX + (u.pn & 7) * 256 : 0;
        bf16_t* base = VT + ((size_t)(b * 4 + u.pm * 2) * 128 + wr * 64 + fr) * NKEY + key0 + wc * 32 + 8 * fq;
#pragma unroll
        for (int ai = 0; ai < 2; ++ai)
#pragma unroll
            for (int m = 0; m < 4; ++m)
#pragma unroll
                for (int bj = 0; bj < 2; ++bj) { const f32x4 v0 = acc[ai][bj][m][0], v1 = acc[ai][bj][m][1];
                    u32x2 w0, w1; w0.x = cvt_pk_bf16(v0[0], v0[1]); w0.y = cvt_pk_bf16(v0[2], v0[3]); w1.x = cvt_pk_bf16(v1[0], v1[1]); w1.y = cvt_pk_bf16(v1[2], v1[3]);
                    bf16_t* q = base + (size_t)(ai * 128 + m * 16) * NKEY + bj * 128; const int odd = fq & 1;
                    *(u32x2*)(q + (odd ? -4 : 0)) = w0; *(u32x2*)(q + (odd ? 4 : 8)) = w1; }
    }
};
struct EpiS1 {
    static constexpr bool PERM = false;
    float* EST;
    __device__ __forceinline__ void operator()(AccRef acc, const Unit& u, int wr, int wc, int fr, int fq) const {
        PG8_FOR_NOPERM({ const int row = u.pm * 256 + tr; if (row < NCHUNK) *(f32x4*)(EST + ((size_t)u.pb * 768 + row) * 256 + tc) = v; })
    }
};
struct EpiS2 {
    static constexpr bool PERM = true;
    bf16_t* GB;
    __device__ __forceinline__ void operator()(AccRef acc, const Unit& u, int wr, int wc, int fr, int fq) const {
        PG8_FOR_PERM({ const int row = u.pm * 256 + tr; if (row < NCHUNK) { const int p = tc >> 4, c = tc & 15;
            u32x4 w; w.x = cvt_pk_bf16(gelu_tanh(v0[0]), gelu_tanh(v0[1])); w.y = cvt_pk_bf16(gelu_tanh(v0[2]), gelu_tanh(v0[3]));
            w.z = cvt_pk_bf16(gelu_tanh(v1[0]), gelu_tanh(v1[1])); w.w = cvt_pk_bf16(gelu_tanh(v1[2]), gelu_tanh(v1[3]));
            *(u32x4*)(GB + (size_t)(row * 16 + p) * 512 + u.pb * 16 + c) = w; } })
    }
};
struct EpiGlu {
    static constexpr bool PERM = true;
    const bf16_t* GB; const float* bias; bf16_t* CAT;
    __device__ __forceinline__ void operator()(AccRef acc, const Unit& u, int wr, int wc, int fr, int fq) const {
        PG8_FOR_PERM({ const int row = u.pm * 256 + tr, col = u.pn * 256 + tc;
            const u32x4 gv = *(const u32x4*)(GB + (size_t)row * 512 + col); const f32x4 b0 = *(const f32x4*)(bias + col), b1 = *(const f32x4*)(bias + col + 4);
            u32x4 w;
            w.x = cvt_pk_bf16(bflo(gv.x) * sigmoid_f(v0[0] + b0[0]), bfhi(gv.x) * sigmoid_f(v0[1] + b0[1]));
            w.y = cvt_pk_bf16(bflo(gv.y) * sigmoid_f(v0[2] + b0[2]), bfhi(gv.y) * sigmoid_f(v0[3] + b0[3]));
            w.z = cvt_pk_bf16(bflo(gv.z) * sigmoid_f(v1[0] + b1[0]), bfhi(gv.z) * sigmoid_f(v1[1] + b1[1]));
            w.w = cvt_pk_bf16(bflo(gv.w) * sigmoid_f(v1[2] + b1[2]), bfhi(gv.w) * sigmoid_f(v1[3] + b1[3]));
            *(u32x4*)(CAT + (size_t)row * DM + 1024 + col) = w; })
    }
};
struct EpiOut {
    static constexpr bool PERM = true;
    const float* xl; const float* xc; const bf16_t* xs; const float* gate; bf16_t* xo;
    __device__ __forceinline__ void operator()(AccRef acc, const Unit& u, int wr, int wc, int fr, int fq) const {
        PG8_FOR_PERM({ const int row = u.pm * 256 + tr, col = u.pn * 256 + tc; const int rr = row < NLAT ? (row >> 11) : 4;
            f32x4 x0, x1;
            if (xs) { const u32x4 xv = *(const u32x4*)(xs + (size_t)row * DM + col); x0 = (f32x4){bflo(xv.x), bfhi(xv.x), bflo(xv.y), bfhi(xv.y)}; x1 = (f32x4){bflo(xv.z), bfhi(xv.z), bflo(xv.w), bfhi(xv.w)}; }
            else { const float* src = (row < NLAT ? xl + (size_t)row * DM : xc + (size_t)(row - NLAT) * DM) + col; x0 = *(const f32x4*)src; x1 = *(const f32x4*)(src + 4); }
            const float* gp = gate + (size_t)rr * 12288 + col; const f32x4 g0 = *(const f32x4*)gp, g1 = *(const f32x4*)(gp + 4);
            x0 += g0 * v0; x1 += g1 * v1;
            u32x4 w; w.x = cvt_pk_bf16(x0[0], x0[1]); w.y = cvt_pk_bf16(x0[2], x0[3]); w.z = cvt_pk_bf16(x1[0], x1[1]); w.w = cvt_pk_bf16(x1[2], x1[3]);
            *(u32x4*)(xo + (size_t)row * DM + col) = w; })
    }
};
struct EpiGU {
    static constexpr bool PERM = true;
    bf16_t* HID;
    __device__ __forceinline__ void operator()(AccRef acc, const Unit& u, int wr, int wc, int fr, int fq) const {
        PG8_FOR_PERM({ const int row = u.pm * 256 + tr, j = (u.pn * 256 + tc) >> 1;
            u32x2 w; w.x = cvt_pk_bf16(silu_f(v0[0]) * v0[1], silu_f(v0[2]) * v0[3]); w.y = cvt_pk_bf16(silu_f(v1[0]) * v1[1], silu_f(v1[2]) * v1[3]);
            *(u32x2*)(HID + ((size_t)u.pb * EROWS + row) * FF + j) = w; })
    }
};
struct EpiDown {
    static constexpr bool PERM = true;
    bf16_t* YS; const float* RA;
    __device__ __forceinline__ void operator()(AccRef acc, const Unit& u, int wr, int wc, int fr, int fq) const {
        PG8_FOR_PERM({ const int row = u.pm * 256 + tr, col = u.pn * 256 + tc; const float a = RA[u.pb * EROWS + row];
            u32x4 w; w.x = cvt_pk_bf16(v0[0] * a, v0[1] * a); w.y = cvt_pk_bf16(v0[2] * a, v0[3] * a); w.z = cvt_pk_bf16(v1[0] * a, v1[1] * a); w.w = cvt_pk_bf16(v1[2] * a, v1[3] * a);
            *(u32x4*)(YS + ((size_t)u.pb * EROWS + row) * DM + col) = w; })
    }
};
}

struct Params { const float* in[33]; float* out; unsigned char* ws; int ph_lo, ph_hi; };
enum { I_X = 0, I_C, I_CTX, I_CCTX, I_N1G, I_N2G, I_WADA, I_BADA, I_WIN, I_WOUT, I_SGUNG, I_SGUW, I_SGUB, I_QNG, I_WUQ, I_KVNG, I_WUKV,
       I_ARE, I_AIM, I_LOGDT, I_BRE, I_BIM, I_CRE, I_CIM, I_S5D, I_WGLU, I_BGLU, I_CONVW, I_WROUTER, I_WGATE, I_WUP, I_WDOWN, I_FNG };

__device__ __forceinline__ void transpose_tile(const float* src, int N, int k0, int n0, bf16_t* dst, int ldd, int rmul, int radd, int remap_kv, LAS float* tile) {
    const int tid = threadIdx.x;
#pragma unroll
    for (int i = 0; i < 2; ++i) { const int r = (tid >> 4) + 32 * i, c4 = (tid & 15) * 4;
        const f32x4 v = *(const f32x4*)(src + (size_t)(k0 + r) * N + n0 + c4);
        tile[r * 65 + c4 + 0] = v[0]; tile[r * 65 + c4 + 1] = v[1]; tile[r * 65 + c4 + 2] = v[2]; tile[r * 65 + c4 + 3] = v[3]; }
    __syncthreads();
    { const int n = tid >> 3, kc = tid & 7; float f[8];
#pragma unroll
        for (int j = 0; j < 8; ++j) f[j] = tile[(kc * 8 + j) * 65 + n];
        int nn = n0 + n; if (remap_kv) nn = ((nn & 255) < 128) ? ((nn >> 8) * 128 + (nn & 127)) : (512 + (nn >> 8) * 128 + (nn & 127));
        const int drow = nn * rmul + radd;
        u32x4 w; w.x = cvt_pk_bf16(f[0], f[1]); w.y = cvt_pk_bf16(f[2], f[3]); w.z = cvt_pk_bf16(f[4], f[5]); w.w = cvt_pk_bf16(f[6], f[7]);
        *(u32x4*)(dst + (size_t)drow * ldd + k0 + kc * 8) = w; }
    __syncthreads();
}
constexpr int N_ADA_UNITS = 192, N_S5T_UNITS = 64, N_ROPE_UNITS = 2;
constexpr int T_WIN = 32 * 14 + 32 * 3  , T_WOUT = 32 * 8  , T_WUQ = 6 * 12, T_WUKV = 4 * 16, T_WGLU = 8 * 8, T_EXP = 512;
constexpr int N_TR = 2 * (T_WIN + T_WOUT + T_WUQ + T_WUKV + T_WGLU);
constexpr int N_PRO_ITEMS = N_ADA_UNITS + N_S5T_UNITS + N_ROPE_UNITS + N_TR;


__device__ __forceinline__ void transpose_block(const float* src, int N, int k0, int n0, bf16_t* dst, int ldd, int rmul, int radd, LAS float* tile  ) {
    const int tid = opaque_tid();
    f32x4 v[8];
#pragma unroll
    for (int i = 0; i < 8; ++i) v[i] = __builtin_nontemporal_load((const f32x4*)(src + (size_t)(k0 + (tid >> 6) + 8 * i) * N + n0 + (tid & 63) * 4));
#pragma unroll
    for (int i = 0; i < 8; ++i) { const int r = (tid >> 6) + 8 * i; *(LAS f32x4*)(tile + r * 260 + (((tid & 63) * 4) ^ (8 * (r >> 3)))) = v[i]; }
    __syncthreads();
#pragma unroll
    for (int i = 0; i < 4; ++i) { const int id = tid + 512 * i, n = id >> 3, kc = id & 7; float f[8];
#pragma unroll
        for (int j = 0; j < 8; ++j) f[j] = tile[(kc * 8 + j) * 260 + (n ^ (8 * kc))];
        u32x4 w; w.x = cvt_pk_bf16(f[0], f[1]); w.y = cvt_pk_bf16(f[2], f[3]); w.z = cvt_pk_bf16(f[4], f[5]); w.w = cvt_pk_bf16(f[6], f[7]);
        *(u32x4*)(dst + (size_t)((n0 + n) * rmul + radd) * ldd + k0 + kc * 8) = w; }
    __syncthreads();
}
constexpr int QB_EXP = T_EXP / 4, Q_GU = NE * 2 * QB_EXP, Q_LAYER = Q_GU + NE * QB_EXP, Q_TOTAL = 2 * Q_LAYER;
constexpr int CW_QHEAD = 4096, CW_DONE = 4160;
static_assert((CW_DONE + 64 * 32) * 4 <= (int)CTL_BYTES, "control words inside the memset region");
__device__ __forceinline__ void moe_convert_block(const Params& p, unsigned char* ws, int t, LAS float* tile) {
    const int l = t / Q_LAYER, r = t % Q_LAYER;
    if (r < Q_GU) { const int e = r / (2 * QB_EXP), rr = r % (2 * QB_EXP), up = rr / QB_EXP, q = rr % QB_EXP; const int le = l * NE + e;
        transpose_block((up ? p.in[I_WUP] : p.in[I_WGATE]) + (size_t)le * DM * FF, FF, (q >> 2) * 64, (q & 3) * 256, (bf16_t*)(ws + WS_WTGU) + (size_t)le * 2048 * DM, DM, 2, up, tile); }
    else { const int r2 = r - Q_GU, e = r2 / QB_EXP, q = r2 % QB_EXP; const int le = l * NE + e;
        transpose_block(p.in[I_WDOWN] + (size_t)le * FF * DM, DM, (q >> 3) * 64, (q & 7) * 256, (bf16_t*)(ws + WS_WTDN) + (size_t)le * DM * FF, FF, 1, 0, tile); }
}
#ifndef FILL_ON
#define FILL_ON 0
#endif
constexpr unsigned Q_BULK = 4;
__device__ __forceinline__ unsigned moe_claim(unsigned* ctl, int ph, int upto, int mode, unsigned target) {
    unsigned t = 0xffffffffu;
    const unsigned head = __hip_atomic_load(ctl + CW_QHEAD, __ATOMIC_RELAXED, __HIP_MEMORY_SCOPE_AGENT);
    const bool go = mode ? (head < (unsigned)upto) : (head < (unsigned)Q_TOTAL && __hip_atomic_load(ctl + CW_DONE + 64 * ph, __ATOMIC_RELAXED, __HIP_MEMORY_SCOPE_AGENT) < target);
    if (go) t = __hip_atomic_fetch_add(ctl + CW_QHEAD, mode ? Q_BULK : 1u, __ATOMIC_RELAXED, __HIP_MEMORY_SCOPE_AGENT);
    return t;
}
__device__ __forceinline__ void moe_pump(const Params& p, LAS unsigned char* lds, int ph, int upto, int mode, unsigned target = 0u, bool count_me = true) {
    unsigned char* ws = opaque_ptr(p.ws); unsigned* ctl = (unsigned*)(ws + WS_CTL);
    LAS float* tile = (LAS float*)lds; volatile LAS unsigned* slot = (volatile LAS unsigned*)(lds + LDS_MISC + 32);
    const int tid = opaque_tid(); const int nblk = mode ? (int)Q_BULK : 1;
    __syncthreads();
    if (tid == 0) { if (mode == 0 && count_me) (void)__hip_atomic_fetch_add(ctl + CW_DONE + 64 * ph, 1u, __ATOMIC_RELAXED, __HIP_MEMORY_SCOPE_AGENT); slot[0] = moe_claim(ctl, ph, upto, mode, target ? target : gridDim.x); }
    __syncthreads();
    for (;;) {
        const unsigned t = slot[0];
        if (t >= (unsigned)Q_TOTAL) break;
        unsigned nxt = 0u;
        if (tid == 0) nxt = moe_claim(ctl, ph, upto, mode, target ? target : gridDim.x);
#pragma unroll 1
        for (int k = 0; k < nblk; ++k) if ((int)t + k < Q_TOTAL) moe_convert_block(p, ws, (int)t + k, tile);
        if (tid == 0) slot[0] = nxt;
        __syncthreads();
    }
}
__device__ __forceinline__ void moe_fill(const Params& p, LAS unsigned char* lds, int ph) { if (FILL_ON) moe_pump(p, lds, ph, Q_TOTAL, 0); }
__device__ __forceinline__ void moe_mark_done(const Params& p, int ph) { if (threadIdx.x == 0) (void)__hip_atomic_fetch_add((unsigned*)(p.ws + WS_CTL) + CW_DONE + 64 * ph, 1u, __ATOMIC_RELAXED, __HIP_MEMORY_SCOPE_AGENT); }
__device__ __forceinline__ void moe_convert_while(const Params& p, LAS unsigned char* lds, int ph, unsigned ngemm) { moe_pump(p, lds, ph, Q_TOTAL, 0, ngemm, false); }
__device__ __forceinline__ void moe_require(const Params& p, LAS unsigned char* lds, int upto) { moe_pump(p, lds, 0, upto, 1); }

__device__ __forceinline__ void ph_prologue(const Params& p, LAS unsigned char* lds) {
    const int tid = opaque_tid(), lane = tid & 63, wave = tid >> 6;
    unsigned char* ws = opaque_ptr(p.ws);
    for (int it = blockIdx.x; it < N_PRO_ITEMS; it += gridDim.x) {
        if (it < N_ADA_UNITS) {
            const int l = it / 96, cb = it % 96;
            LAS float* sil = (LAS float*)lds;
            LAS float* red = (LAS float*)(lds + 40960);
            for (int i = tid; i < 5 * DM; i += 512) { const int r = i >> 11, k = i & (DM - 1); const float v = r < 4 ? p.in[I_C][r * DM + k] : p.in[I_CCTX][k]; sil[i] = silu_f(v); }
            __syncthreads();
            f32x2 acc[5];
#pragma unroll
            for (int r = 0; r < 5; ++r) acc[r] = (f32x2){0.f, 0.f};
            const float* W = p.in[I_WADA] + (size_t)l * DM * 12288 + cb * 128 + lane * 2;
            for (int k = wave * 256; k < wave * 256 + 256; k += 16) {
                f32x2 w[16];
#pragma unroll
                for (int j = 0; j < 16; ++j) w[j] = __builtin_nontemporal_load((const f32x2*)(W + (size_t)(k + j) * 12288));
#pragma unroll
                for (int j = 0; j < 16; ++j)
#pragma unroll
                    for (int r = 0; r < 5; ++r) acc[r] += sil[r * DM + k + j] * w[j];
            }
#pragma unroll
            for (int r = 0; r < 5; ++r) { red[(wave * 5 + r) * 128 + lane * 2] = acc[r].x; red[(wave * 5 + r) * 128 + lane * 2 + 1] = acc[r].y; }
            __syncthreads();
            float* mod = (float*)(ws + WS_MOD);
            for (int o = tid; o < 5 * 128; o += 512) { const int r = o >> 7, cc = o & 127; float sum = p.in[I_BADA][l * 12288 + cb * 128 + cc];
#pragma unroll
                for (int w8 = 0; w8 < 8; ++w8) sum += red[(w8 * 5 + r) * 128 + cc];
                mod[(size_t)(l * 5 + r) * 12288 + cb * 128 + cc] = sum; }
            __syncthreads();
        } else if (it < N_ADA_UNITS + N_S5T_UNITS) {
            const int lg = it - N_ADA_UNITS, l = lg >> 5, g = lg & 31;
            LAS f32x2* PWl = (LAS f32x2*)lds;
            LAS f32x2* BBl = (LAS f32x2*)(lds + 17408);
            LAS f32x2* Cl = (LAS f32x2*)(lds + 33792);
            LAS float* KZl = (LAS float*)(lds + 50176);
            for (int idx = tid; idx < 2 * 64 * 17; idx += 512) { const int z = idx / (64 * 17), n = (idx / 17) & 63, d = idx % 17; const int zgn = ((l * 2 + z) * 32 + g) * 64 + n;
                const float are = fminf(p.in[I_ARE][zgn], -1e-4f), aim = p.in[I_AIM][zgn]; const float dt = expf(p.in[I_LOGDT][zgn >> 6]);
                const double mag = exp((double)are * (double)dt * d); double sn, cs; sincos((double)aim * (double)dt * d, &sn, &cs);
                const f32x2 v = {(float)(mag * cs), (float)(mag * sn)}; PWl[idx] = v; if (d == 16) ((f32x2*)(ws + WS_A16))[zgn] = v; }
            for (int idx = tid; idx < 2 * 64 * 16; idx += 512) { const int z = idx >> 10, n = (idx >> 4) & 63, c = idx & 15; const int zgn = ((l * 2 + z) * 32 + g) * 64 + n;
                const float are = fminf(p.in[I_ARE][zgn], -1e-4f), aim = p.in[I_AIM][zgn]; const float dt = expf(p.in[I_LOGDT][zgn >> 6]);
                const double mag = exp((double)are * (double)dt); double sn, cs; sincos((double)aim * (double)dt, &sn, &cs);
                const float xr = (float)(mag * cs) - 1.0f, xi = (float)(mag * sn), den = 1.0f / (are * are + aim * aim);
                const float cr = (xr * are + xi * aim) * den, ci = (xi * are - xr * aim) * den;
                const float br = p.in[I_BRE][(size_t)zgn * 16 + c], bi = p.in[I_BIM][(size_t)zgn * 16 + c]; BBl[idx] = (f32x2){cr * br - ci * bi, cr * bi + ci * br}; }
            for (int idx = tid; idx < 2 * 16 * 64; idx += 512) { const int z = idx >> 10, cn = idx & 1023; const size_t src = ((size_t)((l * 2 + z) * 32 + g) * 16) * 64 + cn; Cl[idx] = (f32x2){p.in[I_CRE][src], p.in[I_CIM][src]}; }
            __syncthreads();
            { const int z = tid >> 8, d = (tid >> 4) & 15, c = tid & 15; float a16[16];
#pragma unroll
              for (int q = 0; q < 16; ++q) a16[q] = 0.f;
              for (int n = 0; n < 64; ++n) { const f32x2 pw = PWl[(z * 64 + n) * 17 + d], cm = Cl[(z * 16 + c) * 64 + n]; const float tr = cm.x * pw.x - cm.y * pw.y, ti = cm.x * pw.y + cm.y * pw.x;
#pragma unroll
                  for (int q = 0; q < 16; ++q) { const f32x2 bb = BBl[(z * 64 + n) * 16 + q]; a16[q] += tr * bb.x - ti * bb.y; } }
#pragma unroll
              for (int q = 0; q < 16; ++q) KZl[((z * 16 + d) * 16 + c) * 16 + q] = a16[q]; }
            __syncthreads();
            bf16_t* WST = (bf16_t*)(ws + WS_WST) + (size_t)lg * 256 * 256; bf16_t* G2B = (bf16_t*)(ws + WS_G2B) + (size_t)lg * 256 * 512;
            for (int i = 0; i < 16; ++i) { const int id = tid + 512 * i;
                {
                  const int c8 = (id & 1) * 8, pp = (id >> 1) & 15, row = id >> 5, z = row >> 7, ri = (row >> 6) & 1, n = row & 63;
                  const f32x2 pw = PWl[(z * 64 + n) * 17 + (z == 0 ? 15 - pp : pp)]; float f[8];
#pragma unroll
                  for (int j = 0; j < 8; ++j) { const f32x2 bb = BBl[(z * 64 + n) * 16 + c8 + j]; f[j] = ri == 0 ? (pw.x * bb.x - pw.y * bb.y) : (pw.x * bb.y + pw.y * bb.x); }
                  u32x4 w; w.x = cvt_pk_bf16(f[0], f[1]); w.y = cvt_pk_bf16(f[2], f[3]); w.z = cvt_pk_bf16(f[4], f[5]); w.w = cvt_pk_bf16(f[6], f[7]);
                  *(u32x4*)(WST + (size_t)row * 256 + pp * 16 + c8) = w; }
                {
                  const int n8 = (id & 7) * 8, ri = (id >> 3) & 1, z = (id >> 4) & 1, row = id >> 5, pp = row >> 4, c = row & 15; float f[8];
#pragma unroll
                  for (int j = 0; j < 8; ++j) { const f32x2 pw = PWl[(z * 64 + n8 + j) * 17 + (z == 0 ? pp + 1 : 16 - pp)], cm = Cl[(z * 16 + c) * 64 + n8 + j]; f[j] = ri == 0 ? (cm.x * pw.x - cm.y * pw.y) : -(cm.x * pw.y + cm.y * pw.x); }
                  u32x4 w; w.x = cvt_pk_bf16(f[0], f[1]); w.y = cvt_pk_bf16(f[2], f[3]); w.z = cvt_pk_bf16(f[4], f[5]); w.w = cvt_pk_bf16(f[6], f[7]);
                  *(u32x4*)(G2B + (size_t)row * 512 + 256 + z * 128 + ri * 64 + n8) = w; }
                {
                  const int c8 = (id & 1) * 8, pq = (id >> 1) & 15, row = id >> 5, pp = row >> 4, c = row & 15; float f[8];
#pragma unroll
                  for (int j = 0; j < 8; ++j) { float v = 0.f; if (pq <= pp) v += KZl[((0 * 16 + (pp - pq)) * 16 + c) * 16 + c8 + j]; if (pq >= pp) v += KZl[((1 * 16 + (pq - pp)) * 16 + c) * 16 + c8 + j];
                      if (pq == pp && c8 + j == c) v += p.in[I_S5D][l * 512 + g * 16 + c]; f[j] = v; }
                  u32x4 w; w.x = cvt_pk_bf16(f[0], f[1]); w.y = cvt_pk_bf16(f[2], f[3]); w.z = cvt_pk_bf16(f[4], f[5]); w.w = cvt_pk_bf16(f[6], f[7]);
                  *(u32x4*)(G2B + (size_t)row * 512 + pq * 16 + c8) = w; } }
            __syncthreads();
        } else if (it < N_ADA_UNITS + N_S5T_UNITS + N_ROPE_UNITS) {
            const int idx = (it - N_ADA_UNITS - N_S5T_UNITS) * 512 + tid; const int pos = idx >> 4, f = idx & 15;
            const float invf = powf(10000.0f, -(float)f * 0.0625f); const float ang = (float)pos * invf;
            ((f32x2*)(ws + WS_ROPE))[idx] = (f32x2){cosf(ang), sinf(ang)};
        } else {
            int t = it - N_ADA_UNITS - N_S5T_UNITS - N_ROPE_UNITS;
            LAS float* tile = (LAS float*)lds;
            if (t < 2 * T_WIN) { const int l = t / T_WIN, r = t % T_WIN; const float* src = p.in[I_WIN] + (size_t)l * DM * INC; bf16_t* dst = (bf16_t*)(ws + WS_WTIN) + (size_t)l * INP * DM;
                if (r < 448) transpose_block(src, INC, (r / 14) * 64, (r % 14) * 256, dst, DM, 1, 0, tile); else { const int q = r - 448; transpose_tile(src, INC, (q / 3) * 64, 3584 + (q % 3) * 64, dst, DM, 1, 0, 0, tile); }
                continue; }
            t -= 2 * T_WIN;
            if (t < 2 * T_WOUT) { const int l = t / T_WOUT, r = t % T_WOUT; transpose_block(p.in[I_WOUT] + (size_t)l * DM * DM, DM, (r >> 3) * 64, (r & 7) * 256, (bf16_t*)(ws + WS_WTOUT) + (size_t)l * DM * DM, DM, 1, 0, tile); continue; }
            t -= 2 * T_WOUT;
            if (t < 2 * T_WUQ) { const int l = t / T_WUQ, r = t % T_WUQ; transpose_tile(p.in[I_WUQ] + (size_t)l * 384 * 768, 768, (r % 6) * 64, (r / 6) * 64, (bf16_t*)(ws + WS_WTUQ) + (size_t)l * 768 * 384, 384, 1, 0, 0, tile); continue; }
            t -= 2 * T_WUQ;
            if (t < 2 * T_WUKV) { const int l = t / T_WUKV, r = t % T_WUKV; transpose_tile(p.in[I_WUKV] + (size_t)l * 256 * 1024, 1024, (r % 4) * 64, (r / 4) * 64, (bf16_t*)(ws + WS_WTUKV) + (size_t)l * 1024 * 256, 256, 1, 0, 1, tile); continue; }
            t -= 2 * T_WUKV;
            if (t < 2 * T_WGLU) { const int l = t / T_WGLU, r = t % T_WGLU; transpose_tile(p.in[I_WGLU] + (size_t)l * 512 * 512, 512, (r % 8) * 64, (r / 8) * 64, (bf16_t*)(ws + WS_WTGLU) + (size_t)l * 512 * 512, 512, 1, 0, 0, tile); continue; }
        }
    }
}

__device__ __forceinline__ void rms_mod_store(const f32x4 (&x)[8], const float* g, const float* scale, const float* shift, bf16_t* orow, f32x4 (&y)[8], int lane) {
    float ss = 0.f;
#pragma unroll
    for (int j = 0; j < 8; ++j) ss += x[j][0] * x[j][0] + x[j][1] * x[j][1] + x[j][2] * x[j][2] + x[j][3] * x[j][3];
    ss = wave_sum(ss);
    const float rinv = rsqrtf(ss * (1.0f / DM) + EPS);
#pragma unroll
    for (int j = 0; j < 8; ++j) { const int c = j * 256 + lane * 4;
        const f32x4 gv = *(const f32x4*)(g + c), sc = *(const f32x4*)(scale + c), sh = *(const f32x4*)(shift + c);
        y[j] = x[j] * rinv * gv * (1.0f + sc) + sh;
        u32x2 w; w.x = cvt_pk_bf16(y[j][0], y[j][1]); w.y = cvt_pk_bf16(y[j][2], y[j][3]); *(u32x2*)(orow + c) = w; }
}

constexpr int N1_ROWITEMS = MT / 8, N1_KZ = 64, N1_WST = 1024, N1_INTER = 1024;
__device__ __forceinline__ void ph_norm1_tables(const Params& p) {
    const int tid = opaque_tid(), lane = tid & 63, wave = tid >> 6;
    unsigned char* ws = opaque_ptr(p.ws);
    const float* mod = (const float*)(ws + WS_MOD);
    for (int it = blockIdx.x; it < N1_ROWITEMS; it += gridDim.x) {
        {
            const int row = it * 8 + wave; const int rr = row < NLAT ? (row >> 11) : 4;
            const float* xr = row < NLAT ? p.in[I_X] + (size_t)row * DM : p.in[I_CTX] + (size_t)(row - NLAT) * DM;
            f32x4 x[8], y[8];
#pragma unroll
            for (int j = 0; j < 8; ++j) x[j] = *(const f32x4*)(xr + j * 256 + lane * 4);
            const float* m = mod + (size_t)rr * 12288;
            rms_mod_store(x, p.in[I_N1G], m + DM, m, (bf16_t*)(ws + WS_H) + (size_t)row * DM, y, lane);
        }
    }
}

constexpr int B_ROWITEMS = MT / 8, B_SGU = 72 * 4, B_INTRA = 0;
__device__ __forceinline__ void ph_rowsplit(const Params& p, int l, LAS unsigned char* lds) {
    const int tid = opaque_tid(), lane = tid & 63, wave = tid >> 6;
    unsigned char* ws = opaque_ptr(p.ws);
    const bf16_t* P = (const bf16_t*)(ws + WS_PA);
    bf16_t* CAT = (bf16_t*)(ws + WS_CAT);
    const int nsgu = (l == 0) ? B_SGU : 256;
    for (int it0 = blockIdx.x; it0 < B_ROWITEMS + nsgu; it0 += gridDim.x) {
        const int it = it0 < nsgu ? B_ROWITEMS + it0 : it0 - nsgu;
        if (it < B_ROWITEMS) {
            const int row = it * 8 + wave; const bf16_t* pr = P + (size_t)row * INP;
            const bool lat = row < NLAT; const int t = lat ? (row & (SEQ - 1)) : ((row - NLAT) & (CTX - 1)); const int b = lat ? (row >> 11) : ((row - NLAT) >> 8);
            const int seqlen = lat ? SEQ : CTX;
            { float f[8]; float ss = 0.f;
              if (lane < 48) { const u32x4 v = *(const u32x4*)(pr + C_CQ + lane * 8); f[0] = bflo(v.x); f[1] = bfhi(v.x); f[2] = bflo(v.y); f[3] = bfhi(v.y); f[4] = bflo(v.z); f[5] = bfhi(v.z); f[6] = bflo(v.w); f[7] = bfhi(v.w);
#pragma unroll
                  for (int j = 0; j < 8; ++j) ss += f[j] * f[j]; }
              else {
#pragma unroll
                  for (int j = 0; j < 8; ++j) f[j] = 0.f; }
              ss = wave_sum(ss); const float rinv = rsqrtf(ss * (1.0f / 384.0f) + EPS);
              if (lane < 48) { const float* g = p.in[I_QNG] + l * 384 + lane * 8; u32x4 w;
                  w.x = cvt_pk_bf16(f[0] * rinv * g[0], f[1] * rinv * g[1]); w.y = cvt_pk_bf16(f[2] * rinv * g[2], f[3] * rinv * g[3]);
                  w.z = cvt_pk_bf16(f[4] * rinv * g[4], f[5] * rinv * g[5]); w.w = cvt_pk_bf16(f[6] * rinv * g[6], f[7] * rinv * g[7]);
                  *(u32x4*)((bf16_t*)(ws + WS_QA) + (size_t)row * 384 + lane * 8) = w; } }
            { const u32x2 v = *(const u32x2*)(pr + C_CKV + lane * 4); const float f0 = bflo(v.x), f1 = bfhi(v.x), f2 = bflo(v.y), f3 = bfhi(v.y);
              const float ss = wave_sum(f0 * f0 + f1 * f1 + f2 * f2 + f3 * f3); const float rinv = rsqrtf(ss * (1.0f / 256.0f) + EPS);
              const float* g = p.in[I_KVNG] + l * 256 + lane * 4; u32x2 w; w.x = cvt_pk_bf16(f0 * rinv * g[0], f1 * rinv * g[1]); w.y = cvt_pk_bf16(f2 * rinv * g[2], f3 * rinv * g[3]);
              *(u32x2*)((bf16_t*)(ws + WS_KVA) + (size_t)row * 256 + lane * 4) = w; }
            { float v = bf2f(pr[C_KR + lane]); const float partner = __shfl_xor(v, 16);
              if (lat) { const int jj = lane & 31, fi = jj & 15; const int pos = lane >= 32 ? (t & 63) : (t >> 6);
                  const f32x2 r = ((const f32x2*)(ws + WS_ROPE))[pos * 16 + fi]; const float cs = r.x, sn = r.y;
                  v = jj < 16 ? (v * cs - partner * sn) : (v * cs + partner * sn); }
              const int key = lat ? CTX + t : t; const unsigned short o = f2bf(v);
              bf16_t* kc = (bf16_t*)(ws + WS_KC);
#pragma unroll
              for (int h = 0; h < 4; ++h) kc[((size_t)(b * 4 + h) * NKEY + key) * 192 + 128 + lane] = o; }
            { const u32x4 v = *(const u32x4*)(pr + C_S5 + lane * 8); const int g = lane >> 1, half = lane & 1;
              *(u32x4*)((bf16_t*)(ws + WS_UPK) + ((size_t)g * 768 + (row >> 4)) * 512 + (row & 15) * 16 + half * 8) = v; }
            { const int c0 = lane * 8; float zp[8], zc[8], zn[8];
#pragma unroll
              for (int j = 0; j < 8; ++j) { zp[j] = 0.f; zn[j] = 0.f; }
#define CONV_Z(dst, rp) do { const u32x4 a_ = *(const u32x4*)((rp) + C_CVC + c0); const u32x4 h_ = *(const u32x4*)((rp) + C_CVH + c0); \
                  dst[0] = bflo(a_.x) * bflo(h_.x); dst[1] = bfhi(a_.x) * bfhi(h_.x); dst[2] = bflo(a_.y) * bflo(h_.y); dst[3] = bfhi(a_.y) * bfhi(h_.y); \
                  dst[4] = bflo(a_.z) * bflo(h_.z); dst[5] = bfhi(a_.z) * bfhi(h_.z); dst[6] = bflo(a_.w) * bflo(h_.w); dst[7] = bfhi(a_.w) * bfhi(h_.w); } while (0)
              CONV_Z(zc, pr);
              if (t > 0) CONV_Z(zp, pr - INP);
              if (t < seqlen - 1) CONV_Z(zn, pr + INP);
#undef CONV_Z
              const u32x4 bg = *(const u32x4*)(pr + C_CVB + c0); float bgf[8] = {bflo(bg.x), bfhi(bg.x), bflo(bg.y), bfhi(bg.y), bflo(bg.z), bfhi(bg.z), bflo(bg.w), bfhi(bg.w)};
              const float* cw = p.in[I_CONVW] + (size_t)l * 3 * 512 + c0; float o[8];
#pragma unroll
              for (int j = 0; j < 8; ++j) o[j] = bgf[j] * (cw[j] * zp[j] + cw[512 + j] * zc[j] + cw[1024 + j] * zn[j]);
              u32x4 w; w.x = cvt_pk_bf16(o[0], o[1]); w.y = cvt_pk_bf16(o[2], o[3]); w.z = cvt_pk_bf16(o[4], o[5]); w.w = cvt_pk_bf16(o[6], o[7]);
              *(u32x4*)(CAT + (size_t)row * DM + 1536 + c0) = w; }
        } else if (it < B_ROWITEMS + B_SGU) {
            const int un = it - B_ROWITEMS, cc = un >> 2, h = un & 3; const int row0 = cc * 128;
            LAS bf16_t* Wl = (LAS bf16_t*)lds;
            LAS bf16_t* Vl = (LAS bf16_t*)(lds + 128 * 136 * 2);
            const float* Wg = p.in[I_SGUW] + ((size_t)l * 4 + h) * 128 * 128;
#pragma unroll
            for (int i = 0; i < 8; ++i) { const int e4 = (i * 512 + tid) * 4, r = e4 >> 7, c = e4 & 127; const f32x4 v = *(const f32x4*)(Wg + e4);
                u32x2 w; w.x = cvt_pk_bf16(v[0], v[1]); w.y = cvt_pk_bf16(v[2], v[3]); *(LAS u32x2*)(Wl + r * 136 + c) = w; }
            u32x4 vv[16];
#pragma unroll
            for (int qi = 0; qi < 16; ++qi) vv[qi] = *(const u32x4*)(P + (size_t)(row0 + wave * 16 + qi) * INP + C_SGU_V + lane * 8);
#pragma unroll
            for (int qi = 0; qi < 16; ++qi) { const int q = wave * 16 + qi;
                const u32x4 v = vv[qi]; float f[8] = {bflo(v.x), bfhi(v.x), bflo(v.y), bfhi(v.y), bflo(v.z), bfhi(v.z), bflo(v.w), bfhi(v.w)}; float ss = 0.f;
#pragma unroll
                for (int j = 0; j < 8; ++j) { f[j] = gelu_tanh(f[j]); ss += f[j] * f[j]; }
                ss = wave_sum(ss); const float rinv = rsqrtf(ss * (1.0f / 512.0f) + EPS);
                if ((lane >> 4) == h) { const int c0 = (lane & 15) * 8; const float* g = p.in[I_SGUNG] + l * 512 + h * 128 + c0;
#pragma unroll
                    for (int j = 0; j < 8; ++j) Vl[(c0 + j) * 136 + q] = f2bf(f[j] * rinv * g[j]); } }
            __syncthreads();
            { const int fr = lane & 15, fq = lane >> 4; f32x4 acc[8];
#pragma unroll
              for (int nb = 0; nb < 8; ++nb) acc[nb] = (f32x4){0.f, 0.f, 0.f, 0.f};
#pragma unroll
              for (int ks = 0; ks < 4; ++ks) { const bf16x8 af = *(const LAS bf16x8*)(Wl + (wave * 16 + fr) * 136 + ks * 32 + fq * 8);
#pragma unroll
                  for (int nb = 0; nb < 8; ++nb) { const bf16x8 bfr = *(const LAS bf16x8*)(Vl + (nb * 16 + fr) * 136 + ks * 32 + fq * 8);
                      acc[nb] = __builtin_amdgcn_mfma_f32_16x16x32_bf16(bfr, af, acc[nb], 0, 0, 0); } }
              const int pp = wave * 16 + fr; const float bias = p.in[I_SGUB][((size_t)l * 4 + h) * 128 + pp]; const bf16_t* pr = P + (size_t)(row0 + pp) * INP + C_SGU_U + h * 128;
#pragma unroll
              for (int nb = 0; nb < 8; ++nb) { const int c = nb * 16 + 4 * fq; const u32x2 uv = *(const u32x2*)(pr + c);
                  u32x2 w; w.x = cvt_pk_bf16(gelu_tanh(bflo(uv.x)) * (acc[nb][0] + bias), gelu_tanh(bfhi(uv.x)) * (acc[nb][1] + bias));
                  w.y = cvt_pk_bf16(gelu_tanh(bflo(uv.y)) * (acc[nb][2] + bias), gelu_tanh(bfhi(uv.y)) * (acc[nb][3] + bias));
                  *(u32x2*)(CAT + (size_t)(row0 + pp) * DM + h * 128 + c) = w; } }
            __syncthreads();
        }
    }
}

constexpr int KPITCH = 400, VPITCH = 144;
constexpr int KT_BYTES = 64 * KPITCH, VT_BYTES = 128 * VPITCH;
__device__ __forceinline__ void attn_unit(const bf16_t* Qrows  , const bf16_t* Kbh, const bf16_t* Vbh, int nkeys, bf16_t* Orows, LAS unsigned char* lds) {
    const int tid = opaque_tid(), lane = tid & 63, wave = tid >> 6, l32 = lane & 31, hi = lane >> 5, qg = wave & 3, kh = wave >> 2;
    constexpr int VRING = 3 * KT_BYTES;
    bf16x8 qf[12];
    { const bf16_t* qr = Qrows + (size_t)(qg * 32 + l32) * 768 + hi * 8;
#pragma unroll
      for (int ks = 0; ks < 12; ++ks) qf[ks] = *(const bf16x8*)(qr + ks * 16); }
    f32x16 o[4];
#pragma unroll
    for (int db = 0; db < 4; ++db)
#pragma unroll
        for (int r = 0; r < 16; ++r) o[db][r] = 0.f;
    float mrow = -1e30f, lsum = 0.f;
    const int nt = nkeys / 64;
    const int wv = __builtin_amdgcn_readfirstlane(wave);
    unsigned doffK[4], doffV[3];
#pragma unroll
    for (int i = 0; i < 4; ++i) { const int pc = (wv + 8 * i) < 25 ? (wv + 8 * i) : 24; const int X = pc * 1024 + lane * 16, row = X / KPITCH, col = X % KPITCH; doffK[i] = (unsigned)(row * 384 + (col < 384 ? col : 0)); }
#pragma unroll
    for (int i = 0; i < 3; ++i) { const int pc = (wv + 8 * i) < 18 ? (wv + 8 * i) : 17; const int Y = pc * 1024 + lane * 16, row = Y / VPITCH, col = Y % VPITCH; doffV[i] = (unsigned)(row * (NKEY * 2) + (col < 128 ? col : 0)); }
#define ATT_DMAK(tile, slot) do { _Pragma("unroll") for (int i = 0; i < 4; ++i) { const int pc = (wv + 8 * i) < 25 ? (wv + 8 * i) : 24; \
        __builtin_amdgcn_global_load_lds((const unsigned*)((const char*)Kbh + (size_t)(tile) * (64 * 384) + doffK[i]), (LAS unsigned*)(lds + (slot) * KT_BYTES + pc * 1024), 16, 0, 0); } } while (0)
#define ATT_DMAV(tile, slot) do { _Pragma("unroll") for (int i = 0; i < 3; ++i) { const int pc = (wv + 8 * i) < 18 ? (wv + 8 * i) : 17; \
        __builtin_amdgcn_global_load_lds((const unsigned*)((const char*)Vbh + (size_t)(tile) * 128 + doffV[i]), (LAS unsigned*)(lds + VRING + (slot) * VT_BYTES + pc * 1024), 16, 0, 0); } } while (0)
#define ATT_STEP(S, SN, QK, ks_, vs_) do { \
        float mx = S[0]; \
        _Pragma("unroll") for (int r = 1; r < 16; ++r) mx = fmaxf(mx, S[r]); \
        mx = fmaxf(mx, __shfl_xor(mx, 32)); \
        if (__any(mx > mrow + 8.0f)) { const float mnew = fmaxf(mrow, mx), alpha = __builtin_amdgcn_exp2f(mrow - mnew); mrow = mnew; lsum *= alpha; \
            _Pragma("unroll") for (int db = 0; db < 4; ++db) _Pragma("unroll") for (int r = 0; r < 16; ++r) o[db][r] *= alpha; } \
        __builtin_amdgcn_sched_barrier(0); \
        const LAS unsigned char* Vcur = lds + VRING + (vs_) * VT_BYTES; \
        u32x4 vf0[4], vf1[4]; \
        float ps = 0.f; u32x4 pw0, pw1; \
        if (QK) { const LAS unsigned char* kp = lds + (ks_) * KT_BYTES + (kh * 32 + l32) * KPITCH + hi * 16; \
            bf16x8 kf[12]; \
            _Pragma("unroll") for (int i = 0; i < 12; ++i) kf[i] = *(const LAS bf16x8*)(kp + i * 32); \
            _Pragma("unroll") for (int r = 0; r < 16; ++r) SN[r] = 0.f; \
            __builtin_amdgcn_sched_barrier(0); \
              \
            _Pragma("unroll") for (int i = 0; i < 12; ++i) { \
                SN = __builtin_amdgcn_mfma_f32_32x32x16_bf16(kf[i], qf[i], SN, 0, 0, 0); \
                S[i] = __builtin_amdgcn_exp2f(S[i] - mrow); ps += S[i]; \
                if (i < 4) { S[12 + i] = __builtin_amdgcn_exp2f(S[12 + i] - mrow); ps += S[12 + i]; } \
                if (i == 1) pw0.x = cvt_pk_bf16(S[0], S[1]); if (i == 3) { pw0.y = cvt_pk_bf16(S[2], S[3]); pw1.z = cvt_pk_bf16(S[12], S[13]); pw1.w = cvt_pk_bf16(S[14], S[15]); } \
                if (i == 5) pw0.z = cvt_pk_bf16(S[4], S[5]); if (i == 7) pw0.w = cvt_pk_bf16(S[6], S[7]); if (i == 9) pw1.x = cvt_pk_bf16(S[8], S[9]); if (i == 11) pw1.y = cvt_pk_bf16(S[10], S[11]); \
                if (i >= 8) { const int db = i - 8; const LAS unsigned char* vp = Vcur + (db * 32 + l32) * VPITCH + kh * 64 + hi * 16; \
                    vf0[db] = *(const LAS u32x4*)vp; vf1[db] = *(const LAS u32x4*)(vp + 32); } \
                __builtin_amdgcn_sched_barrier(0); } \
        } else { \
            _Pragma("unroll") for (int db = 0; db < 4; ++db) { const LAS unsigned char* vp = Vcur + (db * 32 + l32) * VPITCH + kh * 64 + hi * 16; \
                vf0[db] = *(const LAS u32x4*)vp; vf1[db] = *(const LAS u32x4*)(vp + 32); } \
            _Pragma("unroll") for (int r = 0; r < 16; ++r) { S[r] = __builtin_amdgcn_exp2f(S[r] - mrow); ps += S[r]; } \
            pw0.x = cvt_pk_bf16(S[0], S[1]); pw0.y = cvt_pk_bf16(S[2], S[3]); pw0.z = cvt_pk_bf16(S[4], S[5]); pw0.w = cvt_pk_bf16(S[6], S[7]); \
            pw1.x = cvt_pk_bf16(S[8], S[9]); pw1.y = cvt_pk_bf16(S[10], S[11]); pw1.z = cvt_pk_bf16(S[12], S[13]); pw1.w = cvt_pk_bf16(S[14], S[15]); } \
        lsum += ps; \
        { const bf16x8 pf = __builtin_bit_cast(bf16x8, pw0); \
          _Pragma("unroll") for (int db = 0; db < 4; ++db) o[db] = __builtin_amdgcn_mfma_f32_32x32x16_bf16(__builtin_bit_cast(bf16x8, vf0[db]), pf, o[db], 0, 0, 0); } \
        { const bf16x8 pf = __builtin_bit_cast(bf16x8, pw1); \
          _Pragma("unroll") for (int db = 0; db < 4; ++db) o[db] = __builtin_amdgcn_mfma_f32_32x32x16_bf16(__builtin_bit_cast(bf16x8, vf1[db]), pf, o[db], 0, 0, 0); } \
        __builtin_amdgcn_sched_barrier(0); } while (0)
#define ATT_SYNC(full) do { if (full) asm volatile("s_waitcnt vmcnt(7)" ::: "memory"); else asm volatile("s_waitcnt vmcnt(0)" ::: "memory"); \
        __builtin_amdgcn_s_barrier(); asm volatile("" ::: "memory"); } while (0)
    ATT_DMAK(0, 0); ATT_DMAV(0, 0); ATT_DMAK(1, 1); ATT_DMAV(1, 1); if (nt > 2) ATT_DMAK(2, 2);
    asm volatile("s_waitcnt vmcnt(0)" ::: "memory");
    __builtin_amdgcn_s_barrier(); asm volatile("" ::: "memory");
    f32x16 sA, sB;
    { const LAS unsigned char* kp = lds + (kh * 32 + l32) * KPITCH + hi * 16;
#pragma unroll
      for (int r = 0; r < 16; ++r) sA[r] = 0.f;
#pragma unroll
      for (int i = 0; i < 12; ++i) { const bf16x8 kf = *(const LAS bf16x8*)(kp + i * 32); sA = __builtin_amdgcn_mfma_f32_32x32x16_bf16(kf, qf[i], sA, 0, 0, 0); } }
    int k1 = 1, v0 = 0;
    int j = 0;
    for (; j + 2 < nt; j += 2) {
        ATT_SYNC(true);
        if (j + 3 < nt) ATT_DMAK(j + 3, v0);
        ATT_DMAV(j + 2, v0 == 0 ? 2 : v0 - 1);
        ATT_STEP(sA, sB, true, k1, v0);
        k1 = k1 == 2 ? 0 : k1 + 1; v0 = v0 == 2 ? 0 : v0 + 1;
        ATT_SYNC(j + 3 < nt);
        if (j + 4 < nt) ATT_DMAK(j + 4, v0);
        if (j + 3 < nt) ATT_DMAV(j + 3, v0 == 0 ? 2 : v0 - 1);
        ATT_STEP(sB, sA, true, k1, v0);
        k1 = k1 == 2 ? 0 : k1 + 1; v0 = v0 == 2 ? 0 : v0 + 1;
    }
    ATT_SYNC(false);
    ATT_STEP(sA, sB, true, k1, v0);
    k1 = k1 == 2 ? 0 : k1 + 1; v0 = v0 == 2 ? 0 : v0 + 1;
    ATT_SYNC(false);
    ATT_STEP(sB, sA, false, k1, v0);
#undef ATT_STEP
#undef ATT_SYNC
#undef ATT_DMAK
#undef ATT_DMAV
    __syncthreads();
    lsum += __shfl_xor(lsum, 32);
    LAS float* mb = (LAS float*)lds + (size_t)qg * 66 * 64 + lane;
    if (kh == 1) {
#pragma unroll
        for (int db = 0; db < 4; ++db)
#pragma unroll
            for (int r = 0; r < 16; ++r) mb[(db * 16 + r) * 64] = o[db][r];
        mb[64 * 64] = mrow; mb[65 * 64] = lsum;
    }
    __syncthreads();
    if (kh == 0) {
        const float m1 = mb[64 * 64], l1 = mb[65 * 64];
        const float m = fmaxf(mrow, m1), e0 = __builtin_amdgcn_exp2f(mrow - m), e1 = __builtin_amdgcn_exp2f(m1 - m);
        const float inv = 1.0f / (lsum * e0 + l1 * e1), c0 = e0 * inv, c1 = e1 * inv;
        bf16_t* orow = Orows + (size_t)(qg * 32 + l32) * DM;
#pragma unroll
        for (int db = 0; db < 4; ++db)
#pragma unroll
            for (int k4 = 0; k4 < 4; ++k4) { float v[4];
#pragma unroll
                for (int i = 0; i < 4; ++i) v[i] = o[db][4 * k4 + i] * c0 + mb[(db * 16 + 4 * k4 + i) * 64] * c1;
                u32x2 w; w.x = cvt_pk_bf16(v[0], v[1]); w.y = cvt_pk_bf16(v[2], v[3]);
                *(u32x2*)(orow + db * 32 + 8 * k4 + 4 * hi) = w; }
    }
    __syncthreads();
}
__device__ __forceinline__ void ph_attn_carry(const Params& p, int l, LAS unsigned char* lds) {
    unsigned char* ws = opaque_ptr(p.ws); const int tid = opaque_tid();
    const int natt = (l == 0) ? 288 : 256;
    const bf16_t* QB = (const bf16_t*)(ws + WS_QB); const bf16_t* KC = (const bf16_t*)(ws + WS_KC); const bf16_t* VT = (const bf16_t*)(ws + WS_VT); bf16_t* CAT = (bf16_t*)(ws + WS_CAT);
    for (int it = blockIdx.x; it < natt; it += gridDim.x) {
        {
            int b, h, row0, nkeys;
            if (it < 256) { const int x = it & 7, jj = it >> 3, bh = 2 * x + (jj >> 4); b = bh >> 2; h = bh & 3; row0 = b * SEQ + (jj & 15) * 128; nkeys = NKEY; }
            else { const int u = it - 256; b = u >> 3; h = (u >> 1) & 3; row0 = NLAT + b * CTX + (u & 1) * 128; nkeys = CTX; }
            attn_unit(QB + (size_t)row0 * 768 + h * 192, KC + (size_t)(b * 4 + h) * NKEY * 192, VT + (size_t)(b * 4 + h) * 128 * NKEY, nkeys, CAT + (size_t)row0 * DM + 512 + h * 128, lds);
        }
    }
    for (int it = natt + (int)((blockIdx.x + gridDim.x - natt % gridDim.x) % gridDim.x); it < natt + 256; it += gridDim.x) {
        {
            const int u = it - natt; const int z = u >> 7, b = (u >> 5) & 3, g = u & 31, lane = tid & 63, w = tid >> 6;
            const f32x2 a16 = ((const f32x2*)(ws + WS_A16))[(((size_t)l * 2 + z) * 32 + g) * 64 + lane];
            const float* EST = (const float*)(ws + WS_EST) + (size_t)g * 768 * 256 + z * 128 + lane;
            bf16_t* UP = (bf16_t*)(ws + WS_UPK) + (size_t)g * 768 * 512 + 256 + z * 128 + lane;
            LAS f32x2* seg = (LAS f32x2*)lds;
            float er[18], ei[18];
#pragma unroll
            for (int i = 0; i < 18; ++i) { const int st = w * 18 + i; int chunk;
                if (z == 0) chunk = st < 16 ? (512 + b * 16 + st) : (b * 128 + (st - 16)); else chunk = st < 16 ? (512 + b * 16 + (15 - st)) : (b * 128 + (143 - st));
                er[i] = EST[(size_t)chunk * 256]; ei[i] = EST[(size_t)chunk * 256 + 64]; }
            float sr = 0.f, si = 0.f;
#pragma unroll
            for (int i = 0; i < 18; ++i) { const float nr = a16.x * sr - a16.y * si + er[i], ni = a16.x * si + a16.y * sr + ei[i]; sr = nr; si = ni; }
            seg[w * 64 + lane] = (f32x2){sr, si};
            float pr = 1.f, pi = 0.f;
#pragma unroll
            for (int i = 0; i < 18; ++i) { const float nr = pr * a16.x - pi * a16.y, ni = pr * a16.y + pi * a16.x; pr = nr; pi = ni; }
            __syncthreads();
            sr = 0.f; si = 0.f;
            for (int w2 = 0; w2 < w; ++w2) { const f32x2 sv = seg[w2 * 64 + lane]; const float nr = pr * sr - pi * si + sv.x, ni = pr * si + pi * sr + sv.y; sr = nr; si = ni; }
#pragma unroll
            for (int i = 0; i < 18; ++i) { const int st = w * 18 + i; int chunk;
                if (z == 0) chunk = st < 16 ? (512 + b * 16 + st) : (b * 128 + (st - 16)); else chunk = st < 16 ? (512 + b * 16 + (15 - st)) : (b * 128 + (143 - st));
                UP[(size_t)chunk * 512] = f2bf(sr); UP[(size_t)chunk * 512 + 64] = f2bf(si);
                const float nr = a16.x * sr - a16.y * si + er[i], ni = a16.x * si + a16.y * sr + ei[i]; sr = nr; si = ni; }
            __syncthreads();
        }
    }
}

__device__ __forceinline__ void ph_norm2_router(const Params& p, int l, LAS unsigned char* lds) {
    const int tid = opaque_tid(), lane = tid & 63, wave = tid >> 6;
    unsigned char* ws = opaque_ptr(p.ws); const float* mod = (const float*)(ws + WS_MOD) + (size_t)l * 5 * 12288;
    const int nrows = (l == 0) ? MT : NLAT;
    const float* WR = p.in[I_WROUTER] + (size_t)l * DM * NE;
    for (int idx = tid; idx < DM * 4; idx += 512) { const int c = idx & (DM - 1), e4 = idx >> 11; const f32x4 v = *(const f32x4*)(WR + (size_t)c * NE + e4 * 4);
        *(LAS f32x4*)(lds + (size_t)(((e4 * 2 + (c & 1)) * 1024 + (c >> 1)) * 16)) = v; }
    __syncthreads();
    const float* n2g = p.in[I_N2G] + l * DM;
    for (int it = blockIdx.x; it < nrows / 8; it += gridDim.x) {
        const int row = it * 8 + wave; const int rr = row < NLAT ? (row >> 11) : 4;
        const bf16_t* xr = (const bf16_t*)(ws + WS_XB) + (size_t)row * DM;
        const float* m = mod + (size_t)rr * 12288;
        f32x2 x[16], gv[16], sc[16], sh[16];
#pragma unroll
        for (int j = 0; j < 16; ++j) { const int c = j * 128 + lane * 2; { const unsigned xw = *(const unsigned*)(xr + c); x[j] = (f32x2){bflo(xw), bfhi(xw)}; } gv[j] = *(const f32x2*)(n2g + c); sc[j] = *(const f32x2*)(m + 4 * DM + c); sh[j] = *(const f32x2*)(m + 3 * DM + c); }
        float ss = 0.f;
#pragma unroll
        for (int j = 0; j < 16; ++j) ss += x[j].x * x[j].x + x[j].y * x[j].y;
        ss = wave_sum(ss); const float rinv = rsqrtf(ss * (1.0f / DM) + EPS);
        bf16_t* orow = (bf16_t*)(ws + WS_H) + (size_t)row * DM;
        f32x4 lg[4];
#pragma unroll
        for (int e4 = 0; e4 < 4; ++e4) lg[e4] = (f32x4){0.f, 0.f, 0.f, 0.f};
#pragma unroll
        for (int j = 0; j < 16; ++j) { const f32x2 y = x[j] * rinv * gv[j] * (1.0f + sc[j]) + sh[j];
            *(unsigned*)(orow + j * 128 + lane * 2) = cvt_pk_bf16(y.x, y.y);
#pragma unroll
            for (int e4 = 0; e4 < 4; ++e4) { const f32x4 w0 = *(const LAS f32x4*)(lds + (size_t)(((e4 * 2 + 0) * 1024 + j * 64 + lane) * 16)); const f32x4 w1 = *(const LAS f32x4*)(lds + (size_t)(((e4 * 2 + 1) * 1024 + j * 64 + lane) * 16));
                lg[e4] += y.x * w0 + y.y * w1; }
            __builtin_amdgcn_sched_barrier(0); }
        float lgs[16]; float mx = -1e30f;
#pragma unroll
        for (int e = 0; e < 16; ++e) { lgs[e] = wave_sum(lg[e >> 2][e & 3]); mx = fmaxf(mx, lgs[e]); }
        float se = 0.f;
#pragma unroll
        for (int e = 0; e < 16; ++e) { lgs[e] = __expf(lgs[e] - mx); se += lgs[e]; }
        const float inv = 1.0f / se;
        float mine = 0.f;
#pragma unroll
        for (int e = 0; e < 16; ++e) mine = (lane == e) ? lgs[e] * inv : mine;
        if (lane < 16) ((float*)(ws + WS_AFF))[(size_t)row * 16 + lane] = mine;
    }
}

__device__ __forceinline__ void ph_topk(const Params& p, int l, LAS unsigned char* lds) {
    const int tid = opaque_tid(), lane = tid & 63, wave = tid >> 6;
    unsigned char* ws = opaque_ptr(p.ws); const float* AFF = (const float*)(ws + WS_AFF);
    int* ROWTOK = (int*)(ws + WS_ROWTOK); float* ROWAFF = (float*)(ws + WS_ROWAFF); int* INV = (int*)(ws + WS_INV);
    LAS int* hist = (LAS int*)lds;
    LAS int* ctl = (LAS int*)(lds + 1024);
    LAS int* wsum = (LAS int*)(lds + 1280);
    const int nunits = (l == 0) ? 128 : 64;
    for (int it = blockIdx.x; it < nunits; it += gridDim.x) {
        const bool lat = it < 64; const int u = lat ? it : it - 64; const int b = u >> 4, e = u & 15;
        const int n = lat ? SEQ : CTX, cap = lat ? CAPL : CAPC;
        const int tok0 = lat ? b * SEQ : NLAT + b * CTX; const int rowbase = lat ? b * CAPL : 1024 + b * CAPC;
        unsigned key[4];
#pragma unroll
        for (int j = 0; j < 4; ++j) { const int t = tid * 4 + j; key[j] = t < n ? __float_as_uint(AFF[(size_t)(tok0 + t) * 16 + e]) : 0u; }
        unsigned prefix = 0u; int remaining = cap;
        for (int pass = 3; pass >= 0; --pass) {
            if (tid < 256) hist[tid] = 0;
            __syncthreads();
#pragma unroll
            for (int j = 0; j < 4; ++j) { const int t = tid * 4 + j; if (t < n) { const bool match = (pass == 3) || ((key[j] >> (8 * (pass + 1))) == (prefix >> (8 * (pass + 1)))); if (match) atomicAdd((int*)&hist[(key[j] >> (8 * pass)) & 255u], 1); } }
            __syncthreads();
            if (wave == 0) {
                const int b0 = hist[4 * lane], b1 = hist[4 * lane + 1], b2 = hist[4 * lane + 2], b3 = hist[4 * lane + 3];
                const int s = b0 + b1 + b2 + b3; int suf = s;
#pragma unroll
                for (int off = 1; off < 64; off <<= 1) { const int t = __shfl_down(suf, off); if (lane + off < 64) suf += t; }
                const int above = suf - s; const int c3 = above + b3, c2 = c3 + b2, c1 = c2 + b1, c0 = c1 + b0;
                if (above < remaining && c0 >= remaining) { int dg, nr;
                    if (c3 >= remaining) { dg = 4 * lane + 3; nr = remaining - above; } else if (c2 >= remaining) { dg = 4 * lane + 2; nr = remaining - c3; }
                    else if (c1 >= remaining) { dg = 4 * lane + 1; nr = remaining - c2; } else { dg = 4 * lane; nr = remaining - c1; }
                    ctl[0] = dg; ctl[1] = nr; }
            }
            __syncthreads();
            prefix |= ((unsigned)ctl[0]) << (8 * pass); remaining = ctl[1];
            __syncthreads();
        }
        int cgt = 0, ceq = 0;
#pragma unroll
        for (int j = 0; j < 4; ++j) { const int t = tid * 4 + j; if (t < n) { cgt += key[j] > prefix ? 1 : 0; ceq += key[j] == prefix ? 1 : 0; } }
        const int packed = cgt | (ceq << 16);
        int inc = packed;
#pragma unroll
        for (int off = 1; off < 64; off <<= 1) { const int t = __shfl_up(inc, off); if (lane >= off) inc += t; }
        if (lane == 63) wsum[wave] = inc;
        __syncthreads();
        int base = 0;
#pragma unroll
        for (int w8 = 0; w8 < 8; ++w8) base += (w8 < wave) ? wsum[w8] : 0;
        int excl = base + inc - packed; int egt = excl & 0xffff, eeq = excl >> 16;
#pragma unroll
        for (int j = 0; j < 4; ++j) { const int t = tid * 4 + j; if (t < n) {
                const bool gt = key[j] > prefix, eq = key[j] == prefix; const bool sel = gt || (eq && eeq < remaining);
                const int slot = egt + (eeq < remaining ? eeq : remaining);
                if (sel) { ROWTOK[e * EROWS + rowbase + slot] = tok0 + t; ROWAFF[e * EROWS + rowbase + slot] = __uint_as_float(key[j]); }
                INV[(size_t)(tok0 + t) * 16 + e] = sel ? rowbase + slot : -1;
                egt += gt ? 1 : 0; eeq += eq ? 1 : 0; } }
        __syncthreads();
    }
}

__device__ __forceinline__ void ph_gather(const Params& p, int l) {
    const int tid = opaque_tid(), lane = tid & 63, wave = tid >> 6;
    unsigned char* ws = opaque_ptr(p.ws); const int* ROWTOK = (const int*)(ws + WS_ROWTOK);
    const int rows_per_e = (l == 0) ? 1152 : 1024;
    const int nitems = NE * rows_per_e / 8;
    for (int it = blockIdx.x; it < nitems; it += gridDim.x) {
        const int ridx = it * 8 + wave; const int e = ridx / rows_per_e, r = ridx % rows_per_e;
        const int tok = ROWTOK[e * EROWS + r];
        const u32x4* src = (const u32x4*)((const bf16_t*)(ws + WS_H) + (size_t)tok * DM); u32x4* dst = (u32x4*)((bf16_t*)(ws + WS_PA) + ((size_t)e * EROWS + r) * DM);
#pragma unroll
        for (int j = 0; j < 4; ++j) dst[j * 64 + lane] = src[j * 64 + lane];
    }
}

__device__ __forceinline__ void ph_combine(const Params& p, int l) {
    const int tid = opaque_tid(), lane = tid & 63, wave = tid >> 6;
    unsigned char* ws = opaque_ptr(p.ws); const float* mod = (const float*)(ws + WS_MOD);
    const int nrows = (l == 0) ? MT : NLAT;
    const int* INV = (const int*)(ws + WS_INV); const bf16_t* YS = (const bf16_t*)(ws + WS_YS);
    for (int it = blockIdx.x; it < nrows / 8; it += gridDim.x) {
        const int row = it * 8 + wave; const int rr = row < NLAT ? (row >> 11) : 4;
        const bf16_t* xr = (const bf16_t*)(ws + WS_XB) + (size_t)row * DM;
        f32x4 x[8], s[8], y[8];
#pragma unroll
        for (int j = 0; j < 8; ++j) { const u32x2 xv = *(const u32x2*)(xr + j * 256 + lane * 4); x[j] = (f32x4){bflo(xv.x), bfhi(xv.x), bflo(xv.y), bfhi(xv.y)}; s[j] = (f32x4){0.f, 0.f, 0.f, 0.f}; }
        const int myinv = lane < 16 ? INV[(size_t)row * 16 + lane] : -1;
        unsigned msk = (unsigned)__ballot(myinv >= 0);
        while (msk) {
            const int e0 = __builtin_ctz(msk); msk &= msk - 1; const bool two = msk != 0u; const int e1 = two ? __builtin_ctz(msk) : e0; if (two) msk &= msk - 1;
            const int r0 = __shfl(myinv, e0), r1 = __shfl(myinv, e1);
            const bf16_t* y0 = YS + ((size_t)e0 * EROWS + r0) * DM; const bf16_t* y1 = YS + ((size_t)e1 * EROWS + r1) * DM;
            u32x2 v0[8], v1[8];
#pragma unroll
            for (int j = 0; j < 8; ++j) { v0[j] = *(const u32x2*)(y0 + j * 256 + lane * 4); v1[j] = *(const u32x2*)(y1 + j * 256 + lane * 4); }
            const float f1 = two ? 1.0f : 0.0f;
#pragma unroll
            for (int j = 0; j < 8; ++j) { s[j][0] += bflo(v0[j].x) + f1 * bflo(v1[j].x); s[j][1] += bfhi(v0[j].x) + f1 * bfhi(v1[j].x); s[j][2] += bflo(v0[j].y) + f1 * bflo(v1[j].y); s[j][3] += bfhi(v0[j].y) + f1 * bfhi(v1[j].y); }
        }
        const float* gate = mod + (size_t)(l * 5 + rr) * 12288 + 5 * DM;
#pragma unroll
        for (int j = 0; j < 8; ++j) { const f32x4 gv = *(const f32x4*)(gate + j * 256 + lane * 4); x[j] += gv * s[j]; }
        if (l == 0) {
            bf16_t* xo = (bf16_t*)(ws + WS_XA) + (size_t)row * DM;
#pragma unroll
            for (int j = 0; j < 8; ++j) { u32x2 w; w.x = cvt_pk_bf16(x[j][0], x[j][1]); w.y = cvt_pk_bf16(x[j][2], x[j][3]); *(u32x2*)(xo + j * 256 + lane * 4) = w; }
            const float* m = mod + (size_t)(5 + rr) * 12288;
            rms_mod_store(x, p.in[I_N1G] + DM, m + DM, m, (bf16_t*)(ws + WS_H) + (size_t)row * DM, y, lane);
        } else {
            float ss = 0.f;
#pragma unroll
            for (int j = 0; j < 8; ++j) ss += x[j][0] * x[j][0] + x[j][1] * x[j][1] + x[j][2] * x[j][2] + x[j][3] * x[j][3];
            ss = wave_sum(ss); const float rinv = rsqrtf(ss * (1.0f / DM) + EPS);
            float* orow = p.out + (size_t)row * DM;
#pragma unroll
            for (int j = 0; j < 8; ++j) { const f32x4 gv = *(const f32x4*)(p.in[I_FNG] + j * 256 + lane * 4); *(f32x4*)(orow + j * 256 + lane * 4) = x[j] * rinv * gv; }
        }
    }
}

constexpr int NPH_LAYER = 13, NPH = 2 + 2 * NPH_LAYER;
__global__ void __launch_bounds__(512, 2) fwd(Params p) {
    extern __shared__ __attribute__((aligned(16))) unsigned char lds_raw[];
    LAS unsigned char* lds = (LAS unsigned char*)lds_raw;
    volatile LAS unsigned* MISC = (volatile LAS unsigned*)(lds + LDS_MISC);
    if (threadIdx.x < 16) MISC[threadIdx.x] = 0u;
    __syncthreads();
    unsigned char* ws = p.ws;
    const int lo = p.ph_lo, hi = p.ph_hi;
    XcdBarrier bar; bar.bar = (unsigned*)(ws + WS_CTL); bar.x = 0; bar.st = MISC;
    if (hi - lo > 1) bar = xcd_barrier_post((unsigned*)(ws + WS_CTL), MISC);
    const int G = gridDim.x, c = blockIdx.x;
#ifndef NCONV_A
#define NCONV_A 48
#endif
#ifndef NCONV_G
#define NCONV_G 48
#endif
#ifndef NCONV_K
#define NCONV_K 32
#endif
    const int nconv = (G == 256) ? 1 : 0;
    const int GgA = G - nconv * NCONV_A, GgG = G - nconv * NCONV_G, GgK = G - nconv * NCONV_K;
#ifndef ONLY_PH
#define ONLY_PH -1
#endif
#define PSEL(id) (ONLY_PH < 0 || ONLY_PH == (id))
#ifndef DUP
#define DUP 0
#endif
#define NREP(id) ((((DUP) >> (id)) & 1) ? 2 : 1)
#define REPLOOP(id) for (int rep_ = 0; rep_ < NREP(id); ++rep_)
#define REPBAR(id) do { if (rep_ + 1 < NREP(id)) xcd_barrier(bar); } while (0)
#define IN(k) (lo <= (k) && (k) < hi)
#define SEAM(k) do { if (IN(k) && IN((k) + 1)) xcd_barrier(bar); } while (0)

    if (PSEL(0) && IN(0)) REPLOOP(0) { ph_prologue(p, lds); __syncthreads(); REPBAR(0); }
    SEAM(0);
    if (PSEL(1) && IN(1)) REPLOOP(1) { ph_norm1_tables(p); REPBAR(1); }
    SEAM(1);
    for (int l = 0; l < 2; ++l) {
        const int pb = 2 + NPH_LAYER * l;
        const float* mod = (const float*)(ws + WS_MOD) + (size_t)l * 5 * 12288;
        if (PSEL(2) && IN(pb + 0)) REPLOOP(2) {
            pg8::EpiStoreBf16 E{(bf16_t*)(ws + WS_PA), INP};
            if (l == 0) { if (c >= GgA) moe_convert_while(p, lds, pb + 0, GgA);
                else { pg8::TileSched S; S.init(ws + WS_H, (bf16_t*)(ws + WS_WTIN), DM, DM, MT / 256, INP / 256, 1, 0, 0, GgA, c, 0); pg8::gemm_phase(lds, pg8::Desc{DM, DM, DM}, S, E); if (nconv) moe_mark_done(p, pb + 0); } }
            else { pg8::InSchedLast S; S.init(ws + WS_H, (bf16_t*)(ws + WS_WTIN) + (size_t)INP * DM, G, c); pg8::gemm_phase(lds, pg8::Desc{DM, DM, DM}, S, E); }
            moe_fill(p, lds, pb + 0);
         REPBAR(2); }
        SEAM(pb + 0);
        if (PSEL(3) && IN(pb + 1)) REPLOOP(3) { ph_rowsplit(p, l, lds); __syncthreads();  REPBAR(3); }
        SEAM(pb + 1);
        if (PSEL(4) && IN(pb + 2)) REPLOOP(4) {
#ifndef C_SEL
#define C_SEL 15
#endif
            if (C_SEL & 1) { pg8::TileSched S; S.init(ws + WS_QA, (bf16_t*)(ws + WS_WTUQ) + (size_t)l * 768 * 384, 384, 384, (l == 0 ? MT : NLAT) / 256, 3, 1, 0, 0, G, c, 0);
              pg8::EpiQ E{(bf16_t*)(ws + WS_QB), (const f32x2*)(ws + WS_ROPE)}; pg8::gemm_phase(lds, pg8::Desc{384, 384, 384}, S, E); }
            if (C_SEL & 2) { pg8::TileSched S; S.init(ws + WS_KVA, (bf16_t*)(ws + WS_WTUKV) + (size_t)l * 1024 * 256, 256, 256, MT / 256, 2, 1, 0, 0, G, c, 112);
              pg8::EpiK E{(bf16_t*)(ws + WS_KC)}; pg8::gemm_phase(lds, pg8::Desc{256, 256, 256}, S, E); }
            if (C_SEL & 4) { pg8::TileSched S; S.init((bf16_t*)(ws + WS_WTUKV) + (size_t)l * 1024 * 256 + 512 * 256, ws + WS_KVA, 256, 256, 2, MT / 256, 1, 0, 0, G, c, 184);
              pg8::EpiV E{(bf16_t*)(ws + WS_VT)}; pg8::gemm_phase(lds, pg8::Desc{256, 256, 256}, S, E); }
            if (C_SEL & 8) { pg8::TileSched S; S.init(ws + WS_UPK, (bf16_t*)(ws + WS_WST) + (size_t)l * 32 * 256 * 256, 512, 256, 3, 1, 32, (size_t)768 * 512 * 2, (size_t)256 * 256 * 2, G, c, 0);
              pg8::EpiS1 E{(float*)(ws + WS_EST)}; pg8::gemm_phase(lds, pg8::Desc{512, 256, 256}, S, E); }
            moe_fill(p, lds, pb + 2);
         REPBAR(4); }
        SEAM(pb + 2);
        if (PSEL(5) && IN(pb + 3)) REPLOOP(5) { ph_attn_carry(p, l, lds); __syncthreads();  REPBAR(5); }
        SEAM(pb + 3);
        if (PSEL(6) && IN(pb + 4)) REPLOOP(6) {
            pg8::TileSched S; S.init(ws + WS_UPK, (bf16_t*)(ws + WS_G2B) + (size_t)l * 32 * 256 * 512, 512, 512, 3, 1, 32, (size_t)768 * 512 * 2, (size_t)256 * 512 * 2, G, c, 0);
            pg8::EpiS2 E{(bf16_t*)(ws + WS_GB)}; pg8::gemm_phase(lds, pg8::Desc{512, 512, 512}, S, E);
            moe_fill(p, lds, pb + 4);
         REPBAR(6); }
        SEAM(pb + 4);
        if (PSEL(7) && IN(pb + 5)) REPLOOP(7) {
            pg8::TileSched S; S.init(ws + WS_GB, (bf16_t*)(ws + WS_WTGLU) + (size_t)l * 512 * 512, 512, 512, (l == 0 ? MT : NLAT) / 256, 2, 1, 0, 0, G, c, 0);
            pg8::EpiGlu E{(const bf16_t*)(ws + WS_GB), p.in[I_BGLU] + l * 512, (bf16_t*)(ws + WS_CAT)}; pg8::gemm_phase(lds, pg8::Desc{512, 512, 512}, S, E);
            moe_fill(p, lds, pb + 5);
         REPBAR(7); }
        SEAM(pb + 5);
        if (PSEL(8) && IN(pb + 6)) REPLOOP(8) {
            pg8::TileSched S; S.init(ws + WS_CAT, (bf16_t*)(ws + WS_WTOUT) + (size_t)l * DM * DM, DM, DM, (l == 0 ? MT : NLAT) / 256, DM / 256, 1, 0, 0, l == 0 ? GgG : G, c, 0);
            pg8::EpiOut E{p.in[I_X], p.in[I_CTX], l == 0 ? (const bf16_t*)nullptr : (const bf16_t*)(ws + WS_XA), mod + 2 * DM, (bf16_t*)(ws + WS_XB)};
            if (l == 0 && c >= GgG) moe_convert_while(p, lds, pb + 6, GgG); else { pg8::gemm_phase(lds, pg8::Desc{DM, DM, DM}, S, E); if (l == 0 && nconv) moe_mark_done(p, pb + 6); }
            moe_fill(p, lds, pb + 6);
         REPBAR(8); }
        SEAM(pb + 6);
        if (PSEL(9) && IN(pb + 7)) REPLOOP(9) { ph_norm2_router(p, l, lds); __syncthreads(); REPBAR(9); }
        SEAM(pb + 7);
        if (PSEL(10) && IN(pb + 8)) REPLOOP(10) { ph_topk(p, l, lds); __syncthreads(); moe_require(p, lds, l * Q_LAYER + Q_GU);  REPBAR(10); }
        if (PSEL(11) && IN(pb + 9)) REPLOOP(11) { }
        SEAM(pb + 9);
        if (PSEL(12) && IN(pb + 10)) REPLOOP(12) {
            pg8::MoeSched S; S.init(ws + WS_H, (bf16_t*)(ws + WS_WTGU) + (size_t)l * NE * 2048 * DM, DM, DM, l == 0 ? 5 : 4, 8, 0, (size_t)2048 * DM * 2, l == 0 ? GgK : G, c);
            pg8::EpiGU E{(bf16_t*)(ws + WS_HID)};
            if (l == 0 && c >= GgK) moe_convert_while(p, lds, pb + 10, GgK); else { pg8::gemm_phase<pg8::EpiGU, pg8::MoeSched, true>(lds, pg8::Desc{DM, DM, DM}, S, E, (const int*)(ws + WS_ROWTOK), l == 0 ? 1152 : 1024); if (l == 0 && nconv) moe_mark_done(p, pb + 10); }
            moe_require(p, lds, (l + 1) * Q_LAYER); moe_fill(p, lds, pb + 10);
         REPBAR(12); }
        SEAM(pb + 10);
        if (PSEL(13) && IN(pb + 11)) REPLOOP(13) {
            pg8::MoeSched S; S.init(ws + WS_HID, (bf16_t*)(ws + WS_WTDN) + (size_t)l * NE * DM * FF, FF, FF, l == 0 ? 5 : 4, 8, (size_t)EROWS * FF * 2, (size_t)DM * FF * 2, l == 0 ? GgK : G, c);
            pg8::EpiDown E{(bf16_t*)(ws + WS_YS), (const float*)(ws + WS_ROWAFF)};
            if (l == 0 && c >= GgK) moe_convert_while(p, lds, pb + 11, GgK); else { pg8::gemm_phase(lds, pg8::Desc{FF, FF, FF}, S, E); if (l == 0 && nconv) moe_mark_done(p, pb + 11); }
            moe_fill(p, lds, pb + 11);
         REPBAR(13); }
        SEAM(pb + 11);
        if (PSEL(14) && IN(pb + 12)) REPLOOP(14) { ph_combine(p, l);  REPBAR(14); }
        SEAM(pb + 12);
    }
#undef IN
#undef SEAM
}

extern "C" void kernel_launch(void* const* d_in, const int* in_sizes, int n_in, void* d_out, int out_size, void* d_ws, size_t ws_size, hipStream_t stream) {
    static int grid = 0;
    if (grid == 0) {
        if (n_in != 33 || ws_size < WS_END) { fprintf(stderr, "kernel_launch: need 33 inputs and >= %zu bytes of workspace; got %d, %zu\n", (size_t)WS_END, n_in, ws_size); grid = -1; return; }
        int dev = 0, cus = 0;
        if (hipGetDevice(&dev) != hipSuccess || hipDeviceGetAttribute(&cus, hipDeviceAttributeMultiprocessorCount, dev) != hipSuccess) { grid = -1; return; }
        if (hipFuncSetAttribute((const void*)fwd, hipFuncAttributeMaxDynamicSharedMemorySize, LDS_BYTES) != hipSuccess) { fprintf(stderr, "kernel_launch: hipFuncSetAttribute failed\n"); grid = -1; return; }
        (void)hipGetLastError();
        grid = cus > 256 ? 256 : cus;
    }
    if (grid < 0) return;
    (void)hipMemsetAsync((char*)d_ws + WS_CTL, 0, CTL_BYTES, stream);
    Params a{};
    for (int i = 0; i < 33; ++i) a.in[i] = (const float*)d_in[i];
    a.out = (float*)d_out; a.ws = (unsigned char*)d_ws;
#if MK_SPLIT
    for (int ph = 0; ph < NPH; ++ph) { a.ph_lo = ph; a.ph_hi = ph + 1; hipLaunchKernelGGL(fwd, dim3(grid), dim3(512), LDS_BYTES, stream, a); }
#else
    a.ph_lo = 0; a.ph_hi = NPH; hipLaunchKernelGGL(fwd, dim3(grid), dim3(512), LDS_BYTES, stream, a);
#endif
}
```

```cpp
#include <hip/hip_runtime.h>
#include <cstdint>
#include <cstdio>

#ifndef MK_SPLIT
#define MK_SPLIT 0
#endif

#define LAS __attribute__((address_space(3)))
typedef unsigned short bf16_t;
typedef short bf16x8 __attribute__((ext_vector_type(8)));
typedef short bf16x4 __attribute__((ext_vector_type(4)));
typedef float f32x4 __attribute__((ext_vector_type(4)));
typedef float f32x2 __attribute__((ext_vector_type(2)));
typedef unsigned u32x4 __attribute__((ext_vector_type(4)));
typedef unsigned u32x2 __attribute__((ext_vector_type(2)));
typedef float f32x16 __attribute__((ext_vector_type(16)));

constexpr int DM = 2048, NB = 4, SEQ = 2048, CTX = 256, NLAT = NB * SEQ, NCTX = NB * CTX, MT = NLAT + NCTX;
constexpr int INC = 3776, INP = 3840;
constexpr int C_SGU_U = 0, C_SGU_V = 512, C_CQ = 1024, C_CKV = 1408, C_KR = 1664, C_S5 = 1728, C_CVB = 2240, C_CVC = 2752, C_CVH = 3264;
constexpr int NKEY = CTX + SEQ;
constexpr int NE = 16, FF = 1024, CAPL = 256, CAPC = 32, EROWS = 1280;
constexpr int NCHUNK = MT / 16;
constexpr float EPS = 1e-6f;
constexpr float QSCALE = 0.07216878364870322f * 1.4426950408889634f;

constexpr size_t al256(size_t x) { return (x + 255) & ~(size_t)255; }
constexpr size_t WS_CTL = 0;
constexpr size_t CTL_BYTES = 65536;
constexpr size_t WS_MOD = WS_CTL + CTL_BYTES;
constexpr size_t WS_WTIN = al256(WS_MOD + (size_t)2 * 5 * 12288 * 4);
constexpr size_t WS_WTOUT = al256(WS_WTIN + (size_t)2 * INP * DM * 2);
constexpr size_t WS_WTUQ = al256(WS_WTOUT + (size_t)2 * DM * DM * 2);
constexpr size_t WS_WTUKV = al256(WS_WTUQ + (size_t)2 * 768 * 384 * 2);
constexpr size_t WS_WTGLU = al256(WS_WTUKV + (size_t)2 * 1024 * 256 * 2);
constexpr size_t WS_WTGU = al256(WS_WTGLU + (size_t)2 * 512 * 512 * 2);
constexpr size_t WS_WTDN = al256(WS_WTGU + (size_t)2 * NE * 2048 * DM * 2);
constexpr size_t WS_PW = al256(WS_WTDN + (size_t)2 * NE * DM * FF * 2);
constexpr size_t WS_BB = al256(WS_PW + (size_t)2 * 2 * 32 * 64 * 17 * 8);
constexpr size_t WS_KZ = al256(WS_BB + (size_t)2 * 2 * 32 * 64 * 16 * 8);
constexpr size_t WS_WST = al256(WS_KZ + (size_t)2 * 2 * 32 * 4096 * 4);
constexpr size_t WS_G2B = al256(WS_WST + (size_t)2 * 32 * 256 * 256 * 2);
constexpr size_t WS_H = al256(WS_G2B + (size_t)2 * 32 * 256 * 512 * 2);
constexpr size_t WS_PA = al256(WS_H + (size_t)MT * DM * 2);
constexpr size_t PA_BYTES = (size_t)NE * EROWS * DM * 2;
static_assert(PA_BYTES >= (size_t)MT * INP * 2, "P fits in the union");
constexpr size_t WS_XA = al256(WS_PA + PA_BYTES);
constexpr size_t WS_XB = al256(WS_XA + (size_t)MT * DM * 4);
constexpr size_t WS_CAT = al256(WS_XB + (size_t)MT * DM * 4);
constexpr size_t WS_QA = al256(WS_CAT + (size_t)MT * DM * 2);
constexpr size_t WS_KVA = al256(WS_QA + (size_t)MT * 384 * 2);
constexpr size_t WS_QB = al256(WS_KVA + (size_t)MT * 256 * 2);
constexpr size_t WS_KC = al256(WS_QB + (size_t)MT * 768 * 2);
constexpr size_t WS_VT = al256(WS_KC + (size_t)NB * 4 * NKEY * 192 * 2);
constexpr size_t WS_UPK = al256(WS_VT + (size_t)NB * 4 * 128 * NKEY * 2);
constexpr size_t WS_EST = al256(WS_UPK + (size_t)32 * 768 * 512 * 2);
constexpr size_t WS_GB = al256(WS_EST + (size_t)32 * 768 * 256 * 4);
constexpr size_t WS_AFF = al256(WS_GB + (size_t)MT * 512 * 2);
constexpr size_t WS_ROWTOK = al256(WS_AFF + (size_t)MT * 16 * 4);
constexpr size_t WS_ROWAFF = al256(WS_ROWTOK + (size_t)NE * EROWS * 4);
constexpr size_t WS_INV = al256(WS_ROWAFF + (size_t)NE * EROWS * 4);
constexpr size_t WS_HID = al256(WS_INV + (size_t)MT * 16 * 4);
constexpr size_t WS_YS = al256(WS_HID + (size_t)NE * EROWS * FF * 2);
constexpr size_t WS_ROPE = al256(WS_YS + (size_t)NE * EROWS * DM * 2);
constexpr size_t WS_A16 = al256(WS_ROPE + 64 * 16 * 8);
constexpr size_t WS_END = al256(WS_A16 + (size_t)2 * 2 * 32 * 64 * 8);

constexpr int LDS_GEMM = 131072;
constexpr int LDS_ATTN = 3 * 44032;
constexpr int LDS_MISC = 133120;
constexpr int LDS_BYTES = LDS_MISC + 256;
static_assert(LDS_ATTN <= LDS_MISC && LDS_GEMM <= LDS_MISC, "LDS map");

typedef __bf16 bf16x2_t __attribute__((ext_vector_type(2)));
__device__ __forceinline__ unsigned cvt_pk_bf16(float lo, float hi) { const f32x2 v = {lo, hi}; const bf16x2_t b = __builtin_convertvector(v, bf16x2_t); return __builtin_bit_cast(unsigned, b); }
__device__ __forceinline__ float bf2f(unsigned short b) { return __uint_as_float(((unsigned)b) << 16); }
__device__ __forceinline__ float bflo(unsigned w) { return __uint_as_float(w << 16); }
__device__ __forceinline__ float bfhi(unsigned w) { return __uint_as_float(w & 0xffff0000u); }
__device__ __forceinline__ unsigned short f2bf(float f) { return (unsigned short)(cvt_pk_bf16(f, 0.f) & 0xffffu); }
__device__ __forceinline__ int opaque_tid() { int t = threadIdx.x; asm volatile("" : "+v"(t)); return t; }
__device__ __forceinline__ unsigned char* opaque_ptr(unsigned char* q) { long z = 0; asm volatile("" : "+s"(z)); return q + z; }
__device__ __forceinline__ float wave_sum(float v) {
#pragma unroll
    for (int o = 32; o >= 1; o >>= 1) v += __shfl_xor(v, o);
    return v;
}
__device__ __forceinline__ float gelu_tanh(float x) {
    const float y = x * (-2.3022081986679503f - 0.10294324069457f * x * x);
    return x * __builtin_amdgcn_rcpf(1.0f + __builtin_amdgcn_exp2f(y));
}
__device__ __forceinline__ float silu_f(float x) { return x * __builtin_amdgcn_rcpf(1.0f + __builtin_amdgcn_exp2f(-1.4426950408889634f * x)); }
__device__ __forceinline__ float sigmoid_f(float x) { return __builtin_amdgcn_rcpf(1.0f + __builtin_amdgcn_exp2f(-1.4426950408889634f * x)); }

#define XB_TMO      128
#define XB_XCNT(j)  (256  + 64 * (j))
#define XB_XSUB(j)  (1280 + 64 * (j))
#define XB_XGEN(j)  (2304 + 64 * (j))
#define XB_TOP      3328
#define XB_TOPGEN   3392
#define XCD_BAR_WORDS 3456
#define XB_SPIN_CAP (1u << 22)
__device__ __forceinline__ unsigned xb_ld(unsigned* p)              { return __hip_atomic_load(p, __ATOMIC_RELAXED, __HIP_MEMORY_SCOPE_AGENT); }
__device__ __forceinline__ unsigned xb_add(unsigned* p, unsigned v) { return __hip_atomic_fetch_add(p, v, __ATOMIC_RELAXED, __HIP_MEMORY_SCOPE_AGENT); }
__device__ __forceinline__ unsigned xb_xcc_id() { return (unsigned)__builtin_amdgcn_s_getreg((3 << 11) | 20) & 0xFu; }
#define XB_SPIN(cond, bar) do { unsigned _sp = 0; while (cond) { __builtin_amdgcn_s_sleep(1); \
    if ((++_sp & 255u) == 0u) { if (xb_ld(&(bar)[XB_TMO])) break; if (_sp > XB_SPIN_CAP) { atomicAdd(&(bar)[XB_TMO], 1u); break; } } } } while (0)
struct XcdBarrier { unsigned* bar; unsigned x; volatile LAS unsigned* st; };
__device__ __forceinline__ XcdBarrier xcd_barrier_post(unsigned* bar, volatile LAS unsigned* st) {
    XcdBarrier b; b.bar = bar; b.x = xb_xcc_id(); b.st = st;
    if (threadIdx.x == 0) (void)xb_add(&bar[XB_XCNT(b.x)], 1u);
    return b;
}
__device__ __forceinline__ void xcd_barrier_complete(unsigned* bar, unsigned x, unsigned& nloc, unsigned& nx) {
    const unsigned G = gridDim.x * gridDim.y * gridDim.z;
    unsigned sum, cnt, mine, sp = 0u;
    for (;;) {
        sum = 0u; cnt = 0u; mine = 0u;
#pragma unroll
        for (unsigned j = 0; j < 16; ++j) { const unsigned c = xb_ld(&bar[XB_XCNT(j)]); sum += c; cnt += (c > 0u) ? 1u : 0u; mine = (j == x) ? c : mine; }
        if (sum == G) break;
        __builtin_amdgcn_s_sleep(1);
        if ((++sp & 255u) == 0u) { if (xb_ld(&bar[XB_TMO])) break; if (sp > XB_SPIN_CAP) { atomicAdd(&bar[XB_TMO], 1u); break; } }
    }
    nloc = mine > 0u ? mine : 1u; nx = cnt > 0u ? cnt : 1u;
}
__device__ __forceinline__ void xcd_barrier(const XcdBarrier& b) {
    asm volatile("s_waitcnt vmcnt(0)" ::: "memory");
    __syncthreads();
    if (threadIdx.x == 0) {
        unsigned* bar = b.bar;
        __builtin_amdgcn_s_waitcnt(0);
        unsigned nloc = b.st[0], nx = b.st[1];
        if (nloc == 0u) { xcd_barrier_complete(bar, b.x, nloc, nx); b.st[0] = nloc; b.st[1] = nx; }
        const unsigned old = xb_add(&bar[XB_XSUB(b.x)], 1u);
        const unsigned gen = old / nloc;
        if (old + 1u == (gen + 1u) * nloc) {
            __builtin_amdgcn_fence(__ATOMIC_RELEASE, "agent");
            asm volatile("s_waitcnt vmcnt(0)" ::: "memory");
            const unsigned og = xb_add(&bar[XB_TOP], 1u);
            const unsigned tg = og / nx;
            if (og + 1u == (tg + 1u) * nx) xb_add(&bar[XB_TOPGEN], 1u);
            else XB_SPIN(xb_ld(&bar[XB_TOPGEN]) == tg, bar);
            __builtin_amdgcn_fence(__ATOMIC_ACQUIRE, "agent");
            xb_add(&bar[XB_XGEN(b.x)], 1u);
            asm volatile("s_waitcnt vmcnt(0)" ::: "memory");
        } else {
            XB_SPIN(xb_ld(&bar[XB_XGEN(b.x)]) == gen, bar);
            __builtin_amdgcn_fence(__ATOMIC_ACQUIRE, "agent");
            asm volatile("s_waitcnt vmcnt(0)" ::: "memory");
        }
    }
    __syncthreads();
}

namespace pg8 {
constexpr int BM = 256, BK = 64, HALF = 128, HTB = HALF * BK * 2, STAGE_BYTES = 8 * HTB;
__host__ __device__ __forceinline__ int lds_byte(int r, int c) { const int st = (r >> 4) * 2 + (c >> 5), rr = r & 15, cc = c & 31, ob = rr * 64 + cc * 2; return st * 1024 + (ob ^ (((ob >> 9) & 1) << 5)); }
__host__ __device__ __forceinline__ void stage_rc(int b, int& R, int& C) { const int st = b / 1024, sb = b % 1024, swz = sb ^ (((sb >> 9) & 1) << 5); R = (st >> 1) * 16 + swz / 64; C = (st & 1) * 32 + (swz % 64) / 2; }
__host__ __device__ __forceinline__ int perm32(int rho) { const int n = rho >> 4, i = rho & 15; return 8 * (i >> 2) + 4 * n + (i & 3); }

struct Unit { const char* a; const char* b; int pm, pn, pb; };
struct Desc { int lda, ldb, K; };

struct TileSched {
    const char* A; const char* B; size_t sA, sB;
    int lda, ldb, nM, nN, nB, G, c;
    __device__ __forceinline__ void init(const void* A_, const void* B_, int lda_, int ldb_, int nM_, int nN_, int nB_, size_t sA_, size_t sB_, int G_, int c_, int off) {
        A = (const char*)A_; B = (const char*)B_; lda = lda_; ldb = ldb_; nM = nM_; nN = nN_; nB = nB_; sA = sA_; sB = sB_; G = G_; c = (c_ + G_ - (off % G_)) % G_; }
    __device__ __forceinline__ bool next(int i, Unit& u) const {
        const int nwg = nM * nN; const long L = (long)i * G + c; if (L >= (long)nwg * nB) return false;
        const int pb = (int)(L / nwg); int wgid = (int)(L % nwg);
        { const int q = nwg / 8, r = nwg % 8, xcd = wgid % 8, off = wgid / 8; wgid = (xcd < r ? xcd * (q + 1) : r * (q + 1) + (xcd - r) * q) + off; }
        const int nig = 8 * nN, gid = wgid / nig, fm = gid * 8, gsz = (nM - fm) < 8 ? (nM - fm) : 8;
        u.pm = fm + ((wgid % nig) % gsz); u.pn = (wgid % nig) / gsz; u.pb = pb;
        u.a = A + (size_t)pb * sA + (size_t)u.pm * 256 * lda * 2; u.b = B + (size_t)pb * sB + (size_t)u.pn * 256 * ldb * 2; return true;
    }
};
struct InSchedLast {
    TileSched T;
    __device__ __forceinline__ void init(const void* A_, const void* B_, int G_, int c_) { T.init(A_, B_, DM, DM, NLAT / 256, INP / 256, 1, 0, 0, G_, c_, 0); }
    __device__ __forceinline__ bool next(int i, Unit& u) const {
        const int nlat = (NLAT / 256) * (INP / 256); const long L = (long)i * T.G + T.c;
        if (L < nlat) return T.next(i, u);
        if (L >= nlat + 16) return false;
        const int k = (int)(L - nlat); u.pm = NLAT / 256 + (k >> 2); u.pn = 5 + (k & 3); u.pb = 0;
        u.a = T.A + (size_t)u.pm * 256 * DM * 2; u.b = T.B + (size_t)u.pn * 256 * DM * 2; return true;
    }
};
struct MoeSched {
    const char* A; const char* B; size_t sA, sB; int lda, ldb, nM, nN, G, c;
    __device__ __forceinline__ void init(const void* A_, const void* B_, int lda_, int ldb_, int nM_, int nN_, size_t sA_, size_t sB_, int G_, int c_) {
        A = (const char*)A_; B = (const char*)B_; lda = lda_; ldb = ldb_; nM = nM_; nN = nN_; sA = sA_; sB = sB_; G = G_; c = c_; }
    __device__ __forceinline__ bool next(int i, Unit& u) const {
        int e, rem; const int per = nM * nN;
        if ((G & 7) == 0) { const int x = c & 7, j = c >> 3, w = G >> 3; const int L = i * w + j; if (L >= 2 * per) return false; e = 2 * x + L / per; rem = L % per; }
        else { const long L = (long)i * G + c; if (L >= (long)NE * per) return false; e = (int)(L / per); rem = (int)(L % per); }
        u.pn = rem / nM; u.pm = rem % nM; u.pb = e;
        u.a = sA == 0 ? A : A + (size_t)e * sA + (size_t)u.pm * 256 * lda * 2; u.b = B + (size_t)e * sB + (size_t)u.pn * 256 * ldb * 2; return true;
    }
};

template <class Epi, class Sched, bool GATHER = false>
__device__ __forceinline__ void gemm_phase(LAS unsigned char* lds, const Desc g, const Sched& S, const Epi& E, const int* rowtok = nullptr, int nvalid = 0) {
    const int tid = opaque_tid(), wid = __builtin_amdgcn_readfirstlane(tid >> 6), lane = tid & 63, wr = wid >> 2, wc = wid & 3, fr = lane & 15, fq = lane >> 4;
    const int K = g.K, nt = K / BK;
    unsigned voffA[2], voffB[2]; int gR[2], gCc[2];
#pragma unroll
    for (int i = 0; i < 2; ++i) { int R, C; stage_rc(tid * 16 + i * 8192, R, C); const int Rb = Epi::PERM ? ((R & ~31) + perm32(R & 31)) : R;
        voffA[i] = (unsigned)(R * g.lda + C) * 2u; voffB[i] = (unsigned)(Rb * g.ldb + C) * 2u; gR[i] = R; gCc[i] = C; }
    unsigned gC[2][2], gN[2][2];
#define PG8_GOFF(u, o) do { _Pragma("unroll") for (int _h = 0; _h < 2; ++_h) _Pragma("unroll") for (int _i = 0; _i < 2; ++_i) { const int _r = (u).pm * 256 + _h * 128 + gR[_i]; \
        const int _tok = _r < nvalid ? rowtok[(u).pb * EROWS + _r] : 0; (o)[_h][_i] = (unsigned)(_tok * g.lda + gCc[_i]) * 2u; } } while (0)
    const size_t kstep = (size_t)(BK * 2);
    const size_t hstepA = (size_t)HALF * g.lda * 2, hstepB = (size_t)HALF * g.ldb * 2;
    const unsigned ldsw = (unsigned)wid * 1024u;
    const int aoff = lds_byte(wr * 64 + fr, fq * 8), boff = lds_byte(wc * 32 + fr, fq * 8);
#define PG8_SA(b, h) (((b) * 2 + (h)) * HTB)
#define PG8_SB(b, h) ((4 + (b) * 2 + (h)) * HTB)
#define PG8_STAGE(bufoff, gbase, voff) do { _Pragma("unroll") for (int _i = 0; _i < 2; ++_i) \
        __builtin_amdgcn_global_load_lds((const unsigned*)((const char*)(gbase) + (voff)[_i]), (LAS unsigned*)(lds + (bufoff) + ldsw + _i * 8192), 16, 0, 0); } while (0)
#define PG8_STAGE_A(bufoff, kptr, half, VO) do { if constexpr (GATHER) { _Pragma("unroll") for (int _i = 0; _i < 2; ++_i) \
        __builtin_amdgcn_global_load_lds((const unsigned*)((const char*)(kptr) + (VO)[half][_i]), (LAS unsigned*)(lds + (bufoff) + ldsw + _i * 8192), 16, 0, 0); } \
        else { PG8_STAGE(bufoff, (kptr) + (half) * hstepA, voffA); } } while (0)
#define PG8_LDA(dst, b, h) do { _Pragma("unroll") for (int m = 0; m < 4; ++m) _Pragma("unroll") for (int k = 0; k < 2; ++k) dst[m][k] = *(const LAS bf16x8*)(lds + PG8_SA(b, h) + aoff + m * 2048 + k * 1024); } while (0)
#define PG8_LDB(dst, b, h) do { _Pragma("unroll") for (int n = 0; n < 2; ++n) _Pragma("unroll") for (int k = 0; k < 2; ++k) dst[n][k] = *(const LAS bf16x8*)(lds + PG8_SB(b, h) + boff + n * 2048 + k * 1024); } while (0)
#define PG8_MMA(ai, bj, At, Bt) do { __builtin_amdgcn_s_setprio(1); _Pragma("unroll") for (int m = 0; m < 4; ++m) _Pragma("unroll") for (int n = 0; n < 2; ++n) _Pragma("unroll") for (int k = 0; k < 2; ++k) \
        acc[ai][bj][m][n] = __builtin_amdgcn_mfma_f32_16x16x32_bf16(Bt[n][k], At[m][k], acc[ai][bj][m][n], 0, 0, 0); __builtin_amdgcn_s_setprio(0); } while (0)
#define PG8_WAIT_V(n) asm volatile("s_waitcnt vmcnt(" #n ")" ::: "memory")
#define PG8_WAIT_L(n) asm volatile("s_waitcnt lgkmcnt(" #n ")" ::: "memory")
#define PG8_BAR __builtin_amdgcn_s_barrier()
#define PG8_SCHED __builtin_amdgcn_sched_barrier(0)
    Unit cur, nxt; int ui = 0;
    if (!S.next(0, cur)) return;
    f32x4 acc[2][2][4][2];
#pragma unroll
    for (int a = 0; a < 2; ++a)
#pragma unroll
        for (int b = 0; b < 2; ++b)
#pragma unroll
            for (int m = 0; m < 4; ++m)
#pragma unroll
                for (int n = 0; n < 2; ++n) acc[a][b][m][n] = (f32x4){0.f, 0.f, 0.f, 0.f};
    bf16x8 At[4][2], B0[2][2], B1[2][2];
    const char* cA = cur.a; const char* cB = cur.b;
    if constexpr (GATHER) { PG8_GOFF(cur, gC); }
    PG8_STAGE(PG8_SB(0, 0), cB, voffB); PG8_STAGE_A(PG8_SA(0, 0), cA, 0, gC); PG8_STAGE(PG8_SB(0, 1), cB + hstepB, voffB); PG8_STAGE_A(PG8_SA(0, 1), cA, 1, gC);
    if (wr == 1) PG8_BAR;
    PG8_WAIT_V(4); PG8_BAR;
    PG8_STAGE(PG8_SB(1, 0), cB + kstep, voffB); PG8_STAGE_A(PG8_SA(1, 0), cA + kstep, 0, gC); PG8_STAGE(PG8_SB(1, 1), cB + hstepB + kstep, voffB);
    PG8_WAIT_V(6); PG8_BAR;
    for (;;) {
        const bool has_next = S.next(ui + 1, nxt);
        const char* nA = has_next ? nxt.a : cA; const char* nB = has_next ? nxt.b : cB;
        if constexpr (GATHER) { if (has_next) { PG8_GOFF(nxt, gN); } else {
#pragma unroll
            for (int _h = 0; _h < 2; ++_h)
#pragma unroll
                for (int _i = 0; _i < 2; ++_i) gN[_h][_i] = gC[_h][_i]; } }
#pragma nounroll
        for (int t = 0; t < nt; t += 2) {
            const bool last = (t == nt - 2);
            const char* a1 = cA + (size_t)(t + 1) * kstep;
            const char* a2 = last ? nA : cA + (size_t)(t + 2) * kstep; const char* b2 = last ? nB : cB + (size_t)(t + 2) * kstep;
            const char* a3 = a2 + kstep; const char* b3 = b2 + kstep;
            unsigned g2[2][2];
            if constexpr (GATHER) {
#pragma unroll
                for (int _h = 0; _h < 2; ++_h)
#pragma unroll
                    for (int _i = 0; _i < 2; ++_i) g2[_h][_i] = last ? gN[_h][_i] : gC[_h][_i]; }
            PG8_LDB(B0, 0, 0); PG8_SCHED; PG8_LDA(At, 0, 0); PG8_STAGE_A(PG8_SA(1, 1), a1, 1, gC);
            PG8_WAIT_L(8); PG8_BAR; PG8_WAIT_L(0); PG8_MMA(0, 0, At, B0); PG8_BAR; PG8_SCHED;
            PG8_LDB(B1, 0, 1); PG8_STAGE(PG8_SB(0, 0), b2, voffB);
            PG8_BAR; PG8_WAIT_L(0); PG8_MMA(0, 1, At, B1); PG8_BAR;
            PG8_LDA(At, 0, 1); PG8_STAGE_A(PG8_SA(0, 0), a2, 0, g2);
            PG8_BAR; PG8_WAIT_L(0); PG8_MMA(1, 0, At, B0); PG8_BAR; PG8_SCHED;
            PG8_STAGE(PG8_SB(0, 1), b2 + hstepB, voffB);
            PG8_WAIT_V(6); PG8_BAR; PG8_MMA(1, 1, At, B1); PG8_BAR;
            PG8_LDB(B0, 1, 0); PG8_SCHED; PG8_LDA(At, 1, 0); PG8_STAGE_A(PG8_SA(0, 1), a2, 1, g2);
            PG8_WAIT_L(8); PG8_BAR; PG8_WAIT_L(0); PG8_MMA(0, 0, At, B0); PG8_BAR; PG8_SCHED;
            PG8_LDB(B1, 1, 1); PG8_STAGE(PG8_SB(1, 0), b3, voffB);
            PG8_BAR; PG8_WAIT_L(0); PG8_MMA(0, 1, At, B1); PG8_BAR;
            PG8_LDA(At, 1, 1); PG8_STAGE_A(PG8_SA(1, 0), a3, 0, g2);
            PG8_BAR; PG8_WAIT_L(0); PG8_MMA(1, 0, At, B0); PG8_BAR; PG8_SCHED;
            PG8_STAGE(PG8_SB(1, 1), b3 + hstepB, voffB);
            PG8_WAIT_V(6); PG8_BAR; PG8_MMA(1, 1, At, B1); PG8_BAR;
        }
        E(acc, cur, wr, wc, fr, fq);
        if (!has_next) break;
#pragma unroll
        for (int a = 0; a < 2; ++a)
#pragma unroll
            for (int b = 0; b < 2; ++b)
#pragma unroll
                for (int m = 0; m < 4; ++m)
#pragma unroll
                    for (int n = 0; n < 2; ++n) acc[a][b][m][n] = (f32x4){0.f, 0.f, 0.f, 0.f};
        cur = nxt; cA = nA; cB = nB; ++ui;
        if constexpr (GATHER) {
#pragma unroll
            for (int _h = 0; _h < 2; ++_h)
#pragma unroll
                for (int _i = 0; _i < 2; ++_i) gC[_h][_i] = gN[_h][_i]; }
    }
    PG8_WAIT_V(0);
    if (wr == 0) PG8_BAR;
    PG8_BAR;
#undef PG8_SA
#undef PG8_SB
#undef PG8_STAGE
#undef PG8_STAGE_A
#undef PG8_GOFF
#undef PG8_LDA
#undef PG8_LDB
#undef PG8_MMA
#undef PG8_WAIT_V
#undef PG8_WAIT_L
#undef PG8_BAR
#undef PG8_SCHED
}

#define PG8_FOR_PERM(...) \
    _Pragma("unroll") for (int ai = 0; ai < 2; ++ai) _Pragma("unroll") for (int m = 0; m < 4; ++m) { const int tr = ai * 128 + wr * 64 + m * 16 + fr; \
        _Pragma("unroll") for (int bj = 0; bj < 2; ++bj) { const int tc = bj * 128 + wc * 32 + 8 * fq; const f32x4 v0 = acc[ai][bj][m][0], v1 = acc[ai][bj][m][1]; __VA_ARGS__ } }
#define PG8_FOR_NOPERM(...) \
    _Pragma("unroll") for (int ai = 0; ai < 2; ++ai) _Pragma("unroll") for (int m = 0; m < 4; ++m) { const int tr = ai * 128 + wr * 64 + m * 16 + fr; \
        _Pragma("unroll") for (int bj = 0; bj < 2; ++bj) _Pragma("unroll") for (int n = 0; n < 2; ++n) { const int tc = bj * 128 + wc * 32 + 16 * n + 4 * fq; const f32x4 v = acc[ai][bj][m][n]; __VA_ARGS__ } }

typedef const f32x4 (&AccRef)[2][2][4][2];

struct EpiStoreBf16 {
    static constexpr bool PERM = true;
    bf16_t* O; int ldc;
    __device__ __forceinline__ void operator()(AccRef acc, const Unit& u, int wr, int wc, int fr, int fq) const {
        PG8_FOR_PERM({ u32x4 w; w.x = cvt_pk_bf16(v0[0], v0[1]); w.y = cvt_pk_bf16(v0[2], v0[3]); w.z = cvt_pk_bf16(v1[0], v1[1]); w.w = cvt_pk_bf16(v1[2], v1[3]);
            *(u32x4*)(O + (size_t)(u.pm * 256 + tr) * ldc + u.pn * 256 + tc) = w; })
    }
};
struct EpiQ {
    static constexpr bool PERM = false;
    bf16_t* Q; const f32x2* ROPE;
    __device__ __forceinline__ void operator()(AccRef acc, const Unit& u, int wr, int wc, int fr, int fq) const {
#pragma unroll
        for (int ai = 0; ai < 2; ++ai)
#pragma unroll
            for (int m = 0; m < 4; ++m) { const int row = u.pm * 256 + ai * 128 + wr * 64 + m * 16 + fr; const bool lat = row < NLAT; const int t = row & (SEQ - 1);
#pragma unroll
                for (int bj = 0; bj < 2; ++bj) { const int cg = u.pn * 256 + bj * 128 + wc * 32; const int dd = cg % 192; f32x4 a = acc[ai][bj][m][0], b = acc[ai][bj][m][1];
                    if (dd >= 128 && lat) { const int pos = (dd - 128) >= 32 ? (t & 63) : (t >> 6); const f32x4* rp = (const f32x4*)(ROPE + pos * 16 + 4 * fq); const f32x4 r0 = rp[0], r1 = rp[1];
                        const float cs[4] = {r0[0], r0[2], r1[0], r1[2]}, sn[4] = {r0[1], r0[3], r1[1], r1[3]};
#pragma unroll
                        for (int i = 0; i < 4; ++i) { const float x1 = a[i], x2 = b[i]; a[i] = x1 * cs[i] - x2 * sn[i]; b[i] = x2 * cs[i] + x1 * sn[i]; } }
                    a *= QSCALE; b *= QSCALE;
                    bf16_t* o = Q + (size_t)row * 768 + cg + 4 * fq;
                    u32x2 w0; w0.x = cvt_pk_bf16(a[0], a[1]); w0.y = cvt_pk_bf16(a[2], a[3]); *(u32x2*)o = w0;
                    u32x2 w1; w1.x = cvt_pk_bf16(b[0], b[1]); w1.y = cvt_pk_bf16(b[2], b[3]); *(u32x2*)(o + 16) = w1; } }
    }
};
struct EpiK {
    static constexpr bool PERM = true;
    bf16_t* KC;
    __device__ __forceinline__ void operator()(AccRef acc, const Unit& u, int wr, int wc, int fr, int fq) const {
        const int b = u.pm < 32 ? (u.pm >> 3) : (u.pm - 32), key0 = u.pm < 32 ? CTX + (u.pm & 7) * 256 : 0;
        bf16_t* base = KC + ((size_t)(b * 4 + u.pn * 2) * NKEY + key0) * 192 + (size_t)(wr * 64 + fr) * 192 + wc * 32 + 8 * fq;
#pragma unroll
        for (int ai = 0; ai < 2; ++ai)
#pragma unroll
            for (int m = 0; m < 4; ++m)
#pragma unroll
                for (int bj = 0; bj < 2; ++bj) { const f32x4 v0 = acc[ai][bj][m][0], v1 = acc[ai][bj][m][1];
                    u32x4 w; w.x = cvt_pk_bf16(v0[0], v0[1]); w.y = cvt_pk_bf16(v0[2], v0[3]); w.z = cvt_pk_bf16(v1[0], v1[1]); w.w = cvt_pk_bf16(v1[2], v1[3]);
                    *(u32x4*)(base + (size_t)(ai * 128 + m * 16) * 192 + (size_t)bj * NKEY * 192) = w; }
    }
};
struct EpiV {
    static constexpr bool PERM = true;
    bf16_t* VT;
    __device__ __forceinline__ void operator()(AccRef acc, const Unit& u, int wr, int wc, int fr, int fq) const {
        const int b = u.pn < 32 ? (u.pn >> 3) : (u.pn - 32), key0 = u.pn < 32 ? CTX + (u.pn & 7) * 256 : 0;
        bf16_t* base = VT + ((size_t)(b * 4 + u.pm * 2) * 128 + wr * 64 + fr) * NKEY + key0 + wc * 32 + 8 * fq;
#pragma unroll
        for (int ai = 0; ai < 2; ++ai)
#pragma unroll
            for (int m = 0; m < 4; ++m)
#pragma unroll
                for (int bj = 0; bj < 2; ++bj) { const f32x4 v0 = acc[ai][bj][m][0], v1 = acc[ai][bj][m][1];
                    u32x2 w0, w1; w0.x = cvt_pk_bf16(v0[0], v0[1]); w0.y = cvt_pk_bf16(v0[2], v0[3]); w1.x = cvt_pk_bf16(v1[0], v1[1]); w1.y = cvt_pk_bf16(v1[2], v1[3]);
                    bf16_t* q = base + (size_t)(ai * 128 + m * 16) * NKEY + bj * 128; const int odd = fq & 1;
                    *(u32x2*)(q + (odd ? -4 : 0)) = w0; *(u32x2*)(q + (odd ? 4 : 8)) = w1; }
    }
};
struct EpiS1 {
    static constexpr bool PERM = false;
    float* EST;
    __device__ __forceinline__ void operator()(AccRef acc, const Unit& u, int wr, int wc, int fr, int fq) const {
        PG8_FOR_NOPERM({ const int row = u.pm * 256 + tr; if (row < NCHUNK) *(f32x4*)(EST + ((size_t)u.pb * 768 + row) * 256 + tc) = v; })
    }
};
struct EpiS2 {
    static constexpr bool PERM = true;
    bf16_t* GB;
    __device__ __forceinline__ void operator()(AccRef acc, const Unit& u, int wr, int wc, int fr, int fq) const {
        PG8_FOR_PERM({ const int row = u.pm * 256 + tr; if (row < NCHUNK) { const int p = tc >> 4, c = tc & 15;
            u32x4 w; w.x = cvt_pk_bf16(gelu_tanh(v0[0]), gelu_tanh(v0[1])); w.y = cvt_pk_bf16(gelu_tanh(v0[2]), gelu_tanh(v0[3]));
            w.z = cvt_pk_bf16(gelu_tanh(v1[0]), gelu_tanh(v1[1])); w.w = cvt_pk_bf16(gelu_tanh(v1[2]), gelu_tanh(v1[3]));
            *(u32x4*)(GB + (size_t)(row * 16 + p) * 512 + u.pb * 16 + c) = w; } })
    }
};
struct EpiGlu {
    static constexpr bool PERM = true;
    const bf16_t* GB; const float* bias; bf16_t* CAT;
    __device__ __forceinline__ void operator()(AccRef acc, const Unit& u, int wr, int wc, int fr, int fq) const {
        PG8_FOR_PERM({ const int row = u.pm * 256 + tr, col = u.pn * 256 + tc;
            const u32x4 gv = *(const u32x4*)(GB + (size_t)row * 512 + col); const f32x4 b0 = *(const f32x4*)(bias + col), b1 = *(const f32x4*)(bias + col + 4);
            u32x4 w;
            w.x = cvt_pk_bf16(bflo(gv.x) * sigmoid_f(v0[0] + b0[0]), bfhi(gv.x) * sigmoid_f(v0[1] + b0[1]));
            w.y = cvt_pk_bf16(bflo(gv.y) * sigmoid_f(v0[2] + b0[2]), bfhi(gv.y) * sigmoid_f(v0[3] + b0[3]));
            w.z = cvt_pk_bf16(bflo(gv.z) * sigmoid_f(v1[0] + b1[0]), bfhi(gv.z) * sigmoid_f(v1[1] + b1[1]));
            w.w = cvt_pk_bf16(bflo(gv.w) * sigmoid_f(v1[2] + b1[2]), bfhi(gv.w) * sigmoid_f(v1[3] + b1[3]));
            *(u32x4*)(CAT + (size_t)row * DM + 1024 + col) = w; })
    }
};
struct EpiOut {
    static constexpr bool PERM = true;
    const float* xl; const float* xc; const bf16_t* xs; const float* gate; bf16_t* xo;
    __device__ __forceinline__ void operator()(AccRef acc, const Unit& u, int wr, int wc, int fr, int fq) const {
        PG8_FOR_PERM({ const int row = u.pm * 256 + tr, col = u.pn * 256 + tc; const int rr = row < NLAT ? (row >> 11) : 4;
            f32x4 x0, x1;
            if (xs) { const u32x4 xv = *(const u32x4*)(xs + (size_t)row * DM + col); x0 = (f32x4){bflo(xv.x), bfhi(xv.x), bflo(xv.y), bfhi(xv.y)}; x1 = (f32x4){bflo(xv.z), bfhi(xv.z), bflo(xv.w), bfhi(xv.w)}; }
            else { const float* src = (row < NLAT ? xl + (size_t)row * DM : xc + (size_t)(row - NLAT) * DM) + col; x0 = *(const f32x4*)src; x1 = *(const f32x4*)(src + 4); }
            const float* gp = gate + (size_t)rr * 12288 + col; const f32x4 g0 = *(const f32x4*)gp, g1 = *(const f32x4*)(gp + 4);
            x0 += g0 * v0; x1 += g1 * v1;
            u32x4 w; w.x = cvt_pk_bf16(x0[0], x0[1]); w.y = cvt_pk_bf16(x0[2], x0[3]); w.z = cvt_pk_bf16(x1[0], x1[1]); w.w = cvt_pk_bf16(x1[2], x1[3]);
            *(u32x4*)(xo + (size_t)row * DM + col) = w; })
    }
};
struct EpiGU {
    static constexpr bool PERM = true;
    bf16_t* HID;
    __device__ __forceinline__ void operator()(AccRef acc, const Unit& u, int wr, int wc, int fr, int fq) const {
        PG8_FOR_PERM({ const int row = u.pm * 256 + tr, j = (u.pn * 256 + tc) >> 1;
            u32x2 w; w.x = cvt_pk_bf16(silu_f(v0[0]) * v0[1], silu_f(v0[2]) * v0[3]); w.y = cvt_pk_bf16(silu_f(v1[0]) * v1[1], silu_f(v1[2]) * v1[3]);
            *(u32x2*)(HID + ((size_t)u.pb * EROWS + row) * FF + j) = w; })
    }
};
struct EpiDown {
    static constexpr bool PERM = true;
    bf16_t* YS; const float* RA;
    __device__ __forceinline__ void operator()(AccRef acc, const Unit& u, int wr, int wc, int fr, int fq) const {
        PG8_FOR_PERM({ const int row = u.pm * 256 + tr, col = u.pn * 256 + tc; const float a = RA[u.pb * EROWS + row];
            u32x4 w; w.x = cvt_pk_bf16(v0[0] * a, v0[1] * a); w.y = cvt_pk_bf16(v0[2] * a, v0[3] * a); w.z = cvt_pk_bf16(v1[0] * a, v1[1] * a); w.w = cvt_pk_bf16(v1[2] * a, v1[3] * a);
            *(u32x4*)(YS + ((size_t)u.pb * EROWS + row) * DM + col) = w; })
    }
};
}

struct Params { const float* in[33]; float* out; unsigned char* ws; int ph_lo, ph_hi; };
enum { I_X = 0, I_C, I_CTX, I_CCTX, I_N1G, I_N2G, I_WADA, I_BADA, I_WIN, I_WOUT, I_SGUNG, I_SGUW, I_SGUB, I_QNG, I_WUQ, I_KVNG, I_WUKV,
       I_ARE, I_AIM, I_LOGDT, I_BRE, I_BIM, I_CRE, I_CIM, I_S5D, I_WGLU, I_BGLU, I_CONVW, I_WROUTER, I_WGATE, I_WUP, I_WDOWN, I_FNG };

__device__ __forceinline__ void transpose_tile(const float* src, int N, int k0, int n0, bf16_t* dst, int ldd, int rmul, int radd, int remap_kv, LAS float* tile) {
    const int tid = threadIdx.x;
#pragma unroll
    for (int i = 0; i < 2; ++i) { const int r = (tid >> 4) + 32 * i, c4 = (tid & 15) * 4;
        const f32x4 v = *(const f32x4*)(src + (size_t)(k0 + r) * N + n0 + c4);
        tile[r * 65 + c4 + 0] = v[0]; tile[r * 65 + c4 + 1] = v[1]; tile[r * 65 + c4 + 2] = v[2]; tile[r * 65 + c4 + 3] = v[3]; }
    __syncthreads();
    { const int n = tid >> 3, kc = tid & 7; float f[8];
#pragma unroll
        for (int j = 0; j < 8; ++j) f[j] = tile[(kc * 8 + j) * 65 + n];
        int nn = n0 + n; if (remap_kv) nn = ((nn & 255) < 128) ? ((nn >> 8) * 128 + (nn & 127)) : (512 + (nn >> 8) * 128 + (nn & 127));
        const int drow = nn * rmul + radd;
        u32x4 w; w.x = cvt_pk_bf16(f[0], f[1]); w.y = cvt_pk_bf16(f[2], f[3]); w.z = cvt_pk_bf16(f[4], f[5]); w.w = cvt_pk_bf16(f[6], f[7]);
        *(u32x4*)(dst + (size_t)drow * ldd + k0 + kc * 8) = w; }
    __syncthreads();
}
constexpr int N_ADA_UNITS = 192, N_S5T_UNITS = 64, N_ROPE_UNITS = 2;
constexpr int T_WIN = 32 * 14 + 32 * 3  , T_WOUT = 32 * 8  , T_WUQ = 6 * 12, T_WUKV = 4 * 16, T_WGLU = 8 * 8, T_EXP = 512;
constexpr int N_TR = 2 * (T_WIN + T_WOUT + T_WUQ + T_WUKV + T_WGLU);
constexpr int N_PRO_ITEMS = N_ADA_UNITS + N_S5T_UNITS + N_ROPE_UNITS + N_TR;


__device__ __forceinline__ void transpose_block(const float* src, int N, int k0, int n0, bf16_t* dst, int ldd, int rmul, int radd, LAS float* tile  ) {
    const int tid = opaque_tid();
    f32x4 v[8];
#pragma unroll
    for (int i = 0; i < 8; ++i) v[i] = __builtin_nontemporal_load((const f32x4*)(src + (size_t)(k0 + (tid >> 6) + 8 * i) * N + n0 + (tid & 63) * 4));
#pragma unroll
    for (int i = 0; i < 8; ++i) { const int r = (tid >> 6) + 8 * i; *(LAS f32x4*)(tile + r * 260 + (((tid & 63) * 4) ^ (8 * (r >> 3)))) = v[i]; }
    __syncthreads();
#pragma unroll
    for (int i = 0; i < 4; ++i) { const int id = tid + 512 * i, n = id >> 3, kc = id & 7; float f[8];
#pragma unroll
        for (int j = 0; j < 8; ++j) f[j] = tile[(kc * 8 + j) * 260 + (n ^ (8 * kc))];
        u32x4 w; w.x = cvt_pk_bf16(f[0], f[1]); w.y = cvt_pk_bf16(f[2], f[3]); w.z = cvt_pk_bf16(f[4], f[5]); w.w = cvt_pk_bf16(f[6], f[7]);
        __builtin_nontemporal_store(w, (u32x4*)(dst + (size_t)((n0 + n) * rmul + radd) * ldd + k0 + kc * 8)); }
    __syncthreads();
}
constexpr int QB_EXP = T_EXP / 4, Q_GU = NE * 2 * QB_EXP, Q_LAYER = Q_GU + NE * QB_EXP, Q_TOTAL = 2 * Q_LAYER;
constexpr int CW_QHEAD = 4096, CW_DONE = 4160;
static_assert((CW_DONE + 64 * 32) * 4 <= (int)CTL_BYTES, "control words inside the memset region");
__device__ __forceinline__ void moe_convert_block(const Params& p, unsigned char* ws, int t, LAS float* tile) {
    const int l = t / Q_LAYER, r = t % Q_LAYER;
    if (r < Q_GU) { const int e = r / (2 * QB_EXP), rr = r % (2 * QB_EXP), up = rr / QB_EXP, q = rr % QB_EXP; const int le = l * NE + e;
        transpose_block((up ? p.in[I_WUP] : p.in[I_WGATE]) + (size_t)le * DM * FF, FF, (q >> 2) * 64, (q & 3) * 256, (bf16_t*)(ws + WS_WTGU) + (size_t)le * 2048 * DM, DM, 2, up, tile); }
    else { const int r2 = r - Q_GU, e = r2 / QB_EXP, q = r2 % QB_EXP; const int le = l * NE + e;
        transpose_block(p.in[I_WDOWN] + (size_t)le * FF * DM, DM, (q >> 3) * 64, (q & 7) * 256, (bf16_t*)(ws + WS_WTDN) + (size_t)le * DM * FF, FF, 1, 0, tile); }
}
#ifndef FILL_ON
#define FILL_ON 0
#endif
constexpr unsigned Q_BULK = 4;
__device__ __forceinline__ unsigned moe_claim(unsigned* ctl, int ph, int upto, int mode, unsigned target) {
    unsigned t = 0xffffffffu;
    const unsigned head = __hip_atomic_load(ctl + CW_QHEAD, __ATOMIC_RELAXED, __HIP_MEMORY_SCOPE_AGENT);
    const bool go = mode ? (head < (unsigned)upto) : (head < (unsigned)Q_TOTAL && __hip_atomic_load(ctl + CW_DONE + 64 * ph, __ATOMIC_RELAXED, __HIP_MEMORY_SCOPE_AGENT) < target);
    if (go) t = __hip_atomic_fetch_add(ctl + CW_QHEAD, mode ? Q_BULK : 1u, __ATOMIC_RELAXED, __HIP_MEMORY_SCOPE_AGENT);
    return t;
}
__device__ __forceinline__ void moe_pump(const Params& p, LAS unsigned char* lds, int ph, int upto, int mode, unsigned target = 0u, bool count_me = true) {
    unsigned char* ws = opaque_ptr(p.ws); unsigned* ctl = (unsigned*)(ws + WS_CTL);
    LAS float* tile = (LAS float*)lds; volatile LAS unsigned* slot = (volatile LAS unsigned*)(lds + LDS_MISC + 32);
    const int tid = opaque_tid(); const int nblk = mode ? (int)Q_BULK : 1;
    __syncthreads();
    if (tid == 0) { if (mode == 0 && count_me) (void)__hip_atomic_fetch_add(ctl + CW_DONE + 64 * ph, 1u, __ATOMIC_RELAXED, __HIP_MEMORY_SCOPE_AGENT); slot[0] = moe_claim(ctl, ph, upto, mode, target ? target : gridDim.x); }
    __syncthreads();
    for (;;) {
        const unsigned t = slot[0];
        if (t >= (unsigned)Q_TOTAL) break;
        unsigned nxt = 0u;
        if (tid == 0) nxt = moe_claim(ctl, ph, upto, mode, target ? target : gridDim.x);
#pragma unroll 1
        for (int k = 0; k < nblk; ++k) if ((int)t + k < Q_TOTAL) moe_convert_block(p, ws, (int)t + k, tile);
        if (tid == 0) slot[0] = nxt;
        __syncthreads();
    }
}
__device__ __forceinline__ void moe_fill(const Params& p, LAS unsigned char* lds, int ph) { if (FILL_ON) moe_pump(p, lds, ph, Q_TOTAL, 0); }
__device__ __forceinline__ void moe_mark_done(const Params& p, int ph) { if (threadIdx.x == 0) (void)__hip_atomic_fetch_add((unsigned*)(p.ws + WS_CTL) + CW_DONE + 64 * ph, 1u, __ATOMIC_RELAXED, __HIP_MEMORY_SCOPE_AGENT); }
__device__ __forceinline__ void moe_convert_while(const Params& p, LAS unsigned char* lds, int ph, unsigned ngemm) { moe_pump(p, lds, ph, Q_TOTAL, 0, ngemm, false); }
__device__ __forceinline__ void moe_require(const Params& p, LAS unsigned char* lds, int upto) { moe_pump(p, lds, 0, upto, 1); }

__device__ __forceinline__ void ph_prologue(const Params& p, LAS unsigned char* lds) {
    const int tid = opaque_tid(), lane = tid & 63, wave = tid >> 6;
    unsigned char* ws = opaque_ptr(p.ws);
    for (int it = blockIdx.x; it < N_PRO_ITEMS; it += gridDim.x) {
        if (it < N_ADA_UNITS) {
            const int l = it / 96, cb = it % 96;
            LAS float* sil = (LAS float*)lds;
            LAS float* red = (LAS float*)(lds + 40960);
            for (int i = tid; i < 5 * DM; i += 512) { const int r = i >> 11, k = i & (DM - 1); const float v = r < 4 ? p.in[I_C][r * DM + k] : p.in[I_CCTX][k]; sil[i] = silu_f(v); }
            __syncthreads();
            f32x2 acc[5];
#pragma unroll
            for (int r = 0; r < 5; ++r) acc[r] = (f32x2){0.f, 0.f};
            const float* W = p.in[I_WADA] + (size_t)l * DM * 12288 + cb * 128 + lane * 2;
            for (int k = wave * 256; k < wave * 256 + 256; k += 16) {
                f32x2 w[16];
#pragma unroll
                for (int j = 0; j < 16; ++j) w[j] = __builtin_nontemporal_load((const f32x2*)(W + (size_t)(k + j) * 12288));
#pragma unroll
                for (int j = 0; j < 16; ++j)
#pragma unroll
                    for (int r = 0; r < 5; ++r) acc[r] += sil[r * DM + k + j] * w[j];
            }
#pragma unroll
            for (int r = 0; r < 5; ++r) { red[(wave * 5 + r) * 128 + lane * 2] = acc[r].x; red[(wave * 5 + r) * 128 + lane * 2 + 1] = acc[r].y; }
            __syncthreads();
            float* mod = (float*)(ws + WS_MOD);
            for (int o = tid; o < 5 * 128; o += 512) { const int r = o >> 7, cc = o & 127; float sum = p.in[I_BADA][l * 12288 + cb * 128 + cc];
#pragma unroll
                for (int w8 = 0; w8 < 8; ++w8) sum += red[(w8 * 5 + r) * 128 + cc];
                mod[(size_t)(l * 5 + r) * 12288 + cb * 128 + cc] = sum; }
            __syncthreads();
        } else if (it < N_ADA_UNITS + N_S5T_UNITS) {
            const int lg = it - N_ADA_UNITS, l = lg >> 5, g = lg & 31;
            LAS f32x2* PWl = (LAS f32x2*)lds;
            LAS f32x2* BBl = (LAS f32x2*)(lds + 17408);
            LAS f32x2* Cl = (LAS f32x2*)(lds + 33792);
            LAS float* KZl = (LAS float*)(lds + 50176);
            for (int idx = tid; idx < 2 * 64 * 17; idx += 512) { const int z = idx / (64 * 17), n = (idx / 17) & 63, d = idx % 17; const int zgn = ((l * 2 + z) * 32 + g) * 64 + n;
                const float are = fminf(p.in[I_ARE][zgn], -1e-4f), aim = p.in[I_AIM][zgn]; const float dt = expf(p.in[I_LOGDT][zgn >> 6]);
                const double mag = exp((double)are * (double)dt * d); double sn, cs; sincos((double)aim * (double)dt * d, &sn, &cs);
                const f32x2 v = {(float)(mag * cs), (float)(mag * sn)}; PWl[idx] = v; if (d == 16) ((f32x2*)(ws + WS_A16))[zgn] = v; }
            for (int idx = tid; idx < 2 * 64 * 16; idx += 512) { const int z = idx >> 10, n = (idx >> 4) & 63, c = idx & 15; const int zgn = ((l * 2 + z) * 32 + g) * 64 + n;
                const float are = fminf(p.in[I_ARE][zgn], -1e-4f), aim = p.in[I_AIM][zgn]; const float dt = expf(p.in[I_LOGDT][zgn >> 6]);
                const double mag = exp((double)are * (double)dt); double sn, cs; sincos((double)aim * (double)dt, &sn, &cs);
                const float xr = (float)(mag * cs) - 1.0f, xi = (float)(mag * sn), den = 1.0f / (are * are + aim * aim);
                const float cr = (xr * are + xi * aim) * den, ci = (xi * are - xr * aim) * den;
                const float br = p.in[I_BRE][(size_t)zgn * 16 + c], bi = p.in[I_BIM][(size_t)zgn * 16 + c]; BBl[idx] = (f32x2){cr * br - ci * bi, cr * bi + ci * br}; }
            for (int idx = tid; idx < 2 * 16 * 64; idx += 512) { const int z = idx >> 10, cn = idx & 1023; const size_t src = ((size_t)((l * 2 + z) * 32 + g) * 16) * 64 + cn; Cl[idx] = (f32x2){p.in[I_CRE][src], p.in[I_CIM][src]}; }
            __syncthreads();
            { const int z = tid >> 8, d = (tid >> 4) & 15, c = tid & 15; float a16[16];
#pragma unroll
              for (int q = 0; q < 16; ++q) a16[q] = 0.f;
              for (int n = 0; n < 64; ++n) { const f32x2 pw = PWl[(z * 64 + n) * 17 + d], cm = Cl[(z * 16 + c) * 64 + n]; const float tr = cm.x * pw.x - cm.y * pw.y, ti = cm.x * pw.y + cm.y * pw.x;
#pragma unroll
                  for (int q = 0; q < 16; ++q) { const f32x2 bb = BBl[(z * 64 + n) * 16 + q]; a16[q] += tr * bb.x - ti * bb.y; } }
#pragma unroll
              for (int q = 0; q < 16; ++q) KZl[((z * 16 + d) * 16 + c) * 16 + q] = a16[q]; }
            __syncthreads();
            bf16_t* WST = (bf16_t*)(ws + WS_WST) + (size_t)lg * 256 * 256; bf16_t* G2B = (bf16_t*)(ws + WS_G2B) + (size_t)lg * 256 * 512;
            for (int i = 0; i < 16; ++i) { const int id = tid + 512 * i;
                {
                  const int c8 = (id & 1) * 8, pp = (id >> 1) & 15, row = id >> 5, z = row >> 7, ri = (row >> 6) & 1, n = row & 63;
                  const f32x2 pw = PWl[(z * 64 + n) * 17 + (z == 0 ? 15 - pp : pp)]; float f[8];
#pragma unroll
                  for (int j = 0; j < 8; ++j) { const f32x2 bb = BBl[(z * 64 + n) * 16 + c8 + j]; f[j] = ri == 0 ? (pw.x * bb.x - pw.y * bb.y) : (pw.x * bb.y + pw.y * bb.x); }
                  u32x4 w; w.x = cvt_pk_bf16(f[0], f[1]); w.y = cvt_pk_bf16(f[2], f[3]); w.z = cvt_pk_bf16(f[4], f[5]); w.w = cvt_pk_bf16(f[6], f[7]);
                  *(u32x4*)(WST + (size_t)row * 256 + pp * 16 + c8) = w; }
                {
                  const int n8 = (id & 7) * 8, ri = (id >> 3) & 1, z = (id >> 4) & 1, row = id >> 5, pp = row >> 4, c = row & 15; float f[8];
#pragma unroll
                  for (int j = 0; j < 8; ++j) { const f32x2 pw = PWl[(z * 64 + n8 + j) * 17 + (z == 0 ? pp + 1 : 16 - pp)], cm = Cl[(z * 16 + c) * 64 + n8 + j]; f[j] = ri == 0 ? (cm.x * pw.x - cm.y * pw.y) : -(cm.x * pw.y + cm.y * pw.x); }
                  u32x4 w; w.x = cvt_pk_bf16(f[0], f[1]); w.y = cvt_pk_bf16(f[2], f[3]); w.z = cvt_pk_bf16(f[4], f[5]); w.w = cvt_pk_bf16(f[6], f[7]);
                  *(u32x4*)(G2B + (size_t)row * 512 + 256 + z * 128 + ri * 64 + n8) = w; }
                {
                  const int c8 = (id & 1) * 8, pq = (id >> 1) & 15, row = id >> 5, pp = row >> 4, c = row & 15; float f[8];
#pragma unroll
                  for (int j = 0; j < 8; ++j) { float v = 0.f; if (pq <= pp) v += KZl[((0 * 16 + (pp - pq)) * 16 + c) * 16 + c8 + j]; if (pq >= pp) v += KZl[((1 * 16 + (pq - pp)) * 16 + c) * 16 + c8 + j];
                      if (pq == pp && c8 + j == c) v += p.in[I_S5D][l * 512 + g * 16 + c]; f[j] = v; }
                  u32x4 w; w.x = cvt_pk_bf16(f[0], f[1]); w.y = cvt_pk_bf16(f[2], f[3]); w.z = cvt_pk_bf16(f[4], f[5]); w.w = cvt_pk_bf16(f[6], f[7]);
                  *(u32x4*)(G2B + (size_t)row * 512 + pq * 16 + c8) = w; } }
            __syncthreads();
        } else if (it < N_ADA_UNITS + N_S5T_UNITS + N_ROPE_UNITS) {
            const int idx = (it - N_ADA_UNITS - N_S5T_UNITS) * 512 + tid; const int pos = idx >> 4, f = idx & 15;
            const float invf = powf(10000.0f, -(float)f * 0.0625f); const float ang = (float)pos * invf;
            ((f32x2*)(ws + WS_ROPE))[idx] = (f32x2){cosf(ang), sinf(ang)};
        } else {
            int t = it - N_ADA_UNITS - N_S5T_UNITS - N_ROPE_UNITS;
            LAS float* tile = (LAS float*)lds;
            if (t < 2 * T_WIN) { const int l = t / T_WIN, r = t % T_WIN; const float* src = p.in[I_WIN] + (size_t)l * DM * INC; bf16_t* dst = (bf16_t*)(ws + WS_WTIN) + (size_t)l * INP * DM;
                if (r < 448) transpose_block(src, INC, (r / 14) * 64, (r % 14) * 256, dst, DM, 1, 0, tile); else { const int q = r - 448; transpose_tile(src, INC, (q / 3) * 64, 3584 + (q % 3) * 64, dst, DM, 1, 0, 0, tile); }
                continue; }
            t -= 2 * T_WIN;
            if (t < 2 * T_WOUT) { const int l = t / T_WOUT, r = t % T_WOUT; transpose_block(p.in[I_WOUT] + (size_t)l * DM * DM, DM, (r >> 3) * 64, (r & 7) * 256, (bf16_t*)(ws + WS_WTOUT) + (size_t)l * DM * DM, DM, 1, 0, tile); continue; }
            t -= 2 * T_WOUT;
            if (t < 2 * T_WUQ) { const int l = t / T_WUQ, r = t % T_WUQ; transpose_tile(p.in[I_WUQ] + (size_t)l * 384 * 768, 768, (r % 6) * 64, (r / 6) * 64, (bf16_t*)(ws + WS_WTUQ) + (size_t)l * 768 * 384, 384, 1, 0, 0, tile); continue; }
            t -= 2 * T_WUQ;
            if (t < 2 * T_WUKV) { const int l = t / T_WUKV, r = t % T_WUKV; transpose_tile(p.in[I_WUKV] + (size_t)l * 256 * 1024, 1024, (r % 4) * 64, (r / 4) * 64, (bf16_t*)(ws + WS_WTUKV) + (size_t)l * 1024 * 256, 256, 1, 0, 1, tile); continue; }
            t -= 2 * T_WUKV;
            if (t < 2 * T_WGLU) { const int l = t / T_WGLU, r = t % T_WGLU; transpose_tile(p.in[I_WGLU] + (size_t)l * 512 * 512, 512, (r % 8) * 64, (r / 8) * 64, (bf16_t*)(ws + WS_WTGLU) + (size_t)l * 512 * 512, 512, 1, 0, 0, tile); continue; }
        }
    }
}

__device__ __forceinline__ void rms_mod_store(const f32x4 (&x)[8], const float* g, const float* scale, const float* shift, bf16_t* orow, f32x4 (&y)[8], int lane) {
    float ss = 0.f;
#pragma unroll
    for (int j = 0; j < 8; ++j) ss += x[j][0] * x[j][0] + x[j][1] * x[j][1] + x[j][2] * x[j][2] + x[j][3] * x[j][3];
    ss = wave_sum(ss);
    const float rinv = rsqrtf(ss * (1.0f / DM) + EPS);
#pragma unroll
    for (int j = 0; j < 8; ++j) { const int c = j * 256 + lane * 4;
        const f32x4 gv = *(const f32x4*)(g + c), sc = *(const f32x4*)(scale + c), sh = *(const f32x4*)(shift + c);
        y[j] = x[j] * rinv * gv * (1.0f + sc) + sh;
        u32x2 w; w.x = cvt_pk_bf16(y[j][0], y[j][1]); w.y = cvt_pk_bf16(y[j][2], y[j][3]); *(u32x2*)(orow + c) = w; }
}

constexpr int N1_ROWITEMS = MT / 8, N1_KZ = 64, N1_WST = 1024, N1_INTER = 1024;
__device__ __forceinline__ void ph_norm1_tables(const Params& p) {
    const int tid = opaque_tid(), lane = tid & 63, wave = tid >> 6;
    unsigned char* ws = opaque_ptr(p.ws);
    const float* mod = (const float*)(ws + WS_MOD);
    for (int it = blockIdx.x; it < N1_ROWITEMS; it += gridDim.x) {
        {
            const int row = it * 8 + wave; const int rr = row < NLAT ? (row >> 11) : 4;
            const float* xr = row < NLAT ? p.in[I_X] + (size_t)row * DM : p.in[I_CTX] + (size_t)(row - NLAT) * DM;
            f32x4 x[8], y[8];
#pragma unroll
            for (int j = 0; j < 8; ++j) x[j] = *(const f32x4*)(xr + j * 256 + lane * 4);
            const float* m = mod + (size_t)rr * 12288;
            rms_mod_store(x, p.in[I_N1G], m + DM, m, (bf16_t*)(ws + WS_H) + (size_t)row * DM, y, lane);
        }
    }
}

constexpr int B_ROWITEMS = MT / 8, B_SGU = 72 * 4, B_INTRA = 0;
__device__ __forceinline__ void ph_rowsplit(const Params& p, int l, LAS unsigned char* lds) {
    const int tid = opaque_tid(), lane = tid & 63, wave = tid >> 6;
    unsigned char* ws = opaque_ptr(p.ws);
    const bf16_t* P = (const bf16_t*)(ws + WS_PA);
    bf16_t* CAT = (bf16_t*)(ws + WS_CAT);
    const int nsgu = (l == 0) ? B_SGU : 256;
    const int G_ = (int)gridDim.x, c_ = (int)blockIdx.x, nx = nsgu > G_ ? nsgu - G_ : 0;
    const bool bal = nx > 0 && nx < G_ && nsgu <= 2 * G_;
    const int nfew = bal ? 2 * nx : 0;
    const int nmine = (c_ < nsgu ? 1 : 0) + (c_ < nx ? 1 : 0);
    int rit = bal ? (c_ < nx ? c_ : nfew + (c_ - nx)) : c_; const int rstride = bal ? (c_ < nx ? nx : G_ - nx) : G_; const int rend = bal ? (c_ < nx ? nfew : B_ROWITEMS) : B_ROWITEMS;
    for (int k = 0; ; ++k) {
        int it;
        if (k < nmine) it = B_ROWITEMS + c_ + k * G_;
        else { if (rit >= rend) break; it = rit; rit += rstride; }
        if (it < B_ROWITEMS) {
            const int row = it * 8 + wave; const bf16_t* pr = P + (size_t)row * INP;
            const bool lat = row < NLAT; const int t = lat ? (row & (SEQ - 1)) : ((row - NLAT) & (CTX - 1)); const int b = lat ? (row >> 11) : ((row - NLAT) >> 8);
            const int seqlen = lat ? SEQ : CTX;
            { float f[8]; float ss = 0.f;
              if (lane < 48) { const u32x4 v = *(const u32x4*)(pr + C_CQ + lane * 8); f[0] = bflo(v.x); f[1] = bfhi(v.x); f[2] = bflo(v.y); f[3] = bfhi(v.y); f[4] = bflo(v.z); f[5] = bfhi(v.z); f[6] = bflo(v.w); f[7] = bfhi(v.w);
#pragma unroll
                  for (int j = 0; j < 8; ++j) ss += f[j] * f[j]; }
              else {
#pragma unroll
                  for (int j = 0; j < 8; ++j) f[j] = 0.f; }
              ss = wave_sum(ss); const float rinv = rsqrtf(ss * (1.0f / 384.0f) + EPS);
              if (lane < 48) { const float* g = p.in[I_QNG] + l * 384 + lane * 8; u32x4 w;
                  w.x = cvt_pk_bf16(f[0] * rinv * g[0], f[1] * rinv * g[1]); w.y = cvt_pk_bf16(f[2] * rinv * g[2], f[3] * rinv * g[3]);
                  w.z = cvt_pk_bf16(f[4] * rinv * g[4], f[5] * rinv * g[5]); w.w = cvt_pk_bf16(f[6] * rinv * g[6], f[7] * rinv * g[7]);
                  *(u32x4*)((bf16_t*)(ws + WS_QA) + (size_t)row * 384 + lane * 8) = w; } }
            { const u32x2 v = *(const u32x2*)(pr + C_CKV + lane * 4); const float f0 = bflo(v.x), f1 = bfhi(v.x), f2 = bflo(v.y), f3 = bfhi(v.y);
              const float ss = wave_sum(f0 * f0 + f1 * f1 + f2 * f2 + f3 * f3); const float rinv = rsqrtf(ss * (1.0f / 256.0f) + EPS);
              const float* g = p.in[I_KVNG] + l * 256 + lane * 4; u32x2 w; w.x = cvt_pk_bf16(f0 * rinv * g[0], f1 * rinv * g[1]); w.y = cvt_pk_bf16(f2 * rinv * g[2], f3 * rinv * g[3]);
              *(u32x2*)((bf16_t*)(ws + WS_KVA) + (size_t)row * 256 + lane * 4) = w; }
            { float v = bf2f(pr[C_KR + lane]); const float partner = __shfl_xor(v, 16);
              if (lat) { const int jj = lane & 31, fi = jj & 15; const int pos = lane >= 32 ? (t & 63) : (t >> 6);
                  const f32x2 r = ((const f32x2*)(ws + WS_ROPE))[pos * 16 + fi]; const float cs = r.x, sn = r.y;
                  v = jj < 16 ? (v * cs - partner * sn) : (v * cs + partner * sn); }
              const int key = lat ? CTX + t : t; const unsigned short o = f2bf(v);
              bf16_t* kc = (bf16_t*)(ws + WS_KC);
#pragma unroll
              for (int h = 0; h < 4; ++h) kc[((size_t)(b * 4 + h) * NKEY + key) * 192 + 128 + lane] = o; }
            { const u32x4 v = *(const u32x4*)(pr + C_S5 + lane * 8); const int g = lane >> 1, half = lane & 1;
              *(u32x4*)((bf16_t*)(ws + WS_UPK) + ((size_t)g * 768 + (row >> 4)) * 512 + (row & 15) * 16 + half * 8) = v; }
            { const int c0 = lane * 8; float zp[8], zc[8], zn[8];
#pragma unroll
              for (int j = 0; j < 8; ++j) { zp[j] = 0.f; zn[j] = 0.f; }
#define CONV_Z(dst, rp) do { const u32x4 a_ = *(const u32x4*)((rp) + C_CVC + c0); const u32x4 h_ = *(const u32x4*)((rp) + C_CVH + c0); \
                  dst[0] = bflo(a_.x) * bflo(h_.x); dst[1] = bfhi(a_.x) * bfhi(h_.x); dst[2] = bflo(a_.y) * bflo(h_.y); dst[3] = bfhi(a_.y) * bfhi(h_.y); \
                  dst[4] = bflo(a_.z) * bflo(h_.z); dst[5] = bfhi(a_.z) * bfhi(h_.z); dst[6] = bflo(a_.w) * bflo(h_.w); dst[7] = bfhi(a_.w) * bfhi(h_.w); } while (0)
              CONV_Z(zc, pr);
              if (t > 0) CONV_Z(zp, pr - INP);
              if (t < seqlen - 1) CONV_Z(zn, pr + INP);
#undef CONV_Z
              const u32x4 bg = *(const u32x4*)(pr + C_CVB + c0); float bgf[8] = {bflo(bg.x), bfhi(bg.x), bflo(bg.y), bfhi(bg.y), bflo(bg.z), bfhi(bg.z), bflo(bg.w), bfhi(bg.w)};
              const float* cw = p.in[I_CONVW] + (size_t)l * 3 * 512 + c0; float o[8];
#pragma unroll
              for (int j = 0; j < 8; ++j) o[j] = bgf[j] * (cw[j] * zp[j] + cw[512 + j] * zc[j] + cw[1024 + j] * zn[j]);
              u32x4 w; w.x = cvt_pk_bf16(o[0], o[1]); w.y = cvt_pk_bf16(o[2], o[3]); w.z = cvt_pk_bf16(o[4], o[5]); w.w = cvt_pk_bf16(o[6], o[7]);
              *(u32x4*)(CAT + (size_t)row * DM + 1536 + c0) = w; }
        } else if (it < B_ROWITEMS + B_SGU) {
            const int un = it - B_ROWITEMS, cc = un >> 2, h = un & 3; const int row0 = cc * 128;
            LAS bf16_t* Wl = (LAS bf16_t*)lds;
            LAS bf16_t* Vl = (LAS bf16_t*)(lds + 128 * 136 * 2);
            const float* Wg = p.in[I_SGUW] + ((size_t)l * 4 + h) * 128 * 128;
#pragma unroll
            for (int i = 0; i < 8; ++i) { const int e4 = (i * 512 + tid) * 4, r = e4 >> 7, c = e4 & 127; const f32x4 v = *(const f32x4*)(Wg + e4);
                u32x2 w; w.x = cvt_pk_bf16(v[0], v[1]); w.y = cvt_pk_bf16(v[2], v[3]); *(LAS u32x2*)(Wl + r * 136 + c) = w; }
            u32x4 vv[16];
#pragma unroll
            for (int qi = 0; qi < 16; ++qi) vv[qi] = *(const u32x4*)(P + (size_t)(row0 + wave * 16 + qi) * INP + C_SGU_V + lane * 8);
#pragma unroll
            for (int qi = 0; qi < 16; ++qi) { const int q = wave * 16 + qi;
                const u32x4 v = vv[qi]; float f[8] = {bflo(v.x), bfhi(v.x), bflo(v.y), bfhi(v.y), bflo(v.z), bfhi(v.z), bflo(v.w), bfhi(v.w)}; float ss = 0.f;
#pragma unroll
                for (int j = 0; j < 8; ++j) { f[j] = gelu_tanh(f[j]); ss += f[j] * f[j]; }
                ss = wave_sum(ss); const float rinv = rsqrtf(ss * (1.0f / 512.0f) + EPS);
                if ((lane >> 4) == h) { const int c0 = (lane & 15) * 8; const float* g = p.in[I_SGUNG] + l * 512 + h * 128 + c0;
#pragma unroll
                    for (int j = 0; j < 8; ++j) Vl[(c0 + j) * 136 + q] = f2bf(f[j] * rinv * g[j]); } }
            __syncthreads();
            { const int fr = lane & 15, fq = lane >> 4; f32x4 acc[8];
#pragma unroll
              for (int nb = 0; nb < 8; ++nb) acc[nb] = (f32x4){0.f, 0.f, 0.f, 0.f};
#pragma unroll
              for (int ks = 0; ks < 4; ++ks) { const bf16x8 af = *(const LAS bf16x8*)(Wl + (wave * 16 + fr) * 136 + ks * 32 + fq * 8);
#pragma unroll
                  for (int nb = 0; nb < 8; ++nb) { const bf16x8 bfr = *(const LAS bf16x8*)(Vl + (nb * 16 + fr) * 136 + ks * 32 + fq * 8);
                      acc[nb] = __builtin_amdgcn_mfma_f32_16x16x32_bf16(bfr, af, acc[nb], 0, 0, 0); } }
              const int pp = wave * 16 + fr; const float bias = p.in[I_SGUB][((size_t)l * 4 + h) * 128 + pp]; const bf16_t* pr = P + (size_t)(row0 + pp) * INP + C_SGU_U + h * 128;
#pragma unroll
              for (int nb = 0; nb < 8; ++nb) { const int c = nb * 16 + 4 * fq; const u32x2 uv = *(const u32x2*)(pr + c);
                  u32x2 w; w.x = cvt_pk_bf16(gelu_tanh(bflo(uv.x)) * (acc[nb][0] + bias), gelu_tanh(bfhi(uv.x)) * (acc[nb][1] + bias));
                  w.y = cvt_pk_bf16(gelu_tanh(bflo(uv.y)) * (acc[nb][2] + bias), gelu_tanh(bfhi(uv.y)) * (acc[nb][3] + bias));
                  *(u32x2*)(CAT + (size_t)(row0 + pp) * DM + h * 128 + c) = w; } }
            __syncthreads();
        }
    }
}

constexpr int KPITCH = 400, VPITCH = 144;
constexpr int KT_BYTES = 64 * KPITCH, VT_BYTES = 128 * VPITCH;
__device__ __forceinline__ void attn_unit(const bf16_t* Qrows  , const bf16_t* Kbh, const bf16_t* Vbh, int nkeys, bf16_t* Orows, LAS unsigned char* lds) {
    const int tid = opaque_tid(), lane = tid & 63, wave = tid >> 6, l32 = lane & 31, hi = lane >> 5, qg = wave & 3, kh = wave >> 2;
    constexpr int VRING = 3 * KT_BYTES;
    bf16x8 qf[12];
    { const bf16_t* qr = Qrows + (size_t)(qg * 32 + l32) * 768 + hi * 8;
#pragma unroll
      for (int ks = 0; ks < 12; ++ks) qf[ks] = *(const bf16x8*)(qr + ks * 16); }
    f32x16 o[4];
#pragma unroll
    for (int db = 0; db < 4; ++db)
#pragma unroll
        for (int r = 0; r < 16; ++r) o[db][r] = 0.f;
    float mrow = -1e30f, lsum = 0.f;
    const int nt = nkeys / 64;
    const int wv = __builtin_amdgcn_readfirstlane(wave);
    unsigned doffK[4], doffV[3];
#pragma unroll
    for (int i = 0; i < 4; ++i) { const int pc = (wv + 8 * i) < 25 ? (wv + 8 * i) : 24; const int X = pc * 1024 + lane * 16, row = X / KPITCH, col = X % KPITCH; doffK[i] = (unsigned)(row * 384 + (col < 384 ? col : 0)); }
#pragma unroll
    for (int i = 0; i < 3; ++i) { const int pc = (wv + 8 * i) < 18 ? (wv + 8 * i) : 17; const int Y = pc * 1024 + lane * 16, row = Y / VPITCH, col = Y % VPITCH; doffV[i] = (unsigned)(row * (NKEY * 2) + (col < 128 ? col : 0)); }
#define ATT_DMAK(tile, slot) do { _Pragma("unroll") for (int i = 0; i < 4; ++i) { const int pc = (wv + 8 * i) < 25 ? (wv + 8 * i) : 24; \
        __builtin_amdgcn_global_load_lds((const unsigned*)((const char*)Kbh + (size_t)(tile) * (64 * 384) + doffK[i]), (LAS unsigned*)(lds + (slot) * KT_BYTES + pc * 1024), 16, 0, 0); } } while (0)
#define ATT_DMAV(tile, slot) do { _Pragma("unroll") for (int i = 0; i < 3; ++i) { const int pc = (wv + 8 * i) < 18 ? (wv + 8 * i) : 17; \
        __builtin_amdgcn_global_load_lds((const unsigned*)((const char*)Vbh + (size_t)(tile) * 128 + doffV[i]), (LAS unsigned*)(lds + VRING + (slot) * VT_BYTES + pc * 1024), 16, 0, 0); } } while (0)
#define ATT_STEP(S, SN, QK, ks_, vs_) do { \
        float mx = S[0]; \
        _Pragma("unroll") for (int r = 1; r < 16; ++r) mx = fmaxf(mx, S[r]); \
        mx = fmaxf(mx, __shfl_xor(mx, 32)); \
        if (__any(mx > mrow + 8.0f)) { const float mnew = fmaxf(mrow, mx), alpha = __builtin_amdgcn_exp2f(mrow - mnew); mrow = mnew; lsum *= alpha; \
            _Pragma("unroll") for (int db = 0; db < 4; ++db) _Pragma("unroll") for (int r = 0; r < 16; ++r) o[db][r] *= alpha; } \
        __builtin_amdgcn_sched_barrier(0); \
        const LAS unsigned char* Vcur = lds + VRING + (vs_) * VT_BYTES; \
        u32x4 vf0[4], vf1[4]; \
        float ps = 0.f; u32x4 pw0, pw1; \
        if (QK) { const LAS unsigned char* kp = lds + (ks_) * KT_BYTES + (kh * 32 + l32) * KPITCH + hi * 16; \
            bf16x8 kf[12]; \
            _Pragma("unroll") for (int i = 0; i < 12; ++i) kf[i] = *(const LAS bf16x8*)(kp + i * 32); \
            _Pragma("unroll") for (int r = 0; r < 16; ++r) SN[r] = 0.f; \
            __builtin_amdgcn_sched_barrier(0); \
              \
            _Pragma("unroll") for (int i = 0; i < 12; ++i) { \
                SN = __builtin_amdgcn_mfma_f32_32x32x16_bf16(kf[i], qf[i], SN, 0, 0, 0); \
                S[i] = __builtin_amdgcn_exp2f(S[i] - mrow); ps += S[i]; \
                if (i < 4) { S[12 + i] = __builtin_amdgcn_exp2f(S[12 + i] - mrow); ps += S[12 + i]; } \
                if (i == 1) pw0.x = cvt_pk_bf16(S[0], S[1]); if (i == 3) { pw0.y = cvt_pk_bf16(S[2], S[3]); pw1.z = cvt_pk_bf16(S[12], S[13]); pw1.w = cvt_pk_bf16(S[14], S[15]); } \
                if (i == 5) pw0.z = cvt_pk_bf16(S[4], S[5]); if (i == 7) pw0.w = cvt_pk_bf16(S[6], S[7]); if (i == 9) pw1.x = cvt_pk_bf16(S[8], S[9]); if (i == 11) pw1.y = cvt_pk_bf16(S[10], S[11]); \
                if (i >= 8) { const int db = i - 8; const LAS unsigned char* vp = Vcur + (db * 32 + l32) * VPITCH + kh * 64 + hi * 16; \
                    vf0[db] = *(const LAS u32x4*)vp; vf1[db] = *(const LAS u32x4*)(vp + 32); } \
                __builtin_amdgcn_sched_barrier(0); } \
        } else { \
            _Pragma("unroll") for (int db = 0; db < 4; ++db) { const LAS unsigned char* vp = Vcur + (db * 32 + l32) * VPITCH + kh * 64 + hi * 16; \
                vf0[db] = *(const LAS u32x4*)vp; vf1[db] = *(const LAS u32x4*)(vp + 32); } \
            _Pragma("unroll") for (int r = 0; r < 16; ++r) { S[r] = __builtin_amdgcn_exp2f(S[r] - mrow); ps += S[r]; } \
            pw0.x = cvt_pk_bf16(S[0], S[1]); pw0.y = cvt_pk_bf16(S[2], S[3]); pw0.z = cvt_pk_bf16(S[4], S[5]); pw0.w = cvt_pk_bf16(S[6], S[7]); \
            pw1.x = cvt_pk_bf16(S[8], S[9]); pw1.y = cvt_pk_bf16(S[10], S[11]); pw1.z = cvt_pk_bf16(S[12], S[13]); pw1.w = cvt_pk_bf16(S[14], S[15]); } \
        lsum += ps; \
        { const bf16x8 pf = __builtin_bit_cast(bf16x8, pw0); \
          _Pragma("unroll") for (int db = 0; db < 4; ++db) o[db] = __builtin_amdgcn_mfma_f32_32x32x16_bf16(__builtin_bit_cast(bf16x8, vf0[db]), pf, o[db], 0, 0, 0); } \
        { const bf16x8 pf = __builtin_bit_cast(bf16x8, pw1); \
          _Pragma("unroll") for (int db = 0; db < 4; ++db) o[db] = __builtin_amdgcn_mfma_f32_32x32x16_bf16(__builtin_bit_cast(bf16x8, vf1[db]), pf, o[db], 0, 0, 0); } \
        __builtin_amdgcn_sched_barrier(0); } while (0)
#define ATT_SYNC(full) do { if (full) asm volatile("s_waitcnt vmcnt(7)" ::: "memory"); else asm volatile("s_waitcnt vmcnt(0)" ::: "memory"); \
        __builtin_amdgcn_s_barrier(); asm volatile("" ::: "memory"); } while (0)
    ATT_DMAK(0, 0); ATT_DMAV(0, 0); ATT_DMAK(1, 1); ATT_DMAV(1, 1); if (nt > 2) ATT_DMAK(2, 2);
    asm volatile("s_waitcnt vmcnt(0)" ::: "memory");
    __builtin_amdgcn_s_barrier(); asm volatile("" ::: "memory");
    f32x16 sA, sB;
    { const LAS unsigned char* kp = lds + (kh * 32 + l32) * KPITCH + hi * 16;
#pragma unroll
      for (int r = 0; r < 16; ++r) sA[r] = 0.f;
#pragma unroll
      for (int i = 0; i < 12; ++i) { const bf16x8 kf = *(const LAS bf16x8*)(kp + i * 32); sA = __builtin_amdgcn_mfma_f32_32x32x16_bf16(kf, qf[i], sA, 0, 0, 0); } }
    int k1 = 1, v0 = 0;
    int j = 0;
    for (; j + 2 < nt; j += 2) {
        ATT_SYNC(true);
        if (j + 3 < nt) ATT_DMAK(j + 3, v0);
        ATT_DMAV(j + 2, v0 == 0 ? 2 : v0 - 1);
        ATT_STEP(sA, sB, true, k1, v0);
        k1 = k1 == 2 ? 0 : k1 + 1; v0 = v0 == 2 ? 0 : v0 + 1;
        ATT_SYNC(j + 3 < nt);
        if (j + 4 < nt) ATT_DMAK(j + 4, v0);
        if (j + 3 < nt) ATT_DMAV(j + 3, v0 == 0 ? 2 : v0 - 1);
        ATT_STEP(sB, sA, true, k1, v0);
        k1 = k1 == 2 ? 0 : k1 + 1; v0 = v0 == 2 ? 0 : v0 + 1;
    }
    ATT_SYNC(false);
    ATT_STEP(sA, sB, true, k1, v0);
    k1 = k1 == 2 ? 0 : k1 + 1; v0 = v0 == 2 ? 0 : v0 + 1;
    ATT_SYNC(false);
    ATT_STEP(sB, sA, false, k1, v0);
#undef ATT_STEP
#undef ATT_SYNC
#undef ATT_DMAK
#undef ATT_DMAV
    __syncthreads();
    lsum += __shfl_xor(lsum, 32);
    LAS float* mb = (LAS float*)lds + (size_t)qg * 66 * 64 + lane;
    if (kh == 1) {
#pragma unroll
        for (int db = 0; db < 4; ++db)
#pragma unroll
            for (int r = 0; r < 16; ++r) mb[(db * 16 + r) * 64] = o[db][r];
        mb[64 * 64] = mrow; mb[65 * 64] = lsum;
    }
    __syncthreads();
    if (kh == 0) {
        const float m1 = mb[64 * 64], l1 = mb[65 * 64];
        const float m = fmaxf(mrow, m1), e0 = __builtin_amdgcn_exp2f(mrow - m), e1 = __builtin_amdgcn_exp2f(m1 - m);
        const float inv = 1.0f / (lsum * e0 + l1 * e1), c0 = e0 * inv, c1 = e1 * inv;
        bf16_t* orow = Orows + (size_t)(qg * 32 + l32) * DM;
#pragma unroll
        for (int db = 0; db < 4; ++db)
#pragma unroll
            for (int k4 = 0; k4 < 4; ++k4) { float v[4];
#pragma unroll
                for (int i = 0; i < 4; ++i) v[i] = o[db][4 * k4 + i] * c0 + mb[(db * 16 + 4 * k4 + i) * 64] * c1;
                u32x2 w; w.x = cvt_pk_bf16(v[0], v[1]); w.y = cvt_pk_bf16(v[2], v[3]);
                *(u32x2*)(orow + db * 32 + 8 * k4 + 4 * hi) = w; }
    }
    __syncthreads();
}
__device__ __forceinline__ void ph_attn_carry(const Params& p, int l, LAS unsigned char* lds) {
    unsigned char* ws = opaque_ptr(p.ws); const int tid = opaque_tid();
    const int natt = (l == 0) ? 288 : 256;
    const bf16_t* QB = (const bf16_t*)(ws + WS_QB); const bf16_t* KC = (const bf16_t*)(ws + WS_KC); const bf16_t* VT = (const bf16_t*)(ws + WS_VT); bf16_t* CAT = (bf16_t*)(ws + WS_CAT);
    for (int it = blockIdx.x; it < natt; it += gridDim.x) {
        {
            int b, h, row0, nkeys;
            if (it < 256) { const int x = it & 7, jj = it >> 3, bh = 2 * x + (jj >> 4); b = bh >> 2; h = bh & 3; row0 = b * SEQ + (jj & 15) * 128; nkeys = NKEY; }
            else { const int u = it - 256; b = u >> 3; h = (u >> 1) & 3; row0 = NLAT + b * CTX + (u & 1) * 128; nkeys = CTX; }
            attn_unit(QB + (size_t)row0 * 768 + h * 192, KC + (size_t)(b * 4 + h) * NKEY * 192, VT + (size_t)(b * 4 + h) * 128 * NKEY, nkeys, CAT + (size_t)row0 * DM + 512 + h * 128, lds);
        }
    }
    for (int it = natt + (int)((blockIdx.x + gridDim.x - natt % gridDim.x) % gridDim.x); it < natt + 256; it += gridDim.x) {
        {
            const int u = it - natt; const int z = u >> 7, b = (u >> 5) & 3, g = u & 31, lane = tid & 63, w = tid >> 6;
            const f32x2 a16 = ((const f32x2*)(ws + WS_A16))[(((size_t)l * 2 + z) * 32 + g) * 64 + lane];
            const float* EST = (const float*)(ws + WS_EST) + (size_t)g * 768 * 256 + z * 128 + lane;
            bf16_t* UP = (bf16_t*)(ws + WS_UPK) + (size_t)g * 768 * 512 + 256 + z * 128 + lane;
            LAS f32x2* seg = (LAS f32x2*)lds;
            float er[18], ei[18];
#pragma unroll
            for (int i = 0; i < 18; ++i) { const int st = w * 18 + i; int chunk;
                if (z == 0) chunk = st < 16 ? (512 + b * 16 + st) : (b * 128 + (st - 16)); else chunk = st < 16 ? (512 + b * 16 + (15 - st)) : (b * 128 + (143 - st));
                er[i] = EST[(size_t)chunk * 256]; ei[i] = EST[(size_t)chunk * 256 + 64]; }
            float sr = 0.f, si = 0.f;
#pragma unroll
            for (int i = 0; i < 18; ++i) { const float nr = a16.x * sr - a16.y * si + er[i], ni = a16.x * si + a16.y * sr + ei[i]; sr = nr; si = ni; }
            seg[w * 64 + lane] = (f32x2){sr, si};
            float pr = 1.f, pi = 0.f;
#pragma unroll
            for (int i = 0; i < 18; ++i) { const float nr = pr * a16.x - pi * a16.y, ni = pr * a16.y + pi * a16.x; pr = nr; pi = ni; }
            __syncthreads();
            sr = 0.f; si = 0.f;
            for (int w2 = 0; w2 < w; ++w2) { const f32x2 sv = seg[w2 * 64 + lane]; const float nr = pr * sr - pi * si + sv.x, ni = pr * si + pi * sr + sv.y; sr = nr; si = ni; }
#pragma unroll
            for (int i = 0; i < 18; ++i) { const int st = w * 18 + i; int chunk;
                if (z == 0) chunk = st < 16 ? (512 + b * 16 + st) : (b * 128 + (st - 16)); else chunk = st < 16 ? (512 + b * 16 + (15 - st)) : (b * 128 + (143 - st));
                UP[(size_t)chunk * 512] = f2bf(sr); UP[(size_t)chunk * 512 + 64] = f2bf(si);
                const float nr = a16.x * sr - a16.y * si + er[i], ni = a16.x * si + a16.y * sr + ei[i]; sr = nr; si = ni; }
            __syncthreads();
        }
    }
}

__device__ __forceinline__ void ph_norm2_router(const Params& p, int l, LAS unsigned char* lds) {
    const int tid = opaque_tid(), lane = tid & 63, wave = tid >> 6;
    unsigned char* ws = opaque_ptr(p.ws); const float* mod = (const float*)(ws + WS_MOD) + (size_t)l * 5 * 12288;
    const int nrows = (l == 0) ? MT : NLAT;
    const float* WR = p.in[I_WROUTER] + (size_t)l * DM * NE;
    for (int idx = tid; idx < DM * 4; idx += 512) { const int c = idx & (DM - 1), e4 = idx >> 11; const f32x4 v = *(const f32x4*)(WR + (size_t)c * NE + e4 * 4);
        *(LAS f32x4*)(lds + (size_t)(((e4 * 2 + (c & 1)) * 1024 + (c >> 1)) * 16)) = v; }
    __syncthreads();
    const float* n2g = p.in[I_N2G] + l * DM;
    for (int it = blockIdx.x; it < nrows / 8; it += gridDim.x) {
        const int row = it * 8 + wave; const int rr = row < NLAT ? (row >> 11) : 4;
        const bf16_t* xr = (const bf16_t*)(ws + WS_XB) + (size_t)row * DM;
        const float* m = mod + (size_t)rr * 12288;
        f32x2 x[16], gv[16], sc[16], sh[16];
#pragma unroll
        for (int j = 0; j < 16; ++j) { const int c = j * 128 + lane * 2; { const unsigned xw = *(const unsigned*)(xr + c); x[j] = (f32x2){bflo(xw), bfhi(xw)}; } gv[j] = *(const f32x2*)(n2g + c); sc[j] = *(const f32x2*)(m + 4 * DM + c); sh[j] = *(const f32x2*)(m + 3 * DM + c); }
        float ss = 0.f;
#pragma unroll
        for (int j = 0; j < 16; ++j) ss += x[j].x * x[j].x + x[j].y * x[j].y;
        ss = wave_sum(ss); const float rinv = rsqrtf(ss * (1.0f / DM) + EPS);
        bf16_t* orow = (bf16_t*)(ws + WS_H) + (size_t)row * DM;
        f32x4 lg[4];
#pragma unroll
        for (int e4 = 0; e4 < 4; ++e4) lg[e4] = (f32x4){0.f, 0.f, 0.f, 0.f};
#pragma unroll
        for (int j = 0; j < 16; ++j) { const f32x2 y = x[j] * rinv * gv[j] * (1.0f + sc[j]) + sh[j];
            *(unsigned*)(orow + j * 128 + lane * 2) = cvt_pk_bf16(y.x, y.y);
#pragma unroll
            for (int e4 = 0; e4 < 4; ++e4) { const f32x4 w0 = *(const LAS f32x4*)(lds + (size_t)(((e4 * 2 + 0) * 1024 + j * 64 + lane) * 16)); const f32x4 w1 = *(const LAS f32x4*)(lds + (size_t)(((e4 * 2 + 1) * 1024 + j * 64 + lane) * 16));
                lg[e4] += y.x * w0 + y.y * w1; }
            __builtin_amdgcn_sched_barrier(0); }
        float v8[8], v4[4], v2[2], v1;
#pragma unroll
        for (int e = 0; e < 8; ++e) { const float lo = lg[e >> 2][e & 3], hi_ = lg[(e + 8) >> 2][e & 3]; const float snd = (lane & 32) ? lo : hi_, kp = (lane & 32) ? hi_ : lo; v8[e] = kp + __shfl_xor(snd, 32); }
#pragma unroll
        for (int e = 0; e < 4; ++e) { const float snd = (lane & 16) ? v8[e] : v8[e + 4], kp = (lane & 16) ? v8[e + 4] : v8[e]; v4[e] = kp + __shfl_xor(snd, 16); }
#pragma unroll
        for (int e = 0; e < 2; ++e) { const float snd = (lane & 8) ? v4[e] : v4[e + 2], kp = (lane & 8) ? v4[e + 2] : v4[e]; v2[e] = kp + __shfl_xor(snd, 8); }
        { const float snd = (lane & 4) ? v2[0] : v2[1], kp = (lane & 4) ? v2[1] : v2[0]; v1 = kp + __shfl_xor(snd, 4); }
        v1 += __shfl_xor(v1, 1); v1 += __shfl_xor(v1, 2);
        float mx = v1; mx = fmaxf(mx, __shfl_xor(mx, 4)); mx = fmaxf(mx, __shfl_xor(mx, 8)); mx = fmaxf(mx, __shfl_xor(mx, 16)); mx = fmaxf(mx, __shfl_xor(mx, 32));
        const float ex = __expf(v1 - mx); float se = ex; se += __shfl_xor(se, 4); se += __shfl_xor(se, 8); se += __shfl_xor(se, 16); se += __shfl_xor(se, 32);
        if ((lane & 3) == 0) ((float*)(ws + WS_AFF))[(size_t)row * 16 + (lane >> 2)] = ex / se;
    }
}

__device__ __forceinline__ void ph_topk(const Params& p, int l, LAS unsigned char* lds) {
    const int tid = opaque_tid(), lane = tid & 63, wave = tid >> 6;
    unsigned char* ws = opaque_ptr(p.ws); const float* AFF = (const float*)(ws + WS_AFF);
    int* ROWTOK = (int*)(ws + WS_ROWTOK); float* ROWAFF = (float*)(ws + WS_ROWAFF); int* INV = (int*)(ws + WS_INV);
    LAS int* hist = (LAS int*)lds;
    LAS int* ctl = (LAS int*)(lds + 1024);
    LAS int* wsum = (LAS int*)(lds + 1280);
    const int nunits = (l == 0) ? 128 : 64;
    for (int it = blockIdx.x; it < nunits; it += gridDim.x) {
        const bool lat = it < 64; const int u = lat ? it : it - 64; const int b = u >> 4, e = u & 15;
        const int n = lat ? SEQ : CTX, cap = lat ? CAPL : CAPC;
        const int tok0 = lat ? b * SEQ : NLAT + b * CTX; const int rowbase = lat ? b * CAPL : 1024 + b * CAPC;
        unsigned key[4];
#pragma unroll
        for (int j = 0; j < 4; ++j) { const int t = tid * 4 + j; key[j] = t < n ? __float_as_uint(AFF[(size_t)(tok0 + t) * 16 + e]) : 0u; }
        unsigned prefix = 0u; int remaining = cap;
        for (int pass = 3; pass >= 0; --pass) {
            if (tid < 256) hist[tid] = 0;
            __syncthreads();
#pragma unroll
            for (int j = 0; j < 4; ++j) { const int t = tid * 4 + j; if (t < n) { const bool match = (pass == 3) || ((key[j] >> (8 * (pass + 1))) == (prefix >> (8 * (pass + 1)))); if (match) atomicAdd((int*)&hist[(key[j] >> (8 * pass)) & 255u], 1); } }
            __syncthreads();
            if (wave == 0) {
                const int b0 = hist[4 * lane], b1 = hist[4 * lane + 1], b2 = hist[4 * lane + 2], b3 = hist[4 * lane + 3];
                const int s = b0 + b1 + b2 + b3; int suf = s;
#pragma unroll
                for (int off = 1; off < 64; off <<= 1) { const int t = __shfl_down(suf, off); if (lane + off < 64) suf += t; }
                const int above = suf - s; const int c3 = above + b3, c2 = c3 + b2, c1 = c2 + b1, c0 = c1 + b0;
                if (above < remaining && c0 >= remaining) { int dg, nr;
                    if (c3 >= remaining) { dg = 4 * lane + 3; nr = remaining - above; } else if (c2 >= remaining) { dg = 4 * lane + 2; nr = remaining - c3; }
                    else if (c1 >= remaining) { dg = 4 * lane + 1; nr = remaining - c2; } else { dg = 4 * lane; nr = remaining - c1; }
                    ctl[0] = dg; ctl[1] = nr; }
            }
            __syncthreads();
            prefix |= ((unsigned)ctl[0]) << (8 * pass); remaining = ctl[1];
            __syncthreads();
        }
        int cgt = 0, ceq = 0;
#pragma unroll
        for (int j = 0; j < 4; ++j) { const int t = tid * 4 + j; if (t < n) { cgt += key[j] > prefix ? 1 : 0; ceq += key[j] == prefix ? 1 : 0; } }
        const int packed = cgt | (ceq << 16);
        int inc = packed;
#pragma unroll
        for (int off = 1; off < 64; off <<= 1) { const int t = __shfl_up(inc, off); if (lane >= off) inc += t; }
        if (lane == 63) wsum[wave] = inc;
        __syncthreads();
        int base = 0;
#pragma unroll
        for (int w8 = 0; w8 < 8; ++w8) base += (w8 < wave) ? wsum[w8] : 0;
        int excl = base + inc - packed; int egt = excl & 0xffff, eeq = excl >> 16;
#pragma unroll
        for (int j = 0; j < 4; ++j) { const int t = tid * 4 + j; if (t < n) {
                const bool gt = key[j] > prefix, eq = key[j] == prefix; const bool sel = gt || (eq && eeq < remaining);
                const int slot = egt + (eeq < remaining ? eeq : remaining);
                if (sel) { ROWTOK[e * EROWS + rowbase + slot] = tok0 + t; ROWAFF[e * EROWS + rowbase + slot] = __uint_as_float(key[j]); }
                INV[(size_t)(tok0 + t) * 16 + e] = sel ? rowbase + slot : -1;
                egt += gt ? 1 : 0; eeq += eq ? 1 : 0; } }
        __syncthreads();
    }
}

__device__ __forceinline__ void ph_gather(const Params& p, int l) {
    const int tid = opaque_tid(), lane = tid & 63, wave = tid >> 6;
    unsigned char* ws = opaque_ptr(p.ws); const int* ROWTOK = (const int*)(ws + WS_ROWTOK);
    const int rows_per_e = (l == 0) ? 1152 : 1024;
    const int nitems = NE * rows_per_e / 8;
    for (int it = blockIdx.x; it < nitems; it += gridDim.x) {
        const int ridx = it * 8 + wave; const int e = ridx / rows_per_e, r = ridx % rows_per_e;
        const int tok = ROWTOK[e * EROWS + r];
        const u32x4* src = (const u32x4*)((const bf16_t*)(ws + WS_H) + (size_t)tok * DM); u32x4* dst = (u32x4*)((bf16_t*)(ws + WS_PA) + ((size_t)e * EROWS + r) * DM);
#pragma unroll
        for (int j = 0; j < 4; ++j) dst[j * 64 + lane] = src[j * 64 + lane];
    }
}

__device__ __forceinline__ void ph_combine(const Params& p, int l) {
    const int tid = opaque_tid(), lane = tid & 63, wave = tid >> 6;
    unsigned char* ws = opaque_ptr(p.ws); const float* mod = (const float*)(ws + WS_MOD);
    const int nrows = (l == 0) ? MT : NLAT;
    const int* INV = (const int*)(ws + WS_INV); const bf16_t* YS = (const bf16_t*)(ws + WS_YS);
    for (int it = blockIdx.x; it < nrows / 8; it += gridDim.x) {
        const int row = it * 8 + wave; const int rr = row < NLAT ? (row >> 11) : 4;
        const bf16_t* xr = (const bf16_t*)(ws + WS_XB) + (size_t)row * DM;
        f32x4 x[8], s[8], y[8];
#pragma unroll
        for (int j = 0; j < 8; ++j) { const u32x2 xv = *(const u32x2*)(xr + j * 256 + lane * 4); x[j] = (f32x4){bflo(xv.x), bfhi(xv.x), bflo(xv.y), bfhi(xv.y)}; s[j] = (f32x4){0.f, 0.f, 0.f, 0.f}; }
        const int myinv = lane < 16 ? INV[(size_t)row * 16 + lane] : -1;
        unsigned msk = (unsigned)__ballot(myinv >= 0);
        while (msk) {
            const int e0 = __builtin_ctz(msk); msk &= msk - 1; const bool two = msk != 0u; const int e1 = two ? __builtin_ctz(msk) : e0; if (two) msk &= msk - 1;
            const int r0 = __shfl(myinv, e0), r1 = __shfl(myinv, e1);
            const bf16_t* y0 = YS + ((size_t)e0 * EROWS + r0) * DM; const bf16_t* y1 = YS + ((size_t)e1 * EROWS + r1) * DM;
            u32x2 v0[8], v1[8];
#pragma unroll
            for (int j = 0; j < 8; ++j) { v0[j] = *(const u32x2*)(y0 + j * 256 + lane * 4); v1[j] = *(const u32x2*)(y1 + j * 256 + lane * 4); }
            const float f1 = two ? 1.0f : 0.0f;
#pragma unroll
            for (int j = 0; j < 8; ++j) { s[j][0] += bflo(v0[j].x) + f1 * bflo(v1[j].x); s[j][1] += bfhi(v0[j].x) + f1 * bfhi(v1[j].x); s[j][2] += bflo(v0[j].y) + f1 * bflo(v1[j].y); s[j][3] += bfhi(v0[j].y) + f1 * bfhi(v1[j].y); }
        }
        const float* gate = mod + (size_t)(l * 5 + rr) * 12288 + 5 * DM;
#pragma unroll
        for (int j = 0; j < 8; ++j) { const f32x4 gv = *(const f32x4*)(gate + j * 256 + lane * 4); x[j] += gv * s[j]; }
        if (l == 0) {
            bf16_t* xo = (bf16_t*)(ws + WS_XA) + (size_t)row * DM;
#pragma unroll
            for (int j = 0; j < 8; ++j) { u32x2 w; w.x = cvt_pk_bf16(x[j][0], x[j][1]); w.y = cvt_pk_bf16(x[j][2], x[j][3]); *(u32x2*)(xo + j * 256 + lane * 4) = w; }
            const float* m = mod + (size_t)(5 + rr) * 12288;
            rms_mod_store(x, p.in[I_N1G] + DM, m + DM, m, (bf16_t*)(ws + WS_H) + (size_t)row * DM, y, lane);
        } else {
            float ss = 0.f;
#pragma unroll
            for (int j = 0; j < 8; ++j) ss += x[j][0] * x[j][0] + x[j][1] * x[j][1] + x[j][2] * x[j][2] + x[j][3] * x[j][3];
            ss = wave_sum(ss); const float rinv = rsqrtf(ss * (1.0f / DM) + EPS);
            float* orow = p.out + (size_t)row * DM;
#pragma unroll
            for (int j = 0; j < 8; ++j) { const f32x4 gv = *(const f32x4*)(p.in[I_FNG] + j * 256 + lane * 4); *(f32x4*)(orow + j * 256 + lane * 4) = x[j] * rinv * gv; }
        }
    }
}

constexpr int NPH_LAYER = 13, NPH = 2 + 2 * NPH_LAYER;
__global__ void __launch_bounds__(512, 2) fwd(Params p) {
    extern __shared__ __attribute__((aligned(16))) unsigned char lds_raw[];
    LAS unsigned char* lds = (LAS unsigned char*)lds_raw;
    volatile LAS unsigned* MISC = (volatile LAS unsigned*)(lds + LDS_MISC);
    if (threadIdx.x < 16) MISC[threadIdx.x] = 0u;
    __syncthreads();
    unsigned char* ws = p.ws;
    const int lo = p.ph_lo, hi = p.ph_hi;
    XcdBarrier bar; bar.bar = (unsigned*)(ws + WS_CTL); bar.x = 0; bar.st = MISC;
    if (hi - lo > 1) bar = xcd_barrier_post((unsigned*)(ws + WS_CTL), MISC);
    const int G = gridDim.x, c = blockIdx.x;
#ifndef NCONV_A
#define NCONV_A 48
#endif
#ifndef NCONV_G
#define NCONV_G 48
#endif
#ifndef NCONV_K
#define NCONV_K 32
#endif
    const int nconv = (G == 256) ? 1 : 0;
    const int GgA = G - nconv * NCONV_A, GgG = G - nconv * NCONV_G, GgK = G - nconv * NCONV_K;
#ifndef ONLY_PH
#define ONLY_PH -1
#endif
#define PSEL(id) (ONLY_PH < 0 || ONLY_PH == (id))
#ifndef DUP
#define DUP 0
#endif
#define NREP(id) ((((DUP) >> (id)) & 1) ? 2 : 1)
#define REPLOOP(id) for (int rep_ = 0; rep_ < NREP(id); ++rep_)
#define REPBAR(id) do { if (rep_ + 1 < NREP(id)) xcd_barrier(bar); } while (0)
#define IN(k) (lo <= (k) && (k) < hi)
#define SEAM(k) do { if (IN(k) && IN((k) + 1)) xcd_barrier(bar); } while (0)

    if (PSEL(0) && IN(0)) REPLOOP(0) { ph_prologue(p, lds); __syncthreads(); REPBAR(0); }
    SEAM(0);
    if (PSEL(1) && IN(1)) REPLOOP(1) { ph_norm1_tables(p); REPBAR(1); }
    SEAM(1);
    for (int l = 0; l < 2; ++l) {
        const int pb = 2 + NPH_LAYER * l;
        const float* mod = (const float*)(ws + WS_MOD) + (size_t)l * 5 * 12288;
        if (PSEL(2) && IN(pb + 0)) REPLOOP(2) {
            pg8::EpiStoreBf16 E{(bf16_t*)(ws + WS_PA), INP};
            if (l == 0) { if (c >= GgA) moe_convert_while(p, lds, pb + 0, GgA);
                else { pg8::TileSched S; S.init(ws + WS_H, (bf16_t*)(ws + WS_WTIN), DM, DM, MT / 256, INP / 256, 1, 0, 0, GgA, c, 0); pg8::gemm_phase(lds, pg8::Desc{DM, DM, DM}, S, E); if (nconv) moe_mark_done(p, pb + 0); } }
            else { pg8::InSchedLast S; S.init(ws + WS_H, (bf16_t*)(ws + WS_WTIN) + (size_t)INP * DM, G, c); pg8::gemm_phase(lds, pg8::Desc{DM, DM, DM}, S, E); }
            moe_fill(p, lds, pb + 0);
         REPBAR(2); }
        SEAM(pb + 0);
        if (PSEL(3) && IN(pb + 1)) REPLOOP(3) { ph_rowsplit(p, l, lds); __syncthreads();  REPBAR(3); }
        SEAM(pb + 1);
        if (PSEL(4) && IN(pb + 2)) REPLOOP(4) {
#ifndef C_SEL
#define C_SEL 15
#endif
            if (C_SEL & 1) { pg8::TileSched S; S.init(ws + WS_QA, (bf16_t*)(ws + WS_WTUQ) + (size_t)l * 768 * 384, 384, 384, (l == 0 ? MT : NLAT) / 256, 3, 1, 0, 0, G, c, 0);
              pg8::EpiQ E{(bf16_t*)(ws + WS_QB), (const f32x2*)(ws + WS_ROPE)}; pg8::gemm_phase(lds, pg8::Desc{384, 384, 384}, S, E); }
            if (C_SEL & 2) { pg8::TileSched S; S.init(ws + WS_KVA, (bf16_t*)(ws + WS_WTUKV) + (size_t)l * 1024 * 256, 256, 256, MT / 256, 2, 1, 0, 0, G, c, 112);
              pg8::EpiK E{(bf16_t*)(ws + WS_KC)}; pg8::gemm_phase(lds, pg8::Desc{256, 256, 256}, S, E); }
            if (C_SEL & 4) { pg8::TileSched S; S.init((bf16_t*)(ws + WS_WTUKV) + (size_t)l * 1024 * 256 + 512 * 256, ws + WS_KVA, 256, 256, 2, MT / 256, 1, 0, 0, G, c, 184);
              pg8::EpiV E{(bf16_t*)(ws + WS_VT)}; pg8::gemm_phase(lds, pg8::Desc{256, 256, 256}, S, E); }
            if (C_SEL & 8) { pg8::TileSched S; S.init(ws + WS_UPK, (bf16_t*)(ws + WS_WST) + (size_t)l * 32 * 256 * 256, 512, 256, 3, 1, 32, (size_t)768 * 512 * 2, (size_t)256 * 256 * 2, G, c, 0);
              pg8::EpiS1 E{(float*)(ws + WS_EST)}; pg8::gemm_phase(lds, pg8::Desc{512, 256, 256}, S, E); }
            moe_fill(p, lds, pb + 2);
         REPBAR(4); }
        SEAM(pb + 2);
        if (PSEL(5) && IN(pb + 3)) REPLOOP(5) { ph_attn_carry(p, l, lds); __syncthreads();  REPBAR(5); }
        SEAM(pb + 3);
        if (PSEL(6) && IN(pb + 4)) REPLOOP(6) {
            pg8::TileSched S; S.init(ws + WS_UPK, (bf16_t*)(ws + WS_G2B) + (size_t)l * 32 * 256 * 512, 512, 512, 3, 1, 32, (size_t)768 * 512 * 2, (size_t)256 * 512 * 2, G, c, 0);
            pg8::EpiS2 E{(bf16_t*)(ws + WS_GB)}; pg8::gemm_phase(lds, pg8::Desc{512, 512, 512}, S, E);
            moe_fill(p, lds, pb + 4);
         REPBAR(6); }
        SEAM(pb + 4);
        if (PSEL(7) && IN(pb + 5)) REPLOOP(7) {
            pg8::TileSched S; S.init(ws + WS_GB, (bf16_t*)(ws + WS_WTGLU) + (size_t)l * 512 * 512, 512, 512, (l == 0 ? MT : NLAT) / 256, 2, 1, 0, 0, G, c, 0);
            pg8::EpiGlu E{(const bf16_t*)(ws + WS_GB), p.in[I_BGLU] + l * 512, (bf16_t*)(ws + WS_CAT)}; pg8::gemm_phase(lds, pg8::Desc{512, 512, 512}, S, E);
            moe_fill(p, lds, pb + 5);
         REPBAR(7); }
        SEAM(pb + 5);
        if (PSEL(8) && IN(pb + 6)) REPLOOP(8) {
            pg8::TileSched S; S.init(ws + WS_CAT, (bf16_t*)(ws + WS_WTOUT) + (size_t)l * DM * DM, DM, DM, (l == 0 ? MT : NLAT) / 256, DM / 256, 1, 0, 0, l == 0 ? GgG : G, c, 0);
            pg8::EpiOut E{p.in[I_X], p.in[I_CTX], l == 0 ? (const bf16_t*)nullptr : (const bf16_t*)(ws + WS_XA), mod + 2 * DM, (bf16_t*)(ws + WS_XB)};
            if (l == 0 && c >= GgG) moe_convert_while(p, lds, pb + 6, GgG); else { pg8::gemm_phase(lds, pg8::Desc{DM, DM, DM}, S, E); if (l == 0 && nconv) moe_mark_done(p, pb + 6); }
            moe_fill(p, lds, pb + 6);
         REPBAR(8); }
        SEAM(pb + 6);
        if (PSEL(9) && IN(pb + 7)) REPLOOP(9) { ph_norm2_router(p, l, lds); __syncthreads(); REPBAR(9); }
        SEAM(pb + 7);
        if (PSEL(10) && IN(pb + 8)) REPLOOP(10) { ph_topk(p, l, lds); __syncthreads(); moe_require(p, lds, l * Q_LAYER + Q_GU);  REPBAR(10); }
        if (PSEL(11) && IN(pb + 9)) REPLOOP(11) { }
        SEAM(pb + 9);
        if (PSEL(12) && IN(pb + 10)) REPLOOP(12) {
            pg8::MoeSched S; S.init(ws + WS_H, (bf16_t*)(ws + WS_WTGU) + (size_t)l * NE * 2048 * DM, DM, DM, l == 0 ? 5 : 4, 8, 0, (size_t)2048 * DM * 2, l == 0 ? GgK : G, c);
            pg8::EpiGU E{(bf16_t*)(ws + WS_HID)};
            if (l == 0 && c >= GgK) moe_convert_while(p, lds, pb + 10, GgK); else { pg8::gemm_phase<pg8::EpiGU, pg8::MoeSched, true>(lds, pg8::Desc{DM, DM, DM}, S, E, (const int*)(ws + WS_ROWTOK), l == 0 ? 1152 : 1024); if (l == 0 && nconv) moe_mark_done(p, pb + 10); }
            moe_require(p, lds, (l + 1) * Q_LAYER); moe_fill(p, lds, pb + 10);
         REPBAR(12); }
        SEAM(pb + 10);
        if (PSEL(13) && IN(pb + 11)) REPLOOP(13) {
            pg8::MoeSched S; S.init(ws + WS_HID, (bf16_t*)(ws + WS_WTDN) + (size_t)l * NE * DM * FF, FF, FF, l == 0 ? 5 : 4, 8, (size_t)EROWS * FF * 2, (size_t)DM * FF * 2, l == 0 ? GgK : G, c);
            pg8::EpiDown E{(bf16_t*)(ws + WS_YS), (const float*)(ws + WS_ROWAFF)};
            if (l == 0 && c >= GgK) moe_convert_while(p, lds, pb + 11, GgK); else { pg8::gemm_phase(lds, pg8::Desc{FF, FF, FF}, S, E); if (l == 0 && nconv) moe_mark_done(p, pb + 11); }
            moe_fill(p, lds, pb + 11);
         REPBAR(13); }
        SEAM(pb + 11);
        if (PSEL(14) && IN(pb + 12)) REPLOOP(14) { ph_combine(p, l);  REPBAR(14); }
        SEAM(pb + 12);
    }
#undef IN
#undef SEAM
}

extern "C" void kernel_launch(void* const* d_in, const int* in_sizes, int n_in, void* d_out, int out_size, void* d_ws, size_t ws_size, hipStream_t stream) {
    static int grid = 0;
    if (grid == 0) {
        if (n_in != 33 || ws_size < WS_END) { fprintf(stderr, "kernel_launch: need 33 inputs and >= %zu bytes of workspace; got %d, %zu\n", (size_t)WS_END, n_in, ws_size); grid = -1; return; }
        int dev = 0, cus = 0;
        if (hipGetDevice(&dev) != hipSuccess || hipDeviceGetAttribute(&cus, hipDeviceAttributeMultiprocessorCount, dev) != hipSuccess) { grid = -1; return; }
        if (hipFuncSetAttribute((const void*)fwd, hipFuncAttributeMaxDynamicSharedMemorySize, LDS_BYTES) != hipSuccess) { fprintf(stderr, "kernel_launch: hipFuncSetAttribute failed\n"); grid = -1; return; }
        (void)hipGetLastError();
        grid = cus > 256 ? 256 : cus;
    }
    if (grid < 0) return;
    (void)hipMemsetAsync((char*)d_ws + WS_CTL, 0, CTL_BYTES, stream);
    Params a{};
    for (int i = 0; i < 33; ++i) a.in[i] = (const float*)d_in[i];
    a.out = (float*)d_out; a.ws = (unsigned char*)d_ws;
#if MK_SPLIT
    for (int ph = 0; ph < NPH; ++ph) { a.ph_lo = ph; a.ph_hi = ph + 1; hipLaunchKernelGGL(fwd, dim3(grid), dim3(512), LDS_BYTES, stream, a); }
#else
    a.ph_lo = 0; a.ph_hi = NPH; hipLaunchKernelGGL(fwd, dim3(grid), dim3(512), LDS_BYTES, stream, a);
#endif
}
```

```cpp
#include <hip/hip_runtime.h>
#include <cstdint>
#include <cstdio>

#ifndef MK_SPLIT
#define MK_SPLIT 0
#endif

#define LAS __attribute__((address_space(3)))
typedef unsigned short bf16_t;
typedef short bf16x8 __attribute__((ext_vector_type(8)));
typedef short bf16x4 __attribute__((ext_vector_type(4)));
typedef float f32x4 __attribute__((ext_vector_type(4)));
typedef float f32x2 __attribute__((ext_vector_type(2)));
typedef unsigned u32x4 __attribute__((ext_vector_type(4)));
typedef unsigned u32x2 __attribute__((ext_vector_type(2)));
typedef float f32x16 __attribute__((ext_vector_type(16)));

constexpr int DM = 2048, NB = 4, SEQ = 2048, CTX = 256, NLAT = NB * SEQ, NCTX = NB * CTX, MT = NLAT + NCTX;
constexpr int INC = 3776, INP = 3840;
constexpr int C_SGU_U = 0, C_SGU_V = 512, C_CQ = 1024, C_CKV = 1408, C_KR = 1664, C_S5 = 1728, C_CVB = 2240, C_CVC = 2752, C_CVH = 3264;
constexpr int NKEY = CTX + SEQ;
constexpr int NE = 16, FF = 1024, CAPL = 256, CAPC = 32, EROWS = 1280;
constexpr int NCHUNK = MT / 16;
constexpr float EPS = 1e-6f;
constexpr float QSCALE = 0.07216878364870322f * 1.4426950408889634f;

constexpr size_t al256(size_t x) { return (x + 255) & ~(size_t)255; }
constexpr size_t WS_CTL = 0;
constexpr size_t CTL_BYTES = 65536;
constexpr size_t WS_MOD = WS_CTL + CTL_BYTES;
constexpr size_t WS_WTIN = al256(WS_MOD + (size_t)2 * 5 * 12288 * 4);
constexpr size_t WS_WTOUT = al256(WS_WTIN + (size_t)2 * INP * DM * 2);
constexpr size_t WS_WTUQ = al256(WS_WTOUT + (size_t)2 * DM * DM * 2);
constexpr size_t WS_WTUKV = al256(WS_WTUQ + (size_t)2 * 768 * 384 * 2);
constexpr size_t WS_WTGLU = al256(WS_WTUKV + (size_t)2 * 1024 * 256 * 2);
constexpr size_t WS_WTGU = al256(WS_WTGLU + (size_t)2 * 512 * 512 * 2);
constexpr size_t WS_WTDN = al256(WS_WTGU + (size_t)2 * NE * 2048 * DM * 2);
constexpr size_t WS_PW = al256(WS_WTDN + (size_t)2 * NE * DM * FF * 2);
constexpr size_t WS_BB = al256(WS_PW + (size_t)2 * 2 * 32 * 64 * 17 * 8);
constexpr size_t WS_KZ = al256(WS_BB + (size_t)2 * 2 * 32 * 64 * 16 * 8);
constexpr size_t WS_WST = al256(WS_KZ + (size_t)2 * 2 * 32 * 4096 * 4);
constexpr size_t WS_G2B = al256(WS_WST + (size_t)2 * 32 * 256 * 256 * 2);
constexpr size_t WS_H = al256(WS_G2B + (size_t)2 * 32 * 256 * 512 * 2);
constexpr size_t WS_PA = al256(WS_H + (size_t)MT * DM * 2);
constexpr size_t PA_BYTES = (size_t)NE * EROWS * DM * 2;
static_assert(PA_BYTES >= (size_t)MT * INP * 2, "P fits in the union");
constexpr size_t WS_XA = al256(WS_PA + PA_BYTES);
constexpr size_t WS_XB = al256(WS_XA + (size_t)MT * DM * 4);
constexpr size_t WS_CAT = al256(WS_XB + (size_t)MT * DM * 4);
constexpr size_t WS_QA = al256(WS_CAT + (size_t)MT * DM * 2);
constexpr size_t WS_KVA = al256(WS_QA + (size_t)MT * 384 * 2);
constexpr size_t WS_QB = al256(WS_KVA + (size_t)MT * 256 * 2);
constexpr size_t WS_KC = al256(WS_QB + (size_t)MT * 768 * 2);
constexpr size_t WS_VT = al256(WS_KC + (size_t)NB * 4 * NKEY * 192 * 2);
constexpr size_t WS_UPK = al256(WS_VT + (size_t)NB * 4 * 128 * NKEY * 2);
constexpr size_t WS_EST = al256(WS_UPK + (size_t)32 * 768 * 512 * 2);
constexpr size_t WS_GB = al256(WS_EST + (size_t)32 * 768 * 256 * 4);
constexpr size_t WS_AFF = al256(WS_GB + (size_t)MT * 512 * 2);
constexpr size_t WS_ROWTOK = al256(WS_AFF + (size_t)MT * 16 * 4);
constexpr size_t WS_ROWAFF = al256(WS_ROWTOK + (size_t)NE * EROWS * 4);
constexpr size_t WS_INV = al256(WS_ROWAFF + (size_t)NE * EROWS * 4);
constexpr size_t WS_HID = al256(WS_INV + (size_t)MT * 16 * 4);
constexpr size_t WS_YS = al256(WS_HID + (size_t)NE * EROWS * FF * 2);
constexpr size_t WS_ROPE = al256(WS_YS + (size_t)NE * EROWS * DM * 2);
constexpr size_t WS_A16 = al256(WS_ROPE + 64 * 16 * 8);
constexpr size_t WS_END = al256(WS_A16 + (size_t)2 * 2 * 32 * 64 * 8);

constexpr int LDS_GEMM = 131072;
constexpr int LDS_ATTN = 3 * 44032;
constexpr int LDS_MISC = 133120;
constexpr int LDS_BYTES = LDS_MISC + 256;
static_assert(LDS_ATTN <= LDS_MISC && LDS_GEMM <= LDS_MISC, "LDS map");

typedef __bf16 bf16x2_t __attribute__((ext_vector_type(2)));
__device__ __forceinline__ unsigned cvt_pk_bf16(float lo, float hi) { const f32x2 v = {lo, hi}; const bf16x2_t b = __builtin_convertvector(v, bf16x2_t); return __builtin_bit_cast(unsigned, b); }
__device__ __forceinline__ float bf2f(unsigned short b) { return __uint_as_float(((unsigned)b) << 16); }
__device__ __forceinline__ float bflo(unsigned w) { return __uint_as_float(w << 16); }
__device__ __forceinline__ float bfhi(unsigned w) { return __uint_as_float(w & 0xffff0000u); }
__device__ __forceinline__ unsigned short f2bf(float f) { return (unsigned short)(cvt_pk_bf16(f, 0.f) & 0xffffu); }
__device__ __forceinline__ int opaque_tid() { int t = threadIdx.x; asm volatile("" : "+v"(t)); return t; }
__device__ __forceinline__ unsigned char* opaque_ptr(unsigned char* q) { long z = 0; asm volatile("" : "+s"(z)); return q + z; }
__device__ __forceinline__ float wave_sum(float v) {
#pragma unroll
    for (int o = 32; o >= 1; o >>= 1) v += __shfl_xor(v, o);
    return v;
}
__device__ __forceinline__ float gelu_tanh(float x) {
    const float y = x * (-2.3022081986679503f - 0.10294324069457f * x * x);
    return x * __builtin_amdgcn_rcpf(1.0f + __builtin_amdgcn_exp2f(y));
}
__device__ __forceinline__ float silu_f(float x) { return x * __builtin_amdgcn_rcpf(1.0f + __builtin_amdgcn_exp2f(-1.4426950408889634f * x)); }
__device__ __forceinline__ float sigmoid_f(float x) { return __builtin_amdgcn_rcpf(1.0f + __builtin_amdgcn_exp2f(-1.4426950408889634f * x)); }

#define XB_TMO      128
#define XB_XCNT(j)  (256  + 64 * (j))
#define XB_XSUB(j)  (1280 + 64 * (j))
#define XB_XGEN(j)  (2304 + 64 * (j))
#define XB_TOP      3328
#define XB_TOPGEN   3392
#define XCD_BAR_WORDS 3456
#define XB_SPIN_CAP (1u << 22)
__device__ __forceinline__ unsigned xb_ld(unsigned* p)              { return __hip_atomic_load(p, __ATOMIC_RELAXED, __HIP_MEMORY_SCOPE_AGENT); }
__device__ __forceinline__ unsigned xb_add(unsigned* p, unsigned v) { return __hip_atomic_fetch_add(p, v, __ATOMIC_RELAXED, __HIP_MEMORY_SCOPE_AGENT); }
__device__ __forceinline__ unsigned xb_xcc_id() { return (unsigned)__builtin_amdgcn_s_getreg((3 << 11) | 20) & 0xFu; }
#define XB_SPIN(cond, bar) do { unsigned _sp = 0; while (cond) { __builtin_amdgcn_s_sleep(1); \
    if ((++_sp & 255u) == 0u) { if (xb_ld(&(bar)[XB_TMO])) break; if (_sp > XB_SPIN_CAP) { atomicAdd(&(bar)[XB_TMO], 1u); break; } } } } while (0)
struct XcdBarrier { unsigned* bar; unsigned x; volatile LAS unsigned* st; };
__device__ __forceinline__ XcdBarrier xcd_barrier_post(unsigned* bar, volatile LAS unsigned* st) {
    XcdBarrier b; b.bar = bar; b.x = xb_xcc_id(); b.st = st;
    if (threadIdx.x == 0) (void)xb_add(&bar[XB_XCNT(b.x)], 1u);
    return b;
}
__device__ __forceinline__ void xcd_barrier_complete(unsigned* bar, unsigned x, unsigned& nloc, unsigned& nx) {
    const unsigned G = gridDim.x * gridDim.y * gridDim.z;
    unsigned sum, cnt, mine, sp = 0u;
    for (;;) {
        sum = 0u; cnt = 0u; mine = 0u;
#pragma unroll
        for (unsigned j = 0; j < 16; ++j) { const unsigned c = xb_ld(&bar[XB_XCNT(j)]); sum += c; cnt += (c > 0u) ? 1u : 0u; mine = (j == x) ? c : mine; }
        if (sum == G) break;
        __builtin_amdgcn_s_sleep(1);
        if ((++sp & 255u) == 0u) { if (xb_ld(&bar[XB_TMO])) break; if (sp > XB_SPIN_CAP) { atomicAdd(&bar[XB_TMO], 1u); break; } }
    }
    nloc = mine > 0u ? mine : 1u; nx = cnt > 0u ? cnt : 1u;
}
__device__ __forceinline__ void xcd_barrier(const XcdBarrier& b) {
    asm volatile("s_waitcnt vmcnt(0)" ::: "memory");
    __syncthreads();
    if (threadIdx.x == 0) {
        unsigned* bar = b.bar;
        __builtin_amdgcn_s_waitcnt(0);
        unsigned nloc = b.st[0], nx = b.st[1];
        if (nloc == 0u) { xcd_barrier_complete(bar, b.x, nloc, nx); b.st[0] = nloc; b.st[1] = nx; }
        const unsigned old = xb_add(&bar[XB_XSUB(b.x)], 1u);
        const unsigned gen = old / nloc;
        if (old + 1u == (gen + 1u) * nloc) {
            __builtin_amdgcn_fence(__ATOMIC_RELEASE, "agent");
            asm volatile("s_waitcnt vmcnt(0)" ::: "memory");
            const unsigned og = xb_add(&bar[XB_TOP], 1u);
            const unsigned tg = og / nx;
            if (og + 1u == (tg + 1u) * nx) xb_add(&bar[XB_TOPGEN], 1u);
            else XB_SPIN(xb_ld(&bar[XB_TOPGEN]) == tg, bar);
            __builtin_amdgcn_fence(__ATOMIC_ACQUIRE, "agent");
            xb_add(&bar[XB_XGEN(b.x)], 1u);
            asm volatile("s_waitcnt vmcnt(0)" ::: "memory");
        } else {
            XB_SPIN(xb_ld(&bar[XB_XGEN(b.x)]) == gen, bar);
            __builtin_amdgcn_fence(__ATOMIC_ACQUIRE, "agent");
            asm volatile("s_waitcnt vmcnt(0)" ::: "memory");
        }
    }
    __syncthreads();
}

namespace pg8 {
constexpr int BM = 256, BK = 64, HALF = 128, HTB = HALF * BK * 2, STAGE_BYTES = 8 * HTB;
__host__ __device__ __forceinline__ int lds_byte(int r, int c) { const int st = (r >> 4) * 2 + (c >> 5), rr = r & 15, cc = c & 31, ob = rr * 64 + cc * 2; return st * 1024 + (ob ^ (((ob >> 9) & 1) << 5)); }
__host__ __device__ __forceinline__ void stage_rc(int b, int& R, int& C) { const int st = b / 1024, sb = b % 1024, swz = sb ^ (((sb >> 9) & 1) << 5); R = (st >> 1) * 16 + swz / 64; C = (st & 1) * 32 + (swz % 64) / 2; }
__host__ __device__ __forceinline__ int perm32(int rho) { const int n = rho >> 4, i = rho & 15; return 8 * (i >> 2) + 4 * n + (i & 3); }

struct Unit { const char* a; const char* b; int pm, pn, pb; };
struct Desc { int lda, ldb, K; };

struct TileSched {
    const char* A; const char* B; size_t sA, sB;
    int lda, ldb, nM, nN, nB, G, c;
    __device__ __forceinline__ void init(const void* A_, const void* B_, int lda_, int ldb_, int nM_, int nN_, int nB_, size_t sA_, size_t sB_, int G_, int c_, int off) {
        A = (const char*)A_; B = (const char*)B_; lda = lda_; ldb = ldb_; nM = nM_; nN = nN_; nB = nB_; sA = sA_; sB = sB_; G = G_; c = (c_ + G_ - (off % G_)) % G_; }
    __device__ __forceinline__ bool next(int i, Unit& u) const {
        const int nwg = nM * nN; const long L = (long)i * G + c; if (L >= (long)nwg * nB) return false;
        const int pb = (int)(L / nwg); int wgid = (int)(L % nwg);
        { const int q = nwg / 8, r = nwg % 8, xcd = wgid % 8, off = wgid / 8; wgid = (xcd < r ? xcd * (q + 1) : r * (q + 1) + (xcd - r) * q) + off; }
        const int nig = 8 * nN, gid = wgid / nig, fm = gid * 8, gsz = (nM - fm) < 8 ? (nM - fm) : 8;
        u.pm = fm + ((wgid % nig) % gsz); u.pn = (wgid % nig) / gsz; u.pb = pb;
        u.a = A + (size_t)pb * sA + (size_t)u.pm * 256 * lda * 2; u.b = B + (size_t)pb * sB + (size_t)u.pn * 256 * ldb * 2; return true;
    }
};
struct InSchedLast {
    TileSched T;
    __device__ __forceinline__ void init(const void* A_, const void* B_, int G_, int c_) { T.init(A_, B_, DM, DM, NLAT / 256, INP / 256, 1, 0, 0, G_, c_, 0); }
    __device__ __forceinline__ bool next(int i, Unit& u) const {
        const int nlat = (NLAT / 256) * (INP / 256); const long L = (long)i * T.G + T.c;
        if (L < nlat) return T.next(i, u);
        if (L >= nlat + 16) return false;
        const int k = (int)(L - nlat); u.pm = NLAT / 256 + (k >> 2); u.pn = 5 + (k & 3); u.pb = 0;
        u.a = T.A + (size_t)u.pm * 256 * DM * 2; u.b = T.B + (size_t)u.pn * 256 * DM * 2; return true;
    }
};
struct MoeSched {
    const char* A; const char* B; size_t sA, sB; int lda, ldb, nM, nN, G, c;
    __device__ __forceinline__ void init(const void* A_, const void* B_, int lda_, int ldb_, int nM_, int nN_, size_t sA_, size_t sB_, int G_, int c_) {
        A = (const char*)A_; B = (const char*)B_; lda = lda_; ldb = ldb_; nM = nM_; nN = nN_; sA = sA_; sB = sB_; G = G_; c = c_; }
    __device__ __forceinline__ bool next(int i, Unit& u) const {
        int e, rem; const int per = nM * nN;
        if ((G & 7) == 0) { const int x = c & 7, j = c >> 3, w = G >> 3; const int L = i * w + j; if (L >= 2 * per) return false; e = 2 * x + L / per; rem = L % per; }
        else { const long L = (long)i * G + c; if (L >= (long)NE * per) return false; e = (int)(L / per); rem = (int)(L % per); }
        u.pn = rem / nM; u.pm = rem % nM; u.pb = e;
        u.a = sA == 0 ? A : A + (size_t)e * sA + (size_t)u.pm * 256 * lda * 2; u.b = B + (size_t)e * sB + (size_t)u.pn * 256 * ldb * 2; return true;
    }
};

template <class Epi, class Sched, bool GATHER = false>
__device__ __forceinline__ void gemm_phase(LAS unsigned char* lds, const Desc g, const Sched& S, const Epi& E, const int* rowtok = nullptr, int nvalid = 0) {
    const int tid = opaque_tid(), wid = __builtin_amdgcn_readfirstlane(tid >> 6), lane = tid & 63, wr = wid >> 2, wc = wid & 3, fr = lane & 15, fq = lane >> 4;
    const int K = g.K, nt = K / BK;
    unsigned voffA[2], voffB[2]; int gR[2], gCc[2];
#pragma unroll
    for (int i = 0; i < 2; ++i) { int R, C; stage_rc(tid * 16 + i * 8192, R, C); const int Rb = Epi::PERM ? ((R & ~31) + perm32(R & 31)) : R;
        voffA[i] = (unsigned)(R * g.lda + C) * 2u; voffB[i] = (unsigned)(Rb * g.ldb + C) * 2u; gR[i] = R; gCc[i] = C; }
    unsigned gC[2][2], gN[2][2];
#define PG8_GOFF(u, o) do { _Pragma("unroll") for (int _h = 0; _h < 2; ++_h) _Pragma("unroll") for (int _i = 0; _i < 2; ++_i) { const int _r = (u).pm * 256 + _h * 128 + gR[_i]; \
        const int _tok = _r < nvalid ? rowtok[(u).pb * EROWS + _r] : 0; (o)[_h][_i] = (unsigned)(_tok * g.lda + gCc[_i]) * 2u; } } while (0)
    const size_t kstep = (size_t)(BK * 2);
    const size_t hstepA = (size_t)HALF * g.lda * 2, hstepB = (size_t)HALF * g.ldb * 2;
    const unsigned ldsw = (unsigned)wid * 1024u;
    const int aoff = lds_byte(wr * 64 + fr, fq * 8), boff = lds_byte(wc * 32 + fr, fq * 8);
#define PG8_SA(b, h) (((b) * 2 + (h)) * HTB)
#define PG8_SB(b, h) ((4 + (b) * 2 + (h)) * HTB)
#define PG8_STAGE(bufoff, gbase, voff) do { _Pragma("unroll") for (int _i = 0; _i < 2; ++_i) \
        __builtin_amdgcn_global_load_lds((const unsigned*)((const char*)(gbase) + (voff)[_i]), (LAS unsigned*)(lds + (bufoff) + ldsw + _i * 8192), 16, 0, 0); } while (0)
#define PG8_STAGE_A(bufoff, kptr, half, VO) do { if constexpr (GATHER) { _Pragma("unroll") for (int _i = 0; _i < 2; ++_i) \
        __builtin_amdgcn_global_load_lds((const unsigned*)((const char*)(kptr) + (VO)[half][_i]), (LAS unsigned*)(lds + (bufoff) + ldsw + _i * 8192), 16, 0, 0); } \
        else { PG8_STAGE(bufoff, (kptr) + (half) * hstepA, voffA); } } while (0)
#define PG8_LDA(dst, b, h) do { _Pragma("unroll") for (int m = 0; m < 4; ++m) _Pragma("unroll") for (int k = 0; k < 2; ++k) dst[m][k] = *(const LAS bf16x8*)(lds + PG8_SA(b, h) + aoff + m * 2048 + k * 1024); } while (0)
#define PG8_LDB(dst, b, h) do { _Pragma("unroll") for (int n = 0; n < 2; ++n) _Pragma("unroll") for (int k = 0; k < 2; ++k) dst[n][k] = *(const LAS bf16x8*)(lds + PG8_SB(b, h) + boff + n * 2048 + k * 1024); } while (0)
#define PG8_MMA(ai, bj, At, Bt) do { __builtin_amdgcn_s_setprio(1); _Pragma("unroll") for (int m = 0; m < 4; ++m) _Pragma("unroll") for (int n = 0; n < 2; ++n) _Pragma("unroll") for (int k = 0; k < 2; ++k) \
        acc[ai][bj][m][n] = __builtin_amdgcn_mfma_f32_16x16x32_bf16(Bt[n][k], At[m][k], acc[ai][bj][m][n], 0, 0, 0); __builtin_amdgcn_s_setprio(0); } while (0)
#define PG8_WAIT_V(n) asm volatile("s_waitcnt vmcnt(" #n ")" ::: "memory")
#define PG8_WAIT_L(n) asm volatile("s_waitcnt lgkmcnt(" #n ")" ::: "memory")
#define PG8_BAR __builtin_amdgcn_s_barrier()
#define PG8_SCHED __builtin_amdgcn_sched_barrier(0)
    Unit cur, nxt; int ui = 0;
    if (!S.next(0, cur)) return;
    f32x4 acc[2][2][4][2];
#pragma unroll
    for (int a = 0; a < 2; ++a)
#pragma unroll
        for (int b = 0; b < 2; ++b)
#pragma unroll
            for (int m = 0; m < 4; ++m)
#pragma unroll
                for (int n = 0; n < 2; ++n) acc[a][b][m][n] = (f32x4){0.f, 0.f, 0.f, 0.f};
    bf16x8 At[4][2], B0[2][2], B1[2][2];
    const char* cA = cur.a; const char* cB = cur.b;
    if constexpr (GATHER) { PG8_GOFF(cur, gC); }
    PG8_STAGE(PG8_SB(0, 0), cB, voffB); PG8_STAGE_A(PG8_SA(0, 0), cA, 0, gC); PG8_STAGE(PG8_SB(0, 1), cB + hstepB, voffB); PG8_STAGE_A(PG8_SA(0, 1), cA, 1, gC);
    if (wr == 1) PG8_BAR;
    PG8_WAIT_V(4); PG8_BAR;
    PG8_STAGE(PG8_SB(1, 0), cB + kstep, voffB); PG8_STAGE_A(PG8_SA(1, 0), cA + kstep, 0, gC); PG8_STAGE(PG8_SB(1, 1), cB + hstepB + kstep, voffB);
    PG8_WAIT_V(6); PG8_BAR;
    for (;;) {
        const bool has_next = S.next(ui + 1, nxt);
        const char* nA = has_next ? nxt.a : cA; const char* nB = has_next ? nxt.b : cB;
        if constexpr (GATHER) { if (has_next) { PG8_GOFF(nxt, gN); } else {
#pragma unroll
            for (int _h = 0; _h < 2; ++_h)
#pragma unroll
                for (int _i = 0; _i < 2; ++_i) gN[_h][_i] = gC[_h][_i]; } }
#pragma nounroll
        for (int t = 0; t < nt; t += 2) {
            const bool last = (t == nt - 2);
            const char* a1 = cA + (size_t)(t + 1) * kstep;
            const char* a2 = last ? nA : cA + (size_t)(t + 2) * kstep; const char* b2 = last ? nB : cB + (size_t)(t + 2) * kstep;
            const char* a3 = a2 + kstep; const char* b3 = b2 + kstep;
            unsigned g2[2][2];
            if constexpr (GATHER) {
#pragma unroll
                for (int _h = 0; _h < 2; ++_h)
#pragma unroll
                    for (int _i = 0; _i < 2; ++_i) g2[_h][_i] = last ? gN[_h][_i] : gC[_h][_i]; }
            PG8_LDB(B0, 0, 0); PG8_SCHED; PG8_LDA(At, 0, 0); PG8_STAGE_A(PG8_SA(1, 1), a1, 1, gC);
            PG8_WAIT_L(8); PG8_BAR; PG8_WAIT_L(0); PG8_MMA(0, 0, At, B0); PG8_BAR; PG8_SCHED;
            PG8_LDB(B1, 0, 1); PG8_STAGE(PG8_SB(0, 0), b2, voffB);
            PG8_BAR; PG8_WAIT_L(0); PG8_MMA(0, 1, At, B1); PG8_BAR;
            PG8_LDA(At, 0, 1); PG8_STAGE_A(PG8_SA(0, 0), a2, 0, g2);
            PG8_BAR; PG8_WAIT_L(0); PG8_MMA(1, 0, At, B0); PG8_BAR; PG8_SCHED;
            PG8_STAGE(PG8_SB(0, 1), b2 + hstepB, voffB);
            PG8_WAIT_V(6); PG8_BAR; PG8_MMA(1, 1, At, B1); PG8_BAR;
            PG8_LDB(B0, 1, 0); PG8_SCHED; PG8_LDA(At, 1, 0); PG8_STAGE_A(PG8_SA(0, 1), a2, 1, g2);
            PG8_WAIT_L(8); PG8_BAR; PG8_WAIT_L(0); PG8_MMA(0, 0, At, B0); PG8_BAR; PG8_SCHED;
            PG8_LDB(B1, 1, 1); PG8_STAGE(PG8_SB(1, 0), b3, voffB);
            PG8_BAR; PG8_WAIT_L(0); PG8_MMA(0, 1, At, B1); PG8_BAR;
            PG8_LDA(At, 1, 1); PG8_STAGE_A(PG8_SA(1, 0), a3, 0, g2);
            PG8_BAR; PG8_WAIT_L(0); PG8_MMA(1, 0, At, B0); PG8_BAR; PG8_SCHED;
            PG8_STAGE(PG8_SB(1, 1), b3 + hstepB, voffB);
            PG8_WAIT_V(6); PG8_BAR; PG8_MMA(1, 1, At, B1); PG8_BAR;
        }
        E(acc, cur, wr, wc, fr, fq);
        if (!has_next) break;
#pragma unroll
        for (int a = 0; a < 2; ++a)
#pragma unroll
            for (int b = 0; b < 2; ++b)
#pragma unroll
                for (int m = 0; m < 4; ++m)
#pragma unroll
                    for (int n = 0; n < 2; ++n) acc[a][b][m][n] = (f32x4){0.f, 0.f, 0.f, 0.f};
        cur = nxt; cA = nA; cB = nB; ++ui;
        if constexpr (GATHER) {
#pragma unroll
            for (int _h = 0; _h < 2; ++_h)
#pragma unroll
                for (int _i = 0; _i < 2; ++_i) gC[_h][_i] = gN[_h][_i]; }
    }
    PG8_WAIT_V(0);
    if (wr == 0) PG8_BAR;
    PG8_BAR;
#undef PG8_SA
#undef PG8_SB
#undef PG8_STAGE
#undef PG8_STAGE_A
#undef PG8_GOFF
#undef PG8_LDA
#undef PG8_LDB
#undef PG8_MMA
#undef PG8_WAIT_V
#undef PG8_WAIT_L
#undef PG8_BAR
#undef PG8_SCHED
}

#define PG8_FOR_PERM(...) \
    _Pragma("unroll") for (int ai = 0; ai < 2; ++ai) _Pragma("unroll") for (int m = 0; m < 4; ++m) { const int tr = ai * 128 + wr * 64 + m * 16 + fr; \
        _Pragma("unroll") for (int bj = 0; bj < 2; ++bj) { const int tc = bj * 128 + wc * 32 + 8 * fq; const f32x4 v0 = acc[ai][bj][m][0], v1 = acc[ai][bj][m][1]; __VA_ARGS__ } }
#define PG8_FOR_NOPERM(...) \
    _Pragma("unroll") for (int ai = 0; ai < 2; ++ai) _Pragma("unroll") for (int m = 0; m < 4; ++m) { const int tr = ai * 128 + wr * 64 + m * 16 + fr; \
        _Pragma("unroll") for (int bj = 0; bj < 2; ++bj) _Pragma("unroll") for (int n = 0; n < 2; ++n) { const int tc = bj * 128 + wc * 32 + 16 * n + 4 * fq; const f32x4 v = acc[ai][bj][m][n]; __VA_ARGS__ } }

typedef const f32x4 (&AccRef)[2][2][4][2];

struct EpiStoreBf16 {
    static constexpr bool PERM = true;
    bf16_t* O; int ldc;
    __device__ __forceinline__ void operator()(AccRef acc, const Unit& u, int wr, int wc, int fr, int fq) const {
        PG8_FOR_PERM({ u32x4 w; w.x = cvt_pk_bf16(v0[0], v0[1]); w.y = cvt_pk_bf16(v0[2], v0[3]); w.z = cvt_pk_bf16(v1[0], v1[1]); w.w = cvt_pk_bf16(v1[2], v1[3]);
            *(u32x4*)(O + (size_t)(u.pm * 256 + tr) * ldc + u.pn * 256 + tc) = w; })
    }
};
struct EpiQ {
    static constexpr bool PERM = false;
    bf16_t* Q; const f32x2* ROPE;
    __device__ __forceinline__ void operator()(AccRef acc, const Unit& u, int wr, int wc, int fr, int fq) const {
#pragma unroll
        for (int ai = 0; ai < 2; ++ai)
#pragma unroll
            for (int m = 0; m < 4; ++m) { const int row = u.pm * 256 + ai * 128 + wr * 64 + m * 16 + fr; const bool lat = row < NLAT; const int t = row & (SEQ - 1);
#pragma unroll
                for (int bj = 0; bj < 2; ++bj) { const int cg = u.pn * 256 + bj * 128 + wc * 32; const int dd = cg % 192; f32x4 a = acc[ai][bj][m][0], b = acc[ai][bj][m][1];
                    if (dd >= 128 && lat) { const int pos = (dd - 128) >= 32 ? (t & 63) : (t >> 6); const f32x4* rp = (const f32x4*)(ROPE + pos * 16 + 4 * fq); const f32x4 r0 = rp[0], r1 = rp[1];
                        const float cs[4] = {r0[0], r0[2], r1[0], r1[2]}, sn[4] = {r0[1], r0[3], r1[1], r1[3]};
#pragma unroll
                        for (int i = 0; i < 4; ++i) { const float x1 = a[i], x2 = b[i]; a[i] = x1 * cs[i] - x2 * sn[i]; b[i] = x2 * cs[i] + x1 * sn[i]; } }
                    a *= QSCALE; b *= QSCALE;
                    bf16_t* o = Q + (size_t)row * 768 + cg + 4 * fq;
                    u32x2 w0; w0.x = cvt_pk_bf16(a[0], a[1]); w0.y = cvt_pk_bf16(a[2], a[3]); *(u32x2*)o = w0;
                    u32x2 w1; w1.x = cvt_pk_bf16(b[0], b[1]); w1.y = cvt_pk_bf16(b[2], b[3]); *(u32x2*)(o + 16) = w1; } }
    }
};
struct EpiK {
    static constexpr bool PERM = true;
    bf16_t* KC;
    __device__ __forceinline__ void operator()(AccRef acc, const Unit& u, int wr, int wc, int fr, int fq) const {
        const int b = u.pm < 32 ? (u.pm >> 3) : (u.pm - 32), key0 = u.pm < 32 ? CTX + (u.pm & 7) * 256 : 0;
        bf16_t* base = KC + ((size_t)(b * 4 + u.pn * 2) * NKEY + key0) * 192 + (size_t)(wr * 64 + fr) * 192 + wc * 32 + 8 * fq;
#pragma unroll
        for (int ai = 0; ai < 2; ++ai)
#pragma unroll
            for (int m = 0; m < 4; ++m)
#pragma unroll
                for (int bj = 0; bj < 2; ++bj) { const f32x4 v0 = acc[ai][bj][m][0], v1 = acc[ai][bj][m][1];
                    u32x4 w; w.x = cvt_pk_bf16(v0[0], v0[1]); w.y = cvt_pk_bf16(v0[2], v0[3]); w.z = cvt_pk_bf16(v1[0], v1[1]); w.w = cvt_pk_bf16(v1[2], v1[3]);
                    *(u32x4*)(base + (size_t)(ai * 128 + m * 16) * 192 + (size_t)bj * NKEY * 192) = w; }
    }
};
struct EpiV {
    static constexpr bool PERM = true;
    bf16_t* VT;
    __device__ __forceinline__ void operator()(AccRef acc, const Unit& u, int wr, int wc, int fr, int fq) const {
        const int b = u.pn < 32 ? (u.pn >> 3) : (u.pn - 32), key0 = u.pn < 32 ? CTX + (u.pn & 7) * 256 : 0;
        bf16_t* base = VT + ((size_t)(b * 4 + u.pm * 2) * 128 + wr * 64 + fr) * NKEY + key0 + wc * 32 + 8 * fq;
#pragma unroll
        for (int ai = 0; ai < 2; ++ai)
#pragma unroll
            for (int m = 0; m < 4; ++m)
#pragma unroll
                for (int bj = 0; bj < 2; ++bj) { const f32x4 v0 = acc[ai][bj][m][0], v1 = acc[ai][bj][m][1];
                    u32x2 w0, w1; w0.x = cvt_pk_bf16(v0[0], v0[1]); w0.y = cvt_pk_bf16(v0[2], v0[3]); w1.x = cvt_pk_bf16(v1[0], v1[1]); w1.y = cvt_pk_bf16(v1[2], v1[3]);
                    bf16_t* q = base + (size_t)(ai * 128 + m * 16) * NKEY + bj * 128; const int odd = fq & 1;
                    *(u32x2*)(q + (odd ? -4 : 0)) = w0; *(u32x2*)(q + (odd ? 4 : 8)) = w1; }
    }
};
struct EpiS1 {
    static constexpr bool PERM = false;
    float* EST;
    __device__ __forceinline__ void operator()(AccRef acc, const Unit& u, int wr, int wc, int fr, int fq) const {
        PG8_FOR_NOPERM({ const int row = u.pm * 256 + tr; if (row < NCHUNK) *(f32x4*)(EST + ((size_t)u.pb * 768 + row) * 256 + tc) = v; })
    }
};
struct EpiS2 {
    static constexpr bool PERM = true;
    bf16_t* GB;
    __device__ __forceinline__ void operator()(AccRef acc, const Unit& u, int wr, int wc, int fr, int fq) const {
        PG8_FOR_PERM({ const int row = u.pm * 256 + tr; if (row < NCHUNK) { const int p = tc >> 4, c = tc & 15;
            u32x4 w; w.x = cvt_pk_bf16(gelu_tanh(v0[0]), gelu_tanh(v0[1])); w.y = cvt_pk_bf16(gelu_tanh(v0[2]), gelu_tanh(v0[3]));
            w.z = cvt_pk_bf16(gelu_tanh(v1[0]), gelu_tanh(v1[1])); w.w = cvt_pk_bf16(gelu_tanh(v1[2]), gelu_tanh(v1[3]));
            *(u32x4*)(GB + (size_t)(row * 16 + p) * 512 + u.pb * 16 + c) = w; } })
    }
};
struct EpiGlu {
    static constexpr bool PERM = true;
    const bf16_t* GB; const float* bias; bf16_t* CAT;
    __device__ __forceinline__ void operator()(AccRef acc, const Unit& u, int wr, int wc, int fr, int fq) const {
        PG8_FOR_PERM({ const int row = u.pm * 256 + tr, col = u.pn * 256 + tc;
            const u32x4 gv = *(const u32x4*)(GB + (size_t)row * 512 + col); const f32x4 b0 = *(const f32x4*)(bias + col), b1 = *(const f32x4*)(bias + col + 4);
            u32x4 w;
            w.x = cvt_pk_bf16(bflo(gv.x) * sigmoid_f(v0[0] + b0[0]), bfhi(gv.x) * sigmoid_f(v0[1] + b0[1]));
            w.y = cvt_pk_bf16(bflo(gv.y) * sigmoid_f(v0[2] + b0[2]), bfhi(gv.y) * sigmoid_f(v0[3] + b0[3]));
            w.z = cvt_pk_bf16(bflo(gv.z) * sigmoid_f(v1[0] + b1[0]), bfhi(gv.z) * sigmoid_f(v1[1] + b1[1]));
            w.w = cvt_pk_bf16(bflo(gv.w) * sigmoid_f(v1[2] + b1[2]), bfhi(gv.w) * sigmoid_f(v1[3] + b1[3]));
            *(u32x4*)(CAT + (size_t)row * DM + 1024 + col) = w; })
    }
};
struct EpiOut {
    static constexpr bool PERM = true;
    const float* xl; const float* xc; const bf16_t* xs; const float* gate; bf16_t* xo;
    __device__ __forceinline__ void operator()(AccRef acc, const Unit& u, int wr, int wc, int fr, int fq) const {
        PG8_FOR_PERM({ const int row = u.pm * 256 + tr, col = u.pn * 256 + tc; const int rr = row < NLAT ? (row >> 11) : 4;
            f32x4 x0, x1;
            if (xs) { const u32x4 xv = *(const u32x4*)(xs + (size_t)row * DM + col); x0 = (f32x4){bflo(xv.x), bfhi(xv.x), bflo(xv.y), bfhi(xv.y)}; x1 = (f32x4){bflo(xv.z), bfhi(xv.z), bflo(xv.w), bfhi(xv.w)}; }
            else { const float* src = (row < NLAT ? xl + (size_t)row * DM : xc + (size_t)(row - NLAT) * DM) + col; x0 = *(const f32x4*)src; x1 = *(const f32x4*)(src + 4); }
            const float* gp = gate + (size_t)rr * 12288 + col; const f32x4 g0 = *(const f32x4*)gp, g1 = *(const f32x4*)(gp + 4);
            x0 += g0 * v0; x1 += g1 * v1;
            u32x4 w; w.x = cvt_pk_bf16(x0[0], x0[1]); w.y = cvt_pk_bf16(x0[2], x0[3]); w.z = cvt_pk_bf16(x1[0], x1[1]); w.w = cvt_pk_bf16(x1[2], x1[3]);
            *(u32x4*)(xo + (size_t)row * DM + col) = w; })
    }
};
struct EpiGU {
    static constexpr bool PERM = true;
    bf16_t* HID;
    __device__ __forceinline__ void operator()(AccRef acc, const Unit& u, int wr, int wc, int fr, int fq) const {
        PG8_FOR_PERM({ const int row = u.pm * 256 + tr, j = (u.pn * 256 + tc) >> 1;
            u32x2 w; w.x = cvt_pk_bf16(silu_f(v0[0]) * v0[1], silu_f(v0[2]) * v0[3]); w.y = cvt_pk_bf16(silu_f(v1[0]) * v1[1], silu_f(v1[2]) * v1[3]);
            *(u32x2*)(HID + ((size_t)u.pb * EROWS + row) * FF + j) = w; })
    }
};
struct EpiDown {
    static constexpr bool PERM = true;
    bf16_t* YS; const float* RA;
    __device__ __forceinline__ void operator()(AccRef acc, const Unit& u, int wr, int wc, int fr, int fq) const {
        PG8_FOR_PERM({ const int row = u.pm * 256 + tr, col = u.pn * 256 + tc; const float a = RA[u.pb * EROWS + row];
            u32x4 w; w.x = cvt_pk_bf16(v0[0] * a, v0[1] * a); w.y = cvt_pk_bf16(v0[2] * a, v0[3] * a); w.z = cvt_pk_bf16(v1[0] * a, v1[1] * a); w.w = cvt_pk_bf16(v1[2] * a, v1[3] * a);
            *(u32x4*)(YS + ((size_t)u.pb * EROWS + row) * DM + col) = w; })
    }
};
}

struct Params { const float* in[33]; float* out; unsigned char* ws; int ph_lo, ph_hi; };
enum { I_X = 0, I_C, I_CTX, I_CCTX, I_N1G, I_N2G, I_WADA, I_BADA, I_WIN, I_WOUT, I_SGUNG, I_SGUW, I_SGUB, I_QNG, I_WUQ, I_KVNG, I_WUKV,
       I_ARE, I_AIM, I_LOGDT, I_BRE, I_BIM, I_CRE, I_CIM, I_S5D, I_WGLU, I_BGLU, I_CONVW, I_WROUTER, I_WGATE, I_WUP, I_WDOWN, I_FNG };

__device__ __forceinline__ void transpose_tile(const float* src, int N, int k0, int n0, bf16_t* dst, int ldd, int rmul, int radd, int remap_kv, LAS float* tile) {
    const int tid = threadIdx.x;
#pragma unroll
    for (int i = 0; i < 2; ++i) { const int r = (tid >> 4) + 32 * i, c4 = (tid & 15) * 4;
        const f32x4 v = *(const f32x4*)(src + (size_t)(k0 + r) * N + n0 + c4);
        tile[r * 65 + c4 + 0] = v[0]; tile[r * 65 + c4 + 1] = v[1]; tile[r * 65 + c4 + 2] = v[2]; tile[r * 65 + c4 + 3] = v[3]; }
    __syncthreads();
    { const int n = tid >> 3, kc = tid & 7; float f[8];
#pragma unroll
        for (int j = 0; j < 8; ++j) f[j] = tile[(kc * 8 + j) * 65 + n];
        int nn = n0 + n; if (remap_kv) nn = ((nn & 255) < 128) ? ((nn >> 8) * 128 + (nn & 127)) : (512 + (nn >> 8) * 128 + (nn & 127));
        const int drow = nn * rmul + radd;
        u32x4 w; w.x = cvt_pk_bf16(f[0], f[1]); w.y = cvt_pk_bf16(f[2], f[3]); w.z = cvt_pk_bf16(f[4], f[5]); w.w = cvt_pk_bf16(f[6], f[7]);
        *(u32x4*)(dst + (size_t)drow * ldd + k0 + kc * 8) = w; }
    __syncthreads();
}
constexpr int N_ADA_UNITS = 192, N_S5T_UNITS = 64, N_ROPE_UNITS = 2;
constexpr int T_WIN = 32 * 14 + 32 * 3  , T_WOUT = 32 * 8  , T_WUQ = 6 * 12, T_WUKV = 4 * 16, T_WGLU = 8 * 8, T_EXP = 512;
constexpr int N_TR = 2 * (T_WIN + T_WOUT + T_WUQ + T_WUKV + T_WGLU);
constexpr int N_PRO_ITEMS = N_ADA_UNITS + N_S5T_UNITS + N_ROPE_UNITS + N_TR;


__device__ __forceinline__ void transpose_block(const float* src, int N, int k0, int n0, bf16_t* dst, int ldd, int rmul, int radd, LAS float* tile  ) {
    const int tid = opaque_tid();
    f32x4 v[8];
#pragma unroll
    for (int i = 0; i < 8; ++i) v[i] = __builtin_nontemporal_load((const f32x4*)(src + (size_t)(k0 + (tid >> 6) + 8 * i) * N + n0 + (tid & 63) * 4));
#pragma unroll
    for (int i = 0; i < 8; ++i) { const int r = (tid >> 6) + 8 * i; *(LAS f32x4*)(tile + r * 260 + (((tid & 63) * 4) ^ (8 * (r >> 3)))) = v[i]; }
    __syncthreads();
#pragma unroll
    for (int i = 0; i < 4; ++i) { const int id = tid + 512 * i, n = id >> 3, kc = id & 7; float f[8];
#pragma unroll
        for (int j = 0; j < 8; ++j) f[j] = tile[(kc * 8 + j) * 260 + (n ^ (8 * kc))];
        u32x4 w; w.x = cvt_pk_bf16(f[0], f[1]); w.y = cvt_pk_bf16(f[2], f[3]); w.z = cvt_pk_bf16(f[4], f[5]); w.w = cvt_pk_bf16(f[6], f[7]);
        __builtin_nontemporal_store(w, (u32x4*)(dst + (size_t)((n0 + n) * rmul + radd) * ldd + k0 + kc * 8)); }
    __syncthreads();
}
constexpr int QB_EXP = T_EXP / 4, Q_GU = NE * 2 * QB_EXP, Q_LAYER = Q_GU + NE * QB_EXP, Q_TOTAL = 2 * Q_LAYER;
constexpr int CW_QHEAD = 4096, CW_DONE = 4160;
static_assert((CW_DONE + 64 * 32) * 4 <= (int)CTL_BYTES, "control words inside the memset region");
__device__ __forceinline__ void moe_convert_block(const Params& p, unsigned char* ws, int t, LAS float* tile) {
    const int l = t / Q_LAYER, r = t % Q_LAYER;
    if (r < Q_GU) { const int e = r / (2 * QB_EXP), rr = r % (2 * QB_EXP), up = rr / QB_EXP, q = rr % QB_EXP; const int le = l * NE + e;
        transpose_block((up ? p.in[I_WUP] : p.in[I_WGATE]) + (size_t)le * DM * FF, FF, (q >> 2) * 64, (q & 3) * 256, (bf16_t*)(ws + WS_WTGU) + (size_t)le * 2048 * DM, DM, 2, up, tile); }
    else { const int r2 = r - Q_GU, e = r2 / QB_EXP, q = r2 % QB_EXP; const int le = l * NE + e;
        transpose_block(p.in[I_WDOWN] + (size_t)le * FF * DM, DM, (q >> 3) * 64, (q & 7) * 256, (bf16_t*)(ws + WS_WTDN) + (size_t)le * DM * FF, FF, 1, 0, tile); }
}
#ifndef FILL_ON
#define FILL_ON 0
#endif
constexpr unsigned Q_BULK = 4;
__device__ __forceinline__ unsigned moe_claim(unsigned* ctl, int ph, int upto, int mode, unsigned target) {
    unsigned t = 0xffffffffu;
    const unsigned head = __hip_atomic_load(ctl + CW_QHEAD, __ATOMIC_RELAXED, __HIP_MEMORY_SCOPE_AGENT);
    const bool go = mode ? (head < (unsigned)upto) : (head < (unsigned)Q_TOTAL && __hip_atomic_load(ctl + CW_DONE + 64 * ph, __ATOMIC_RELAXED, __HIP_MEMORY_SCOPE_AGENT) < target);
    if (go) t = __hip_atomic_fetch_add(ctl + CW_QHEAD, mode ? Q_BULK : 1u, __ATOMIC_RELAXED, __HIP_MEMORY_SCOPE_AGENT);
    return t;
}
__device__ __forceinline__ void moe_pump(const Params& p, LAS unsigned char* lds, int ph, int upto, int mode, unsigned target = 0u, bool count_me = true) {
    unsigned char* ws = opaque_ptr(p.ws); unsigned* ctl = (unsigned*)(ws + WS_CTL);
    LAS float* tile = (LAS float*)lds; volatile LAS unsigned* slot = (volatile LAS unsigned*)(lds + LDS_MISC + 32);
    const int tid = opaque_tid(); const int nblk = mode ? (int)Q_BULK : 1;
    __syncthreads();
    if (tid == 0) { if (mode == 0 && count_me) (void)__hip_atomic_fetch_add(ctl + CW_DONE + 64 * ph, 1u, __ATOMIC_RELAXED, __HIP_MEMORY_SCOPE_AGENT); slot[0] = moe_claim(ctl, ph, upto, mode, target ? target : gridDim.x); }
    __syncthreads();
    for (;;) {
        const unsigned t = slot[0];
        if (t >= (unsigned)Q_TOTAL) break;
        unsigned nxt = 0u;
        if (tid == 0) nxt = moe_claim(ctl, ph, upto, mode, target ? target : gridDim.x);
#pragma unroll 1
        for (int k = 0; k < nblk; ++k) if ((int)t + k < Q_TOTAL) moe_convert_block(p, ws, (int)t + k, tile);
        if (tid == 0) slot[0] = nxt;
        __syncthreads();
    }
}
__device__ __forceinline__ void moe_fill(const Params& p, LAS unsigned char* lds, int ph) { if (FILL_ON) moe_pump(p, lds, ph, Q_TOTAL, 0); }
__device__ __forceinline__ void moe_mark_done(const Params& p, int ph) { if (threadIdx.x == 0) (void)__hip_atomic_fetch_add((unsigned*)(p.ws + WS_CTL) + CW_DONE + 64 * ph, 1u, __ATOMIC_RELAXED, __HIP_MEMORY_SCOPE_AGENT); }
__device__ __forceinline__ void moe_convert_while(const Params& p, LAS unsigned char* lds, int ph, unsigned ngemm) { moe_pump(p, lds, ph, Q_TOTAL, 0, ngemm, false); }
__device__ __forceinline__ void moe_require(const Params& p, LAS unsigned char* lds, int upto) { moe_pump(p, lds, 0, upto, 1); }

__device__ __forceinline__ void ph_prologue(const Params& p, LAS unsigned char* lds) {
    const int tid = opaque_tid(), lane = tid & 63, wave = tid >> 6;
    unsigned char* ws = opaque_ptr(p.ws);
    for (int it = blockIdx.x; it < N_PRO_ITEMS; it += gridDim.x) {
        if (it < N_ADA_UNITS) {
            const int l = it / 96, cb = it % 96;
            LAS float* sil = (LAS float*)lds;
            LAS float* red = (LAS float*)(lds + 40960);
            for (int i = tid; i < 5 * DM; i += 512) { const int r = i >> 11, k = i & (DM - 1); const float v = r < 4 ? p.in[I_C][r * DM + k] : p.in[I_CCTX][k]; sil[i] = silu_f(v); }
            __syncthreads();
            f32x2 acc[5];
#pragma unroll
            for (int r = 0; r < 5; ++r) acc[r] = (f32x2){0.f, 0.f};
            const float* W = p.in[I_WADA] + (size_t)l * DM * 12288 + cb * 128 + lane * 2;
            for (int k = wave * 256; k < wave * 256 + 256; k += 16) {
                f32x2 w[16];
#pragma unroll
                for (int j = 0; j < 16; ++j) w[j] = __builtin_nontemporal_load((const f32x2*)(W + (size_t)(k + j) * 12288));
#pragma unroll
                for (int j = 0; j < 16; ++j)
#pragma unroll
                    for (int r = 0; r < 5; ++r) acc[r] += sil[r * DM + k + j] * w[j];
            }
#pragma unroll
            for (int r = 0; r < 5; ++r) { red[(wave * 5 + r) * 128 + lane * 2] = acc[r].x; red[(wave * 5 + r) * 128 + lane * 2 + 1] = acc[r].y; }
            __syncthreads();
            float* mod = (float*)(ws + WS_MOD);
            for (int o = tid; o < 5 * 128; o += 512) { const int r = o >> 7, cc = o & 127; float sum = p.in[I_BADA][l * 12288 + cb * 128 + cc];
#pragma unroll
                for (int w8 = 0; w8 < 8; ++w8) sum += red[(w8 * 5 + r) * 128 + cc];
                mod[(size_t)(l * 5 + r) * 12288 + cb * 128 + cc] = sum; }
            __syncthreads();
        } else if (it < N_ADA_UNITS + N_S5T_UNITS) {
            const int lg = it - N_ADA_UNITS, l = lg >> 5, g = lg & 31;
            LAS f32x2* PWl = (LAS f32x2*)lds;
            LAS f32x2* BBl = (LAS f32x2*)(lds + 17408);
            LAS f32x2* Cl = (LAS f32x2*)(lds + 33792);
            LAS float* KZl = (LAS float*)(lds + 50176);
            for (int idx = tid; idx < 2 * 64 * 17; idx += 512) { const int z = idx / (64 * 17), n = (idx / 17) & 63, d = idx % 17; const int zgn = ((l * 2 + z) * 32 + g) * 64 + n;
                const float are = fminf(p.in[I_ARE][zgn], -1e-4f), aim = p.in[I_AIM][zgn]; const float dt = expf(p.in[I_LOGDT][zgn >> 6]);
                const double mag = exp((double)are * (double)dt * d); double sn, cs; sincos((double)aim * (double)dt * d, &sn, &cs);
                const f32x2 v = {(float)(mag * cs), (float)(mag * sn)}; PWl[idx] = v; if (d == 16) ((f32x2*)(ws + WS_A16))[zgn] = v; }
            for (int idx = tid; idx < 2 * 64 * 16; idx += 512) { const int z = idx >> 10, n = (idx >> 4) & 63, c = idx & 15; const int zgn = ((l * 2 + z) * 32 + g) * 64 + n;
                const float are = fminf(p.in[I_ARE][zgn], -1e-4f), aim = p.in[I_AIM][zgn]; const float dt = expf(p.in[I_LOGDT][zgn >> 6]);
                const double mag = exp((double)are * (double)dt); double sn, cs; sincos((double)aim * (double)dt, &sn, &cs);
                const float xr = (float)(mag * cs) - 1.0f, xi = (float)(mag * sn), den = 1.0f / (are * are + aim * aim);
                const float cr = (xr * are + xi * aim) * den, ci = (xi * are - xr * aim) * den;
                const float br = p.in[I_BRE][(size_t)zgn * 16 + c], bi = p.in[I_BIM][(size_t)zgn * 16 + c]; BBl[idx] = (f32x2){cr * br - ci * bi, cr * bi + ci * br}; }
            for (int idx = tid; idx < 2 * 16 * 64; idx += 512) { const int z = idx >> 10, cn = idx & 1023; const size_t src = ((size_t)((l * 2 + z) * 32 + g) * 16) * 64 + cn; Cl[idx] = (f32x2){p.in[I_CRE][src], p.in[I_CIM][src]}; }
            __syncthreads();
            { const int z = tid >> 8, d = (tid >> 4) & 15, c = tid & 15; float a16[16];
#pragma unroll
              for (int q = 0; q < 16; ++q) a16[q] = 0.f;
              for (int n = 0; n < 64; ++n) { const f32x2 pw = PWl[(z * 64 + n) * 17 + d], cm = Cl[(z * 16 + c) * 64 + n]; const float tr = cm.x * pw.x - cm.y * pw.y, ti = cm.x * pw.y + cm.y * pw.x;
#pragma unroll
                  for (int q = 0; q < 16; ++q) { const f32x2 bb = BBl[(z * 64 + n) * 16 + q]; a16[q] += tr * bb.x - ti * bb.y; } }
#pragma unroll
              for (int q = 0; q < 16; ++q) KZl[((z * 16 + d) * 16 + c) * 16 + q] = a16[q]; }
            __syncthreads();
            bf16_t* WST = (bf16_t*)(ws + WS_WST) + (size_t)lg * 256 * 256; bf16_t* G2B = (bf16_t*)(ws + WS_G2B) + (size_t)lg * 256 * 512;
            for (int i = 0; i < 16; ++i) { const int id = tid + 512 * i;
                {
                  const int c8 = (id & 1) * 8, pp = (id >> 1) & 15, row = id >> 5, z = row >> 7, ri = (row >> 6) & 1, n = row & 63;
                  const f32x2 pw = PWl[(z * 64 + n) * 17 + (z == 0 ? 15 - pp : pp)]; float f[8];
#pragma unroll
                  for (int j = 0; j < 8; ++j) { const f32x2 bb = BBl[(z * 64 + n) * 16 + c8 + j]; f[j] = ri == 0 ? (pw.x * bb.x - pw.y * bb.y) : (pw.x * bb.y + pw.y * bb.x); }
                  u32x4 w; w.x = cvt_pk_bf16(f[0], f[1]); w.y = cvt_pk_bf16(f[2], f[3]); w.z = cvt_pk_bf16(f[4], f[5]); w.w = cvt_pk_bf16(f[6], f[7]);
                  *(u32x4*)(WST + (size_t)row * 256 + pp * 16 + c8) = w; }
                {
                  const int n8 = (id & 7) * 8, ri = (id >> 3) & 1, z = (id >> 4) & 1, row = id >> 5, pp = row >> 4, c = row & 15; float f[8];
#pragma unroll
                  for (int j = 0; j < 8; ++j) { const f32x2 pw = PWl[(z * 64 + n8 + j) * 17 + (z == 0 ? pp + 1 : 16 - pp)], cm = Cl[(z * 16 + c) * 64 + n8 + j]; f[j] = ri == 0 ? (cm.x * pw.x - cm.y * pw.y) : -(cm.x * pw.y + cm.y * pw.x); }
                  u32x4 w; w.x = cvt_pk_bf16(f[0], f[1]); w.y = cvt_pk_bf16(f[2], f[3]); w.z = cvt_pk_bf16(f[4], f[5]); w.w = cvt_pk_bf16(f[6], f[7]);
                  *(u32x4*)(G2B + (size_t)row * 512 + 256 + z * 128 + ri * 64 + n8) = w; }
                {
                  const int c8 = (id & 1) * 8, pq = (id >> 1) & 15, row = id >> 5, pp = row >> 4, c = row & 15; float f[8];
#pragma unroll
                  for (int j = 0; j < 8; ++j) { float v = 0.f; if (pq <= pp) v += KZl[((0 * 16 + (pp - pq)) * 16 + c) * 16 + c8 + j]; if (pq >= pp) v += KZl[((1 * 16 + (pq - pp)) * 16 + c) * 16 + c8 + j];
                      if (pq == pp && c8 + j == c) v += p.in[I_S5D][l * 512 + g * 16 + c]; f[j] = v; }
                  u32x4 w; w.x = cvt_pk_bf16(f[0], f[1]); w.y = cvt_pk_bf16(f[2], f[3]); w.z = cvt_pk_bf16(f[4], f[5]); w.w = cvt_pk_bf16(f[6], f[7]);
                  *(u32x4*)(G2B + (size_t)row * 512 + pq * 16 + c8) = w; } }
            __syncthreads();
        } else if (it < N_ADA_UNITS + N_S5T_UNITS + N_ROPE_UNITS) {
            const int idx = (it - N_ADA_UNITS - N_S5T_UNITS) * 512 + tid; const int pos = idx >> 4, f = idx & 15;
            const float invf = powf(10000.0f, -(float)f * 0.0625f); const float ang = (float)pos * invf;
            ((f32x2*)(ws + WS_ROPE))[idx] = (f32x2){cosf(ang), sinf(ang)};
        } else {
            int t = it - N_ADA_UNITS - N_S5T_UNITS - N_ROPE_UNITS;
            LAS float* tile = (LAS float*)lds;
            if (t < 2 * T_WIN) { const int l = t / T_WIN, r = t % T_WIN; const float* src = p.in[I_WIN] + (size_t)l * DM * INC; bf16_t* dst = (bf16_t*)(ws + WS_WTIN) + (size_t)l * INP * DM;
                if (r < 448) transpose_block(src, INC, (r / 14) * 64, (r % 14) * 256, dst, DM, 1, 0, tile); else { const int q = r - 448; transpose_tile(src, INC, (q / 3) * 64, 3584 + (q % 3) * 64, dst, DM, 1, 0, 0, tile); }
                continue; }
            t -= 2 * T_WIN;
            if (t < 2 * T_WOUT) { const int l = t / T_WOUT, r = t % T_WOUT; transpose_block(p.in[I_WOUT] + (size_t)l * DM * DM, DM, (r >> 3) * 64, (r & 7) * 256, (bf16_t*)(ws + WS_WTOUT) + (size_t)l * DM * DM, DM, 1, 0, tile); continue; }
            t -= 2 * T_WOUT;
            if (t < 2 * T_WUQ) { const int l = t / T_WUQ, r = t % T_WUQ; transpose_tile(p.in[I_WUQ] + (size_t)l * 384 * 768, 768, (r % 6) * 64, (r / 6) * 64, (bf16_t*)(ws + WS_WTUQ) + (size_t)l * 768 * 384, 384, 1, 0, 0, tile); continue; }
            t -= 2 * T_WUQ;
            if (t < 2 * T_WUKV) { const int l = t / T_WUKV, r = t % T_WUKV; transpose_tile(p.in[I_WUKV] + (size_t)l * 256 * 1024, 1024, (r % 4) * 64, (r / 4) * 64, (bf16_t*)(ws + WS_WTUKV) + (size_t)l * 1024 * 256, 256, 1, 0, 1, tile); continue; }
            t -= 2 * T_WUKV;
            if (t < 2 * T_WGLU) { const int l = t / T_WGLU, r = t % T_WGLU; transpose_tile(p.in[I_WGLU] + (size_t)l * 512 * 512, 512, (r % 8) * 64, (r / 8) * 64, (bf16_t*)(ws + WS_WTGLU) + (size_t)l * 512 * 512, 512, 1, 0, 0, tile); continue; }
        }
    }
}

__device__ __forceinline__ void rms_mod_store(const f32x4 (&x)[8], const float* g, const float* scale, const float* shift, bf16_t* orow, f32x4 (&y)[8], int lane) {
    float ss = 0.f;
#pragma unroll
    for (int j = 0; j < 8; ++j) ss += x[j][0] * x[j][0] + x[j][1] * x[j][1] + x[j][2] * x[j][2] + x[j][3] * x[j][3];
    ss = wave_sum(ss);
    const float rinv = rsqrtf(ss * (1.0f / DM) + EPS);
#pragma unroll
    for (int j = 0; j < 8; ++j) { const int c = j * 256 + lane * 4;
        const f32x4 gv = *(const f32x4*)(g + c), sc = *(const f32x4*)(scale + c), sh = *(const f32x4*)(shift + c);
        y[j] = x[j] * rinv * gv * (1.0f + sc) + sh;
        u32x2 w; w.x = cvt_pk_bf16(y[j][0], y[j][1]); w.y = cvt_pk_bf16(y[j][2], y[j][3]); *(u32x2*)(orow + c) = w; }
}

constexpr int N1_ROWITEMS = MT / 8, N1_KZ = 64, N1_WST = 1024, N1_INTER = 1024;
__device__ __forceinline__ void ph_norm1_tables(const Params& p) {
    const int tid = opaque_tid(), lane = tid & 63, wave = tid >> 6;
    unsigned char* ws = opaque_ptr(p.ws);
    const float* mod = (const float*)(ws + WS_MOD);
    for (int it = blockIdx.x; it < N1_ROWITEMS; it += gridDim.x) {
        {
            const int row = it * 8 + wave; const int rr = row < NLAT ? (row >> 11) : 4;
            const float* xr = row < NLAT ? p.in[I_X] + (size_t)row * DM : p.in[I_CTX] + (size_t)(row - NLAT) * DM;
            f32x4 x[8], y[8];
#pragma unroll
            for (int j = 0; j < 8; ++j) x[j] = *(const f32x4*)(xr + j * 256 + lane * 4);
            const float* m = mod + (size_t)rr * 12288;
            rms_mod_store(x, p.in[I_N1G], m + DM, m, (bf16_t*)(ws + WS_H) + (size_t)row * DM, y, lane);
        }
    }
}

constexpr int B_ROWITEMS = MT / 8, B_SGU = 72 * 4, B_INTRA = 0;
__device__ __forceinline__ void ph_rowsplit(const Params& p, int l, LAS unsigned char* lds) {
    const int tid = opaque_tid(), lane = tid & 63, wave = tid >> 6;
    unsigned char* ws = opaque_ptr(p.ws);
    const bf16_t* P = (const bf16_t*)(ws + WS_PA);
    bf16_t* CAT = (bf16_t*)(ws + WS_CAT);
    const int nsgu = (l == 0) ? B_SGU : 256;
    const int G_ = (int)gridDim.x, c_ = (int)blockIdx.x, nx = nsgu > G_ ? nsgu - G_ : 0;
    const bool bal = nx > 0 && nx < G_ && nsgu <= 2 * G_;
    const int nfew = bal ? 2 * nx : 0;
    const int nmine = (c_ < nsgu ? 1 : 0) + (c_ < nx ? 1 : 0);
    int rit = bal ? (c_ < nx ? c_ : nfew + (c_ - nx)) : c_; const int rstride = bal ? (c_ < nx ? nx : G_ - nx) : G_; const int rend = bal ? (c_ < nx ? nfew : B_ROWITEMS) : B_ROWITEMS;
    for (int k = 0; ; ++k) {
        int it;
        if (k < nmine) it = B_ROWITEMS + c_ + k * G_;
        else { if (rit >= rend) break; it = rit; rit += rstride; }
        if (it < B_ROWITEMS) {
            const int row = it * 8 + wave; const bf16_t* pr = P + (size_t)row * INP;
            const bool lat = row < NLAT; const int t = lat ? (row & (SEQ - 1)) : ((row - NLAT) & (CTX - 1)); const int b = lat ? (row >> 11) : ((row - NLAT) >> 8);
            const int seqlen = lat ? SEQ : CTX;
            { float f[8]; float ss = 0.f;
              if (lane < 48) { const u32x4 v = *(const u32x4*)(pr + C_CQ + lane * 8); f[0] = bflo(v.x); f[1] = bfhi(v.x); f[2] = bflo(v.y); f[3] = bfhi(v.y); f[4] = bflo(v.z); f[5] = bfhi(v.z); f[6] = bflo(v.w); f[7] = bfhi(v.w);
#pragma unroll
                  for (int j = 0; j < 8; ++j) ss += f[j] * f[j]; }
              else {
#pragma unroll
                  for (int j = 0; j < 8; ++j) f[j] = 0.f; }
              ss = wave_sum(ss); const float rinv = rsqrtf(ss * (1.0f / 384.0f) + EPS);
              if (lane < 48) { const float* g = p.in[I_QNG] + l * 384 + lane * 8; u32x4 w;
                  w.x = cvt_pk_bf16(f[0] * rinv * g[0], f[1] * rinv * g[1]); w.y = cvt_pk_bf16(f[2] * rinv * g[2], f[3] * rinv * g[3]);
                  w.z = cvt_pk_bf16(f[4] * rinv * g[4], f[5] * rinv * g[5]); w.w = cvt_pk_bf16(f[6] * rinv * g[6], f[7] * rinv * g[7]);
                  *(u32x4*)((bf16_t*)(ws + WS_QA) + (size_t)row * 384 + lane * 8) = w; } }
            { const u32x2 v = *(const u32x2*)(pr + C_CKV + lane * 4); const float f0 = bflo(v.x), f1 = bfhi(v.x), f2 = bflo(v.y), f3 = bfhi(v.y);
              const float ss = wave_sum(f0 * f0 + f1 * f1 + f2 * f2 + f3 * f3); const float rinv = rsqrtf(ss * (1.0f / 256.0f) + EPS);
              const float* g = p.in[I_KVNG] + l * 256 + lane * 4; u32x2 w; w.x = cvt_pk_bf16(f0 * rinv * g[0], f1 * rinv * g[1]); w.y = cvt_pk_bf16(f2 * rinv * g[2], f3 * rinv * g[3]);
              *(u32x2*)((bf16_t*)(ws + WS_KVA) + (size_t)row * 256 + lane * 4) = w; }
            { float v = bf2f(pr[C_KR + lane]); const float partner = __shfl_xor(v, 16);
              if (lat) { const int jj = lane & 31, fi = jj & 15; const int pos = lane >= 32 ? (t & 63) : (t >> 6);
                  const f32x2 r = ((const f32x2*)(ws + WS_ROPE))[pos * 16 + fi]; const float cs = r.x, sn = r.y;
                  v = jj < 16 ? (v * cs - partner * sn) : (v * cs + partner * sn); }
              const int key = lat ? CTX + t : t; const unsigned short o = f2bf(v);
              bf16_t* kc = (bf16_t*)(ws + WS_KC);
#pragma unroll
              for (int h = 0; h < 4; ++h) kc[((size_t)(b * 4 + h) * NKEY + key) * 192 + 128 + lane] = o; }
            { const u32x4 v = *(const u32x4*)(pr + C_S5 + lane * 8); const int g = lane >> 1, half = lane & 1;
              *(u32x4*)((bf16_t*)(ws + WS_UPK) + ((size_t)g * 768 + (row >> 4)) * 512 + (row & 15) * 16 + half * 8) = v; }
            { const int c0 = lane * 8; float zp[8], zc[8], zn[8];
#pragma unroll
              for (int j = 0; j < 8; ++j) { zp[j] = 0.f; zn[j] = 0.f; }
#define CONV_Z(dst, rp) do { const u32x4 a_ = *(const u32x4*)((rp) + C_CVC + c0); const u32x4 h_ = *(const u32x4*)((rp) + C_CVH + c0); \
                  dst[0] = bflo(a_.x) * bflo(h_.x); dst[1] = bfhi(a_.x) * bfhi(h_.x); dst[2] = bflo(a_.y) * bflo(h_.y); dst[3] = bfhi(a_.y) * bfhi(h_.y); \
                  dst[4] = bflo(a_.z) * bflo(h_.z); dst[5] = bfhi(a_.z) * bfhi(h_.z); dst[6] = bflo(a_.w) * bflo(h_.w); dst[7] = bfhi(a_.w) * bfhi(h_.w); } while (0)
              CONV_Z(zc, pr);
              if (t > 0) CONV_Z(zp, pr - INP);
              if (t < seqlen - 1) CONV_Z(zn, pr + INP);
#undef CONV_Z
              const u32x4 bg = *(const u32x4*)(pr + C_CVB + c0); float bgf[8] = {bflo(bg.x), bfhi(bg.x), bflo(bg.y), bfhi(bg.y), bflo(bg.z), bfhi(bg.z), bflo(bg.w), bfhi(bg.w)};
              const float* cw = p.in[I_CONVW] + (size_t)l * 3 * 512 + c0; float o[8];
#pragma unroll
              for (int j = 0; j < 8; ++j) o[j] = bgf[j] * (cw[j] * zp[j] + cw[512 + j] * zc[j] + cw[1024 + j] * zn[j]);
              u32x4 w; w.x = cvt_pk_bf16(o[0], o[1]); w.y = cvt_pk_bf16(o[2], o[3]); w.z = cvt_pk_bf16(o[4], o[5]); w.w = cvt_pk_bf16(o[6], o[7]);
              *(u32x4*)(CAT + (size_t)row * DM + 1536 + c0) = w; }
        } else if (it < B_ROWITEMS + B_SGU) {
            const int un = it - B_ROWITEMS, cc = un >> 2, h = un & 3; const int row0 = cc * 128;
            LAS bf16_t* Wl = (LAS bf16_t*)lds;
            LAS bf16_t* Vl = (LAS bf16_t*)(lds + 128 * 136 * 2);
            const float* Wg = p.in[I_SGUW] + ((size_t)l * 4 + h) * 128 * 128;
#pragma unroll
            for (int i = 0; i < 8; ++i) { const int e4 = (i * 512 + tid) * 4, r = e4 >> 7, c = e4 & 127; const f32x4 v = *(const f32x4*)(Wg + e4);
                u32x2 w; w.x = cvt_pk_bf16(v[0], v[1]); w.y = cvt_pk_bf16(v[2], v[3]); *(LAS u32x2*)(Wl + r * 136 + c) = w; }
            u32x4 vv[16];
#pragma unroll
            for (int qi = 0; qi < 16; ++qi) vv[qi] = *(const u32x4*)(P + (size_t)(row0 + wave * 16 + qi) * INP + C_SGU_V + lane * 8);
#pragma unroll
            for (int qi = 0; qi < 16; ++qi) { const int q = wave * 16 + qi;
                const u32x4 v = vv[qi]; float f[8] = {bflo(v.x), bfhi(v.x), bflo(v.y), bfhi(v.y), bflo(v.z), bfhi(v.z), bflo(v.w), bfhi(v.w)}; float ss = 0.f;
#pragma unroll
                for (int j = 0; j < 8; ++j) { f[j] = gelu_tanh(f[j]); ss += f[j] * f[j]; }
                ss = wave_sum(ss); const float rinv = rsqrtf(ss * (1.0f / 512.0f) + EPS);
                if ((lane >> 4) == h) { const int c0 = (lane & 15) * 8; const float* g = p.in[I_SGUNG] + l * 512 + h * 128 + c0;
#pragma unroll
                    for (int j = 0; j < 8; ++j) Vl[(c0 + j) * 136 + q] = f2bf(f[j] * rinv * g[j]); } }
            __syncthreads();
            { const int fr = lane & 15, fq = lane >> 4; f32x4 acc[8];
#pragma unroll
              for (int nb = 0; nb < 8; ++nb) acc[nb] = (f32x4){0.f, 0.f, 0.f, 0.f};
#pragma unroll
              for (int ks = 0; ks < 4; ++ks) { const bf16x8 af = *(const LAS bf16x8*)(Wl + (wave * 16 + fr) * 136 + ks * 32 + fq * 8);
#pragma unroll
                  for (int nb = 0; nb < 8; ++nb) { const bf16x8 bfr = *(const LAS bf16x8*)(Vl + (nb * 16 + fr) * 136 + ks * 32 + fq * 8);
                      acc[nb] = __builtin_amdgcn_mfma_f32_16x16x32_bf16(bfr, af, acc[nb], 0, 0, 0); } }
              const int pp = wave * 16 + fr; const float bias = p.in[I_SGUB][((size_t)l * 4 + h) * 128 + pp]; const bf16_t* pr = P + (size_t)(row0 + pp) * INP + C_SGU_U + h * 128;
#pragma unroll
              for (int nb = 0; nb < 8; ++nb) { const int c = nb * 16 + 4 * fq; const u32x2 uv = *(const u32x2*)(pr + c);
                  u32x2 w; w.x = cvt_pk_bf16(gelu_tanh(bflo(uv.x)) * (acc[nb][0] + bias), gelu_tanh(bfhi(uv.x)) * (acc[nb][1] + bias));
                  w.y = cvt_pk_bf16(gelu_tanh(bflo(uv.y)) * (acc[nb][2] + bias), gelu_tanh(bfhi(uv.y)) * (acc[nb][3] + bias));
                  *(u32x2*)(CAT + (size_t)(row0 + pp) * DM + h * 128 + c) = w; } }
            __syncthreads();
        }
    }
}

constexpr int KPITCH = 400, VPITCH = 144;
constexpr int KT_BYTES = 64 * KPITCH, VT_BYTES = 128 * VPITCH;
__device__ __forceinline__ void attn_unit(const bf16_t* Qrows  , const bf16_t* Kbh, const bf16_t* Vbh, int nkeys, bf16_t* Orows, LAS unsigned char* lds) {
    const int tid = opaque_tid(), lane = tid & 63, wave = tid >> 6, l32 = lane & 31, hi = lane >> 5, qg = wave & 3, kh = wave >> 2;
    constexpr int VRING = 3 * KT_BYTES;
    bf16x8 qf[12];
    { const bf16_t* qr = Qrows + (size_t)(qg * 32 + l32) * 768 + hi * 8;
#pragma unroll
      for (int ks = 0; ks < 12; ++ks) qf[ks] = *(const bf16x8*)(qr + ks * 16); }
    f32x16 o[4];
#pragma unroll
    for (int db = 0; db < 4; ++db)
#pragma unroll
        for (int r = 0; r < 16; ++r) o[db][r] = 0.f;
    float mrow = -1e30f, lsum = 0.f;
    const int nt = nkeys / 64;
    const int wv = __builtin_amdgcn_readfirstlane(wave);
    unsigned doffK[4], doffV[3];
#pragma unroll
    for (int i = 0; i < 4; ++i) { const int pc = (wv + 8 * i) < 25 ? (wv + 8 * i) : 24; const int X = pc * 1024 + lane * 16, row = X / KPITCH, col = X % KPITCH; doffK[i] = (unsigned)(row * 384 + (col < 384 ? col : 0)); }
#pragma unroll
    for (int i = 0; i < 3; ++i) { const int pc = (wv + 8 * i) < 18 ? (wv + 8 * i) : 17; const int Y = pc * 1024 + lane * 16, row = Y / VPITCH, col = Y % VPITCH; doffV[i] = (unsigned)(row * (NKEY * 2) + (col < 128 ? col : 0)); }
#define ATT_DMAK(tile, slot) do { _Pragma("unroll") for (int i = 0; i < 4; ++i) { const int pc = (wv + 8 * i) < 25 ? (wv + 8 * i) : 24; \
        __builtin_amdgcn_global_load_lds((const unsigned*)((const char*)Kbh + (size_t)(tile) * (64 * 384) + doffK[i]), (LAS unsigned*)(lds + (slot) * KT_BYTES + pc * 1024), 16, 0, 0); } } while (0)
#define ATT_DMAV(tile, slot) do { _Pragma("unroll") for (int i = 0; i < 3; ++i) { const int pc = (wv + 8 * i) < 18 ? (wv + 8 * i) : 17; \
        __builtin_amdgcn_global_load_lds((const unsigned*)((const char*)Vbh + (size_t)(tile) * 128 + doffV[i]), (LAS unsigned*)(lds + VRING + (slot) * VT_BYTES + pc * 1024), 16, 0, 0); } } while (0)
#define ATT_STEP(S, SN, QK, ks_, vs_) do { \
        float mx = S[0]; \
        _Pragma("unroll") for (int r = 1; r < 16; ++r) mx = fmaxf(mx, S[r]); \
        mx = fmaxf(mx, __shfl_xor(mx, 32)); \
        if (__any(mx > mrow + 8.0f)) { const float mnew = fmaxf(mrow, mx), alpha = __builtin_amdgcn_exp2f(mrow - mnew); mrow = mnew; lsum *= alpha; \
            _Pragma("unroll") for (int db = 0; db < 4; ++db) _Pragma("unroll") for (int r = 0; r < 16; ++r) o[db][r] *= alpha; } \
        __builtin_amdgcn_sched_barrier(0); \
        const LAS unsigned char* Vcur = lds + VRING + (vs_) * VT_BYTES; \
        u32x4 vf0[4], vf1[4]; \
        float ps = 0.f; u32x4 pw0, pw1; \
        if (QK) { const LAS unsigned char* kp = lds + (ks_) * KT_BYTES + (kh * 32 + l32) * KPITCH + hi * 16; \
            bf16x8 kf[12]; \
            _Pragma("unroll") for (int i = 0; i < 12; ++i) kf[i] = *(const LAS bf16x8*)(kp + i * 32); \
            _Pragma("unroll") for (int r = 0; r < 16; ++r) SN[r] = 0.f; \
            __builtin_amdgcn_sched_barrier(0); \
              \
            _Pragma("unroll") for (int i = 0; i < 12; ++i) { \
                SN = __builtin_amdgcn_mfma_f32_32x32x16_bf16(kf[i], qf[i], SN, 0, 0, 0); \
                S[i] = __builtin_amdgcn_exp2f(S[i] - mrow); ps += S[i]; \
                if (i < 4) { S[12 + i] = __builtin_amdgcn_exp2f(S[12 + i] - mrow); ps += S[12 + i]; } \
                if (i == 1) pw0.x = cvt_pk_bf16(S[0], S[1]); if (i == 3) { pw0.y = cvt_pk_bf16(S[2], S[3]); pw1.z = cvt_pk_bf16(S[12], S[13]); pw1.w = cvt_pk_bf16(S[14], S[15]); } \
                if (i == 5) pw0.z = cvt_pk_bf16(S[4], S[5]); if (i == 7) pw0.w = cvt_pk_bf16(S[6], S[7]); if (i == 9) pw1.x = cvt_pk_bf16(S[8], S[9]); if (i == 11) pw1.y = cvt_pk_bf16(S[10], S[11]); \
                if (i >= 8) { const int db = i - 8; const LAS unsigned char* vp = Vcur + (db * 32 + l32) * VPITCH + kh * 64 + hi * 16; \
                    vf0[db] = *(const LAS u32x4*)vp; vf1[db] = *(const LAS u32x4*)(vp + 32); } \
                __builtin_amdgcn_sched_barrier(0); } \
        } else { \
            _Pragma("unroll") for (int db = 0; db < 4; ++db) { const LAS unsigned char* vp = Vcur + (db * 32 + l32) * VPITCH + kh * 64 + hi * 16; \
                vf0[db] = *(const LAS u32x4*)vp; vf1[db] = *(const LAS u32x4*)(vp + 32); } \
            _Pragma("unroll") for (int r = 0; r < 16; ++r) { S[r] = __builtin_amdgcn_exp2f(S[r] - mrow); ps += S[r]; } \
            pw0.x = cvt_pk_bf16(S[0], S[1]); pw0.y = cvt_pk_bf16(S[2], S[3]); pw0.z = cvt_pk_bf16(S[4], S[5]); pw0.w = cvt_pk_bf16(S[6], S[7]); \
            pw1.x = cvt_pk_bf16(S[8], S[9]); pw1.y = cvt_pk_bf16(S[10], S[11]); pw1.z = cvt_pk_bf16(S[12], S[13]); pw1.w = cvt_pk_bf16(S[14], S[15]); } \
        lsum += ps; \
        { const bf16x8 pf = __builtin_bit_cast(bf16x8, pw0); \
          _Pragma("unroll") for (int db = 0; db < 4; ++db) o[db] = __builtin_amdgcn_mfma_f32_32x32x16_bf16(__builtin_bit_cast(bf16x8, vf0[db]), pf, o[db], 0, 0, 0); } \
        { const bf16x8 pf = __builtin_bit_cast(bf16x8, pw1); \
          _Pragma("unroll") for (int db = 0; db < 4; ++db) o[db] = __builtin_amdgcn_mfma_f32_32x32x16_bf16(__builtin_bit_cast(bf16x8, vf1[db]), pf, o[db], 0, 0, 0); } \
        __builtin_amdgcn_sched_barrier(0); } while (0)
#define ATT_SYNC(full) do { if (full) asm volatile("s_waitcnt vmcnt(7)" ::: "memory"); else asm volatile("s_waitcnt vmcnt(0)" ::: "memory"); \
        __builtin_amdgcn_s_barrier(); asm volatile("" ::: "memory"); } while (0)
    ATT_DMAK(0, 0); ATT_DMAV(0, 0); ATT_DMAK(1, 1); ATT_DMAV(1, 1); if (nt > 2) ATT_DMAK(2, 2);
    asm volatile("s_waitcnt vmcnt(0)" ::: "memory");
    __builtin_amdgcn_s_barrier(); asm volatile("" ::: "memory");
    f32x16 sA, sB;
    { const LAS unsigned char* kp = lds + (kh * 32 + l32) * KPITCH + hi * 16;
#pragma unroll
      for (int r = 0; r < 16; ++r) sA[r] = 0.f;
#pragma unroll
      for (int i = 0; i < 12; ++i) { const bf16x8 kf = *(const LAS bf16x8*)(kp + i * 32); sA = __builtin_amdgcn_mfma_f32_32x32x16_bf16(kf, qf[i], sA, 0, 0, 0); } }
    int k1 = 1, v0 = 0;
    int j = 0;
    for (; j + 2 < nt; j += 2) {
        ATT_SYNC(true);
        if (j + 3 < nt) ATT_DMAK(j + 3, v0);
        ATT_DMAV(j + 2, v0 == 0 ? 2 : v0 - 1);
        ATT_STEP(sA, sB, true, k1, v0);
        k1 = k1 == 2 ? 0 : k1 + 1; v0 = v0 == 2 ? 0 : v0 + 1;
        ATT_SYNC(j + 3 < nt);
        if (j + 4 < nt) ATT_DMAK(j + 4, v0);
        if (j + 3 < nt) ATT_DMAV(j + 3, v0 == 0 ? 2 : v0 - 1);
        ATT_STEP(sB, sA, true, k1, v0);
        k1 = k1 == 2 ? 0 : k1 + 1; v0 = v0 == 2 ? 0 : v0 + 1;
    }
    ATT_SYNC(false);
    ATT_STEP(sA, sB, true, k1, v0);
    k1 = k1 == 2 ? 0 : k1 + 1; v0 = v0 == 2 ? 0 : v0 + 1;
    ATT_SYNC(false);
    ATT_STEP(sB, sA, false, k1, v0);
#undef ATT_STEP
#undef ATT_SYNC
#undef ATT_DMAK
#undef ATT_DMAV
    __syncthreads();
    lsum += __shfl_xor(lsum, 32);
    LAS float* mb = (LAS float*)lds + (size_t)qg * 66 * 64 + lane;
    if (kh == 1) {
#pragma unroll
        for (int db = 0; db < 4; ++db)
#pragma unroll
            for (int r = 0; r < 16; ++r) mb[(db * 16 + r) * 64] = o[db][r];
        mb[64 * 64] = mrow; mb[65 * 64] = lsum;
    }
    __syncthreads();
    if (kh == 0) {
        const float m1 = mb[64 * 64], l1 = mb[65 * 64];
        const float m = fmaxf(mrow, m1), e0 = __builtin_amdgcn_exp2f(mrow - m), e1 = __builtin_amdgcn_exp2f(m1 - m);
        const float inv = 1.0f / (lsum * e0 + l1 * e1), c0 = e0 * inv, c1 = e1 * inv;
        bf16_t* orow = Orows + (size_t)(qg * 32 + l32) * DM;
#pragma unroll
        for (int db = 0; db < 4; ++db)
#pragma unroll
            for (int k4 = 0; k4 < 4; ++k4) { float v[4];
#pragma unroll
                for (int i = 0; i < 4; ++i) v[i] = o[db][4 * k4 + i] * c0 + mb[(db * 16 + 4 * k4 + i) * 64] * c1;
                u32x2 w; w.x = cvt_pk_bf16(v[0], v[1]); w.y = cvt_pk_bf16(v[2], v[3]);
                *(u32x2*)(orow + db * 32 + 8 * k4 + 4 * hi) = w; }
    }
    __syncthreads();
}
__device__ __forceinline__ void ph_attn_carry(const Params& p, int l, LAS unsigned char* lds) {
    unsigned char* ws = opaque_ptr(p.ws); const int tid = opaque_tid();
    const int natt = (l == 0) ? 288 : 256;
    const bf16_t* QB = (const bf16_t*)(ws + WS_QB); const bf16_t* KC = (const bf16_t*)(ws + WS_KC); const bf16_t* VT = (const bf16_t*)(ws + WS_VT); bf16_t* CAT = (bf16_t*)(ws + WS_CAT);
    for (int it = blockIdx.x; it < natt; it += gridDim.x) {
        {
            int b, h, row0, nkeys;
            if (it < 256) { const int x = it & 7, jj = it >> 3, bh = 2 * x + (jj >> 4); b = bh >> 2; h = bh & 3; row0 = b * SEQ + (jj & 15) * 128; nkeys = NKEY; }
            else { const int u = it - 256; b = u >> 3; h = (u >> 1) & 3; row0 = NLAT + b * CTX + (u & 1) * 128; nkeys = CTX; }
            attn_unit(QB + (size_t)row0 * 768 + h * 192, KC + (size_t)(b * 4 + h) * NKEY * 192, VT + (size_t)(b * 4 + h) * 128 * NKEY, nkeys, CAT + (size_t)row0 * DM + 512 + h * 128, lds);
        }
    }
    for (int it = natt + (int)((blockIdx.x + gridDim.x - natt % gridDim.x) % gridDim.x); it < natt + 256; it += gridDim.x) {
        {
            const int u = it - natt; const int z = u >> 7, b = (u >> 5) & 3, g = u & 31, lane = tid & 63, w = tid >> 6;
            const f32x2 a16 = ((const f32x2*)(ws + WS_A16))[(((size_t)l * 2 + z) * 32 + g) * 64 + lane];
            const float* EST = (const float*)(ws + WS_EST) + (size_t)g * 768 * 256 + z * 128 + lane;
            bf16_t* UP = (bf16_t*)(ws + WS_UPK) + (size_t)g * 768 * 512 + 256 + z * 128 + lane;
            LAS f32x2* seg = (LAS f32x2*)lds;
            float er[18], ei[18];
#pragma unroll
            for (int i = 0; i < 18; ++i) { const int st = w * 18 + i; int chunk;
                if (z == 0) chunk = st < 16 ? (512 + b * 16 + st) : (b * 128 + (st - 16)); else chunk = st < 16 ? (512 + b * 16 + (15 - st)) : (b * 128 + (143 - st));
                er[i] = EST[(size_t)chunk * 256]; ei[i] = EST[(size_t)chunk * 256 + 64]; }
            float sr = 0.f, si = 0.f;
#pragma unroll
            for (int i = 0; i < 18; ++i) { const float nr = a16.x * sr - a16.y * si + er[i], ni = a16.x * si + a16.y * sr + ei[i]; sr = nr; si = ni; }
            seg[w * 64 + lane] = (f32x2){sr, si};
            float pr = 1.f, pi = 0.f;
#pragma unroll
            for (int i = 0; i < 18; ++i) { const float nr = pr * a16.x - pi * a16.y, ni = pr * a16.y + pi * a16.x; pr = nr; pi = ni; }
            __syncthreads();
            sr = 0.f; si = 0.f;
            for (int w2 = 0; w2 < w; ++w2) { const f32x2 sv = seg[w2 * 64 + lane]; const float nr = pr * sr - pi * si + sv.x, ni = pr * si + pi * sr + sv.y; sr = nr; si = ni; }
#pragma unroll
            for (int i = 0; i < 18; ++i) { const int st = w * 18 + i; int chunk;
                if (z == 0) chunk = st < 16 ? (512 + b * 16 + st) : (b * 128 + (st - 16)); else chunk = st < 16 ? (512 + b * 16 + (15 - st)) : (b * 128 + (143 - st));
                UP[(size_t)chunk * 512] = f2bf(sr); UP[(size_t)chunk * 512 + 64] = f2bf(si);
                const float nr = a16.x * sr - a16.y * si + er[i], ni = a16.x * si + a16.y * sr + ei[i]; sr = nr; si = ni; }
            __syncthreads();
        }
    }
}

__device__ __forceinline__ void ph_norm2_router(const Params& p, int l, LAS unsigned char* lds) {
    const int tid = opaque_tid(), lane = tid & 63, wave = tid >> 6;
    unsigned char* ws = opaque_ptr(p.ws); const float* mod = (const float*)(ws + WS_MOD) + (size_t)l * 5 * 12288;
    const int nrows = (l == 0) ? MT : NLAT;
    const float* WR = p.in[I_WROUTER] + (size_t)l * DM * NE;
    for (int idx = tid; idx < DM * 4; idx += 512) { const int c = idx & (DM - 1), e4 = idx >> 11; const f32x4 v = *(const f32x4*)(WR + (size_t)c * NE + e4 * 4);
        *(LAS f32x4*)(lds + (size_t)(((e4 * 8 + (c & 7)) * 256 + (c >> 3)) * 16)) = v; }
    __syncthreads();
    const float* n2g = p.in[I_N2G] + l * DM;
    for (int it = blockIdx.x; it < nrows / 8; it += gridDim.x) {
        const int row = it * 8 + wave; const int rr = row < NLAT ? (row >> 11) : 4;
        const bf16_t* xr = (const bf16_t*)(ws + WS_XB) + (size_t)row * DM + lane * 8;
        const float* m = mod + (size_t)rr * 12288 + lane * 8; const float* gp = n2g + lane * 8;
        u32x4 xv[4];
#pragma unroll
        for (int j = 0; j < 4; ++j) xv[j] = *(const u32x4*)(xr + j * 512);
        float x[4][8]; float ss = 0.f;
#pragma unroll
        for (int j = 0; j < 4; ++j) { x[j][0] = bflo(xv[j].x); x[j][1] = bfhi(xv[j].x); x[j][2] = bflo(xv[j].y); x[j][3] = bfhi(xv[j].y); x[j][4] = bflo(xv[j].z); x[j][5] = bfhi(xv[j].z); x[j][6] = bflo(xv[j].w); x[j][7] = bfhi(xv[j].w);
#pragma unroll
            for (int i = 0; i < 8; ++i) ss += x[j][i] * x[j][i]; }
        ss = wave_sum(ss); const float rinv = rsqrtf(ss * (1.0f / DM) + EPS);
        bf16_t* orow = (bf16_t*)(ws + WS_H) + (size_t)row * DM + lane * 8;
        f32x4 lg[4];
#pragma unroll
        for (int e4 = 0; e4 < 4; ++e4) lg[e4] = (f32x4){0.f, 0.f, 0.f, 0.f};
#pragma unroll
        for (int j = 0; j < 4; ++j) {
            const f32x4 ga = *(const f32x4*)(gp + j * 512), gb = *(const f32x4*)(gp + j * 512 + 4), sa = *(const f32x4*)(m + 4 * DM + j * 512), sb = *(const f32x4*)(m + 4 * DM + j * 512 + 4),
                        ha = *(const f32x4*)(m + 3 * DM + j * 512), hb = *(const f32x4*)(m + 3 * DM + j * 512 + 4);
            float y[8];
#pragma unroll
            for (int i = 0; i < 8; ++i) y[i] = x[j][i] * rinv * (i < 4 ? ga[i] : gb[i - 4]) * (1.0f + (i < 4 ? sa[i] : sb[i - 4])) + (i < 4 ? ha[i] : hb[i - 4]);
            u32x4 h; h.x = cvt_pk_bf16(y[0], y[1]); h.y = cvt_pk_bf16(y[2], y[3]); h.z = cvt_pk_bf16(y[4], y[5]); h.w = cvt_pk_bf16(y[6], y[7]);
            *(u32x4*)(orow + j * 512) = h;
#pragma unroll
            for (int i2 = 0; i2 < 8; i2 += 2) {
#pragma unroll
                for (int e4 = 0; e4 < 4; ++e4) { const f32x4 w0 = *(const LAS f32x4*)(lds + (size_t)(((e4 * 8 + i2) * 256 + j * 64 + lane) * 16)); const f32x4 w1 = *(const LAS f32x4*)(lds + (size_t)(((e4 * 8 + i2 + 1) * 256 + j * 64 + lane) * 16));
                    lg[e4] += y[i2] * w0 + y[i2 + 1] * w1; }
                __builtin_amdgcn_sched_barrier(0); } }
        float v8[8], v4[4], v2[2], v1;
#pragma unroll
        for (int e = 0; e < 8; ++e) { const float lo = lg[e >> 2][e & 3], hi_ = lg[(e + 8) >> 2][e & 3]; const float snd = (lane & 32) ? lo : hi_, kp = (lane & 32) ? hi_ : lo; v8[e] = kp + __shfl_xor(snd, 32); }
#pragma unroll
        for (int e = 0; e < 4; ++e) { const float snd = (lane & 16) ? v8[e] : v8[e + 4], kp = (lane & 16) ? v8[e + 4] : v8[e]; v4[e] = kp + __shfl_xor(snd, 16); }
#pragma unroll
        for (int e = 0; e < 2; ++e) { const float snd = (lane & 8) ? v4[e] : v4[e + 2], kp = (lane & 8) ? v4[e + 2] : v4[e]; v2[e] = kp + __shfl_xor(snd, 8); }
        { const float snd = (lane & 4) ? v2[0] : v2[1], kp = (lane & 4) ? v2[1] : v2[0]; v1 = kp + __shfl_xor(snd, 4); }
        v1 += __shfl_xor(v1, 1); v1 += __shfl_xor(v1, 2);
        float mx = v1; mx = fmaxf(mx, __shfl_xor(mx, 4)); mx = fmaxf(mx, __shfl_xor(mx, 8)); mx = fmaxf(mx, __shfl_xor(mx, 16)); mx = fmaxf(mx, __shfl_xor(mx, 32));
        const float ex = __expf(v1 - mx); float se = ex; se += __shfl_xor(se, 4); se += __shfl_xor(se, 8); se += __shfl_xor(se, 16); se += __shfl_xor(se, 32);
        if ((lane & 3) == 0) ((float*)(ws + WS_AFF))[(size_t)row * 16 + (lane >> 2)] = ex / se;
    }
}

__device__ __forceinline__ void ph_topk(const Params& p, int l, LAS unsigned char* lds) {
    const int tid = opaque_tid(), lane = tid & 63, wave = tid >> 6;
    unsigned char* ws = opaque_ptr(p.ws); const float* AFF = (const float*)(ws + WS_AFF);
    int* ROWTOK = (int*)(ws + WS_ROWTOK); float* ROWAFF = (float*)(ws + WS_ROWAFF); int* INV = (int*)(ws + WS_INV);
    LAS int* hist = (LAS int*)lds;
    LAS int* ctl = (LAS int*)(lds + 1024);
    LAS int* wsum = (LAS int*)(lds + 1280);
    const int nunits = (l == 0) ? 128 : 64;
    for (int it = blockIdx.x; it < nunits; it += gridDim.x) {
        const bool lat = it < 64; const int u = lat ? it : it - 64; const int b = u >> 4, e = u & 15;
        const int n = lat ? SEQ : CTX, cap = lat ? CAPL : CAPC;
        const int tok0 = lat ? b * SEQ : NLAT + b * CTX; const int rowbase = lat ? b * CAPL : 1024 + b * CAPC;
        unsigned key[4];
#pragma unroll
        for (int j = 0; j < 4; ++j) { const int t = tid * 4 + j; key[j] = t < n ? __float_as_uint(AFF[(size_t)(tok0 + t) * 16 + e]) : 0u; }
        unsigned prefix = 0u; int remaining = cap;
        for (int pass = 3; pass >= 0; --pass) {
            if (tid < 256) hist[tid] = 0;
            __syncthreads();
#pragma unroll
            for (int j = 0; j < 4; ++j) { const int t = tid * 4 + j; if (t < n) { const bool match = (pass == 3) || ((key[j] >> (8 * (pass + 1))) == (prefix >> (8 * (pass + 1)))); if (match) atomicAdd((int*)&hist[(key[j] >> (8 * pass)) & 255u], 1); } }
            __syncthreads();
            if (wave == 0) {
                const int b0 = hist[4 * lane], b1 = hist[4 * lane + 1], b2 = hist[4 * lane + 2], b3 = hist[4 * lane + 3];
                const int s = b0 + b1 + b2 + b3; int suf = s;
#pragma unroll
                for (int off = 1; off < 64; off <<= 1) { const int t = __shfl_down(suf, off); if (lane + off < 64) suf += t; }
                const int above = suf - s; const int c3 = above + b3, c2 = c3 + b2, c1 = c2 + b1, c0 = c1 + b0;
                if (above < remaining && c0 >= remaining) { int dg, nr;
                    if (c3 >= remaining) { dg = 4 * lane + 3; nr = remaining - above; } else if (c2 >= remaining) { dg = 4 * lane + 2; nr = remaining - c3; }
                    else if (c1 >= remaining) { dg = 4 * lane + 1; nr = remaining - c2; } else { dg = 4 * lane; nr = remaining - c1; }
                    ctl[0] = dg; ctl[1] = nr; }
            }
            __syncthreads();
            prefix |= ((unsigned)ctl[0]) << (8 * pass); remaining = ctl[1];
            __syncthreads();
        }
        int cgt = 0, ceq = 0;
#pragma unroll
        for (int j = 0; j < 4; ++j) { const int t = tid * 4 + j; if (t < n) { cgt += key[j] > prefix ? 1 : 0; ceq += key[j] == prefix ? 1 : 0; } }
        const int packed = cgt | (ceq << 16);
        int inc = packed;
#pragma unroll
        for (int off = 1; off < 64; off <<= 1) { const int t = __shfl_up(inc, off); if (lane >= off) inc += t; }
        if (lane == 63) wsum[wave] = inc;
        __syncthreads();
        int base = 0;
#pragma unroll
        for (int w8 = 0; w8 < 8; ++w8) base += (w8 < wave) ? wsum[w8] : 0;
        int excl = base + inc - packed; int egt = excl & 0xffff, eeq = excl >> 16;
#pragma unroll
        for (int j = 0; j < 4; ++j) { const int t = tid * 4 + j; if (t < n) {
                const bool gt = key[j] > prefix, eq = key[j] == prefix; const bool sel = gt || (eq && eeq < remaining);
                const int slot = egt + (eeq < remaining ? eeq : remaining);
                if (sel) { ROWTOK[e * EROWS + rowbase + slot] = tok0 + t; ROWAFF[e * EROWS + rowbase + slot] = __uint_as_float(key[j]); }
                INV[(size_t)(tok0 + t) * 16 + e] = sel ? rowbase + slot : -1;
                egt += gt ? 1 : 0; eeq += eq ? 1 : 0; } }
        __syncthreads();
    }
}

__device__ __forceinline__ void ph_gather(const Params& p, int l) {
    const int tid = opaque_tid(), lane = tid & 63, wave = tid >> 6;
    unsigned char* ws = opaque_ptr(p.ws); const int* ROWTOK = (const int*)(ws + WS_ROWTOK);
    const int rows_per_e = (l == 0) ? 1152 : 1024;
    const int nitems = NE * rows_per_e / 8;
    for (int it = blockIdx.x; it < nitems; it += gridDim.x) {
        const int ridx = it * 8 + wave; const int e = ridx / rows_per_e, r = ridx % rows_per_e;
        const int tok = ROWTOK[e * EROWS + r];
        const u32x4* src = (const u32x4*)((const bf16_t*)(ws + WS_H) + (size_t)tok * DM); u32x4* dst = (u32x4*)((bf16_t*)(ws + WS_PA) + ((size_t)e * EROWS + r) * DM);
#pragma unroll
        for (int j = 0; j < 4; ++j) dst[j * 64 + lane] = src[j * 64 + lane];
    }
}

__device__ __forceinline__ void ph_combine(const Params& p, int l) {
    const int tid = opaque_tid(), lane = tid & 63, wave = tid >> 6;
    unsigned char* ws = opaque_ptr(p.ws); const float* mod = (const float*)(ws + WS_MOD);
    const int nrows = (l == 0) ? MT : NLAT;
    const int* INV = (const int*)(ws + WS_INV); const bf16_t* YS = (const bf16_t*)(ws + WS_YS);
#define M_UNPACK(dst, v) do { dst[0] = bflo(v.x); dst[1] = bfhi(v.x); dst[2] = bflo(v.y); dst[3] = bfhi(v.y); dst[4] = bflo(v.z); dst[5] = bfhi(v.z); dst[6] = bflo(v.w); dst[7] = bfhi(v.w); } while (0)
    for (int it = blockIdx.x; it < nrows / 8; it += gridDim.x) {
        const int row = it * 8 + wave; const int rr = row < NLAT ? (row >> 11) : 4;
        const bf16_t* xr = (const bf16_t*)(ws + WS_XB) + (size_t)row * DM + lane * 8;
        float x[4][8], s[4][8];
        u32x4 xv[4];
#pragma unroll
        for (int j = 0; j < 4; ++j) xv[j] = *(const u32x4*)(xr + j * 512);
        const int myinv = lane < 16 ? INV[(size_t)row * 16 + lane] : -1;
#pragma unroll
        for (int j = 0; j < 4; ++j) { M_UNPACK(x[j], xv[j]);
#pragma unroll
            for (int i = 0; i < 8; ++i) s[j][i] = 0.f; }
        unsigned msk = (unsigned)__ballot(myinv >= 0);
        while (msk) {
            const int e0 = __builtin_ctz(msk); msk &= msk - 1; const bool two = msk != 0u; const int e1 = two ? __builtin_ctz(msk) : e0; if (two) msk &= msk - 1;
            const int r0 = __shfl(myinv, e0), r1 = __shfl(myinv, e1);
            const bf16_t* y0 = YS + ((size_t)e0 * EROWS + r0) * DM + lane * 8; const bf16_t* y1 = YS + ((size_t)e1 * EROWS + r1) * DM + lane * 8;
            u32x4 v0[4], v1[4];
#pragma unroll
            for (int j = 0; j < 4; ++j) { v0[j] = *(const u32x4*)(y0 + j * 512); v1[j] = *(const u32x4*)(y1 + j * 512); }
            const float f1 = two ? 1.0f : 0.0f;
#pragma unroll
            for (int j = 0; j < 4; ++j) { float a[8], b[8]; M_UNPACK(a, v0[j]); M_UNPACK(b, v1[j]);
#pragma unroll
                for (int i = 0; i < 8; ++i) s[j][i] += a[i] + f1 * b[i]; }
        }
        const float* gate = mod + (size_t)(l * 5 + rr) * 12288 + 5 * DM + lane * 8;
        float ss = 0.f;
#pragma unroll
        for (int j = 0; j < 4; ++j) { const f32x4 g0 = *(const f32x4*)(gate + j * 512), g1 = *(const f32x4*)(gate + j * 512 + 4);
#pragma unroll
            for (int i = 0; i < 8; ++i) { x[j][i] += (i < 4 ? g0[i] : g1[i - 4]) * s[j][i]; ss += x[j][i] * x[j][i]; } }
        ss = wave_sum(ss); const float rinv = rsqrtf(ss * (1.0f / DM) + EPS);
        if (l == 0) {
            bf16_t* xo = (bf16_t*)(ws + WS_XA) + (size_t)row * DM + lane * 8; bf16_t* ho = (bf16_t*)(ws + WS_H) + (size_t)row * DM + lane * 8;
            const float* m = mod + (size_t)(5 + rr) * 12288 + lane * 8;
            const float* g = p.in[I_N1G] + DM + lane * 8;
#pragma unroll
            for (int j = 0; j < 4; ++j) {
                u32x4 w; w.x = cvt_pk_bf16(x[j][0], x[j][1]); w.y = cvt_pk_bf16(x[j][2], x[j][3]); w.z = cvt_pk_bf16(x[j][4], x[j][5]); w.w = cvt_pk_bf16(x[j][6], x[j][7]);
                *(u32x4*)(xo + j * 512) = w;
                const f32x4 ga = *(const f32x4*)(g + j * 512), gb = *(const f32x4*)(g + j * 512 + 4), sa = *(const f32x4*)(m + DM + j * 512), sb = *(const f32x4*)(m + DM + j * 512 + 4), ha = *(const f32x4*)(m + j * 512), hb = *(const f32x4*)(m + j * 512 + 4);
                float y[8];
#pragma unroll
                for (int i = 0; i < 8; ++i) y[i] = x[j][i] * rinv * (i < 4 ? ga[i] : gb[i - 4]) * (1.0f + (i < 4 ? sa[i] : sb[i - 4])) + (i < 4 ? ha[i] : hb[i - 4]);
                u32x4 h; h.x = cvt_pk_bf16(y[0], y[1]); h.y = cvt_pk_bf16(y[2], y[3]); h.z = cvt_pk_bf16(y[4], y[5]); h.w = cvt_pk_bf16(y[6], y[7]);
                *(u32x4*)(ho + j * 512) = h; }
        } else {
            float* orow = p.out + (size_t)row * DM + lane * 8; const float* g = p.in[I_FNG] + lane * 8;
#pragma unroll
            for (int j = 0; j < 4; ++j) { const f32x4 ga = *(const f32x4*)(g + j * 512), gb = *(const f32x4*)(g + j * 512 + 4);
                *(f32x4*)(orow + j * 512) = (f32x4){x[j][0] * rinv * ga[0], x[j][1] * rinv * ga[1], x[j][2] * rinv * ga[2], x[j][3] * rinv * ga[3]};
                *(f32x4*)(orow + j * 512 + 4) = (f32x4){x[j][4] * rinv * gb[0], x[j][5] * rinv * gb[1], x[j][6] * rinv * gb[2], x[j][7] * rinv * gb[3]}; }
        }
    }
#undef M_UNPACK
}

constexpr int NPH_LAYER = 13, NPH = 2 + 2 * NPH_LAYER;
__global__ void __launch_bounds__(512, 2) fwd(Params p) {
    extern __shared__ __attribute__((aligned(16))) unsigned char lds_raw[];
    LAS unsigned char* lds = (LAS unsigned char*)lds_raw;
    volatile LAS unsigned* MISC = (volatile LAS unsigned*)(lds + LDS_MISC);
    if (threadIdx.x < 16) MISC[threadIdx.x] = 0u;
    __syncthreads();
    unsigned char* ws = p.ws;
    const int lo = p.ph_lo, hi = p.ph_hi;
    XcdBarrier bar; bar.bar = (unsigned*)(ws + WS_CTL); bar.x = 0; bar.st = MISC;
    if (hi - lo > 1) bar = xcd_barrier_post((unsigned*)(ws + WS_CTL), MISC);
    const int G = gridDim.x, c = blockIdx.x;
#ifndef NCONV_A
#define NCONV_A 48
#endif
#ifndef NCONV_G
#define NCONV_G 48
#endif
#ifndef NCONV_K
#define NCONV_K 32
#endif
    const int nconv = (G == 256) ? 1 : 0;
    const int GgA = G - nconv * NCONV_A, GgG = G - nconv * NCONV_G, GgK = G - nconv * NCONV_K;
#ifndef ONLY_PH
#define ONLY_PH -1
#endif
#define PSEL(id) (ONLY_PH < 0 || ONLY_PH == (id))
#ifndef DUP
#define DUP 0
#endif
#define NREP(id) ((((DUP) >> (id)) & 1) ? 2 : 1)
#define REPLOOP(id) for (int rep_ = 0; rep_ < NREP(id); ++rep_)
#define REPBAR(id) do { if (rep_ + 1 < NREP(id)) xcd_barrier(bar); } while (0)
#define IN(k) (lo <= (k) && (k) < hi)
#define SEAM(k) do { if (IN(k) && IN((k) + 1)) xcd_barrier(bar); } while (0)

    if (PSEL(0) && IN(0)) REPLOOP(0) { ph_prologue(p, lds); __syncthreads(); REPBAR(0); }
    SEAM(0);
    if (PSEL(1) && IN(1)) REPLOOP(1) { ph_norm1_tables(p); REPBAR(1); }
    SEAM(1);
    for (int l = 0; l < 2; ++l) {
        const int pb = 2 + NPH_LAYER * l;
        const float* mod = (const float*)(ws + WS_MOD) + (size_t)l * 5 * 12288;
        if (PSEL(2) && IN(pb + 0)) REPLOOP(2) {
            pg8::EpiStoreBf16 E{(bf16_t*)(ws + WS_PA), INP};
            if (l == 0) { if (c >= GgA) moe_convert_while(p, lds, pb + 0, GgA);
                else { pg8::TileSched S; S.init(ws + WS_H, (bf16_t*)(ws + WS_WTIN), DM, DM, MT / 256, INP / 256, 1, 0, 0, GgA, c, 0); pg8::gemm_phase(lds, pg8::Desc{DM, DM, DM}, S, E); if (nconv) moe_mark_done(p, pb + 0); } }
            else { pg8::InSchedLast S; S.init(ws + WS_H, (bf16_t*)(ws + WS_WTIN) + (size_t)INP * DM, G, c); pg8::gemm_phase(lds, pg8::Desc{DM, DM, DM}, S, E); }
            moe_fill(p, lds, pb + 0);
         REPBAR(2); }
        SEAM(pb + 0);
        if (PSEL(3) && IN(pb + 1)) REPLOOP(3) { ph_rowsplit(p, l, lds); __syncthreads();  REPBAR(3); }
        SEAM(pb + 1);
        if (PSEL(4) && IN(pb + 2)) REPLOOP(4) {
#ifndef C_SEL
#define C_SEL 15
#endif
            if (C_SEL & 1) { pg8::TileSched S; S.init(ws + WS_QA, (bf16_t*)(ws + WS_WTUQ) + (size_t)l * 768 * 384, 384, 384, (l == 0 ? MT : NLAT) / 256, 3, 1, 0, 0, G, c, 0);
              pg8::EpiQ E{(bf16_t*)(ws + WS_QB), (const f32x2*)(ws + WS_ROPE)}; pg8::gemm_phase(lds, pg8::Desc{384, 384, 384}, S, E); }
            if (C_SEL & 2) { pg8::TileSched S; S.init(ws + WS_KVA, (bf16_t*)(ws + WS_WTUKV) + (size_t)l * 1024 * 256, 256, 256, MT / 256, 2, 1, 0, 0, G, c, 112);
              pg8::EpiK E{(bf16_t*)(ws + WS_KC)}; pg8::gemm_phase(lds, pg8::Desc{256, 256, 256}, S, E); }
            if (C_SEL & 4) { pg8::TileSched S; S.init((bf16_t*)(ws + WS_WTUKV) + (size_t)l * 1024 * 256 + 512 * 256, ws + WS_KVA, 256, 256, 2, MT / 256, 1, 0, 0, G, c, 184);
              pg8::EpiV E{(bf16_t*)(ws + WS_VT)}; pg8::gemm_phase(lds, pg8::Desc{256, 256, 256}, S, E); }
            if (C_SEL & 8) { pg8::TileSched S; S.init(ws + WS_UPK, (bf16_t*)(ws + WS_WST) + (size_t)l * 32 * 256 * 256, 512, 256, 3, 1, 32, (size_t)768 * 512 * 2, (size_t)256 * 256 * 2, G, c, 0);
              pg8::EpiS1 E{(float*)(ws + WS_EST)}; pg8::gemm_phase(lds, pg8::Desc{512, 256, 256}, S, E); }
            moe_fill(p, lds, pb + 2);
         REPBAR(4); }
        SEAM(pb + 2);
        if (PSEL(5) && IN(pb + 3)) REPLOOP(5) { ph_attn_carry(p, l, lds); __syncthreads();  REPBAR(5); }
        SEAM(pb + 3);
        if (PSEL(6) && IN(pb + 4)) REPLOOP(6) {
            pg8::TileSched S; S.init(ws + WS_UPK, (bf16_t*)(ws + WS_G2B) + (size_t)l * 32 * 256 * 512, 512, 512, 3, 1, 32, (size_t)768 * 512 * 2, (size_t)256 * 512 * 2, G, c, 0);
            pg8::EpiS2 E{(bf16_t*)(ws + WS_GB)}; pg8::gemm_phase(lds, pg8::Desc{512, 512, 512}, S, E);
            moe_fill(p, lds, pb + 4);
         REPBAR(6); }
        SEAM(pb + 4);
        if (PSEL(7) && IN(pb + 5)) REPLOOP(7) {
            pg8::TileSched S; S.init(ws + WS_GB, (bf16_t*)(ws + WS_WTGLU) + (size_t)l * 512 * 512, 512, 512, (l == 0 ? MT : NLAT) / 256, 2, 1, 0, 0, G, c, 0);
            pg8::EpiGlu E{(const bf16_t*)(ws + WS_GB), p.in[I_BGLU] + l * 512, (bf16_t*)(ws + WS_CAT)}; pg8::gemm_phase(lds, pg8::Desc{512, 512, 512}, S, E);
            moe_fill(p, lds, pb + 5);
         REPBAR(7); }
        SEAM(pb + 5);
        if (PSEL(8) && IN(pb + 6)) REPLOOP(8) {
            pg8::TileSched S; S.init(ws + WS_CAT, (bf16_t*)(ws + WS_WTOUT) + (size_t)l * DM * DM, DM, DM, (l == 0 ? MT : NLAT) / 256, DM / 256, 1, 0, 0, l == 0 ? GgG : G, c, 0);
            pg8::EpiOut E{p.in[I_X], p.in[I_CTX], l == 0 ? (const bf16_t*)nullptr : (const bf16_t*)(ws + WS_XA), mod + 2 * DM, (bf16_t*)(ws + WS_XB)};
            if (l == 0 && c >= GgG) moe_convert_while(p, lds, pb + 6, GgG); else { pg8::gemm_phase(lds, pg8::Desc{DM, DM, DM}, S, E); if (l == 0 && nconv) moe_mark_done(p, pb + 6); }
            moe_fill(p, lds, pb + 6);
         REPBAR(8); }
        SEAM(pb + 6);
        if (PSEL(9) && IN(pb + 7)) REPLOOP(9) { ph_norm2_router(p, l, lds); __syncthreads(); REPBAR(9); }
        SEAM(pb + 7);
        if (PSEL(10) && IN(pb + 8)) REPLOOP(10) { ph_topk(p, l, lds); __syncthreads(); moe_require(p, lds, l * Q_LAYER + Q_GU);  REPBAR(10); }
        if (PSEL(11) && IN(pb + 9)) REPLOOP(11) { }
        SEAM(pb + 9);
        if (PSEL(12) && IN(pb + 10)) REPLOOP(12) {
            pg8::MoeSched S; S.init(ws + WS_H, (bf16_t*)(ws + WS_WTGU) + (size_t)l * NE * 2048 * DM, DM, DM, l == 0 ? 5 : 4, 8, 0, (size_t)2048 * DM * 2, l == 0 ? GgK : G, c);
            pg8::EpiGU E{(bf16_t*)(ws + WS_HID)};
            if (l == 0 && c >= GgK) moe_convert_while(p, lds, pb + 10, GgK); else { pg8::gemm_phase<pg8::EpiGU, pg8::MoeSched, true>(lds, pg8::Desc{DM, DM, DM}, S, E, (const int*)(ws + WS_ROWTOK), l == 0 ? 1152 : 1024); if (l == 0 && nconv) moe_mark_done(p, pb + 10); }
            moe_require(p, lds, (l + 1) * Q_LAYER); moe_fill(p, lds, pb + 10);
         REPBAR(12); }
        SEAM(pb + 10);
        if (PSEL(13) && IN(pb + 11)) REPLOOP(13) {
            pg8::MoeSched S; S.init(ws + WS_HID, (bf16_t*)(ws + WS_WTDN) + (size_t)l * NE * DM * FF, FF, FF, l == 0 ? 5 : 4, 8, (size_t)EROWS * FF * 2, (size_t)DM * FF * 2, l == 0 ? GgK : G, c);
            pg8::EpiDown E{(bf16_t*)(ws + WS_YS), (const float*)(ws + WS_ROWAFF)};
            if (l == 0 && c >= GgK) moe_convert_while(p, lds, pb + 11, GgK); else { pg8::gemm_phase(lds, pg8::Desc{FF, FF, FF}, S, E); if (l == 0 && nconv) moe_mark_done(p, pb + 11); }
            moe_fill(p, lds, pb + 11);
         REPBAR(13); }
        SEAM(pb + 11);
        if (PSEL(14) && IN(pb + 12)) REPLOOP(14) { ph_combine(p, l);  REPBAR(14); }
        SEAM(pb + 12);
    }
#undef IN
#undef SEAM
}

extern "C" void kernel_launch(void* const* d_in, const int* in_sizes, int n_in, void* d_out, int out_size, void* d_ws, size_t ws_size, hipStream_t stream) {
    static int grid = 0;
    if (grid == 0) {
        if (n_in != 33 || ws_size < WS_END) { fprintf(stderr, "kernel_launch: need 33 inputs and >= %zu bytes of workspace; got %d, %zu\n", (size_t)WS_END, n_in, ws_size); grid = -1; return; }
        int dev = 0, cus = 0;
        if (hipGetDevice(&dev) != hipSuccess || hipDeviceGetAttribute(&cus, hipDeviceAttributeMultiprocessorCount, dev) != hipSuccess) { grid = -1; return; }
        if (hipFuncSetAttribute((const void*)fwd, hipFuncAttributeMaxDynamicSharedMemorySize, LDS_BYTES) != hipSuccess) { fprintf(stderr, "kernel_launch: hipFuncSetAttribute failed\n"); grid = -1; return; }
        (void)hipGetLastError();
        grid = cus > 256 ? 256 : cus;
    }
    if (grid < 0) return;
    (void)hipMemsetAsync((char*)d_ws + WS_CTL, 0, CTL_BYTES, stream);
    Params a{};
    for (int i = 0; i < 33; ++i) a.in[i] = (const float*)d_in[i];
    a.out = (float*)d_out; a.ws = (unsigned char*)d_ws;
#if MK_SPLIT
    for (int ph = 0; ph < NPH; ++ph) { a.ph_lo = ph; a.ph_hi = ph + 1; hipLaunchKernelGGL(fwd, dim3(grid), dim3(512), LDS_BYTES, stream, a); }
#else
    a.ph_lo = 0; a.ph_hi = NPH; hipLaunchKernelGGL(fwd, dim3(grid), dim3(512), LDS_BYTES, stream, a);
#endif
}
```

```cpp
#include <hip/hip_runtime.h>
#include <cstdint>
#include <cstdio>

#ifndef MK_SPLIT
#define MK_SPLIT 0
#endif

#define LAS __attribute__((address_space(3)))
typedef unsigned short bf16_t;
typedef short bf16x8 __attribute__((ext_vector_type(8)));
typedef short bf16x4 __attribute__((ext_vector_type(4)));
typedef float f32x4 __attribute__((ext_vector_type(4)));
typedef float f32x2 __attribute__((ext_vector_type(2)));
typedef unsigned u32x4 __attribute__((ext_vector_type(4)));
typedef unsigned u32x2 __attribute__((ext_vector_type(2)));
typedef float f32x16 __attribute__((ext_vector_type(16)));

constexpr int DM = 2048, NB = 4, SEQ = 2048, CTX = 256, NLAT = NB * SEQ, NCTX = NB * CTX, MT = NLAT + NCTX;
constexpr int INC = 3776, INP = 3840;
constexpr int C_SGU_U = 0, C_SGU_V = 512, C_CQ = 1024, C_CKV = 1408, C_KR = 1664, C_S5 = 1728, C_CVB = 2240, C_CVC = 2752, C_CVH = 3264;
constexpr int NKEY = CTX + SEQ;
constexpr int NE = 16, FF = 1024, CAPL = 256, CAPC = 32, EROWS = 1280;
constexpr int NCHUNK = MT / 16;
constexpr float EPS = 1e-6f;
constexpr float QSCALE = 0.07216878364870322f * 1.4426950408889634f;

constexpr size_t al256(size_t x) { return (x + 255) & ~(size_t)255; }
constexpr size_t WS_CTL = 0;
constexpr size_t CTL_BYTES = 65536;
constexpr size_t WS_MOD = WS_CTL + CTL_BYTES;
constexpr size_t WS_WTIN = al256(WS_MOD + (size_t)2 * 5 * 12288 * 4);
constexpr size_t WS_WTOUT = al256(WS_WTIN + (size_t)2 * INP * DM * 2);
constexpr size_t WS_WTUQ = al256(WS_WTOUT + (size_t)2 * DM * DM * 2);
constexpr size_t WS_WTUKV = al256(WS_WTUQ + (size_t)2 * 768 * 384 * 2);
constexpr size_t WS_WTGLU = al256(WS_WTUKV + (size_t)2 * 1024 * 256 * 2);
constexpr size_t WS_WTGU = al256(WS_WTGLU + (size_t)2 * 512 * 512 * 2);
constexpr size_t WS_WTDN = al256(WS_WTGU + (size_t)2 * NE * 2048 * DM * 2);
constexpr size_t WS_PW = al256(WS_WTDN + (size_t)2 * NE * DM * FF * 2);
constexpr size_t WS_BB = al256(WS_PW + (size_t)2 * 2 * 32 * 64 * 17 * 8);
constexpr size_t WS_KZ = al256(WS_BB + (size_t)2 * 2 * 32 * 64 * 16 * 8);
constexpr size_t WS_WST = al256(WS_KZ + (size_t)2 * 2 * 32 * 4096 * 4);
constexpr size_t WS_G2B = al256(WS_WST + (size_t)2 * 32 * 256 * 256 * 2);
constexpr size_t WS_H = al256(WS_G2B + (size_t)2 * 32 * 256 * 512 * 2);
constexpr size_t WS_PA = al256(WS_H + (size_t)MT * DM * 2);
constexpr size_t PA_BYTES = (size_t)NE * EROWS * DM * 2;
static_assert(PA_BYTES >= (size_t)MT * INP * 2, "P fits in the union");
constexpr size_t WS_XA = al256(WS_PA + PA_BYTES);
constexpr size_t WS_XB = al256(WS_XA + (size_t)MT * DM * 4);
constexpr size_t WS_CAT = al256(WS_XB + (size_t)MT * DM * 4);
constexpr size_t WS_QA = al256(WS_CAT + (size_t)MT * DM * 2);
constexpr size_t WS_KVA = al256(WS_QA + (size_t)MT * 384 * 2);
constexpr size_t WS_QB = al256(WS_KVA + (size_t)MT * 256 * 2);
constexpr size_t WS_KC = al256(WS_QB + (size_t)MT * 768 * 2);
constexpr size_t WS_VT = al256(WS_KC + (size_t)NB * 4 * NKEY * 192 * 2);
constexpr size_t WS_UPK = al256(WS_VT + (size_t)NB * 4 * 128 * NKEY * 2);
constexpr size_t WS_EST = al256(WS_UPK + (size_t)32 * 768 * 512 * 2);
constexpr size_t WS_GB = al256(WS_EST + (size_t)32 * 768 * 256 * 4);
constexpr size_t WS_AFF = al256(WS_GB + (size_t)MT * 512 * 2);
constexpr size_t WS_ROWTOK = al256(WS_AFF + (size_t)MT * 16 * 4);
constexpr size_t WS_ROWAFF = al256(WS_ROWTOK + (size_t)NE * EROWS * 4);
constexpr size_t WS_INV = al256(WS_ROWAFF + (size_t)NE * EROWS * 4);
constexpr size_t WS_HID = al256(WS_INV + (size_t)MT * 16 * 4);
constexpr size_t WS_YS = al256(WS_HID + (size_t)NE * EROWS * FF * 2);
constexpr size_t WS_ROPE = al256(WS_YS + (size_t)NE * EROWS * DM * 2);
constexpr size_t WS_A16 = al256(WS_ROPE + 64 * 16 * 8);
constexpr size_t WS_END = al256(WS_A16 + (size_t)2 * 2 * 32 * 64 * 8);

constexpr int LDS_GEMM = 131072;
constexpr int LDS_ATTN = 3 * 44032;
constexpr int LDS_MISC = 133120;
constexpr int LDS_BYTES = LDS_MISC + 256;
static_assert(LDS_ATTN <= LDS_MISC && LDS_GEMM <= LDS_MISC, "LDS map");

typedef __bf16 bf16x2_t __attribute__((ext_vector_type(2)));
__device__ __forceinline__ unsigned cvt_pk_bf16(float lo, float hi) { const f32x2 v = {lo, hi}; const bf16x2_t b = __builtin_convertvector(v, bf16x2_t); return __builtin_bit_cast(unsigned, b); }
__device__ __forceinline__ float bf2f(unsigned short b) { return __uint_as_float(((unsigned)b) << 16); }
__device__ __forceinline__ float bflo(unsigned w) { return __uint_as_float(w << 16); }
__device__ __forceinline__ float bfhi(unsigned w) { return __uint_as_float(w & 0xffff0000u); }
__device__ __forceinline__ unsigned short f2bf(float f) { return (unsigned short)(cvt_pk_bf16(f, 0.f) & 0xffffu); }
__device__ __forceinline__ int opaque_tid() { int t = threadIdx.x; asm volatile("" : "+v"(t)); return t; }
__device__ __forceinline__ unsigned char* opaque_ptr(unsigned char* q) { long z = 0; asm volatile("" : "+s"(z)); return q + z; }
__device__ __forceinline__ float wave_sum(float v) {
#pragma unroll
    for (int o = 32; o >= 1; o >>= 1) v += __shfl_xor(v, o);
    return v;
}
__device__ __forceinline__ float gelu_tanh(float x) {
    const float y = x * (-2.3022081986679503f - 0.10294324069457f * x * x);
    return x * __builtin_amdgcn_rcpf(1.0f + __builtin_amdgcn_exp2f(y));
}
__device__ __forceinline__ float silu_f(float x) { return x * __builtin_amdgcn_rcpf(1.0f + __builtin_amdgcn_exp2f(-1.4426950408889634f * x)); }
__device__ __forceinline__ float sigmoid_f(float x) { return __builtin_amdgcn_rcpf(1.0f + __builtin_amdgcn_exp2f(-1.4426950408889634f * x)); }

#define XB_TMO      128
#define XB_XCNT(j)  (256  + 64 * (j))
#define XB_XSUB(j)  (1280 + 64 * (j))
#define XB_XGEN(j)  (2304 + 64 * (j))
#define XB_TOP      3328
#define XB_TOPGEN   3392
#define XCD_BAR_WORDS 3456
#define XB_SPIN_CAP (1u << 22)
__device__ __forceinline__ unsigned xb_ld(unsigned* p)              { return __hip_atomic_load(p, __ATOMIC_RELAXED, __HIP_MEMORY_SCOPE_AGENT); }
__device__ __forceinline__ unsigned xb_add(unsigned* p, unsigned v) { return __hip_atomic_fetch_add(p, v, __ATOMIC_RELAXED, __HIP_MEMORY_SCOPE_AGENT); }
__device__ __forceinline__ unsigned xb_xcc_id() { return (unsigned)__builtin_amdgcn_s_getreg((3 << 11) | 20) & 0xFu; }
#define XB_SPIN(cond, bar) do { unsigned _sp = 0; while (cond) { __builtin_amdgcn_s_sleep(1); \
    if ((++_sp & 255u) == 0u) { if (xb_ld(&(bar)[XB_TMO])) break; if (_sp > XB_SPIN_CAP) { atomicAdd(&(bar)[XB_TMO], 1u); break; } } } } while (0)
struct XcdBarrier { unsigned* bar; unsigned x; volatile LAS unsigned* st; };
__device__ __forceinline__ XcdBarrier xcd_barrier_post(unsigned* bar, volatile LAS unsigned* st) {
    XcdBarrier b; b.bar = bar; b.x = xb_xcc_id(); b.st = st;
    if (threadIdx.x == 0) (void)xb_add(&bar[XB_XCNT(b.x)], 1u);
    return b;
}
__device__ __forceinline__ void xcd_barrier_complete(unsigned* bar, unsigned x, unsigned& nloc, unsigned& nx) {
    const unsigned G = gridDim.x * gridDim.y * gridDim.z;
    unsigned sum, cnt, mine, sp = 0u;
    for (;;) {
        sum = 0u; cnt = 0u; mine = 0u;
#pragma unroll
        for (unsigned j = 0; j < 16; ++j) { const unsigned c = xb_ld(&bar[XB_XCNT(j)]); sum += c; cnt += (c > 0u) ? 1u : 0u; mine = (j == x) ? c : mine; }
        if (sum == G) break;
        __builtin_amdgcn_s_sleep(1);
        if ((++sp & 255u) == 0u) { if (xb_ld(&bar[XB_TMO])) break; if (sp > XB_SPIN_CAP) { atomicAdd(&bar[XB_TMO], 1u); break; } }
    }
    nloc = mine > 0u ? mine : 1u; nx = cnt > 0u ? cnt : 1u;
}
__device__ __forceinline__ void xcd_barrier(const XcdBarrier& b) {
    asm volatile("s_waitcnt vmcnt(0)" ::: "memory");
    __syncthreads();
    if (threadIdx.x == 0) {
        unsigned* bar = b.bar;
        __builtin_amdgcn_s_waitcnt(0);
        unsigned nloc = b.st[0], nx = b.st[1];
        if (nloc == 0u) { xcd_barrier_complete(bar, b.x, nloc, nx); b.st[0] = nloc; b.st[1] = nx; }
        const unsigned old = xb_add(&bar[XB_XSUB(b.x)], 1u);
        const unsigned gen = old / nloc;
        if (old + 1u == (gen + 1u) * nloc) {
            __builtin_amdgcn_fence(__ATOMIC_RELEASE, "agent");
            asm volatile("s_waitcnt vmcnt(0)" ::: "memory");
            const unsigned og = xb_add(&bar[XB_TOP], 1u);
            const unsigned tg = og / nx;
            if (og + 1u == (tg + 1u) * nx) xb_add(&bar[XB_TOPGEN], 1u);
            else XB_SPIN(xb_ld(&bar[XB_TOPGEN]) == tg, bar);
            __builtin_amdgcn_fence(__ATOMIC_ACQUIRE, "agent");
            xb_add(&bar[XB_XGEN(b.x)], 1u);
            asm volatile("s_waitcnt vmcnt(0)" ::: "memory");
        } else {
            XB_SPIN(xb_ld(&bar[XB_XGEN(b.x)]) == gen, bar);
            __builtin_amdgcn_fence(__ATOMIC_ACQUIRE, "agent");
            asm volatile("s_waitcnt vmcnt(0)" ::: "memory");
        }
    }
    __syncthreads();
}

namespace pg8 {
constexpr int BM = 256, BK = 64, HALF = 128, HTB = HALF * BK * 2, STAGE_BYTES = 8 * HTB;
__host__ __device__ __forceinline__ int lds_byte(int r, int c) { const int st = (r >> 4) * 2 + (c >> 5), rr = r & 15, cc = c & 31, ob = rr * 64 + cc * 2; return st * 1024 + (ob ^ (((ob >> 9) & 1) << 5)); }
__host__ __device__ __forceinline__ void stage_rc(int b, int& R, int& C) { const int st = b / 1024, sb = b % 1024, swz = sb ^ (((sb >> 9) & 1) << 5); R = (st >> 1) * 16 + swz / 64; C = (st & 1) * 32 + (swz % 64) / 2; }
__host__ __device__ __forceinline__ int perm32(int rho) { const int n = rho >> 4, i = rho & 15; return 8 * (i >> 2) + 4 * n + (i & 3); }

struct Unit { const char* a; const char* b; int pm, pn, pb; };
struct Desc { int lda, ldb, K; };

struct TileSched {
    const char* A; const char* B; size_t sA, sB;
    int lda, ldb, nM, nN, nB, G, c;
    __device__ __forceinline__ void init(const void* A_, const void* B_, int lda_, int ldb_, int nM_, int nN_, int nB_, size_t sA_, size_t sB_, int G_, int c_, int off) {
        A = (const char*)A_; B = (const char*)B_; lda = lda_; ldb = ldb_; nM = nM_; nN = nN_; nB = nB_; sA = sA_; sB = sB_; G = G_; c = (c_ + G_ - (off % G_)) % G_; }
    __device__ __forceinline__ bool next(int i, Unit& u) const {
        const int nwg = nM * nN; const long L = (long)i * G + c; if (L >= (long)nwg * nB) return false;
        const int pb = (int)(L / nwg); int wgid = (int)(L % nwg);
        { const int q = nwg / 8, r = nwg % 8, xcd = wgid % 8, off = wgid / 8; wgid = (xcd < r ? xcd * (q + 1) : r * (q + 1) + (xcd - r) * q) + off; }
        const int nig = 8 * nN, gid = wgid / nig, fm = gid * 8, gsz = (nM - fm) < 8 ? (nM - fm) : 8;
        u.pm = fm + ((wgid % nig) % gsz); u.pn = (wgid % nig) / gsz; u.pb = pb;
        u.a = A + (size_t)pb * sA + (size_t)u.pm * 256 * lda * 2; u.b = B + (size_t)pb * sB + (size_t)u.pn * 256 * ldb * 2; return true;
    }
};
struct InSchedLast {
    TileSched T;
    __device__ __forceinline__ void init(const void* A_, const void* B_, int G_, int c_) { T.init(A_, B_, DM, DM, NLAT / 256, INP / 256, 1, 0, 0, G_, c_, 0); }
    __device__ __forceinline__ bool next(int i, Unit& u) const {
        const int nlat = (NLAT / 256) * (INP / 256); const long L = (long)i * T.G + T.c;
        if (L < nlat) return T.next(i, u);
        if (L >= nlat + 16) return false;
        const int k = (int)(L - nlat); u.pm = NLAT / 256 + (k >> 2); u.pn = 5 + (k & 3); u.pb = 0;
        u.a = T.A + (size_t)u.pm * 256 * DM * 2; u.b = T.B + (size_t)u.pn * 256 * DM * 2; return true;
    }
};
struct MoeSched {
    const char* A; const char* B; size_t sA, sB; int lda, ldb, nM, nN, G, c;
    __device__ __forceinline__ void init(const void* A_, const void* B_, int lda_, int ldb_, int nM_, int nN_, size_t sA_, size_t sB_, int G_, int c_) {
        A = (const char*)A_; B = (const char*)B_; lda = lda_; ldb = ldb_; nM = nM_; nN = nN_; sA = sA_; sB = sB_; G = G_; c = c_; }
    __device__ __forceinline__ bool next(int i, Unit& u) const {
        int e, rem; const int per = nM * nN;
        if ((G & 7) == 0) { const int x = c & 7, j = c >> 3, w = G >> 3; const int L = i * w + j; if (L >= 2 * per) return false; e = 2 * x + L / per; rem = L % per; }
        else { const long L = (long)i * G + c; if (L >= (long)NE * per) return false; e = (int)(L / per); rem = (int)(L % per); }
        u.pn = rem / nM; u.pm = rem % nM; u.pb = e;
        u.a = sA == 0 ? A : A + (size_t)e * sA + (size_t)u.pm * 256 * lda * 2; u.b = B + (size_t)e * sB + (size_t)u.pn * 256 * ldb * 2; return true;
    }
};

#ifndef PG8_SP2
#define PG8_SP2 true
#endif
#ifndef PG8_ALIGN
#define PG8_ALIGN true
#endif
template <class Epi, class Sched, bool GATHER = false, bool SP2 = PG8_SP2, bool ALIGN_EPI = PG8_ALIGN>
__device__ __forceinline__ void gemm_phase(LAS unsigned char* lds, const Desc g, const Sched& S, const Epi& E, const int* rowtok = nullptr, int nvalid = 0) {
    const int tid = opaque_tid(), wid = __builtin_amdgcn_readfirstlane(tid >> 6), lane = tid & 63, wr = wid >> 2, wc = wid & 3, fr = lane & 15, fq = lane >> 4;
    const int K = g.K, nt = K / BK;
    unsigned voffA[2], voffB[2]; int gR[2], gCc[2];
#pragma unroll
    for (int i = 0; i < 2; ++i) { int R, C; stage_rc(tid * 16 + i * 8192, R, C); const int Rb = Epi::PERM ? ((R & ~31) + perm32(R & 31)) : R;
        voffA[i] = (unsigned)(R * g.lda + C) * 2u; voffB[i] = (unsigned)(Rb * g.ldb + C) * 2u; gR[i] = R; gCc[i] = C; }
    unsigned gC[2][2], gN[2][2];
#define PG8_GOFF(u, o) do { _Pragma("unroll") for (int _h = 0; _h < 2; ++_h) _Pragma("unroll") for (int _i = 0; _i < 2; ++_i) { const int _r = (u).pm * 256 + _h * 128 + gR[_i]; \
        const int _tok = _r < nvalid ? rowtok[(u).pb * EROWS + _r] : 0; (o)[_h][_i] = (unsigned)(_tok * g.lda + gCc[_i]) * 2u; } } while (0)
    const size_t kstep = (size_t)(BK * 2);
    const size_t hstepA = (size_t)HALF * g.lda * 2, hstepB = (size_t)HALF * g.ldb * 2;
    const unsigned ldsw = (unsigned)wid * 1024u;
    const int aoff = lds_byte(wr * 64 + fr, fq * 8), boff = lds_byte(wc * 32 + fr, fq * 8);
#define PG8_SA(b, h) (((b) * 2 + (h)) * HTB)
#define PG8_SB(b, h) ((4 + (b) * 2 + (h)) * HTB)
#define PG8_STAGE(bufoff, gbase, voff) do { _Pragma("unroll") for (int _i = 0; _i < 2; ++_i) \
        __builtin_amdgcn_global_load_lds((const unsigned*)((const char*)(gbase) + (voff)[_i]), (LAS unsigned*)(lds + (bufoff) + ldsw + _i * 8192), 16, 0, 0); } while (0)
#define PG8_STAGE_A(bufoff, kptr, half, VO) do { if constexpr (GATHER) { _Pragma("unroll") for (int _i = 0; _i < 2; ++_i) \
        __builtin_amdgcn_global_load_lds((const unsigned*)((const char*)(kptr) + (VO)[half][_i]), (LAS unsigned*)(lds + (bufoff) + ldsw + _i * 8192), 16, 0, 0); } \
        else { PG8_STAGE(bufoff, (kptr) + (half) * hstepA, voffA); } } while (0)
#define PG8_LDA(dst, b, h) do { _Pragma("unroll") for (int m = 0; m < 4; ++m) _Pragma("unroll") for (int k = 0; k < 2; ++k) dst[m][k] = *(const LAS bf16x8*)(lds + PG8_SA(b, h) + aoff + m * 2048 + k * 1024); } while (0)
#define PG8_LDB(dst, b, h) do { _Pragma("unroll") for (int n = 0; n < 2; ++n) _Pragma("unroll") for (int k = 0; k < 2; ++k) dst[n][k] = *(const LAS bf16x8*)(lds + PG8_SB(b, h) + boff + n * 2048 + k * 1024); } while (0)
#define PG8_MMA(ai, bj, At, Bt) do { __builtin_amdgcn_s_setprio(1); _Pragma("unroll") for (int m = 0; m < 4; ++m) _Pragma("unroll") for (int n = 0; n < 2; ++n) _Pragma("unroll") for (int k = 0; k < 2; ++k) \
        acc[ai][bj][m][n] = __builtin_amdgcn_mfma_f32_16x16x32_bf16(Bt[n][k], At[m][k], acc[ai][bj][m][n], 0, 0, 0); __builtin_amdgcn_s_setprio(0); } while (0)
#define PG8_WAIT_V(n) asm volatile("s_waitcnt vmcnt(" #n ")" ::: "memory")
#define PG8_WAIT_L(n) asm volatile("s_waitcnt lgkmcnt(" #n ")" ::: "memory")
#define PG8_BAR __builtin_amdgcn_s_barrier()
#define PG8_SCHED __builtin_amdgcn_sched_barrier(0)
    Unit cur, nxt; int ui = 0;
    if (!S.next(0, cur)) return;
    f32x4 acc[2][2][4][2];
#pragma unroll
    for (int a = 0; a < 2; ++a)
#pragma unroll
        for (int b = 0; b < 2; ++b)
#pragma unroll
            for (int m = 0; m < 4; ++m)
#pragma unroll
                for (int n = 0; n < 2; ++n) acc[a][b][m][n] = (f32x4){0.f, 0.f, 0.f, 0.f};
    bf16x8 At[4][2], B0[2][2], B1[2][2];
    const char* cA = cur.a; const char* cB = cur.b;
    if constexpr (GATHER) { PG8_GOFF(cur, gC); }
    if constexpr (SP2) {
        PG8_STAGE(PG8_SB(0, 0), cB, voffB); PG8_STAGE(PG8_SB(0, 1), cB + hstepB, voffB); PG8_STAGE_A(PG8_SA(0, 0), cA, 0, gC); PG8_STAGE_A(PG8_SA(0, 1), cA, 1, gC);
        if (wr == 1) PG8_BAR;
        PG8_WAIT_V(2); PG8_BAR;
        PG8_STAGE(PG8_SB(1, 0), cB + kstep, voffB); PG8_STAGE_A(PG8_SA(1, 0), cA + kstep, 0, gC); PG8_STAGE(PG8_SB(1, 1), cB + hstepB + kstep, voffB);
        PG8_WAIT_V(6); PG8_BAR;
    } else {
    PG8_STAGE(PG8_SB(0, 0), cB, voffB); PG8_STAGE_A(PG8_SA(0, 0), cA, 0, gC); PG8_STAGE(PG8_SB(0, 1), cB + hstepB, voffB); PG8_STAGE_A(PG8_SA(0, 1), cA, 1, gC);
    if (wr == 1) PG8_BAR;
    PG8_WAIT_V(4); PG8_BAR;
    PG8_STAGE(PG8_SB(1, 0), cB + kstep, voffB); PG8_STAGE_A(PG8_SA(1, 0), cA + kstep, 0, gC); PG8_STAGE(PG8_SB(1, 1), cB + hstepB + kstep, voffB);
    PG8_WAIT_V(6); PG8_BAR;
    }
    for (;;) {
        const bool has_next = S.next(ui + 1, nxt);
        const char* nA = has_next ? nxt.a : cA; const char* nB = has_next ? nxt.b : cB;
        if constexpr (GATHER) { if (has_next) { PG8_GOFF(nxt, gN); } else {
#pragma unroll
            for (int _h = 0; _h < 2; ++_h)
#pragma unroll
                for (int _i = 0; _i < 2; ++_i) gN[_h][_i] = gC[_h][_i]; } }
#pragma nounroll
        for (int t = 0; t < nt; t += 2) {
            const bool last = (t == nt - 2);
            const char* a1 = cA + (size_t)(t + 1) * kstep;
            const char* a2 = last ? nA : cA + (size_t)(t + 2) * kstep; const char* b2 = last ? nB : cB + (size_t)(t + 2) * kstep;
            const char* a3 = a2 + kstep; const char* b3 = b2 + kstep;
            unsigned g2[2][2];
            if constexpr (GATHER) {
#pragma unroll
                for (int _h = 0; _h < 2; ++_h)
#pragma unroll
                    for (int _i = 0; _i < 2; ++_i) g2[_h][_i] = last ? gN[_h][_i] : gC[_h][_i]; }
            if constexpr (SP2) {
            PG8_LDB(B0, 0, 0); PG8_LDB(B1, 0, 1); PG8_SCHED; PG8_LDA(At, 0, 0); PG8_STAGE_A(PG8_SA(1, 1), a1, 1, gC);
            PG8_WAIT_V(8); PG8_WAIT_L(0); PG8_BAR; PG8_MMA(0, 0, At, B0); PG8_MMA(0, 1, At, B1); PG8_BAR; PG8_SCHED;
            PG8_LDA(At, 0, 1); PG8_STAGE(PG8_SB(0, 0), b2, voffB); PG8_STAGE(PG8_SB(0, 1), b2 + hstepB, voffB); PG8_STAGE_A(PG8_SA(0, 0), a2, 0, g2);
            PG8_WAIT_V(8); PG8_WAIT_L(0); PG8_BAR; PG8_MMA(1, 0, At, B0); PG8_MMA(1, 1, At, B1); PG8_BAR; PG8_SCHED;
            PG8_LDB(B0, 1, 0); PG8_LDB(B1, 1, 1); PG8_SCHED; PG8_LDA(At, 1, 0); PG8_STAGE_A(PG8_SA(0, 1), a2, 1, g2);
            PG8_WAIT_V(8); PG8_WAIT_L(0); PG8_BAR; PG8_MMA(0, 0, At, B0); PG8_MMA(0, 1, At, B1); PG8_BAR; PG8_SCHED;
            PG8_LDA(At, 1, 1); PG8_STAGE(PG8_SB(1, 0), b3, voffB); PG8_STAGE(PG8_SB(1, 1), b3 + hstepB, voffB); PG8_STAGE_A(PG8_SA(1, 0), a3, 0, g2);
            PG8_WAIT_V(8); PG8_WAIT_L(0); PG8_BAR; PG8_MMA(1, 0, At, B0); PG8_MMA(1, 1, At, B1); PG8_BAR; PG8_SCHED;
            } else {
            PG8_LDB(B0, 0, 0); PG8_SCHED; PG8_LDA(At, 0, 0); PG8_STAGE_A(PG8_SA(1, 1), a1, 1, gC);
            PG8_WAIT_L(8); PG8_BAR; PG8_WAIT_L(0); PG8_MMA(0, 0, At, B0); PG8_BAR; PG8_SCHED;
            PG8_LDB(B1, 0, 1); PG8_STAGE(PG8_SB(0, 0), b2, voffB);
            PG8_BAR; PG8_WAIT_L(0); PG8_MMA(0, 1, At, B1); PG8_BAR;
            PG8_LDA(At, 0, 1); PG8_STAGE_A(PG8_SA(0, 0), a2, 0, g2);
            PG8_BAR; PG8_WAIT_L(0); PG8_MMA(1, 0, At, B0); PG8_BAR; PG8_SCHED;
            PG8_STAGE(PG8_SB(0, 1), b2 + hstepB, voffB);
            PG8_WAIT_V(6); PG8_BAR; PG8_MMA(1, 1, At, B1); PG8_BAR;
            PG8_LDB(B0, 1, 0); PG8_SCHED; PG8_LDA(At, 1, 0); PG8_STAGE_A(PG8_SA(0, 1), a2, 1, g2);
            PG8_WAIT_L(8); PG8_BAR; PG8_WAIT_L(0); PG8_MMA(0, 0, At, B0); PG8_BAR; PG8_SCHED;
            PG8_LDB(B1, 1, 1); PG8_STAGE(PG8_SB(1, 0), b3, voffB);
            PG8_BAR; PG8_WAIT_L(0); PG8_MMA(0, 1, At, B1); PG8_BAR;
            PG8_LDA(At, 1, 1); PG8_STAGE_A(PG8_SA(1, 0), a3, 0, g2);
            PG8_BAR; PG8_WAIT_L(0); PG8_MMA(1, 0, At, B0); PG8_BAR; PG8_SCHED;
            PG8_STAGE(PG8_SB(1, 1), b3 + hstepB, voffB);
            PG8_WAIT_V(6); PG8_BAR; PG8_MMA(1, 1, At, B1); PG8_BAR;
            }
        }
        if constexpr (ALIGN_EPI) { if (wr == 0) PG8_BAR; }
        E(acc, cur, wr, wc, fr, fq);
        if (!has_next) break;
#pragma unroll
        for (int a = 0; a < 2; ++a)
#pragma unroll
            for (int b = 0; b < 2; ++b)
#pragma unroll
                for (int m = 0; m < 4; ++m)
#pragma unroll
                    for (int n = 0; n < 2; ++n) acc[a][b][m][n] = (f32x4){0.f, 0.f, 0.f, 0.f};
        cur = nxt; cA = nA; cB = nB; ++ui;
        if constexpr (GATHER) {
#pragma unroll
            for (int _h = 0; _h < 2; ++_h)
#pragma unroll
                for (int _i = 0; _i < 2; ++_i) gC[_h][_i] = gN[_h][_i]; }
        if constexpr (ALIGN_EPI) { if (wr == 1) PG8_BAR; }
    }
    PG8_WAIT_V(0);
    if constexpr (!ALIGN_EPI) { if (wr == 0) PG8_BAR; }
    PG8_BAR;
#undef PG8_SA
#undef PG8_SB
#undef PG8_STAGE
#undef PG8_STAGE_A
#undef PG8_GOFF
#undef PG8_LDA
#undef PG8_LDB
#undef PG8_MMA
#undef PG8_WAIT_V
#undef PG8_WAIT_L
#undef PG8_BAR
#undef PG8_SCHED
}

#define PG8_FOR_PERM(...) \
    _Pragma("unroll") for (int ai = 0; ai < 2; ++ai) _Pragma("unroll") for (int m = 0; m < 4; ++m) { const int tr = ai * 128 + wr * 64 + m * 16 + fr; \
        _Pragma("unroll") for (int bj = 0; bj < 2; ++bj) { const int tc = bj * 128 + wc * 32 + 8 * fq; const f32x4 v0 = acc[ai][bj][m][0], v1 = acc[ai][bj][m][1]; __VA_ARGS__ } }
#define PG8_FOR_NOPERM(...) \
    _Pragma("unroll") for (int ai = 0; ai < 2; ++ai) _Pragma("unroll") for (int m = 0; m < 4; ++m) { const int tr = ai * 128 + wr * 64 + m * 16 + fr; \
        _Pragma("unroll") for (int bj = 0; bj < 2; ++bj) _Pragma("unroll") for (int n = 0; n < 2; ++n) { const int tc = bj * 128 + wc * 32 + 16 * n + 4 * fq; const f32x4 v = acc[ai][bj][m][n]; __VA_ARGS__ } }

typedef const f32x4 (&AccRef)[2][2][4][2];

struct EpiStoreBf16 {
    static constexpr bool PERM = true;
    bf16_t* O; int ldc;
    __device__ __forceinline__ void operator()(AccRef acc, const Unit& u, int wr, int wc, int fr, int fq) const {
        PG8_FOR_PERM({ u32x4 w; w.x = cvt_pk_bf16(v0[0], v0[1]); w.y = cvt_pk_bf16(v0[2], v0[3]); w.z = cvt_pk_bf16(v1[0], v1[1]); w.w = cvt_pk_bf16(v1[2], v1[3]);
            *(u32x4*)(O + (size_t)(u.pm * 256 + tr) * ldc + u.pn * 256 + tc) = w; })
    }
};
struct EpiQ {
    static constexpr bool PERM = false;
    bf16_t* Q; const f32x2* ROPE;
    __device__ __forceinline__ void operator()(AccRef acc, const Unit& u, int wr, int wc, int fr, int fq) const {
#pragma unroll
        for (int ai = 0; ai < 2; ++ai)
#pragma unroll
            for (int m = 0; m < 4; ++m) { const int row = u.pm * 256 + ai * 128 + wr * 64 + m * 16 + fr; const bool lat = row < NLAT; const int t = row & (SEQ - 1);
#pragma unroll
                for (int bj = 0; bj < 2; ++bj) { const int cg = u.pn * 256 + bj * 128 + wc * 32; const int dd = cg % 192; f32x4 a = acc[ai][bj][m][0], b = acc[ai][bj][m][1];
                    if (dd >= 128 && lat) { const int pos = (dd - 128) >= 32 ? (t & 63) : (t >> 6); const f32x4* rp = (const f32x4*)(ROPE + pos * 16 + 4 * fq); const f32x4 r0 = rp[0], r1 = rp[1];
                        const float cs[4] = {r0[0], r0[2], r1[0], r1[2]}, sn[4] = {r0[1], r0[3], r1[1], r1[3]};
#pragma unroll
                        for (int i = 0; i < 4; ++i) { const float x1 = a[i], x2 = b[i]; a[i] = x1 * cs[i] - x2 * sn[i]; b[i] = x2 * cs[i] + x1 * sn[i]; } }
                    a *= QSCALE; b *= QSCALE;
                    bf16_t* o = Q + (size_t)row * 768 + cg + 4 * fq;
                    u32x2 w0; w0.x = cvt_pk_bf16(a[0], a[1]); w0.y = cvt_pk_bf16(a[2], a[3]); *(u32x2*)o = w0;
                    u32x2 w1; w1.x = cvt_pk_bf16(b[0], b[1]); w1.y = cvt_pk_bf16(b[2], b[3]); *(u32x2*)(o + 16) = w1; } }
    }
};
struct EpiK {
    static constexpr bool PERM = true;
    bf16_t* KC;
    __device__ __forceinline__ void operator()(AccRef acc, const Unit& u, int wr, int wc, int fr, int fq) const {
        const int b = u.pm < 32 ? (u.pm >> 3) : (u.pm - 32), key0 = u.pm < 32 ? CTX + (u.pm & 7) * 256 : 0;
        bf16_t* base = KC + ((size_t)(b * 4 + u.pn * 2) * NKEY + key0) * 192 + (size_t)(wr * 64 + fr) * 192 + wc * 32 + 8 * fq;
#pragma unroll
        for (int ai = 0; ai < 2; ++ai)
#pragma unroll
            for (int m = 0; m < 4; ++m)
#pragma unroll
                for (int bj = 0; bj < 2; ++bj) { const f32x4 v0 = acc[ai][bj][m][0], v1 = acc[ai][bj][m][1];
                    u32x4 w; w.x = cvt_pk_bf16(v0[0], v0[1]); w.y = cvt_pk_bf16(v0[2], v0[3]); w.z = cvt_pk_bf16(v1[0], v1[1]); w.w = cvt_pk_bf16(v1[2], v1[3]);
                    *(u32x4*)(base + (size_t)(ai * 128 + m * 16) * 192 + (size_t)bj * NKEY * 192) = w; }
    }
};
struct EpiV {
    static constexpr bool PERM = true;
    bf16_t* VT;
    __device__ __forceinline__ void operator()(AccRef acc, const Unit& u, int wr, int wc, int fr, int fq) const {
        const int b = u.pn < 32 ? (u.pn >> 3) : (u.pn - 32), key0 = u.pn < 32 ? CTX + (u.pn & 7) * 256 : 0;
        bf16_t* base = VT + ((size_t)(b * 4 + u.pm * 2) * 128 + wr * 64 + fr) * NKEY + key0 + wc * 32 + 8 * fq;
#pragma unroll
        for (int ai = 0; ai < 2; ++ai)
#pragma unroll
            for (int m = 0; m < 4; ++m)
#pragma unroll
                for (int bj = 0; bj < 2; ++bj) { const f32x4 v0 = acc[ai][bj][m][0], v1 = acc[ai][bj][m][1];
                    u32x2 w0, w1; w0.x = cvt_pk_bf16(v0[0], v0[1]); w0.y = cvt_pk_bf16(v0[2], v0[3]); w1.x = cvt_pk_bf16(v1[0], v1[1]); w1.y = cvt_pk_bf16(v1[2], v1[3]);
                    bf16_t* q = base + (size_t)(ai * 128 + m * 16) * NKEY + bj * 128; const int odd = fq & 1;
                    *(u32x2*)(q + (odd ? -4 : 0)) = w0; *(u32x2*)(q + (odd ? 4 : 8)) = w1; }
    }
};
struct EpiS1 {
    static constexpr bool PERM = false;
    float* EST;
    __device__ __forceinline__ void operator()(AccRef acc, const Unit& u, int wr, int wc, int fr, int fq) const {
        PG8_FOR_NOPERM({ const int row = u.pm * 256 + tr; if (row < NCHUNK) *(f32x4*)(EST + ((size_t)u.pb * 768 + row) * 256 + tc) = v; })
    }
};
struct EpiS2 {
    static constexpr bool PERM = true;
    bf16_t* GB;
    __device__ __forceinline__ void operator()(AccRef acc, const Unit& u, int wr, int wc, int fr, int fq) const {
        PG8_FOR_PERM({ const int row = u.pm * 256 + tr; if (row < NCHUNK) { const int p = tc >> 4, c = tc & 15;
            u32x4 w; w.x = cvt_pk_bf16(gelu_tanh(v0[0]), gelu_tanh(v0[1])); w.y = cvt_pk_bf16(gelu_tanh(v0[2]), gelu_tanh(v0[3]));
            w.z = cvt_pk_bf16(gelu_tanh(v1[0]), gelu_tanh(v1[1])); w.w = cvt_pk_bf16(gelu_tanh(v1[2]), gelu_tanh(v1[3]));
            *(u32x4*)(GB + (size_t)(row * 16 + p) * 512 + u.pb * 16 + c) = w; } })
    }
};
struct EpiGlu {
    static constexpr bool PERM = true;
    const bf16_t* GB; const float* bias; bf16_t* CAT;
    __device__ __forceinline__ void operator()(AccRef acc, const Unit& u, int wr, int wc, int fr, int fq) const {
        PG8_FOR_PERM({ const int row = u.pm * 256 + tr, col = u.pn * 256 + tc;
            const u32x4 gv = *(const u32x4*)(GB + (size_t)row * 512 + col); const f32x4 b0 = *(const f32x4*)(bias + col), b1 = *(const f32x4*)(bias + col + 4);
            u32x4 w;
            w.x = cvt_pk_bf16(bflo(gv.x) * sigmoid_f(v0[0] + b0[0]), bfhi(gv.x) * sigmoid_f(v0[1] + b0[1]));
            w.y = cvt_pk_bf16(bflo(gv.y) * sigmoid_f(v0[2] + b0[2]), bfhi(gv.y) * sigmoid_f(v0[3] + b0[3]));
            w.z = cvt_pk_bf16(bflo(gv.z) * sigmoid_f(v1[0] + b1[0]), bfhi(gv.z) * sigmoid_f(v1[1] + b1[1]));
            w.w = cvt_pk_bf16(bflo(gv.w) * sigmoid_f(v1[2] + b1[2]), bfhi(gv.w) * sigmoid_f(v1[3] + b1[3]));
            *(u32x4*)(CAT + (size_t)row * DM + 1024 + col) = w; })
    }
};
struct EpiOut {
    static constexpr bool PERM = true;
    const float* xl; const float* xc; const bf16_t* xs; const float* gate; bf16_t* xo;
    __device__ __forceinline__ void operator()(AccRef acc, const Unit& u, int wr, int wc, int fr, int fq) const {
        PG8_FOR_PERM({ const int row = u.pm * 256 + tr, col = u.pn * 256 + tc; const int rr = row < NLAT ? (row >> 11) : 4;
            f32x4 x0, x1;
            if (xs) { const u32x4 xv = *(const u32x4*)(xs + (size_t)row * DM + col); x0 = (f32x4){bflo(xv.x), bfhi(xv.x), bflo(xv.y), bfhi(xv.y)}; x1 = (f32x4){bflo(xv.z), bfhi(xv.z), bflo(xv.w), bfhi(xv.w)}; }
            else { const float* src = (row < NLAT ? xl + (size_t)row * DM : xc + (size_t)(row - NLAT) * DM) + col; x0 = *(const f32x4*)src; x1 = *(const f32x4*)(src + 4); }
            const float* gp = gate + (size_t)rr * 12288 + col; const f32x4 g0 = *(const f32x4*)gp, g1 = *(const f32x4*)(gp + 4);
            x0 += g0 * v0; x1 += g1 * v1;
            u32x4 w; w.x = cvt_pk_bf16(x0[0], x0[1]); w.y = cvt_pk_bf16(x0[2], x0[3]); w.z = cvt_pk_bf16(x1[0], x1[1]); w.w = cvt_pk_bf16(x1[2], x1[3]);
            *(u32x4*)(xo + (size_t)row * DM + col) = w; })
    }
};
struct EpiGU {
    static constexpr bool PERM = true;
    bf16_t* HID;
    __device__ __forceinline__ void operator()(AccRef acc, const Unit& u, int wr, int wc, int fr, int fq) const {
        PG8_FOR_PERM({ const int row = u.pm * 256 + tr, j = (u.pn * 256 + tc) >> 1;
            u32x2 w; w.x = cvt_pk_bf16(silu_f(v0[0]) * v0[1], silu_f(v0[2]) * v0[3]); w.y = cvt_pk_bf16(silu_f(v1[0]) * v1[1], silu_f(v1[2]) * v1[3]);
            *(u32x2*)(HID + ((size_t)u.pb * EROWS + row) * FF + j) = w; })
    }
};
struct EpiDown {
    static constexpr bool PERM = true;
    bf16_t* YS; const float* RA;
    __device__ __forceinline__ void operator()(AccRef acc, const Unit& u, int wr, int wc, int fr, int fq) const {
        PG8_FOR_PERM({ const int row = u.pm * 256 + tr, col = u.pn * 256 + tc; const float a = RA[u.pb * EROWS + row];
            u32x4 w; w.x = cvt_pk_bf16(v0[0] * a, v0[1] * a); w.y = cvt_pk_bf16(v0[2] * a, v0[3] * a); w.z = cvt_pk_bf16(v1[0] * a, v1[1] * a); w.w = cvt_pk_bf16(v1[2] * a, v1[3] * a);
            *(u32x4*)(YS + ((size_t)u.pb * EROWS + row) * DM + col) = w; })
    }
};
}

struct Params { const float* in[33]; float* out; unsigned char* ws; int ph_lo, ph_hi; };
enum { I_X = 0, I_C, I_CTX, I_CCTX, I_N1G, I_N2G, I_WADA, I_BADA, I_WIN, I_WOUT, I_SGUNG, I_SGUW, I_SGUB, I_QNG, I_WUQ, I_KVNG, I_WUKV,
       I_ARE, I_AIM, I_LOGDT, I_BRE, I_BIM, I_CRE, I_CIM, I_S5D, I_WGLU, I_BGLU, I_CONVW, I_WROUTER, I_WGATE, I_WUP, I_WDOWN, I_FNG };

__device__ __forceinline__ void transpose_tile(const float* src, int N, int k0, int n0, bf16_t* dst, int ldd, int rmul, int radd, int remap_kv, LAS float* tile) {
    const int tid = threadIdx.x;
#pragma unroll
    for (int i = 0; i < 2; ++i) { const int r = (tid >> 4) + 32 * i, c4 = (tid & 15) * 4;
        const f32x4 v = *(const f32x4*)(src + (size_t)(k0 + r) * N + n0 + c4);
        tile[r * 65 + c4 + 0] = v[0]; tile[r * 65 + c4 + 1] = v[1]; tile[r * 65 + c4 + 2] = v[2]; tile[r * 65 + c4 + 3] = v[3]; }
    __syncthreads();
    { const int n = tid >> 3, kc = tid & 7; float f[8];
#pragma unroll
        for (int j = 0; j < 8; ++j) f[j] = tile[(kc * 8 + j) * 65 + n];
        int nn = n0 + n; if (remap_kv) nn = ((nn & 255) < 128) ? ((nn >> 8) * 128 + (nn & 127)) : (512 + (nn >> 8) * 128 + (nn & 127));
        const int drow = nn * rmul + radd;
        u32x4 w; w.x = cvt_pk_bf16(f[0], f[1]); w.y = cvt_pk_bf16(f[2], f[3]); w.z = cvt_pk_bf16(f[4], f[5]); w.w = cvt_pk_bf16(f[6], f[7]);
        *(u32x4*)(dst + (size_t)drow * ldd + k0 + kc * 8) = w; }
    __syncthreads();
}
constexpr int N_ADA_UNITS = 192, N_S5T_UNITS = 64, N_ROPE_UNITS = 2;
constexpr int T_WIN = 32 * 14 + 32 * 3  , T_WOUT = 32 * 8  , T_WUQ = 6 * 12, T_WUKV = 4 * 16, T_WGLU = 8 * 8, T_EXP = 512;
constexpr int N_TR = 2 * (T_WIN + T_WOUT + T_WUQ + T_WUKV + T_WGLU);
constexpr int N_PRO_ITEMS = N_ADA_UNITS + N_S5T_UNITS + N_ROPE_UNITS + N_TR;


__device__ __forceinline__ void transpose_block(const float* src, int N, int k0, int n0, bf16_t* dst, int ldd, int rmul, int radd, LAS float* tile  ) {
    const int tid = opaque_tid();
    f32x4 v[8];
#pragma unroll
    for (int i = 0; i < 8; ++i) v[i] = __builtin_nontemporal_load((const f32x4*)(src + (size_t)(k0 + (tid >> 6) + 8 * i) * N + n0 + (tid & 63) * 4));
#pragma unroll
    for (int i = 0; i < 8; ++i) { const int r = (tid >> 6) + 8 * i; *(LAS f32x4*)(tile + r * 260 + (((tid & 63) * 4) ^ (8 * (r >> 3)))) = v[i]; }
    __syncthreads();
#pragma unroll
    for (int i = 0; i < 4; ++i) { const int id = tid + 512 * i, n = id >> 3, kc = id & 7; float f[8];
#pragma unroll
        for (int j = 0; j < 8; ++j) f[j] = tile[(kc * 8 + j) * 260 + (n ^ (8 * kc))];
        u32x4 w; w.x = cvt_pk_bf16(f[0], f[1]); w.y = cvt_pk_bf16(f[2], f[3]); w.z = cvt_pk_bf16(f[4], f[5]); w.w = cvt_pk_bf16(f[6], f[7]);
        __builtin_nontemporal_store(w, (u32x4*)(dst + (size_t)((n0 + n) * rmul + radd) * ldd + k0 + kc * 8)); }
    __syncthreads();
}
constexpr int QB_EXP = T_EXP / 4, Q_GU = NE * 2 * QB_EXP, Q_LAYER = Q_GU + NE * QB_EXP, Q_TOTAL = 2 * Q_LAYER;
constexpr int CW_QHEAD = 4096, CW_DONE = 4160;
static_assert((CW_DONE + 64 * 32) * 4 <= (int)CTL_BYTES, "control words inside the memset region");
__device__ __forceinline__ void moe_convert_block(const Params& p, unsigned char* ws, int t, LAS float* tile) {
    const int l = t / Q_LAYER, r = t % Q_LAYER;
    if (r < Q_GU) { const int e = r / (2 * QB_EXP), rr = r % (2 * QB_EXP), up = rr / QB_EXP, q = rr % QB_EXP; const int le = l * NE + e;
        transpose_block((up ? p.in[I_WUP] : p.in[I_WGATE]) + (size_t)le * DM * FF, FF, (q >> 2) * 64, (q & 3) * 256, (bf16_t*)(ws + WS_WTGU) + (size_t)le * 2048 * DM, DM, 2, up, tile); }
    else { const int r2 = r - Q_GU, e = r2 / QB_EXP, q = r2 % QB_EXP; const int le = l * NE + e;
        transpose_block(p.in[I_WDOWN] + (size_t)le * FF * DM, DM, (q >> 3) * 64, (q & 7) * 256, (bf16_t*)(ws + WS_WTDN) + (size_t)le * DM * FF, FF, 1, 0, tile); }
}
#ifndef FILL_ON
#define FILL_ON 0
#endif
constexpr unsigned Q_BULK = 4;
__device__ __forceinline__ unsigned moe_claim(unsigned* ctl, int ph, int upto, int mode, unsigned target) {
    unsigned t = 0xffffffffu;
    const unsigned head = __hip_atomic_load(ctl + CW_QHEAD, __ATOMIC_RELAXED, __HIP_MEMORY_SCOPE_AGENT);
    const bool go = mode ? (head < (unsigned)upto) : (head < (unsigned)Q_TOTAL && __hip_atomic_load(ctl + CW_DONE + 64 * ph, __ATOMIC_RELAXED, __HIP_MEMORY_SCOPE_AGENT) < target);
    if (go) t = __hip_atomic_fetch_add(ctl + CW_QHEAD, mode ? Q_BULK : 1u, __ATOMIC_RELAXED, __HIP_MEMORY_SCOPE_AGENT);
    return t;
}
__device__ __forceinline__ void moe_pump(const Params& p, LAS unsigned char* lds, int ph, int upto, int mode, unsigned target = 0u, bool count_me = true) {
    unsigned char* ws = opaque_ptr(p.ws); unsigned* ctl = (unsigned*)(ws + WS_CTL);
    LAS float* tile = (LAS float*)lds; volatile LAS unsigned* slot = (volatile LAS unsigned*)(lds + LDS_MISC + 32);
    const int tid = opaque_tid(); const int nblk = mode ? (int)Q_BULK : 1;
    __syncthreads();
    if (tid == 0) { if (mode == 0 && count_me) (void)__hip_atomic_fetch_add(ctl + CW_DONE + 64 * ph, 1u, __ATOMIC_RELAXED, __HIP_MEMORY_SCOPE_AGENT); slot[0] = moe_claim(ctl, ph, upto, mode, target ? target : gridDim.x); }
    __syncthreads();
    for (;;) {
        const unsigned t = slot[0];
        if (t >= (unsigned)Q_TOTAL) break;
        unsigned nxt = 0u;
        if (tid == 0) nxt = moe_claim(ctl, ph, upto, mode, target ? target : gridDim.x);
#pragma unroll 1
        for (int k = 0; k < nblk; ++k) if ((int)t + k < Q_TOTAL) moe_convert_block(p, ws, (int)t + k, tile);
        if (tid == 0) slot[0] = nxt;
        __syncthreads();
    }
}
__device__ __forceinline__ void moe_fill(const Params& p, LAS unsigned char* lds, int ph) { if (FILL_ON) moe_pump(p, lds, ph, Q_TOTAL, 0); }
__device__ __forceinline__ void moe_mark_done(const Params& p, int ph) { if (threadIdx.x == 0) (void)__hip_atomic_fetch_add((unsigned*)(p.ws + WS_CTL) + CW_DONE + 64 * ph, 1u, __ATOMIC_RELAXED, __HIP_MEMORY_SCOPE_AGENT); }
__device__ __forceinline__ void moe_convert_while(const Params& p, LAS unsigned char* lds, int ph, unsigned ngemm) { moe_pump(p, lds, ph, Q_TOTAL, 0, ngemm, false); }
__device__ __forceinline__ void moe_require(const Params& p, LAS unsigned char* lds, int upto) { moe_pump(p, lds, 0, upto, 1); }

__device__ __forceinline__ void ph_prologue(const Params& p, LAS unsigned char* lds) {
    const int tid = opaque_tid(), lane = tid & 63, wave = tid >> 6;
    unsigned char* ws = opaque_ptr(p.ws);
    for (int it = blockIdx.x; it < N_PRO_ITEMS; it += gridDim.x) {
        if (it < N_ADA_UNITS) {
            const int l = it / 96, cb = it % 96;
            LAS float* sil = (LAS float*)lds;
            LAS float* red = (LAS float*)(lds + 40960);
            for (int i = tid; i < 5 * DM; i += 512) { const int r = i >> 11, k = i & (DM - 1); const float v = r < 4 ? p.in[I_C][r * DM + k] : p.in[I_CCTX][k]; sil[i] = silu_f(v); }
            __syncthreads();
            f32x2 acc[5];
#pragma unroll
            for (int r = 0; r < 5; ++r) acc[r] = (f32x2){0.f, 0.f};
            const float* W = p.in[I_WADA] + (size_t)l * DM * 12288 + cb * 128 + lane * 2;
            for (int k = wave * 256; k < wave * 256 + 256; k += 16) {
                f32x2 w[16];
#pragma unroll
                for (int j = 0; j < 16; ++j) w[j] = __builtin_nontemporal_load((const f32x2*)(W + (size_t)(k + j) * 12288));
#pragma unroll
                for (int j = 0; j < 16; ++j)
#pragma unroll
                    for (int r = 0; r < 5; ++r) acc[r] += sil[r * DM + k + j] * w[j];
            }
#pragma unroll
            for (int r = 0; r < 5; ++r) { red[(wave * 5 + r) * 128 + lane * 2] = acc[r].x; red[(wave * 5 + r) * 128 + lane * 2 + 1] = acc[r].y; }
            __syncthreads();
            float* mod = (float*)(ws + WS_MOD);
            for (int o = tid; o < 5 * 128; o += 512) { const int r = o >> 7, cc = o & 127; float sum = p.in[I_BADA][l * 12288 + cb * 128 + cc];
#pragma unroll
                for (int w8 = 0; w8 < 8; ++w8) sum += red[(w8 * 5 + r) * 128 + cc];
                mod[(size_t)(l * 5 + r) * 12288 + cb * 128 + cc] = sum; }
            __syncthreads();
        } else if (it < N_ADA_UNITS + N_S5T_UNITS) {
            const int lg = it - N_ADA_UNITS, l = lg >> 5, g = lg & 31;
            LAS f32x2* PWl = (LAS f32x2*)lds;
            LAS f32x2* BBl = (LAS f32x2*)(lds + 17408);
            LAS f32x2* Cl = (LAS f32x2*)(lds + 33792);
            LAS float* KZl = (LAS float*)(lds + 50176);
            for (int idx = tid; idx < 2 * 64 * 17; idx += 512) { const int z = idx / (64 * 17), n = (idx / 17) & 63, d = idx % 17; const int zgn = ((l * 2 + z) * 32 + g) * 64 + n;
                const float are = fminf(p.in[I_ARE][zgn], -1e-4f), aim = p.in[I_AIM][zgn]; const float dt = expf(p.in[I_LOGDT][zgn >> 6]);
                const double mag = exp((double)are * (double)dt * d); double sn, cs; sincos((double)aim * (double)dt * d, &sn, &cs);
                const f32x2 v = {(float)(mag * cs), (float)(mag * sn)}; PWl[idx] = v; if (d == 16) ((f32x2*)(ws + WS_A16))[zgn] = v; }
            for (int idx = tid; idx < 2 * 64 * 16; idx += 512) { const int z = idx >> 10, n = (idx >> 4) & 63, c = idx & 15; const int zgn = ((l * 2 + z) * 32 + g) * 64 + n;
                const float are = fminf(p.in[I_ARE][zgn], -1e-4f), aim = p.in[I_AIM][zgn]; const float dt = expf(p.in[I_LOGDT][zgn >> 6]);
                const double mag = exp((double)are * (double)dt); double sn, cs; sincos((double)aim * (double)dt, &sn, &cs);
                const float xr = (float)(mag * cs) - 1.0f, xi = (float)(mag * sn), den = 1.0f / (are * are + aim * aim);
                const float cr = (xr * are + xi * aim) * den, ci = (xi * are - xr * aim) * den;
                const float br = p.in[I_BRE][(size_t)zgn * 16 + c], bi = p.in[I_BIM][(size_t)zgn * 16 + c]; BBl[idx] = (f32x2){cr * br - ci * bi, cr * bi + ci * br}; }
            for (int idx = tid; idx < 2 * 16 * 64; idx += 512) { const int z = idx >> 10, cn = idx & 1023; const size_t src = ((size_t)((l * 2 + z) * 32 + g) * 16) * 64 + cn; Cl[idx] = (f32x2){p.in[I_CRE][src], p.in[I_CIM][src]}; }
            __syncthreads();
            { const int z = tid >> 8, d = (tid >> 4) & 15, c = tid & 15; float a16[16];
#pragma unroll
              for (int q = 0; q < 16; ++q) a16[q] = 0.f;
              for (int n = 0; n < 64; ++n) { const f32x2 pw = PWl[(z * 64 + n) * 17 + d], cm = Cl[(z * 16 + c) * 64 + n]; const float tr = cm.x * pw.x - cm.y * pw.y, ti = cm.x * pw.y + cm.y * pw.x;
#pragma unroll
                  for (int q = 0; q < 16; ++q) { const f32x2 bb = BBl[(z * 64 + n) * 16 + q]; a16[q] += tr * bb.x - ti * bb.y; } }
#pragma unroll
              for (int q = 0; q < 16; ++q) KZl[((z * 16 + d) * 16 + c) * 16 + q] = a16[q]; }
            __syncthreads();
            bf16_t* WST = (bf16_t*)(ws + WS_WST) + (size_t)lg * 256 * 256; bf16_t* G2B = (bf16_t*)(ws + WS_G2B) + (size_t)lg * 256 * 512;
            for (int i = 0; i < 16; ++i) { const int id = tid + 512 * i;
                {
                  const int c8 = (id & 1) * 8, pp = (id >> 1) & 15, row = id >> 5, z = row >> 7, ri = (row >> 6) & 1, n = row & 63;
                  const f32x2 pw = PWl[(z * 64 + n) * 17 + (z == 0 ? 15 - pp : pp)]; float f[8];
#pragma unroll
                  for (int j = 0; j < 8; ++j) { const f32x2 bb = BBl[(z * 64 + n) * 16 + c8 + j]; f[j] = ri == 0 ? (pw.x * bb.x - pw.y * bb.y) : (pw.x * bb.y + pw.y * bb.x); }
                  u32x4 w; w.x = cvt_pk_bf16(f[0], f[1]); w.y = cvt_pk_bf16(f[2], f[3]); w.z = cvt_pk_bf16(f[4], f[5]); w.w = cvt_pk_bf16(f[6], f[7]);
                  *(u32x4*)(WST + (size_t)row * 256 + pp * 16 + c8) = w; }
                {
                  const int n8 = (id & 7) * 8, ri = (id >> 3) & 1, z = (id >> 4) & 1, row = id >> 5, pp = row >> 4, c = row & 15; float f[8];
#pragma unroll
                  for (int j = 0; j < 8; ++j) { const f32x2 pw = PWl[(z * 64 + n8 + j) * 17 + (z == 0 ? pp + 1 : 16 - pp)], cm = Cl[(z * 16 + c) * 64 + n8 + j]; f[j] = ri == 0 ? (cm.x * pw.x - cm.y * pw.y) : -(cm.x * pw.y + cm.y * pw.x); }
                  u32x4 w; w.x = cvt_pk_bf16(f[0], f[1]); w.y = cvt_pk_bf16(f[2], f[3]); w.z = cvt_pk_bf16(f[4], f[5]); w.w = cvt_pk_bf16(f[6], f[7]);
                  *(u32x4*)(G2B + (size_t)row * 512 + 256 + z * 128 + ri * 64 + n8) = w; }
                {
                  const int c8 = (id & 1) * 8, pq = (id >> 1) & 15, row = id >> 5, pp = row >> 4, c = row & 15; float f[8];
#pragma unroll
                  for (int j = 0; j < 8; ++j) { float v = 0.f; if (pq <= pp) v += KZl[((0 * 16 + (pp - pq)) * 16 + c) * 16 + c8 + j]; if (pq >= pp) v += KZl[((1 * 16 + (pq - pp)) * 16 + c) * 16 + c8 + j];
                      if (pq == pp && c8 + j == c) v += p.in[I_S5D][l * 512 + g * 16 + c]; f[j] = v; }
                  u32x4 w; w.x = cvt_pk_bf16(f[0], f[1]); w.y = cvt_pk_bf16(f[2], f[3]); w.z = cvt_pk_bf16(f[4], f[5]); w.w = cvt_pk_bf16(f[6], f[7]);
                  *(u32x4*)(G2B + (size_t)row * 512 + pq * 16 + c8) = w; } }
            __syncthreads();
        } else if (it < N_ADA_UNITS + N_S5T_UNITS + N_ROPE_UNITS) {
            const int idx = (it - N_ADA_UNITS - N_S5T_UNITS) * 512 + tid; const int pos = idx >> 4, f = idx & 15;
            const float invf = powf(10000.0f, -(float)f * 0.0625f); const float ang = (float)pos * invf;
            ((f32x2*)(ws + WS_ROPE))[idx] = (f32x2){cosf(ang), sinf(ang)};
        } else {
            int t = it - N_ADA_UNITS - N_S5T_UNITS - N_ROPE_UNITS;
            LAS float* tile = (LAS float*)lds;
            if (t < 2 * T_WIN) { const int l = t / T_WIN, r = t % T_WIN; const float* src = p.in[I_WIN] + (size_t)l * DM * INC; bf16_t* dst = (bf16_t*)(ws + WS_WTIN) + (size_t)l * INP * DM;
                if (r < 448) transpose_block(src, INC, (r / 14) * 64, (r % 14) * 256, dst, DM, 1, 0, tile); else { const int q = r - 448; transpose_tile(src, INC, (q / 3) * 64, 3584 + (q % 3) * 64, dst, DM, 1, 0, 0, tile); }
                continue; }
            t -= 2 * T_WIN;
            if (t < 2 * T_WOUT) { const int l = t / T_WOUT, r = t % T_WOUT; transpose_block(p.in[I_WOUT] + (size_t)l * DM * DM, DM, (r >> 3) * 64, (r & 7) * 256, (bf16_t*)(ws + WS_WTOUT) + (size_t)l * DM * DM, DM, 1, 0, tile); continue; }
            t -= 2 * T_WOUT;
            if (t < 2 * T_WUQ) { const int l = t / T_WUQ, r = t % T_WUQ; transpose_tile(p.in[I_WUQ] + (size_t)l * 384 * 768, 768, (r % 6) * 64, (r / 6) * 64, (bf16_t*)(ws + WS_WTUQ) + (size_t)l * 768 * 384, 384, 1, 0, 0, tile); continue; }
            t -= 2 * T_WUQ;
            if (t < 2 * T_WUKV) { const int l = t / T_WUKV, r = t % T_WUKV; transpose_tile(p.in[I_WUKV] + (size_t)l * 256 * 1024, 1024, (r % 4) * 64, (r / 4) * 64, (bf16_t*)(ws + WS_WTUKV) + (size_t)l * 1024 * 256, 256, 1, 0, 1, tile); continue; }
            t -= 2 * T_WUKV;
            if (t < 2 * T_WGLU) { const int l = t / T_WGLU, r = t % T_WGLU; transpose_tile(p.in[I_WGLU] + (size_t)l * 512 * 512, 512, (r % 8) * 64, (r / 8) * 64, (bf16_t*)(ws + WS_WTGLU) + (size_t)l * 512 * 512, 512, 1, 0, 0, tile); continue; }
        }
    }
}

__device__ __forceinline__ void rms_mod_store(const f32x4 (&x)[8], const float* g, const float* scale, const float* shift, bf16_t* orow, f32x4 (&y)[8], int lane) {
    float ss = 0.f;
#pragma unroll
    for (int j = 0; j < 8; ++j) ss += x[j][0] * x[j][0] + x[j][1] * x[j][1] + x[j][2] * x[j][2] + x[j][3] * x[j][3];
    ss = wave_sum(ss);
    const float rinv = rsqrtf(ss * (1.0f / DM) + EPS);
#pragma unroll
    for (int j = 0; j < 8; ++j) { const int c = j * 256 + lane * 4;
        const f32x4 gv = *(const f32x4*)(g + c), sc = *(const f32x4*)(scale + c), sh = *(const f32x4*)(shift + c);
        y[j] = x[j] * rinv * gv * (1.0f + sc) + sh;
        u32x2 w; w.x = cvt_pk_bf16(y[j][0], y[j][1]); w.y = cvt_pk_bf16(y[j][2], y[j][3]); *(u32x2*)(orow + c) = w; }
}

constexpr int N1_ROWITEMS = MT / 8, N1_KZ = 64, N1_WST = 1024, N1_INTER = 1024;
__device__ __forceinline__ void ph_norm1_tables(const Params& p) {
    const int tid = opaque_tid(), lane = tid & 63, wave = tid >> 6;
    unsigned char* ws = opaque_ptr(p.ws);
    const float* mod = (const float*)(ws + WS_MOD);
    for (int it = blockIdx.x; it < N1_ROWITEMS; it += gridDim.x) {
        {
            const int row = it * 8 + wave; const int rr = row < NLAT ? (row >> 11) : 4;
            const float* xr = row < NLAT ? p.in[I_X] + (size_t)row * DM : p.in[I_CTX] + (size_t)(row - NLAT) * DM;
            f32x4 x[8], y[8];
#pragma unroll
            for (int j = 0; j < 8; ++j) x[j] = *(const f32x4*)(xr + j * 256 + lane * 4);
            const float* m = mod + (size_t)rr * 12288;
            rms_mod_store(x, p.in[I_N1G], m + DM, m, (bf16_t*)(ws + WS_H) + (size_t)row * DM, y, lane);
        }
    }
}

constexpr int B_ROWITEMS = MT / 8, B_SGU = 72 * 4, B_INTRA = 0;
__device__ __forceinline__ void ph_rowsplit(const Params& p, int l, LAS unsigned char* lds) {
    const int tid = opaque_tid(), lane = tid & 63, wave = tid >> 6;
    unsigned char* ws = opaque_ptr(p.ws);
    const bf16_t* P = (const bf16_t*)(ws + WS_PA);
    bf16_t* CAT = (bf16_t*)(ws + WS_CAT);
    const int nsgu = (l == 0) ? B_SGU : 256;
    const int G_ = (int)gridDim.x, c_ = (int)blockIdx.x, nx = nsgu > G_ ? nsgu - G_ : 0;
    const bool bal = nx > 0 && nx < G_ && nsgu <= 2 * G_;
    const int nfew = bal ? 2 * nx : 0;
    const int nmine = (c_ < nsgu ? 1 : 0) + (c_ < nx ? 1 : 0);
    int rit = bal ? (c_ < nx ? c_ : nfew + (c_ - nx)) : c_; const int rstride = bal ? (c_ < nx ? nx : G_ - nx) : G_; const int rend = bal ? (c_ < nx ? nfew : B_ROWITEMS) : B_ROWITEMS;
    for (int k = 0; ; ++k) {
        int it;
        if (k < nmine) it = B_ROWITEMS + c_ + k * G_;
        else { if (rit >= rend) break; it = rit; rit += rstride; }
        if (it < B_ROWITEMS) {
            const int row = it * 8 + wave; const bf16_t* pr = P + (size_t)row * INP;
            const bool lat = row < NLAT; const int t = lat ? (row & (SEQ - 1)) : ((row - NLAT) & (CTX - 1)); const int b = lat ? (row >> 11) : ((row - NLAT) >> 8);
            const int seqlen = lat ? SEQ : CTX;
            { float f[8]; float ss = 0.f;
              if (lane < 48) { const u32x4 v = *(const u32x4*)(pr + C_CQ + lane * 8); f[0] = bflo(v.x); f[1] = bfhi(v.x); f[2] = bflo(v.y); f[3] = bfhi(v.y); f[4] = bflo(v.z); f[5] = bfhi(v.z); f[6] = bflo(v.w); f[7] = bfhi(v.w);
#pragma unroll
                  for (int j = 0; j < 8; ++j) ss += f[j] * f[j]; }
              else {
#pragma unroll
                  for (int j = 0; j < 8; ++j) f[j] = 0.f; }
              ss = wave_sum(ss); const float rinv = rsqrtf(ss * (1.0f / 384.0f) + EPS);
              if (lane < 48) { const float* g = p.in[I_QNG] + l * 384 + lane * 8; u32x4 w;
                  w.x = cvt_pk_bf16(f[0] * rinv * g[0], f[1] * rinv * g[1]); w.y = cvt_pk_bf16(f[2] * rinv * g[2], f[3] * rinv * g[3]);
                  w.z = cvt_pk_bf16(f[4] * rinv * g[4], f[5] * rinv * g[5]); w.w = cvt_pk_bf16(f[6] * rinv * g[6], f[7] * rinv * g[7]);
                  *(u32x4*)((bf16_t*)(ws + WS_QA) + (size_t)row * 384 + lane * 8) = w; } }
            { const u32x2 v = *(const u32x2*)(pr + C_CKV + lane * 4); const float f0 = bflo(v.x), f1 = bfhi(v.x), f2 = bflo(v.y), f3 = bfhi(v.y);
              const float ss = wave_sum(f0 * f0 + f1 * f1 + f2 * f2 + f3 * f3); const float rinv = rsqrtf(ss * (1.0f / 256.0f) + EPS);
              const float* g = p.in[I_KVNG] + l * 256 + lane * 4; u32x2 w; w.x = cvt_pk_bf16(f0 * rinv * g[0], f1 * rinv * g[1]); w.y = cvt_pk_bf16(f2 * rinv * g[2], f3 * rinv * g[3]);
              *(u32x2*)((bf16_t*)(ws + WS_KVA) + (size_t)row * 256 + lane * 4) = w; }
            { float v = bf2f(pr[C_KR + lane]); const float partner = __shfl_xor(v, 16);
              if (lat) { const int jj = lane & 31, fi = jj & 15; const int pos = lane >= 32 ? (t & 63) : (t >> 6);
                  const f32x2 r = ((const f32x2*)(ws + WS_ROPE))[pos * 16 + fi]; const float cs = r.x, sn = r.y;
                  v = jj < 16 ? (v * cs - partner * sn) : (v * cs + partner * sn); }
              const int key = lat ? CTX + t : t; const unsigned short o = f2bf(v);
              bf16_t* kc = (bf16_t*)(ws + WS_KC);
#pragma unroll
              for (int h = 0; h < 4; ++h) kc[((size_t)(b * 4 + h) * NKEY + key) * 192 + 128 + lane] = o; }
            { const u32x4 v = *(const u32x4*)(pr + C_S5 + lane * 8); const int g = lane >> 1, half = lane & 1;
              *(u32x4*)((bf16_t*)(ws + WS_UPK) + ((size_t)g * 768 + (row >> 4)) * 512 + (row & 15) * 16 + half * 8) = v; }
            { const int c0 = lane * 8; float zp[8], zc[8], zn[8];
#pragma unroll
              for (int j = 0; j < 8; ++j) { zp[j] = 0.f; zn[j] = 0.f; }
#define CONV_Z(dst, rp) do { const u32x4 a_ = *(const u32x4*)((rp) + C_CVC + c0); const u32x4 h_ = *(const u32x4*)((rp) + C_CVH + c0); \
                  dst[0] = bflo(a_.x) * bflo(h_.x); dst[1] = bfhi(a_.x) * bfhi(h_.x); dst[2] = bflo(a_.y) * bflo(h_.y); dst[3] = bfhi(a_.y) * bfhi(h_.y); \
                  dst[4] = bflo(a_.z) * bflo(h_.z); dst[5] = bfhi(a_.z) * bfhi(h_.z); dst[6] = bflo(a_.w) * bflo(h_.w); dst[7] = bfhi(a_.w) * bfhi(h_.w); } while (0)
              CONV_Z(zc, pr);
              if (t > 0) CONV_Z(zp, pr - INP);
              if (t < seqlen - 1) CONV_Z(zn, pr + INP);
#undef CONV_Z
              const u32x4 bg = *(const u32x4*)(pr + C_CVB + c0); float bgf[8] = {bflo(bg.x), bfhi(bg.x), bflo(bg.y), bfhi(bg.y), bflo(bg.z), bfhi(bg.z), bflo(bg.w), bfhi(bg.w)};
              const float* cw = p.in[I_CONVW] + (size_t)l * 3 * 512 + c0; float o[8];
#pragma unroll
              for (int j = 0; j < 8; ++j) o[j] = bgf[j] * (cw[j] * zp[j] + cw[512 + j] * zc[j] + cw[1024 + j] * zn[j]);
              u32x4 w; w.x = cvt_pk_bf16(o[0], o[1]); w.y = cvt_pk_bf16(o[2], o[3]); w.z = cvt_pk_bf16(o[4], o[5]); w.w = cvt_pk_bf16(o[6], o[7]);
              *(u32x4*)(CAT + (size_t)row * DM + 1536 + c0) = w; }
        } else if (it < B_ROWITEMS + B_SGU) {
            const int un = it - B_ROWITEMS, cc = un >> 2, h = un & 3; const int row0 = cc * 128;
            LAS bf16_t* Wl = (LAS bf16_t*)lds;
            LAS bf16_t* Vl = (LAS bf16_t*)(lds + 128 * 136 * 2);
            const float* Wg = p.in[I_SGUW] + ((size_t)l * 4 + h) * 128 * 128;
#pragma unroll
            for (int i = 0; i < 8; ++i) { const int e4 = (i * 512 + tid) * 4, r = e4 >> 7, c = e4 & 127; const f32x4 v = *(const f32x4*)(Wg + e4);
                u32x2 w; w.x = cvt_pk_bf16(v[0], v[1]); w.y = cvt_pk_bf16(v[2], v[3]); *(LAS u32x2*)(Wl + r * 136 + c) = w; }
            u32x4 vv[16];
#pragma unroll
            for (int qi = 0; qi < 16; ++qi) vv[qi] = *(const u32x4*)(P + (size_t)(row0 + wave * 16 + qi) * INP + C_SGU_V + lane * 8);
#pragma unroll
            for (int qi = 0; qi < 16; ++qi) { const int q = wave * 16 + qi;
                const u32x4 v = vv[qi]; float f[8] = {bflo(v.x), bfhi(v.x), bflo(v.y), bfhi(v.y), bflo(v.z), bfhi(v.z), bflo(v.w), bfhi(v.w)}; float ss = 0.f;
#pragma unroll
                for (int j = 0; j < 8; ++j) { f[j] = gelu_tanh(f[j]); ss += f[j] * f[j]; }
                ss = wave_sum(ss); const float rinv = rsqrtf(ss * (1.0f / 512.0f) + EPS);
                if ((lane >> 4) == h) { const int c0 = (lane & 15) * 8; const float* g = p.in[I_SGUNG] + l * 512 + h * 128 + c0;
#pragma unroll
                    for (int j = 0; j < 8; ++j) Vl[(c0 + j) * 136 + q] = f2bf(f[j] * rinv * g[j]); } }
            __syncthreads();
            { const int fr = lane & 15, fq = lane >> 4; f32x4 acc[8];
#pragma unroll
              for (int nb = 0; nb < 8; ++nb) acc[nb] = (f32x4){0.f, 0.f, 0.f, 0.f};
#pragma unroll
              for (int ks = 0; ks < 4; ++ks) { const bf16x8 af = *(const LAS bf16x8*)(Wl + (wave * 16 + fr) * 136 + ks * 32 + fq * 8);
#pragma unroll
                  for (int nb = 0; nb < 8; ++nb) { const bf16x8 bfr = *(const LAS bf16x8*)(Vl + (nb * 16 + fr) * 136 + ks * 32 + fq * 8);
                      acc[nb] = __builtin_amdgcn_mfma_f32_16x16x32_bf16(bfr, af, acc[nb], 0, 0, 0); } }
              const int pp = wave * 16 + fr; const float bias = p.in[I_SGUB][((size_t)l * 4 + h) * 128 + pp]; const bf16_t* pr = P + (size_t)(row0 + pp) * INP + C_SGU_U + h * 128;
#pragma unroll
              for (int nb = 0; nb < 8; ++nb) { const int c = nb * 16 + 4 * fq; const u32x2 uv = *(const u32x2*)(pr + c);
                  u32x2 w; w.x = cvt_pk_bf16(gelu_tanh(bflo(uv.x)) * (acc[nb][0] + bias), gelu_tanh(bfhi(uv.x)) * (acc[nb][1] + bias));
                  w.y = cvt_pk_bf16(gelu_tanh(bflo(uv.y)) * (acc[nb][2] + bias), gelu_tanh(bfhi(uv.y)) * (acc[nb][3] + bias));
                  *(u32x2*)(CAT + (size_t)(row0 + pp) * DM + h * 128 + c) = w; } }
            __syncthreads();
        }
    }
}

constexpr int KPITCH = 400, VPITCH = 144;
constexpr int KT_BYTES = 64 * KPITCH, VT_BYTES = 128 * VPITCH;
__device__ __forceinline__ void attn_unit(const bf16_t* Qrows  , const bf16_t* Kbh, const bf16_t* Vbh, int nkeys, bf16_t* Orows, LAS unsigned char* lds) {
    const int tid = opaque_tid(), lane = tid & 63, wave = tid >> 6, l32 = lane & 31, hi = lane >> 5, qg = wave & 3, kh = wave >> 2;
    constexpr int VRING = 3 * KT_BYTES;
    bf16x8 qf[12];
    { const bf16_t* qr = Qrows + (size_t)(qg * 32 + l32) * 768 + hi * 8;
#pragma unroll
      for (int ks = 0; ks < 12; ++ks) qf[ks] = *(const bf16x8*)(qr + ks * 16); }
    f32x16 o[4];
#pragma unroll
    for (int db = 0; db < 4; ++db)
#pragma unroll
        for (int r = 0; r < 16; ++r) o[db][r] = 0.f;
    float mrow = -1e30f, lsum = 0.f;
    const int nt = nkeys / 64;
    const int wv = __builtin_amdgcn_readfirstlane(wave);
    unsigned doffK[4], doffV[3];
#pragma unroll
    for (int i = 0; i < 4; ++i) { const int pc = (wv + 8 * i) < 25 ? (wv + 8 * i) : 24; const int X = pc * 1024 + lane * 16, row = X / KPITCH, col = X % KPITCH; doffK[i] = (unsigned)(row * 384 + (col < 384 ? col : 0)); }
#pragma unroll
    for (int i = 0; i < 3; ++i) { const int pc = (wv + 8 * i) < 18 ? (wv + 8 * i) : 17; const int Y = pc * 1024 + lane * 16, row = Y / VPITCH, col = Y % VPITCH; doffV[i] = (unsigned)(row * (NKEY * 2) + (col < 128 ? col : 0)); }
#define ATT_DMAK(tile, slot) do { _Pragma("unroll") for (int i = 0; i < 4; ++i) { const int pc = (wv + 8 * i) < 25 ? (wv + 8 * i) : 24; \
        __builtin_amdgcn_global_load_lds((const unsigned*)((const char*)Kbh + (size_t)(tile) * (64 * 384) + doffK[i]), (LAS unsigned*)(lds + (slot) * KT_BYTES + pc * 1024), 16, 0, 0); } } while (0)
#define ATT_DMAV(tile, slot) do { _Pragma("unroll") for (int i = 0; i < 3; ++i) { const int pc = (wv + 8 * i) < 18 ? (wv + 8 * i) : 17; \
        __builtin_amdgcn_global_load_lds((const unsigned*)((const char*)Vbh + (size_t)(tile) * 128 + doffV[i]), (LAS unsigned*)(lds + VRING + (slot) * VT_BYTES + pc * 1024), 16, 0, 0); } } while (0)
#define ATT_STEP(S, SN, QK, ks_, vs_) do { \
        float mx = S[0]; \
        _Pragma("unroll") for (int r = 1; r < 16; ++r) mx = fmaxf(mx, S[r]); \
        mx = fmaxf(mx, __shfl_xor(mx, 32)); \
        if (__any(mx > mrow + 8.0f)) { const float mnew = fmaxf(mrow, mx), alpha = __builtin_amdgcn_exp2f(mrow - mnew); mrow = mnew; lsum *= alpha; \
            _Pragma("unroll") for (int db = 0; db < 4; ++db) _Pragma("unroll") for (int r = 0; r < 16; ++r) o[db][r] *= alpha; } \
        __builtin_amdgcn_sched_barrier(0); \
        const LAS unsigned char* Vcur = lds + VRING + (vs_) * VT_BYTES; \
        u32x4 vf0[4], vf1[4]; \
        float ps = 0.f; u32x4 pw0, pw1; \
        if (QK) { const LAS unsigned char* kp = lds + (ks_) * KT_BYTES + (kh * 32 + l32) * KPITCH + hi * 16; \
            bf16x8 kf[12]; \
            _Pragma("unroll") for (int i = 0; i < 12; ++i) kf[i] = *(const LAS bf16x8*)(kp + i * 32); \
            _Pragma("unroll") for (int r = 0; r < 16; ++r) SN[r] = 0.f; \
            __builtin_amdgcn_sched_barrier(0); \
              \
            _Pragma("unroll") for (int i = 0; i < 12; ++i) { \
                SN = __builtin_amdgcn_mfma_f32_32x32x16_bf16(kf[i], qf[i], SN, 0, 0, 0); \
                S[i] = __builtin_amdgcn_exp2f(S[i] - mrow); ps += S[i]; \
                if (i < 4) { S[12 + i] = __builtin_amdgcn_exp2f(S[12 + i] - mrow); ps += S[12 + i]; } \
                if (i == 1) pw0.x = cvt_pk_bf16(S[0], S[1]); if (i == 3) { pw0.y = cvt_pk_bf16(S[2], S[3]); pw1.z = cvt_pk_bf16(S[12], S[13]); pw1.w = cvt_pk_bf16(S[14], S[15]); } \
                if (i == 5) pw0.z = cvt_pk_bf16(S[4], S[5]); if (i == 7) pw0.w = cvt_pk_bf16(S[6], S[7]); if (i == 9) pw1.x = cvt_pk_bf16(S[8], S[9]); if (i == 11) pw1.y = cvt_pk_bf16(S[10], S[11]); \
                if (i >= 8) { const int db = i - 8; const LAS unsigned char* vp = Vcur + (db * 32 + l32) * VPITCH + kh * 64 + hi * 16; \
                    vf0[db] = *(const LAS u32x4*)vp; vf1[db] = *(const LAS u32x4*)(vp + 32); } \
                __builtin_amdgcn_sched_barrier(0); } \
        } else { \
            _Pragma("unroll") for (int db = 0; db < 4; ++db) { const LAS unsigned char* vp = Vcur + (db * 32 + l32) * VPITCH + kh * 64 + hi * 16; \
                vf0[db] = *(const LAS u32x4*)vp; vf1[db] = *(const LAS u32x4*)(vp + 32); } \
            _Pragma("unroll") for (int r = 0; r < 16; ++r) { S[r] = __builtin_amdgcn_exp2f(S[r] - mrow); ps += S[r]; } \
            pw0.x = cvt_pk_bf16(S[0], S[1]); pw0.y = cvt_pk_bf16(S[2], S[3]); pw0.z = cvt_pk_bf16(S[4], S[5]); pw0.w = cvt_pk_bf16(S[6], S[7]); \
            pw1.x = cvt_pk_bf16(S[8], S[9]); pw1.y = cvt_pk_bf16(S[10], S[11]); pw1.z = cvt_pk_bf16(S[12], S[13]); pw1.w = cvt_pk_bf16(S[14], S[15]); } \
        lsum += ps; \
        { const bf16x8 pf = __builtin_bit_cast(bf16x8, pw0); \
          _Pragma("unroll") for (int db = 0; db < 4; ++db) o[db] = __builtin_amdgcn_mfma_f32_32x32x16_bf16(__builtin_bit_cast(bf16x8, vf0[db]), pf, o[db], 0, 0, 0); } \
        { const bf16x8 pf = __builtin_bit_cast(bf16x8, pw1); \
          _Pragma("unroll") for (int db = 0; db < 4; ++db) o[db] = __builtin_amdgcn_mfma_f32_32x32x16_bf16(__builtin_bit_cast(bf16x8, vf1[db]), pf, o[db], 0, 0, 0); } \
        __builtin_amdgcn_sched_barrier(0); } while (0)
#define ATT_SYNC(full) do { if (full) asm volatile("s_waitcnt vmcnt(7)" ::: "memory"); else asm volatile("s_waitcnt vmcnt(0)" ::: "memory"); \
        __builtin_amdgcn_s_barrier(); asm volatile("" ::: "memory"); } while (0)
    ATT_DMAK(0, 0); ATT_DMAV(0, 0); ATT_DMAK(1, 1); ATT_DMAV(1, 1); if (nt > 2) ATT_DMAK(2, 2);
    asm volatile("s_waitcnt vmcnt(0)" ::: "memory");
    __builtin_amdgcn_s_barrier(); asm volatile("" ::: "memory");
    f32x16 sA, sB;
    { const LAS unsigned char* kp = lds + (kh * 32 + l32) * KPITCH + hi * 16;
#pragma unroll
      for (int r = 0; r < 16; ++r) sA[r] = 0.f;
#pragma unroll
      for (int i = 0; i < 12; ++i) { const bf16x8 kf = *(const LAS bf16x8*)(kp + i * 32); sA = __builtin_amdgcn_mfma_f32_32x32x16_bf16(kf, qf[i], sA, 0, 0, 0); } }
    int k1 = 1, v0 = 0;
    int j = 0;
    for (; j + 2 < nt; j += 2) {
        ATT_SYNC(true);
        if (j + 3 < nt) ATT_DMAK(j + 3, v0);
        ATT_DMAV(j + 2, v0 == 0 ? 2 : v0 - 1);
        ATT_STEP(sA, sB, true, k1, v0);
        k1 = k1 == 2 ? 0 : k1 + 1; v0 = v0 == 2 ? 0 : v0 + 1;
        ATT_SYNC(j + 3 < nt);
        if (j + 4 < nt) ATT_DMAK(j + 4, v0);
        if (j + 3 < nt) ATT_DMAV(j + 3, v0 == 0 ? 2 : v0 - 1);
        ATT_STEP(sB, sA, true, k1, v0);
        k1 = k1 == 2 ? 0 : k1 + 1; v0 = v0 == 2 ? 0 : v0 + 1;
    }
    ATT_SYNC(false);
    ATT_STEP(sA, sB, true, k1, v0);
    k1 = k1 == 2 ? 0 : k1 + 1; v0 = v0 == 2 ? 0 : v0 + 1;
    ATT_SYNC(false);
    ATT_STEP(sB, sA, false, k1, v0);
#undef ATT_STEP
#undef ATT_SYNC
#undef ATT_DMAK
#undef ATT_DMAV
    __syncthreads();
    lsum += __shfl_xor(lsum, 32);
    LAS float* mb = (LAS float*)lds + (size_t)qg * 66 * 64 + lane;
    if (kh == 1) {
#pragma unroll
        for (int db = 0; db < 4; ++db)
#pragma unroll
            for (int r = 0; r < 16; ++r) mb[(db * 16 + r) * 64] = o[db][r];
        mb[64 * 64] = mrow; mb[65 * 64] = lsum;
    }
    __syncthreads();
    if (kh == 0) {
        const float m1 = mb[64 * 64], l1 = mb[65 * 64];
        const float m = fmaxf(mrow, m1), e0 = __builtin_amdgcn_exp2f(mrow - m), e1 = __builtin_amdgcn_exp2f(m1 - m);
        const float inv = 1.0f / (lsum * e0 + l1 * e1), c0 = e0 * inv, c1 = e1 * inv;
        bf16_t* orow = Orows + (size_t)(qg * 32 + l32) * DM;
#pragma unroll
        for (int db = 0; db < 4; ++db)
#pragma unroll
            for (int k4 = 0; k4 < 4; ++k4) { float v[4];
#pragma unroll
                for (int i = 0; i < 4; ++i) v[i] = o[db][4 * k4 + i] * c0 + mb[(db * 16 + 4 * k4 + i) * 64] * c1;
                u32x2 w; w.x = cvt_pk_bf16(v[0], v[1]); w.y = cvt_pk_bf16(v[2], v[3]);
                *(u32x2*)(orow + db * 32 + 8 * k4 + 4 * hi) = w; }
    }
    __syncthreads();
}
__device__ __forceinline__ void ph_attn_carry(const Params& p, int l, LAS unsigned char* lds) {
    unsigned char* ws = opaque_ptr(p.ws); const int tid = opaque_tid();
    const int natt = (l == 0) ? 288 : 256;
    const bf16_t* QB = (const bf16_t*)(ws + WS_QB); const bf16_t* KC = (const bf16_t*)(ws + WS_KC); const bf16_t* VT = (const bf16_t*)(ws + WS_VT); bf16_t* CAT = (bf16_t*)(ws + WS_CAT);
    for (int it = blockIdx.x; it < natt; it += gridDim.x) {
        {
            int b, h, row0, nkeys;
            if (it < 256) { const int x = it & 7, jj = it >> 3, bh = 2 * x + (jj >> 4); b = bh >> 2; h = bh & 3; row0 = b * SEQ + (jj & 15) * 128; nkeys = NKEY; }
            else { const int u = it - 256; b = u >> 3; h = (u >> 1) & 3; row0 = NLAT + b * CTX + (u & 1) * 128; nkeys = CTX; }
            attn_unit(QB + (size_t)row0 * 768 + h * 192, KC + (size_t)(b * 4 + h) * NKEY * 192, VT + (size_t)(b * 4 + h) * 128 * NKEY, nkeys, CAT + (size_t)row0 * DM + 512 + h * 128, lds);
        }
    }
    for (int it = natt + (int)((blockIdx.x + gridDim.x - natt % gridDim.x) % gridDim.x); it < natt + 256; it += gridDim.x) {
        {
            const int u = it - natt; const int z = u >> 7, b = (u >> 5) & 3, g = u & 31, lane = tid & 63, w = tid >> 6;
            const f32x2 a16 = ((const f32x2*)(ws + WS_A16))[(((size_t)l * 2 + z) * 32 + g) * 64 + lane];
            const float* EST = (const float*)(ws + WS_EST) + (size_t)g * 768 * 256 + z * 128 + lane;
            bf16_t* UP = (bf16_t*)(ws + WS_UPK) + (size_t)g * 768 * 512 + 256 + z * 128 + lane;
            LAS f32x2* seg = (LAS f32x2*)lds;
            float er[18], ei[18];
#pragma unroll
            for (int i = 0; i < 18; ++i) { const int st = w * 18 + i; int chunk;
                if (z == 0) chunk = st < 16 ? (512 + b * 16 + st) : (b * 128 + (st - 16)); else chunk = st < 16 ? (512 + b * 16 + (15 - st)) : (b * 128 + (143 - st));
                er[i] = EST[(size_t)chunk * 256]; ei[i] = EST[(size_t)chunk * 256 + 64]; }
            float sr = 0.f, si = 0.f;
#pragma unroll
            for (int i = 0; i < 18; ++i) { const float nr = a16.x * sr - a16.y * si + er[i], ni = a16.x * si + a16.y * sr + ei[i]; sr = nr; si = ni; }
            seg[w * 64 + lane] = (f32x2){sr, si};
            float pr = 1.f, pi = 0.f;
#pragma unroll
            for (int i = 0; i < 18; ++i) { const float nr = pr * a16.x - pi * a16.y, ni = pr * a16.y + pi * a16.x; pr = nr; pi = ni; }
            __syncthreads();
            sr = 0.f; si = 0.f;
            for (int w2 = 0; w2 < w; ++w2) { const f32x2 sv = seg[w2 * 64 + lane]; const float nr = pr * sr - pi * si + sv.x, ni = pr * si + pi * sr + sv.y; sr = nr; si = ni; }
#pragma unroll
            for (int i = 0; i < 18; ++i) { const int st = w * 18 + i; int chunk;
                if (z == 0) chunk = st < 16 ? (512 + b * 16 + st) : (b * 128 + (st - 16)); else chunk = st < 16 ? (512 + b * 16 + (15 - st)) : (b * 128 + (143 - st));
                UP[(size_t)chunk * 512] = f2bf(sr); UP[(size_t)chunk * 512 + 64] = f2bf(si);
                const float nr = a16.x * sr - a16.y * si + er[i], ni = a16.x * si + a16.y * sr + ei[i]; sr = nr; si = ni; }
            __syncthreads();
        }
    }
}

__device__ __forceinline__ void ph_norm2_router(const Params& p, int l, LAS unsigned char* lds) {
    const int tid = opaque_tid(), lane = tid & 63, wave = tid >> 6;
    unsigned char* ws = opaque_ptr(p.ws); const float* mod = (const float*)(ws + WS_MOD) + (size_t)l * 5 * 12288;
    const int nrows = (l == 0) ? MT : NLAT;
    const float* WR = p.in[I_WROUTER] + (size_t)l * DM * NE;
    for (int idx = tid; idx < DM * 4; idx += 512) { const int c = idx & (DM - 1), e4 = idx >> 11; const f32x4 v = *(const f32x4*)(WR + (size_t)c * NE + e4 * 4);
        *(LAS f32x4*)(lds + (size_t)(((e4 * 8 + (c & 7)) * 256 + (c >> 3)) * 16)) = v; }
    __syncthreads();
    const float* n2g = p.in[I_N2G] + l * DM;
    for (int it = blockIdx.x; it < nrows / 8; it += gridDim.x) {
        const int row = it * 8 + wave; const int rr = row < NLAT ? (row >> 11) : 4;
        const bf16_t* xr = (const bf16_t*)(ws + WS_XB) + (size_t)row * DM + lane * 8;
        const float* m = mod + (size_t)rr * 12288 + lane * 8; const float* gp = n2g + lane * 8;
        u32x4 xv[4];
#pragma unroll
        for (int j = 0; j < 4; ++j) xv[j] = *(const u32x4*)(xr + j * 512);
        float x[4][8]; float ss = 0.f;
#pragma unroll
        for (int j = 0; j < 4; ++j) { x[j][0] = bflo(xv[j].x); x[j][1] = bfhi(xv[j].x); x[j][2] = bflo(xv[j].y); x[j][3] = bfhi(xv[j].y); x[j][4] = bflo(xv[j].z); x[j][5] = bfhi(xv[j].z); x[j][6] = bflo(xv[j].w); x[j][7] = bfhi(xv[j].w);
#pragma unroll
            for (int i = 0; i < 8; ++i) ss += x[j][i] * x[j][i]; }
        ss = wave_sum(ss); const float rinv = rsqrtf(ss * (1.0f / DM) + EPS);
        bf16_t* orow = (bf16_t*)(ws + WS_H) + (size_t)row * DM + lane * 8;
        f32x4 lg[4];
#pragma unroll
        for (int e4 = 0; e4 < 4; ++e4) lg[e4] = (f32x4){0.f, 0.f, 0.f, 0.f};
#pragma unroll
        for (int j = 0; j < 4; ++j) {
            const f32x4 ga = *(const f32x4*)(gp + j * 512), gb = *(const f32x4*)(gp + j * 512 + 4), sa = *(const f32x4*)(m + 4 * DM + j * 512), sb = *(const f32x4*)(m + 4 * DM + j * 512 + 4),
                        ha = *(const f32x4*)(m + 3 * DM + j * 512), hb = *(const f32x4*)(m + 3 * DM + j * 512 + 4);
            float y[8];
#pragma unroll
            for (int i = 0; i < 8; ++i) y[i] = x[j][i] * rinv * (i < 4 ? ga[i] : gb[i - 4]) * (1.0f + (i < 4 ? sa[i] : sb[i - 4])) + (i < 4 ? ha[i] : hb[i - 4]);
            u32x4 h; h.x = cvt_pk_bf16(y[0], y[1]); h.y = cvt_pk_bf16(y[2], y[3]); h.z = cvt_pk_bf16(y[4], y[5]); h.w = cvt_pk_bf16(y[6], y[7]);
            *(u32x4*)(orow + j * 512) = h;
#pragma unroll
            for (int i2 = 0; i2 < 8; i2 += 2) {
#pragma unroll
                for (int e4 = 0; e4 < 4; ++e4) { const f32x4 w0 = *(const LAS f32x4*)(lds + (size_t)(((e4 * 8 + i2) * 256 + j * 64 + lane) * 16)); const f32x4 w1 = *(const LAS f32x4*)(lds + (size_t)(((e4 * 8 + i2 + 1) * 256 + j * 64 + lane) * 16));
                    lg[e4] += y[i2] * w0 + y[i2 + 1] * w1; }
                __builtin_amdgcn_sched_barrier(0); } }
        float v8[8], v4[4], v2[2], v1;
#pragma unroll
        for (int e = 0; e < 8; ++e) { const float lo = lg[e >> 2][e & 3], hi_ = lg[(e + 8) >> 2][e & 3]; const float snd = (lane & 32) ? lo : hi_, kp = (lane & 32) ? hi_ : lo; v8[e] = kp + __shfl_xor(snd, 32); }
#pragma unroll
        for (int e = 0; e < 4; ++e) { const float snd = (lane & 16) ? v8[e] : v8[e + 4], kp = (lane & 16) ? v8[e + 4] : v8[e]; v4[e] = kp + __shfl_xor(snd, 16); }
#pragma unroll
        for (int e = 0; e < 2; ++e) { const float snd = (lane & 8) ? v4[e] : v4[e + 2], kp = (lane & 8) ? v4[e + 2] : v4[e]; v2[e] = kp + __shfl_xor(snd, 8); }
        { const float snd = (lane & 4) ? v2[0] : v2[1], kp = (lane & 4) ? v2[1] : v2[0]; v1 = kp + __shfl_xor(snd, 4); }
        v1 += __shfl_xor(v1, 1); v1 += __shfl_xor(v1, 2);
        float mx = v1; mx = fmaxf(mx, __shfl_xor(mx, 4)); mx = fmaxf(mx, __shfl_xor(mx, 8)); mx = fmaxf(mx, __shfl_xor(mx, 16)); mx = fmaxf(mx, __shfl_xor(mx, 32));
        const float ex = __expf(v1 - mx); float se = ex; se += __shfl_xor(se, 4); se += __shfl_xor(se, 8); se += __shfl_xor(se, 16); se += __shfl_xor(se, 32);
        if ((lane & 3) == 0) ((float*)(ws + WS_AFF))[(size_t)row * 16 + (lane >> 2)] = ex / se;
    }
}

__device__ __forceinline__ void ph_topk(const Params& p, int l, LAS unsigned char* lds) {
    const int tid = opaque_tid(), lane = tid & 63, wave = tid >> 6;
    unsigned char* ws = opaque_ptr(p.ws); const float* AFF = (const float*)(ws + WS_AFF);
    int* ROWTOK = (int*)(ws + WS_ROWTOK); float* ROWAFF = (float*)(ws + WS_ROWAFF); int* INV = (int*)(ws + WS_INV);
    LAS int* hist = (LAS int*)lds;
    LAS int* ctl = (LAS int*)(lds + 1024);
    LAS int* wsum = (LAS int*)(lds + 1280);
    const int nunits = (l == 0) ? 128 : 64;
    for (int it = blockIdx.x; it < nunits; it += gridDim.x) {
        const bool lat = it < 64; const int u = lat ? it : it - 64; const int b = u >> 4, e = u & 15;
        const int n = lat ? SEQ : CTX, cap = lat ? CAPL : CAPC;
        const int tok0 = lat ? b * SEQ : NLAT + b * CTX; const int rowbase = lat ? b * CAPL : 1024 + b * CAPC;
        unsigned key[4];
#pragma unroll
        for (int j = 0; j < 4; ++j) { const int t = tid * 4 + j; key[j] = t < n ? __float_as_uint(AFF[(size_t)(tok0 + t) * 16 + e]) : 0u; }
        unsigned prefix = 0u; int remaining = cap;
        for (int pass = 3; pass >= 0; --pass) {
            if (tid < 256) hist[tid] = 0;
            __syncthreads();
#pragma unroll
            for (int j = 0; j < 4; ++j) { const int t = tid * 4 + j; if (t < n) { const bool match = (pass == 3) || ((key[j] >> (8 * (pass + 1))) == (prefix >> (8 * (pass + 1)))); if (match) atomicAdd((int*)&hist[(key[j] >> (8 * pass)) & 255u], 1); } }
            __syncthreads();
            if (wave == 0) {
                const int b0 = hist[4 * lane], b1 = hist[4 * lane + 1], b2 = hist[4 * lane + 2], b3 = hist[4 * lane + 3];
                const int s = b0 + b1 + b2 + b3; int suf = s;
#pragma unroll
                for (int off = 1; off < 64; off <<= 1) { const int t = __shfl_down(suf, off); if (lane + off < 64) suf += t; }
                const int above = suf - s; const int c3 = above + b3, c2 = c3 + b2, c1 = c2 + b1, c0 = c1 + b0;
                if (above < remaining && c0 >= remaining) { int dg, nr;
                    if (c3 >= remaining) { dg = 4 * lane + 3; nr = remaining - above; } else if (c2 >= remaining) { dg = 4 * lane + 2; nr = remaining - c3; }
                    else if (c1 >= remaining) { dg = 4 * lane + 1; nr = remaining - c2; } else { dg = 4 * lane; nr = remaining - c1; }
                    ctl[0] = dg; ctl[1] = nr; }
            }
            __syncthreads();
            prefix |= ((unsigned)ctl[0]) << (8 * pass); remaining = ctl[1];
            __syncthreads();
        }
        int cgt = 0, ceq = 0;
#pragma unroll
        for (int j = 0; j < 4; ++j) { const int t = tid * 4 + j; if (t < n) { cgt += key[j] > prefix ? 1 : 0; ceq += key[j] == prefix ? 1 : 0; } }
        const int packed = cgt | (ceq << 16);
        int inc = packed;
#pragma unroll
        for (int off = 1; off < 64; off <<= 1) { const int t = __shfl_up(inc, off); if (lane >= off) inc += t; }
        if (lane == 63) wsum[wave] = inc;
        __syncthreads();
        int base = 0;
#pragma unroll
        for (int w8 = 0; w8 < 8; ++w8) base += (w8 < wave) ? wsum[w8] : 0;
        int excl = base + inc - packed; int egt = excl & 0xffff, eeq = excl >> 16;
#pragma unroll
        for (int j = 0; j < 4; ++j) { const int t = tid * 4 + j; if (t < n) {
                const bool gt = key[j] > prefix, eq = key[j] == prefix; const bool sel = gt || (eq && eeq < remaining);
                const int slot = egt + (eeq < remaining ? eeq : remaining);
                if (sel) { ROWTOK[e * EROWS + rowbase + slot] = tok0 + t; ROWAFF[e * EROWS + rowbase + slot] = __uint_as_float(key[j]); }
                INV[(size_t)(tok0 + t) * 16 + e] = sel ? rowbase + slot : -1;
                egt += gt ? 1 : 0; eeq += eq ? 1 : 0; } }
        __syncthreads();
    }
}

__device__ __forceinline__ void ph_gather(const Params& p, int l) {
    const int tid = opaque_tid(), lane = tid & 63, wave = tid >> 6;
    unsigned char* ws = opaque_ptr(p.ws); const int* ROWTOK = (const int*)(ws + WS_ROWTOK);
    const int rows_per_e = (l == 0) ? 1152 : 1024;
    const int nitems = NE * rows_per_e / 8;
    for (int it = blockIdx.x; it < nitems; it += gridDim.x) {
        const int ridx = it * 8 + wave; const int e = ridx / rows_per_e, r = ridx % rows_per_e;
        const int tok = ROWTOK[e * EROWS + r];
        const u32x4* src = (const u32x4*)((const bf16_t*)(ws + WS_H) + (size_t)tok * DM); u32x4* dst = (u32x4*)((bf16_t*)(ws + WS_PA) + ((size_t)e * EROWS + r) * DM);
#pragma unroll
        for (int j = 0; j < 4; ++j) dst[j * 64 + lane] = src[j * 64 + lane];
    }
}

__device__ __forceinline__ void ph_combine(const Params& p, int l) {
    const int tid = opaque_tid(), lane = tid & 63, wave = tid >> 6;
    unsigned char* ws = opaque_ptr(p.ws); const float* mod = (const float*)(ws + WS_MOD);
    const int nrows = (l == 0) ? MT : NLAT;
    const int* INV = (const int*)(ws + WS_INV); const bf16_t* YS = (const bf16_t*)(ws + WS_YS);
#define M_UNPACK(dst, v) do { dst[0] = bflo(v.x); dst[1] = bfhi(v.x); dst[2] = bflo(v.y); dst[3] = bfhi(v.y); dst[4] = bflo(v.z); dst[5] = bfhi(v.z); dst[6] = bflo(v.w); dst[7] = bfhi(v.w); } while (0)
    for (int it = blockIdx.x; it < nrows / 8; it += gridDim.x) {
        const int row = it * 8 + wave; const int rr = row < NLAT ? (row >> 11) : 4;
        const bf16_t* xr = (const bf16_t*)(ws + WS_XB) + (size_t)row * DM + lane * 8;
        float x[4][8], s[4][8];
        u32x4 xv[4];
#pragma unroll
        for (int j = 0; j < 4; ++j) xv[j] = *(const u32x4*)(xr + j * 512);
        const int myinv = lane < 16 ? INV[(size_t)row * 16 + lane] : -1;
#pragma unroll
        for (int j = 0; j < 4; ++j) { M_UNPACK(x[j], xv[j]);
#pragma unroll
            for (int i = 0; i < 8; ++i) s[j][i] = 0.f; }
        unsigned msk = (unsigned)__ballot(myinv >= 0);
        while (msk) {
            const int e0 = __builtin_ctz(msk); msk &= msk - 1; const bool two = msk != 0u; const int e1 = two ? __builtin_ctz(msk) : e0; if (two) msk &= msk - 1;
            const int r0 = __shfl(myinv, e0), r1 = __shfl(myinv, e1);
            const bf16_t* y0 = YS + ((size_t)e0 * EROWS + r0) * DM + lane * 8; const bf16_t* y1 = YS + ((size_t)e1 * EROWS + r1) * DM + lane * 8;
            u32x4 v0[4], v1[4];
#pragma unroll
            for (int j = 0; j < 4; ++j) { v0[j] = *(const u32x4*)(y0 + j * 512); v1[j] = *(const u32x4*)(y1 + j * 512); }
            const float f1 = two ? 1.0f : 0.0f;
#pragma unroll
            for (int j = 0; j < 4; ++j) { float a[8], b[8]; M_UNPACK(a, v0[j]); M_UNPACK(b, v1[j]);
#pragma unroll
                for (int i = 0; i < 8; ++i) s[j][i] += a[i] + f1 * b[i]; }
        }
        const float* gate = mod + (size_t)(l * 5 + rr) * 12288 + 5 * DM + lane * 8;
        float ss = 0.f;
#pragma unroll
        for (int j = 0; j < 4; ++j) { const f32x4 g0 = *(const f32x4*)(gate + j * 512), g1 = *(const f32x4*)(gate + j * 512 + 4);
#pragma unroll
            for (int i = 0; i < 8; ++i) { x[j][i] += (i < 4 ? g0[i] : g1[i - 4]) * s[j][i]; ss += x[j][i] * x[j][i]; } }
        ss = wave_sum(ss); const float rinv = rsqrtf(ss * (1.0f / DM) + EPS);
        if (l == 0) {
            bf16_t* xo = (bf16_t*)(ws + WS_XA) + (size_t)row * DM + lane * 8; bf16_t* ho = (bf16_t*)(ws + WS_H) + (size_t)row * DM + lane * 8;
            const float* m = mod + (size_t)(5 + rr) * 12288 + lane * 8;
            const float* g = p.in[I_N1G] + DM + lane * 8;
#pragma unroll
            for (int j = 0; j < 4; ++j) {
                u32x4 w; w.x = cvt_pk_bf16(x[j][0], x[j][1]); w.y = cvt_pk_bf16(x[j][2], x[j][3]); w.z = cvt_pk_bf16(x[j][4], x[j][5]); w.w = cvt_pk_bf16(x[j][6], x[j][7]);
                *(u32x4*)(xo + j * 512) = w;
                const f32x4 ga = *(const f32x4*)(g + j * 512), gb = *(const f32x4*)(g + j * 512 + 4), sa = *(const f32x4*)(m + DM + j * 512), sb = *(const f32x4*)(m + DM + j * 512 + 4), ha = *(const f32x4*)(m + j * 512), hb = *(const f32x4*)(m + j * 512 + 4);
                float y[8];
#pragma unroll
                for (int i = 0; i < 8; ++i) y[i] = x[j][i] * rinv * (i < 4 ? ga[i] : gb[i - 4]) * (1.0f + (i < 4 ? sa[i] : sb[i - 4])) + (i < 4 ? ha[i] : hb[i - 4]);
                u32x4 h; h.x = cvt_pk_bf16(y[0], y[1]); h.y = cvt_pk_bf16(y[2], y[3]); h.z = cvt_pk_bf16(y[4], y[5]); h.w = cvt_pk_bf16(y[6], y[7]);
                *(u32x4*)(ho + j * 512) = h; }
        } else {
            float* orow = p.out + (size_t)row * DM + lane * 8; const float* g = p.in[I_FNG] + lane * 8;
#pragma unroll
            for (int j = 0; j < 4; ++j) { const f32x4 ga = *(const f32x4*)(g + j * 512), gb = *(const f32x4*)(g + j * 512 + 4);
                *(f32x4*)(orow + j * 512) = (f32x4){x[j][0] * rinv * ga[0], x[j][1] * rinv * ga[1], x[j][2] * rinv * ga[2], x[j][3] * rinv * ga[3]};
                *(f32x4*)(orow + j * 512 + 4) = (f32x4){x[j][4] * rinv * gb[0], x[j][5] * rinv * gb[1], x[j][6] * rinv * gb[2], x[j][7] * rinv * gb[3]}; }
        }
    }
#undef M_UNPACK
}

constexpr int NPH_LAYER = 13, NPH = 2 + 2 * NPH_LAYER;
__global__ void __launch_bounds__(512, 2) fwd(Params p) {
    extern __shared__ __attribute__((aligned(16))) unsigned char lds_raw[];
    LAS unsigned char* lds = (LAS unsigned char*)lds_raw;
    volatile LAS unsigned* MISC = (volatile LAS unsigned*)(lds + LDS_MISC);
    if (threadIdx.x < 16) MISC[threadIdx.x] = 0u;
    __syncthreads();
    unsigned char* ws = p.ws;
    const int lo = p.ph_lo, hi = p.ph_hi;
    XcdBarrier bar; bar.bar = (unsigned*)(ws + WS_CTL); bar.x = 0; bar.st = MISC;
    if (hi - lo > 1) bar = xcd_barrier_post((unsigned*)(ws + WS_CTL), MISC);
    const int G = gridDim.x, c = blockIdx.x;
#ifndef NCONV_A
#define NCONV_A 48
#endif
#ifndef NCONV_G
#define NCONV_G 48
#endif
#ifndef NCONV_K
#define NCONV_K 32
#endif
    const int nconv = (G == 256) ? 1 : 0;
    const int GgA = G - nconv * NCONV_A, GgG = G - nconv * NCONV_G, GgK = G - nconv * NCONV_K;
#ifndef ONLY_PH
#define ONLY_PH -1
#endif
#define PSEL(id) (ONLY_PH < 0 || ONLY_PH == (id))
#ifndef DUP
#define DUP 0
#endif
#define NREP(id) ((((DUP) >> (id)) & 1) ? 2 : 1)
#define REPLOOP(id) for (int rep_ = 0; rep_ < NREP(id); ++rep_)
#define REPBAR(id) do { if (rep_ + 1 < NREP(id)) xcd_barrier(bar); } while (0)
#define IN(k) (lo <= (k) && (k) < hi)
#define SEAM(k) do { if (IN(k) && IN((k) + 1)) xcd_barrier(bar); } while (0)

    if (PSEL(0) && IN(0)) REPLOOP(0) { ph_prologue(p, lds); __syncthreads(); REPBAR(0); }
    SEAM(0);
    if (PSEL(1) && IN(1)) REPLOOP(1) { ph_norm1_tables(p); REPBAR(1); }
    SEAM(1);
    for (int l = 0; l < 2; ++l) {
        const int pb = 2 + NPH_LAYER * l;
        const float* mod = (const float*)(ws + WS_MOD) + (size_t)l * 5 * 12288;
        if (PSEL(2) && IN(pb + 0)) REPLOOP(2) {
            pg8::EpiStoreBf16 E{(bf16_t*)(ws + WS_PA), INP};
            if (l == 0) { if (c >= GgA) moe_convert_while(p, lds, pb + 0, GgA);
                else { pg8::TileSched S; S.init(ws + WS_H, (bf16_t*)(ws + WS_WTIN), DM, DM, MT / 256, INP / 256, 1, 0, 0, GgA, c, 0); pg8::gemm_phase(lds, pg8::Desc{DM, DM, DM}, S, E); if (nconv) moe_mark_done(p, pb + 0); } }
            else { pg8::InSchedLast S; S.init(ws + WS_H, (bf16_t*)(ws + WS_WTIN) + (size_t)INP * DM, G, c); pg8::gemm_phase(lds, pg8::Desc{DM, DM, DM}, S, E); }
            moe_fill(p, lds, pb + 0);
         REPBAR(2); }
        SEAM(pb + 0);
        if (PSEL(3) && IN(pb + 1)) REPLOOP(3) { ph_rowsplit(p, l, lds); __syncthreads();  REPBAR(3); }
        SEAM(pb + 1);
        if (PSEL(4) && IN(pb + 2)) REPLOOP(4) {
#ifndef C_SEL
#define C_SEL 15
#endif
            if (C_SEL & 1) { pg8::TileSched S; S.init(ws + WS_QA, (bf16_t*)(ws + WS_WTUQ) + (size_t)l * 768 * 384, 384, 384, (l == 0 ? MT : NLAT) / 256, 3, 1, 0, 0, G, c, 0);
              pg8::EpiQ E{(bf16_t*)(ws + WS_QB), (const f32x2*)(ws + WS_ROPE)}; pg8::gemm_phase(lds, pg8::Desc{384, 384, 384}, S, E); }
            if (C_SEL & 2) { pg8::TileSched S; S.init(ws + WS_KVA, (bf16_t*)(ws + WS_WTUKV) + (size_t)l * 1024 * 256, 256, 256, MT / 256, 2, 1, 0, 0, G, c, 112);
              pg8::EpiK E{(bf16_t*)(ws + WS_KC)}; pg8::gemm_phase(lds, pg8::Desc{256, 256, 256}, S, E); }
            if (C_SEL & 4) { pg8::TileSched S; S.init((bf16_t*)(ws + WS_WTUKV) + (size_t)l * 1024 * 256 + 512 * 256, ws + WS_KVA, 256, 256, 2, MT / 256, 1, 0, 0, G, c, 184);
              pg8::EpiV E{(bf16_t*)(ws + WS_VT)}; pg8::gemm_phase(lds, pg8::Desc{256, 256, 256}, S, E); }
            if (C_SEL & 8) { pg8::TileSched S; S.init(ws + WS_UPK, (bf16_t*)(ws + WS_WST) + (size_t)l * 32 * 256 * 256, 512, 256, 3, 1, 32, (size_t)768 * 512 * 2, (size_t)256 * 256 * 2, G, c, 0);
              pg8::EpiS1 E{(float*)(ws + WS_EST)}; pg8::gemm_phase(lds, pg8::Desc{512, 256, 256}, S, E); }
            moe_fill(p, lds, pb + 2);
         REPBAR(4); }
        SEAM(pb + 2);
        if (PSEL(5) && IN(pb + 3)) REPLOOP(5) { ph_attn_carry(p, l, lds); __syncthreads();  REPBAR(5); }
        SEAM(pb + 3);
        if (PSEL(6) && IN(pb + 4)) REPLOOP(6) {
            pg8::TileSched S; S.init(ws + WS_UPK, (bf16_t*)(ws + WS_G2B) + (size_t)l * 32 * 256 * 512, 512, 512, 3, 1, 32, (size_t)768 * 512 * 2, (size_t)256 * 512 * 2, G, c, 0);
            pg8::EpiS2 E{(bf16_t*)(ws + WS_GB)}; pg8::gemm_phase(lds, pg8::Desc{512, 512, 512}, S, E);
            moe_fill(p, lds, pb + 4);
         REPBAR(6); }
        SEAM(pb + 4);
        if (PSEL(7) && IN(pb + 5)) REPLOOP(7) {
            pg8::TileSched S; S.init(ws + WS_GB, (bf16_t*)(ws + WS_WTGLU) + (size_t)l * 512 * 512, 512, 512, (l == 0 ? MT : NLAT) / 256, 2, 1, 0, 0, G, c, 0);
            pg8::EpiGlu E{(const bf16_t*)(ws + WS_GB), p.in[I_BGLU] + l * 512, (bf16_t*)(ws + WS_CAT)}; pg8::gemm_phase(lds, pg8::Desc{512, 512, 512}, S, E);
            moe_fill(p, lds, pb + 5);
         REPBAR(7); }
        SEAM(pb + 5);
        if (PSEL(8) && IN(pb + 6)) REPLOOP(8) {
            pg8::TileSched S; S.init(ws + WS_CAT, (bf16_t*)(ws + WS_WTOUT) + (size_t)l * DM * DM, DM, DM, (l == 0 ? MT : NLAT) / 256, DM / 256, 1, 0, 0, l == 0 ? GgG : G, c, 0);
            pg8::EpiOut E{p.in[I_X], p.in[I_CTX], l == 0 ? (const bf16_t*)nullptr : (const bf16_t*)(ws + WS_XA), mod + 2 * DM, (bf16_t*)(ws + WS_XB)};
            if (l == 0 && c >= GgG) moe_convert_while(p, lds, pb + 6, GgG); else { pg8::gemm_phase(lds, pg8::Desc{DM, DM, DM}, S, E); if (l == 0 && nconv) moe_mark_done(p, pb + 6); }
            moe_fill(p, lds, pb + 6);
         REPBAR(8); }
        SEAM(pb + 6);
        if (PSEL(9) && IN(pb + 7)) REPLOOP(9) { ph_norm2_router(p, l, lds); __syncthreads(); REPBAR(9); }
        SEAM(pb + 7);
        if (PSEL(10) && IN(pb + 8)) REPLOOP(10) { ph_topk(p, l, lds); __syncthreads(); moe_require(p, lds, l * Q_LAYER + Q_GU);  REPBAR(10); }
        if (PSEL(11) && IN(pb + 9)) REPLOOP(11) { }
        SEAM(pb + 9);
        if (PSEL(12) && IN(pb + 10)) REPLOOP(12) {
            pg8::MoeSched S; S.init(ws + WS_H, (bf16_t*)(ws + WS_WTGU) + (size_t)l * NE * 2048 * DM, DM, DM, l == 0 ? 5 : 4, 8, 0, (size_t)2048 * DM * 2, l == 0 ? GgK : G, c);
            pg8::EpiGU E{(bf16_t*)(ws + WS_HID)};
            if (l == 0 && c >= GgK) moe_convert_while(p, lds, pb + 10, GgK); else { pg8::gemm_phase<pg8::EpiGU, pg8::MoeSched, true>(lds, pg8::Desc{DM, DM, DM}, S, E, (const int*)(ws + WS_ROWTOK), l == 0 ? 1152 : 1024); if (l == 0 && nconv) moe_mark_done(p, pb + 10); }
            moe_require(p, lds, (l + 1) * Q_LAYER); moe_fill(p, lds, pb + 10);
         REPBAR(12); }
        SEAM(pb + 10);
        if (PSEL(13) && IN(pb + 11)) REPLOOP(13) {
            pg8::MoeSched S; S.init(ws + WS_HID, (bf16_t*)(ws + WS_WTDN) + (size_t)l * NE * DM * FF, FF, FF, l == 0 ? 5 : 4, 8, (size_t)EROWS * FF * 2, (size_t)DM * FF * 2, l == 0 ? GgK : G, c);
            pg8::EpiDown E{(bf16_t*)(ws + WS_YS), (const float*)(ws + WS_ROWAFF)};
            if (l == 0 && c >= GgK) moe_convert_while(p, lds, pb + 11, GgK); else { pg8::gemm_phase(lds, pg8::Desc{FF, FF, FF}, S, E); if (l == 0 && nconv) moe_mark_done(p, pb + 11); }
            moe_fill(p, lds, pb + 11);
         REPBAR(13); }
        SEAM(pb + 11);
        if (PSEL(14) && IN(pb + 12)) REPLOOP(14) { ph_combine(p, l);  REPBAR(14); }
        SEAM(pb + 12);
    }
#undef IN
#undef SEAM
}

extern "C" void kernel_launch(void* const* d_in, const int* in_sizes, int n_in, void* d_out, int out_size, void* d_ws, size_t ws_size, hipStream_t stream) {
    static int grid = 0;
    if (grid == 0) {
        if (n_in != 33 || ws_size < WS_END) { fprintf(stderr, "kernel_launch: need 33 inputs and >= %zu bytes of workspace; got %d, %zu\n", (size_t)WS_END, n_in, ws_size); grid = -1; return; }
        int dev = 0, cus = 0;
        if (hipGetDevice(&dev) != hipSuccess || hipDeviceGetAttribute(&cus, hipDeviceAttributeMultiprocessorCount, dev) != hipSuccess) { grid = -1; return; }
        if (hipFuncSetAttribute((const void*)fwd, hipFuncAttributeMaxDynamicSharedMemorySize, LDS_BYTES) != hipSuccess) { fprintf(stderr, "kernel_launch: hipFuncSetAttribute failed\n"); grid = -1; return; }
        (void)hipGetLastError();
        grid = cus > 256 ? 256 : cus;
    }
    if (grid < 0) return;
    (void)hipMemsetAsync((char*)d_ws + WS_CTL, 0, CTL_BYTES, stream);
    Params a{};
    for (int i = 0; i < 33; ++i) a.in[i] = (const float*)d_in[i];
    a.out = (float*)d_out; a.ws = (unsigned char*)d_ws;
#if MK_SPLIT
    for (int ph = 0; ph < NPH; ++ph) { a.ph_lo = ph; a.ph_hi = ph + 1; hipLaunchKernelGGL(fwd, dim3(grid), dim3(512), LDS_BYTES, stream, a); }
#else
    a.ph_lo = 0; a.ph_hi = NPH; hipLaunchKernelGGL(fwd, dim3(grid), dim3(512), LDS_BYTES, stream, a);
#endif
}
```

```cpp
#include <hip/hip_runtime.h>
#include <cstdint>
#include <cstdio>

#ifndef MK_SPLIT
#define MK_SPLIT 0
#endif

#define LAS __attribute__((address_space(3)))
typedef unsigned short bf16_t;
typedef short bf16x8 __attribute__((ext_vector_type(8)));
typedef short bf16x4 __attribute__((ext_vector_type(4)));
typedef float f32x4 __attribute__((ext_vector_type(4)));
typedef float f32x2 __attribute__((ext_vector_type(2)));
typedef unsigned u32x4 __attribute__((ext_vector_type(4)));
typedef unsigned u32x2 __attribute__((ext_vector_type(2)));
typedef float f32x16 __attribute__((ext_vector_type(16)));

constexpr int DM = 2048, NB = 4, SEQ = 2048, CTX = 256, NLAT = NB * SEQ, NCTX = NB * CTX, MT = NLAT + NCTX;
constexpr int INC = 3776, INP = 3840;
constexpr int C_SGU_U = 0, C_SGU_V = 512, C_CQ = 1024, C_CKV = 1408, C_KR = 1664, C_S5 = 1728, C_CVB = 2240, C_CVC = 2752, C_CVH = 3264;
constexpr int NKEY = CTX + SEQ;
constexpr int NE = 16, FF = 1024, CAPL = 256, CAPC = 32, EROWS = 1280;
constexpr int NCHUNK = MT / 16;
constexpr float EPS = 1e-6f;
constexpr float QSCALE = 0.07216878364870322f * 1.4426950408889634f;

constexpr size_t al256(size_t x) { return (x + 255) & ~(size_t)255; }
constexpr size_t WS_CTL = 0;
constexpr size_t CTL_BYTES = 65536;
constexpr size_t WS_MOD = WS_CTL + CTL_BYTES;
constexpr size_t WS_WTIN = al256(WS_MOD + (size_t)2 * 5 * 12288 * 4);
constexpr size_t WS_WTOUT = al256(WS_WTIN + (size_t)2 * INP * DM * 2);
constexpr size_t WS_WTUQ = al256(WS_WTOUT + (size_t)2 * DM * DM * 2);
constexpr size_t WS_WTUKV = al256(WS_WTUQ + (size_t)2 * 768 * 384 * 2);
constexpr size_t WS_WTGLU = al256(WS_WTUKV + (size_t)2 * 1024 * 256 * 2);
constexpr size_t WS_WTGU = al256(WS_WTGLU + (size_t)2 * 512 * 512 * 2);
constexpr size_t WS_WTDN = al256(WS_WTGU + (size_t)2 * NE * 2048 * DM * 2);
constexpr size_t WS_PW = al256(WS_WTDN + (size_t)2 * NE * DM * FF * 2);
constexpr size_t WS_BB = al256(WS_PW + (size_t)2 * 2 * 32 * 64 * 17 * 8);
constexpr size_t WS_KZ = al256(WS_BB + (size_t)2 * 2 * 32 * 64 * 16 * 8);
constexpr size_t WS_WST = al256(WS_KZ + (size_t)2 * 2 * 32 * 4096 * 4);
constexpr size_t WS_G2B = al256(WS_WST + (size_t)2 * 32 * 256 * 256 * 2);
constexpr size_t WS_H = al256(WS_G2B + (size_t)2 * 32 * 256 * 512 * 2);
constexpr size_t WS_PA = al256(WS_H + (size_t)MT * DM * 2);
constexpr size_t PA_BYTES = (size_t)NE * EROWS * DM * 2;
static_assert(PA_BYTES >= (size_t)MT * INP * 2, "P fits in the union");
constexpr size_t WS_XA = al256(WS_PA + PA_BYTES);
constexpr size_t WS_XB = al256(WS_XA + (size_t)MT * DM * 4);
constexpr size_t WS_CAT = al256(WS_XB + (size_t)MT * DM * 4);
constexpr size_t WS_QA = al256(WS_CAT + (size_t)MT * DM * 2);
constexpr size_t WS_KVA = al256(WS_QA + (size_t)MT * 384 * 2);
constexpr size_t WS_QB = al256(WS_KVA + (size_t)MT * 256 * 2);
constexpr size_t WS_KC = al256(WS_QB + (size_t)MT * 768 * 2);
constexpr size_t WS_VT = al256(WS_KC + (size_t)NB * 4 * NKEY * 192 * 2);
constexpr size_t WS_UPK = al256(WS_VT + (size_t)NB * 4 * 128 * NKEY * 2);
constexpr size_t WS_EST = al256(WS_UPK + (size_t)32 * 768 * 512 * 2);
constexpr size_t WS_GB = al256(WS_EST + (size_t)32 * 768 * 256 * 4);
constexpr size_t WS_AFF = al256(WS_GB + (size_t)MT * 512 * 2);
constexpr size_t WS_ROWTOK = al256(WS_AFF + (size_t)MT * 16 * 4);
constexpr size_t WS_ROWAFF = al256(WS_ROWTOK + (size_t)NE * EROWS * 4);
constexpr size_t WS_INV = al256(WS_ROWAFF + (size_t)NE * EROWS * 4);
constexpr size_t WS_HID = al256(WS_INV + (size_t)MT * 16 * 4);
constexpr size_t WS_YS = al256(WS_HID + (size_t)NE * EROWS * FF * 2);
constexpr size_t WS_ROPE = al256(WS_YS + (size_t)NE * EROWS * DM * 2);
constexpr size_t WS_A16 = al256(WS_ROPE + 64 * 16 * 8);
constexpr size_t WS_END = al256(WS_A16 + (size_t)2 * 2 * 32 * 64 * 8);

constexpr int LDS_GEMM = 131072;
constexpr int LDS_ATTN = 3 * 44032;
constexpr int LDS_MISC = 133120;
constexpr int LDS_BYTES = LDS_MISC + 256;
static_assert(LDS_ATTN <= LDS_MISC && LDS_GEMM <= LDS_MISC, "LDS map");

typedef __bf16 bf16x2_t __attribute__((ext_vector_type(2)));
__device__ __forceinline__ unsigned cvt_pk_bf16(float lo, float hi) { const f32x2 v = {lo, hi}; const bf16x2_t b = __builtin_convertvector(v, bf16x2_t); return __builtin_bit_cast(unsigned, b); }
__device__ __forceinline__ float bf2f(unsigned short b) { return __uint_as_float(((unsigned)b) << 16); }
__device__ __forceinline__ float bflo(unsigned w) { return __uint_as_float(w << 16); }
__device__ __forceinline__ float bfhi(unsigned w) { return __uint_as_float(w & 0xffff0000u); }
__device__ __forceinline__ unsigned short f2bf(float f) { return (unsigned short)(cvt_pk_bf16(f, 0.f) & 0xffffu); }
__device__ __forceinline__ int opaque_tid() { int t = threadIdx.x; asm volatile("" : "+v"(t)); return t; }
__device__ __forceinline__ unsigned char* opaque_ptr(unsigned char* q) { long z = 0; asm volatile("" : "+s"(z)); return q + z; }
__device__ __forceinline__ float wave_sum(float v) {
#pragma unroll
    for (int o = 32; o >= 1; o >>= 1) v += __shfl_xor(v, o);
    return v;
}
__device__ __forceinline__ float gelu_tanh(float x) {
    const float y = x * (-2.3022081986679503f - 0.10294324069457f * x * x);
    return x * __builtin_amdgcn_rcpf(1.0f + __builtin_amdgcn_exp2f(y));
}
__device__ __forceinline__ float silu_f(float x) { return x * __builtin_amdgcn_rcpf(1.0f + __builtin_amdgcn_exp2f(-1.4426950408889634f * x)); }
__device__ __forceinline__ float sigmoid_f(float x) { return __builtin_amdgcn_rcpf(1.0f + __builtin_amdgcn_exp2f(-1.4426950408889634f * x)); }

#define XB_TMO      128
#define XB_XCNT(j)  (256  + 64 * (j))
#define XB_XSUB(j)  (1280 + 64 * (j))
#define XB_XGEN(j)  (2304 + 64 * (j))
#define XB_TOP      3328
#define XB_TOPGEN   3392
#define XCD_BAR_WORDS 3456
#define XB_SPIN_CAP (1u << 22)
__device__ __forceinline__ unsigned xb_ld(unsigned* p)              { return __hip_atomic_load(p, __ATOMIC_RELAXED, __HIP_MEMORY_SCOPE_AGENT); }
__device__ __forceinline__ unsigned xb_add(unsigned* p, unsigned v) { return __hip_atomic_fetch_add(p, v, __ATOMIC_RELAXED, __HIP_MEMORY_SCOPE_AGENT); }
__device__ __forceinline__ unsigned xb_xcc_id() { return (unsigned)__builtin_amdgcn_s_getreg((3 << 11) | 20) & 0xFu; }
#define XB_SPIN(cond, bar) do { unsigned _sp = 0; while (cond) { __builtin_amdgcn_s_sleep(1); \
    if ((++_sp & 255u) == 0u) { if (xb_ld(&(bar)[XB_TMO])) break; if (_sp > XB_SPIN_CAP) { atomicAdd(&(bar)[XB_TMO], 1u); break; } } } } while (0)
struct XcdBarrier { unsigned* bar; unsigned x; volatile LAS unsigned* st; };
__device__ __forceinline__ XcdBarrier xcd_barrier_post(unsigned* bar, volatile LAS unsigned* st) {
    XcdBarrier b; b.bar = bar; b.x = xb_xcc_id(); b.st = st;
    if (threadIdx.x == 0) (void)xb_add(&bar[XB_XCNT(b.x)], 1u);
    return b;
}
__device__ __forceinline__ void xcd_barrier_complete(unsigned* bar, unsigned x, unsigned& nloc, unsigned& nx) {
    const unsigned G = gridDim.x * gridDim.y * gridDim.z;
    unsigned sum, cnt, mine, sp = 0u;
    for (;;) {
        sum = 0u; cnt = 0u; mine = 0u;
#pragma unroll
        for (unsigned j = 0; j < 16; ++j) { const unsigned c = xb_ld(&bar[XB_XCNT(j)]); sum += c; cnt += (c > 0u) ? 1u : 0u; mine = (j == x) ? c : mine; }
        if (sum == G) break;
        __builtin_amdgcn_s_sleep(1);
        if ((++sp & 255u) == 0u) { if (xb_ld(&bar[XB_TMO])) break; if (sp > XB_SPIN_CAP) { atomicAdd(&bar[XB_TMO], 1u); break; } }
    }
    nloc = mine > 0u ? mine : 1u; nx = cnt > 0u ? cnt : 1u;
}
__device__ __forceinline__ void xcd_barrier(const XcdBarrier& b) {
    asm volatile("s_waitcnt vmcnt(0)" ::: "memory");
    __syncthreads();
    if (threadIdx.x == 0) {
        unsigned* bar = b.bar;
        __builtin_amdgcn_s_waitcnt(0);
        unsigned nloc = b.st[0], nx = b.st[1];
        if (nloc == 0u) { xcd_barrier_complete(bar, b.x, nloc, nx); b.st[0] = nloc; b.st[1] = nx; }
        const unsigned old = xb_add(&bar[XB_XSUB(b.x)], 1u);
        const unsigned gen = old / nloc;
        if (old + 1u == (gen + 1u) * nloc) {
            __builtin_amdgcn_fence(__ATOMIC_RELEASE, "agent");
            asm volatile("s_waitcnt vmcnt(0)" ::: "memory");
            const unsigned og = xb_add(&bar[XB_TOP], 1u);
            const unsigned tg = og / nx;
            if (og + 1u == (tg + 1u) * nx) xb_add(&bar[XB_TOPGEN], 1u);
            else XB_SPIN(xb_ld(&bar[XB_TOPGEN]) == tg, bar);
            __builtin_amdgcn_fence(__ATOMIC_ACQUIRE, "agent");
            xb_add(&bar[XB_XGEN(b.x)], 1u);
            asm volatile("s_waitcnt vmcnt(0)" ::: "memory");
        } else {
            XB_SPIN(xb_ld(&bar[XB_XGEN(b.x)]) == gen, bar);
            __builtin_amdgcn_fence(__ATOMIC_ACQUIRE, "agent");
            asm volatile("s_waitcnt vmcnt(0)" ::: "memory");
        }
    }
    __syncthreads();
}

namespace pg8 {
constexpr int BM = 256, BK = 64, HALF = 128, HTB = HALF * BK * 2, STAGE_BYTES = 8 * HTB;
__host__ __device__ __forceinline__ int lds_byte(int r, int c) { const int st = (r >> 4) * 2 + (c >> 5), rr = r & 15, cc = c & 31, ob = rr * 64 + cc * 2; return st * 1024 + (ob ^ (((ob >> 9) & 1) << 5)); }
__host__ __device__ __forceinline__ void stage_rc(int b, int& R, int& C) { const int st = b / 1024, sb = b % 1024, swz = sb ^ (((sb >> 9) & 1) << 5); R = (st >> 1) * 16 + swz / 64; C = (st & 1) * 32 + (swz % 64) / 2; }
__host__ __device__ __forceinline__ int perm32(int rho) { const int n = rho >> 4, i = rho & 15; return 8 * (i >> 2) + 4 * n + (i & 3); }

struct Unit { const char* a; const char* b; int pm, pn, pb; };
struct Desc { int lda, ldb, K; };

struct TileSched {
    const char* A; const char* B; size_t sA, sB;
    int lda, ldb, nM, nN, nB, G, c;
    __device__ __forceinline__ void init(const void* A_, const void* B_, int lda_, int ldb_, int nM_, int nN_, int nB_, size_t sA_, size_t sB_, int G_, int c_, int off) {
        A = (const char*)A_; B = (const char*)B_; lda = lda_; ldb = ldb_; nM = nM_; nN = nN_; nB = nB_; sA = sA_; sB = sB_; G = G_; c = (c_ + G_ - (off % G_)) % G_; }
    __device__ __forceinline__ bool next(int i, Unit& u) const {
        const int nwg = nM * nN; const long L = (long)i * G + c; if (L >= (long)nwg * nB) return false;
        const int pb = (int)(L / nwg); int wgid = (int)(L % nwg);
        { const int q = nwg / 8, r = nwg % 8, xcd = wgid % 8, off = wgid / 8; wgid = (xcd < r ? xcd * (q + 1) : r * (q + 1) + (xcd - r) * q) + off; }
        const int nig = 8 * nN, gid = wgid / nig, fm = gid * 8, gsz = (nM - fm) < 8 ? (nM - fm) : 8;
        u.pm = fm + ((wgid % nig) % gsz); u.pn = (wgid % nig) / gsz; u.pb = pb;
        u.a = A + (size_t)pb * sA + (size_t)u.pm * 256 * lda * 2; u.b = B + (size_t)pb * sB + (size_t)u.pn * 256 * ldb * 2; return true;
    }
};
struct InSchedLast {
    TileSched T;
    __device__ __forceinline__ void init(const void* A_, const void* B_, int G_, int c_) { T.init(A_, B_, DM, DM, NLAT / 256, INP / 256, 1, 0, 0, G_, c_, 0); }
    __device__ __forceinline__ bool next(int i, Unit& u) const {
        const int nlat = (NLAT / 256) * (INP / 256); const long L = (long)i * T.G + T.c;
        if (L < nlat) return T.next(i, u);
        if (L >= nlat + 16) return false;
        const int k = (int)(L - nlat); u.pm = NLAT / 256 + (k >> 2); u.pn = 5 + (k & 3); u.pb = 0;
        u.a = T.A + (size_t)u.pm * 256 * DM * 2; u.b = T.B + (size_t)u.pn * 256 * DM * 2; return true;
    }
};
struct MoeSched {
    const char* A; const char* B; size_t sA, sB; int lda, ldb, nM, nN, G, c;
    __device__ __forceinline__ void init(const void* A_, const void* B_, int lda_, int ldb_, int nM_, int nN_, size_t sA_, size_t sB_, int G_, int c_) {
        A = (const char*)A_; B = (const char*)B_; lda = lda_; ldb = ldb_; nM = nM_; nN = nN_; sA = sA_; sB = sB_; G = G_; c = c_; }
    __device__ __forceinline__ bool next(int i, Unit& u) const {
        int e, rem; const int per = nM * nN;
        if ((G & 7) == 0) { const int x = c & 7, j = c >> 3, w = G >> 3; const int L = i * w + j; if (L >= 2 * per) return false; e = 2 * x + L / per; rem = L % per; }
        else { const long L = (long)i * G + c; if (L >= (long)NE * per) return false; e = (int)(L / per); rem = (int)(L % per); }
        u.pn = rem / nM; u.pm = rem % nM; u.pb = e;
        u.a = sA == 0 ? A : A + (size_t)e * sA + (size_t)u.pm * 256 * lda * 2; u.b = B + (size_t)e * sB + (size_t)u.pn * 256 * ldb * 2; return true;
    }
};

#ifndef PG8_SP2
#define PG8_SP2 true
#endif
#ifndef PG8_ALIGN
#define PG8_ALIGN true
#endif
template <class Epi, class Sched, bool GATHER = false, bool SP2 = PG8_SP2, bool ALIGN_EPI = PG8_ALIGN>
__device__ __forceinline__ void gemm_phase(LAS unsigned char* lds, const Desc g, const Sched& S, const Epi& E, const int* rowtok = nullptr, int nvalid = 0) {
    const int tid = opaque_tid(), wid = __builtin_amdgcn_readfirstlane(tid >> 6), lane = tid & 63, wr = wid >> 2, wc = wid & 3, fr = lane & 15, fq = lane >> 4;
    const int K = g.K, nt = K / BK;
    unsigned voffA[2], voffB[2]; int gR[2], gCc[2];
#pragma unroll
    for (int i = 0; i < 2; ++i) { int R, C; stage_rc(tid * 16 + i * 8192, R, C); const int Rb = Epi::PERM ? ((R & ~31) + perm32(R & 31)) : R;
        voffA[i] = (unsigned)(R * g.lda + C) * 2u; voffB[i] = (unsigned)(Rb * g.ldb + C) * 2u; gR[i] = R; gCc[i] = C; }
    unsigned gC[2][2], gN[2][2];
#define PG8_GOFF(u, o) do { _Pragma("unroll") for (int _h = 0; _h < 2; ++_h) _Pragma("unroll") for (int _i = 0; _i < 2; ++_i) { const int _r = (u).pm * 256 + _h * 128 + gR[_i]; \
        const int _tok = _r < nvalid ? rowtok[(u).pb * EROWS + _r] : 0; (o)[_h][_i] = (unsigned)(_tok * g.lda + gCc[_i]) * 2u; } } while (0)
    const size_t kstep = (size_t)(BK * 2);
    const size_t hstepA = (size_t)HALF * g.lda * 2, hstepB = (size_t)HALF * g.ldb * 2;
    const unsigned ldsw = (unsigned)wid * 1024u;
    const int aoff = lds_byte(wr * 64 + fr, fq * 8), boff = lds_byte(wc * 32 + fr, fq * 8);
#define PG8_SA(b, h) (((b) * 2 + (h)) * HTB)
#define PG8_SB(b, h) ((4 + (b) * 2 + (h)) * HTB)
#define PG8_STAGE(bufoff, gbase, voff) do { _Pragma("unroll") for (int _i = 0; _i < 2; ++_i) \
        __builtin_amdgcn_global_load_lds((const unsigned*)((const char*)(gbase) + (voff)[_i]), (LAS unsigned*)(lds + (bufoff) + ldsw + _i * 8192), 16, 0, 0); } while (0)
#define PG8_STAGE_A(bufoff, kptr, half, VO) do { if constexpr (GATHER) { _Pragma("unroll") for (int _i = 0; _i < 2; ++_i) \
        __builtin_amdgcn_global_load_lds((const unsigned*)((const char*)(kptr) + (VO)[half][_i]), (LAS unsigned*)(lds + (bufoff) + ldsw + _i * 8192), 16, 0, 0); } \
        else { PG8_STAGE(bufoff, (kptr) + (half) * hstepA, voffA); } } while (0)
#define PG8_LDA(dst, b, h) do { _Pragma("unroll") for (int m = 0; m < 4; ++m) _Pragma("unroll") for (int k = 0; k < 2; ++k) dst[m][k] = *(const LAS bf16x8*)(lds + PG8_SA(b, h) + aoff + m * 2048 + k * 1024); } while (0)
#define PG8_LDB(dst, b, h) do { _Pragma("unroll") for (int n = 0; n < 2; ++n) _Pragma("unroll") for (int k = 0; k < 2; ++k) dst[n][k] = *(const LAS bf16x8*)(lds + PG8_SB(b, h) + boff + n * 2048 + k * 1024); } while (0)
#define PG8_MMA(ai, bj, At, Bt) do { __builtin_amdgcn_s_setprio(1); _Pragma("unroll") for (int m = 0; m < 4; ++m) _Pragma("unroll") for (int n = 0; n < 2; ++n) _Pragma("unroll") for (int k = 0; k < 2; ++k) \
        acc[ai][bj][m][n] = __builtin_amdgcn_mfma_f32_16x16x32_bf16(Bt[n][k], At[m][k], acc[ai][bj][m][n], 0, 0, 0); __builtin_amdgcn_s_setprio(0); } while (0)
#define PG8_WAIT_V(n) asm volatile("s_waitcnt vmcnt(" #n ")" ::: "memory")
#define PG8_WAIT_L(n) asm volatile("s_waitcnt lgkmcnt(" #n ")" ::: "memory")
#define PG8_BAR __builtin_amdgcn_s_barrier()
#define PG8_SCHED __builtin_amdgcn_sched_barrier(0)
    Unit cur, nxt; int ui = 0;
    if (!S.next(0, cur)) return;
    f32x4 acc[2][2][4][2];
#pragma unroll
    for (int a = 0; a < 2; ++a)
#pragma unroll
        for (int b = 0; b < 2; ++b)
#pragma unroll
            for (int m = 0; m < 4; ++m)
#pragma unroll
                for (int n = 0; n < 2; ++n) acc[a][b][m][n] = (f32x4){0.f, 0.f, 0.f, 0.f};
    bf16x8 At[4][2], B0[2][2], B1[2][2];
    const char* cA = cur.a; const char* cB = cur.b;
    if constexpr (GATHER) { PG8_GOFF(cur, gC); }
    if constexpr (SP2) {
        PG8_STAGE(PG8_SB(0, 0), cB, voffB); PG8_STAGE(PG8_SB(0, 1), cB + hstepB, voffB); PG8_STAGE_A(PG8_SA(0, 0), cA, 0, gC); PG8_STAGE_A(PG8_SA(0, 1), cA, 1, gC);
        if (wr == 1) PG8_BAR;
        PG8_WAIT_V(2); PG8_BAR;
        PG8_STAGE(PG8_SB(1, 0), cB + kstep, voffB); PG8_STAGE_A(PG8_SA(1, 0), cA + kstep, 0, gC); PG8_STAGE(PG8_SB(1, 1), cB + hstepB + kstep, voffB);
        PG8_WAIT_V(6); PG8_BAR;
    } else {
    PG8_STAGE(PG8_SB(0, 0), cB, voffB); PG8_STAGE_A(PG8_SA(0, 0), cA, 0, gC); PG8_STAGE(PG8_SB(0, 1), cB + hstepB, voffB); PG8_STAGE_A(PG8_SA(0, 1), cA, 1, gC);
    if (wr == 1) PG8_BAR;
    PG8_WAIT_V(4); PG8_BAR;
    PG8_STAGE(PG8_SB(1, 0), cB + kstep, voffB); PG8_STAGE_A(PG8_SA(1, 0), cA + kstep, 0, gC); PG8_STAGE(PG8_SB(1, 1), cB + hstepB + kstep, voffB);
    PG8_WAIT_V(6); PG8_BAR;
    }
    for (;;) {
        const bool has_next = S.next(ui + 1, nxt);
        const char* nA = has_next ? nxt.a : cA; const char* nB = has_next ? nxt.b : cB;
        if constexpr (GATHER) { if (has_next) { PG8_GOFF(nxt, gN); } else {
#pragma unroll
            for (int _h = 0; _h < 2; ++_h)
#pragma unroll
                for (int _i = 0; _i < 2; ++_i) gN[_h][_i] = gC[_h][_i]; } }
#pragma nounroll
        for (int t = 0; t < nt; t += 2) {
            const bool last = (t == nt - 2);
            const char* a1 = cA + (size_t)(t + 1) * kstep;
            const char* a2 = last ? nA : cA + (size_t)(t + 2) * kstep; const char* b2 = last ? nB : cB + (size_t)(t + 2) * kstep;
            const char* a3 = a2 + kstep; const char* b3 = b2 + kstep;
            unsigned g2[2][2];
            if constexpr (GATHER) {
#pragma unroll
                for (int _h = 0; _h < 2; ++_h)
#pragma unroll
                    for (int _i = 0; _i < 2; ++_i) g2[_h][_i] = last ? gN[_h][_i] : gC[_h][_i]; }
            if constexpr (SP2) {
            PG8_LDB(B0, 0, 0); PG8_LDB(B1, 0, 1); PG8_SCHED; PG8_LDA(At, 0, 0); PG8_STAGE_A(PG8_SA(1, 1), a1, 1, gC);
            PG8_WAIT_V(8); PG8_WAIT_L(0); PG8_BAR; PG8_MMA(0, 0, At, B0); PG8_MMA(0, 1, At, B1); PG8_BAR; PG8_SCHED;
            PG8_LDA(At, 0, 1); PG8_STAGE(PG8_SB(0, 0), b2, voffB); PG8_STAGE(PG8_SB(0, 1), b2 + hstepB, voffB); PG8_STAGE_A(PG8_SA(0, 0), a2, 0, g2);
            PG8_WAIT_V(8); PG8_WAIT_L(0); PG8_BAR; PG8_MMA(1, 0, At, B0); PG8_MMA(1, 1, At, B1); PG8_BAR; PG8_SCHED;
            PG8_LDB(B0, 1, 0); PG8_LDB(B1, 1, 1); PG8_SCHED; PG8_LDA(At, 1, 0); PG8_STAGE_A(PG8_SA(0, 1), a2, 1, g2);
            PG8_WAIT_V(8); PG8_WAIT_L(0); PG8_BAR; PG8_MMA(0, 0, At, B0); PG8_MMA(0, 1, At, B1); PG8_BAR; PG8_SCHED;
            PG8_LDA(At, 1, 1); PG8_STAGE(PG8_SB(1, 0), b3, voffB); PG8_STAGE(PG8_SB(1, 1), b3 + hstepB, voffB); PG8_STAGE_A(PG8_SA(1, 0), a3, 0, g2);
            PG8_WAIT_V(8); PG8_WAIT_L(0); PG8_BAR; PG8_MMA(1, 0, At, B0); PG8_MMA(1, 1, At, B1); PG8_BAR; PG8_SCHED;
            } else {
            PG8_LDB(B0, 0, 0); PG8_SCHED; PG8_LDA(At, 0, 0); PG8_STAGE_A(PG8_SA(1, 1), a1, 1, gC);
            PG8_WAIT_L(8); PG8_BAR; PG8_WAIT_L(0); PG8_MMA(0, 0, At, B0); PG8_BAR; PG8_SCHED;
            PG8_LDB(B1, 0, 1); PG8_STAGE(PG8_SB(0, 0), b2, voffB);
            PG8_BAR; PG8_WAIT_L(0); PG8_MMA(0, 1, At, B1); PG8_BAR;
            PG8_LDA(At, 0, 1); PG8_STAGE_A(PG8_SA(0, 0), a2, 0, g2);
            PG8_BAR; PG8_WAIT_L(0); PG8_MMA(1, 0, At, B0); PG8_BAR; PG8_SCHED;
            PG8_STAGE(PG8_SB(0, 1), b2 + hstepB, voffB);
            PG8_WAIT_V(6); PG8_BAR; PG8_MMA(1, 1, At, B1); PG8_BAR;
            PG8_LDB(B0, 1, 0); PG8_SCHED; PG8_LDA(At, 1, 0); PG8_STAGE_A(PG8_SA(0, 1), a2, 1, g2);
            PG8_WAIT_L(8); PG8_BAR; PG8_WAIT_L(0); PG8_MMA(0, 0, At, B0); PG8_BAR; PG8_SCHED;
            PG8_LDB(B1, 1, 1); PG8_STAGE(PG8_SB(1, 0), b3, voffB);
            PG8_BAR; PG8_WAIT_L(0); PG8_MMA(0, 1, At, B1); PG8_BAR;
            PG8_LDA(At, 1, 1); PG8_STAGE_A(PG8_SA(1, 0), a3, 0, g2);
            PG8_BAR; PG8_WAIT_L(0); PG8_MMA(1, 0, At, B0); PG8_BAR; PG8_SCHED;
            PG8_STAGE(PG8_SB(1, 1), b3 + hstepB, voffB);
            PG8_WAIT_V(6); PG8_BAR; PG8_MMA(1, 1, At, B1); PG8_BAR;
            }
        }
        if constexpr (ALIGN_EPI) { if (wr == 0) PG8_BAR; }
        E(acc, cur, wr, wc, fr, fq);
        if (!has_next) break;
#pragma unroll
        for (int a = 0; a < 2; ++a)
#pragma unroll
            for (int b = 0; b < 2; ++b)
#pragma unroll
                for (int m = 0; m < 4; ++m)
#pragma unroll
                    for (int n = 0; n < 2; ++n) acc[a][b][m][n] = (f32x4){0.f, 0.f, 0.f, 0.f};
        cur = nxt; cA = nA; cB = nB; ++ui;
        if constexpr (GATHER) {
#pragma unroll
            for (int _h = 0; _h < 2; ++_h)
#pragma unroll
                for (int _i = 0; _i < 2; ++_i) gC[_h][_i] = gN[_h][_i]; }
        if constexpr (ALIGN_EPI) { if (wr == 1) PG8_BAR; }
    }
    PG8_WAIT_V(0);
    if constexpr (!ALIGN_EPI) { if (wr == 0) PG8_BAR; }
    PG8_BAR;
#undef PG8_SA
#undef PG8_SB
#undef PG8_STAGE
#undef PG8_STAGE_A
#undef PG8_GOFF
#undef PG8_LDA
#undef PG8_LDB
#undef PG8_MMA
#undef PG8_WAIT_V
#undef PG8_WAIT_L
#undef PG8_BAR
#undef PG8_SCHED
}

#define PG8_FOR_PERM(...) \
    _Pragma("unroll") for (int ai = 0; ai < 2; ++ai) _Pragma("unroll") for (int m = 0; m < 4; ++m) { const int tr = ai * 128 + wr * 64 + m * 16 + fr; \
        _Pragma("unroll") for (int bj = 0; bj < 2; ++bj) { const int tc = bj * 128 + wc * 32 + 8 * fq; const f32x4 v0 = acc[ai][bj][m][0], v1 = acc[ai][bj][m][1]; __VA_ARGS__ } }
#define PG8_FOR_NOPERM(...) \
    _Pragma("unroll") for (int ai = 0; ai < 2; ++ai) _Pragma("unroll") for (int m = 0; m < 4; ++m) { const int tr = ai * 128 + wr * 64 + m * 16 + fr; \
        _Pragma("unroll") for (int bj = 0; bj < 2; ++bj) _Pragma("unroll") for (int n = 0; n < 2; ++n) { const int tc = bj * 128 + wc * 32 + 16 * n + 4 * fq; const f32x4 v = acc[ai][bj][m][n]; __VA_ARGS__ } }

typedef const f32x4 (&AccRef)[2][2][4][2];

struct EpiStoreBf16 {
    static constexpr bool PERM = true;
    bf16_t* O; int ldc;
    __device__ __forceinline__ void operator()(AccRef acc, const Unit& u, int wr, int wc, int fr, int fq) const {
        PG8_FOR_PERM({ u32x4 w; w.x = cvt_pk_bf16(v0[0], v0[1]); w.y = cvt_pk_bf16(v0[2], v0[3]); w.z = cvt_pk_bf16(v1[0], v1[1]); w.w = cvt_pk_bf16(v1[2], v1[3]);
            *(u32x4*)(O + (size_t)(u.pm * 256 + tr) * ldc + u.pn * 256 + tc) = w; })
    }
};
struct EpiQ {
    static constexpr bool PERM = false;
    bf16_t* Q; const f32x2* ROPE;
    __device__ __forceinline__ void operator()(AccRef acc, const Unit& u, int wr, int wc, int fr, int fq) const {
        const int cg0 = u.pn * 256 + wc * 32, dd0 = cg0 % 192, dd1 = (cg0 + 128) % 192; const int rb = dd0 >= 128 ? 0 : (dd1 >= 128 ? 1 : -1); const int ddr = rb == 0 ? dd0 : dd1;
        const bool lat = u.pm < NLAT / 256;
        f32x4 rq[2][4][2];
        if (rb >= 0 && lat) {
#pragma unroll
            for (int ai = 0; ai < 2; ++ai)
#pragma unroll
                for (int m = 0; m < 4; ++m) { const int row = u.pm * 256 + ai * 128 + wr * 64 + m * 16 + fr, t = row & (SEQ - 1); const int pos = (ddr - 128) >= 32 ? (t & 63) : (t >> 6);
                    const f32x4* rp = (const f32x4*)(ROPE + pos * 16 + 4 * fq); rq[ai][m][0] = rp[0]; rq[ai][m][1] = rp[1]; }
        }
#pragma unroll
        for (int ai = 0; ai < 2; ++ai)
#pragma unroll
            for (int m = 0; m < 4; ++m) { const int row = u.pm * 256 + ai * 128 + wr * 64 + m * 16 + fr;
#pragma unroll
                for (int bj = 0; bj < 2; ++bj) { const int cg = u.pn * 256 + bj * 128 + wc * 32; f32x4 a = acc[ai][bj][m][0], b = acc[ai][bj][m][1];
                    if (bj == rb && lat) { const f32x4 r0 = rq[ai][m][0], r1 = rq[ai][m][1];
                        const float cs[4] = {r0[0], r0[2], r1[0], r1[2]}, sn[4] = {r0[1], r0[3], r1[1], r1[3]};
#pragma unroll
                        for (int i = 0; i < 4; ++i) { const float x1 = a[i], x2 = b[i]; a[i] = x1 * cs[i] - x2 * sn[i]; b[i] = x2 * cs[i] + x1 * sn[i]; } }
                    a *= QSCALE; b *= QSCALE;
                    bf16_t* o = Q + (size_t)row * 768 + cg + 4 * fq;
                    u32x2 w0; w0.x = cvt_pk_bf16(a[0], a[1]); w0.y = cvt_pk_bf16(a[2], a[3]); *(u32x2*)o = w0;
                    u32x2 w1; w1.x = cvt_pk_bf16(b[0], b[1]); w1.y = cvt_pk_bf16(b[2], b[3]); *(u32x2*)(o + 16) = w1; } }
    }
};
struct EpiK {
    static constexpr bool PERM = true;
    bf16_t* KC;
    __device__ __forceinline__ void operator()(AccRef acc, const Unit& u, int wr, int wc, int fr, int fq) const {
        const int b = u.pm < 32 ? (u.pm >> 3) : (u.pm - 32), key0 = u.pm < 32 ? CTX + (u.pm & 7) * 256 : 0;
        bf16_t* base = KC + ((size_t)(b * 4 + u.pn * 2) * NKEY + key0) * 192 + (size_t)(wr * 64 + fr) * 192 + wc * 32 + 8 * fq;
#pragma unroll
        for (int ai = 0; ai < 2; ++ai)
#pragma unroll
            for (int m = 0; m < 4; ++m)
#pragma unroll
                for (int bj = 0; bj < 2; ++bj) { const f32x4 v0 = acc[ai][bj][m][0], v1 = acc[ai][bj][m][1];
                    u32x4 w; w.x = cvt_pk_bf16(v0[0], v0[1]); w.y = cvt_pk_bf16(v0[2], v0[3]); w.z = cvt_pk_bf16(v1[0], v1[1]); w.w = cvt_pk_bf16(v1[2], v1[3]);
                    *(u32x4*)(base + (size_t)(ai * 128 + m * 16) * 192 + (size_t)bj * NKEY * 192) = w; }
    }
};
struct EpiV {
    static constexpr bool PERM = true;
    bf16_t* VT;
    __device__ __forceinline__ void operator()(AccRef acc, const Unit& u, int wr, int wc, int fr, int fq) const {
        const int b = u.pn < 32 ? (u.pn >> 3) : (u.pn - 32), key0 = u.pn < 32 ? CTX + (u.pn & 7) * 256 : 0;
        bf16_t* base = VT + ((size_t)(b * 4 + u.pm * 2) * 128 + wr * 64 + fr) * NKEY + key0 + wc * 32 + 8 * fq;
#pragma unroll
        for (int ai = 0; ai < 2; ++ai)
#pragma unroll
            for (int m = 0; m < 4; ++m)
#pragma unroll
                for (int bj = 0; bj < 2; ++bj) { const f32x4 v0 = acc[ai][bj][m][0], v1 = acc[ai][bj][m][1];
                    u32x2 w0, w1; w0.x = cvt_pk_bf16(v0[0], v0[1]); w0.y = cvt_pk_bf16(v0[2], v0[3]); w1.x = cvt_pk_bf16(v1[0], v1[1]); w1.y = cvt_pk_bf16(v1[2], v1[3]);
                    bf16_t* q = base + (size_t)(ai * 128 + m * 16) * NKEY + bj * 128; const int odd = fq & 1;
                    *(u32x2*)(q + (odd ? -4 : 0)) = w0; *(u32x2*)(q + (odd ? 4 : 8)) = w1; }
    }
};
struct EpiS1 {
    static constexpr bool PERM = false;
    float* EST;
    __device__ __forceinline__ void operator()(AccRef acc, const Unit& u, int wr, int wc, int fr, int fq) const {
        PG8_FOR_NOPERM({ const int row = u.pm * 256 + tr; if (row < NCHUNK) *(f32x4*)(EST + ((size_t)u.pb * 768 + row) * 256 + tc) = v; })
    }
};
struct EpiS2 {
    static constexpr bool PERM = true;
    bf16_t* GB;
    __device__ __forceinline__ void operator()(AccRef acc, const Unit& u, int wr, int wc, int fr, int fq) const {
        PG8_FOR_PERM({ const int row = u.pm * 256 + tr; if (row < NCHUNK) { const int p = tc >> 4, c = tc & 15;
            u32x4 w; w.x = cvt_pk_bf16(gelu_tanh(v0[0]), gelu_tanh(v0[1])); w.y = cvt_pk_bf16(gelu_tanh(v0[2]), gelu_tanh(v0[3]));
            w.z = cvt_pk_bf16(gelu_tanh(v1[0]), gelu_tanh(v1[1])); w.w = cvt_pk_bf16(gelu_tanh(v1[2]), gelu_tanh(v1[3]));
            *(u32x4*)(GB + (size_t)(row * 16 + p) * 512 + u.pb * 16 + c) = w; } })
    }
};
struct EpiGlu {
    static constexpr bool PERM = true;
    const bf16_t* GB; const float* bias; bf16_t* CAT;
    __device__ __forceinline__ void operator()(AccRef acc, const Unit& u, int wr, int wc, int fr, int fq) const {
        const int colb = u.pn * 256 + wc * 32 + 8 * fq;
        f32x4 bv[2][2];
#pragma unroll
        for (int bj = 0; bj < 2; ++bj) { bv[bj][0] = *(const f32x4*)(bias + colb + bj * 128); bv[bj][1] = *(const f32x4*)(bias + colb + bj * 128 + 4); }
#pragma unroll
        for (int ai = 0; ai < 2; ++ai) {
            u32x4 gq[4][2];
#pragma unroll
            for (int m = 0; m < 4; ++m)
#pragma unroll
                for (int bj = 0; bj < 2; ++bj) gq[m][bj] = *(const u32x4*)(GB + (size_t)(u.pm * 256 + ai * 128 + wr * 64 + m * 16 + fr) * 512 + colb + bj * 128);
#pragma unroll
            for (int m = 0; m < 4; ++m)
#pragma unroll
                for (int bj = 0; bj < 2; ++bj) { const int row = u.pm * 256 + ai * 128 + wr * 64 + m * 16 + fr, col = colb + bj * 128;
                    const f32x4 v0 = acc[ai][bj][m][0], v1 = acc[ai][bj][m][1]; const u32x4 gv = gq[m][bj]; const f32x4 b0 = bv[bj][0], b1 = bv[bj][1];
                    u32x4 w;
                    w.x = cvt_pk_bf16(bflo(gv.x) * sigmoid_f(v0[0] + b0[0]), bfhi(gv.x) * sigmoid_f(v0[1] + b0[1]));
                    w.y = cvt_pk_bf16(bflo(gv.y) * sigmoid_f(v0[2] + b0[2]), bfhi(gv.y) * sigmoid_f(v0[3] + b0[3]));
                    w.z = cvt_pk_bf16(bflo(gv.z) * sigmoid_f(v1[0] + b1[0]), bfhi(gv.z) * sigmoid_f(v1[1] + b1[1]));
                    w.w = cvt_pk_bf16(bflo(gv.w) * sigmoid_f(v1[2] + b1[2]), bfhi(gv.w) * sigmoid_f(v1[3] + b1[3]));
                    *(u32x4*)(CAT + (size_t)row * DM + 1024 + col) = w; }
        }
    }
};
struct EpiOut {
    static constexpr bool PERM = true;
    const float* xl; const float* xc; const bf16_t* xs; const float* gate; bf16_t* xo;
    __device__ __forceinline__ void operator()(AccRef acc, const Unit& u, int wr, int wc, int fr, int fq) const {
        const int rr = u.pm < NLAT / 256 ? (u.pm >> 3) : 4; const int colb = u.pn * 256 + wc * 32 + 8 * fq;
        const float* tb = (u.pm < NLAT / 256 ? xl + (size_t)(u.pm * 256) * DM : xc + (size_t)(u.pm * 256 - NLAT) * DM) + u.pn * 256;
        const int lo = (wr * 64 + fr) * DM + wc * 32 + 8 * fq;
        const float* gp = gate + (size_t)rr * 12288 + colb;
        u32x4 pk[2][4][2];
        { const f32x4 g00 = *(const f32x4*)gp, g01 = *(const f32x4*)(gp + 4), g10 = *(const f32x4*)(gp + 128), g11 = *(const f32x4*)(gp + 132);
#pragma unroll
          for (int ai = 0; ai < 2; ++ai)
#pragma unroll
            for (int m = 0; m < 4; ++m)
#pragma unroll
                for (int bj = 0; bj < 2; ++bj) { const f32x4 y0 = (bj ? g10 : g00) * acc[ai][bj][m][0], y1 = (bj ? g11 : g01) * acc[ai][bj][m][1];
                    pk[ai][m][bj].x = cvt_pk_bf16(y0[0], y0[1]); pk[ai][m][bj].y = cvt_pk_bf16(y0[2], y0[3]); pk[ai][m][bj].z = cvt_pk_bf16(y1[0], y1[1]); pk[ai][m][bj].w = cvt_pk_bf16(y1[2], y1[3]); } }
        asm volatile("" ::: "memory");
#pragma unroll
        for (int ai = 0; ai < 2; ++ai) {
            f32x4 xa[4][2][2];
#pragma unroll
            for (int m = 0; m < 4; ++m)
#pragma unroll
                for (int bj = 0; bj < 2; ++bj) { const float* src = tb + (lo + (ai * 128 + m * 16) * DM + bj * 128); xa[m][bj][0] = *(const f32x4*)src; xa[m][bj][1] = *(const f32x4*)(src + 4); }
#pragma unroll
            for (int m = 0; m < 4; ++m)
#pragma unroll
                for (int bj = 0; bj < 2; ++bj) { const int row = u.pm * 256 + ai * 128 + wr * 64 + m * 16 + fr, col = colb + bj * 128; const u32x4 y = pk[ai][m][bj];
                    const f32x4 x0 = xa[m][bj][0] + (f32x4){bflo(y.x), bfhi(y.x), bflo(y.y), bfhi(y.y)}, x1 = xa[m][bj][1] + (f32x4){bflo(y.z), bfhi(y.z), bflo(y.w), bfhi(y.w)};
                    u32x4 w; w.x = cvt_pk_bf16(x0[0], x0[1]); w.y = cvt_pk_bf16(x0[2], x0[3]); w.z = cvt_pk_bf16(x1[0], x1[1]); w.w = cvt_pk_bf16(x1[2], x1[3]);
                    *(u32x4*)(xo + (size_t)row * DM + col) = w; }
        }
    }
};
struct EpiOutBf {
    static constexpr bool PERM = true;
    const bf16_t* xs; const float* gate; bf16_t* xo;
    __device__ __forceinline__ void operator()(AccRef acc, const Unit& u, int wr, int wc, int fr, int fq) const {
        const int rr = u.pm < NLAT / 256 ? (u.pm >> 3) : 4; const int colb = u.pn * 256 + wc * 32 + 8 * fq;
        f32x4 gv[2][2]; u32x4 xq[2][4][2];
#pragma unroll
        for (int bj = 0; bj < 2; ++bj) { const float* gp = gate + (size_t)rr * 12288 + colb + bj * 128; gv[bj][0] = *(const f32x4*)gp; gv[bj][1] = *(const f32x4*)(gp + 4); }
#pragma unroll
        for (int ai = 0; ai < 2; ++ai)
#pragma unroll
            for (int m = 0; m < 4; ++m)
#pragma unroll
                for (int bj = 0; bj < 2; ++bj) xq[ai][m][bj] = *(const u32x4*)(xs + (size_t)(u.pm * 256 + ai * 128 + wr * 64 + m * 16 + fr) * DM + colb + bj * 128);
        PG8_FOR_PERM({ const int row = u.pm * 256 + tr, col = u.pn * 256 + tc; const u32x4 xv = xq[ai][m][bj];
            const f32x4 x0 = (f32x4){bflo(xv.x), bfhi(xv.x), bflo(xv.y), bfhi(xv.y)} + gv[bj][0] * v0, x1 = (f32x4){bflo(xv.z), bfhi(xv.z), bflo(xv.w), bfhi(xv.w)} + gv[bj][1] * v1;
            u32x4 w; w.x = cvt_pk_bf16(x0[0], x0[1]); w.y = cvt_pk_bf16(x0[2], x0[3]); w.z = cvt_pk_bf16(x1[0], x1[1]); w.w = cvt_pk_bf16(x1[2], x1[3]);
            *(u32x4*)(xo + (size_t)row * DM + col) = w; })
    }
};
struct EpiGU {
    static constexpr bool PERM = true;
    bf16_t* HID;
    __device__ __forceinline__ void operator()(AccRef acc, const Unit& u, int wr, int wc, int fr, int fq) const {
        PG8_FOR_PERM({ const int row = u.pm * 256 + tr, j = (u.pn * 256 + tc) >> 1;
            u32x2 w; w.x = cvt_pk_bf16(silu_f(v0[0]) * v0[1], silu_f(v0[2]) * v0[3]); w.y = cvt_pk_bf16(silu_f(v1[0]) * v1[1], silu_f(v1[2]) * v1[3]);
            *(u32x2*)(HID + ((size_t)u.pb * EROWS + row) * FF + j) = w; })
    }
};
struct EpiDown {
    static constexpr bool PERM = true;
    bf16_t* YS; const float* RA;
    __device__ __forceinline__ void operator()(AccRef acc, const Unit& u, int wr, int wc, int fr, int fq) const {
        float ra[2][4];
#pragma unroll
        for (int ai = 0; ai < 2; ++ai)
#pragma unroll
            for (int m = 0; m < 4; ++m) ra[ai][m] = RA[u.pb * EROWS + u.pm * 256 + ai * 128 + wr * 64 + m * 16 + fr];
        PG8_FOR_PERM({ const int row = u.pm * 256 + tr, col = u.pn * 256 + tc; const float a = ra[ai][m];
            u32x4 w; w.x = cvt_pk_bf16(v0[0] * a, v0[1] * a); w.y = cvt_pk_bf16(v0[2] * a, v0[3] * a); w.z = cvt_pk_bf16(v1[0] * a, v1[1] * a); w.w = cvt_pk_bf16(v1[2] * a, v1[3] * a);
            *(u32x4*)(YS + ((size_t)u.pb * EROWS + row) * DM + col) = w; })
    }
};
}

struct Params { const float* in[33]; float* out; unsigned char* ws; int ph_lo, ph_hi; };
enum { I_X = 0, I_C, I_CTX, I_CCTX, I_N1G, I_N2G, I_WADA, I_BADA, I_WIN, I_WOUT, I_SGUNG, I_SGUW, I_SGUB, I_QNG, I_WUQ, I_KVNG, I_WUKV,
       I_ARE, I_AIM, I_LOGDT, I_BRE, I_BIM, I_CRE, I_CIM, I_S5D, I_WGLU, I_BGLU, I_CONVW, I_WROUTER, I_WGATE, I_WUP, I_WDOWN, I_FNG };

__device__ __forceinline__ void transpose_tile(const float* src, int N, int k0, int n0, bf16_t* dst, int ldd, int rmul, int radd, int remap_kv, LAS float* tile) {
    const int tid = threadIdx.x;
#pragma unroll
    for (int i = 0; i < 2; ++i) { const int r = (tid >> 4) + 32 * i, c4 = (tid & 15) * 4;
        const f32x4 v = *(const f32x4*)(src + (size_t)(k0 + r) * N + n0 + c4);
        tile[r * 65 + c4 + 0] = v[0]; tile[r * 65 + c4 + 1] = v[1]; tile[r * 65 + c4 + 2] = v[2]; tile[r * 65 + c4 + 3] = v[3]; }
    __syncthreads();
    { const int n = tid >> 3, kc = tid & 7; float f[8];
#pragma unroll
        for (int j = 0; j < 8; ++j) f[j] = tile[(kc * 8 + j) * 65 + n];
        int nn = n0 + n; if (remap_kv) nn = ((nn & 255) < 128) ? ((nn >> 8) * 128 + (nn & 127)) : (512 + (nn >> 8) * 128 + (nn & 127));
        const int drow = nn * rmul + radd;
        u32x4 w; w.x = cvt_pk_bf16(f[0], f[1]); w.y = cvt_pk_bf16(f[2], f[3]); w.z = cvt_pk_bf16(f[4], f[5]); w.w = cvt_pk_bf16(f[6], f[7]);
        *(u32x4*)(dst + (size_t)drow * ldd + k0 + kc * 8) = w; }
    asm volatile("s_waitcnt lgkmcnt(0)\n\ts_barrier" ::: "memory");
}
constexpr int N_ADA_UNITS = 192, N_S5T_UNITS = 64, N_ROPE_UNITS = 2;
constexpr int T_WIN = 32 * 14 + 32 * 3  , T_WOUT = 32 * 8  , T_WUQ = 6 * 12, T_WUKV = 4 * 16, T_WGLU = 8 * 8, T_EXP = 512;
constexpr int N_TR = 2 * (T_WIN + T_WOUT + T_WUQ + T_WUKV + T_WGLU);
constexpr int N_PRO_ITEMS = N_ADA_UNITS + N_S5T_UNITS + N_ROPE_UNITS + N_TR;


__device__ __forceinline__ void transpose_block(const float* src, int N, int k0, int n0, bf16_t* dst, int ldd, int rmul, int radd, LAS float* tile  ) {
    const int tid = opaque_tid();
    f32x4 v[8];
#pragma unroll
    for (int i = 0; i < 8; ++i) v[i] = __builtin_nontemporal_load((const f32x4*)(src + (size_t)(k0 + (tid >> 6) + 8 * i) * N + n0 + (tid & 63) * 4));
#pragma unroll
    for (int i = 0; i < 8; ++i) { const int r = (tid >> 6) + 8 * i; *(LAS f32x4*)(tile + r * 260 + (((tid & 63) * 4) ^ (8 * (r >> 3)))) = v[i]; }
    __syncthreads();
#pragma unroll
    for (int i = 0; i < 4; ++i) { const int id = tid + 512 * i, n = id >> 3, kc = id & 7; float f[8];
#pragma unroll
        for (int j = 0; j < 8; ++j) f[j] = tile[(kc * 8 + j) * 260 + (n ^ (8 * kc))];
        u32x4 w; w.x = cvt_pk_bf16(f[0], f[1]); w.y = cvt_pk_bf16(f[2], f[3]); w.z = cvt_pk_bf16(f[4], f[5]); w.w = cvt_pk_bf16(f[6], f[7]);
        __builtin_nontemporal_store(w, (u32x4*)(dst + (size_t)((n0 + n) * rmul + radd) * ldd + k0 + kc * 8)); }
    asm volatile("s_waitcnt lgkmcnt(0)\n\ts_barrier" ::: "memory");
}
constexpr int QB_EXP = T_EXP / 4, Q_GU = NE * 2 * QB_EXP, Q_LAYER = Q_GU + NE * QB_EXP, Q_TOTAL = 2 * Q_LAYER;
constexpr int CW_QHEAD = 4096, CW_DONE = 4160;
static_assert((CW_DONE + 64 * 32) * 4 <= (int)CTL_BYTES, "control words inside the memset region");
struct CvtDesc { const float* src; bf16_t* dst; int N, ldd, rmul; };
__device__ __forceinline__ CvtDesc moe_block_desc(const Params& p, unsigned char* ws, int t) {
    const int l = t / Q_LAYER, r = t % Q_LAYER; CvtDesc d;
    if (r < Q_GU) { const int e = r / (2 * QB_EXP), rr = r % (2 * QB_EXP), up = rr / QB_EXP, q = rr % QB_EXP; const int le = l * NE + e, k0 = (q >> 2) * 64, n0 = (q & 3) * 256;
        d.src = (up ? p.in[I_WUP] : p.in[I_WGATE]) + (size_t)le * DM * FF + (size_t)k0 * FF + n0; d.N = FF; d.ldd = DM; d.rmul = 2;
        d.dst = (bf16_t*)(ws + WS_WTGU) + (size_t)le * 2048 * DM + (size_t)(n0 * 2 + up) * DM + k0; }
    else { const int r2 = r - Q_GU, e = r2 / QB_EXP, q = r2 % QB_EXP; const int le = l * NE + e, k0 = (q >> 3) * 64, n0 = (q & 7) * 256;
        d.src = p.in[I_WDOWN] + (size_t)le * FF * DM + (size_t)k0 * DM + n0; d.N = DM; d.ldd = FF; d.rmul = 1;
        d.dst = (bf16_t*)(ws + WS_WTDN) + (size_t)le * DM * FF + (size_t)n0 * FF + k0; }
    return d;
}
#ifndef FILL_ON
#define FILL_ON 0
#endif
constexpr unsigned Q_NONE = 0xffffffffu;
#ifndef Q_BULK
#define Q_BULK 1
#endif
#ifndef PUMP_DIST
#define PUMP_DIST 1
#endif
constexpr int CW_SEG = 8192;
__device__ __forceinline__ unsigned seg_base(unsigned sg) { return (sg >> 1) * (unsigned)Q_LAYER + (sg & 1u) * (unsigned)Q_GU; }
__device__ __forceinline__ unsigned seg_len(unsigned sg) { return (sg & 1u) ? (unsigned)(Q_LAYER - Q_GU) : (unsigned)Q_GU; }
__device__ __forceinline__ void moe_pump(const Params& p, LAS unsigned char* lds, int ph, int upto, int mode, unsigned target = 0u, bool count_me = true) {
    unsigned char* ws = opaque_ptr(p.ws); unsigned* ctl = (unsigned*)(ws + WS_CTL);
    LAS float* tile0 = (LAS float*)lds; LAS float* tile1 = (LAS float*)(lds + 66560); volatile LAS unsigned* slot = (volatile LAS unsigned*)(lds + LDS_MISC + 32);
    const int tid = opaque_tid(); const unsigned nblk = mode == 1 ? (unsigned)Q_BULK : 1u, tgt = target ? target : gridDim.x;
    const unsigned slast = mode == 1 ? (2u * (unsigned)((upto - 1) / Q_LAYER) + (((upto - 1) % Q_LAYER) >= Q_GU ? 1u : 0u)) : 3u;
    unsigned sg = 0u, nb = 0u, left = 0u, craw = 0u, dchk = 0u, given = 0u; bool cok = false, dead = false, want = false;
    unsigned zv = 0u; asm volatile("" : "+v"(zv));
    unsigned* const segh = ctl + CW_SEG + zv; unsigned* const donep = ctl + CW_DONE + 64 * ph;
#define PUMP_TAKE(out) do { unsigned id_ = Q_NONE; \
        for (;;) { if (left > 0u) { const unsigned lid_ = nb; ++nb; --left; if (lid_ < seg_len(sg)) { id_ = seg_base(sg) + lid_; ++given; break; } left = 0u; } \
            if (dead) break; \
            unsigned t_; \
            if (cok) { asm volatile("s_waitcnt vmcnt(4)" : "+v"(craw) :: "memory"); t_ = craw; cok = false; }            \
            else { if ((mode == 0 && dchk >= tgt) || (mode == 2 && given >= tgt)) { dead = true; break; } unsigned* hp_ = segh + 64 * sg; \
                   asm volatile("global_atomic_add %0, %1, %2, off sc0\n\ts_waitcnt vmcnt(0)" : "+v"(craw) : "v"(hp_), "v"(nblk) : "memory"); t_ = craw; }     \
            if (t_ < seg_len(sg)) { nb = t_; left = nblk; } else if (sg < slast) ++sg; else dead = true; } \
        want = !dead && left == 0u && !cok && (mode != 0 || dchk < tgt) && (mode != 2 || given < tgt); (out) = id_; } while (0)
#define PUMP_AHEAD() do { if (want) { unsigned* hp_ = segh + 64 * sg; asm volatile("global_atomic_add %0, %1, %2, off sc0" : "+v"(craw) : "v"(hp_), "v"(nblk) : "memory"); cok = true; want = false; } \
        if (mode == 0) dchk = __hip_atomic_load(donep, __ATOMIC_RELAXED, __HIP_MEMORY_SCOPE_AGENT); } while (0)
    __syncthreads();
    if (tid == 0) {
        if (mode == 0 && count_me) (void)__hip_atomic_fetch_add(donep, 1u, __ATOMIC_RELAXED, __HIP_MEMORY_SCOPE_AGENT);
        unsigned h_[4];
#pragma unroll
        for (int i = 0; i < 4; ++i) h_[i] = __hip_atomic_load(ctl + CW_SEG + 64 * i, __ATOMIC_RELAXED, __HIP_MEMORY_SCOPE_AGENT);
        if (mode == 0) dchk = __hip_atomic_load(donep, __ATOMIC_RELAXED, __HIP_MEMORY_SCOPE_AGENT);
        sg = slast; dead = true;
#pragma unroll
        for (int i = 3; i >= 0; --i) if ((unsigned)i <= slast && h_[i] < seg_len((unsigned)i)) { sg = (unsigned)i; dead = false; }
        unsigned b0 = Q_NONE, b1 = Q_NONE;
        PUMP_TAKE(b0); if (PUMP_DIST == 2) PUMP_TAKE(b1);
        slot[2] = b0; slot[3] = b1;
    }
    __syncthreads();
    unsigned cur = (unsigned)__builtin_amdgcn_readfirstlane((int)slot[2]), n1 = (unsigned)__builtin_amdgcn_readfirstlane((int)slot[3]);
    if (cur != Q_NONE) {
        f32x4 va[8], vb[8];
        const int lrow = tid >> 6, lcol = (tid & 63) * 4;
#define PUMP_LOADS(V, blk) do { const CvtDesc d_ = moe_block_desc(p, ws, (int)((blk) != Q_NONE ? (blk) : 0u)); const float* s_ = d_.src + (size_t)lrow * d_.N + lcol; \
        _Pragma("unroll") for (int i = 0; i < 8; ++i) V[i] = __builtin_nontemporal_load((const f32x4*)(s_ + (size_t)(8 * i) * d_.N)); } while (0)
#define PUMP_STEP(V, TILE, S) { \
        if (tid == 0) { unsigned h_; PUMP_TAKE(h_); slot[S] = h_; } \
        const CvtDesc dc_ = moe_block_desc(p, ws, (int)cur); \
        _Pragma("unroll") for (int i = 0; i < 8; ++i) { const int r_ = lrow + 8 * i; *(LAS f32x4*)(TILE + r_ * 260 + (lcol ^ (8 * i))) = V[i]; } \
        asm volatile("s_waitcnt lgkmcnt(0)\n\ts_barrier" ::: "memory"); \
        const unsigned n2_ = (unsigned)__builtin_amdgcn_readfirstlane((int)slot[S]); \
        PUMP_LOADS(V, n2_); \
        if (tid == 0) PUMP_AHEAD(); \
        _Pragma("unroll") for (int i = 0; i < 4; ++i) { const int id_ = tid + 512 * i, n_ = id_ >> 3, kc_ = id_ & 7; float f_[8]; \
            _Pragma("unroll") for (int j = 0; j < 8; ++j) f_[j] = TILE[(kc_ * 8 + j) * 260 + (n_ ^ (8 * kc_))]; \
            u32x4 w_; w_.x = cvt_pk_bf16(f_[0], f_[1]); w_.y = cvt_pk_bf16(f_[2], f_[3]); w_.z = cvt_pk_bf16(f_[4], f_[5]); w_.w = cvt_pk_bf16(f_[6], f_[7]); \
            __builtin_nontemporal_store(w_, (u32x4*)(dc_.dst + (size_t)(n_ * dc_.rmul) * dc_.ldd + kc_ * 8)); } \
        if (PUMP_DIST == 2) { cur = n1; n1 = n2_; } else cur = n2_; if (cur == Q_NONE) break; }
        PUMP_LOADS(va, cur);
        if (PUMP_DIST == 2) { PUMP_LOADS(vb, n1); do { PUMP_STEP(va, tile0, 0) PUMP_STEP(vb, tile1, 1) for (;;) { PUMP_STEP(va, tile0, 0) PUMP_STEP(vb, tile1, 1) } } while (0); }
        else { do { PUMP_STEP(va, tile0, 0) for (;;) { PUMP_STEP(va, tile1, 1) PUMP_STEP(va, tile0, 0) } } while (0); }
#undef PUMP_STEP
#undef PUMP_LOADS
    }
#undef PUMP_TAKE
#undef PUMP_AHEAD
    __syncthreads();
}
__device__ __forceinline__ void moe_fill(const Params& p, LAS unsigned char* lds, int ph) { if (FILL_ON) moe_pump(p, lds, ph, Q_TOTAL, 0); }
__device__ __forceinline__ void moe_mark_done(const Params& p, int ph) { if (threadIdx.x == 0) (void)__hip_atomic_fetch_add((unsigned*)(p.ws + WS_CTL) + CW_DONE + 64 * ph, 1u, __ATOMIC_RELAXED, __HIP_MEMORY_SCOPE_AGENT); }
__device__ __forceinline__ void moe_convert_while(const Params& p, LAS unsigned char* lds, int ph, unsigned ngemm) { moe_pump(p, lds, ph, Q_TOTAL, 0, ngemm, false); }
__device__ __forceinline__ void moe_convert_quota(const Params& p, LAS unsigned char* lds, unsigned quota) { if (quota) moe_pump(p, lds, 0, Q_TOTAL, 2, quota, false); }
__device__ __forceinline__ void moe_require(const Params& p, LAS unsigned char* lds, int upto) { moe_pump(p, lds, 0, upto, 1); }

__device__ __forceinline__ void ph_prologue(const Params& p, LAS unsigned char* lds) {
    const int tid = opaque_tid(), lane = tid & 63, wave = tid >> 6;
    unsigned char* ws = opaque_ptr(p.ws);
#ifndef PRO_HEAD
#define PRO_HEAD 3
#endif
    const bool full = gridDim.x == 256; const int c0 = blockIdx.x, nstat = N_ADA_UNITS + N_S5T_UNITS + N_ROPE_UNITS;
    for (int k = 0;; ++k) {
        int it;
        if (!full) { it = c0 + k * (int)gridDim.x; if (it >= N_PRO_ITEMS) break; }
        else if (k == 0) it = c0;
        else if (k == 1 && c0 < N_ROPE_UNITS) it = N_ADA_UNITS + N_S5T_UNITS + c0;
        else { const int kk = k - 1 - (c0 < N_ROPE_UNITS ? 1 : 0); int t;
            if (c0 < 192) t = kk < PRO_HEAD ? c0 + 192 * kk : 192 * PRO_HEAD + c0 + 256 * (kk - PRO_HEAD); else t = 192 * PRO_HEAD + c0 + 256 * kk;
            if (t >= N_TR) break; it = nstat + t; }
        if (it < N_ADA_UNITS) {
            const int l = it / 96, cb = it % 96;
            LAS float* sil = (LAS float*)lds;
            LAS float* red = (LAS float*)(lds + 40960);
            { float cv[20];
#pragma unroll
              for (int ii = 0; ii < 20; ++ii) { const int i = tid + 512 * ii, r = i >> 11, k = i & (DM - 1); cv[ii] = r < 4 ? p.in[I_C][r * DM + k] : p.in[I_CCTX][k]; }
#pragma unroll
              for (int ii = 0; ii < 20; ++ii) sil[tid + 512 * ii] = silu_f(cv[ii]); }
            __syncthreads();
            f32x2 acc[5];
#pragma unroll
            for (int r = 0; r < 5; ++r) acc[r] = (f32x2){0.f, 0.f};
            const float* W = p.in[I_WADA] + (size_t)l * DM * 12288 + cb * 128 + lane * 2;
            for (int k = wave * 256; k < wave * 256 + 256; k += 16) {
                f32x2 w[16];
#pragma unroll
                for (int j = 0; j < 16; ++j) w[j] = __builtin_nontemporal_load((const f32x2*)(W + (size_t)(k + j) * 12288));
#pragma unroll
                for (int j = 0; j < 16; ++j)
#pragma unroll
                    for (int r = 0; r < 5; ++r) acc[r] += sil[r * DM + k + j] * w[j];
            }
#pragma unroll
            for (int r = 0; r < 5; ++r) { red[(wave * 5 + r) * 128 + lane * 2] = acc[r].x; red[(wave * 5 + r) * 128 + lane * 2 + 1] = acc[r].y; }
            __syncthreads();
            float* mod = (float*)(ws + WS_MOD);
            for (int o = tid; o < 5 * 128; o += 512) { const int r = o >> 7, cc = o & 127; float sum = p.in[I_BADA][l * 12288 + cb * 128 + cc];
#pragma unroll
                for (int w8 = 0; w8 < 8; ++w8) sum += red[(w8 * 5 + r) * 128 + cc];
                mod[(size_t)(l * 5 + r) * 12288 + cb * 128 + cc] = sum; }
            __syncthreads();
        } else if (it < N_ADA_UNITS + N_S5T_UNITS) {
            const int lg = it - N_ADA_UNITS, l = lg >> 5, g = lg & 31;
            LAS f32x2* PWl = (LAS f32x2*)lds;
            LAS f32x2* BBl = (LAS f32x2*)(lds + 17408);
            LAS f32x2* Cl = (LAS f32x2*)(lds + 33792);
            LAS float* KZl = (LAS float*)(lds + 50176);
            LAS f32x2* CFl = (LAS f32x2*)(lds + 82944);
            LAS f32x2* ClT = (LAS f32x2*)(lds + 84224);
            LAS float* Dl = (LAS float*)(lds + 83968);
            if (tid >= 128 && tid < 144) Dl[tid - 128] = p.in[I_S5D][l * 512 + g * 16 + (tid - 128)];
            { float br[4], bi[4], cre[4], cim[4];
#pragma unroll
              for (int ii = 0; ii < 4; ++ii) { const int idx = tid + 512 * ii, z = idx >> 10, n = (idx >> 4) & 63, c = idx & 15; const int zgn = ((l * 2 + z) * 32 + g) * 64 + n;
                  br[ii] = p.in[I_BRE][(size_t)zgn * 16 + c]; bi[ii] = p.in[I_BIM][(size_t)zgn * 16 + c];
                  const size_t src = ((size_t)((l * 2 + z) * 32 + g) * 16) * 64 + (idx & 1023); cre[ii] = p.in[I_CRE][src]; cim[ii] = p.in[I_CIM][src]; }
            if (tid < 128) { const int z = tid >> 6, n = tid & 63; const int zgn = ((l * 2 + z) * 32 + g) * 64 + n;
                const float are = fminf(p.in[I_ARE][zgn], -1e-4f), aim = p.in[I_AIM][zgn]; const float dt = expf(p.in[I_LOGDT][zgn >> 6]);
                const double mag = exp((double)are * (double)dt); double sn, cs; sincos((double)aim * (double)dt, &sn, &cs);
                const double ar = mag * cs, ai = mag * sn;
                const float xr = (float)ar - 1.0f, xi = (float)ai, den = 1.0f / (are * are + aim * aim);
                CFl[tid] = (f32x2){(xr * are + xi * aim) * den, (xi * are - xr * aim) * den};
                double pr = 1.0, pi = 0.0;
#pragma unroll 1
                for (int d = 0; d <= 16; ++d) { const f32x2 v = {(float)pr, (float)pi}; PWl[(z * 64 + n) * 17 + d] = v; if (d == 16) ((f32x2*)(ws + WS_A16))[zgn] = v;
                    const double nr = pr * ar - pi * ai, ni = pr * ai + pi * ar; pr = nr; pi = ni; } }
            __syncthreads();
#pragma unroll
              for (int ii = 0; ii < 4; ++ii) { const int idx = tid + 512 * ii, z = idx >> 10, n = (idx >> 4) & 63; const f32x2 cf = CFl[z * 64 + n];
                  BBl[idx] = (f32x2){cf.x * br[ii] - cf.y * bi[ii], cf.x * bi[ii] + cf.y * br[ii]}; Cl[idx] = (f32x2){cre[ii], cim[ii]}; ClT[(z * 64 + (idx & 63)) * 16 + ((idx >> 6) & 15)] = (f32x2){cre[ii], cim[ii]}; } }
            __syncthreads();
            { const int z = tid >> 8, d = (tid >> 4) & 15, c = tid & 15; float a16[16];
#pragma unroll
              for (int q = 0; q < 16; ++q) a16[q] = 0.f;
              for (int n = 0; n < 64; ++n) { const f32x2 pw = PWl[(z * 64 + n) * 17 + d], cm = ClT[(z * 64 + n) * 16 + c]; const float tr = cm.x * pw.x - cm.y * pw.y, ti = cm.x * pw.y + cm.y * pw.x;
#pragma unroll
                  for (int q = 0; q < 16; ++q) { const f32x2 bb = BBl[(z * 64 + n) * 16 + q]; a16[q] += tr * bb.x - ti * bb.y; } }
#pragma unroll
              for (int q = 0; q < 16; ++q) KZl[((z * 16 + d) * 16 + c) * 16 + q] = a16[q]; }
            __syncthreads();
            bf16_t* WST = (bf16_t*)(ws + WS_WST) + (size_t)lg * 256 * 256; bf16_t* G2B = (bf16_t*)(ws + WS_G2B) + (size_t)lg * 256 * 512;
            for (int i = 0; i < 16; ++i) { const int id = tid + 512 * i;
                {
                  const int c8 = (id & 1) * 8, pp = (id >> 1) & 15, row = id >> 5, z = row >> 7, ri = (row >> 6) & 1, n = row & 63;
                  const f32x2 pw = PWl[(z * 64 + n) * 17 + (z == 0 ? 15 - pp : pp)]; float f[8];
#pragma unroll
                  for (int j = 0; j < 8; j += 2) { const f32x4 b2 = *(const LAS f32x4*)(BBl + (z * 64 + n) * 16 + c8 + j);
                      f[j] = ri == 0 ? (pw.x * b2[0] - pw.y * b2[1]) : (pw.x * b2[1] + pw.y * b2[0]); f[j + 1] = ri == 0 ? (pw.x * b2[2] - pw.y * b2[3]) : (pw.x * b2[3] + pw.y * b2[2]); }
                  u32x4 w; w.x = cvt_pk_bf16(f[0], f[1]); w.y = cvt_pk_bf16(f[2], f[3]); w.z = cvt_pk_bf16(f[4], f[5]); w.w = cvt_pk_bf16(f[6], f[7]);
                  *(u32x4*)(WST + (size_t)row * 256 + pp * 16 + c8) = w; }
                {
                  const int n8 = (id & 7) * 8, ri = (id >> 3) & 1, z = (id >> 4) & 1, row = id >> 5, pp = row >> 4, c = row & 15; float f[8];
#pragma unroll
                  for (int j = 0; j < 8; j += 2) { const f32x4 c2 = *(const LAS f32x4*)(Cl + (z * 16 + c) * 64 + n8 + j);
                      const f32x2 pw0 = PWl[(z * 64 + n8 + j) * 17 + (z == 0 ? pp + 1 : 16 - pp)], pw1 = PWl[(z * 64 + n8 + j + 1) * 17 + (z == 0 ? pp + 1 : 16 - pp)];
                      f[j] = ri == 0 ? (c2[0] * pw0.x - c2[1] * pw0.y) : -(c2[0] * pw0.y + c2[1] * pw0.x); f[j + 1] = ri == 0 ? (c2[2] * pw1.x - c2[3] * pw1.y) : -(c2[2] * pw1.y + c2[3] * pw1.x); }
                  u32x4 w; w.x = cvt_pk_bf16(f[0], f[1]); w.y = cvt_pk_bf16(f[2], f[3]); w.z = cvt_pk_bf16(f[4], f[5]); w.w = cvt_pk_bf16(f[6], f[7]);
                  *(u32x4*)(G2B + (size_t)row * 512 + 256 + z * 128 + ri * 64 + n8) = w; }
                {
                  const int c8 = (id & 1) * 8, pq = (id >> 1) & 15, row = id >> 5, pp = row >> 4, c = row & 15; float f[8];
                  const int d0 = pp >= pq ? pp - pq : 0, d1 = pq >= pp ? pq - pp : 0; const float m0 = pq <= pp ? 1.f : 0.f, m1 = pq >= pp ? 1.f : 0.f, dsk = pq == pp ? Dl[c] : 0.f;
                  const LAS f32x4* k0 = (const LAS f32x4*)(KZl + ((0 * 16 + d0) * 16 + c) * 16 + c8); const LAS f32x4* k1 = (const LAS f32x4*)(KZl + ((1 * 16 + d1) * 16 + c) * 16 + c8);
                  const f32x4 a0 = k0[0], a1 = k0[1], b0 = k1[0], b1 = k1[1];
#pragma unroll
                  for (int j = 0; j < 8; ++j) f[j] = m0 * (j < 4 ? a0[j] : a1[j - 4]) + m1 * (j < 4 ? b0[j] : b1[j - 4]) + (c8 + j == c ? dsk : 0.f);
                  u32x4 w; w.x = cvt_pk_bf16(f[0], f[1]); w.y = cvt_pk_bf16(f[2], f[3]); w.z = cvt_pk_bf16(f[4], f[5]); w.w = cvt_pk_bf16(f[6], f[7]);
                  *(u32x4*)(G2B + (size_t)row * 512 + pq * 16 + c8) = w; } }
            __syncthreads();
        } else if (it < N_ADA_UNITS + N_S5T_UNITS + N_ROPE_UNITS) {
            const int idx = (it - N_ADA_UNITS - N_S5T_UNITS) * 512 + tid; const int pos = idx >> 4, f = idx & 15;
            const float invf = powf(10000.0f, -(float)f * 0.0625f); const float ang = (float)pos * invf;
            ((f32x2*)(ws + WS_ROPE))[idx] = (f32x2){cosf(ang), sinf(ang)};
        } else {
            int t = it - N_ADA_UNITS - N_S5T_UNITS - N_ROPE_UNITS;
            LAS float* tile = (LAS float*)lds;
            if (t < 2 * T_WIN) { const int l = t / T_WIN, r = t % T_WIN; const float* src = p.in[I_WIN] + (size_t)l * DM * INC; bf16_t* dst = (bf16_t*)(ws + WS_WTIN) + (size_t)l * INP * DM;
                if (r < 448) transpose_block(src, INC, (r / 14) * 64, (r % 14) * 256, dst, DM, 1, 0, tile); else { const int q = r - 448; transpose_tile(src, INC, (q / 3) * 64, 3584 + (q % 3) * 64, dst, DM, 1, 0, 0, tile); }
                continue; }
            t -= 2 * T_WIN;
            if (t < 2 * T_WOUT) { const int l = t / T_WOUT, r = t % T_WOUT; transpose_block(p.in[I_WOUT] + (size_t)l * DM * DM, DM, (r >> 3) * 64, (r & 7) * 256, (bf16_t*)(ws + WS_WTOUT) + (size_t)l * DM * DM, DM, 1, 0, tile); continue; }
            t -= 2 * T_WOUT;
            if (t < 2 * T_WUQ) { const int l = t / T_WUQ, r = t % T_WUQ; transpose_tile(p.in[I_WUQ] + (size_t)l * 384 * 768, 768, (r % 6) * 64, (r / 6) * 64, (bf16_t*)(ws + WS_WTUQ) + (size_t)l * 768 * 384, 384, 1, 0, 0, tile); continue; }
            t -= 2 * T_WUQ;
            if (t < 2 * T_WUKV) { const int l = t / T_WUKV, r = t % T_WUKV; transpose_tile(p.in[I_WUKV] + (size_t)l * 256 * 1024, 1024, (r % 4) * 64, (r / 4) * 64, (bf16_t*)(ws + WS_WTUKV) + (size_t)l * 1024 * 256, 256, 1, 0, 1, tile); continue; }
            t -= 2 * T_WUKV;
            if (t < 2 * T_WGLU) { const int l = t / T_WGLU, r = t % T_WGLU; transpose_tile(p.in[I_WGLU] + (size_t)l * 512 * 512, 512, (r % 8) * 64, (r / 8) * 64, (bf16_t*)(ws + WS_WTGLU) + (size_t)l * 512 * 512, 512, 1, 0, 0, tile); continue; }
        }
    }
}

__device__ __forceinline__ void rms_mod_store(const f32x4 (&x)[8], const float* g, const float* scale, const float* shift, bf16_t* orow, f32x4 (&y)[8], int lane) {
    float ss = 0.f;
#pragma unroll
    for (int j = 0; j < 8; ++j) ss += x[j][0] * x[j][0] + x[j][1] * x[j][1] + x[j][2] * x[j][2] + x[j][3] * x[j][3];
    ss = wave_sum(ss);
    const float rinv = rsqrtf(ss * (1.0f / DM) + EPS);
#pragma unroll
    for (int j = 0; j < 8; ++j) { const int c = j * 256 + lane * 4;
        const f32x4 gv = *(const f32x4*)(g + c), sc = *(const f32x4*)(scale + c), sh = *(const f32x4*)(shift + c);
        y[j] = x[j] * rinv * gv * (1.0f + sc) + sh; }
#pragma unroll
    for (int j = 0; j < 8; ++j) { const int c = j * 256 + lane * 4; u32x2 w; w.x = cvt_pk_bf16(y[j][0], y[j][1]); w.y = cvt_pk_bf16(y[j][2], y[j][3]); *(u32x2*)(orow + c) = w; }
}

constexpr int N1_ROWITEMS = MT / 8, N1_KZ = 64, N1_WST = 1024, N1_INTER = 1024;
__device__ __forceinline__ void ph_norm1_tables(const Params& p) {
    const int tid = opaque_tid(), lane = tid & 63, wave = tid >> 6;
    unsigned char* ws = opaque_ptr(p.ws);
    const float* mod = (const float*)(ws + WS_MOD);
    for (int it = blockIdx.x; it < N1_ROWITEMS; it += gridDim.x) {
        {
            const int row = it * 8 + wave; const int rr = row < NLAT ? (row >> 11) : 4;
            const float* xr = row < NLAT ? p.in[I_X] + (size_t)row * DM : p.in[I_CTX] + (size_t)(row - NLAT) * DM;
            f32x4 x[8], y[8];
#pragma unroll
            for (int j = 0; j < 8; ++j) x[j] = *(const f32x4*)(xr + j * 256 + lane * 4);
            const float* m = mod + (size_t)rr * 12288;
            rms_mod_store(x, p.in[I_N1G], m + DM, m, (bf16_t*)(ws + WS_H) + (size_t)row * DM, y, lane);
        }
    }
}

template <bool MAIN, bool CONV>
__device__ __forceinline__ void b_row(const Params& p, unsigned char* ws, int l, int row, int lane) {
    const bf16_t* P = (const bf16_t*)(ws + WS_PA); bf16_t* CAT = (bf16_t*)(ws + WS_CAT);
    const bf16_t* pr = P + (size_t)row * INP;
    const bool lat = row < NLAT; const int t = lat ? (row & (SEQ - 1)) : ((row - NLAT) & (CTX - 1)); const int b = lat ? (row >> 11) : ((row - NLAT) >> 8);
    const int seqlen = lat ? SEQ : CTX;
    const int c0 = lane * 8; const u32x4 zero4 = (u32x4){0u, 0u, 0u, 0u};
    u32x4 vq = zero4, vs5 = zero4, ca = zero4, ch = zero4, bg = zero4, pa = zero4, ph = zero4, na = zero4, nh = zero4; u32x2 vkv = (u32x2){0u, 0u}; unsigned short vkr = 0;
    f32x4 cw0a, cw0b, cw1a, cw1b, cw2a, cw2b, gq0 = (f32x4){0.f, 0.f, 0.f, 0.f}, gq1 = gq0, gkv = gq0; f32x2 rope = (f32x2){1.f, 0.f};
    cw0a = cw0b = cw1a = cw1b = cw2a = cw2b = gq0;
    if (MAIN) {
        if (lane < 48) vq = *(const u32x4*)(pr + C_CQ + lane * 8);
        vkv = *(const u32x2*)(pr + C_CKV + lane * 4);
        vkr = pr[C_KR + lane];
        vs5 = *(const u32x4*)(pr + C_S5 + lane * 8);
        if (lane < 48) { const float* g = p.in[I_QNG] + l * 384 + lane * 8; gq0 = *(const f32x4*)g; gq1 = *(const f32x4*)(g + 4); }
        gkv = *(const f32x4*)(p.in[I_KVNG] + l * 256 + lane * 4);
        if (lat) { const int pos = lane >= 32 ? (t & 63) : (t >> 6); rope = ((const f32x2*)(ws + WS_ROPE))[pos * 16 + (lane & 15)]; }
    }
    if (CONV) {
        ca = *(const u32x4*)(pr + C_CVC + c0); ch = *(const u32x4*)(pr + C_CVH + c0); bg = *(const u32x4*)(pr + C_CVB + c0);
        if (t > 0) { pa = *(const u32x4*)(pr - INP + C_CVC + c0); ph = *(const u32x4*)(pr - INP + C_CVH + c0); }
        if (t < seqlen - 1) { na = *(const u32x4*)(pr + INP + C_CVC + c0); nh = *(const u32x4*)(pr + INP + C_CVH + c0); }
        const float* cw = p.in[I_CONVW] + (size_t)l * 3 * 512 + c0;
        cw0a = *(const f32x4*)cw; cw0b = *(const f32x4*)(cw + 4); cw1a = *(const f32x4*)(cw + 512); cw1b = *(const f32x4*)(cw + 516); cw2a = *(const f32x4*)(cw + 1024); cw2b = *(const f32x4*)(cw + 1028);
    }
    asm volatile("" ::: "memory");
    if (MAIN) {
        { float f[8]; float ss = 0.f;
          if (lane < 48) { const u32x4 v = vq; f[0] = bflo(v.x); f[1] = bfhi(v.x); f[2] = bflo(v.y); f[3] = bfhi(v.y); f[4] = bflo(v.z); f[5] = bfhi(v.z); f[6] = bflo(v.w); f[7] = bfhi(v.w);
    #pragma unroll
              for (int j = 0; j < 8; ++j) ss += f[j] * f[j]; }
          else {
    #pragma unroll
              for (int j = 0; j < 8; ++j) f[j] = 0.f; }
          ss = wave_sum(ss); const float rinv = rsqrtf(ss * (1.0f / 384.0f) + EPS);
          if (lane < 48) { u32x4 w;
              w.x = cvt_pk_bf16(f[0] * rinv * gq0[0], f[1] * rinv * gq0[1]); w.y = cvt_pk_bf16(f[2] * rinv * gq0[2], f[3] * rinv * gq0[3]);
              w.z = cvt_pk_bf16(f[4] * rinv * gq1[0], f[5] * rinv * gq1[1]); w.w = cvt_pk_bf16(f[6] * rinv * gq1[2], f[7] * rinv * gq1[3]);
              *(u32x4*)((bf16_t*)(ws + WS_QA) + (size_t)row * 384 + lane * 8) = w; } }
        { const u32x2 v = vkv; const float f0 = bflo(v.x), f1 = bfhi(v.x), f2 = bflo(v.y), f3 = bfhi(v.y);
          const float ss = wave_sum(f0 * f0 + f1 * f1 + f2 * f2 + f3 * f3); const float rinv = rsqrtf(ss * (1.0f / 256.0f) + EPS);
          u32x2 w; w.x = cvt_pk_bf16(f0 * rinv * gkv[0], f1 * rinv * gkv[1]); w.y = cvt_pk_bf16(f2 * rinv * gkv[2], f3 * rinv * gkv[3]);
          *(u32x2*)((bf16_t*)(ws + WS_KVA) + (size_t)row * 256 + lane * 4) = w; }
        { float v = bf2f(vkr); const float partner = __shfl_xor(v, 16);
          if (lat) { const int jj = lane & 31; const float cs = rope.x, sn = rope.y;
              v = jj < 16 ? (v * cs - partner * sn) : (v * cs + partner * sn); }
          const int key = lat ? CTX + t : t; const unsigned short o = f2bf(v);
          bf16_t* kc = (bf16_t*)(ws + WS_KC);
    #pragma unroll
          for (int h = 0; h < 4; ++h) kc[((size_t)(b * 4 + h) * NKEY + key) * 192 + 128 + lane] = o; }
        { const u32x4 v = vs5; const int g = lane >> 1, half = lane & 1;
          *(u32x4*)((bf16_t*)(ws + WS_UPK) + ((size_t)g * 768 + (row >> 4)) * 512 + (row & 15) * 16 + half * 8) = v; }
    }
    if (CONV) {
        { float zp[8], zc[8], zn[8];
    #define CONV_Z(dst, a_, h_) do { \
              dst[0] = bflo(a_.x) * bflo(h_.x); dst[1] = bfhi(a_.x) * bfhi(h_.x); dst[2] = bflo(a_.y) * bflo(h_.y); dst[3] = bfhi(a_.y) * bfhi(h_.y); \
              dst[4] = bflo(a_.z) * bflo(h_.z); dst[5] = bfhi(a_.z) * bfhi(h_.z); dst[6] = bflo(a_.w) * bflo(h_.w); dst[7] = bfhi(a_.w) * bfhi(h_.w); } while (0)
          CONV_Z(zc, ca, ch); CONV_Z(zp, pa, ph); CONV_Z(zn, na, nh);
    #undef CONV_Z
          float bgf[8] = {bflo(bg.x), bfhi(bg.x), bflo(bg.y), bfhi(bg.y), bflo(bg.z), bfhi(bg.z), bflo(bg.w), bfhi(bg.w)};
          const float w0[8] = {cw0a[0], cw0a[1], cw0a[2], cw0a[3], cw0b[0], cw0b[1], cw0b[2], cw0b[3]}, w1[8] = {cw1a[0], cw1a[1], cw1a[2], cw1a[3], cw1b[0], cw1b[1], cw1b[2], cw1b[3]},
                      w2[8] = {cw2a[0], cw2a[1], cw2a[2], cw2a[3], cw2b[0], cw2b[1], cw2b[2], cw2b[3]};
          float o[8];
    #pragma unroll
          for (int j = 0; j < 8; ++j) o[j] = bgf[j] * (w0[j] * zp[j] + w1[j] * zc[j] + w2[j] * zn[j]);
          u32x4 w; w.x = cvt_pk_bf16(o[0], o[1]); w.y = cvt_pk_bf16(o[2], o[3]); w.z = cvt_pk_bf16(o[4], o[5]); w.w = cvt_pk_bf16(o[6], o[7]);
          *(u32x4*)(CAT + (size_t)row * DM + 1536 + c0) = w; }
    }
}
__device__ __forceinline__ void sgu_unit(const Params& p, int l, int un, LAS unsigned char* lds) {
    const int tid = opaque_tid(), lane = tid & 63, wave = tid >> 6;
    unsigned char* ws = opaque_ptr(p.ws);
    const bf16_t* P = (const bf16_t*)(ws + WS_PA);
    bf16_t* CAT = (bf16_t*)(ws + WS_CAT);
    const int cc = un >> 2, h = un & 3; const int row0 = cc * 128;
    LAS bf16_t* Wl = (LAS bf16_t*)lds;
    LAS bf16_t* Vl = (LAS bf16_t*)(lds + 128 * 136 * 2);
    const float* Wg = p.in[I_SGUW] + ((size_t)l * 4 + h) * 128 * 128;
    f32x4 wq[8]; u32x4 vv[16];
#pragma unroll
    for (int i = 0; i < 8; ++i) wq[i] = *(const f32x4*)(Wg + (i * 512 + tid) * 4);
#pragma unroll
    for (int qi = 0; qi < 16; ++qi) vv[qi] = *(const u32x4*)(P + (size_t)(row0 + wave * 16 + qi) * INP + C_SGU_V + lane * 8);
#pragma unroll
    for (int i = 0; i < 8; ++i) { const int e4 = (i * 512 + tid) * 4, r = e4 >> 7, c = e4 & 127; const f32x4 v = wq[i];
        u32x2 w; w.x = cvt_pk_bf16(v[0], v[1]); w.y = cvt_pk_bf16(v[2], v[3]); *(LAS u32x2*)(Wl + r * 136 + c) = w; }
#pragma unroll
    for (int qi = 0; qi < 16; ++qi) { const int q = wave * 16 + qi;
        const u32x4 v = vv[qi]; float f[8] = {bflo(v.x), bfhi(v.x), bflo(v.y), bfhi(v.y), bflo(v.z), bfhi(v.z), bflo(v.w), bfhi(v.w)}; float ss = 0.f;
#pragma unroll
        for (int j = 0; j < 8; ++j) { f[j] = gelu_tanh(f[j]); ss += f[j] * f[j]; }
        ss = wave_sum(ss); const float rinv = rsqrtf(ss * (1.0f / 512.0f) + EPS);
        if ((lane >> 4) == h) { const int c0 = (lane & 15) * 8; const float* g = p.in[I_SGUNG] + l * 512 + h * 128 + c0;
#pragma unroll
            for (int j = 0; j < 8; ++j) Vl[(c0 + j) * 136 + q] = f2bf(f[j] * rinv * g[j]); } }
    __syncthreads();
    { const int fr = lane & 15, fq = lane >> 4; f32x4 acc[8];
#pragma unroll
      for (int nb = 0; nb < 8; ++nb) acc[nb] = (f32x4){0.f, 0.f, 0.f, 0.f};
#pragma unroll
      for (int ks = 0; ks < 4; ++ks) { const bf16x8 af = *(const LAS bf16x8*)(Wl + (wave * 16 + fr) * 136 + ks * 32 + fq * 8);
#pragma unroll
          for (int nb = 0; nb < 8; ++nb) { const bf16x8 bfr = *(const LAS bf16x8*)(Vl + (nb * 16 + fr) * 136 + ks * 32 + fq * 8);
              acc[nb] = __builtin_amdgcn_mfma_f32_16x16x32_bf16(bfr, af, acc[nb], 0, 0, 0); } }
      const int pp = wave * 16 + fr; const float bias = p.in[I_SGUB][((size_t)l * 4 + h) * 128 + pp]; const bf16_t* pr = P + (size_t)(row0 + pp) * INP + C_SGU_U + h * 128;
      u32x2 uq[8];
#pragma unroll
      for (int nb = 0; nb < 8; ++nb) uq[nb] = *(const u32x2*)(pr + nb * 16 + 4 * fq);
#pragma unroll
      for (int nb = 0; nb < 8; ++nb) { const int c = nb * 16 + 4 * fq; const u32x2 uv = uq[nb];
          u32x2 w; w.x = cvt_pk_bf16(gelu_tanh(bflo(uv.x)) * (acc[nb][0] + bias), gelu_tanh(bfhi(uv.x)) * (acc[nb][1] + bias));
          w.y = cvt_pk_bf16(gelu_tanh(bflo(uv.y)) * (acc[nb][2] + bias), gelu_tanh(bfhi(uv.y)) * (acc[nb][3] + bias));
          *(u32x2*)(CAT + (size_t)(row0 + pp) * DM + h * 128 + c) = w; } }
    __syncthreads();
}
constexpr int B_ROWITEMS = MT / 8, B_SGU = 72 * 4, B_INTRA = 0;
__device__ __forceinline__ void ph_rowsplit(const Params& p, int l, LAS unsigned char* lds) {
    const int tid = opaque_tid(), lane = tid & 63, wave = tid >> 6;
    unsigned char* ws = opaque_ptr(p.ws);
    const bf16_t* P = (const bf16_t*)(ws + WS_PA);
    bf16_t* CAT = (bf16_t*)(ws + WS_CAT);
    const int nsgu = gridDim.x == 256 ? 0 : ((l == 0) ? B_SGU : 256);
    const int G_ = (int)gridDim.x, c_ = (int)blockIdx.x, nx = nsgu > G_ ? nsgu - G_ : 0;
    const bool bal = nx > 0 && nx < G_ && nsgu <= 2 * G_;
    const int nfew = bal ? 2 * nx : 0;
    const int nmine = (c_ < nsgu ? 1 : 0) + (c_ < nx ? 1 : 0);
    int rit = bal ? (c_ < nx ? c_ : nfew + (c_ - nx)) : c_; const int rstride = bal ? (c_ < nx ? nx : G_ - nx) : G_; const int rend = bal ? (c_ < nx ? nfew : B_ROWITEMS) : B_ROWITEMS;
    for (int k = 0; ; ++k) {
        int it;
        if (k < nmine) it = B_ROWITEMS + c_ + k * G_;
        else { if (rit >= rend) break; it = rit; rit += rstride; }
        if (it < B_ROWITEMS) {
            const int row = it * 8 + wave;
            if (gridDim.x == 256) b_row<true, false>(p, ws, l, row, lane); else b_row<true, true>(p, ws, l, row, lane);
        } else if (it < B_ROWITEMS + B_SGU) {
            sgu_unit(p, l, it - B_ROWITEMS, lds);
        }
    }
}

constexpr int KPITCH = 400, VPITCH = 144;
constexpr int KT_BYTES = 64 * KPITCH, VT_BYTES = 128 * VPITCH;
__device__ __forceinline__ void attn_unit(const bf16_t* Qrows  , const bf16_t* Kbh, const bf16_t* Vbh, int nkeys, bf16_t* Orows, LAS unsigned char* lds) {
    const int tid = opaque_tid(), lane = tid & 63, wave = tid >> 6, l32 = lane & 31, hi = lane >> 5, qg = wave & 3, kh = wave >> 2;
    constexpr int VRING = 3 * KT_BYTES;
    bf16x8 qf[12];
    { const bf16_t* qr = Qrows + (size_t)(qg * 32 + l32) * 768 + hi * 8;
#pragma unroll
      for (int ks = 0; ks < 12; ++ks) qf[ks] = *(const bf16x8*)(qr + ks * 16); }
    f32x16 o[4];
#pragma unroll
    for (int db = 0; db < 4; ++db)
#pragma unroll
        for (int r = 0; r < 16; ++r) o[db][r] = 0.f;
    float mrow = -1e30f, lsum = 0.f;
    const int nt = nkeys / 64;
    const int wv = __builtin_amdgcn_readfirstlane(wave);
    unsigned doffK[4], doffV[3];
#pragma unroll
    for (int i = 0; i < 4; ++i) { const int pc = (wv + 8 * i) < 25 ? (wv + 8 * i) : 24; const int X = pc * 1024 + lane * 16, row = X / KPITCH, col = X % KPITCH; doffK[i] = (unsigned)(row * 384 + (col < 384 ? col : 0)); }
#pragma unroll
    for (int i = 0; i < 3; ++i) { const int pc = (wv + 8 * i) < 18 ? (wv + 8 * i) : 17; const int Y = pc * 1024 + lane * 16, row = Y / VPITCH, col = Y % VPITCH; doffV[i] = (unsigned)(row * (NKEY * 2) + (col < 128 ? col : 0)); }
#define ATT_DMAK(tile, slot) do { _Pragma("unroll") for (int i = 0; i < 4; ++i) { const int pc = (wv + 8 * i) < 25 ? (wv + 8 * i) : 24; \
        __builtin_amdgcn_global_load_lds((const unsigned*)((const char*)Kbh + (size_t)(tile) * (64 * 384) + doffK[i]), (LAS unsigned*)(lds + (slot) * KT_BYTES + pc * 1024), 16, 0, 0); } } while (0)
#define ATT_DMAV(tile, slot) do { _Pragma("unroll") for (int i = 0; i < 3; ++i) { const int pc = (wv + 8 * i) < 18 ? (wv + 8 * i) : 17; \
        __builtin_amdgcn_global_load_lds((const unsigned*)((const char*)Vbh + (size_t)(tile) * 128 + doffV[i]), (LAS unsigned*)(lds + VRING + (slot) * VT_BYTES + pc * 1024), 16, 0, 0); } } while (0)
#define ATT_STEP(S, SN, QK, ks_, vs_) do { \
        float mx = S[0]; \
        _Pragma("unroll") for (int r = 1; r < 16; ++r) mx = fmaxf(mx, S[r]); \
        mx = fmaxf(mx, __shfl_xor(mx, 32)); \
        if (__any(mx > mrow + 8.0f)) { const float mnew = fmaxf(mrow, mx), alpha = __builtin_amdgcn_exp2f(mrow - mnew); mrow = mnew; lsum *= alpha; \
            _Pragma("unroll") for (int db = 0; db < 4; ++db) _Pragma("unroll") for (int r = 0; r < 16; ++r) o[db][r] *= alpha; } \
        __builtin_amdgcn_sched_barrier(0); \
        const LAS unsigned char* Vcur = lds + VRING + (vs_) * VT_BYTES; \
        u32x4 vf0[4], vf1[4]; \
        float ps = 0.f; u32x4 pw0, pw1; \
        if (QK) { const LAS unsigned char* kp = lds + (ks_) * KT_BYTES + (kh * 32 + l32) * KPITCH + hi * 16; \
            bf16x8 kf[12]; \
            _Pragma("unroll") for (int i = 0; i < 12; ++i) kf[i] = *(const LAS bf16x8*)(kp + i * 32); \
            _Pragma("unroll") for (int r = 0; r < 16; ++r) SN[r] = 0.f; \
            __builtin_amdgcn_sched_barrier(0); \
              \
            _Pragma("unroll") for (int i = 0; i < 12; ++i) { \
                SN = __builtin_amdgcn_mfma_f32_32x32x16_bf16(kf[i], qf[i], SN, 0, 0, 0); \
                S[i] = __builtin_amdgcn_exp2f(S[i] - mrow); ps += S[i]; \
                if (i < 4) { S[12 + i] = __builtin_amdgcn_exp2f(S[12 + i] - mrow); ps += S[12 + i]; } \
                if (i == 1) pw0.x = cvt_pk_bf16(S[0], S[1]); if (i == 3) { pw0.y = cvt_pk_bf16(S[2], S[3]); pw1.z = cvt_pk_bf16(S[12], S[13]); pw1.w = cvt_pk_bf16(S[14], S[15]); } \
                if (i == 5) pw0.z = cvt_pk_bf16(S[4], S[5]); if (i == 7) pw0.w = cvt_pk_bf16(S[6], S[7]); if (i == 9) pw1.x = cvt_pk_bf16(S[8], S[9]); if (i == 11) pw1.y = cvt_pk_bf16(S[10], S[11]); \
                if (i >= 8) { const int db = i - 8; const LAS unsigned char* vp = Vcur + (db * 32 + l32) * VPITCH + kh * 64 + hi * 16; \
                    vf0[db] = *(const LAS u32x4*)vp; vf1[db] = *(const LAS u32x4*)(vp + 32); } \
                __builtin_amdgcn_sched_barrier(0); } \
        } else { \
            _Pragma("unroll") for (int db = 0; db < 4; ++db) { const LAS unsigned char* vp = Vcur + (db * 32 + l32) * VPITCH + kh * 64 + hi * 16; \
                vf0[db] = *(const LAS u32x4*)vp; vf1[db] = *(const LAS u32x4*)(vp + 32); } \
            _Pragma("unroll") for (int r = 0; r < 16; ++r) { S[r] = __builtin_amdgcn_exp2f(S[r] - mrow); ps += S[r]; } \
            pw0.x = cvt_pk_bf16(S[0], S[1]); pw0.y = cvt_pk_bf16(S[2], S[3]); pw0.z = cvt_pk_bf16(S[4], S[5]); pw0.w = cvt_pk_bf16(S[6], S[7]); \
            pw1.x = cvt_pk_bf16(S[8], S[9]); pw1.y = cvt_pk_bf16(S[10], S[11]); pw1.z = cvt_pk_bf16(S[12], S[13]); pw1.w = cvt_pk_bf16(S[14], S[15]); } \
        lsum += ps; \
        { const bf16x8 pf = __builtin_bit_cast(bf16x8, pw0); \
          _Pragma("unroll") for (int db = 0; db < 4; ++db) o[db] = __builtin_amdgcn_mfma_f32_32x32x16_bf16(__builtin_bit_cast(bf16x8, vf0[db]), pf, o[db], 0, 0, 0); } \
        { const bf16x8 pf = __builtin_bit_cast(bf16x8, pw1); \
          _Pragma("unroll") for (int db = 0; db < 4; ++db) o[db] = __builtin_amdgcn_mfma_f32_32x32x16_bf16(__builtin_bit_cast(bf16x8, vf1[db]), pf, o[db], 0, 0, 0); } \
        __builtin_amdgcn_sched_barrier(0); } while (0)
#define ATT_SYNC(full) do { if (full) asm volatile("s_waitcnt vmcnt(7)" ::: "memory"); else asm volatile("s_waitcnt vmcnt(0)" ::: "memory"); \
        __builtin_amdgcn_s_barrier(); asm volatile("" ::: "memory"); } while (0)
    ATT_DMAK(0, 0); ATT_DMAV(0, 0); ATT_DMAK(1, 1); ATT_DMAV(1, 1); if (nt > 2) ATT_DMAK(2, 2);
    asm volatile("s_waitcnt vmcnt(0)" ::: "memory");
    __builtin_amdgcn_s_barrier(); asm volatile("" ::: "memory");
    f32x16 sA, sB;
    { const LAS unsigned char* kp = lds + (kh * 32 + l32) * KPITCH + hi * 16;
#pragma unroll
      for (int r = 0; r < 16; ++r) sA[r] = 0.f;
#pragma unroll
      for (int i = 0; i < 12; ++i) { const bf16x8 kf = *(const LAS bf16x8*)(kp + i * 32); sA = __builtin_amdgcn_mfma_f32_32x32x16_bf16(kf, qf[i], sA, 0, 0, 0); } }
    int k1 = 1, v0 = 0;
    int j = 0;
    for (; j + 2 < nt; j += 2) {
        ATT_SYNC(true);
        if (j + 3 < nt) ATT_DMAK(j + 3, v0);
        ATT_DMAV(j + 2, v0 == 0 ? 2 : v0 - 1);
        ATT_STEP(sA, sB, true, k1, v0);
        k1 = k1 == 2 ? 0 : k1 + 1; v0 = v0 == 2 ? 0 : v0 + 1;
        ATT_SYNC(j + 3 < nt);
        if (j + 4 < nt) ATT_DMAK(j + 4, v0);
        if (j + 3 < nt) ATT_DMAV(j + 3, v0 == 0 ? 2 : v0 - 1);
        ATT_STEP(sB, sA, true, k1, v0);
        k1 = k1 == 2 ? 0 : k1 + 1; v0 = v0 == 2 ? 0 : v0 + 1;
    }
    ATT_SYNC(false);
    ATT_STEP(sA, sB, true, k1, v0);
    k1 = k1 == 2 ? 0 : k1 + 1; v0 = v0 == 2 ? 0 : v0 + 1;
    ATT_SYNC(false);
    ATT_STEP(sB, sA, false, k1, v0);
#undef ATT_STEP
#undef ATT_SYNC
#undef ATT_DMAK
#undef ATT_DMAV
    __syncthreads();
    lsum += __shfl_xor(lsum, 32);
    LAS float* mb = (LAS float*)lds + (size_t)qg * 66 * 64 + lane;
    if (kh == 1) {
#pragma unroll
        for (int db = 0; db < 4; ++db)
#pragma unroll
            for (int r = 0; r < 16; ++r) mb[(db * 16 + r) * 64] = o[db][r];
        mb[64 * 64] = mrow; mb[65 * 64] = lsum;
    }
    __syncthreads();
    if (kh == 0) {
        const float m1 = mb[64 * 64], l1 = mb[65 * 64];
        const float m = fmaxf(mrow, m1), e0 = __builtin_amdgcn_exp2f(mrow - m), e1 = __builtin_amdgcn_exp2f(m1 - m);
        const float inv = 1.0f / (lsum * e0 + l1 * e1), c0 = e0 * inv, c1 = e1 * inv;
        bf16_t* orow = Orows + (size_t)(qg * 32 + l32) * DM;
#pragma unroll
        for (int db = 0; db < 4; ++db)
#pragma unroll
            for (int k4 = 0; k4 < 4; ++k4) { float v[4];
#pragma unroll
                for (int i = 0; i < 4; ++i) v[i] = o[db][4 * k4 + i] * c0 + mb[(db * 16 + 4 * k4 + i) * 64] * c1;
                u32x2 w; w.x = cvt_pk_bf16(v[0], v[1]); w.y = cvt_pk_bf16(v[2], v[3]);
                *(u32x2*)(orow + db * 32 + 8 * k4 + 4 * hi) = w; }
    }
    __syncthreads();
}
constexpr int CW_CARRY = 12288;
__device__ __forceinline__ void carry_wait(const Params& p, int l) {
    if (threadIdx.x == 0) { unsigned* bar = (unsigned*)(p.ws + WS_CTL); unsigned* cnt = bar + CW_CARRY + 64 * l;
        XB_SPIN(xb_ld(cnt) < 256u, bar);
        __builtin_amdgcn_fence(__ATOMIC_ACQUIRE, "agent"); asm volatile("s_waitcnt vmcnt(0)" ::: "memory"); }
    __syncthreads();
}
__device__ __forceinline__ void ph_attn_carry(const Params& p, int l, LAS unsigned char* lds) {
    unsigned char* ws = opaque_ptr(p.ws); const int tid = opaque_tid();
    const int natt = (l == 0) ? 288 : 256;
    const bf16_t* QB = (const bf16_t*)(ws + WS_QB); const bf16_t* KC = (const bf16_t*)(ws + WS_KC); const bf16_t* VT = (const bf16_t*)(ws + WS_VT); bf16_t* CAT = (bf16_t*)(ws + WS_CAT);
    unsigned ncarry = 0u;
    for (int it = natt + (int)blockIdx.x; it < natt + 256; it += gridDim.x, ++ncarry) {
        {
            const int u = it - natt; const int z = u >> 7, b = (u >> 5) & 3, g = u & 31, lane = tid & 63, w = tid >> 6;
            const f32x2 a16 = ((const f32x2*)(ws + WS_A16))[(((size_t)l * 2 + z) * 32 + g) * 64 + lane];
            const float* EST = (const float*)(ws + WS_EST) + (size_t)g * 768 * 256 + z * 128 + lane;
            bf16_t* UP = (bf16_t*)(ws + WS_UPK) + (size_t)g * 768 * 512 + 256 + z * 128 + lane;
            LAS f32x2* seg = (LAS f32x2*)lds;
            float er[18], ei[18];
#pragma unroll
            for (int i = 0; i < 18; ++i) { const int st = w * 18 + i; int chunk;
                if (z == 0) chunk = st < 16 ? (512 + b * 16 + st) : (b * 128 + (st - 16)); else chunk = st < 16 ? (512 + b * 16 + (15 - st)) : (b * 128 + (143 - st));
                er[i] = EST[(size_t)chunk * 256]; ei[i] = EST[(size_t)chunk * 256 + 64]; }
            float sr = 0.f, si = 0.f;
#pragma unroll
            for (int i = 0; i < 18; ++i) { const float nr = a16.x * sr - a16.y * si + er[i], ni = a16.x * si + a16.y * sr + ei[i]; sr = nr; si = ni; }
            seg[w * 64 + lane] = (f32x2){sr, si};
            float pr = 1.f, pi = 0.f;
#pragma unroll
            for (int i = 0; i < 18; ++i) { const float nr = pr * a16.x - pi * a16.y, ni = pr * a16.y + pi * a16.x; pr = nr; pi = ni; }
            __syncthreads();
            sr = 0.f; si = 0.f;
            for (int w2 = 0; w2 < w; ++w2) { const f32x2 sv = seg[w2 * 64 + lane]; const float nr = pr * sr - pi * si + sv.x, ni = pr * si + pi * sr + sv.y; sr = nr; si = ni; }
#pragma unroll
            for (int i = 0; i < 18; ++i) { const int st = w * 18 + i; int chunk;
                if (z == 0) chunk = st < 16 ? (512 + b * 16 + st) : (b * 128 + (st - 16)); else chunk = st < 16 ? (512 + b * 16 + (15 - st)) : (b * 128 + (143 - st));
                __hip_atomic_store(UP + (size_t)chunk * 512, f2bf(sr), __ATOMIC_RELAXED, __HIP_MEMORY_SCOPE_AGENT);
                __hip_atomic_store(UP + (size_t)chunk * 512 + 64, f2bf(si), __ATOMIC_RELAXED, __HIP_MEMORY_SCOPE_AGENT);
                const float nr = a16.x * sr - a16.y * si + er[i], ni = a16.x * si + a16.y * sr + ei[i]; sr = nr; si = ni; }
            __syncthreads();
        }
    }
    if (tid == 0 && ncarry) { asm volatile("s_waitcnt vmcnt(0)" ::: "memory");
        (void)__hip_atomic_fetch_add((unsigned*)(ws + WS_CTL) + CW_CARRY + 64 * l, ncarry, __ATOMIC_RELAXED, __HIP_MEMORY_SCOPE_AGENT); }
    for (int it = blockIdx.x; it < natt; it += gridDim.x) {
        {
            int b, h, row0, nkeys;
            if (it < 256) { const int x = it & 7, jj = it >> 3, bh = 2 * x + (jj >> 4); b = bh >> 2; h = bh & 3; row0 = b * SEQ + (jj & 15) * 128; nkeys = NKEY; }
            else { const int u = it - 256; b = u >> 3; h = (u >> 1) & 3; row0 = NLAT + b * CTX + (u & 1) * 128; nkeys = CTX; }
            attn_unit(QB + (size_t)row0 * 768 + h * 192, KC + (size_t)(b * 4 + h) * NKEY * 192, VT + (size_t)(b * 4 + h) * 128 * NKEY, nkeys, CAT + (size_t)row0 * DM + 512 + h * 128, lds);
        }
    }

}

__device__ __forceinline__ void ph_norm2_router(const Params& p, int l, LAS unsigned char* lds) {
    const int tid = opaque_tid(), lane = tid & 63, wave = tid >> 6;
    unsigned char* ws = opaque_ptr(p.ws); const float* mod = (const float*)(ws + WS_MOD) + (size_t)l * 5 * 12288;
    const int nrows = (l == 0) ? MT : NLAT;
    const float* WR = p.in[I_WROUTER] + (size_t)l * DM * NE;
    { f32x4 rv[16];
#pragma unroll
      for (int i = 0; i < 16; ++i) { const int idx = tid + 512 * i, c = idx & (DM - 1), e4 = idx >> 11; rv[i] = *(const f32x4*)(WR + (size_t)c * NE + e4 * 4); }
#pragma unroll
      for (int i = 0; i < 16; ++i) { const int idx = tid + 512 * i, c = idx & (DM - 1), e4 = idx >> 11; *(LAS f32x4*)(lds + (size_t)(((e4 * 8 + (c & 7)) * 256 + (c >> 3)) * 16)) = rv[i]; } }
    __syncthreads();
    const float* n2g = p.in[I_N2G] + l * DM;
    u32x4 xn[4];
    { const int it0 = blockIdx.x; if (it0 < nrows / 8) { const bf16_t* xr = (const bf16_t*)(ws + WS_XB) + (size_t)(it0 * 8 + wave) * DM + lane * 8;
#pragma unroll
        for (int j = 0; j < 4; ++j) xn[j] = *(const u32x4*)(xr + j * 512); } }
    for (int it = blockIdx.x; it < nrows / 8; it += gridDim.x) {
        const int row = it * 8 + wave; const int rr = row < NLAT ? (row >> 11) : 4;
        const float* m = mod + (size_t)rr * 12288 + lane * 8; const float* gp = n2g + lane * 8;
        u32x4 xv[4];
#pragma unroll
        for (int j = 0; j < 4; ++j) xv[j] = xn[j];
        { const int itn = it + (int)gridDim.x; if (itn < nrows / 8) { const bf16_t* xr = (const bf16_t*)(ws + WS_XB) + (size_t)(itn * 8 + wave) * DM + lane * 8;
#pragma unroll
            for (int j = 0; j < 4; ++j) xn[j] = *(const u32x4*)(xr + j * 512); } }
        float x[4][8]; float ss = 0.f;
#pragma unroll
        for (int j = 0; j < 4; ++j) { x[j][0] = bflo(xv[j].x); x[j][1] = bfhi(xv[j].x); x[j][2] = bflo(xv[j].y); x[j][3] = bfhi(xv[j].y); x[j][4] = bflo(xv[j].z); x[j][5] = bfhi(xv[j].z); x[j][6] = bflo(xv[j].w); x[j][7] = bfhi(xv[j].w);
#pragma unroll
            for (int i = 0; i < 8; ++i) ss += x[j][i] * x[j][i]; }
        ss = wave_sum(ss); const float rinv = rsqrtf(ss * (1.0f / DM) + EPS);
        bf16_t* orow = (bf16_t*)(ws + WS_H) + (size_t)row * DM + lane * 8;
        f32x4 lg[4];
#pragma unroll
        for (int e4 = 0; e4 < 4; ++e4) lg[e4] = (f32x4){0.f, 0.f, 0.f, 0.f};
        f32x4 mv[2][6];
#define H_MLOAD(dst, jj) do { dst[0] = *(const f32x4*)(gp + (jj) * 512); dst[1] = *(const f32x4*)(gp + (jj) * 512 + 4); dst[2] = *(const f32x4*)(m + 4 * DM + (jj) * 512); dst[3] = *(const f32x4*)(m + 4 * DM + (jj) * 512 + 4); \
            dst[4] = *(const f32x4*)(m + 3 * DM + (jj) * 512); dst[5] = *(const f32x4*)(m + 3 * DM + (jj) * 512 + 4); } while (0)
        H_MLOAD(mv[0], 0);
#pragma unroll
        for (int j = 0; j < 4; ++j) {
            if (j < 3) H_MLOAD(mv[(j + 1) & 1], j + 1);
            const f32x4 ga = mv[j & 1][0], gb = mv[j & 1][1], sa = mv[j & 1][2], sb = mv[j & 1][3], ha = mv[j & 1][4], hb = mv[j & 1][5];
            float y[8];
#pragma unroll
            for (int i = 0; i < 8; ++i) y[i] = x[j][i] * rinv * (i < 4 ? ga[i] : gb[i - 4]) * (1.0f + (i < 4 ? sa[i] : sb[i - 4])) + (i < 4 ? ha[i] : hb[i - 4]);
            u32x4 h; h.x = cvt_pk_bf16(y[0], y[1]); h.y = cvt_pk_bf16(y[2], y[3]); h.z = cvt_pk_bf16(y[4], y[5]); h.w = cvt_pk_bf16(y[6], y[7]);
            *(u32x4*)(orow + j * 512) = h;
#pragma unroll
            for (int i2 = 0; i2 < 8; i2 += 2) {
#pragma unroll
                for (int e4 = 0; e4 < 4; ++e4) { const f32x4 w0 = *(const LAS f32x4*)(lds + (size_t)(((e4 * 8 + i2) * 256 + j * 64 + lane) * 16)); const f32x4 w1 = *(const LAS f32x4*)(lds + (size_t)(((e4 * 8 + i2 + 1) * 256 + j * 64 + lane) * 16));
                    lg[e4] = __builtin_elementwise_fma(w0, (f32x4){y[i2], y[i2], y[i2], y[i2]}, lg[e4]); lg[e4] = __builtin_elementwise_fma(w1, (f32x4){y[i2 + 1], y[i2 + 1], y[i2 + 1], y[i2 + 1]}, lg[e4]); }
                __builtin_amdgcn_sched_barrier(0); } }
        float v8[8], v4[4], v2[2], v1;
#pragma unroll
        for (int e = 0; e < 8; ++e) { const float lo = lg[e >> 2][e & 3], hi_ = lg[(e + 8) >> 2][e & 3]; const float snd = (lane & 32) ? lo : hi_, kp = (lane & 32) ? hi_ : lo; v8[e] = kp + __shfl_xor(snd, 32); }
#pragma unroll
        for (int e = 0; e < 4; ++e) { const float snd = (lane & 16) ? v8[e] : v8[e + 4], kp = (lane & 16) ? v8[e + 4] : v8[e]; v4[e] = kp + __shfl_xor(snd, 16); }
#pragma unroll
        for (int e = 0; e < 2; ++e) { const float snd = (lane & 8) ? v4[e] : v4[e + 2], kp = (lane & 8) ? v4[e + 2] : v4[e]; v2[e] = kp + __shfl_xor(snd, 8); }
        { const float snd = (lane & 4) ? v2[0] : v2[1], kp = (lane & 4) ? v2[1] : v2[0]; v1 = kp + __shfl_xor(snd, 4); }
        v1 += __shfl_xor(v1, 1); v1 += __shfl_xor(v1, 2);
        float mx = v1; mx = fmaxf(mx, __shfl_xor(mx, 4)); mx = fmaxf(mx, __shfl_xor(mx, 8)); mx = fmaxf(mx, __shfl_xor(mx, 16)); mx = fmaxf(mx, __shfl_xor(mx, 32));
        const float ex = __expf(v1 - mx); float se = ex; se += __shfl_xor(se, 4); se += __shfl_xor(se, 8); se += __shfl_xor(se, 16); se += __shfl_xor(se, 32);
        if ((lane & 3) == 0) ((float*)(ws + WS_AFF))[(size_t)row * 16 + (lane >> 2)] = ex / se;
    }
}

__device__ __forceinline__ void ph_topk(const Params& p, int l, LAS unsigned char* lds) {
    const int tid = opaque_tid(), lane = tid & 63, wave = tid >> 6;
    unsigned char* ws = opaque_ptr(p.ws); const float* AFF = (const float*)(ws + WS_AFF);
    int* ROWTOK = (int*)(ws + WS_ROWTOK); float* ROWAFF = (float*)(ws + WS_ROWAFF); int* INV = (int*)(ws + WS_INV);
    LAS int* hist = (LAS int*)lds;
    LAS int* ctl = (LAS int*)(lds + 1024);
    LAS int* wsum = (LAS int*)(lds + 1280);
    const int nunits = (l == 0) ? 128 : 64;
    for (int it = blockIdx.x; it < nunits; it += gridDim.x) {
        const bool lat = it < 64; const int u = lat ? it : it - 64; const int b = u >> 4, e = u & 15;
        const int n = lat ? SEQ : CTX, cap = lat ? CAPL : CAPC;
        const int tok0 = lat ? b * SEQ : NLAT + b * CTX; const int rowbase = lat ? b * CAPL : 1024 + b * CAPC;
        unsigned key[4];
#pragma unroll
        for (int j = 0; j < 4; ++j) { const int t = tid * 4 + j; key[j] = t < n ? __float_as_uint(AFF[(size_t)(tok0 + t) * 16 + e]) : 0u; }
        unsigned prefix = 0u; int remaining = cap;
        for (int pass = 3; pass >= 0; --pass) {
            if (tid < 256) hist[tid] = 0;
            __syncthreads();
#pragma unroll
            for (int j = 0; j < 4; ++j) { const int t = tid * 4 + j; if (t < n) { const bool match = (pass == 3) || ((key[j] >> (8 * (pass + 1))) == (prefix >> (8 * (pass + 1)))); if (match) atomicAdd((int*)&hist[(key[j] >> (8 * pass)) & 255u], 1); } }
            __syncthreads();
            if (wave == 0) {
                const int b0 = hist[4 * lane], b1 = hist[4 * lane + 1], b2 = hist[4 * lane + 2], b3 = hist[4 * lane + 3];
                const int s = b0 + b1 + b2 + b3; int suf = s;
#pragma unroll
                for (int off = 1; off < 64; off <<= 1) { const int t = __shfl_down(suf, off); if (lane + off < 64) suf += t; }
                const int above = suf - s; const int c3 = above + b3, c2 = c3 + b2, c1 = c2 + b1, c0 = c1 + b0;
                if (above < remaining && c0 >= remaining) { int dg, nr;
                    if (c3 >= remaining) { dg = 4 * lane + 3; nr = remaining - above; } else if (c2 >= remaining) { dg = 4 * lane + 2; nr = remaining - c3; }
                    else if (c1 >= remaining) { dg = 4 * lane + 1; nr = remaining - c2; } else { dg = 4 * lane; nr = remaining - c1; }
                    ctl[0] = dg; ctl[1] = nr; }
            }
            __syncthreads();
            prefix |= ((unsigned)ctl[0]) << (8 * pass); remaining = ctl[1];
            __syncthreads();
        }
        int cgt = 0, ceq = 0;
#pragma unroll
        for (int j = 0; j < 4; ++j) { const int t = tid * 4 + j; if (t < n) { cgt += key[j] > prefix ? 1 : 0; ceq += key[j] == prefix ? 1 : 0; } }
        const int packed = cgt | (ceq << 16);
        int inc = packed;
#pragma unroll
        for (int off = 1; off < 64; off <<= 1) { const int t = __shfl_up(inc, off); if (lane >= off) inc += t; }
        if (lane == 63) wsum[wave] = inc;
        __syncthreads();
        int base = 0;
#pragma unroll
        for (int w8 = 0; w8 < 8; ++w8) base += (w8 < wave) ? wsum[w8] : 0;
        int excl = base + inc - packed; int egt = excl & 0xffff, eeq = excl >> 16;
#pragma unroll
        for (int j = 0; j < 4; ++j) { const int t = tid * 4 + j; if (t < n) {
                const bool gt = key[j] > prefix, eq = key[j] == prefix; const bool sel = gt || (eq && eeq < remaining);
                const int slot = egt + (eeq < remaining ? eeq : remaining);
                if (sel) { ROWTOK[e * EROWS + rowbase + slot] = tok0 + t; ROWAFF[e * EROWS + rowbase + slot] = __uint_as_float(key[j]); }
                INV[(size_t)(tok0 + t) * 16 + e] = sel ? rowbase + slot : -1;
                egt += gt ? 1 : 0; eeq += eq ? 1 : 0; } }
        __syncthreads();
    }
}

__device__ __forceinline__ void ph_gather(const Params& p, int l) {
    const int tid = opaque_tid(), lane = tid & 63, wave = tid >> 6;
    unsigned char* ws = opaque_ptr(p.ws); const int* ROWTOK = (const int*)(ws + WS_ROWTOK);
    const int rows_per_e = (l == 0) ? 1152 : 1024;
    const int nitems = NE * rows_per_e / 8;
    for (int it = blockIdx.x; it < nitems; it += gridDim.x) {
        const int ridx = it * 8 + wave; const int e = ridx / rows_per_e, r = ridx % rows_per_e;
        const int tok = ROWTOK[e * EROWS + r];
        const u32x4* src = (const u32x4*)((const bf16_t*)(ws + WS_H) + (size_t)tok * DM); u32x4* dst = (u32x4*)((bf16_t*)(ws + WS_PA) + ((size_t)e * EROWS + r) * DM);
#pragma unroll
        for (int j = 0; j < 4; ++j) dst[j * 64 + lane] = src[j * 64 + lane];
    }
}

__device__ __forceinline__ void ph_combine(const Params& p, int l) {
    const int tid = opaque_tid(), lane = tid & 63, wave = tid >> 6;
    unsigned char* ws = opaque_ptr(p.ws); const float* mod = (const float*)(ws + WS_MOD);
    const int nrows = (l == 0) ? MT : NLAT;
    const int* INV = (const int*)(ws + WS_INV); const bf16_t* YS = (const bf16_t*)(ws + WS_YS);
#define M_UNPACK(dst, v) do { dst[0] = bflo(v.x); dst[1] = bfhi(v.x); dst[2] = bflo(v.y); dst[3] = bfhi(v.y); dst[4] = bflo(v.z); dst[5] = bfhi(v.z); dst[6] = bflo(v.w); dst[7] = bfhi(v.w); } while (0)
    u32x4 xn[4]; int invn = -1;
    { const int it0 = blockIdx.x; if (it0 < nrows / 8) { const int r0 = it0 * 8 + wave; const bf16_t* xr = (const bf16_t*)(ws + WS_XB) + (size_t)r0 * DM + lane * 8;
#pragma unroll
        for (int j = 0; j < 4; ++j) xn[j] = *(const u32x4*)(xr + j * 512);
        if (lane < 16) invn = INV[(size_t)r0 * 16 + lane]; } }
    for (int it = blockIdx.x; it < nrows / 8; it += gridDim.x) {
        const int row = it * 8 + wave; const int rr = row < NLAT ? (row >> 11) : 4;
        float x[4][8], s[4][8];
        u32x4 xv[4];
#pragma unroll
        for (int j = 0; j < 4; ++j) xv[j] = xn[j];
        const int myinv = invn;
        { const int itn = it + (int)gridDim.x; invn = -1; if (itn < nrows / 8) { const int r1 = itn * 8 + wave; const bf16_t* xr = (const bf16_t*)(ws + WS_XB) + (size_t)r1 * DM + lane * 8;
#pragma unroll
            for (int j = 0; j < 4; ++j) xn[j] = *(const u32x4*)(xr + j * 512);
            if (lane < 16) invn = INV[(size_t)r1 * 16 + lane]; } }
#pragma unroll
        for (int j = 0; j < 4; ++j) { M_UNPACK(x[j], xv[j]);
#pragma unroll
            for (int i = 0; i < 8; ++i) s[j][i] = 0.f; }
        unsigned msk = (unsigned)__ballot(myinv >= 0);
        while (msk) {
            const int e0 = __builtin_ctz(msk); msk &= msk - 1; const bool two = msk != 0u; const int e1 = two ? __builtin_ctz(msk) : e0; if (two) msk &= msk - 1;
            const int r0 = __shfl(myinv, e0), r1 = __shfl(myinv, e1);
            const bf16_t* y0 = YS + ((size_t)e0 * EROWS + r0) * DM + lane * 8; const bf16_t* y1 = YS + ((size_t)e1 * EROWS + r1) * DM + lane * 8;
            u32x4 v0[4], v1[4];
#pragma unroll
            for (int j = 0; j < 4; ++j) { v0[j] = *(const u32x4*)(y0 + j * 512); v1[j] = *(const u32x4*)(y1 + j * 512); }
            const float f1 = two ? 1.0f : 0.0f;
#pragma unroll
            for (int j = 0; j < 4; ++j) { float a[8], b[8]; M_UNPACK(a, v0[j]); M_UNPACK(b, v1[j]);
#pragma unroll
                for (int i = 0; i < 8; ++i) s[j][i] += a[i] + f1 * b[i]; }
        }
        const float* gate = mod + (size_t)(l * 5 + rr) * 12288 + 5 * DM + lane * 8;
        float ss = 0.f;
#pragma unroll
        for (int j = 0; j < 4; ++j) { const f32x4 g0 = *(const f32x4*)(gate + j * 512), g1 = *(const f32x4*)(gate + j * 512 + 4);
#pragma unroll
            for (int i = 0; i < 8; ++i) { x[j][i] += (i < 4 ? g0[i] : g1[i - 4]) * s[j][i]; ss += x[j][i] * x[j][i]; } }
        ss = wave_sum(ss); const float rinv = rsqrtf(ss * (1.0f / DM) + EPS);
        if (l == 0) {
            bf16_t* xo = (bf16_t*)(ws + WS_XA) + (size_t)row * DM + lane * 8; bf16_t* ho = (bf16_t*)(ws + WS_H) + (size_t)row * DM + lane * 8;
            const float* m = mod + (size_t)(5 + rr) * 12288 + lane * 8;
            const float* g = p.in[I_N1G] + DM + lane * 8;
            f32x4 mv[2][6];
#define M_MLOAD(dst, jj) do { dst[0] = *(const f32x4*)(g + (jj) * 512); dst[1] = *(const f32x4*)(g + (jj) * 512 + 4); dst[2] = *(const f32x4*)(m + DM + (jj) * 512); dst[3] = *(const f32x4*)(m + DM + (jj) * 512 + 4); \
                dst[4] = *(const f32x4*)(m + (jj) * 512); dst[5] = *(const f32x4*)(m + (jj) * 512 + 4); } while (0)
            M_MLOAD(mv[0], 0);
#pragma unroll
            for (int j = 0; j < 4; ++j) {
                if (j < 3) M_MLOAD(mv[(j + 1) & 1], j + 1);
                u32x4 w; w.x = cvt_pk_bf16(x[j][0], x[j][1]); w.y = cvt_pk_bf16(x[j][2], x[j][3]); w.z = cvt_pk_bf16(x[j][4], x[j][5]); w.w = cvt_pk_bf16(x[j][6], x[j][7]);
                *(u32x4*)(xo + j * 512) = w;
                const f32x4 ga = mv[j & 1][0], gb = mv[j & 1][1], sa = mv[j & 1][2], sb = mv[j & 1][3], ha = mv[j & 1][4], hb = mv[j & 1][5];
                float y[8];
#pragma unroll
                for (int i = 0; i < 8; ++i) y[i] = x[j][i] * rinv * (i < 4 ? ga[i] : gb[i - 4]) * (1.0f + (i < 4 ? sa[i] : sb[i - 4])) + (i < 4 ? ha[i] : hb[i - 4]);
                u32x4 h; h.x = cvt_pk_bf16(y[0], y[1]); h.y = cvt_pk_bf16(y[2], y[3]); h.z = cvt_pk_bf16(y[4], y[5]); h.w = cvt_pk_bf16(y[6], y[7]);
                *(u32x4*)(ho + j * 512) = h; }
#undef M_MLOAD
        } else {
            float* orow = p.out + (size_t)row * DM + lane * 8; const float* g = p.in[I_FNG] + lane * 8;
            f32x4 gq[8];
#pragma unroll
            for (int j = 0; j < 4; ++j) { gq[2 * j] = *(const f32x4*)(g + j * 512); gq[2 * j + 1] = *(const f32x4*)(g + j * 512 + 4); }
#pragma unroll
            for (int j = 0; j < 4; ++j) { const f32x4 ga = gq[2 * j], gb = gq[2 * j + 1];
                *(f32x4*)(orow + j * 512) = (f32x4){x[j][0] * rinv * ga[0], x[j][1] * rinv * ga[1], x[j][2] * rinv * ga[2], x[j][3] * rinv * ga[3]};
                *(f32x4*)(orow + j * 512 + 4) = (f32x4){x[j][4] * rinv * gb[0], x[j][5] * rinv * gb[1], x[j][6] * rinv * gb[2], x[j][7] * rinv * gb[3]}; }
        }
    }
#undef M_UNPACK
}

constexpr int NPH_LAYER = 13, NPH = 2 + 2 * NPH_LAYER;
__global__ void __launch_bounds__(512, 2) fwd(Params p) {
    extern __shared__ __attribute__((aligned(16))) unsigned char lds_raw[];
    LAS unsigned char* lds = (LAS unsigned char*)lds_raw;
    volatile LAS unsigned* MISC = (volatile LAS unsigned*)(lds + LDS_MISC);
    if (threadIdx.x < 16) MISC[threadIdx.x] = 0u;
    __syncthreads();
    unsigned char* ws = p.ws;
    const int lo = p.ph_lo, hi = p.ph_hi;
    XcdBarrier bar; bar.bar = (unsigned*)(ws + WS_CTL); bar.x = 0; bar.st = MISC;
    if (hi - lo > 1) bar = xcd_barrier_post((unsigned*)(ws + WS_CTL), MISC);
    const int G = gridDim.x, c = blockIdx.x;
#ifndef QUOTA_E
#define QUOTA_E 0
#endif
#ifndef QUOTA_F
#define QUOTA_F 0
#endif
#ifndef NCONV_A
#define NCONV_A 72
#endif
#ifndef NCONV_G
#define NCONV_G 112
#endif
#ifndef NCONV_K
#define NCONV_K 40
#endif
    const int nconv = (G == 256) ? 1 : 0;
    const int GgA = G - nconv * NCONV_A, GgG = G - nconv * NCONV_G, GgK = G - nconv * NCONV_K;
#ifndef ONLY_PH
#define ONLY_PH -1
#endif
#define PSEL(id) (ONLY_PH < 0 || ONLY_PH == (id))
#ifndef DUP
#define DUP 0
#endif
#define NREP(id) ((((DUP) >> (id)) & 1) ? 2 : 1)
#define REPLOOP(id) for (int rep_ = 0; rep_ < NREP(id); ++rep_)
#define REPBAR(id) do { if (rep_ + 1 < NREP(id)) xcd_barrier(bar); } while (0)
#define IN(k) (lo <= (k) && (k) < hi)
#define SEAM(k) do { if (IN(k) && IN((k) + 1)) xcd_barrier(bar); } while (0)

    if (PSEL(0) && IN(0)) REPLOOP(0) { ph_prologue(p, lds); __syncthreads(); REPBAR(0); }
    SEAM(0);
    if (PSEL(1) && IN(1)) REPLOOP(1) { ph_norm1_tables(p); REPBAR(1); }
    SEAM(1);
    for (int l = 0; l < 2; ++l) {
        const int pb = 2 + NPH_LAYER * l;
        const float* mod = (const float*)(ws + WS_MOD) + (size_t)l * 5 * 12288;
        if (PSEL(2) && IN(pb + 0)) REPLOOP(2) {
            pg8::EpiStoreBf16 E{(bf16_t*)(ws + WS_PA), INP};
            if (l == 0) { if (c >= GgA) moe_convert_while(p, lds, pb + 0, GgA);
                else { pg8::TileSched S; S.init(ws + WS_H, (bf16_t*)(ws + WS_WTIN), DM, DM, MT / 256, INP / 256, 1, 0, 0, GgA, c, 0); pg8::gemm_phase(lds, pg8::Desc{DM, DM, DM}, S, E); if (nconv) moe_mark_done(p, pb + 0); } }
            else { pg8::InSchedLast S; S.init(ws + WS_H, (bf16_t*)(ws + WS_WTIN) + (size_t)INP * DM, G, c); pg8::gemm_phase(lds, pg8::Desc{DM, DM, DM}, S, E); }
            moe_fill(p, lds, pb + 0);
         REPBAR(2); }
        SEAM(pb + 0);
        if (PSEL(3) && IN(pb + 1)) REPLOOP(3) { ph_rowsplit(p, l, lds); __syncthreads();  REPBAR(3); }
        SEAM(pb + 1);
        if (PSEL(4) && IN(pb + 2)) REPLOOP(4) {
#ifndef C_SEL
#define C_SEL 15
#endif
            if (C_SEL & 1) { pg8::TileSched S; S.init(ws + WS_QA, (bf16_t*)(ws + WS_WTUQ) + (size_t)l * 768 * 384, 384, 384, (l == 0 ? MT : NLAT) / 256, 3, 1, 0, 0, G, c, 0);
              pg8::EpiQ E{(bf16_t*)(ws + WS_QB), (const f32x2*)(ws + WS_ROPE)}; pg8::gemm_phase(lds, pg8::Desc{384, 384, 384}, S, E); }
            if (C_SEL & 2) { pg8::TileSched S; S.init(ws + WS_KVA, (bf16_t*)(ws + WS_WTUKV) + (size_t)l * 1024 * 256, 256, 256, MT / 256, 2, 1, 0, 0, G, c, 112);
              pg8::EpiK E{(bf16_t*)(ws + WS_KC)}; pg8::gemm_phase(lds, pg8::Desc{256, 256, 256}, S, E); }
            if (C_SEL & 4) { pg8::TileSched S; S.init((bf16_t*)(ws + WS_WTUKV) + (size_t)l * 1024 * 256 + 512 * 256, ws + WS_KVA, 256, 256, 2, MT / 256, 1, 0, 0, G, c, 184);
              pg8::EpiV E{(bf16_t*)(ws + WS_VT)}; pg8::gemm_phase(lds, pg8::Desc{256, 256, 256}, S, E); }
            if (C_SEL & 8) { pg8::TileSched S; S.init(ws + WS_UPK, (bf16_t*)(ws + WS_WST) + (size_t)l * 32 * 256 * 256, 512, 256, 3, 1, 32, (size_t)768 * 512 * 2, (size_t)256 * 256 * 2, G, c, G == 256 ? 112 : 0);
              pg8::EpiS1 E{(float*)(ws + WS_EST)}; pg8::gemm_phase(lds, pg8::Desc{512, 256, 256}, S, E); }
            if (G == 256) { const int j = c < 112 ? c : (c >= 208 ? 112 + (c - 208) : -1);
                if (j >= 0) { unsigned char* wsq = opaque_ptr(p.ws); const int t_ = opaque_tid(); const int nit = (l == 0 ? MT : NLAT) / 8;
                    for (int it = j; it < nit; it += 160) b_row<false, true>(p, wsq, l, it * 8 + (t_ >> 6), t_ & 63); } }
            moe_fill(p, lds, pb + 2);
         REPBAR(4); }
        SEAM(pb + 2);
        if (PSEL(5) && IN(pb + 3)) REPLOOP(5) {
            ph_attn_carry(p, l, lds); __syncthreads();
            { pg8::TileSched S; S.init(ws + WS_UPK, (bf16_t*)(ws + WS_G2B) + (size_t)l * 32 * 256 * 512, 512, 512, 3, 1, 32, (size_t)768 * 512 * 2, (size_t)256 * 512 * 2, G, c, (l == 0 && G == 256) ? 32 : 0);
              pg8::EpiS2 E{(bf16_t*)(ws + WS_GB)};
              pg8::Unit u0; if (S.next(0, u0)) { carry_wait(p, l); pg8::gemm_phase(lds, pg8::Desc{512, 512, 512}, S, E); }
              else if (G == 256) { const int un = c - (l == 0 ? 128 : 96); if (un >= 0) sgu_unit(p, l, un, lds); } }
            REPBAR(5); }
        if (PSEL(6) && IN(pb + 4)) REPLOOP(6) { }
        SEAM(pb + 4);
        if (PSEL(7) && IN(pb + 5)) REPLOOP(7) {
            pg8::TileSched S; S.init(ws + WS_GB, (bf16_t*)(ws + WS_WTGLU) + (size_t)l * 512 * 512, 512, 512, (l == 0 ? MT : NLAT) / 256, 2, 1, 0, 0, G, c, 0);
            pg8::EpiGlu E{(const bf16_t*)(ws + WS_GB), p.in[I_BGLU] + l * 512, (bf16_t*)(ws + WS_CAT)};
            if (c < (l == 0 ? 72 : 64) || G != 256) pg8::gemm_phase(lds, pg8::Desc{512, 512, 512}, S, E);
            else { const int un = (l == 0 ? 128 + (c - 72) : 160 + (c - 64)); if (un < (l == 0 ? B_SGU : 256)) sgu_unit(p, l, un, lds); }
            moe_fill(p, lds, pb + 5);
         REPBAR(7); }
        SEAM(pb + 5);
        if (PSEL(8) && IN(pb + 6)) REPLOOP(8) {
            pg8::TileSched S; S.init(ws + WS_CAT, (bf16_t*)(ws + WS_WTOUT) + (size_t)l * DM * DM, DM, DM, (l == 0 ? MT : NLAT) / 256, DM / 256, 1, 0, 0, l == 0 ? GgG : G, c, 0);
            pg8::EpiOut E{p.in[I_X], p.in[I_CTX], l == 0 ? (const bf16_t*)nullptr : (const bf16_t*)(ws + WS_XA), mod + 2 * DM, (bf16_t*)(ws + WS_XB)};
            if (l == 0 && c >= GgG) moe_convert_while(p, lds, pb + 6, GgG);
            else if (l == 0) { pg8::gemm_phase(lds, pg8::Desc{DM, DM, DM}, S, E); if (nconv) moe_mark_done(p, pb + 6); }
            else { pg8::EpiOutBf Eb{(const bf16_t*)(ws + WS_XA), mod + 2 * DM, (bf16_t*)(ws + WS_XB)}; pg8::gemm_phase(lds, pg8::Desc{DM, DM, DM}, S, Eb); }
            moe_fill(p, lds, pb + 6);
         REPBAR(8); }
        SEAM(pb + 6);
        if (PSEL(9) && IN(pb + 7)) REPLOOP(9) { ph_norm2_router(p, l, lds); __syncthreads(); REPBAR(9); }
        SEAM(pb + 7);
        if (PSEL(10) && IN(pb + 8)) REPLOOP(10) { ph_topk(p, l, lds); __syncthreads(); moe_require(p, lds, l * Q_LAYER + Q_GU);  REPBAR(10); }
        if (PSEL(11) && IN(pb + 9)) REPLOOP(11) { }
        SEAM(pb + 9);
        if (PSEL(12) && IN(pb + 10)) REPLOOP(12) {
            pg8::MoeSched S; S.init(ws + WS_H, (bf16_t*)(ws + WS_WTGU) + (size_t)l * NE * 2048 * DM, DM, DM, l == 0 ? 5 : 4, 8, 0, (size_t)2048 * DM * 2, l == 0 ? GgK : G, c);
            pg8::EpiGU E{(bf16_t*)(ws + WS_HID)};
            if (l == 0 && c >= GgK) moe_convert_while(p, lds, pb + 10, GgK); else { pg8::gemm_phase<pg8::EpiGU, pg8::MoeSched, true>(lds, pg8::Desc{DM, DM, DM}, S, E, (const int*)(ws + WS_ROWTOK), l == 0 ? 1152 : 1024); if (l == 0 && nconv) moe_mark_done(p, pb + 10); }
            moe_require(p, lds, (l + 1) * Q_LAYER); moe_fill(p, lds, pb + 10);
         REPBAR(12); }
        SEAM(pb + 10);
        if (PSEL(13) && IN(pb + 11)) REPLOOP(13) {
            pg8::MoeSched S; S.init(ws + WS_HID, (bf16_t*)(ws + WS_WTDN) + (size_t)l * NE * DM * FF, FF, FF, l == 0 ? 5 : 4, 8, (size_t)EROWS * FF * 2, (size_t)DM * FF * 2, l == 0 ? GgK : G, c);
            pg8::EpiDown E{(bf16_t*)(ws + WS_YS), (const float*)(ws + WS_ROWAFF)};
            if (l == 0 && c >= GgK) moe_convert_while(p, lds, pb + 11, GgK); else { pg8::gemm_phase(lds, pg8::Desc{FF, FF, FF}, S, E); if (l == 0 && nconv) moe_mark_done(p, pb + 11); }
            moe_fill(p, lds, pb + 11);
         REPBAR(13); }
        SEAM(pb + 11);
        if (PSEL(14) && IN(pb + 12)) REPLOOP(14) { ph_combine(p, l);  REPBAR(14); }
        SEAM(pb + 12);
    }
#undef IN
#undef SEAM
}

extern "C" void kernel_launch(void* const* d_in, const int* in_sizes, int n_in, void* d_out, int out_size, void* d_ws, size_t ws_size, hipStream_t stream) {
    static int grid = 0;
    if (grid == 0) {
        if (n_in != 33 || ws_size < WS_END) { fprintf(stderr, "kernel_launch: need 33 inputs and >= %zu bytes of workspace; got %d, %zu\n", (size_t)WS_END, n_in, ws_size); grid = -1; return; }
        int dev = 0, cus = 0;
        if (hipGetDevice(&dev) != hipSuccess || hipDeviceGetAttribute(&cus, hipDeviceAttributeMultiprocessorCount, dev) != hipSuccess) { grid = -1; return; }
        if (hipFuncSetAttribute((const void*)fwd, hipFuncAttributeMaxDynamicSharedMemorySize, LDS_BYTES) != hipSuccess) { fprintf(stderr, "kernel_launch: hipFuncSetAttribute failed\n"); grid = -1; return; }
        (void)hipGetLastError();
        grid = cus > 256 ? 256 : cus;
    }
    if (grid < 0) return;
    (void)hipMemsetAsync((char*)d_ws + WS_CTL, 0, CTL_BYTES, stream);
    Params a{};
    for (int i = 0; i < 33; ++i) a.in[i] = (const float*)d_in[i];
    a.out = (float*)d_out; a.ws = (unsigned char*)d_ws;
#if MK_SPLIT
    for (int ph = 0; ph < NPH; ++ph) { a.ph_lo = ph; a.ph_hi = ph + 1; hipLaunchKernelGGL(fwd, dim3(grid), dim3(512), LDS_BYTES, stream, a); }
#else
    a.ph_lo = 0; a.ph_hi = NPH; hipLaunchKernelGGL(fwd, dim3(grid), dim3(512), LDS_BYTES, stream, a);
#endif
}
```
